# Optimizing an MI355X kernel written in HIP

```python
import math
import jax, jax.numpy as jnp
from jax import lax
import numpy as np

D_MODEL = 1024
BATCH = 8
SEQ = 2048
DEPTH = 4
DEC_BATCH = 32
DEC_SEQ = 8
PAST_LEN = 8192
PAGE_SIZE = 128

MIX_W = D_MODEL
SSD_W = MIX_W // 2
SSD_HD = 64
SSD_H = SSD_W // SSD_HD
SSD_N = 128
SSD_G = 2
SSD_CONV = 4
SSD_CHUNK = 128
SSD_CONV_DIM = SSD_W + 2 * SSD_G * SSD_N
POOL_W = MIX_W // 4
POOL_WINDOWS = (2, 4, 8, 16)
POOL_GC = POOL_W // len(POOL_WINDOWS)
POOL_KEEP = max(POOL_WINDOWS) - 1
NSA_W = MIX_W // 4
NSA_HD = 64
NSA_H = NSA_W // NSA_HD
CMP_STRIDE = 16
CMP_LEN = 2 * CMP_STRIDE
CMP_HID = 2 * NSA_HD
SLC_BLOCK = 64
N_SELECT = 16
WINDOW = 512
Q_BLOCK = 128
ROPE_DIM = NSA_HD // 4
ROPE_THETA = 500000.0
D_FF = 4 * D_MODEL
FFN_CONV = 3
RMS_EPS = 1e-6
OFF_Z = SSD_W
OFF_XBC = OFF_Z + SSD_CONV_DIM
OFF_DT = OFF_XBC + SSD_H
OFF_POOL = OFF_DT + POOL_W
OFF_Q = OFF_POOL + NSA_W
OFF_KV = OFF_Q + 6 * NSA_HD
IN_W = OFF_KV + 3 * NSA_H
IN_SPLITS = (OFF_Z, OFF_XBC, OFF_DT, OFF_POOL, OFF_Q, OFF_KV)

kernel_name = 'hymba_ssd_pool_nsa_decode_step'


def rmsnorm(x, w):
    xf = x.astype(jnp.float32)
    y = xf * lax.rsqrt(jnp.mean(xf * xf, axis=-1, keepdims=True) + RMS_EPS)
    return (y * w.astype(jnp.float32)).astype(x.dtype)


def rope(x, pos):
    half = ROPE_DIM // 2
    inv = 1.0 / (ROPE_THETA ** (jnp.arange(half, dtype=jnp.float32) / half))
    ang = pos.astype(jnp.float32)[:, None] * inv
    shape = (ang.shape[0],) + (1,) * (x.ndim - 3) + (half,)
    cos = jnp.cos(ang).reshape(shape)
    sin = jnp.sin(ang).reshape(shape)
    xf = x.astype(jnp.float32)
    x1 = xf[..., :half]
    x2 = xf[..., half:ROPE_DIM]
    out = jnp.concatenate([x1 * cos - x2 * sin, x2 * cos + x1 * sin, xf[..., ROPE_DIM:]], axis=-1)
    return out.astype(x.dtype)


def causal_dwconv(u, prev, w, b):
    k_w = w.shape[0]
    t = u.shape[1]
    ext = jnp.concatenate([prev, u], axis=1)
    out = ext[:, :t] * w[0]
    for k in range(1, k_w):
        out = out + ext[:, k:k + t] * w[k]
    return out + b, ext[:, t:]


def masked_softmax(s, mask):
    s = jnp.where(mask, s, -jnp.inf)
    m = jnp.max(s, axis=-1, keepdims=True)
    m = jnp.where(jnp.isfinite(m), m, 0.0)
    e = jnp.where(mask, jnp.exp(s - m), 0.0)
    return e / jnp.maximum(jnp.sum(e, axis=-1, keepdims=True), 1e-30)


def segsum(a):
    t = a.shape[-1]
    x = jnp.broadcast_to(a[..., :, None], a.shape + (t,))
    s = jnp.cumsum(jnp.where(jnp.tril(jnp.ones((t, t), bool), -1), x, 0.0), axis=-2)
    return jnp.where(jnp.tril(jnp.ones((t, t), bool)), s, -jnp.inf)


def ssd_chunked(x, dt, a, bg, cg, h0):
    b, t, h, p = x.shape
    q = min(SSD_CHUNK, t)
    nc = -(-t // q)
    pad = nc * q - t
    def padt(v):
        return jnp.pad(v, ((0, 0), (0, pad)) + ((0, 0),) * (v.ndim - 2))
    x, dt, bg, cg = padt(x), padt(dt), padt(bg), padt(cg)
    rep = h // SSD_G
    bh = jnp.repeat(bg, rep, axis=2).reshape(b, nc, q, h, SSD_N)
    ch = jnp.repeat(cg, rep, axis=2).reshape(b, nc, q, h, SSD_N)
    xc = (x * dt[..., None]).reshape(b, nc, q, h, p)
    ac = (dt * a).reshape(b, nc, q, h).transpose(0, 3, 1, 2)
    a_cum = jnp.cumsum(ac, axis=-1)
    decay_in = jnp.exp(segsum(ac))
    scores = jnp.einsum('bclhn,bcshn->bhcls', ch, bh) * decay_in
    y_diag = jnp.einsum('bhcls,bcshp->bclhp', scores, xc)
    decay_to_end = jnp.exp(a_cum[..., -1:] - a_cum)
    chunk_states = jnp.einsum('bclhn,bhcl,bclhp->bchpn', bh, decay_to_end, xc)
    states = jnp.concatenate([h0[:, None], chunk_states], axis=1)
    chunk_decay = jnp.exp(segsum(jnp.pad(a_cum[..., -1], ((0, 0), (0, 0), (1, 0)))))
    states = jnp.einsum('bhzc,bchpn->bzhpn', chunk_decay, states)
    y_off = jnp.einsum('bclhn,bchpn,bhcl->bclhp', ch, states[:, :-1], jnp.exp(a_cum))
    y = (y_diag + y_off).reshape(b, nc * q, h, p)[:, :t]
    return y, states[:, -1]


def ssd_mixer(z, xbc, dt_raw, conv_prev, ssm_prev, conv_w, conv_b, dt_bias, a_log, d_skip, norm_w):
    f32 = jnp.float32
    b, t, _ = z.shape
    xbc, conv_new = causal_dwconv(xbc, conv_prev, conv_w, conv_b)
    xbc = jax.nn.silu(xbc)
    xs, bm, cm = jnp.split(xbc, (SSD_W, SSD_W + SSD_G * SSD_N), axis=-1)
    xh = xs.reshape(b, t, SSD_H, SSD_HD).astype(f32)
    dt = jax.nn.softplus(dt_raw.astype(f32) + dt_bias.astype(f32))
    a = -jnp.exp(a_log.astype(f32))
    y, ssm_new = ssd_chunked(xh, dt, a, bm.reshape(b, t, SSD_G, SSD_N).astype(f32),
                             cm.reshape(b, t, SSD_G, SSD_N).astype(f32), ssm_prev.astype(f32))
    y = y + d_skip.astype(f32)[:, None] * xh
    y = y.reshape(b, t, SSD_W) * jax.nn.silu(z.astype(f32))
    y = rmsnorm(y, norm_w)
    return y.astype(z.dtype), conv_new, ssm_new.astype(ssm_prev.dtype)


def pool_mixer(u, prev, pos0, w_grp, scale):
    b, t, c = u.shape
    ext = jnp.concatenate([prev, u], axis=1).astype(jnp.float32)
    cs = jnp.concatenate([jnp.zeros((b, 1, c), jnp.float32), jnp.cumsum(ext, axis=1)], axis=1)
    pos = pos0 + jnp.arange(t)
    outs = []
    for g, w in enumerate(POOL_WINDOWS):
        sl = slice(g * POOL_GC, (g + 1) * POOL_GC)
        s = cs[:, POOL_KEEP + 1:POOL_KEEP + 1 + t, sl] - cs[:, POOL_KEEP + 1 - w:POOL_KEEP + 1 - w + t, sl]
        cnt = jnp.minimum(pos + 1, w).astype(jnp.float32)
        outs.append(s / cnt[None, :, None])
    pooled = jnp.concatenate(outs, axis=-1) - u.astype(jnp.float32)
    y = jnp.einsum('btgc,gcd->btgd', pooled.reshape(b, t, len(POOL_WINDOWS), POOL_GC), w_grp.astype(jnp.float32))
    y = y.reshape(b, t, c) * scale.astype(jnp.float32)
    return y.astype(u.dtype), ext[:, -POOL_KEEP:].astype(u.dtype)


def compress_blocks(rows, pe, w1, w2):
    b, l, d = rows.shape
    n_ch = -(-l // CMP_STRIDE)
    rows = jnp.pad(rows, ((0, 0), (0, n_ch * CMP_STRIDE - l), (0, 0)))
    ch = rows.reshape(b, n_ch, CMP_STRIDE, d)
    h = (jnp.einsum('bnld,lde->bne', ch[:, :-1] + pe[:CMP_STRIDE], w1[:CMP_STRIDE])
         + jnp.einsum('bnld,lde->bne', ch[:, 1:] + pe[CMP_STRIDE:], w1[CMP_STRIDE:]))
    return jax.nn.gelu(h) @ w2


def nsa_attend(q, gates, full, win_ext, pos0, pe_k, pe_v, w1_k, w1_v, w2_k, w2_v):
    f32 = jnp.float32
    b, t, h, d = q.shape
    q = q.astype(f32) * (d ** -0.5)
    gates = gates.astype(f32)
    full = full.astype(f32)
    win_ext = win_ext.astype(f32)
    lk = full.shape[1]
    ck = compress_blocks(full[:, :, 0], pe_k.astype(f32), w1_k.astype(f32), w2_k.astype(f32))
    cv = compress_blocks(full[:, :, 1], pe_v.astype(f32), w1_v.astype(f32), w2_v.astype(f32))
    n_cmp = ck.shape[1]
    cmp_end = jnp.arange(n_cmp) * CMP_STRIDE + (CMP_LEN - 1)
    n_slc = -(-lk // SLC_BLOCK)
    pad_k = n_slc * SLC_BLOCK - lk
    ks = jnp.pad(full[:, :, 2], ((0, 0), (0, pad_k), (0, 0)))
    vs = jnp.pad(full[:, :, 3], ((0, 0), (0, pad_k), (0, 0)))
    c_start = jnp.arange(n_cmp)[:, None] * CMP_STRIDE
    s_start = jnp.arange(n_slc)[None, :] * SLC_BLOCK
    overlap = ((c_start < s_start + SLC_BLOCK) & (c_start + CMP_LEN > s_start)).astype(f32)
    n_sel = min(N_SELECT, n_slc)
    blk = jnp.arange(n_slc)
    qb_len = min(Q_BLOCK, t)
    n_qb = -(-t // qb_len)
    pad_q = n_qb * qb_len - t
    qp = jnp.pad(q, ((0, 0), (0, pad_q), (0, 0), (0, 0)))
    gp = jnp.pad(gates, ((0, 0), (0, pad_q), (0, 0), (0, 0)))
    wk = jnp.pad(win_ext[:, :, 0], ((0, 0), (0, pad_q), (0, 0)))
    wv = jnp.pad(win_ext[:, :, 1], ((0, 0), (0, pad_q), (0, 0)))
    band = WINDOW + qb_len

    def query_block(args):
        qb, gb, s = args
        tpos = pos0 + s + jnp.arange(qb_len)
        sc = jnp.einsum('bqhd,bnd->bhqn', qb, ck)
        pc = masked_softmax(sc, (cmp_end[None, :] <= tpos[:, None])[None, None])
        o_cmp = jnp.einsum('bhqn,bnd->bqhd', pc, cv)
        imp = jnp.einsum('bhqn,nj->bqj', pc, overlap)
        cur = (tpos // SLC_BLOCK)[:, None]
        forced = (blk[None] == 0) | (blk[None] == cur) | (blk[None] == cur - 1)
        imp = jnp.where(forced[None], jnp.inf, imp)
        imp = jnp.where((blk[None] * SLC_BLOCK <= tpos[:, None])[None], imp, -jnp.inf)
        top_v, top_i = lax.top_k(imp, n_sel)
        tok = (top_i[..., None] * SLC_BLOCK + jnp.arange(SLC_BLOCK)).reshape(b, qb_len, n_sel * SLC_BLOCK)
        kg = jax.vmap(lambda kk, ii: kk[ii])(ks, tok)
        vg = jax.vmap(lambda vv, ii: vv[ii])(vs, tok)
        smask = (tok <= tpos[None, :, None]) & jnp.repeat(top_v > -jnp.inf, SLC_BLOCK, axis=-1)
        ss = jnp.einsum('bqhd,bqsd->bhqs', qb, kg)
        ps = masked_softmax(ss, smask[:, None])
        o_slc = jnp.einsum('bhqs,bqsd->bqhd', ps, vg)
        kw = lax.dynamic_slice_in_dim(wk, s, band, axis=1)
        vw = lax.dynamic_slice_in_dim(wv, s, band, axis=1)
        kpos = pos0 - WINDOW + s + jnp.arange(band)
        wmask = (kpos[None] >= 0) & (kpos[None] <= tpos[:, None]) & (kpos[None] > tpos[:, None] - WINDOW)
        sw = jnp.einsum('bqhd,bkd->bhqk', qb, kw)
        pw = masked_softmax(sw, wmask[None, None])
        o_win = jnp.einsum('bhqk,bkd->bqhd', pw, vw)
        return gb[..., 0:1] * o_cmp + gb[..., 1:2] * o_slc + gb[..., 2:3] * o_win

    qs = qp.reshape(b, n_qb, qb_len, h, d).swapaxes(0, 1)
    gs = gp.reshape(b, n_qb, qb_len, h, 3).swapaxes(0, 1)
    starts = jnp.arange(n_qb, dtype=jnp.int32) * qb_len
    out = lax.map(query_block, (qs, gs, starts))
    return out.swapaxes(0, 1).reshape(b, n_qb * qb_len, h, d)[:, :t]


def conv_ffn(h, prev, w_gate, w_val, conv_w, conv_b, w_down):
    gc, new_prev = causal_dwconv(h @ w_gate, prev, conv_w, conv_b)
    act = jax.nn.gelu(gc, approximate=True) * (h @ w_val)
    return act @ w_down, new_prev


def hybrid_layer(x, pos0, nsa_past, win_prefix, win_keep, conv_prev, ssm_prev, pool_prev, ffn_prev, p):
    b, t, _ = x.shape
    pos = pos0 + jnp.arange(t, dtype=jnp.int32)
    h = rmsnorm(x, p['norm_mix_pre'])
    proj = h @ p['w_in']
    z, xbc, dt_raw, u_pool, q, kv, g = jnp.split(proj, IN_SPLITS, axis=-1)
    y_ssd, conv_new, ssm_new = ssd_mixer(z, xbc, dt_raw, conv_prev, ssm_prev, p['ssd_conv_w'], p['ssd_conv_b'],
                                         p['ssd_dt_bias'], p['ssd_a_log'], p['ssd_d'], p['ssd_norm'])
    y_pool, pool_new = pool_mixer(u_pool, pool_prev, pos0, p['pool_w'], p['pool_scale'])
    q = rope(q.reshape(b, t, NSA_H, NSA_HD), pos)
    kv = kv.reshape(b, t, 6, NSA_HD)
    rows = jnp.stack([rope(kv[:, :, 0::2], pos), kv[:, :, 1::2]], axis=3).reshape(b, t, 6, NSA_HD)
    cache_rows = rows[:, :, :4]
    win_ext = jnp.concatenate([win_prefix, rows[:, :, 4:]], axis=1)
    full = cache_rows if nsa_past is None else jnp.concatenate([nsa_past, cache_rows], axis=1)
    gates = jax.nn.sigmoid(g.reshape(b, t, NSA_H, 3))
    y_nsa = nsa_attend(q, gates, full, win_ext, pos0, p['nsa_pe_k'], p['nsa_pe_v'], p['nsa_w1_k'],
                       p['nsa_w1_v'], p['nsa_w2_k'], p['nsa_w2_v']).astype(x.dtype)
    new_win = win_ext[:, -win_keep:]
    mix = jnp.concatenate([y_ssd, y_pool, y_nsa.reshape(b, t, NSA_W)], axis=-1) @ p['w_out']
    x = x + rmsnorm(mix, p['norm_mix_post'])
    f, ffn_new = conv_ffn(rmsnorm(x, p['norm_ffn_pre']), ffn_prev, p['ffn_w_gate'], p['ffn_w_val'],
                          p['ffn_conv_w'], p['ffn_conv_b'], p['ffn_w_down'])
    x = x + rmsnorm(f, p['norm_ffn_post'])
    return x, (cache_rows, new_win, conv_new, ssm_new, pool_new, ffn_new)


def setup_inputs(seed: int = 0) -> dict:
    key = jax.random.key(seed)
    keys = iter(jax.random.split(key, 48))
    f32 = jnp.float32

    def nrm(shape, scale):
        return jax.random.normal(next(keys), shape, f32) * scale

    def gain(shape):
        return 1.0 + nrm(shape, 0.05)

    n_pages = PAST_LEN // PAGE_SIZE
    n_phys = (5 * DEC_BATCH * n_pages + 3) // 4
    win_buf = min(WINDOW, PAST_LEN)
    perm = jax.random.permutation(next(keys), n_phys)
    page_table = perm[:DEC_BATCH * n_pages].reshape(DEC_BATCH, n_pages).astype(jnp.int32)
    u = jax.random.uniform(next(keys), (DEPTH, SSD_H), f32)
    dt0 = jnp.exp(u * (math.log(0.1) - math.log(0.001)) + math.log(0.001))
    ssd_dt_bias = dt0 + jnp.log(-jnp.expm1(-dt0))
    ssd_a_log = jnp.log(jax.random.uniform(next(keys), (DEPTH, SSD_H), f32, 1.0, 16.0))
    return {
        'x_prompt': nrm((BATCH, SEQ, D_MODEL), 1.0),
        'x_sample': nrm((DEC_BATCH, DEC_SEQ, D_MODEL), 1.0),
        'cache_nsa_kv': nrm((DEPTH, n_phys, PAGE_SIZE, 4, NSA_HD), 1.0),
        'page_table': page_table,
        'state_nsa_win': nrm((DEPTH, DEC_BATCH, win_buf, 2, NSA_HD), 1.0),
        'state_ssd_conv': nrm((DEPTH, DEC_BATCH, SSD_CONV - 1, SSD_CONV_DIM), 1.0),
        'state_ssm': nrm((DEPTH, DEC_BATCH, SSD_H, SSD_HD, SSD_N), 0.1),
        'state_pool': nrm((DEPTH, DEC_BATCH, POOL_KEEP, POOL_W), 1.0),
        'state_ffn_conv': nrm((DEPTH, DEC_BATCH, FFN_CONV - 1, D_FF), 1.0),
        'norm_mix_pre': gain((DEPTH, D_MODEL)),
        'w_in': nrm((DEPTH, D_MODEL, IN_W), D_MODEL ** -0.5),
        'ssd_conv_w': nrm((DEPTH, SSD_CONV, SSD_CONV_DIM), SSD_CONV ** -0.5),
        'ssd_conv_b': nrm((DEPTH, SSD_CONV_DIM), 0.02),
        'ssd_dt_bias': ssd_dt_bias,
        'ssd_a_log': ssd_a_log,
        'ssd_d': gain((DEPTH, SSD_H)),
        'ssd_norm': gain((DEPTH, SSD_W)),
        'pool_w': nrm((DEPTH, len(POOL_WINDOWS), POOL_GC, POOL_GC), POOL_GC ** -0.5),
        'pool_scale': 1.0 + nrm((DEPTH, POOL_W), 0.1),
        'nsa_pe_k': nrm((DEPTH, CMP_LEN, NSA_HD), 0.1),
        'nsa_pe_v': nrm((DEPTH, CMP_LEN, NSA_HD), 0.1),
        'nsa_w1_k': nrm((DEPTH, CMP_LEN, NSA_HD, CMP_HID), (CMP_LEN * NSA_HD) ** -0.5),
        'nsa_w1_v': nrm((DEPTH, CMP_LEN, NSA_HD, CMP_HID), (CMP_LEN * NSA_HD) ** -0.5),
        'nsa_w2_k': nrm((DEPTH, CMP_HID, NSA_HD), CMP_HID ** -0.5),
        'nsa_w2_v': nrm((DEPTH, CMP_HID, NSA_HD), CMP_HID ** -0.5),
        'w_out': nrm((DEPTH, MIX_W, D_MODEL), MIX_W ** -0.5),
        'norm_mix_post': gain((DEPTH, D_MODEL)),
        'norm_ffn_pre': gain((DEPTH, D_MODEL)),
        'ffn_w_gate': nrm((DEPTH, D_MODEL, D_FF), D_MODEL ** -0.5),
        'ffn_w_val': nrm((DEPTH, D_MODEL, D_FF), D_MODEL ** -0.5),
        'ffn_conv_w': nrm((DEPTH, FFN_CONV, D_FF), FFN_CONV ** -0.5),
        'ffn_conv_b': nrm((DEPTH, D_FF), 0.02),
        'ffn_w_down': nrm((DEPTH, D_FF, D_MODEL), D_FF ** -0.5),
        'norm_ffn_post': gain((DEPTH, D_MODEL)),
    }


def reference(x_prompt, x_sample, cache_nsa_kv, page_table, state_nsa_win, state_ssd_conv, state_ssm,
              state_pool, state_ffn_conv, norm_mix_pre, w_in, ssd_conv_w, ssd_conv_b, ssd_dt_bias, ssd_a_log,
              ssd_d, ssd_norm, pool_w, pool_scale, nsa_pe_k, nsa_pe_v, nsa_w1_k, nsa_w1_v, nsa_w2_k, nsa_w2_v,
              w_out, norm_mix_post, norm_ffn_pre, ffn_w_gate, ffn_w_val, ffn_conv_w, ffn_conv_b, ffn_w_down,
              norm_ffn_post):
    params = dict(norm_mix_pre=norm_mix_pre, w_in=w_in, ssd_conv_w=ssd_conv_w, ssd_conv_b=ssd_conv_b,
                  ssd_dt_bias=ssd_dt_bias, ssd_a_log=ssd_a_log, ssd_d=ssd_d, ssd_norm=ssd_norm, pool_w=pool_w,
                  pool_scale=pool_scale, nsa_pe_k=nsa_pe_k, nsa_pe_v=nsa_pe_v, nsa_w1_k=nsa_w1_k,
                  nsa_w1_v=nsa_w1_v, nsa_w2_k=nsa_w2_k, nsa_w2_v=nsa_w2_v, w_out=w_out,
                  norm_mix_post=norm_mix_post, norm_ffn_pre=norm_ffn_pre, ffn_w_gate=ffn_w_gate,
                  ffn_w_val=ffn_w_val, ffn_conv_w=ffn_conv_w, ffn_conv_b=ffn_conv_b, ffn_w_down=ffn_w_down,
                  norm_ffn_post=norm_ffn_post)
    bp, tp, _ = x_prompt.shape
    bs = x_sample.shape[0]
    past_len = page_table.shape[1] * PAGE_SIZE
    win_buf = state_nsa_win.shape[2]
    dty = x_prompt.dtype
    win0 = jnp.zeros((bp, WINDOW, 2, NSA_HD), dty)
    conv0 = jnp.zeros((bp, SSD_CONV - 1, SSD_CONV_DIM), dty)
    ssm0 = jnp.zeros((bp, SSD_H, SSD_HD, SSD_N), dty)
    pool0 = jnp.zeros((bp, POOL_KEEP, POOL_W), dty)
    ffn0 = jnp.zeros((bp, FFN_CONV - 1, D_FF), dty)
    h_p = x_prompt
    h_s = x_sample
    outs_p = []
    outs_s = []
    for l in range(DEPTH):
        p = {k: v[l] for k, v in params.items()}
        h_p, st_p = hybrid_layer(h_p, 0, None, win0, min(WINDOW, tp), conv0, ssm0, pool0, ffn0, p)
        past = cache_nsa_kv[l][page_table].reshape(bs, past_len, 4, NSA_HD)
        prefix = jnp.pad(state_nsa_win[l], ((0, 0), (WINDOW - win_buf, 0), (0, 0), (0, 0)))
        h_s, st_s = hybrid_layer(h_s, past_len, past, prefix, win_buf, state_ssd_conv[l], state_ssm[l],
                                 state_pool[l], state_ffn_conv[l], p)
        outs_p.append(st_p)
        outs_s.append(st_s)

    def stk(outs, i):
        return jnp.stack([o[i] for o in outs])

    return (h_p, h_s, stk(outs_p, 0), stk(outs_s, 0), stk(outs_p, 1), stk(outs_s, 1), stk(outs_p, 2),
            stk(outs_s, 2), stk(outs_p, 3), stk(outs_s, 3), stk(outs_p, 4), stk(outs_s, 4), stk(outs_p, 5),
            stk(outs_s, 5))
```

```cpp
#include <hip/hip_runtime.h>
#include <cstdio>
#include <cstdint>

namespace pg8 {
#define PG8_LAS __attribute__((address_space(3)))
typedef unsigned short bf16_t;
typedef short bf16x8 __attribute__((ext_vector_type(8)));
typedef float f32x4 __attribute__((ext_vector_type(4)));
typedef unsigned u32x4 __attribute__((ext_vector_type(4)));
constexpr int BM = 256, BK = 64, HALF = 128, HTB = HALF * BK * 2  , STAGE_BYTES = 8 * HTB, NXCD = 8, WGM = 8;

__host__ __device__ __forceinline__ int lds_byte(int r, int c) { const int st = (r >> 4) * 2 + (c >> 5), rr = r & 15, cc = c & 31, ob = rr * 64 + cc * 2; return st * 1024 + (ob ^ (((ob >> 9) & 1) << 5)); }
__host__ __device__ __forceinline__ void stage_rc(int b, int& R, int& C) { const int st = b / 1024, sb = b % 1024, swz = sb ^ (((sb >> 9) & 1) << 5); R = (st >> 1) * 16 + swz / 64; C = (st & 1) * 32 + (swz % 64) / 2; }
__host__ __device__ __forceinline__ int perm32(int rho) { const int n = rho >> 4, i = rho & 15; return 8 * (i >> 2) + 4 * n + (i & 3); }

struct Unit { int pm, pn, kt0, nt; };
struct Gemm { const bf16_t* A; const bf16_t* Bt; int M, N, K; };

struct StaticOrder {
    int nM, nN, nwg, G, c;
    __host__ __device__ __forceinline__ void init(int M, int N, int G_, int c_) { nM = M / BM; nN = N / BM; nwg = nM * nN; G = G_; c = c_; }
    __host__ __device__ __forceinline__ bool next(int i, Unit& u) const {
        const long L = (long)i * G + c; if (L >= nwg) return false;
        int wgid = (int)L; { const int q = nwg / NXCD, r = nwg % NXCD, xcd = wgid % NXCD, off = wgid / NXCD; wgid = (xcd < r ? xcd * (q + 1) : r * (q + 1) + (xcd - r) * q) + off; }
        const int nig = WGM * nN, gid = wgid / nig, fm = gid * WGM, gsz = (nM - fm) < WGM ? (nM - fm) : WGM;
        u.pm = fm + ((wgid % nig) % gsz); u.pn = (wgid % nig) / gsz; u.kt0 = 0; u.nt = 0; return true;
    }
    __device__ __forceinline__ void a_ready(const Unit&) const {}
    __device__ __forceinline__ void done(const Unit&) const {}
};

__device__ __forceinline__ unsigned cvt_pk_bf16(float lo, float hi) { unsigned r; asm volatile("v_cvt_pk_bf16_f32 %0, %1, %2" : "=v"(r) : "v"(lo), "v"(hi)); return r; }
struct EpiF32 {
    static constexpr bool PERM = true, AFTER_DRAIN = false;
    float* O; int ldc;
    __device__ __forceinline__ void operator()(const f32x4 (&acc)[2][2][4][2], const Unit& u, int wr, int wc, int fr, int fq) const {
        const int row0 = u.pm * BM + wr * 64 + fr; const int col0 = u.pn * BM + wc * 32 + 8 * fq;
#pragma unroll
        for (int ai = 0; ai < 2; ++ai)
#pragma unroll
            for (int m = 0; m < 4; ++m) { float* rowp = O + (size_t)(row0 + ai * HALF + m * 16) * ldc + col0;
#pragma unroll
                for (int bj = 0; bj < 2; ++bj) { *(f32x4*)(rowp + bj * HALF) = acc[ai][bj][m][0]; *(f32x4*)(rowp + bj * HALF + 4) = acc[ai][bj][m][1]; } }
    }
};

struct CmpOrder {
    int G, c;
    __device__ __forceinline__ bool next(int i, Unit& u) const { const int L = i * G + c; if (L >= 512) return false; u.pm = L; u.pn = L >> 6; u.kt0 = 0; u.nt = 0; return true; }
    __device__ __forceinline__ void a_ready(const Unit&) const {}
    __device__ __forceinline__ void done(const Unit&) const {}
};
struct EpiCmp {
    static constexpr bool PERM = true, AFTER_DRAIN = false;
    float* O;
    __device__ __forceinline__ void operator()(const f32x4 (&acc)[2][2][4][2], const Unit& u, int wr, int wc, int fr, int fq) const {
        const int row0 = u.pm * BM + wr * 64 + fr; const int col0 = wc * 32 + 8 * fq;
#pragma unroll
        for (int ai = 0; ai < 2; ++ai)
#pragma unroll
            for (int m = 0; m < 4; ++m) { float* rowp = O + (size_t)(row0 + ai * HALF + m * 16) * 256 + col0;
#pragma unroll
                for (int bj = 0; bj < 2; ++bj) { *(f32x4*)(rowp + bj * HALF) = acc[ai][bj][m][0]; *(f32x4*)(rowp + bj * HALF + 4) = acc[ai][bj][m][1]; } }
    }
};

struct EpiB16 {
    static constexpr bool PERM = true, AFTER_DRAIN = false;
    bf16_t* O; int ldc;
    __device__ __forceinline__ void operator()(const f32x4 (&acc)[2][2][4][2], const Unit& u, int wr, int wc, int fr, int fq) const {
        const int row0 = u.pm * BM + wr * 64 + fr; const int col0 = u.pn * BM + wc * 32 + 8 * fq;
#pragma unroll
        for (int ai = 0; ai < 2; ++ai)
#pragma unroll
            for (int m = 0; m < 4; ++m) { bf16_t* rowp = O + (size_t)(row0 + ai * HALF + m * 16) * ldc + col0;
#pragma unroll
                for (int bj = 0; bj < 2; ++bj) { const f32x4 v0 = acc[ai][bj][m][0], v1 = acc[ai][bj][m][1];
                    u32x4 w; w.x = cvt_pk_bf16(v0[0], v0[1]); w.y = cvt_pk_bf16(v0[2], v0[3]); w.z = cvt_pk_bf16(v1[0], v1[1]); w.w = cvt_pk_bf16(v1[2], v1[3]);
                    *(u32x4*)(rowp + bj * HALF) = w; } }
    }
};

struct TailSplitOrder {
    StaticOrder P; int nN, ntf, split;
    __device__ __forceinline__ void init(int Mp, int N, int K, int split_, int G, int c) { P.init(Mp, N, G, c); nN = N / BM; ntf = K / BK; split = split_; }
    __device__ __forceinline__ bool next(int i, Unit& u) const {
        const int L = i * P.G + P.c; const bool isp = L < P.nwg;
        int wgid = isp ? L : 0; { const int q = P.nwg / NXCD, r = P.nwg % NXCD, xcd = wgid % NXCD, off = wgid / NXCD; wgid = (xcd < r ? xcd * (q + 1) : r * (q + 1) + (xcd - r) * q) + off; }
        const int nig = WGM * P.nN, gid = wgid / nig, fm = gid * WGM, gsz = (P.nM - fm) < WGM ? (P.nM - fm) : WGM;
        const int ppm = fm + ((wgid % nig) % gsz), ppn = (wgid % nig) / gsz;
        const int t = L - P.nwg, nts = ntf / split;
        u.pm = isp ? ppm : P.nM; u.pn = isp ? ppn : t % nN; u.nt = isp ? 0 : nts; u.kt0 = isp ? 0 : (t / nN) * nts;
        return isp || t < nN * split;
    }
    __device__ __forceinline__ void a_ready(const Unit&) const {}
    __device__ __forceinline__ void done(const Unit&) const {}
};
struct EpiB16Split {
    static constexpr bool PERM = true, AFTER_DRAIN = false;
    bf16_t* O; float* S; int ldc; int tail_pm;
    __device__ __forceinline__ void operator()(const f32x4 (&acc)[2][2][4][2], const Unit& u, int wr, int wc, int fr, int fq) const {
        const int col0 = u.pn * BM + wc * 32 + 8 * fq;
        if (u.pm < tail_pm) {
            bf16_t* base = O + (size_t)(u.pm * BM + wr * 64 + fr) * ldc + col0;
#pragma unroll
            for (int ai = 0; ai < 2; ++ai)
#pragma unroll
                for (int m = 0; m < 4; ++m) { bf16_t* rowp = base + (size_t)(ai * HALF + m * 16) * ldc;
#pragma unroll
                    for (int bj = 0; bj < 2; ++bj) { const f32x4 v0 = acc[ai][bj][m][0], v1 = acc[ai][bj][m][1];
                        u32x4 w; w.x = cvt_pk_bf16(v0[0], v0[1]); w.y = cvt_pk_bf16(v0[2], v0[3]); w.z = cvt_pk_bf16(v1[0], v1[1]); w.w = cvt_pk_bf16(v1[2], v1[3]);
                        *(u32x4*)(rowp + bj * HALF) = w; } }
        } else {
            float* base = S + ((size_t)(u.kt0 / (u.nt ? u.nt : 1)) * BM + wr * 64 + fr) * ldc + col0;
#pragma unroll
            for (int ai = 0; ai < 2; ++ai)
#pragma unroll
                for (int m = 0; m < 4; ++m) { float* rowp = base + (size_t)(ai * HALF + m * 16) * ldc;
#pragma unroll
                    for (int bj = 0; bj < 2; ++bj) { *(f32x4*)(rowp + bj * HALF) = acc[ai][bj][m][0]; *(f32x4*)(rowp + bj * HALF + 4) = acc[ai][bj][m][1]; } }
        }
    }
};
struct EpiF32Split {
    static constexpr bool PERM = true, AFTER_DRAIN = false;
    float* O; float* S; int ldc; int tail_pm;
    __device__ __forceinline__ void operator()(const f32x4 (&acc)[2][2][4][2], const Unit& u, int wr, int wc, int fr, int fq) const {
        const int col0 = u.pn * BM + wc * 32 + 8 * fq;
        float* base = (u.pm < tail_pm) ? O + (size_t)(u.pm * BM + wr * 64 + fr) * ldc : S + ((size_t)(u.kt0 / (u.nt ? u.nt : 1)) * BM + wr * 64 + fr) * ldc;
#pragma unroll
        for (int ai = 0; ai < 2; ++ai)
#pragma unroll
            for (int m = 0; m < 4; ++m) { float* rowp = base + (size_t)(ai * HALF + m * 16) * ldc + col0;
#pragma unroll
                for (int bj = 0; bj < 2; ++bj) { *(f32x4*)(rowp + bj * HALF) = acc[ai][bj][m][0]; *(f32x4*)(rowp + bj * HALF + 4) = acc[ai][bj][m][1]; } }
    }
};

__device__ __forceinline__ float dpp_ror1(float v) { return __builtin_bit_cast(float, __builtin_amdgcn_update_dpp(0, __builtin_bit_cast(int, v), 0x121, 0xf, 0xf, false)); }
__device__ __forceinline__ float dpp_ror2(float v) { return __builtin_bit_cast(float, __builtin_amdgcn_update_dpp(0, __builtin_bit_cast(int, v), 0x122, 0xf, 0xf, false)); }
__device__ __forceinline__ float dpp_shr1(float old, float v) { return __builtin_bit_cast(float, __builtin_amdgcn_update_dpp(__builtin_bit_cast(int, old), __builtin_bit_cast(int, v), 0x111, 0xf, 0xf, false)); }
__device__ __forceinline__ float dpp_shr2(float old, float v) { return __builtin_bit_cast(float, __builtin_amdgcn_update_dpp(__builtin_bit_cast(int, old), __builtin_bit_cast(int, v), 0x112, 0xf, 0xf, false)); }
__device__ __forceinline__ float gelu_t(float x) {
    const float p = x * __builtin_fmaf(x * x, 0.044715f * 2.302208198f, 2.302208198f);
    return x * __builtin_amdgcn_rcpf(1.f + __builtin_amdgcn_exp2f(-p));
}
struct EpiFfn {
    static constexpr bool PERM = true, AFTER_DRAIN = false;
    bf16_t* ACT;
    float* RAW;
    float* HALO;
    float* LAST;
    const float* cw; const float* cb;
    PG8_LAS float* xb;
    int tail_pm;
    __device__ __forceinline__ void operator()(const f32x4 (&acc)[2][2][4][2], const Unit& u, int wr, int wc, int fr_in, int fq_in) const {
        int fr = fr_in, fq = fq_in; asm volatile("" : "+v"(fr), "+v"(fq));
        const int colt = wc * 32 + 8 * fq, gcol = u.pn * 128 + colt;
        const bool tail = (u.pm >= tail_pm);
#pragma unroll
        for (int ai = 0; ai < 2; ++ai) {
            if (fr >= 14) { PG8_LAS float* d = xb + ((ai * 2 + wr) * 2 + (fr - 14)) * 128 + colt;
                *(PG8_LAS f32x4*)d = acc[ai][0][3][0]; *(PG8_LAS f32x4*)(d + 4) = acc[ai][0][3][1]; }
        }
        if (!tail) {
            if (wr == 1 && fr >= 14) { float* d = LAST + ((size_t)u.pm * 2 + (fr - 14)) * 4096 + gcol; *(f32x4*)d = acc[1][0][3][0]; *(f32x4*)(d + 4) = acc[1][0][3][1]; }
            if (wr == 0 && fr < 2) { float* d = HALO + ((size_t)u.pm * 2 + fr) * 8192 + gcol;
                *(f32x4*)d = acc[0][0][0][0]; *(f32x4*)(d + 4) = acc[0][0][0][1]; *(f32x4*)(d + 4096) = acc[0][1][0][0]; *(f32x4*)(d + 4096 + 4) = acc[0][1][0][1]; }
        } else {
#pragma unroll
            for (int ai = 0; ai < 2; ++ai)
#pragma unroll
                for (int m = 0; m < 4; ++m) { float* d = RAW + ((size_t)(u.kt0 / (u.nt ? u.nt : 1)) * BM + ai * HALF + wr * 64 + m * 16 + fr) * 8192 + gcol;
                    *(f32x4*)d = acc[ai][0][m][0]; *(f32x4*)(d + 4) = acc[ai][0][m][1]; *(f32x4*)(d + 4096) = acc[ai][1][m][0]; *(f32x4*)(d + 4096 + 4) = acc[ai][1][m][1]; }
        }
        asm volatile("s_waitcnt lgkmcnt(0)" ::: "memory");
        __builtin_amdgcn_s_barrier();
        if (tail) return;
#pragma unroll
        for (int n = 0; n < 2; ++n) {
            const f32x4 w0 = *(const f32x4*)(cw + gcol + 4 * n), w1 = *(const f32x4*)(cw + 4096 + gcol + 4 * n), w2 = *(const f32x4*)(cw + 8192 + gcol + 4 * n), bb = *(const f32x4*)(cb + gcol + 4 * n);
#pragma unroll
            for (int ai = 0; ai < 2; ++ai) {
                const int pgrp = (wr == 1) ? (ai * 2 + 0) : (0 * 2 + 1);
                const f32x4 pv = *(const PG8_LAS f32x4*)(xb + (pgrp * 2 + (fr == 15 ? 1 : 0)) * 128 + colt + 4 * n);
#pragma unroll
                for (int m = 0; m < 4; ++m) {
                    float a4[4];
#pragma unroll
                    for (int k = 0; k < 4; ++k) {
                        const float cur = acc[ai][0][m][n][k]; const float prm = (m > 0) ? acc[ai][0][m > 0 ? m - 1 : 0][n][k] : pv[k];
                        const float p1 = dpp_shr1(dpp_ror1(prm), cur), p2 = dpp_shr2(dpp_ror2(prm), cur);
                        const float pre = w0[k] * p2 + w1[k] * p1 + w2[k] * cur + bb[k];
                        a4[k] = gelu_t(pre) * acc[ai][1][m][n][k];
                    }
                    const bool deferred = (ai == 0 && wr == 0 && m == 0 && fr < 2);
                    if (!deferred) *(unsigned long long*)(ACT + (size_t)(u.pm * BM + ai * HALF + wr * 64 + m * 16 + fr) * 4096 + gcol + 4 * n) =
                        (unsigned long long)cvt_pk_bf16(a4[0], a4[1]) | ((unsigned long long)cvt_pk_bf16(a4[2], a4[3]) << 32);
                }
            }
        }
    }
};
template <class Epi, class Sched, bool ALIGN_EPI = false, bool SP2 = false>
__device__ __forceinline__ void gemm_phase(PG8_LAS unsigned char* lds, const Gemm g, const Sched& S, const Epi& E, const int tid_in) {
    int tid_ = tid_in; asm volatile("" : "+v"(tid_));
    const int tid = tid_, wid = __builtin_amdgcn_readfirstlane(tid >> 6), lane = tid & 63, wr = wid >> 2, wc = wid & 3, fr = lane & 15, fq = lane >> 4;
    const int K = g.K, ntf = K / BK;
    unsigned voffA[2], voffB[2];
#pragma unroll
    for (int i = 0; i < 2; ++i) { int R, C; stage_rc(tid * 16 + i * 8192, R, C); const int Rb = Epi::PERM ? ((R & ~31) + perm32(R & 31)) : R;
        voffA[i] = (unsigned)(R * K + C) * 2u; voffB[i] = (unsigned)(Rb * K + C) * 2u; }
    const size_t kstep = (size_t)(BK * 2);
    const size_t hstep = (size_t)HALF * K * 2;
    const size_t tstep = 2 * hstep;
    const unsigned ldsw = (unsigned)wid * 1024u;
    const int aoff = lds_byte(wr * 64 + fr, fq * 8), boff = lds_byte(wc * 32 + fr, fq * 8);
#define PG8_SA(b, h) (((b) * 2 + (h)) * HTB)
#define PG8_SB(b, h) ((4 + (b) * 2 + (h)) * HTB)
#define PG8_STAGE(bufoff, gbase, voff) do { _Pragma("unroll") for (int _i = 0; _i < 2; ++_i) \
        __builtin_amdgcn_global_load_lds((const unsigned*)((const char*)(gbase) + (voff)[_i]), (PG8_LAS unsigned*)(lds + (bufoff) + ldsw + _i * 8192), 16, 0, 0); } while (0)
#define PG8_LDA(dst, b, h) do { _Pragma("unroll") for (int m = 0; m < 4; ++m) _Pragma("unroll") for (int k = 0; k < 2; ++k) dst[m][k] = *(const PG8_LAS bf16x8*)(lds + PG8_SA(b, h) + aoff + m * 2048 + k * 1024); } while (0)
#define PG8_LDB(dst, b, h) do { _Pragma("unroll") for (int n = 0; n < 2; ++n) _Pragma("unroll") for (int k = 0; k < 2; ++k) dst[n][k] = *(const PG8_LAS bf16x8*)(lds + PG8_SB(b, h) + boff + n * 2048 + k * 1024); } while (0)
#define PG8_MMA(ai, bj, At, Bt) do { __builtin_amdgcn_s_setprio(1); _Pragma("unroll") for (int m = 0; m < 4; ++m) _Pragma("unroll") for (int n = 0; n < 2; ++n) _Pragma("unroll") for (int k = 0; k < 2; ++k) \
        acc[ai][bj][m][n] = __builtin_amdgcn_mfma_f32_16x16x32_bf16(Bt[n][k], At[m][k], acc[ai][bj][m][n], 0, 0, 0); __builtin_amdgcn_s_setprio(0); } while (0)
#define PG8_WAIT_V(n) asm volatile("s_waitcnt vmcnt(" #n ")" ::: "memory")
#define PG8_WAIT_L(n) asm volatile("s_waitcnt lgkmcnt(" #n ")" ::: "memory")
#define PG8_BAR __builtin_amdgcn_s_barrier()
#define PG8_SCHED __builtin_amdgcn_sched_barrier(0)
    Unit cur = {0, 0, 0, 0}, nxt = {0, 0, 0, 0}; int ui = 0;
    if (!S.next(0, cur)) return;
    f32x4 acc[2][2][4][2];
#pragma unroll
    for (int a = 0; a < 2; ++a)
#pragma unroll
        for (int b = 0; b < 2; ++b)
#pragma unroll
            for (int m = 0; m < 4; ++m)
#pragma unroll
                for (int n = 0; n < 2; ++n) acc[a][b][m][n] = (f32x4){0.f, 0.f, 0.f, 0.f};
    bf16x8 At[4][2], B0[2][2], B1[2][2];
    const char* cA = (const char*)g.A + (size_t)cur.pm * tstep + (size_t)cur.kt0 * kstep; const char* cB = (const char*)g.Bt + (size_t)cur.pn * tstep + (size_t)cur.kt0 * kstep;
    S.a_ready(cur);
    if constexpr (SP2) {
        PG8_STAGE(PG8_SB(0, 0), cB, voffB); PG8_STAGE(PG8_SB(0, 1), cB + hstep, voffB); PG8_STAGE(PG8_SA(0, 0), cA, voffA); PG8_STAGE(PG8_SA(0, 1), cA + hstep, voffA);
        if (wr == 1) PG8_BAR;
        PG8_WAIT_V(2); PG8_BAR;
        PG8_STAGE(PG8_SB(1, 0), cB + kstep, voffB); PG8_STAGE(PG8_SA(1, 0), cA + kstep, voffA); PG8_STAGE(PG8_SB(1, 1), cB + hstep + kstep, voffB);
        PG8_WAIT_V(6); PG8_BAR;
    } else {
        PG8_STAGE(PG8_SB(0, 0), cB, voffB); PG8_STAGE(PG8_SA(0, 0), cA, voffA); PG8_STAGE(PG8_SB(0, 1), cB + hstep, voffB); PG8_STAGE(PG8_SA(0, 1), cA + hstep, voffA);
        if (wr == 1) PG8_BAR;
        PG8_WAIT_V(4); PG8_BAR;
        PG8_STAGE(PG8_SB(1, 0), cB + kstep, voffB); PG8_STAGE(PG8_SA(1, 0), cA + kstep, voffA); PG8_STAGE(PG8_SB(1, 1), cB + hstep + kstep, voffB);
        PG8_WAIT_V(6); PG8_BAR;
    }
    for (;;) {
        const bool has_next = S.next(ui + 1, nxt);
        const char* nA = has_next ? (const char*)g.A + (size_t)nxt.pm * tstep + (size_t)nxt.kt0 * kstep : cA; const char* nB = has_next ? (const char*)g.Bt + (size_t)nxt.pn * tstep + (size_t)nxt.kt0 * kstep : cB;
        const int nt = cur.nt ? cur.nt : ntf;
        for (int t = 0; t < nt; t += 2) {
            const bool last = (t == nt - 2);
            const char* a1 = cA + (size_t)(t + 1) * kstep;
            const char* a2 = last ? nA : cA + (size_t)(t + 2) * kstep; const char* b2 = last ? nB : cB + (size_t)(t + 2) * kstep;
            const char* a3 = a2 + kstep; const char* b3 = b2 + kstep;
            if (last && has_next) S.a_ready(nxt);
            if constexpr (SP2) {
            PG8_LDB(B0, 0, 0); PG8_LDB(B1, 0, 1); PG8_SCHED; PG8_LDA(At, 0, 0); PG8_STAGE(PG8_SA(1, 1), a1 + hstep, voffA);
            PG8_WAIT_V(8); PG8_WAIT_L(0); PG8_BAR; PG8_MMA(0, 0, At, B0); PG8_MMA(0, 1, At, B1); PG8_BAR; PG8_SCHED;
            PG8_LDA(At, 0, 1); PG8_STAGE(PG8_SB(0, 0), b2, voffB); PG8_STAGE(PG8_SB(0, 1), b2 + hstep, voffB); PG8_STAGE(PG8_SA(0, 0), a2, voffA);
            PG8_WAIT_V(8); PG8_WAIT_L(0); PG8_BAR; PG8_MMA(1, 0, At, B0); PG8_MMA(1, 1, At, B1); PG8_BAR; PG8_SCHED;
            PG8_LDB(B0, 1, 0); PG8_LDB(B1, 1, 1); PG8_SCHED; PG8_LDA(At, 1, 0); PG8_STAGE(PG8_SA(0, 1), a2 + hstep, voffA);
            PG8_WAIT_V(8); PG8_WAIT_L(0); PG8_BAR; PG8_MMA(0, 0, At, B0); PG8_MMA(0, 1, At, B1); PG8_BAR; PG8_SCHED;
            PG8_LDA(At, 1, 1); PG8_STAGE(PG8_SB(1, 0), b3, voffB); PG8_STAGE(PG8_SB(1, 1), b3 + hstep, voffB); PG8_STAGE(PG8_SA(1, 0), a3, voffA);
            PG8_WAIT_V(8); PG8_WAIT_L(0); PG8_BAR; PG8_MMA(1, 0, At, B0); PG8_MMA(1, 1, At, B1); PG8_BAR; PG8_SCHED;
            } else {
            PG8_LDB(B0, 0, 0); PG8_SCHED; PG8_LDA(At, 0, 0); PG8_STAGE(PG8_SA(1, 1), a1 + hstep, voffA);
            PG8_WAIT_L(8); PG8_BAR; PG8_WAIT_L(0); PG8_MMA(0, 0, At, B0); PG8_BAR; PG8_SCHED;
            PG8_LDB(B1, 0, 1); PG8_STAGE(PG8_SB(0, 0), b2, voffB);
            PG8_BAR; PG8_WAIT_L(0); PG8_MMA(0, 1, At, B1); PG8_BAR;
            PG8_LDA(At, 0, 1); PG8_STAGE(PG8_SA(0, 0), a2, voffA);
            PG8_BAR; PG8_WAIT_L(0); PG8_MMA(1, 0, At, B0); PG8_BAR; PG8_SCHED;
            PG8_STAGE(PG8_SB(0, 1), b2 + hstep, voffB);
            PG8_WAIT_V(6); PG8_BAR; PG8_MMA(1, 1, At, B1); PG8_BAR;
            PG8_LDB(B0, 1, 0); PG8_SCHED; PG8_LDA(At, 1, 0); PG8_STAGE(PG8_SA(0, 1), a2 + hstep, voffA);
            PG8_WAIT_L(8); PG8_BAR; PG8_WAIT_L(0); PG8_MMA(0, 0, At, B0); PG8_BAR; PG8_SCHED;
            PG8_LDB(B1, 1, 1); PG8_STAGE(PG8_SB(1, 0), b3, voffB);
            PG8_BAR; PG8_WAIT_L(0); PG8_MMA(0, 1, At, B1); PG8_BAR;
            PG8_LDA(At, 1, 1); PG8_STAGE(PG8_SA(1, 0), a3, voffA);
            PG8_BAR; PG8_WAIT_L(0); PG8_MMA(1, 0, At, B0); PG8_BAR; PG8_SCHED;
            PG8_STAGE(PG8_SB(1, 1), b3 + hstep, voffB);
            PG8_WAIT_V(6); PG8_BAR; PG8_MMA(1, 1, At, B1); PG8_BAR;
            }
        }
        if constexpr (ALIGN_EPI) { if (wr == 0) PG8_BAR; }
        if constexpr (!Epi::AFTER_DRAIN) { E(acc, cur, wr, wc, fr, fq); S.done(cur); }
        if (!has_next) break;
#pragma unroll
        for (int a = 0; a < 2; ++a)
#pragma unroll
            for (int b = 0; b < 2; ++b)
#pragma unroll
                for (int m = 0; m < 4; ++m)
#pragma unroll
                    for (int n = 0; n < 2; ++n) acc[a][b][m][n] = (f32x4){0.f, 0.f, 0.f, 0.f};
        cur = nxt; cA = nA; cB = nB; ++ui;
        if constexpr (ALIGN_EPI) { if (wr == 1) PG8_BAR; }
    }
    PG8_WAIT_V(0);
    if constexpr (!ALIGN_EPI) { if (wr == 0) PG8_BAR; }
    PG8_BAR;
    if constexpr (Epi::AFTER_DRAIN) { E.fused(acc, cur, wr, wc, fr, fq, lds, wid, lane); S.done(cur); }
#undef PG8_SA
#undef PG8_SB
#undef PG8_STAGE
#undef PG8_LDA
#undef PG8_LDB
#undef PG8_MMA
#undef PG8_WAIT_V
#undef PG8_WAIT_L
#undef PG8_BAR
#undef PG8_SCHED
}
}

#define GAS __attribute__((address_space(1)))
#define LAS __attribute__((address_space(3)))
typedef unsigned short bf16;
typedef unsigned v4u __attribute__((ext_vector_type(4)));
typedef float f32x4 __attribute__((ext_vector_type(4)));
typedef short bf16x8 __attribute__((ext_vector_type(8)));

constexpr int DM = 1024, BP = 8, TP = 2048, DEPTH = 4, BS = 32, TS = 8, PAST = 8192, PAGE = 128;
constexpr int NP = BP * TP, NS = BS * TS, MROWS = NP + NS;
constexpr int NSEQ = BP + BS;
constexpr int SSD_W = 512, SSD_H = 8, SSD_HD = 64, SSD_N = 128, CONV_DIM = 1024;
constexpr int POOL_W = 256, POOL_KEEP = 15;
constexpr int NSA_H = 4, NSA_HD = 64;
constexpr int OFF_XBC = 512, OFF_DT = 1536, OFF_POOL = 1544, OFF_Q = 1800, OFF_KV = 2056, OFF_G = 2440, IN_W = 2452, IN_WP = 2560;
constexpr int DFF = 4096;
constexpr int NPHYS = 2560, NPAGES = 64;
constexpr int NCMP_P = 127, NCMP_S = 511;
constexpr float RMS_EPS = 1e-6f;

constexpr size_t O_YP = 0;
constexpr size_t O_YS = O_YP + (size_t)NP * DM;
constexpr size_t O_KVP = O_YS + (size_t)NS * DM;
constexpr size_t O_KVS = O_KVP + (size_t)DEPTH * NP * 256;
constexpr size_t O_WINP = O_KVS + (size_t)DEPTH * NS * 256;
constexpr size_t O_WINS = O_WINP + (size_t)DEPTH * BP * 512 * 128;
constexpr size_t O_CONVP = O_WINS + (size_t)DEPTH * BS * 512 * 128;
constexpr size_t O_CONVS = O_CONVP + (size_t)DEPTH * BP * 3 * 1024;
constexpr size_t O_SSMP = O_CONVS + (size_t)DEPTH * BS * 3 * 1024;
constexpr size_t O_SSMS = O_SSMP + (size_t)DEPTH * BP * 8 * 64 * 128;
constexpr size_t O_POOLP = O_SSMS + (size_t)DEPTH * BS * 8 * 64 * 128;
constexpr size_t O_POOLS = O_POOLP + (size_t)DEPTH * BP * 15 * 256;
constexpr size_t O_FFNP = O_POOLS + (size_t)DEPTH * BS * 15 * 256;
constexpr size_t O_FFNS = O_FFNP + (size_t)DEPTH * BP * 2 * 4096;
constexpr size_t O_END = O_FFNS + (size_t)DEPTH * BS * 2 * 4096;

enum { I_XP = 0, I_XS, I_CACHE, I_PT, I_SWIN, I_SCONV, I_SSM, I_SPOOL, I_SFFN, I_NMPRE, I_WIN, I_CONVW, I_CONVB, I_DTB, I_ALOG, I_SSDD, I_SSDNORM,
       I_POOLW, I_POOLSC, I_PEK, I_PEV, I_W1K, I_W1V, I_W2K, I_W2V, I_WOUT, I_NMPOST, I_NFPRE, I_WGATE, I_WVAL, I_FCW, I_FCB, I_WDOWN, I_NFPOST, N_IN };

constexpr size_t al256(size_t x) { return (x + 255) & ~(size_t)255; }
constexpr size_t WS_CTL = 0, CTL_BYTES = 1u << 20;
constexpr size_t WS_WTIN = WS_CTL + CTL_BYTES;
constexpr size_t WS_WTOUT = WS_WTIN + (size_t)DEPTH * IN_WP * DM * 2;
constexpr size_t WS_WTUP = WS_WTOUT + (size_t)DEPTH * DM * DM * 2;
constexpr size_t WS_WTDN = WS_WTUP + (size_t)DEPTH * 2 * DFF * DM * 2;
constexpr size_t WS_ROPE = WS_WTDN + (size_t)DEPTH * DM * DFF * 2;
constexpr size_t WS_X = WS_ROPE + al256((size_t)2056 * 16 * 4);
constexpr size_t WS_XN = WS_X + (size_t)MROWS * DM * 4;
constexpr size_t WS_PROJ = WS_XN + (size_t)MROWS * DM * 2;
constexpr size_t WS_YSSD = WS_PROJ + (size_t)MROWS * IN_WP * 4;
constexpr size_t WS_Q = WS_YSSD + (size_t)MROWS * SSD_W * 4;
constexpr size_t WS_KWIN = WS_Q + (size_t)MROWS * 256 * 4;
constexpr size_t WS_CKP = WS_KWIN + (size_t)MROWS * 128 * 4;
constexpr size_t WS_CVP = WS_CKP + al256((size_t)BP * NCMP_P * 64 * 4);
constexpr size_t WS_CKS = WS_CVP + al256((size_t)BP * NCMP_P * 64 * 4);
constexpr size_t WS_CVS = WS_CKS + al256((size_t)DEPTH * BS * NCMP_S * 64 * 4);
constexpr size_t WS_MIX = WS_CVS + al256((size_t)DEPTH * BS * NCMP_S * 64 * 4);
constexpr size_t WS_MIXO = WS_MIX + (size_t)MROWS * DM * 2;
constexpr size_t WS_GV = WS_MIXO + (size_t)MROWS * DM * 4;
constexpr size_t WS_ACT = WS_GV + (size_t)MROWS * 2 * DFF * 4;
constexpr size_t WS_QB = WS_ACT + (size_t)MROWS * DFF * 2;
constexpr size_t WS_SAC = WS_QB + (size_t)MROWS * 256 * 2;
constexpr size_t WS_SCD = WS_SAC + (size_t)NP * 8 * 4;
constexpr size_t WS_SCB = WS_SCD + al256((size_t)BP * 16 * 8 * 4);
constexpr size_t WS_SCS = WS_SCB + (size_t)NP * 256 * 2;
constexpr size_t WS_SHS = WS_SCS + (size_t)BP * 16 * 8 * 8192 * 4;
constexpr size_t WS_WTC = WS_SHS + (size_t)BP * 16 * 8 * 8192 * 2;
constexpr size_t WS_CBIAS = WS_WTC + (size_t)8 * 256 * 1024 * 2;
constexpr size_t WS_AS = WS_GV;
constexpr size_t WS_HS = WS_AS + (size_t)8 * BS * 512 * 1024 * 2;
static_assert(WS_HS + (size_t)8 * BS * 512 * 256 * 4 <= WS_GV + (size_t)MROWS * 2 * DFF * 4, "prologue buffers must fit inside the GV region");
constexpr size_t WS_SLAB = WS_CBIAS + 8 * 128 * 4;
constexpr size_t WS_W2T = WS_SLAB + (size_t)8 * 256 * DM * 4;
constexpr size_t WS_FRAW = WS_W2T + (size_t)8 * 64 * 128 * 2;
constexpr int SPLIT_UP = 1;
constexpr size_t WS_FHALO = WS_FRAW + (size_t)SPLIT_UP * 256 * 2 * DFF * 4;
constexpr size_t WS_FLAST = WS_FHALO + (size_t)64 * 2 * 2 * DFF * 4;
constexpr size_t WS_END = WS_FLAST + (size_t)64 * 2 * DFF * 4;
constexpr int SPLIT_OUT = 4, SPLIT_DOWN = 8;

constexpr int RING_BYTES = 131072;
constexpr int MISC_OFF = RING_BYTES + 320;
constexpr int LDS_BYTES = 147456;
constexpr int NWAVES = 8, NTHR = 512;
constexpr int XB_OFF = RING_BYTES + 1024;
static_assert(XB_OFF + 4096 <= LDS_BYTES, "LDS map");

constexpr int PH_PER_LAYER = 10, N_PRO = 3, N_PHASES = N_PRO + DEPTH * PH_PER_LAYER;

struct Params { const float* in[N_IN]; float* out; unsigned char* ws; int ph_lo, ph_hi; };

__device__ __forceinline__ unsigned f2bf(float f) { unsigned u = __builtin_bit_cast(unsigned, f); return (u + 0x7fffu + ((u >> 16) & 1u)) >> 16; }
__device__ __forceinline__ unsigned pk2(float lo, float hi) { return f2bf(lo) | (f2bf(hi) << 16); }
__device__ __forceinline__ f32x4 bf4_to_f32(unsigned long long u) {
    return (f32x4){__uint_as_float((unsigned)u << 16), __uint_as_float((unsigned)u & 0xffff0000u), __uint_as_float((unsigned)(u >> 32) << 16), __uint_as_float((unsigned)(u >> 32) & 0xffff0000u)};
}
__device__ __forceinline__ float wave_sum(float v) {
#pragma unroll
    for (int o = 1; o < 64; o <<= 1) v += __shfl_xor(v, o);
    return v;
}
__device__ __forceinline__ float sum16(float v) {
#pragma unroll
    for (int o = 1; o < 16; o <<= 1) v += __shfl_xor(v, o);
    return v;
}
__device__ __forceinline__ float sigmoidf_(float x) { return 1.f / (1.f + expf(-x)); }
__device__ __forceinline__ float siluf_(float x) { return x / (1.f + expf(-x)); }
__device__ __forceinline__ float softplusf_(float x) { return x > 0.f ? x + log1pf(expf(-x)) : log1pf(expf(x)); }
__device__ __forceinline__ float gelu_tanh(float x) {
    const float u = 0.7978845608028654f * (x + 0.044715f * x * x * x);
    const float t = 1.f - 2.f / (expf(2.f * u) + 1.f);
    return 0.5f * x * (1.f + t);
}
__device__ __forceinline__ void cossin_d(float angf, float& c, float& s) {
    const double a = (double)angf;
    const double k = rint(a * 0.63661977236758134308);
    const double r = (a - k * 1.57079632679489655800) - k * 6.123233995736766036e-17;
    const double r2 = r * r;
    double sp = r * (1.0 + r2 * (-1.0 / 6 + r2 * (1.0 / 120 + r2 * (-1.0 / 5040 + r2 * (1.0 / 362880 + r2 * (-1.0 / 39916800 + r2 * (1.0 / 6227020800.0)))))));
    double cp = 1.0 + r2 * (-0.5 + r2 * (1.0 / 24 + r2 * (-1.0 / 720 + r2 * (1.0 / 40320 + r2 * (-1.0 / 3628800 + r2 * (1.0 / 479001600.0 + r2 * (-1.0 / 87178291200.0)))))));
    const int q = ((int)k) & 3;
    double cc = (q == 0) ? cp : (q == 1) ? -sp : (q == 2) ? -cp : sp;
    double ss = (q == 0) ? sp : (q == 1) ? cp : (q == 2) ? -sp : -cp;
    c = (float)cc; s = (float)ss;
}

struct Seq { int T, row0, pos0, b, samp; };
__device__ __forceinline__ Seq seq_of(int s) {
    Seq q;
    if (s < BP) { q.T = TP; q.row0 = s * TP; q.pos0 = 0; q.b = s; q.samp = 0; }
    else { q.T = TS; q.row0 = NP + (s - BP) * TS; q.pos0 = PAST; q.b = s - BP; q.samp = 1; }
    return q;
}
__device__ __forceinline__ void row_to_seq(int r, int& s, int& t) {
    if (r < NP) { s = r >> 11; t = r & (TP - 1); } else { const int q = r - NP; s = BP + (q >> 3); t = q & 7; }
}

#define XB_TMO      128
#define XB_XCNT(j)  (256  + 64 * (j))
#define XB_XSUB(j)  (1280 + 64 * (j))
#define XB_XGEN(j)  (2304 + 64 * (j))
#define XB_TOP      3328
#define XB_TOPGEN   3392
#define XCD_BAR_WORDS 3456
#define XB_SPIN_CAP (1u << 21)
__device__ __forceinline__ unsigned xb_ld(unsigned* p)              { return __hip_atomic_load(p, __ATOMIC_RELAXED, __HIP_MEMORY_SCOPE_AGENT); }
__device__ __forceinline__ unsigned xb_add(unsigned* p, unsigned v) { return __hip_atomic_fetch_add(p, v, __ATOMIC_RELAXED, __HIP_MEMORY_SCOPE_AGENT); }
__device__ __forceinline__ unsigned xb_xcc_id() { return (unsigned)__builtin_amdgcn_s_getreg((3 << 11) | 20) & 0xFu; }
#define XB_SPIN(cond, bar) do { unsigned _sp = 0; while (cond) { __builtin_amdgcn_s_sleep(1); \
    if ((++_sp & 255u) == 0u) { if (xb_ld(&(bar)[XB_TMO])) break; if (_sp > XB_SPIN_CAP) { atomicAdd(&(bar)[XB_TMO], 1u); break; } } } } while (0)
struct XcdBarrier { unsigned* bar; unsigned x; volatile LAS unsigned* st; };
__device__ __forceinline__ XcdBarrier xcd_barrier_post(unsigned* bar, volatile LAS unsigned* st) {
    XcdBarrier b; b.bar = bar; b.x = xb_xcc_id(); b.st = st;
    if (threadIdx.x == 0) (void)xb_add(&bar[XB_XCNT(b.x)], 1u);
    return b;
}
__device__ __forceinline__ void xcd_barrier_complete(unsigned* bar, unsigned x, unsigned& nloc, unsigned& nx) {
    const unsigned G = gridDim.x * gridDim.y * gridDim.z;
    unsigned sum, cnt, mine, sp = 0u;
    for (;;) {
        sum = 0u; cnt = 0u; mine = 0u;
#pragma unroll
        for (unsigned j = 0; j < 16; ++j) { const unsigned c = xb_ld(&bar[XB_XCNT(j)]); sum += c; cnt += (c > 0u) ? 1u : 0u; mine = (j == x) ? c : mine; }
        if (sum == G) break;
        __builtin_amdgcn_s_sleep(1);
        if ((++sp & 255u) == 0u) { if (xb_ld(&bar[XB_TMO])) break; if (sp > XB_SPIN_CAP) { atomicAdd(&bar[XB_TMO], 1u); break; } }
    }
    nloc = mine > 0u ? mine : 1u; nx = cnt > 0u ? cnt : 1u;
}
__device__ __forceinline__ void xcd_barrier(const XcdBarrier& b, const bool lead) {
    asm volatile("s_waitcnt vmcnt(0)" ::: "memory");
    __syncthreads();
    if (lead) {
        unsigned* bar = b.bar;
        __builtin_amdgcn_s_waitcnt(0);
        unsigned nloc = b.st[0], nx = b.st[1];
        if (nloc == 0u) { xcd_barrier_complete(bar, b.x, nloc, nx); b.st[0] = nloc; b.st[1] = nx; }
        const unsigned old = xb_add(&bar[XB_XSUB(b.x)], 1u);
        const unsigned gen = old / nloc;
        if (old + 1u == (gen + 1u) * nloc) {
            __builtin_amdgcn_fence(__ATOMIC_RELEASE, "agent");
            asm volatile("s_waitcnt vmcnt(0)" ::: "memory");
            const unsigned og = xb_add(&bar[XB_TOP], 1u);
            const unsigned tg = og / nx;
            if (og + 1u == (tg + 1u) * nx) xb_add(&bar[XB_TOPGEN], 1u);
            else XB_SPIN(xb_ld(&bar[XB_TOPGEN]) == tg, bar);
            __builtin_amdgcn_fence(__ATOMIC_ACQUIRE, "agent");
            xb_add(&bar[XB_XGEN(b.x)], 1u);
            asm volatile("s_waitcnt vmcnt(0)" ::: "memory");
        } else {
            XB_SPIN(xb_ld(&bar[XB_XGEN(b.x)]) == gen, bar);
            __builtin_amdgcn_fence(__ATOMIC_ACQUIRE, "agent");
            asm volatile("s_waitcnt vmcnt(0)" ::: "memory");
        }
    }
    __syncthreads();
}

struct Frame {
    LAS unsigned char* lds;
    int tid, lane, wave, gw, ngw, G;
    const __attribute__((address_space(4))) Params* p;
    unsigned char* ws;
    float* out;
};
#define INP(F, i) ((F).p->in[(i)])
#define WSP(F, T, off) ((T*)((F).ws + (off)))

__device__ __forceinline__ const float* x_in_row(const Frame& F, int r) {
    return r < NP ? INP(F, I_XP) + (size_t)r * DM : INP(F, I_XS) + (size_t)(r - NP) * DM;
}

template <bool ILV = false>
__device__ __forceinline__ void transpose_item(const float* W, int K, int N, int nblk, bf16* WT, int row_off, LAS float* scr, int item, int lane) {
    const int kb = item / nblk, nb = item % nblk, k0 = 64 * kb, n0 = 32 * nb;
    const int r0 = ILV ? 256 * (n0 >> 7) + (n0 & 127) : n0;
    const int n = n0 + (lane & 31);
    float tv[32];
#pragma unroll
    for (int i = 0; i < 32; ++i) { const int kk = 2 * i + (lane >> 5); tv[i] = (n < N) ? W[(size_t)(k0 + kk) * N + n] : 0.f; }
#pragma unroll
    for (int i = 0; i < 32; ++i) { const int kk = 2 * i + (lane >> 5); scr[kk * 33 + (lane & 31)] = tv[i]; }
    asm volatile("s_waitcnt lgkmcnt(0)" ::: "memory");
    const int c = lane & 7;
#pragma unroll
    for (int j = 0; j < 4; ++j) { const int nn = (lane >> 3) + 8 * j; const LAS float* s = scr + (8 * c) * 33 + nn;
        v4u o; o.x = pk2(s[0 * 33], s[1 * 33]); o.y = pk2(s[2 * 33], s[3 * 33]); o.z = pk2(s[4 * 33], s[5 * 33]); o.w = pk2(s[6 * 33], s[7 * 33]);
        *(v4u*)(WT + (size_t)(row_off + r0 + nn) * K + k0 + 8 * c) = o; }
    asm volatile("s_waitcnt lgkmcnt(0)" ::: "memory");
}
__device__ __forceinline__ void norm_row_to_bf16(const Frame& F, const float* xrow, const float* w, bf16* orow) {
    const f32x4* xr = (const f32x4*)xrow + F.lane; const f32x4* wr = (const f32x4*)w + F.lane;
    f32x4 v[4]; float ss = 0.f;
#pragma unroll
    for (int j = 0; j < 4; ++j) { v[j] = xr[64 * j]; ss += (v[j].x * v[j].x + v[j].y * v[j].y) + (v[j].z * v[j].z + v[j].w * v[j].w); }
    const float rs = 1.f / sqrtf(wave_sum(ss) * (1.f / DM) + RMS_EPS);
    unsigned long long* o8 = (unsigned long long*)orow + F.lane;
#pragma unroll
    for (int j = 0; j < 4; ++j) { const f32x4 g = wr[64 * j];
        o8[64 * j] = (unsigned long long)pk2(v[j].x * rs * g.x, v[j].y * rs * g.y) | ((unsigned long long)pk2(v[j].z * rs * g.z, v[j].w * rs * g.w) << 32); }
}
__device__ __forceinline__ void phase_prologue(const Frame& F) {
    LAS float* scr = (LAS float*)(F.lds + F.wave * 16384);
    constexpr int IT_IN = 16 * (IN_WP / 32), IT_OUT = 16 * 32, IT_UP = 16 * 128, IT_DN = 64 * 32, IT_L = IT_IN + IT_OUT + 2 * IT_UP + IT_DN;
    for (int it = F.gw; it < DEPTH * IT_L; it += F.ngw) {
        const int l = it / IT_L; int r = it % IT_L;
        if (r < IT_IN) { transpose_item(INP(F, I_WIN) + (size_t)l * DM * IN_W, DM, IN_W, IN_WP / 32, WSP(F, bf16, WS_WTIN) + (size_t)l * IN_WP * DM, 0, scr, r, F.lane); continue; } r -= IT_IN;
        if (r < IT_OUT) { transpose_item(INP(F, I_WOUT) + (size_t)l * DM * DM, DM, DM, 32, WSP(F, bf16, WS_WTOUT) + (size_t)l * DM * DM, 0, scr, r, F.lane); continue; } r -= IT_OUT;
        if (r < IT_UP) { transpose_item<true>(INP(F, I_WGATE) + (size_t)l * DM * DFF, DM, DFF, 128, WSP(F, bf16, WS_WTUP) + (size_t)l * 2 * DFF * DM, 0, scr, r, F.lane); continue; } r -= IT_UP;
        if (r < IT_UP) { transpose_item<true>(INP(F, I_WVAL) + (size_t)l * DM * DFF, DM, DFF, 128, WSP(F, bf16, WS_WTUP) + (size_t)l * 2 * DFF * DM, 128, scr, r, F.lane); continue; } r -= IT_UP;
        transpose_item(INP(F, I_WDOWN) + (size_t)l * DFF * DM, DFF, DM, 32, WSP(F, bf16, WS_WTDN) + (size_t)l * DM * DFF, 0, scr, r, F.lane);
    }
    for (int it = F.gw; it < 8 * 2 * 64; it += F.ngw) {
        const int i = it >> 7, half = (it >> 6) & 1, r = it & 63; const int lyr = i >> 1, kv = i & 1;
        const float* w1 = INP(F, kv ? I_W1V : I_W1K) + (size_t)lyr * 32 * 64 * 128 + (size_t)half * 1024 * 128;
        transpose_item(w1, 1024, 128, 4, WSP(F, bf16, WS_WTC) + (size_t)i * 256 * 1024, half * 128, scr, r, F.lane);
    }
    for (int idx = blockIdx.x * NTHR + F.tid; idx < 8 * 64 * 128; idx += F.G * NTHR) {
        const int i = idx >> 13, d = (idx >> 7) & 63, e = idx & 127;
        WSP(F, bf16, WS_W2T)[idx] = (bf16)f2bf((INP(F, (i & 1) ? I_W2V : I_W2K) + (size_t)(i >> 1) * 128 * 64)[e * 64 + d]);
    }
    for (int idx = blockIdx.x * NTHR + F.tid; idx < 8 * 128; idx += F.G * NTHR) {
        const int i = idx >> 7, e = idx & 127; const int lyr = i >> 1, kv = i & 1;
        const float* w1 = INP(F, kv ? I_W1V : I_W1K) + (size_t)lyr * 32 * 64 * 128; const float* pe = INP(F, kv ? I_PEV : I_PEK) + (size_t)lyr * 32 * 64;
        float a = 0.f; for (int k = 0; k < 2048; ++k) a += pe[k] * w1[(size_t)k * 128 + e];
        WSP(F, float, WS_CBIAS)[idx] = a;
    }
    for (int it2 = F.gw; it2 < DEPTH * BS * 256; it2 += F.ngw) {
        f32x4 a[2][2][4]; int lyrv[2], bv[2], cv[2];
#pragma unroll
        for (int u = 0; u < 2; ++u) {
            const int it = 2 * it2 + u; const int lyr = it >> 14, b = (it >> 9) & 31, c = it & 511; lyrv[u] = lyr; bv[u] = b; cv[u] = c;
            const int page = ((const int*)INP(F, I_PT))[b * NPAGES + (c >> 3)];
            const int row = F.lane >> 2, qd = F.lane & 3;
            const float* src = INP(F, I_CACHE) + ((((size_t)lyr * NPHYS + page) * PAGE + (c & 7) * 16 + row) * 4) * 64 + qd * 16;
#pragma unroll
            for (int kv = 0; kv < 2; ++kv)
#pragma unroll
                for (int k = 0; k < 4; ++k) a[u][kv][k] = *(const f32x4*)(src + kv * 64 + 4 * k);
        }
#pragma unroll
        for (int u = 0; u < 2; ++u) {
            const int row = F.lane >> 2, qd = F.lane & 3;
#pragma unroll
            for (int kv = 0; kv < 2; ++kv) {
                const f32x4 a0 = a[u][kv][0], a1 = a[u][kv][1], a2 = a[u][kv][2], a3 = a[u][kv][3];
                v4u o0, o1; o0.x = pk2(a0.x, a0.y); o0.y = pk2(a0.z, a0.w); o0.z = pk2(a1.x, a1.y); o0.w = pk2(a1.z, a1.w); o1.x = pk2(a2.x, a2.y); o1.y = pk2(a2.z, a2.w); o1.z = pk2(a3.x, a3.y); o1.w = pk2(a3.z, a3.w);
                bf16* dst = WSP(F, bf16, WS_AS) + ((((size_t)(lyrv[u] * 2 + kv) * BS + bv[u]) * 512 + cv[u]) * 1024) + row * 64 + qd * 16;
                *(v4u*)dst = o0; *(v4u*)(dst + 8) = o1;
            }
        }
    }
    {
        const float inv[8] = {1.0f, 0.193922758102417f, 0.03760603070259094f, 0.00729266507551074f, 0.001414213445968926f, 0.00027424818836152554f, 5.318296462064609e-05f, 1.0313385246263351e-05f};
        float* rope = WSP(F, float, WS_ROPE);
        for (int i = blockIdx.x * NTHR + F.tid; i < 2056 * 8; i += F.G * NTHR) {
            const int pi = i >> 3, f = i & 7; const int pos = pi < TP ? pi : PAST + (pi - TP);
            float iv = inv[0];
#pragma unroll
            for (int k = 1; k < 8; ++k) iv = (f == k) ? inv[k] : iv;
            const float ang = (float)pos * iv; float c, s; cossin_d(ang, c, s);
            rope[pi * 16 + f] = c; rope[pi * 16 + 8 + f] = s;
        }
    }
    for (int r = F.gw; r < MROWS; r += F.ngw) norm_row_to_bf16(F, x_in_row(F, r), INP(F, I_NMPRE), WSP(F, bf16, WS_XN) + (size_t)r * DM);
}

typedef float f32x16p __attribute__((ext_vector_type(16)));
__device__ __forceinline__ void phase_cmp_finish(const Frame& F) {
    const float* H = WSP(F, float, WS_HS);
    const int lane = F.lane, r32 = lane & 31, hp = lane >> 5;
    for (int it = F.gw; it < 8 * BS * 16; it += F.ngw) {
        const int i = it >> 9, b = (it >> 4) & 31, n0 = (it & 15) * 32; const int lyr = i >> 1, kv = i & 1;
        const int n = n0 + r32; const int n1 = (n + 1 < 512) ? n + 1 : 511;
        const float* h0 = H + (((size_t)i * BS + b) * 512 + n) * 256; const float* h1 = H + (((size_t)i * BS + b) * 512 + n1) * 256 + 128;
        const float* bias = WSP(F, float, WS_CBIAS) + i * 128;
        const bf16* w2t = WSP(F, bf16, WS_W2T) + (size_t)i * 64 * 128;
        f32x16p acc0, acc1;
#pragma unroll
        for (int k = 0; k < 16; ++k) { acc0[k] = 0.f; acc1[k] = 0.f; }
#pragma unroll
        for (int ks = 0; ks < 8; ++ks) {
            const int e = 16 * ks + 8 * hp;
            const f32x4 a0 = *(const f32x4*)(h0 + e), a1 = *(const f32x4*)(h0 + e + 4), c0 = *(const f32x4*)(h1 + e), c1 = *(const f32x4*)(h1 + e + 4);
            const f32x4 b0 = *(const f32x4*)(bias + e), b1 = *(const f32x4*)(bias + e + 4);
            const f32x4 x0 = a0 + c0 + b0, x1 = a1 + c1 + b1;
            v4u av; av.x = pk2(gelu_tanh(x0.x), gelu_tanh(x0.y)); av.y = pk2(gelu_tanh(x0.z), gelu_tanh(x0.w)); av.z = pk2(gelu_tanh(x1.x), gelu_tanh(x1.y)); av.w = pk2(gelu_tanh(x1.z), gelu_tanh(x1.w));
            const bf16x8 bf0 = *(const bf16x8*)(w2t + (size_t)r32 * 128 + e), bf1 = *(const bf16x8*)(w2t + (size_t)(32 + r32) * 128 + e);
            acc0 = __builtin_amdgcn_mfma_f32_32x32x16_bf16(__builtin_bit_cast(bf16x8, av), bf0, acc0, 0, 0, 0);
            acc1 = __builtin_amdgcn_mfma_f32_32x32x16_bf16(__builtin_bit_cast(bf16x8, av), bf1, acc1, 0, 0, 0);
        }
        float* dst = WSP(F, float, kv ? WS_CVS : WS_CKS) + (((size_t)lyr * BS + b) * NCMP_S) * 64;
#pragma unroll
        for (int k = 0; k < 16; ++k) { const int nn = n0 + (k & 3) + 8 * (k >> 2) + 4 * hp;
            if (nn < NCMP_S) { dst[(size_t)nn * 64 + r32] = acc0[k]; dst[(size_t)nn * 64 + 32 + r32] = acc1[k]; } }
    }
}

__device__ __forceinline__ float rope_lane(float x, int lane, float cs_c, float cs_s) {
    const float other = __shfl_xor(x, 8);
    const float rot = (lane < 8) ? x * cs_c - other * cs_s : x * cs_c + other * cs_s;
    return (lane < 16) ? rot : x;
}
__device__ __forceinline__ void token_prep4(const Frame& F, int l, int r0, const LAS float* pw_lds, LAS float* pl) {
    constexpr int NR = 4;
    int s, t0; row_to_seq(r0, s, t0); const Seq q = seq_of(s);
    const int lane = F.lane;
    const float* spool = INP(F, I_SPOOL) + ((size_t)l * BS + q.b) * POOL_KEEP * POOL_W;
    const float* proj0 = WSP(F, float, WS_PROJ) + (size_t)r0 * IN_WP;
    float qx[NR][4], kx[NR][6], csc[NR], css[NR];
#pragma unroll
    for (int u = 0; u < NR; ++u) {
        const float* proj = proj0 + (size_t)u * IN_WP; const int t = t0 + u;
        const float* rp = WSP(F, float, WS_ROPE) + (size_t)(q.samp ? TP + t : t) * 16;
#pragma unroll
        for (int j = 0; j < 4; ++j) qx[u][j] = proj[OFF_Q + j * 64 + lane];
#pragma unroll
        for (int j = 0; j < 6; ++j) kx[u][j] = proj[OFF_KV + j * 64 + lane];
        csc[u] = rp[lane & 7]; css[u] = rp[8 + (lane & 7)];
    }
    float e0[2 + 3], e1[4 + 3], e2[8 + 3], e3[16 + 3];
#define LOAD_EXT(EARR, G, W) do { _Pragma("unroll") for (int k = 0; k < (W) + 3; ++k) { const int tt = t0 - ((W) - 1) + k; const int c = (G) * 64 + lane; \
          \
        const float* pa = (tt >= 0) ? proj0 + (long)(tt - t0) * IN_WP + OFF_POOL + c : (q.samp ? spool + (POOL_KEEP + tt) * POOL_W + c : proj0 + OFF_POOL + c); \
        const float v = *pa; EARR[k] = (tt >= 0 || q.samp) ? v : 0.f; } } while (0)
    LOAD_EXT(e0, 0, 2); LOAD_EXT(e1, 1, 4); LOAD_EXT(e2, 2, 8); LOAD_EXT(e3, 3, 16);
#undef LOAD_EXT
    float pooled[NR][4], pu[NR][4];
#pragma unroll
    for (int u = 0; u < NR; ++u) {
        const int pos = q.pos0 + t0 + u;
        float s0 = 0.f, s1 = 0.f, s2 = 0.f, s3 = 0.f;
#pragma unroll
        for (int i = 0; i < 2; ++i) s0 += e0[u + i];
#pragma unroll
        for (int i = 0; i < 4; ++i) s1 += e1[u + i];
#pragma unroll
        for (int i = 0; i < 8; ++i) s2 += e2[u + i];
#pragma unroll
        for (int i = 0; i < 16; ++i) s3 += e3[u + i];
        pu[u][0] = e0[u + 1]; pu[u][1] = e1[u + 3]; pu[u][2] = e2[u + 7]; pu[u][3] = e3[u + 15];
        pooled[u][0] = s0 / (float)((pos + 1 < 2) ? pos + 1 : 2) - pu[u][0];
        pooled[u][1] = s1 / (float)((pos + 1 < 4) ? pos + 1 : 4) - pu[u][1];
        pooled[u][2] = s2 / (float)((pos + 1 < 8) ? pos + 1 : 8) - pu[u][2];
        pooled[u][3] = s3 / (float)((pos + 1 < 16) ? pos + 1 : 16) - pu[u][3];
    }
#pragma unroll
    for (int u = 0; u < NR; ++u) {
        const int r = r0 + u, t = t0 + u;
        bf16* qb = WSP(F, bf16, WS_QB) + (size_t)r * 256;
#pragma unroll
        for (int j = 0; j < 4; ++j) qb[j * 64 + lane] = (bf16)f2bf(rope_lane(qx[u][j], lane, csc[u], css[u]) * (0.125f * 1.4426950408889634f));
        float* kvout = q.samp ? F.out + O_KVS + ((size_t)l * NS + (r - NP)) * 256 : F.out + O_KVP + ((size_t)l * NP + r) * 256;
        float* kwin = WSP(F, float, WS_KWIN) + (size_t)r * 128;
#pragma unroll
        for (int j = 0; j < 6; ++j) {
            const float v = (j & 1) ? kx[u][j] : rope_lane(kx[u][j], lane, csc[u], css[u]);
            if (j < 4) kvout[j * 64 + lane] = v;
            else {
                kwin[(j - 4) * 64 + lane] = v;
                if (!q.samp) { if (t >= TP - 512) F.out[O_WINP + (((size_t)l * BP + q.b) * 512 + (t - (TP - 512))) * 128 + (j - 4) * 64 + lane] = v; }
                else F.out[O_WINS + (((size_t)l * BS + q.b) * 512 + 504 + t) * 128 + (j - 4) * 64 + lane] = v;
            }
        }
#pragma unroll
        for (int g = 0; g < 4; ++g) pl[u * 256 + g * 64 + lane] = pooled[u][g];
    }
    asm volatile("s_waitcnt lgkmcnt(0)" ::: "memory");
    const float* psc = INP(F, I_POOLSC) + (size_t)l * POOL_W;
#pragma unroll
    for (int g = 0; g < 4; ++g) {
        float y[NR];
#pragma unroll
        for (int u = 0; u < NR; ++u) y[u] = 0.f;
#pragma unroll 4
        for (int c = 0; c < 64; c += 4) { const LAS float* wv = pw_lds + (g * 64 + c) * 64 + lane;
            const float w0 = wv[0], w1 = wv[64], w2 = wv[128], w3 = wv[192];
#pragma unroll
            for (int u = 0; u < NR; ++u) { const f32x4 pa = *(const LAS f32x4*)(pl + u * 256 + g * 64 + c); y[u] += pa.x * w0 + pa.y * w1 + pa.z * w2 + pa.w * w3; } }
        const float sc = psc[g * 64 + lane];
#pragma unroll
        for (int u = 0; u < NR; ++u) (WSP(F, bf16, WS_MIX) + (size_t)(r0 + u) * DM)[512 + g * 64 + lane] = (bf16)f2bf(y[u] * sc);
    }
    asm volatile("s_waitcnt lgkmcnt(0)" ::: "memory");
#pragma unroll
    for (int u = 0; u < NR; ++u) {
        const int r = r0 + u, t = t0 + u; const float* proj = WSP(F, float, WS_PROJ) + (size_t)r * IN_WP;
        if (!q.samp) {
            if (t >= TP - 15) { float* o = F.out + O_POOLP + (((size_t)l * BP + q.b) * 15 + (t - (TP - 15))) * POOL_W;
#pragma unroll
                for (int j = 0; j < 4; ++j) o[j * 64 + lane] = pu[u][j]; }
            if (t >= TP - 3) { float* o = F.out + O_CONVP + (((size_t)l * BP + q.b) * 3 + (t - (TP - 3))) * CONV_DIM;
                for (int j = 0; j < 16; ++j) o[j * 64 + lane] = proj[OFF_XBC + j * 64 + lane]; }
        } else {
            { float* o = F.out + O_POOLS + (((size_t)l * BS + q.b) * 15 + 7 + t) * POOL_W;
#pragma unroll
                for (int j = 0; j < 4; ++j) o[j * 64 + lane] = pu[u][j]; }
            if (t < 7) { float* o = F.out + O_POOLS + (((size_t)l * BS + q.b) * 15 + t) * POOL_W;
#pragma unroll
                for (int j = 0; j < 4; ++j) o[j * 64 + lane] = spool[(8 + t) * POOL_W + j * 64 + lane]; }
            if (t >= TS - 3) { float* o = F.out + O_CONVS + (((size_t)l * BS + q.b) * 3 + (t - (TS - 3))) * CONV_DIM;
                for (int j = 0; j < 16; ++j) o[j * 64 + lane] = proj[OFF_XBC + j * 64 + lane]; }
        }
    }
}

__device__ __forceinline__ float xbc_conv(const Frame& F, int l, const Seq& q, int t, int c) {
    const float* cw = INP(F, I_CONVW) + (size_t)l * 4 * CONV_DIM; const float* cb = INP(F, I_CONVB) + (size_t)l * CONV_DIM;
    const float* proj = WSP(F, float, WS_PROJ);
    const float* sconv = INP(F, I_SCONV) + ((size_t)l * BS + q.b) * 3 * CONV_DIM;
    float acc = cb[c];
#pragma unroll
    for (int k = 0; k < 4; ++k) { const int tt = t - 3 + k; float e = 0.f;
        if (tt >= 0) e = proj[(size_t)(q.row0 + tt) * IN_WP + OFF_XBC + c];
        else if (q.samp) e = sconv[(3 + tt) * CONV_DIM + c];
        acc += e * cw[k * CONV_DIM + c]; }
    return siluf_(acc);
}
__device__ __forceinline__ void ssd_item(const Frame& F, int l, int s, int h) {
    const Seq q = seq_of(s);
    constexpr int TSTG = 16;
    LAS float* xs = (LAS float*)F.lds;
    LAS float* Bs = xs + TSTG * 64;
    LAS float* Cs = Bs + TSTG * 128;
    LAS float* dts = Cs + TSTG * 128;
    LAS float* dAs = dts + TSTG;
    const int tid = F.tid, p = tid >> 3, nq = tid & 7, g = h >> 2;
    const float a = -expf(INP(F, I_ALOG)[l * SSD_H + h]), dtb = INP(F, I_DTB)[l * SSD_H + h], dsk = INP(F, I_SSDD)[l * SSD_H + h];
    float st[16];
    if (q.samp) { const float* s0 = INP(F, I_SSM) + ((((size_t)l * BS + q.b) * SSD_H + h) * SSD_HD + p) * SSD_N + nq * 16;
#pragma unroll
        for (int i = 0; i < 16; ++i) st[i] = s0[i]; }
    else {
#pragma unroll
        for (int i = 0; i < 16; ++i) st[i] = 0.f; }
    const float* proj = WSP(F, float, WS_PROJ);
    float* yssd = WSP(F, float, WS_YSSD);
    for (int t0 = 0; t0 < q.T; t0 += TSTG) {
        const int nt = (q.T - t0 < TSTG) ? q.T - t0 : TSTG;
        __syncthreads();
        for (int i = tid; i < nt * 320; i += NTHR) { const int tt = i / 320, c = i % 320; const int t = t0 + tt;
            if (c < 64) xs[tt * 64 + c] = xbc_conv(F, l, q, t, h * 64 + c);
            else if (c < 192) Bs[tt * 128 + (c - 64)] = xbc_conv(F, l, q, t, 512 + g * 128 + (c - 64));
            else Cs[tt * 128 + (c - 192)] = xbc_conv(F, l, q, t, 768 + g * 128 + (c - 192)); }
        if (tid < nt) { const float dt = softplusf_(proj[(size_t)(q.row0 + t0 + tid) * IN_WP + OFF_DT + h] + dtb); dts[tid] = dt; dAs[tid] = expf(dt * a); }
        __syncthreads();
        for (int tt = 0; tt < nt; ++tt) {
            const float dt = dts[tt], dA = dAs[tt], x = xs[tt * 64 + p], xd = x * dt;
            float y = 0.f;
#pragma unroll
            for (int i = 0; i < 16; ++i) { st[i] = st[i] * dA + xd * Bs[tt * 128 + nq * 16 + i]; y += st[i] * Cs[tt * 128 + nq * 16 + i]; }
            y += __shfl_xor(y, 1); y += __shfl_xor(y, 2); y += __shfl_xor(y, 4);
            if (nq == 0) yssd[(size_t)(q.row0 + t0 + tt) * SSD_W + h * 64 + p] = y + dsk * x;
        }
    }
    float* so = q.samp ? F.out + O_SSMS + ((((size_t)l * BS + q.b) * SSD_H + h) * SSD_HD + p) * SSD_N + nq * 16
                       : F.out + O_SSMP + ((((size_t)l * BP + q.b) * SSD_H + h) * SSD_HD + p) * SSD_N + nq * 16;
#pragma unroll
    for (int i = 0; i < 16; ++i) so[i] = st[i];
    __syncthreads();
}
__device__ __forceinline__ void ssd_chunk_unit(const Frame& F, int l, int b, int c, int g);
__device__ __forceinline__ void ssd_scan(const Frame& F, int l);
__device__ __forceinline__ void ssd_out_unit(const Frame& F, int l, int b, int hc);
__device__ __forceinline__ void phase_prep(const Frame& F, int l) {
    for (int u = blockIdx.x; u < BP * 16 * 2; u += F.G) ssd_chunk_unit(F, l, u >> 5, (u >> 1) & 15, u & 1);
    for (int it = BP * SSD_H + blockIdx.x; it < NSEQ * SSD_H; it += F.G) ssd_item(F, l, it >> 3, it & 7);
    {
        __syncthreads();
        LAS float* pw_lds = (LAS float*)F.lds; const float* pw = INP(F, I_POOLW) + (size_t)l * 4 * 64 * 64;
        for (int i = F.tid; i < 4 * 64 * 64 / 4; i += NTHR) *(LAS f32x4*)(pw_lds + i * 4) = *(const f32x4*)(pw + i * 4);
        __syncthreads();
        LAS float* pl = (LAS float*)(F.lds + 65536) + F.wave * 1024;
        for (int rp = F.gw; rp < MROWS / 4; rp += F.ngw) token_prep4(F, l, 4 * rp, pw_lds, pl);
        __syncthreads();
    }
    {
        const f32x4* src = (const f32x4*)(INP(F, I_SWIN) + (size_t)l * BS * 512 * 128);
        f32x4* dst = (f32x4*)(F.out + O_WINS + (size_t)l * BS * 512 * 128);
        const int nth = F.G * NTHR, i0 = blockIdx.x * NTHR + F.tid;
        f32x4 v[4]; size_t o[4]; bool ok[4];
#pragma unroll
        for (int k = 0; k < 4; ++k) { const int i = i0 + k * nth; ok[k] = i < BS * 504 * 32; const int ic = ok[k] ? i : 0; const int b = ic / (504 * 32), rem = ic % (504 * 32);
            o[k] = (size_t)b * 512 * 32 + rem; v[k] = src[o[k] + 8 * 32]; }
#pragma unroll
        for (int k = 0; k < 4; ++k) if (ok[k]) dst[o[k]] = v[k];
        for (int i = i0 + 4 * nth; i < BS * 504 * 32; i += nth) { const int b = i / (504 * 32), rem = i % (504 * 32);
            dst[(size_t)b * 512 * 32 + rem] = src[(size_t)b * 512 * 32 + 8 * 32 + rem]; }
    }
}

__device__ __forceinline__ const float* kv_row(const Frame& F, int l, const Seq& q, int tok, int kind) {
    if (!q.samp) return F.out + O_KVP + ((size_t)l * NP + q.row0 + tok) * 256 + kind * 64;
    if (tok >= PAST) return F.out + O_KVS + ((size_t)l * NS + (q.row0 - NP) + (tok - PAST)) * 256 + kind * 64;
    const int page = ((const int*)INP(F, I_PT))[q.b * NPAGES + (tok >> 7)];
    return INP(F, I_CACHE) + ((((size_t)l * NPHYS + page) * PAGE + (tok & 127)) * 4 + kind) * 64;
}
typedef float f32x4c __attribute__((ext_vector_type(4)));
__device__ __forceinline__ void compress_item(const Frame& F, int l, int s, int grp, int kv) {
    const Seq q = seq_of(s);
    const int ncmp = NCMP_P;
    const int n0 = grp * 16; const int nb = (ncmp - n0 < 16) ? ncmp - n0 : 16;
    constexpr int CST = 2064;
    LAS unsigned char* rows = F.lds;
    LAS float* hid = (LAS float*)(F.lds + 36864);
    const int tid = F.tid, lane = F.lane, wave = F.wave;
    __syncthreads();
    for (int i = tid; i < 17 * 16 * 8; i += NTHR) { const int rr = i >> 3, dc = i & 7; const int tok = n0 * 16 + rr;
        v4u o = (v4u){0u, 0u, 0u, 0u};
        if (tok < TP) { const float* p = kv_row(F, l, q, tok, kv) + dc * 8; const f32x4 a = *(const f32x4*)p, b = *(const f32x4*)(p + 4);
            o.x = pk2(a.x, a.y); o.y = pk2(a.z, a.w); o.z = pk2(b.x, b.y); o.w = pk2(b.z, b.w); }
        *(LAS v4u*)(rows + (rr >> 4) * CST + (rr & 15) * 128 + dc * 16) = o; }
    __syncthreads();
    const int i2 = l * 2 + kv;
    const bf16* wt = WSP(F, bf16, WS_WTC) + (size_t)i2 * 256 * 1024;
    const int e = 16 * wave + (lane & 15), kq = lane >> 4, blk = lane & 15;
    f32x4c acc = (f32x4c){0.f, 0.f, 0.f, 0.f};
#pragma unroll 8
    for (int ks = 0; ks < 64; ++ks) {
        const int half = ks >> 5, kk = (ks & 31) * 32 + 8 * kq;
        const bf16x8 bfrag = *(const bf16x8*)(wt + (size_t)(half * 128 + e) * 1024 + kk);
        const bf16x8 afrag = *(const LAS bf16x8*)(rows + (blk + half) * CST + kk * 2);
        acc = __builtin_amdgcn_mfma_f32_16x16x32_bf16(afrag, bfrag, acc, 0, 0, 0);
    }
    { const float bias = WSP(F, float, WS_CBIAS)[i2 * 128 + e];
#pragma unroll
      for (int k = 0; k < 4; ++k) hid[(kq * 4 + k) * 128 + e] = gelu_tanh(acc[k] + bias); }
    __syncthreads();
    const float* w2 = INP(F, kv ? I_W2V : I_W2K) + (size_t)l * 128 * 64;
    float* dst = WSP(F, float, kv ? WS_CVP : WS_CKP) + (size_t)q.b * NCMP_P * 64;
    { const int bi = tid >> 5, d0 = (tid & 31) * 2;
        if (bi < nb) { float o0 = 0.f, o1 = 0.f;
#pragma unroll 8
            for (int k = 0; k < 128; ++k) { const float hv = hid[bi * 128 + k]; o0 += hv * w2[k * 64 + d0]; o1 += hv * w2[k * 64 + d0 + 1]; }
            dst[(size_t)(n0 + bi) * 64 + d0] = o0; dst[(size_t)(n0 + bi) * 64 + d0 + 1] = o1; } }
    __syncthreads();
}
__device__ __forceinline__ void attn_sample_unit(const Frame& F, int l, int b, int t0);
__device__ __forceinline__ void phase_compress(const Frame& F, int l) {
    constexpr int NI_P = BP * 8 * 2;
    for (int it = blockIdx.x; it < NI_P; it += F.G) compress_item(F, l, it >> 4, (it >> 1) & 7, it & 1);
    ssd_scan(F, l);
    { Frame G2 = F; { int ln = G2.lane; asm volatile("" : "+v"(ln)); G2.lane = ln; G2.tid = G2.wave * 64 + ln; }
      for (int u = blockIdx.x; u < NS; u += F.G) attn_sample_unit(G2, l, u >> 3, u & 7); }
}

__device__ __forceinline__ void osm_step(float sc, const f32x4 v, float& m, float& lsum, f32x4& o) {
    const float mn = fmaxf(m, sc); const float al = expf(m - mn), pp = expf(sc - mn);
    lsum = lsum * al + pp; o = o * al + v * pp; m = mn;
}
__device__ __forceinline__ void nsa_token(const Frame& F, int l, int r) {
    int s, t; row_to_seq(r, s, t); const Seq q = seq_of(s);
    const int lane = F.lane, hh = lane >> 4, sub = lane & 15;
    const int tpos = q.pos0 + t;
    LAS float* sc = (LAS float*)(F.lds + F.wave * 12288);
    LAS float* impv = sc + 2048;
    LAS int* sel = (LAS int*)(impv + 192);
    const f32x4 qv = *(const f32x4*)(WSP(F, float, WS_Q) + (size_t)r * 256 + hh * 64 + sub * 4);
    const int ncmp = q.samp ? NCMP_S : NCMP_P;
    const float* ck = q.samp ? WSP(F, float, WS_CKS) + (size_t)q.b * NCMP_S * 64 : WSP(F, float, WS_CKP) + (size_t)q.b * NCMP_P * 64;
    const float* cv = q.samp ? WSP(F, float, WS_CVS) + (size_t)q.b * NCMP_S * 64 : WSP(F, float, WS_CVP) + (size_t)q.b * NCMP_P * 64;
    int nvis = 0; if (tpos >= 31) { nvis = (tpos - 31) / 16 + 1; if (nvis > ncmp) nvis = ncmp; }
    float mx = -INFINITY;
    for (int n = 0; n < nvis; ++n) { const f32x4 kk = *(const f32x4*)(ck + (size_t)n * 64 + sub * 4);
        const float d = sum16(qv.x * kk.x + qv.y * kk.y + qv.z * kk.z + qv.w * kk.w);
        if (sub == 0) sc[hh * 512 + n] = d; mx = fmaxf(mx, d); }
    asm volatile("s_waitcnt lgkmcnt(0)" ::: "memory");
    float ls = 0.f;
    for (int n = sub; n < nvis; n += 16) { const float e = expf(sc[hh * 512 + n] - mx); sc[hh * 512 + n] = e; ls += e; }
    ls = sum16(ls);
    const float rl = ls > 0.f ? 1.f / ls : 0.f;
    for (int n = sub; n < nvis; n += 16) sc[hh * 512 + n] *= rl;
    asm volatile("s_waitcnt lgkmcnt(0)" ::: "memory");
    f32x4 ocmp = (f32x4){0.f, 0.f, 0.f, 0.f};
    for (int n = 0; n < nvis; ++n) { const float pp = sc[hh * 512 + n]; ocmp += *(const f32x4*)(cv + (size_t)n * 64 + sub * 4) * pp; }
    const int nslc = q.samp ? 129 : 32, cur = tpos >> 6;
    for (int j = lane; j < nslc; j += 64) {
        float v;
        if (j > cur) v = -INFINITY;
        else if (j == 0 || j == cur || j == cur - 1) v = INFINITY;
        else { v = 0.f;
            for (int n = 4 * j - 1; n <= 4 * j + 3; ++n) if (n >= 0 && n < nvis) v += (sc[n] + sc[512 + n]) + (sc[1024 + n] + sc[1536 + n]); }
        impv[j] = v;
    }
    asm volatile("s_waitcnt lgkmcnt(0)" ::: "memory");
    int nsel = 0;
    for (int j0 = 0; j0 < nslc; j0 += 64) {
        const int j = j0 + lane; bool selj = false;
        if (j < nslc) { const float vj = impv[j]; int rank = 0;
            for (int k = 0; k < nslc; ++k) { const float vk = impv[k]; rank += (vk > vj || (vk == vj && k < j)) ? 1 : 0; }
            selj = (rank < 16) && (j <= cur); }
        const unsigned long long bal = __ballot(selj);
        if (selj) sel[nsel + __popcll(bal & ((1ull << lane) - 1ull))] = j;
        nsel += __popcll(bal);
    }
    asm volatile("s_waitcnt lgkmcnt(0)" ::: "memory");
    float m2 = -INFINITY, l2 = 0.f; f32x4 o2 = (f32x4){0.f, 0.f, 0.f, 0.f};
    for (int si = 0; si < nsel; ++si) {
        const int j = sel[si]; int ntok = tpos - 64 * j + 1; if (ntok > 64) ntok = 64;
        for (int i = 0; i < ntok; ++i) { const int tok = 64 * j + i;
            const float* kr = kv_row(F, l, q, tok, 2);
            const f32x4 kk = *(const f32x4*)(kr + sub * 4); const f32x4 vv = *(const f32x4*)(kr + 64 + sub * 4);
            const float d = sum16(qv.x * kk.x + qv.y * kk.y + qv.z * kk.z + qv.w * kk.w);
            osm_step(d, vv, m2, l2, o2); }
    }
    float m3 = -INFINITY, l3 = 0.f; f32x4 o3 = (f32x4){0.f, 0.f, 0.f, 0.f};
    {
        int k0 = tpos - 511; if (k0 < 0) k0 = 0;
        const float* swin = INP(F, I_SWIN) + ((size_t)l * BS + q.b) * 512 * 128;
        const float* kwin = WSP(F, float, WS_KWIN);
        for (int kp = k0; kp <= tpos; ++kp) {
            const float* kr;
            if (!q.samp) kr = kwin + (size_t)(q.row0 + kp) * 128;
            else if (kp >= PAST) kr = kwin + (size_t)(q.row0 + kp - PAST) * 128;
            else kr = swin + (size_t)(kp - (PAST - 512)) * 128;
            const f32x4 kk = *(const f32x4*)(kr + sub * 4); const f32x4 vv = *(const f32x4*)(kr + 64 + sub * 4);
            const float d = sum16(qv.x * kk.x + qv.y * kk.y + qv.z * kk.z + qv.w * kk.w);
            osm_step(d, vv, m3, l3, o3); }
    }
    const float* gp = WSP(F, float, WS_PROJ) + (size_t)r * IN_WP + OFF_G + hh * 3;
    const float g0 = sigmoidf_(gp[0]), g1 = sigmoidf_(gp[1]), g2 = sigmoidf_(gp[2]);
    const float r2 = l2 > 0.f ? 1.f / l2 : 0.f, r3 = l3 > 0.f ? 1.f / l3 : 0.f;
    const f32x4 y = ocmp * g0 + o2 * (g1 * r2) + o3 * (g2 * r3);
    unsigned long long* mo = (unsigned long long*)(WSP(F, bf16, WS_MIX) + (size_t)r * DM + 768 + hh * 64 + sub * 4);
    *mo = (unsigned long long)pk2(y.x, y.y) | ((unsigned long long)pk2(y.z, y.w) << 32);
}
__device__ __forceinline__ void ssd_finish_token(const Frame& F, int l, int r) {
    const float* y = WSP(F, float, WS_YSSD) + (size_t)r * SSD_W; const float* z = WSP(F, float, WS_PROJ) + (size_t)r * IN_WP;
    const float* nw = INP(F, I_SSDNORM) + (size_t)l * SSD_W;
    float v[8]; float ss = 0.f;
#pragma unroll
    for (int j = 0; j < 8; ++j) { const int c = j * 64 + F.lane; v[j] = y[c] * siluf_(z[c]); ss += v[j] * v[j]; }
    const float rs = 1.f / sqrtf(wave_sum(ss) * (1.f / SSD_W) + RMS_EPS);
    bf16* mix = WSP(F, bf16, WS_MIX) + (size_t)r * DM;
#pragma unroll
    for (int j = 0; j < 8; ++j) { const int c = j * 64 + F.lane; mix[c] = (bf16)f2bf(v[j] * rs * nw[c]); }
}
__device__ __forceinline__ void phase_attn(const Frame& F, int l) {
    for (int r = F.gw; r < MROWS; r += F.ngw) { nsa_token(F, l, r); ssd_finish_token(F, l, r); }
}


typedef short bf16x8 __attribute__((ext_vector_type(8)));
typedef float f32x16 __attribute__((ext_vector_type(16)));
typedef float f32x2_t __attribute__((ext_vector_type(2))); typedef __bf16 bf16x2_t __attribute__((ext_vector_type(2)));
__device__ __forceinline__ unsigned cvtpk(float lo, float hi) { f32x2_t v = {lo, hi}; bf16x2_t b = __builtin_convertvector(v, bf16x2_t); return __builtin_bit_cast(unsigned, b); }
__device__ __forceinline__ float half_sum(float v) { auto rr = __builtin_amdgcn_permlane32_swap(__float_as_uint(v), __float_as_uint(v), false, false); return __uint_as_float(rr[0]) + __uint_as_float(rr[1]); }
__device__ __forceinline__ float half_max(float v) { auto rr = __builtin_amdgcn_permlane32_swap(__float_as_uint(v), __float_as_uint(v), false, false); return fmaxf(__uint_as_float(rr[0]), __uint_as_float(rr[1])); }

constexpr float QSCALE_B = 0.125f * 1.4426950408889634f;
constexpr int AT_K = 0, AT_V = 16384, AT_IMPG = 32768, AT_IMPE = AT_IMPG + 8192, AT_SEL = AT_IMPE + 8192, AT_UNI = AT_SEL + 2048, AT_LIST = AT_UNI + 64, AT_NLIST = AT_LIST + 768,
              AT_PAGE = AT_NLIST + 64, AT_RANK = AT_PAGE + 768, AT_OUT = AT_RANK + 8 * 1024, AT_END = AT_OUT + 8 * 8192;
static_assert(AT_END <= RING_BYTES, "attention LDS map");
enum { KIND_CMP1 = 0, KIND_CMP2 = 1, KIND_SLC = 2, KIND_WIN = 3 };

struct TileRegs { f32x4 k0, k1, v0, v1; };
__device__ __forceinline__ void tile_load(const Frame& F, int l, const Seq& q, int kind, int tile, int pg, TileRegs& R) {
    int t_ = F.tid; asm volatile("" : "+v"(t_));
    const int key = tile * 64 + (t_ >> 3), dc = t_ & 7;
    const float* kr = nullptr; const float* vr = nullptr;
    if (kind <= KIND_CMP2) {
        const int ncmp = q.samp ? NCMP_S : NCMP_P;
        if (key < ncmp) {
            kr = (q.samp ? WSP(F, float, WS_CKS) + ((size_t)l * BS + q.b) * NCMP_S * 64 : WSP(F, float, WS_CKP) + (size_t)q.b * NCMP_P * 64) + (size_t)key * 64;
            vr = (q.samp ? WSP(F, float, WS_CVS) + ((size_t)l * BS + q.b) * NCMP_S * 64 : WSP(F, float, WS_CVP) + (size_t)q.b * NCMP_P * 64) + (size_t)key * 64; }
    } else if (kind == KIND_SLC) {
        if (key < q.pos0 + q.T) {
            if (!q.samp) kr = F.out + O_KVP + ((size_t)l * NP + q.row0 + key) * 256 + 2 * 64;
            else if (key < PAST) kr = INP(F, I_CACHE) + ((((size_t)l * NPHYS + pg) * PAGE + (key & 127)) * 4 + 2) * 64;
            else kr = F.out + O_KVS + ((size_t)l * NS + (q.row0 - NP) + (key - PAST)) * 256 + 2 * 64;
            vr = kr + 64; }
    } else {
        if (key < q.pos0 + q.T) {
            if (!q.samp) kr = WSP(F, float, WS_KWIN) + (size_t)(q.row0 + key) * 128;
            else if (key >= PAST) kr = WSP(F, float, WS_KWIN) + (size_t)(q.row0 + key - PAST) * 128;
            else if (key >= PAST - 512) kr = INP(F, I_SWIN) + (((size_t)l * BS + q.b) * 512 + (key - (PAST - 512))) * 128;
            if (kr) vr = kr + 64; }
    }
    const f32x4 z = (f32x4){0.f, 0.f, 0.f, 0.f};
    if (kr) { R.k0 = *(const f32x4*)(kr + dc * 8); R.k1 = *(const f32x4*)(kr + dc * 8 + 4); R.v0 = *(const f32x4*)(vr + dc * 8); R.v1 = *(const f32x4*)(vr + dc * 8 + 4); }
    else { R.k0 = z; R.k1 = z; R.v0 = z; R.v1 = z; }
}
__device__ __forceinline__ void tile_store(const Frame& F, LAS unsigned char* kb, LAS unsigned char* vb, const TileRegs& R) {
    int t_ = F.tid; asm volatile("" : "+v"(t_));
    const int key = t_ >> 3, dc = t_ & 7;
    v4u kk; kk.x = cvtpk(R.k0.x, R.k0.y); kk.y = cvtpk(R.k0.z, R.k0.w); kk.z = cvtpk(R.k1.x, R.k1.y); kk.w = cvtpk(R.k1.z, R.k1.w);
    *(LAS v4u*)(kb + key * 128 + ((dc ^ (key & 7)) << 4)) = kk;
    const unsigned vp[4] = {cvtpk(R.v0.x, R.v0.y), cvtpk(R.v0.z, R.v0.w), cvtpk(R.v1.x, R.v1.y), cvtpk(R.v1.z, R.v1.w)};
#pragma unroll
    for (int j = 0; j < 4; ++j) { const int d = dc * 8 + 2 * j; const int ch = (key >> 2) ^ ((d >> 1) & 15);
        *(LAS unsigned short*)(vb + d * 128 + ch * 8 + (key & 3) * 2) = (unsigned short)vp[j];
        *(LAS unsigned short*)(vb + (d + 1) * 128 + ch * 8 + (key & 3) * 2) = (unsigned short)(vp[j] >> 16); }
}
__device__ __forceinline__ void qk_tile(const LAS unsigned char* kb, const bf16x8 (&qf)[4], f32x16& s0, f32x16& s1, int lane, float init = 0.f) {
    const int r = lane & 31, h = lane >> 5;
#pragma unroll
    for (int i = 0; i < 16; ++i) { s0[i] = init; s1[i] = init; }
#pragma unroll
    for (int ks = 0; ks < 4; ++ks) {
        const bf16x8 a0 = *(const LAS bf16x8*)(kb + r * 128 + (((2 * ks + h) ^ (r & 7)) << 4));
        const bf16x8 a1 = *(const LAS bf16x8*)(kb + (32 + r) * 128 + (((2 * ks + h) ^ (r & 7)) << 4));
        s0 = __builtin_amdgcn_mfma_f32_32x32x16_bf16(a0, qf[ks], s0, 0, 0, 0);
        s1 = __builtin_amdgcn_mfma_f32_32x32x16_bf16(a1, qf[ks], s1, 0, 0, 0);
    }
}
__device__ __forceinline__ void mask_tile(f32x16& s0, f32x16& s1, int kbase, int lo, int hi) {
#pragma unroll
    for (int i = 0; i < 16; ++i) { const int k = kbase + (i & 3) + 8 * (i >> 2);
        if (k < lo || k > hi) s0[i] = -INFINITY;
        if (k + 32 < lo || k + 32 > hi) s1[i] = -INFINITY; }
}
__device__ __forceinline__ float max3_(float x, float y, float z) { float r; asm("v_max3_f32 %0, %1, %2, %3" : "=v"(r) : "v"(x), "v"(y), "v"(z)); return r; }
__device__ __forceinline__ float tile_max(const f32x16& s0, const f32x16& s1) {
    float a = max3_(s0[0], s0[1], s0[2]), b = max3_(s1[0], s1[1], s1[2]);
#pragma unroll
    for (int i = 3; i < 15; i += 2) { a = max3_(a, s0[i], s0[i + 1]); b = max3_(b, s1[i], s1[i + 1]); }
    return half_max(max3_(a, b, fmaxf(s0[15], s1[15])));
}
__device__ __forceinline__ void pv_tile(const LAS unsigned char* vb, const f32x16& s0, const f32x16& s1, f32x16 (&O)[2], int lane) {
    const int r = lane & 31, h = lane >> 5;
    bf16x8 pf[2][2];
#pragma unroll
    for (int sp = 0; sp < 2; ++sp) {
        v4u a; a.x = cvtpk(s0[8 * sp + 0], s0[8 * sp + 1]); a.y = cvtpk(s0[8 * sp + 2], s0[8 * sp + 3]); a.z = cvtpk(s0[8 * sp + 4], s0[8 * sp + 5]); a.w = cvtpk(s0[8 * sp + 6], s0[8 * sp + 7]);
        v4u b; b.x = cvtpk(s1[8 * sp + 0], s1[8 * sp + 1]); b.y = cvtpk(s1[8 * sp + 2], s1[8 * sp + 3]); b.z = cvtpk(s1[8 * sp + 4], s1[8 * sp + 5]); b.w = cvtpk(s1[8 * sp + 6], s1[8 * sp + 7]);
        pf[0][sp] = __builtin_bit_cast(bf16x8, a); pf[1][sp] = __builtin_bit_cast(bf16x8, b);
    }
#pragma unroll
    for (int dh = 0; dh < 2; ++dh) {
        const int d = dh * 32 + r, sw = (d >> 1) & 15; const LAS unsigned char* rb = vb + d * 128;
#pragma unroll
        for (int kh = 0; kh < 2; ++kh)
#pragma unroll
            for (int sp = 0; sp < 2; ++sp) {
                const int q0 = kh * 8 + 4 * sp + h;
                const unsigned long long lo8 = *(const LAS unsigned long long*)(rb + ((q0 ^ sw) << 3));
                const unsigned long long hi8 = *(const LAS unsigned long long*)(rb + (((q0 + 2) ^ sw) << 3));
                v4u av; av.x = (unsigned)lo8; av.y = (unsigned)(lo8 >> 32); av.z = (unsigned)hi8; av.w = (unsigned)(hi8 >> 32);
                O[dh] = __builtin_amdgcn_mfma_f32_32x32x16_bf16(__builtin_bit_cast(bf16x8, av), pf[kh][sp], O[dh], 0, 0, 0);
            }
        __builtin_amdgcn_sched_barrier(0);
    }
}

__device__ __forceinline__ void attn_unit(const Frame& F, int l, int s, int t0, int ntok) {
    Seq q; q.T = TP; q.row0 = s * TP; q.pos0 = 0; q.b = s; q.samp = 0;
    int lane_ = F.lane; asm volatile("" : "+v"(lane_));
    int wave_ = F.wave; asm volatile("" : "+s"(wave_));
    const int lane = lane_, wave = wave_, tid = wave * 64 + lane, h = lane >> 5;
    LAS unsigned char* lds = F.lds;
    LAS float* impG = (LAS float*)(lds + AT_IMPG); LAS float* impE = (LAS float*)(lds + AT_IMPE);
    LAS unsigned* selw = (LAS unsigned*)(lds + AT_SEL);
    LAS unsigned* uni = (LAS unsigned*)(lds + AT_UNI);
    LAS int* list = (LAS int*)(lds + AT_LIST);
    LAS int* nlist = (LAS int*)(lds + AT_NLIST);
    LAS int* lpage = (LAS int*)(lds + AT_PAGE);
    LAS float* rankv = (LAS float*)(lds + AT_RANK + wave * 1024);
    const int nslc = q.samp ? 129 : 32, njs = q.samp ? 128 : 32;
    const int ncmp = q.samp ? NCMP_S : NCMP_P;
    const int tl = wave * 8 + ((lane & 31) >> 2), head = lane & 3;
    const bool vcol = tl < ntok; const bool wact = (wave * 8) < ntok;
    const int tlc = vcol ? tl : 0;
    const int r = q.row0 + t0 + tlc, tpos = q.pos0 + t0 + tlc;
    int nvis = 0; if (vcol && tpos >= 31) { nvis = (tpos - 31) / 16 + 1; if (nvis > ncmp) nvis = ncmp; }
    const int tpos_last = q.pos0 + t0 + ntok - 1;
    int nvis_max = 0; if (tpos_last >= 31) { nvis_max = (tpos_last - 31) / 16 + 1; if (nvis_max > ncmp) nvis_max = ncmp; }
    const int nct = (nvis_max + 63) >> 6;
    bf16x8 qf[4];
    { const bf16* qb = WSP(F, bf16, WS_QB) + ((size_t)r * 4 + head) * 64;
#pragma unroll
      for (int ks = 0; ks < 4; ++ks) qf[ks] = *(const bf16x8*)(qb + 16 * ks + 8 * h); }
    const float* gp = WSP(F, float, WS_PROJ) + (size_t)r * IN_WP + OFF_G + head * 3;
    const float g0 = sigmoidf_(gp[0]), g1 = sigmoidf_(gp[1]), g2 = sigmoidf_(gp[2]);
#define GATE(k) sigmoidf_((WSP(F, float, WS_PROJ) + (size_t)r * IN_WP + OFF_G + head * 3)[(k)])
    f32x16 O[2];
    LAS float* outl = (LAS float*)(lds + AT_OUT + wave * 8192) + lane;
#pragma unroll
    for (int i = 0; i < 16; ++i) { O[0][i] = 0.f; O[1][i] = 0.f; }
    float m = -1e30f, lsum = 0.f, rinv = 0.f;

    __syncthreads();
    if (tid < 2 * nct) list[tid] = (tid < nct ? KIND_CMP1 : KIND_CMP2) | ((tid < nct ? tid : tid - nct) << 4);
    for (int i = tid; i < 64 * 8; i += NTHR) selw[i] = 0u;
    __syncthreads();
    {
        const int n = 2 * nct; TileRegs R;
        if (n > 0) tile_load(F, l, q, KIND_CMP1, 0, 0, R);
        for (int i = 0; i < n; ++i) {
            LAS unsigned char* kb = lds + AT_K + (i & 1) * 8192; LAS unsigned char* vb = lds + AT_V + (i & 1) * 8192;
            tile_store(F, kb, vb, R);
            const int e = __builtin_amdgcn_readfirstlane(list[i]); const int kind = e & 15, tile = e >> 4;
            if (i + 1 < n) { const int e2 = __builtin_amdgcn_readfirstlane(list[i + 1]); tile_load(F, l, q, e2 & 15, e2 >> 4, 0, R); }
            __syncthreads();
            if (wact) {
                if (i == nct) { const float L = half_sum(lsum); rinv = L > 0.f ? 1.f / L : 0.f; }
                f32x16 s0, s1; qk_tile(kb, qf, s0, s1, lane);
                mask_tile(s0, s1, tile * 64 + 4 * h, 0, nvis - 1);
                if (kind == KIND_CMP1) {
                    const float mt = tile_max(s0, s1); const float mn = fmaxf(m, mt); const float al = __builtin_amdgcn_exp2f(m - mn);
                    float rs = 0.f;
#pragma unroll
                    for (int k = 0; k < 16; ++k) rs += __builtin_amdgcn_exp2f(s0[k] - mn) + __builtin_amdgcn_exp2f(s1[k] - mn);
                    lsum = lsum * al + rs; m = mn;
                } else {
#pragma unroll
                    for (int k = 0; k < 16; ++k) { s0[k] = __builtin_amdgcn_exp2f(s0[k] - m) * rinv; s1[k] = __builtin_amdgcn_exp2f(s1[k] - m) * rinv; }
                    pv_tile(vb, s0, s1, O, lane);
#pragma unroll
                    for (int kh = 0; kh < 2; ++kh)
#pragma unroll
                        for (int gq = 0; gq < 4; ++gq) {
                            const f32x16& sv = kh ? s1 : s0;
                            float G = (sv[4 * gq] + sv[4 * gq + 1]) + (sv[4 * gq + 2] + sv[4 * gq + 3]), E = sv[4 * gq + 3];
                            G += __shfl_xor(G, 1); G += __shfl_xor(G, 2); E += __shfl_xor(E, 1); E += __shfl_xor(E, 2);
                            const int j = 16 * tile + 8 * kh + 2 * gq + h;
                            if (head == 0 && vcol && j < njs) { impG[tl * njs + j] = G; impE[tl * njs + j] = E; }
                        }
                }
            }
        }
    }
    const float g0v = GATE(0);
#pragma unroll
    for (int i = 0; i < 16; ++i) { outl[i * 64] = O[0][i] * g0v; outl[(16 + i) * 64] = O[1][i] * g0v; O[0][i] = 0.f; O[1][i] = 0.f; }
    m = 0.f; lsum = 0.f;
    bool started = false;
    asm volatile("s_waitcnt lgkmcnt(0)" ::: "memory");
    if (wact) {
        const int ntw = (ntok - wave * 8 < 8) ? ntok - wave * 8 : 8;
        for (int tt = 0; tt < ntw; ++tt) {
            const int tk = wave * 8 + tt; const int tp = q.pos0 + t0 + tk; const int cur = tp >> 6;
            int nv = 0; if (tp >= 31) { nv = (tp - 31) / 16 + 1; if (nv > ncmp) nv = ncmp; }
            const int jcov = (nv + 3) >> 2;
            for (int j = lane; j < nslc; j += 64) {
                float v;
                if (j > cur) v = -INFINITY;
                else if (j == 0 || j == cur || j == cur - 1) v = INFINITY;
                else { v = 0.f; if (j < jcov) v += impG[tk * njs + j]; if (j - 1 < jcov) v += impE[tk * njs + j - 1]; }
                rankv[j] = v;
            }
            asm volatile("s_waitcnt lgkmcnt(0)" ::: "memory");
            for (int j0 = 0; j0 < nslc; j0 += 64) {
                const int j = j0 + lane; bool selj = false;
                if (j < nslc) { const float vj = rankv[j]; int rank = 0;
                    for (int k = 0; k < nslc; ++k) { const float vk = rankv[k]; rank += (vk > vj || (vk == vj && k < j)) ? 1 : 0; }
                    selj = (rank < 16) && (j <= cur); }
                const unsigned long long bal = __ballot(selj);
                if (lane == 0) { selw[tk * 8 + (j0 >> 5)] = (unsigned)bal; selw[tk * 8 + (j0 >> 5) + 1] = (unsigned)(bal >> 32); }
            }
            asm volatile("s_waitcnt lgkmcnt(0)" ::: "memory");
        }
    }
    __syncthreads();
    if (tid < 8) { unsigned u = 0u; for (int k = 0; k < ntok; ++k) u |= selw[k * 8 + tid]; uni[tid] = u; }
    __syncthreads();
    if (wave == 0) {
        int n = 0;
        for (int j0 = 0; j0 < nslc; j0 += 64) {
            const int j = j0 + lane; const bool sj = (j < nslc) && ((uni[j >> 5] >> (j & 31)) & 1u);
            int pg = 0; if (sj && q.samp && j * 64 < PAST) pg = ((const int*)INP(F, I_PT))[q.b * NPAGES + (j >> 1)];
            const unsigned long long bal = __ballot(sj);
            if (sj) { const int idx = n + __popcll(bal & ((1ull << lane) - 1ull)); list[idx] = KIND_SLC | (j << 4); lpage[idx] = pg; }
            n += __popcll(bal);
        }
        const int p0 = q.pos0 + t0; int w0 = (p0 - 511) >> 6; if (w0 < 0) w0 = 0; if (q.samp && w0 < (PAST - 512) / 64) w0 = (PAST - 512) / 64;
        const int w1 = (p0 + ntok - 1) >> 6;
        if (lane <= w1 - w0) { list[n + lane] = KIND_WIN | ((w0 + lane) << 4); lpage[n + lane] = 0; }
        if (lane == 0) nlist[0] = n + (w1 - w0 + 1);
    }
    __syncthreads();
    {
        const int n = nlist[0]; TileRegs R0, R1; int pkind = KIND_SLC;
        const unsigned selm = vcol ? selw[tlc * 8] : 0u;
        { const int e0 = __builtin_amdgcn_readfirstlane(list[0]); tile_load(F, l, q, e0 & 15, e0 >> 4, __builtin_amdgcn_readfirstlane(lpage[0]), R0); }
        if (n > 1) { const int e1 = __builtin_amdgcn_readfirstlane(list[1]); tile_load(F, l, q, e1 & 15, e1 >> 4, __builtin_amdgcn_readfirstlane(lpage[1]), R1); }
#define ATTN_STEP(RR, BI, II) do { \
            LAS unsigned char* kb = lds + AT_K + (BI) * 8192; LAS unsigned char* vb = lds + AT_V + (BI) * 8192; \
            tile_store(F, kb, vb, RR); \
            const int e = __builtin_amdgcn_readfirstlane(list[(II)]); const int kind = e & 15, tile = e >> 4; \
            if ((II) + 2 < n) { const int e2 = __builtin_amdgcn_readfirstlane(list[(II) + 2]); tile_load(F, l, q, e2 & 15, e2 >> 4, __builtin_amdgcn_readfirstlane(lpage[(II) + 2]), RR); } \
            __syncthreads(); \
            if (wact) { \
                if (kind != pkind) { \
                    const float L = half_sum(lsum); const float sc = L > 0.f ? GATE(1) / L : 0.f; \
                    _Pragma("unroll") for (int k = 0; k < 16; ++k) { outl[k * 64] += O[0][k] * sc; outl[(16 + k) * 64] += O[1][k] * sc; O[0][k] = 0.f; O[1][k] = 0.f; } \
                    m = 0.f; lsum = 0.f; started = false; pkind = kind; \
                } \
                int lo, hi; \
                if (kind == KIND_SLC) { const bool sb = (selm >> (tile & 31)) & 1u; lo = 0; hi = sb ? tpos : -1; } \
                else { lo = tpos - 511; hi = vcol ? tpos : -1; } \
                const bool any = (hi >= tile * 64) && (lo <= tile * 64 + 63); \
                if (__ballot(any) != 0ull) { \
                      \
                      \
                    const bool part = any && !((lo <= tile * 64) && (hi >= tile * 64 + 63)); \
                      \
                      \
                    f32x16 s0, s1; qk_tile(kb, qf, s0, s1, lane, any ? -m : -INFINITY); \
                    if (__ballot(part) != 0ull) mask_tile(s0, s1, tile * 64 + 4 * h, lo, hi); \
                    const float mt = tile_max(s0, s1); \
                    const bool seen = mt > -INFINITY; const bool need = (mt > 8.f) || (seen && !started); started = started || seen; \
                    if (__ballot(need) != 0ull) { \
                        const float dl = need ? mt : 0.f; const float al = __builtin_amdgcn_exp2f(-dl); m += dl; lsum *= al; \
                        _Pragma("unroll") for (int k = 0; k < 16; ++k) { s0[k] -= dl; s1[k] -= dl; O[0][k] *= al; O[1][k] *= al; } } \
                    float rs = 0.f; \
                    _Pragma("unroll") for (int k = 0; k < 16; ++k) { s0[k] = __builtin_amdgcn_exp2f(s0[k]); s1[k] = __builtin_amdgcn_exp2f(s1[k]); rs += s0[k] + s1[k]; } \
                    lsum += rs; \
                    pv_tile(vb, s0, s1, O, lane); \
                } \
            } } while (0)
        for (int i = 0; i < n; i += 2) {
            ATTN_STEP(R0, 0, i);
            if (i + 1 < n) ATTN_STEP(R1, 1, i + 1);
        }
#undef ATTN_STEP
        if (wact) {
            const float L = half_sum(lsum); const float sc = L > 0.f ? (pkind == KIND_SLC ? GATE(1) : GATE(2)) / L : 0.f;
#pragma unroll
            for (int k = 0; k < 16; ++k) { O[0][k] = outl[k * 64] + O[0][k] * sc; O[1][k] = outl[(16 + k) * 64] + O[1][k] * sc; }
        }
    }
    if (vcol) {
        bf16* mo = WSP(F, bf16, WS_MIX) + (size_t)r * DM + 768 + head * 64;
#pragma unroll
        for (int dh = 0; dh < 2; ++dh)
#pragma unroll
            for (int gq = 0; gq < 4; ++gq) {
                const int d = dh * 32 + 8 * gq + 4 * h;
                *(unsigned long long*)(mo + d) = (unsigned long long)cvtpk(O[dh][4 * gq], O[dh][4 * gq + 1]) | ((unsigned long long)cvtpk(O[dh][4 * gq + 2], O[dh][4 * gq + 3]) << 32);
            }
    }
}

#undef GATE
constexpr int SW_T = 0, SW_ML = 65536, SW_IMPG = SW_ML + 4096, SW_IMPE = SW_IMPG + 4096, SW_SEL = SW_IMPE + 4096, SW_UNI = SW_SEL + 256, SW_LIST = SW_UNI + 64,
              SW_PAGE = SW_LIST + 1280, SW_NL = SW_PAGE + 1280, SW_RANK = SW_NL + 64, SW_OUT = SW_RANK + 8 * 1024, SW_END = SW_OUT + 8192;
static_assert(SW_END <= RING_BYTES, "sample attention LDS map");
struct HRegs { f32x4 v[8]; };
__device__ __forceinline__ void h_load(const Frame& F, int l, int b, int kind, int ht, int pg, int which, int lane_in, HRegs& R) {
    int lane = lane_in; asm volatile("" : "+v"(lane));
    const int key = ht * 32 + (lane >> 1), hv = lane & 1;
    const float* base; size_t off; bool ok;
    if (kind <= KIND_CMP2) { ok = key < NCMP_S; const int kc = ok ? key : 0;
        base = WSP(F, float, which ? WS_CVS : WS_CKS); off = (((size_t)l * BS + b) * NCMP_S + kc) * 64; }
    else if (kind == KIND_SLC) { ok = key < PAST + TS;
        if (key < PAST) { base = INP(F, I_CACHE); off = ((((size_t)l * NPHYS + pg) * PAGE + (key & 127)) * 4 + 2 + which) * 64; }
        else { const int kk = ok ? key - PAST : 0; base = F.out + O_KVS; off = ((size_t)l * NS + b * TS + kk) * 256 + (2 + which) * 64; } }
    else { ok = (key >= PAST - 512) && (key < PAST + TS);
        if (key < PAST) { const int kk = ok ? key - (PAST - 512) : 0; base = INP(F, I_SWIN); off = (((size_t)l * BS + b) * 512 + kk) * 128 + which * 64; }
        else { const int kk = ok ? key - PAST : 0; base = WSP(F, float, WS_KWIN); off = ((size_t)NP + b * TS + kk) * 128 + which * 64; } }
    const float* p = base + off + hv * 32;
#pragma unroll
    for (int i = 0; i < 8; ++i) { const f32x4 x = *(const f32x4*)(p + 4 * i); R.v[i] = ok ? x : (f32x4){0.f, 0.f, 0.f, 0.f}; }
}
__device__ __forceinline__ void h_store_k(LAS unsigned char* kb, const HRegs& R, int lane_in) {
    int lane = lane_in; asm volatile("" : "+v"(lane));
    const int key = lane >> 1, hv = lane & 1;
#pragma unroll
    for (int i = 0; i < 4; ++i) { v4u o; o.x = cvtpk(R.v[2 * i].x, R.v[2 * i].y); o.y = cvtpk(R.v[2 * i].z, R.v[2 * i].w); o.z = cvtpk(R.v[2 * i + 1].x, R.v[2 * i + 1].y); o.w = cvtpk(R.v[2 * i + 1].z, R.v[2 * i + 1].w);
        *(LAS v4u*)(kb + key * 128 + (((4 * hv + i) ^ (key & 7)) << 4)) = o; }
}
__device__ __forceinline__ void h_store_v(LAS unsigned char* vb, const HRegs& R, int lane_in) {
    int lane = lane_in; asm volatile("" : "+v"(lane));
    const int key = lane >> 1, hv = lane & 1;
#pragma unroll
    for (int i = 0; i < 8; ++i) {
        const float xs[4] = {R.v[i].x, R.v[i].y, R.v[i].z, R.v[i].w};
#pragma unroll
        for (int k = 0; k < 4; ++k) { const int d = 32 * hv + 4 * i + k;
            *(LAS unsigned short*)(vb + d * 64 + (((key >> 2) ^ ((d >> 2) & 7)) << 3) + (key & 3) * 2) = (unsigned short)f2bf(xs[k]); }
    }
}
__device__ __forceinline__ void qk_half(const LAS unsigned char* kb, const bf16x8 (&qf)[4], f32x16& s0, int lane_in) {
    int lane = lane_in; asm volatile("" : "+v"(lane));
    const int r = lane & 31, h = lane >> 5;
#pragma unroll
    for (int i = 0; i < 16; ++i) s0[i] = 0.f;
#pragma unroll
    for (int ks = 0; ks < 4; ++ks) { const bf16x8 a0 = *(const LAS bf16x8*)(kb + r * 128 + (((2 * ks + h) ^ (r & 7)) << 4));
        s0 = __builtin_amdgcn_mfma_f32_32x32x16_bf16(a0, qf[ks], s0, 0, 0, 0); }
}
__device__ __forceinline__ void pv_half(const LAS unsigned char* vb, const f32x16& s0, f32x16 (&O)[2], int lane_in) {
    int lane = lane_in; asm volatile("" : "+v"(lane));
    const int r = lane & 31, h = lane >> 5;
    bf16x8 pf[2];
#pragma unroll
    for (int sp = 0; sp < 2; ++sp) { v4u a; a.x = cvtpk(s0[8 * sp + 0], s0[8 * sp + 1]); a.y = cvtpk(s0[8 * sp + 2], s0[8 * sp + 3]); a.z = cvtpk(s0[8 * sp + 4], s0[8 * sp + 5]); a.w = cvtpk(s0[8 * sp + 6], s0[8 * sp + 7]);
        pf[sp] = __builtin_bit_cast(bf16x8, a); }
#pragma unroll
    for (int dh = 0; dh < 2; ++dh) { const int d = dh * 32 + r, sw = (d >> 2) & 7; const LAS unsigned char* rb = vb + d * 64;
#pragma unroll
        for (int sp = 0; sp < 2; ++sp) { const int q0 = 4 * sp + h;
            const unsigned long long lo8 = *(const LAS unsigned long long*)(rb + ((q0 ^ sw) << 3)), hi8 = *(const LAS unsigned long long*)(rb + (((q0 + 2) ^ sw) << 3));
            v4u av; av.x = (unsigned)lo8; av.y = (unsigned)(lo8 >> 32); av.z = (unsigned)hi8; av.w = (unsigned)(hi8 >> 32);
            O[dh] = __builtin_amdgcn_mfma_f32_32x32x16_bf16(__builtin_bit_cast(bf16x8, av), pf[sp], O[dh], 0, 0, 0); } }
}
__device__ __forceinline__ void mask_half(f32x16& s0, int kbase, int lo, int hi) {
#pragma unroll
    for (int i = 0; i < 16; ++i) { const int k = kbase + (i & 3) + 8 * (i >> 2); if (k < lo || k > hi) s0[i] = -INFINITY; }
}
__device__ __forceinline__ float max16(const f32x16& s0) {
    float a = s0[0];
#pragma unroll
    for (int i = 1; i < 16; ++i) a = fmaxf(a, s0[i]);
    return half_max(a);
}
__device__ __forceinline__ void merge_branch(LAS unsigned char* lds, int wave, int lane, float m, float lsum, f32x16 (&O)[2], float gate) {
    LAS float* ml = (LAS float*)(lds + SW_ML); LAS float* outl = (LAS float*)(lds + SW_OUT) + lane;
    LAS float* slot = (LAS float*)(lds + SW_T + wave * 8192) + lane;
    const float lw = half_sum(lsum);
    ml[wave * 64 + lane] = m; ml[512 + wave * 64 + lane] = lw;
#pragma unroll
    for (int i = 0; i < 16; ++i) { slot[i * 64] = O[0][i]; slot[(16 + i) * 64] = O[1][i]; O[0][i] = 0.f; O[1][i] = 0.f; }
    __syncthreads();
    float M = -1e30f;
#pragma unroll
    for (int w = 0; w < 8; ++w) M = fmaxf(M, ml[w * 64 + lane]);
    float L = 0.f, sc[8];
#pragma unroll
    for (int w = 0; w < 8; ++w) { sc[w] = __builtin_amdgcn_exp2f(ml[w * 64 + lane] - M); L += ml[512 + w * 64 + lane] * sc[w]; }
    const float gl = (L > 0.f) ? gate / L : 0.f;
#pragma unroll
    for (int k = 0; k < 4; ++k) { const int i = wave * 4 + k; float a = 0.f;
#pragma unroll
        for (int w = 0; w < 8; ++w) a += ((LAS float*)(lds + SW_T + w * 8192))[i * 64 + lane] * sc[w];
        outl[i * 64] += a * gl; }
    __syncthreads();
}

__device__ __forceinline__ void attn_sample_unit(const Frame& F, int l, int b, int t0) {
    int lane_ = F.lane; asm volatile("" : "+v"(lane_));
    const int lane = lane_, wave = F.wave, tid = wave * 64 + lane, h = lane >> 5;
    LAS unsigned char* lds = F.lds;
    LAS unsigned char* kb = lds + SW_T + wave * 8192; LAS unsigned char* vb = kb + 4096;
    LAS float* impG = (LAS float*)(lds + SW_IMPG); LAS float* impE = (LAS float*)(lds + SW_IMPE);
    LAS unsigned* selw = (LAS unsigned*)(lds + SW_SEL); LAS unsigned* uni = (LAS unsigned*)(lds + SW_UNI);
    LAS int* list = (LAS int*)(lds + SW_LIST); LAS int* lpage = (LAS int*)(lds + SW_PAGE); LAS int* nlist = (LAS int*)(lds + SW_NL);
    LAS float* rankv = (LAS float*)(lds + SW_RANK + wave * 1024);
    LAS float* outl = (LAS float*)(lds + SW_OUT);
    const int tl = 0, head = lane & 3; const bool wcol = ((lane & 31) >> 2) == 0;
    const int r = NP + b * TS + t0, tpos = PAST + t0;
    bf16x8 qf[4];
    { const bf16* qb = WSP(F, bf16, WS_QB) + ((size_t)r * 4 + head) * 64;
#pragma unroll
      for (int ks = 0; ks < 4; ++ks) qf[ks] = *(const bf16x8*)(qb + 16 * ks + 8 * h); }
    const float* gp = WSP(F, float, WS_PROJ) + (size_t)r * IN_WP + OFF_G + head * 3;
    const float g0 = sigmoidf_(gp[0]), g1 = sigmoidf_(gp[1]), g2 = sigmoidf_(gp[2]);
    f32x16 O[2];
#pragma unroll
    for (int i = 0; i < 16; ++i) { O[0][i] = 0.f; O[1][i] = 0.f; }
    __syncthreads();
    if (tid < 64) selw[tid] = 0u;
    f32x16 sa, sb; float m = -1e30f, lsum = 0.f;
    {
        HRegs Ra, Rb; h_load(F, l, b, KIND_CMP1, wave, 0, 0, lane, Ra); h_load(F, l, b, KIND_CMP1, wave + 8, 0, 0, lane, Rb);
        h_store_k(kb, Ra, lane); asm volatile("s_waitcnt lgkmcnt(0)" ::: "memory");
        qk_half(kb, qf, sa, lane); mask_half(sa, wave * 32 + 4 * h, 0, NCMP_S - 1);
        asm volatile("s_waitcnt lgkmcnt(0)" ::: "memory");
        h_store_k(kb, Rb, lane); asm volatile("s_waitcnt lgkmcnt(0)" ::: "memory");
        qk_half(kb, qf, sb, lane); mask_half(sb, (wave + 8) * 32 + 4 * h, 0, NCMP_S - 1);
        m = fmaxf(max16(sa), max16(sb));
#pragma unroll
        for (int k = 0; k < 16; ++k) lsum += __builtin_amdgcn_exp2f(sa[k] - m) + __builtin_amdgcn_exp2f(sb[k] - m);
    }
    {
        LAS float* ml = (LAS float*)(lds + SW_ML);
        const float lw = half_sum(lsum);
        ml[wave * 64 + lane] = m; ml[512 + wave * 64 + lane] = lw;
        HRegs Ra, Rb; h_load(F, l, b, KIND_CMP2, wave, 0, 1, lane, Ra); h_load(F, l, b, KIND_CMP2, wave + 8, 0, 1, lane, Rb);
        __syncthreads();
        float M = -1e30f;
#pragma unroll
        for (int w = 0; w < 8; ++w) M = fmaxf(M, ml[w * 64 + lane]);
        float L = 0.f;
#pragma unroll
        for (int w = 0; w < 8; ++w) L += ml[512 + w * 64 + lane] * __builtin_amdgcn_exp2f(ml[w * 64 + lane] - M);
        const float rinv = L > 0.f ? 1.f / L : 0.f;
#pragma unroll
        for (int pass = 0; pass < 2; ++pass) {
            f32x16& sv = pass ? sb : sa; const int ht = pass ? wave + 8 : wave;
#pragma unroll
            for (int k = 0; k < 16; ++k) sv[k] = __builtin_amdgcn_exp2f(sv[k] - M) * rinv;
            if (pass) h_store_v(vb, Rb, lane); else h_store_v(vb, Ra, lane);
            asm volatile("s_waitcnt lgkmcnt(0)" ::: "memory");
            pv_half(vb, sv, O, lane);
            asm volatile("s_waitcnt lgkmcnt(0)" ::: "memory");
#pragma unroll
            for (int gq = 0; gq < 4; ++gq) {
                float G = (sv[4 * gq] + sv[4 * gq + 1]) + (sv[4 * gq + 2] + sv[4 * gq + 3]), E = sv[4 * gq + 3];
                G += __shfl_xor(G, 1); G += __shfl_xor(G, 2); E += __shfl_xor(E, 1); E += __shfl_xor(E, 2);
                const int j = 8 * ht + 2 * gq + h;
                if (head == 0) { impG[tl * 128 + j] = G; impE[tl * 128 + j] = E; }
            }
        }
        { LAS float* slot = (LAS float*)(lds + SW_T + wave * 8192) + lane;
#pragma unroll
          for (int i = 0; i < 16; ++i) { slot[i * 64] = O[0][i]; slot[(16 + i) * 64] = O[1][i]; O[0][i] = 0.f; O[1][i] = 0.f; } }
    }
    __syncthreads();
#pragma unroll
    for (int k = 0; k < 4; ++k) { const int i = wave * 4 + k; float a = 0.f;
#pragma unroll
        for (int w = 0; w < 8; ++w) a += ((LAS float*)(lds + SW_T + w * 8192))[i * 64 + lane];
        outl[i * 64 + lane] = a * g0; }
    __syncthreads();
    if (wave == 0) {
        const int tk = 0, cur = tpos >> 6;
        for (int j = lane; j < 132; j += 64) {
            float v;
            if (j > cur) v = -INFINITY;
            else if (j == 0 || j == cur || j == cur - 1) v = INFINITY;
            else v = impG[tk * 128 + j] + impE[tk * 128 + j - 1];
            rankv[j] = v;
        }
        asm volatile("s_waitcnt lgkmcnt(0)" ::: "memory");
        const float v0 = rankv[lane], v1 = rankv[64 + lane], v2 = (lane < 1) ? rankv[128 + lane] : -INFINITY;
        int r0 = 0, r1 = 0, r2 = 0;
        for (int k4 = 0; k4 < 132; k4 += 4) {
            const f32x4 vk = *(const LAS f32x4*)(rankv + k4);
#pragma unroll
            for (int u = 0; u < 4; ++u) { const float x = vk[u]; const int k = k4 + u;
                r0 += (x > v0 || (x == v0 && k < lane)) ? 1 : 0; r1 += (x > v1 || (x == v1 && k < 64 + lane)) ? 1 : 0; r2 += (x > v2 || (x == v2 && k < 128 + lane)) ? 1 : 0; }
        }
        const unsigned long long b0 = __ballot(r0 < 16 && lane <= cur), b1 = __ballot(r1 < 16 && 64 + lane <= cur), b2 = __ballot(lane < 1 && r2 < 16 && 128 + lane <= cur);
        if (lane == 0) { selw[tk * 8 + 0] = (unsigned)b0; selw[tk * 8 + 1] = (unsigned)(b0 >> 32); selw[tk * 8 + 2] = (unsigned)b1; selw[tk * 8 + 3] = (unsigned)(b1 >> 32); selw[tk * 8 + 4] = (unsigned)b2; }
    }
    __syncthreads();
    if (tid < 8) uni[tid] = selw[tid];
    __syncthreads();
    if (wave == 0) {
        int n = 0;
        for (int j0 = 0; j0 < 129; j0 += 64) {
            const int j = j0 + lane; const bool sj = (j < 129) && ((uni[j >> 5] >> (j & 31)) & 1u);
            int pg = 0; if (sj && j * 64 < PAST) pg = ((const int*)INP(F, I_PT))[b * NPAGES + (j >> 1)];
            const unsigned long long bal = __ballot(sj);
            if (sj) { const int idx = n + 2 * __popcll(bal & ((1ull << lane) - 1ull)); list[idx] = KIND_SLC | ((2 * j) << 4); list[idx + 1] = KIND_SLC | ((2 * j + 1) << 4); lpage[idx] = pg; lpage[idx + 1] = pg; }
            n += 2 * __popcll(bal);
        }
        if (lane == 0) nlist[0] = n;
        const int w0 = (PAST - 512) / 32, w1 = (PAST + TS - 1) / 32;
        if (lane <= w1 - w0) { list[n + lane] = KIND_WIN | ((w0 + lane) << 4); lpage[n + lane] = 0; }
        if (lane == 0) nlist[1] = n + (w1 - w0 + 1);
    }
    __syncthreads();
    const int n_slc = nlist[0], n_all = nlist[1];
#pragma unroll 1
    for (int br = 0; br < 2; ++br) {
        const int i0 = br ? n_slc : 0, i1 = br ? n_all : n_slc;
        m = -1e30f; lsum = 0.f;
        HRegs Rk, Rv;
        int it = i0 + wave;
        if (it < i1) { const int e = list[it], pg = lpage[it]; h_load(F, l, b, e & 15, e >> 4, pg, 0, lane, Rk); h_load(F, l, b, e & 15, e >> 4, pg, 1, lane, Rv); }
#pragma unroll 1
        for (; it < i1; it += 8) {
            const int e = __builtin_amdgcn_readfirstlane(list[it]); const int kind = e & 15, ht = e >> 4;
            h_store_k(kb, Rk, lane); h_store_v(vb, Rv, lane);
            if (it + 8 < i1) { const int e2 = list[it + 8], pg2 = lpage[it + 8]; h_load(F, l, b, e2 & 15, e2 >> 4, pg2, 0, lane, Rk); h_load(F, l, b, e2 & 15, e2 >> 4, pg2, 1, lane, Rv); }
            asm volatile("s_waitcnt lgkmcnt(0)" ::: "memory");
            int lo, hi;
            if (kind == KIND_SLC) { const int j = ht >> 1; const bool sbit = (selw[tl * 8 + (j >> 5)] >> (j & 31)) & 1u; lo = 0; hi = sbit ? tpos : -1; }
            else { lo = tpos - 511; hi = tpos; }
            f32x16 s0; qk_half(kb, qf, s0, lane);
            mask_half(s0, ht * 32 + 4 * h, lo, hi);
            const float mt = max16(s0); const float mn = fmaxf(m, mt); const float al = __builtin_amdgcn_exp2f(m - mn);
            float rs = 0.f;
#pragma unroll
            for (int k = 0; k < 16; ++k) { s0[k] = __builtin_amdgcn_exp2f(s0[k] - mn); rs += s0[k]; }
            lsum = lsum * al + rs; m = mn;
#pragma unroll
            for (int k = 0; k < 16; ++k) { O[0][k] *= al; O[1][k] *= al; }
            pv_half(vb, s0, O, lane);
            asm volatile("s_waitcnt lgkmcnt(0)" ::: "memory");
        }
        merge_branch(lds, wave, lane, m, lsum, O, br ? g2 : g1);
    }
    if (wave == 0 && wcol) {
        bf16* mo = WSP(F, bf16, WS_MIX) + (size_t)r * DM + 768 + head * 64;
#pragma unroll
        for (int dh = 0; dh < 2; ++dh)
#pragma unroll
            for (int gq = 0; gq < 4; ++gq) { const int d = dh * 32 + 8 * gq + 4 * h; const LAS float* o = outl + (dh * 16 + 4 * gq) * 64 + lane;
                *(unsigned long long*)(mo + d) = (unsigned long long)cvtpk(o[0], o[64]) | ((unsigned long long)cvtpk(o[128], o[192]) << 32); }
    }
    __syncthreads();
}


__device__ __forceinline__ void phase_attn2(const Frame& F, int l) {
    for (int u = blockIdx.x; u < 256; u += F.G) attn_unit(F, l, u & 7, (u >> 3) * 64, 64);
    Frame G2 = F; { int ln = G2.lane; asm volatile("" : "+v"(ln)); G2.lane = ln; G2.tid = G2.wave * 64 + ln; }
    if (F.G == 256) { if (blockIdx.x < 128) { ssd_out_unit(G2, l, (int)blockIdx.x >> 5, (int)blockIdx.x & 31); ssd_out_unit(G2, l, ((int)blockIdx.x + 128) >> 5, ((int)blockIdx.x + 128) & 31); } }
    else for (int u = blockIdx.x; u < BP * 32; u += F.G) ssd_out_unit(G2, l, u >> 5, u & 31);
    for (int r = NP + G2.gw; r < MROWS; r += G2.ngw) ssd_finish_token(G2, l, r);
}


constexpr float LOG2E = 1.4426950408889634f;
constexpr int SD_B = 0, SD_BT = 32768, SD_C = 65536, SD_AC = 98304, SD_DT = SD_AC + 2048, SD_W = SD_DT + 2048, SD_END = SD_W + 2048;
static_assert(SD_END <= RING_BYTES, "ssd LDS map");
__device__ __forceinline__ int crow16(int i, int hp) { return (i & 3) + 8 * (i >> 2) + 4 * hp; }
__device__ __forceinline__ unsigned long long pack4bf(float a, float b, float c, float d) { return (unsigned long long)cvtpk(a, b) | ((unsigned long long)cvtpk(c, d) << 32); }

__device__ __forceinline__ void ssd_chunk_unit(const Frame& F, int l, int b, int c, int g) {
    const int tid = F.tid, lane = F.lane, wave = F.wave;
    LAS unsigned char* lds = F.lds;
    const float* proj = WSP(F, float, WS_PROJ);
    const size_t rbase = (size_t)b * TP + (size_t)c * 128;
    const float* cw = INP(F, I_CONVW) + (size_t)l * 4 * CONV_DIM; const float* cbv = INP(F, I_CONVB) + (size_t)l * CONV_DIM;
    LAS float* acs = (LAS float*)(lds + SD_AC); LAS float* dts = (LAS float*)(lds + SD_DT); LAS float* wts = (LAS float*)(lds + SD_W);
    __syncthreads();
    if (wave < 4) {
        const int hh = wave, head = 4 * g + hh;
        const float a2 = -expf(INP(F, I_ALOG)[l * SSD_H + head]) * LOG2E, dtb = INP(F, I_DTB)[l * SSD_H + head];
        const float d0 = softplusf_(proj[(rbase + 2 * lane) * IN_WP + OFF_DT + head] + dtb), d1 = softplusf_(proj[(rbase + 2 * lane + 1) * IN_WP + OFF_DT + head] + dtb);
        float sc = (d0 + d1) * a2;
#pragma unroll
        for (int o = 1; o < 64; o <<= 1) { const float t = __shfl_up(sc, o); if (lane >= o) sc += t; }
        const float ac1 = sc, ac0 = sc - d1 * a2; const float tot = __uint_as_float(__builtin_amdgcn_readlane(__float_as_uint(sc), 63));
        acs[hh * 128 + 2 * lane] = ac0; acs[hh * 128 + 2 * lane + 1] = ac1; dts[hh * 128 + 2 * lane] = d0; dts[hh * 128 + 2 * lane + 1] = d1;
        wts[hh * 128 + 2 * lane] = __builtin_amdgcn_exp2f(tot - ac0); wts[hh * 128 + 2 * lane + 1] = __builtin_amdgcn_exp2f(tot - ac1);
        float* acg = WSP(F, float, WS_SAC); acg[(rbase + 2 * lane) * SSD_H + head] = ac0; acg[(rbase + 2 * lane + 1) * SSD_H + head] = ac1;
        if (lane == 63) WSP(F, float, WS_SCD)[((size_t)b * 16 + c) * SSD_H + head] = __builtin_amdgcn_exp2f(tot);
    }
    {
        const int ch = tid & 255, th = tid >> 8;
        const int chan = (ch < 128) ? 512 + g * 128 + ch : 768 + g * 128 + (ch - 128);
        const float w0 = cw[chan], w1 = cw[CONV_DIM + chan], w2 = cw[2 * CONV_DIM + chan], w3 = cw[3 * CONV_DIM + chan], bb = cbv[chan];
        const int tl0 = th * 64;
        const float* src = proj + (rbase + tl0) * IN_WP + OFF_XBC + chan;
        const bool hasp = (c > 0) || (th > 0);
        float x0 = hasp ? src[-3 * IN_WP] : 0.f, x1 = hasp ? src[-2 * IN_WP] : 0.f, x2 = hasp ? src[-IN_WP] : 0.f;
        const int n = ch & 127;
        bf16* cbg = WSP(F, bf16, WS_SCB) + (rbase + tl0) * 256 + g * 128 + n;
        for (int i1 = 0; i1 < 64; i1 += 16) {
          float rawv[16];
#pragma unroll
          for (int k = 0; k < 16; ++k) rawv[k] = src[(size_t)(i1 + k) * IN_WP];
#pragma unroll
          for (int i2 = 0; i2 < 16; i2 += 4) { const int i0 = i1 + i2;
            float v[4];
#pragma unroll
            for (int k = 0; k < 4; ++k) { const float cur = rawv[i2 + k]; v[k] = siluf_(bb + w0 * x0 + w1 * x1 + w2 * x2 + w3 * cur); x0 = x1; x1 = x2; x2 = cur; }
            const int s = tl0 + i0;
            if (ch < 128) {
#pragma unroll
                for (int k = 0; k < 4; ++k) *(LAS unsigned short*)(lds + SD_B + (s + k) * 256 + (((n >> 3) ^ ((s + k) & 15)) << 4) + (n & 7) * 2) = (unsigned short)f2bf(v[k]);
                *(LAS unsigned long long*)(lds + SD_BT + n * 256 + (((s >> 2) ^ (n & 31)) << 3)) = pack4bf(v[0], v[1], v[2], v[3]);
            } else {
#pragma unroll
                for (int k = 0; k < 4; ++k) { const unsigned short hv = (unsigned short)f2bf(v[k]);
                    *(LAS unsigned short*)(lds + SD_C + (s + k) * 256 + (((n >> 3) ^ ((s + k) & 15)) << 4) + (n & 7) * 2) = hv; cbg[(size_t)(i0 + k) * 256] = hv; }
            }
          }
        }
    }
    __syncthreads();
    const int lb = wave & 3, hw = wave >> 2;
    int lane_g = lane; asm volatile("" : "+v"(lane_g));
    f32x16 Gt[4];
    {
        const int r32 = lane_g & 31, hp = lane_g >> 5, lloc = lb * 32 + r32;
        bf16x8 cf[8];
#pragma unroll
        for (int ks = 0; ks < 8; ++ks) cf[ks] = *(const LAS bf16x8*)(lds + SD_C + lloc * 256 + (((2 * ks + hp) ^ (lloc & 15)) << 4));
#pragma unroll
        for (int sb = 0; sb < 4; ++sb) {
#pragma unroll
            for (int i = 0; i < 16; ++i) Gt[sb][i] = 0.f;
            if (sb <= lb) {
                int s = sb * 32 + r32; asm volatile("" : "+v"(s));
#pragma unroll
                for (int ks = 0; ks < 8; ++ks) { const bf16x8 a = *(const LAS bf16x8*)(lds + SD_B + s * 256 + (((2 * ks + hp) ^ (s & 15)) << 4));
                    Gt[sb] = __builtin_amdgcn_mfma_f32_32x32x16_bf16(a, cf[ks], Gt[sb], 0, 0, 0); }
            }
            __builtin_amdgcn_sched_barrier(0);
        }
    }
    __syncthreads();
    for (int rd = 0; rd < 2; ++rd) {
        {
            int tid_r = tid; asm volatile("" : "+v"(tid_r));
            const int ch = tid_r & 127, tq = tid_r >> 7; const int hh2 = ch >> 6, p = ch & 63, hh = 2 * rd + hh2;
            const int chan = (4 * g + hh) * 64 + p;
            const float w0 = cw[chan], w1 = cw[CONV_DIM + chan], w2 = cw[2 * CONV_DIM + chan], w3 = cw[3 * CONV_DIM + chan], bb = cbv[chan];
            const int tl0 = tq * 32;
            const float* src = proj + (rbase + tl0) * IN_WP + OFF_XBC + chan;
            const bool hasp = (c > 0) || (tq > 0);
            float x0 = hasp ? src[-3 * IN_WP] : 0.f, x1 = hasp ? src[-2 * IN_WP] : 0.f, x2 = hasp ? src[-IN_WP] : 0.f;
            for (int i1 = 0; i1 < 32; i1 += 16) {
              float rawv[16];
#pragma unroll
              for (int k = 0; k < 16; ++k) rawv[k] = src[(size_t)(i1 + k) * IN_WP];
#pragma unroll
              for (int i2 = 0; i2 < 16; i2 += 4) { const int i0 = i1 + i2;
                float v[4]; const int s = tl0 + i0;
#pragma unroll
                for (int k = 0; k < 4; ++k) { const float cur = rawv[i2 + k]; v[k] = siluf_(bb + w0 * x0 + w1 * x1 + w2 * x2 + w3 * cur) * dts[hh * 128 + s + k]; x0 = x1; x1 = x2; x2 = cur; }
                *(LAS unsigned long long*)(lds + SD_C + hh2 * 16384 + p * 256 + (((s >> 2) ^ (p & 31)) << 3)) = pack4bf(v[0], v[1], v[2], v[3]);
              }
            }
        }
        __syncthreads();
        int lane_r = lane; asm volatile("" : "+v"(lane_r));
        const int r32 = lane_r & 31, hp = lane_r >> 5, lloc = lb * 32 + r32;
        const int hh = 2 * rd + hw, head = 4 * g + hh;
        const LAS float* ac = acs + hh * 128; const LAS float* wp = wts + hh * 128;
        const LAS unsigned char* xt = lds + SD_C + hw * 16384;
        const float acl = ac[lloc], ddt = INP(F, I_SSDD)[l * SSD_H + head] / dts[hh * 128 + lloc];
        f32x16 Y[2];
#pragma unroll
        for (int i = 0; i < 16; ++i) { Y[0][i] = 0.f; Y[1][i] = 0.f; }
#pragma unroll
        for (int sb = 0; sb < 4; ++sb) {
            if (sb <= lb) {
                f32x16 mt;
#pragma unroll
                for (int i = 0; i < 16; ++i) { const int s = sb * 32 + crow16(i, hp);
                    float mv = Gt[sb][i] * __builtin_amdgcn_exp2f(acl - ac[s]);
                    if (sb == lb) { mv = (s > lloc) ? 0.f : mv; mv += (s == lloc) ? ddt : 0.f; }
                    mt[i] = mv; }
                bf16x8 pf[2];
#pragma unroll
                for (int sp = 0; sp < 2; ++sp) { v4u a; a.x = cvtpk(mt[8 * sp + 0], mt[8 * sp + 1]); a.y = cvtpk(mt[8 * sp + 2], mt[8 * sp + 3]); a.z = cvtpk(mt[8 * sp + 4], mt[8 * sp + 5]); a.w = cvtpk(mt[8 * sp + 6], mt[8 * sp + 7]);
                    pf[sp] = __builtin_bit_cast(bf16x8, a); }
#pragma unroll
                for (int pt = 0; pt < 2; ++pt) { int p = pt * 32 + r32; asm volatile("" : "+v"(p)); const int sw = p & 31; const LAS unsigned char* rb = xt + p * 256;
#pragma unroll
                    for (int sp = 0; sp < 2; ++sp) { const int q0 = sb * 8 + 4 * sp + hp;
                        const unsigned long long lo8 = *(const LAS unsigned long long*)(rb + ((q0 ^ sw) << 3)), hi8 = *(const LAS unsigned long long*)(rb + (((q0 + 2) ^ sw) << 3));
                        v4u av; av.x = (unsigned)lo8; av.y = (unsigned)(lo8 >> 32); av.z = (unsigned)hi8; av.w = (unsigned)(hi8 >> 32);
                        Y[pt] = __builtin_amdgcn_mfma_f32_32x32x16_bf16(__builtin_bit_cast(bf16x8, av), pf[sp], Y[pt], 0, 0, 0); } }
            }
            __builtin_amdgcn_sched_barrier(0);
        }
        {
            float* yo = WSP(F, float, WS_YSSD) + (rbase + lloc) * SSD_W + head * 64;
#pragma unroll
            for (int pt = 0; pt < 2; ++pt)
#pragma unroll
                for (int qd = 0; qd < 4; ++qd) *(f32x4*)(yo + pt * 32 + 8 * qd + 4 * hp) = (f32x4){Y[pt][4 * qd], Y[pt][4 * qd + 1], Y[pt][4 * qd + 2], Y[pt][4 * qd + 3]};
        }
        {
            f32x16 St[2];
#pragma unroll
            for (int i = 0; i < 16; ++i) { St[0][i] = 0.f; St[1][i] = 0.f; }
            const int n = lb * 32 + r32;
#pragma unroll
            for (int ks = 0; ks < 8; ++ks) {
                const int cb0 = 4 * ks + 2 * hp; int nn = n; asm volatile("" : "+v"(nn));
                const unsigned long long blo = *(const LAS unsigned long long*)(lds + SD_BT + nn * 256 + ((cb0 ^ (nn & 31)) << 3)), bhi = *(const LAS unsigned long long*)(lds + SD_BT + nn * 256 + (((cb0 + 1) ^ (nn & 31)) << 3));
                v4u bv; bv.x = (unsigned)blo; bv.y = (unsigned)(blo >> 32); bv.z = (unsigned)bhi; bv.w = (unsigned)(bhi >> 32);
                const f32x4 wa = *(const LAS f32x4*)(wp + 16 * ks + 8 * hp), wb = *(const LAS f32x4*)(wp + 16 * ks + 8 * hp + 4);
#pragma unroll
                for (int pt = 0; pt < 2; ++pt) { const int p = pt * 32 + (nn & 31); const LAS unsigned char* rb = xt + p * 256;
                    const unsigned long long alo = *(const LAS unsigned long long*)(rb + ((cb0 ^ (p & 31)) << 3)), ahi = *(const LAS unsigned long long*)(rb + (((cb0 + 1) ^ (p & 31)) << 3));
                    const unsigned a0 = (unsigned)alo, a1 = (unsigned)(alo >> 32), a2 = (unsigned)ahi, a3 = (unsigned)(ahi >> 32);
                    v4u av;
                    av.x = cvtpk(__uint_as_float(a0 << 16) * wa.x, __uint_as_float(a0 & 0xffff0000u) * wa.y); av.y = cvtpk(__uint_as_float(a1 << 16) * wa.z, __uint_as_float(a1 & 0xffff0000u) * wa.w);
                    av.z = cvtpk(__uint_as_float(a2 << 16) * wb.x, __uint_as_float(a2 & 0xffff0000u) * wb.y); av.w = cvtpk(__uint_as_float(a3 << 16) * wb.z, __uint_as_float(a3 & 0xffff0000u) * wb.w);
                    St[pt] = __builtin_amdgcn_mfma_f32_32x32x16_bf16(__builtin_bit_cast(bf16x8, av), __builtin_bit_cast(bf16x8, bv), St[pt], 0, 0, 0); }
                __builtin_amdgcn_sched_barrier(0);
            }
            float* cs = WSP(F, float, WS_SCS) + (((size_t)b * 16 + c) * SSD_H + head) * (SSD_HD * SSD_N) + n;
#pragma unroll
            for (int pt = 0; pt < 2; ++pt)
#pragma unroll
                for (int i = 0; i < 16; ++i) cs[(size_t)(pt * 32 + crow16(i, hp)) * SSD_N] = St[pt][i];
        }
        __syncthreads();
    }
}

__device__ __forceinline__ void ssd_scan(const Frame& F, int l) {
    const float* cs = WSP(F, float, WS_SCS); const float* cd = WSP(F, float, WS_SCD); bf16* hs = WSP(F, bf16, WS_SHS);
    for (int idx = blockIdx.x * NTHR + F.tid; idx < BP * SSD_H * 2048; idx += F.G * NTHR) {
        const int e4 = idx & 2047, bh = idx >> 11, b = bh >> 3, h = bh & 7;
        f32x4 st = (f32x4){0.f, 0.f, 0.f, 0.f};
#pragma unroll 8
        for (int c = 0; c < 16; ++c) {
            const size_t o = (((size_t)b * 16 + c) * SSD_H + h) * (SSD_HD * SSD_N) + e4 * 4;
            *(unsigned long long*)(hs + o) = pack4bf(st.x, st.y, st.z, st.w);
            const f32x4 sv = *(const f32x4*)(cs + o); const float d = cd[((size_t)b * 16 + c) * SSD_H + h];
            st = st * d + sv;
        }
        *(f32x4*)(F.out + O_SSMP + (((size_t)l * BP + b) * SSD_H + h) * (SSD_HD * SSD_N) + e4 * 4) = st;
    }
}

__device__ __forceinline__ void ssd_out_unit(const Frame& F, int l, int b, int hc) {
    const int lane = F.lane, h = F.wave, g = h >> 2, c = hc >> 1, l0 = hc * 64, r32 = lane & 31, hp = lane >> 5;
    LAS float* ssq = (LAS float*)F.lds;
    const bf16* Hs = WSP(F, bf16, WS_SHS) + (((size_t)b * 16 + c) * SSD_H + h) * (SSD_HD * SSD_N);
    const bf16* Cb = WSP(F, bf16, WS_SCB) + ((size_t)b * TP + l0) * 256 + g * 128;
    f32x16 Yo[2][2];
#pragma unroll
    for (int i = 0; i < 16; ++i) { Yo[0][0][i] = 0.f; Yo[0][1][i] = 0.f; Yo[1][0][i] = 0.f; Yo[1][1][i] = 0.f; }
#pragma unroll
    for (int ks = 0; ks < 8; ++ks) {
        bf16x8 af[2], bfr[2];
#pragma unroll
        for (int pt = 0; pt < 2; ++pt) af[pt] = *(const bf16x8*)(Hs + (size_t)(pt * 32 + r32) * SSD_N + 16 * ks + 8 * hp);
#pragma unroll
        for (int lt = 0; lt < 2; ++lt) bfr[lt] = *(const bf16x8*)(Cb + (size_t)(lt * 32 + r32) * 256 + 16 * ks + 8 * hp);
#pragma unroll
        for (int lt = 0; lt < 2; ++lt)
#pragma unroll
            for (int pt = 0; pt < 2; ++pt) Yo[lt][pt] = __builtin_amdgcn_mfma_f32_32x32x16_bf16(af[pt], bfr[lt], Yo[lt][pt], 0, 0, 0);
    }
    __syncthreads();
#pragma unroll
    for (int lt = 0; lt < 2; ++lt) {
        const size_t row = (size_t)b * TP + l0 + lt * 32 + r32;
        const float sc = __builtin_amdgcn_exp2f(WSP(F, float, WS_SAC)[row * SSD_H + h]);
        const float* yd = WSP(F, float, WS_YSSD) + row * SSD_W + h * 64; const float* zz = WSP(F, float, WS_PROJ) + row * IN_WP + h * 64;
        float ss = 0.f;
#pragma unroll
        for (int pt = 0; pt < 2; ++pt) {
            f32x4 y4v[4], z4v[4];
#pragma unroll
            for (int i = 0; i < 4; ++i) { const int p = pt * 32 + 8 * i + 4 * hp; y4v[i] = *(const f32x4*)(yd + p); z4v[i] = *(const f32x4*)(zz + p); }
#pragma unroll
            for (int qd = 0; qd < 4; ++qd) { const f32x4 y4 = y4v[qd], z4 = z4v[qd];
#pragma unroll
                for (int k = 0; k < 4; ++k) { const float v = (y4[k] + sc * Yo[lt][pt][4 * qd + k]) * siluf_(z4[k]); Yo[lt][pt][4 * qd + k] = v; ss += v * v; } }
        }
        ss = half_sum(ss);
        if (hp == 0) ssq[(lt * 32 + r32) * 8 + h] = ss;
    }
    __syncthreads();
    const float* nw = INP(F, I_SSDNORM) + (size_t)l * SSD_W + h * 64;
#pragma unroll
    for (int lt = 0; lt < 2; ++lt) {
        const size_t row = (size_t)b * TP + l0 + lt * 32 + r32;
        const LAS float* sq = ssq + (lt * 32 + r32) * 8;
        const float tot = ((sq[0] + sq[1]) + (sq[2] + sq[3])) + ((sq[4] + sq[5]) + (sq[6] + sq[7]));
        const float rs = 1.f / sqrtf(tot * (1.f / SSD_W) + RMS_EPS);
        bf16* mo = WSP(F, bf16, WS_MIX) + row * DM + h * 64;
#pragma unroll
        for (int pt = 0; pt < 2; ++pt)
#pragma unroll
            for (int qd = 0; qd < 4; ++qd) { const int p = pt * 32 + 8 * qd + 4 * hp; const f32x4 w4 = *(const f32x4*)(nw + p);
                *(unsigned long long*)(mo + p) = pack4bf(Yo[lt][pt][4 * qd] * rs * w4.x, Yo[lt][pt][4 * qd + 1] * rs * w4.y, Yo[lt][pt][4 * qd + 2] * rs * w4.z, Yo[lt][pt][4 * qd + 3] * rs * w4.w); }
    }
    __syncthreads();
}

__device__ __forceinline__ void resid_row(const Frame& F, const float* xold, const float* f, const bf16* fb, int nsl, size_t slstride, const float* w_post, float* xnew, const float* w_next, bf16* xn) {
    const f32x4* xo = (const f32x4*)xold + F.lane; const f32x4* fr = (const f32x4*)f + F.lane; const f32x4* wp = (const f32x4*)w_post + F.lane;
    f32x4 fv[4]; float ss = 0.f;
#pragma unroll
    for (int j = 0; j < 4; ++j) {
        if (fb) fv[j] = bf4_to_f32(((const unsigned long long*)fb + F.lane)[64 * j]); else fv[j] = fr[64 * j];
        for (int s = 1; s < nsl; ++s) fv[j] += ((const f32x4*)(f + s * slstride) + F.lane)[64 * j];
        ss += (fv[j].x * fv[j].x + fv[j].y * fv[j].y) + (fv[j].z * fv[j].z + fv[j].w * fv[j].w); }
    const float rs = 1.f / sqrtf(wave_sum(ss) * (1.f / DM) + RMS_EPS);
    f32x4 xv[4]; float s2 = 0.f;
#pragma unroll
    for (int j = 0; j < 4; ++j) { xv[j] = xo[64 * j] + fv[j] * rs * wp[64 * j]; s2 += (xv[j].x * xv[j].x + xv[j].y * xv[j].y) + (xv[j].z * xv[j].z + xv[j].w * xv[j].w);
        ((f32x4*)xnew + F.lane)[64 * j] = xv[j]; }
    if (w_next) {
        const float r2 = 1.f / sqrtf(wave_sum(s2) * (1.f / DM) + RMS_EPS);
        const f32x4* wn = (const f32x4*)w_next + F.lane; unsigned long long* o8 = (unsigned long long*)xn + F.lane;
#pragma unroll
        for (int j = 0; j < 4; ++j) { const f32x4 g = wn[64 * j];
            o8[64 * j] = (unsigned long long)pk2(xv[j].x * r2 * g.x, xv[j].y * r2 * g.y) | ((unsigned long long)pk2(xv[j].z * r2 * g.z, xv[j].w * r2 * g.w) << 32); }
    }
}
template <int NR>
__device__ __forceinline__ void resid_rowsN(const Frame& F, const float* xold, const bf16* f, const float* w_post, float* xnew, const float* w_next, bf16* xn) {
    const int lane = F.lane;
    unsigned long long fr[NR][4]; f32x4 xv[NR][4];
#pragma unroll
    for (int r = 0; r < NR; ++r)
#pragma unroll
        for (int j = 0; j < 4; ++j) { fr[r][j] = ((const unsigned long long*)(f + (size_t)r * DM) + lane)[64 * j]; xv[r][j] = ((const f32x4*)(xold + (size_t)r * DM) + lane)[64 * j]; }
    float rs[NR];
#pragma unroll
    for (int r = 0; r < NR; ++r) { float s = 0.f;
#pragma unroll
        for (int j = 0; j < 4; ++j) { const f32x4 v = bf4_to_f32(fr[r][j]); s += (v.x * v.x + v.y * v.y) + (v.z * v.z + v.w * v.w); }
        rs[r] = s; }
#pragma unroll
    for (int r = 0; r < NR; ++r) rs[r] = 1.f / sqrtf(wave_sum(rs[r]) * (1.f / DM) + RMS_EPS);
    float s2[NR];
#pragma unroll
    for (int r = 0; r < NR; ++r) s2[r] = 0.f;
#pragma unroll
    for (int j = 0; j < 4; ++j) { const f32x4 wp = ((const f32x4*)w_post + lane)[64 * j];
#pragma unroll
        for (int r = 0; r < NR; ++r) { xv[r][j] = xv[r][j] + bf4_to_f32(fr[r][j]) * rs[r] * wp;
            s2[r] += (xv[r][j].x * xv[r][j].x + xv[r][j].y * xv[r][j].y) + (xv[r][j].z * xv[r][j].z + xv[r][j].w * xv[r][j].w);
            ((f32x4*)(xnew + (size_t)r * DM) + lane)[64 * j] = xv[r][j]; } }
    if (w_next) {
#pragma unroll
        for (int r = 0; r < NR; ++r) s2[r] = 1.f / sqrtf(wave_sum(s2[r]) * (1.f / DM) + RMS_EPS);
#pragma unroll
        for (int j = 0; j < 4; ++j) { const f32x4 g = ((const f32x4*)w_next + lane)[64 * j];
#pragma unroll
            for (int r = 0; r < NR; ++r) { const float q = s2[r];
                ((unsigned long long*)(xn + (size_t)r * DM) + lane)[64 * j] = (unsigned long long)pk2(xv[r][j].x * q * g.x, xv[r][j].y * q * g.y) | ((unsigned long long)pk2(xv[r][j].z * q * g.z, xv[r][j].w * q * g.w) << 32); } }
    }
}
constexpr int RES_NR = 4;
__device__ __forceinline__ void phase_resid_mix(const Frame& F, int l) {
    for (int rp = F.gw; rp < NP / RES_NR; rp += F.ngw) { const int r = RES_NR * rp;
        const float* x0 = (l == 0) ? x_in_row(F, r) : WSP(F, float, WS_X) + (size_t)r * DM;
        resid_rowsN<RES_NR>(F, x0, WSP(F, bf16, WS_MIXO) + (size_t)r * DM, INP(F, I_NMPOST) + (size_t)l * DM, WSP(F, float, WS_X) + (size_t)r * DM,
                            INP(F, I_NFPRE) + (size_t)l * DM, WSP(F, bf16, WS_XN) + (size_t)r * DM);
    }
    for (int r = NP + F.gw; r < MROWS; r += F.ngw) {
        const float* xold = (l == 0) ? x_in_row(F, r) : WSP(F, float, WS_X) + (size_t)r * DM;
        resid_row(F, xold, WSP(F, float, WS_SLAB) + (size_t)(r - NP) * DM, nullptr, SPLIT_OUT, (size_t)256 * DM, INP(F, I_NMPOST) + (size_t)l * DM, WSP(F, float, WS_X) + (size_t)r * DM,
                  INP(F, I_NFPRE) + (size_t)l * DM, WSP(F, bf16, WS_XN) + (size_t)r * DM);
    }
}
__device__ __forceinline__ void phase_resid_ffn(const Frame& F, int l) {
    const float* wn = (l == DEPTH - 1) ? nullptr : INP(F, I_NMPRE) + (size_t)(l + 1) * DM;
    for (int rp = F.gw; rp < NP / RES_NR; rp += F.ngw) { const int r = RES_NR * rp;
        float* xn = (l == DEPTH - 1) ? F.out + O_YP + (size_t)r * DM : WSP(F, float, WS_X) + (size_t)r * DM;
        resid_rowsN<RES_NR>(F, WSP(F, float, WS_X) + (size_t)r * DM, WSP(F, bf16, WS_MIXO) + (size_t)r * DM, INP(F, I_NFPOST) + (size_t)l * DM, xn, wn, WSP(F, bf16, WS_XN) + (size_t)r * DM);
    }
    for (int r = NP + F.gw; r < MROWS; r += F.ngw) {
        float* xnew = (l == DEPTH - 1) ? F.out + O_YS + (size_t)(r - NP) * DM : WSP(F, float, WS_X) + (size_t)r * DM;
        resid_row(F, WSP(F, float, WS_X) + (size_t)r * DM, WSP(F, float, WS_SLAB) + (size_t)(r - NP) * DM, nullptr, SPLIT_DOWN, (size_t)256 * DM, INP(F, I_NFPOST) + (size_t)l * DM, xnew,
                  wn, WSP(F, bf16, WS_XN) + (size_t)r * DM);
    }
}

__device__ __forceinline__ void phase_ffn_act(const Frame& F, int l) {
    bf16* act = WSP(F, bf16, WS_ACT);
    const float* cw = INP(F, I_FCW) + (size_t)l * 3 * DFF; const float* cb = INP(F, I_FCB) + (size_t)l * DFF;
    const float* halo = WSP(F, float, WS_FHALO); const float* last = WSP(F, float, WS_FLAST); const float* raw = WSP(F, float, WS_FRAW);
    for (int it = F.gw; it < 64 * 2 * 16; it += F.ngw) {
        const int pm = it >> 5, j = (it >> 4) & 1, c = (it & 15) * 256 + F.lane * 4;
        const bool first = (pm & 7) == 0;
        const f32x4 z = (f32x4){0.f, 0.f, 0.f, 0.f};
        const f32x4 ga = *(const f32x4*)(halo + ((size_t)pm * 2 + j) * 8192 + c), vv = *(const f32x4*)(halo + ((size_t)pm * 2 + j) * 8192 + 4096 + c);
        f32x4 gb, gc;
        if (j == 0) { gb = first ? z : *(const f32x4*)(last + ((size_t)(pm - 1) * 2 + 1) * 4096 + c); gc = first ? z : *(const f32x4*)(last + ((size_t)(pm - 1) * 2 + 0) * 4096 + c); }
        else { gb = *(const f32x4*)(halo + ((size_t)pm * 2 + 0) * 8192 + c); gc = first ? z : *(const f32x4*)(last + ((size_t)(pm - 1) * 2 + 1) * 4096 + c); }
        const f32x4 w0 = *(const f32x4*)(cw + c), w1 = *(const f32x4*)(cw + DFF + c), w2 = *(const f32x4*)(cw + 2 * DFF + c), bb = *(const f32x4*)(cb + c);
        const f32x4 pre = gc * w0 + gb * w1 + ga * w2 + bb;
        const float a0 = gelu_tanh(pre.x) * vv.x, a1 = gelu_tanh(pre.y) * vv.y, a2 = gelu_tanh(pre.z) * vv.z, a3 = gelu_tanh(pre.w) * vv.w;
        *(unsigned long long*)(act + (size_t)(pm * 256 + j) * DFF + c) = (unsigned long long)pk2(a0, a1) | ((unsigned long long)pk2(a2, a3) << 32);
    }
    for (int it = F.gw; it < BP * 2 * 16; it += F.ngw) {
        const int b = it >> 5, j = (it >> 4) & 1, c = (it & 15) * 256 + F.lane * 4;
        *(f32x4*)(F.out + O_FFNP + (((size_t)l * BP + b) * 2 + j) * DFF + c) = *(const f32x4*)(last + ((size_t)(8 * b + 7) * 2 + j) * 4096 + c);
    }
    for (int it = F.gw; it < NS * 16; it += F.ngw) {
        const int r = NP + (it >> 4), j = it & 15;
        const int qq = r - NP, b = qq >> 3, t = qq & 7;
        const float* sffn = INP(F, I_SFFN) + ((size_t)l * BS + b) * 2 * DFF;
        const float* g0 = raw + (size_t)qq * 2 * DFF;
        { const int c = j * 256 + F.lane * 4;
            constexpr size_t SL = (size_t)256 * 2 * DFF;
            f32x4 ga = *(const f32x4*)(g0 + c), gb, gc, vv = *(const f32x4*)(g0 + DFF + c);
            if (t >= 1) gb = *(const f32x4*)(g0 - (size_t)2 * DFF + c); else gb = *(const f32x4*)(sffn + DFF + c);
            if (t >= 2) gc = *(const f32x4*)(g0 - (size_t)4 * DFF + c); else gc = *(const f32x4*)(sffn + (size_t)t * DFF + c);
#pragma unroll
            for (int sl = 1; sl < SPLIT_UP; ++sl) { ga += *(const f32x4*)(g0 + sl * SL + c); vv += *(const f32x4*)(g0 + sl * SL + DFF + c);
                if (t >= 1) gb += *(const f32x4*)(g0 + sl * SL - (size_t)2 * DFF + c);
                if (t >= 2) gc += *(const f32x4*)(g0 + sl * SL - (size_t)4 * DFF + c); }
            const f32x4 w0 = *(const f32x4*)(cw + c), w1 = *(const f32x4*)(cw + DFF + c), w2 = *(const f32x4*)(cw + 2 * DFF + c), bb = *(const f32x4*)(cb + c);
            const f32x4 pre = gc * w0 + gb * w1 + ga * w2 + bb;
            const float a0 = gelu_tanh(pre.x) * vv.x, a1 = gelu_tanh(pre.y) * vv.y, a2 = gelu_tanh(pre.z) * vv.z, a3 = gelu_tanh(pre.w) * vv.w;
            *(unsigned long long*)(act + (size_t)r * DFF + c) = (unsigned long long)pk2(a0, a1) | ((unsigned long long)pk2(a2, a3) << 32);
            if (t >= TS - 2) *(f32x4*)(F.out + O_FFNS + (((size_t)l * BS + b) * 2 + (t - (TS - 2))) * DFF + c) = ga;
        }
    }
}

__global__ void __launch_bounds__(NTHR, 2) hymba_fwd(Params prm) {
    extern __shared__ __attribute__((aligned(16))) unsigned char lds_raw[];
    Frame F;
    F.lds = (LAS unsigned char*)lds_raw;
#define REFRESH() do { unsigned z_ = 0u; asm volatile("" : "+v"(z_)); int ln_ = (int)__builtin_amdgcn_mbcnt_hi(~0u, __builtin_amdgcn_mbcnt_lo(~0u, z_)); F.lane = ln_; F.wave = wave_s; F.tid = wave_s * 64 + ln_; \
        F.gw = blockIdx.x * NWAVES + F.wave; \
        const __attribute__((address_space(4))) void* kp_ = (const __attribute__((address_space(4))) void*)__builtin_amdgcn_kernarg_segment_ptr(); asm volatile("" : "+s"(kp_)); \
        F.p = (const __attribute__((address_space(4))) Params*)kp_; F.ws = F.p->ws; F.out = F.p->out; } while (0)
    F.G = gridDim.x; F.ngw = F.G * NWAVES;
    const int wave_s = __builtin_amdgcn_readfirstlane((int)threadIdx.x >> 6);
    REFRESH();
    volatile LAS unsigned* MISC = (volatile LAS unsigned*)(F.lds + MISC_OFF);
    for (int u = F.tid; u < (LDS_BYTES - RING_BYTES) / 4; u += NTHR) ((LAS unsigned*)(F.lds + RING_BYTES))[u] = 0u;
    __syncthreads();
    const int lo = F.p->ph_lo, hi = F.p->ph_hi;
    const bool use_bar = (hi - lo) > 1;
    XcdBarrier bar; bar.bar = (unsigned*)(F.ws + WS_CTL) + 4096; bar.x = 0; bar.st = nullptr;
    if (use_bar) bar = xcd_barrier_post((unsigned*)(F.ws + WS_CTL) + 4096, MISC + 8);
#define IN(k) (lo <= (k) && (k) < hi)
#define SEAM(k) do { if (IN((k) + 1)) { REFRESH(); xcd_barrier(bar, F.tid == 0); } } while (0)

    if (IN(0)) { REFRESH(); phase_prologue(F); SEAM(0); }
    if (IN(1)) { REFRESH();
        pg8::Gemm g{WSP(F, pg8::bf16_t, WS_AS), WSP(F, pg8::bf16_t, WS_WTC), 8 * BS * 512, 256, 1024};
        pg8::CmpOrder S; S.G = F.G; S.c = (int)blockIdx.x;
        pg8::EpiCmp E{WSP(F, float, WS_HS)};
        pg8::gemm_phase<pg8::EpiCmp, pg8::CmpOrder, true, true>(F.lds, g, S, E, F.tid);
        SEAM(1);
    }
    if (IN(2)) { REFRESH(); phase_cmp_finish(F); SEAM(2); }
    for (int l = 0; l < DEPTH; ++l) {
        const int pb = N_PRO + l * PH_PER_LAYER;
        if (IN(pb + 0)) { REFRESH();
            pg8::Gemm g{WSP(F, pg8::bf16_t, WS_XN), WSP(F, pg8::bf16_t, WS_WTIN) + (size_t)l * IN_WP * DM, MROWS, IN_WP, DM};
            pg8::StaticOrder S; S.init(MROWS, IN_WP, F.G, (int)blockIdx.x);
            pg8::EpiF32 E{WSP(F, float, WS_PROJ), IN_WP};
            pg8::gemm_phase<pg8::EpiF32, pg8::StaticOrder, true, true>(F.lds, g, S, E, F.tid);
            SEAM(pb + 0);
        }
        if (IN(pb + 1)) { REFRESH(); phase_prep(F, l); SEAM(pb + 1); }
        if (IN(pb + 2)) { REFRESH(); phase_compress(F, l); SEAM(pb + 2); }
        if (IN(pb + 3)) { REFRESH(); phase_attn2(F, l); SEAM(pb + 3); }
        if (IN(pb + 4)) { REFRESH();
            pg8::Gemm g{WSP(F, pg8::bf16_t, WS_MIX), WSP(F, pg8::bf16_t, WS_WTOUT) + (size_t)l * DM * DM, MROWS, DM, DM};
            pg8::TailSplitOrder S; S.init(NP, DM, DM, SPLIT_OUT, F.G, (int)blockIdx.x);
            pg8::EpiB16Split E{WSP(F, pg8::bf16_t, WS_MIXO), WSP(F, float, WS_SLAB), DM, NP / 256};
            pg8::gemm_phase<pg8::EpiB16Split, pg8::TailSplitOrder, true, true>(F.lds, g, S, E, F.tid);
            SEAM(pb + 4);
        }
        if (IN(pb + 5)) { REFRESH(); phase_resid_mix(F, l); SEAM(pb + 5); }
        if (IN(pb + 6)) { REFRESH();
            pg8::Gemm g{WSP(F, pg8::bf16_t, WS_XN), WSP(F, pg8::bf16_t, WS_WTUP) + (size_t)l * 2 * DFF * DM, MROWS, 2 * DFF, DM};
            pg8::StaticOrder S; S.init(MROWS, 2 * DFF, F.G, (int)blockIdx.x);
            pg8::EpiFfn E{WSP(F, pg8::bf16_t, WS_ACT), WSP(F, float, WS_FRAW), WSP(F, float, WS_FHALO), WSP(F, float, WS_FLAST),
                          INP(F, I_FCW) + (size_t)l * 3 * DFF, INP(F, I_FCB) + (size_t)l * DFF, (LAS float*)(F.lds + XB_OFF), NP / 256};
            pg8::gemm_phase<pg8::EpiFfn, pg8::StaticOrder, true, true>(F.lds, g, S, E, F.tid);
            SEAM(pb + 6);
        }
        if (IN(pb + 7)) { REFRESH(); phase_ffn_act(F, l); SEAM(pb + 7); }
        if (IN(pb + 8)) { REFRESH();
            pg8::Gemm g{WSP(F, pg8::bf16_t, WS_ACT), WSP(F, pg8::bf16_t, WS_WTDN) + (size_t)l * DM * DFF, MROWS, DM, DFF};
            pg8::TailSplitOrder S; S.init(NP, DM, DFF, SPLIT_DOWN, F.G, (int)blockIdx.x);
            pg8::EpiB16Split E{WSP(F, pg8::bf16_t, WS_MIXO), WSP(F, float, WS_SLAB), DM, NP / 256};
            pg8::gemm_phase<pg8::EpiB16Split, pg8::TailSplitOrder, true, true>(F.lds, g, S, E, F.tid);
            SEAM(pb + 8);
        }
        if (IN(pb + 9)) { REFRESH(); phase_resid_ffn(F, l); SEAM(pb + 9); }
    }
#undef IN
#undef SEAM
}

#ifndef N_LAUNCH_MODE
#define N_LAUNCH_MODE 1
#endif
extern "C" void kernel_launch(void* const* d_in, const int* in_sizes, int n_in, void* d_out, int out_size, void* d_ws, size_t ws_size, hipStream_t stream) {
    static int grid = 0;
    if (grid == 0) {
        if (n_in != N_IN || (size_t)out_size != O_END || ws_size < WS_END) {
            fprintf(stderr, "kernel_launch: unexpected shapes: n_in %d (want %d), out %d (want %zu), ws %zu (want >= %zu); nothing launched\n", n_in, (int)N_IN, out_size, (size_t)O_END, ws_size, (size_t)WS_END);
            grid = -1; return; }
        int dev = 0, cus = 0, per_cu = 0;
        if (hipGetDevice(&dev) != hipSuccess || hipDeviceGetAttribute(&cus, hipDeviceAttributeMultiprocessorCount, dev) != hipSuccess) { grid = -1; return; }
        if (hipFuncSetAttribute((const void*)hymba_fwd, hipFuncAttributeMaxDynamicSharedMemorySize, LDS_BYTES) != hipSuccess) { fprintf(stderr, "kernel_launch: hipFuncSetAttribute failed\n"); grid = -1; return; }
        if (hipOccupancyMaxActiveBlocksPerMultiprocessor(&per_cu, (const void*)hymba_fwd, NTHR, LDS_BYTES) != hipSuccess || per_cu < 1)
            fprintf(stderr, "kernel_launch: note: occupancy query reports %d workgroups per CU\n", per_cu);
        (void)hipGetLastError();
        grid = cus;
    }
    if (grid < 0) return;
    (void)hipMemsetAsync((char*)d_ws + WS_CTL, 0, CTL_BYTES, stream);
    Params prm{};
    for (int i = 0; i < N_IN; ++i) prm.in[i] = (const float*)d_in[i];
    prm.out = (float*)d_out; prm.ws = (unsigned char*)d_ws;
#if N_LAUNCH_MODE == 1
    prm.ph_lo = 0; prm.ph_hi = N_PHASES;
    hipLaunchKernelGGL(hymba_fwd, dim3(grid), dim3(NTHR), LDS_BYTES, stream, prm);
#else
    for (int ph = 0; ph < N_PHASES; ++ph) {
        prm.ph_lo = ph; prm.ph_hi = ph + 1;
        hipLaunchKernelGGL(hymba_fwd, dim3(grid), dim3(NTHR), LDS_BYTES, stream, prm);
    }
#endif
}
```

```cpp
#include <hip/hip_runtime.h>
#include <cstdio>
#include <cstdint>

namespace pg8 {
#define PG8_LAS __attribute__((address_space(3)))
typedef unsigned short bf16_t;
typedef short bf16x8 __attribute__((ext_vector_type(8)));
typedef float f32x4 __attribute__((ext_vector_type(4)));
typedef unsigned u32x4 __attribute__((ext_vector_type(4)));
constexpr int BM = 256, BK = 64, HALF = 128, HTB = HALF * BK * 2  , STAGE_BYTES = 8 * HTB, NXCD = 8, WGM = 8;

__host__ __device__ __forceinline__ int lds_byte(int r, int c) { const int st = (r >> 4) * 2 + (c >> 5), rr = r & 15, cc = c & 31, ob = rr * 64 + cc * 2; return st * 1024 + (ob ^ (((ob >> 9) & 1) << 5)); }
__host__ __device__ __forceinline__ void stage_rc(int b, int& R, int& C) { const int st = b / 1024, sb = b % 1024, swz = sb ^ (((sb >> 9) & 1) << 5); R = (st >> 1) * 16 + swz / 64; C = (st & 1) * 32 + (swz % 64) / 2; }
__host__ __device__ __forceinline__ int perm32(int rho) { const int n = rho >> 4, i = rho & 15; return 8 * (i >> 2) + 4 * n + (i & 3); }

struct Unit { int pm, pn, kt0, nt; };
struct Gemm { const bf16_t* A; const bf16_t* Bt; int M, N, K; };

struct StaticOrder {
    int nM, nN, nwg, G, c;
    __host__ __device__ __forceinline__ void init(int M, int N, int G_, int c_) { nM = M / BM; nN = N / BM; nwg = nM * nN; G = G_; c = c_; }
    __host__ __device__ __forceinline__ bool next(int i, Unit& u) const {
        const long L = (long)i * G + c; if (L >= nwg) return false;
        int wgid = (int)L; { const int q = nwg / NXCD, r = nwg % NXCD, xcd = wgid % NXCD, off = wgid / NXCD; wgid = (xcd < r ? xcd * (q + 1) : r * (q + 1) + (xcd - r) * q) + off; }
        const int nig = WGM * nN, gid = wgid / nig, fm = gid * WGM, gsz = (nM - fm) < WGM ? (nM - fm) : WGM;
        u.pm = fm + ((wgid % nig) % gsz); u.pn = (wgid % nig) / gsz; u.kt0 = 0; u.nt = 0; return true;
    }
    __device__ __forceinline__ void a_ready(const Unit&) const {}
    __device__ __forceinline__ void done(const Unit&) const {}
};

__device__ __forceinline__ unsigned cvt_pk_bf16(float lo, float hi) { unsigned r; asm volatile("v_cvt_pk_bf16_f32 %0, %1, %2" : "=v"(r) : "v"(lo), "v"(hi)); return r; }
struct EpiF32 {
    static constexpr bool PERM = true, AFTER_DRAIN = false;
    float* O; int ldc;
    __device__ __forceinline__ void operator()(const f32x4 (&acc)[2][2][4][2], const Unit& u, int wr, int wc, int fr, int fq) const {
        const int row0 = u.pm * BM + wr * 64 + fr; const int col0 = u.pn * BM + wc * 32 + 8 * fq;
#pragma unroll
        for (int ai = 0; ai < 2; ++ai)
#pragma unroll
            for (int m = 0; m < 4; ++m) { float* rowp = O + (size_t)(row0 + ai * HALF + m * 16) * ldc + col0;
#pragma unroll
                for (int bj = 0; bj < 2; ++bj) { *(f32x4*)(rowp + bj * HALF) = acc[ai][bj][m][0]; *(f32x4*)(rowp + bj * HALF + 4) = acc[ai][bj][m][1]; } }
    }
};

struct CmpOrder {
    int G, c;
    __device__ __forceinline__ bool next(int i, Unit& u) const { const int L = i * G + c; if (L >= 512) return false; u.pm = L; u.pn = L >> 6; u.kt0 = 0; u.nt = 0; return true; }
    __device__ __forceinline__ void a_ready(const Unit&) const {}
    __device__ __forceinline__ void done(const Unit&) const {}
};
struct EpiCmp {
    static constexpr bool PERM = true, AFTER_DRAIN = false;
    float* O;
    __device__ __forceinline__ void operator()(const f32x4 (&acc)[2][2][4][2], const Unit& u, int wr, int wc, int fr, int fq) const {
        const int row0 = u.pm * BM + wr * 64 + fr; const int col0 = wc * 32 + 8 * fq;
#pragma unroll
        for (int ai = 0; ai < 2; ++ai)
#pragma unroll
            for (int m = 0; m < 4; ++m) { float* rowp = O + (size_t)(row0 + ai * HALF + m * 16) * 256 + col0;
#pragma unroll
                for (int bj = 0; bj < 2; ++bj) { *(f32x4*)(rowp + bj * HALF) = acc[ai][bj][m][0]; *(f32x4*)(rowp + bj * HALF + 4) = acc[ai][bj][m][1]; } }
    }
};

struct EpiB16 {
    static constexpr bool PERM = true, AFTER_DRAIN = false;
    bf16_t* O; int ldc;
    __device__ __forceinline__ void operator()(const f32x4 (&acc)[2][2][4][2], const Unit& u, int wr, int wc, int fr, int fq) const {
        const int row0 = u.pm * BM + wr * 64 + fr; const int col0 = u.pn * BM + wc * 32 + 8 * fq;
#pragma unroll
        for (int ai = 0; ai < 2; ++ai)
#pragma unroll
            for (int m = 0; m < 4; ++m) { bf16_t* rowp = O + (size_t)(row0 + ai * HALF + m * 16) * ldc + col0;
#pragma unroll
                for (int bj = 0; bj < 2; ++bj) { const f32x4 v0 = acc[ai][bj][m][0], v1 = acc[ai][bj][m][1];
                    u32x4 w; w.x = cvt_pk_bf16(v0[0], v0[1]); w.y = cvt_pk_bf16(v0[2], v0[3]); w.z = cvt_pk_bf16(v1[0], v1[1]); w.w = cvt_pk_bf16(v1[2], v1[3]);
                    *(u32x4*)(rowp + bj * HALF) = w; } }
    }
};

struct TailSplitOrder {
    StaticOrder P; int nN, ntf, split;
    __device__ __forceinline__ void init(int Mp, int N, int K, int split_, int G, int c) { P.init(Mp, N, G, c); nN = N / BM; ntf = K / BK; split = split_; }
    __device__ __forceinline__ bool next(int i, Unit& u) const {
        const int L = i * P.G + P.c; const bool isp = L < P.nwg;
        int wgid = isp ? L : 0; { const int q = P.nwg / NXCD, r = P.nwg % NXCD, xcd = wgid % NXCD, off = wgid / NXCD; wgid = (xcd < r ? xcd * (q + 1) : r * (q + 1) + (xcd - r) * q) + off; }
        const int nig = WGM * P.nN, gid = wgid / nig, fm = gid * WGM, gsz = (P.nM - fm) < WGM ? (P.nM - fm) : WGM;
        const int ppm = fm + ((wgid % nig) % gsz), ppn = (wgid % nig) / gsz;
        const int t = L - P.nwg, nts = ntf / split;
        u.pm = isp ? ppm : P.nM; u.pn = isp ? ppn : t % nN; u.nt = isp ? 0 : nts; u.kt0 = isp ? 0 : (t / nN) * nts;
        return isp || t < nN * split;
    }
    __device__ __forceinline__ void a_ready(const Unit&) const {}
    __device__ __forceinline__ void done(const Unit&) const {}
};
struct EpiB16Split {
    static constexpr bool PERM = true, AFTER_DRAIN = false;
    bf16_t* O; float* S; int ldc; int tail_pm;
    __device__ __forceinline__ void operator()(const f32x4 (&acc)[2][2][4][2], const Unit& u, int wr, int wc, int fr, int fq) const {
        const int col0 = u.pn * BM + wc * 32 + 8 * fq;
        if (u.pm < tail_pm) {
            bf16_t* base = O + (size_t)(u.pm * BM + wr * 64 + fr) * ldc + col0;
#pragma unroll
            for (int ai = 0; ai < 2; ++ai)
#pragma unroll
                for (int m = 0; m < 4; ++m) { bf16_t* rowp = base + (size_t)(ai * HALF + m * 16) * ldc;
#pragma unroll
                    for (int bj = 0; bj < 2; ++bj) { const f32x4 v0 = acc[ai][bj][m][0], v1 = acc[ai][bj][m][1];
                        u32x4 w; w.x = cvt_pk_bf16(v0[0], v0[1]); w.y = cvt_pk_bf16(v0[2], v0[3]); w.z = cvt_pk_bf16(v1[0], v1[1]); w.w = cvt_pk_bf16(v1[2], v1[3]);
                        *(u32x4*)(rowp + bj * HALF) = w; } }
        } else {
            float* base = S + ((size_t)(u.kt0 / (u.nt ? u.nt : 1)) * BM + wr * 64 + fr) * ldc + col0;
#pragma unroll
            for (int ai = 0; ai < 2; ++ai)
#pragma unroll
                for (int m = 0; m < 4; ++m) { float* rowp = base + (size_t)(ai * HALF + m * 16) * ldc;
#pragma unroll
                    for (int bj = 0; bj < 2; ++bj) { *(f32x4*)(rowp + bj * HALF) = acc[ai][bj][m][0]; *(f32x4*)(rowp + bj * HALF + 4) = acc[ai][bj][m][1]; } }
        }
    }
};
struct EpiF32Split {
    static constexpr bool PERM = true, AFTER_DRAIN = false;
    float* O; float* S; int ldc; int tail_pm;
    __device__ __forceinline__ void operator()(const f32x4 (&acc)[2][2][4][2], const Unit& u, int wr, int wc, int fr, int fq) const {
        const int col0 = u.pn * BM + wc * 32 + 8 * fq;
        float* base = (u.pm < tail_pm) ? O + (size_t)(u.pm * BM + wr * 64 + fr) * ldc : S + ((size_t)(u.kt0 / (u.nt ? u.nt : 1)) * BM + wr * 64 + fr) * ldc;
#pragma unroll
        for (int ai = 0; ai < 2; ++ai)
#pragma unroll
            for (int m = 0; m < 4; ++m) { float* rowp = base + (size_t)(ai * HALF + m * 16) * ldc + col0;
#pragma unroll
                for (int bj = 0; bj < 2; ++bj) { *(f32x4*)(rowp + bj * HALF) = acc[ai][bj][m][0]; *(f32x4*)(rowp + bj * HALF + 4) = acc[ai][bj][m][1]; } }
    }
};

__device__ __forceinline__ float dpp_ror1(float v) { return __builtin_bit_cast(float, __builtin_amdgcn_update_dpp(0, __builtin_bit_cast(int, v), 0x121, 0xf, 0xf, false)); }
__device__ __forceinline__ float dpp_ror2(float v) { return __builtin_bit_cast(float, __builtin_amdgcn_update_dpp(0, __builtin_bit_cast(int, v), 0x122, 0xf, 0xf, false)); }
__device__ __forceinline__ float dpp_shr1(float old, float v) { return __builtin_bit_cast(float, __builtin_amdgcn_update_dpp(__builtin_bit_cast(int, old), __builtin_bit_cast(int, v), 0x111, 0xf, 0xf, false)); }
__device__ __forceinline__ float dpp_shr2(float old, float v) { return __builtin_bit_cast(float, __builtin_amdgcn_update_dpp(__builtin_bit_cast(int, old), __builtin_bit_cast(int, v), 0x112, 0xf, 0xf, false)); }
__device__ __forceinline__ float gelu_t(float x) {
    const float p = x * __builtin_fmaf(x * x, 0.044715f * 2.302208198f, 2.302208198f);
    return x * __builtin_amdgcn_rcpf(1.f + __builtin_amdgcn_exp2f(-p));
}
struct EpiFfn {
    static constexpr bool PERM = true, AFTER_DRAIN = false;
    bf16_t* ACT;
    float* RAW;
    float* HALO;
    float* LAST;
    const float* cw; const float* cb;
    PG8_LAS float* xb;
    int tail_pm;
    __device__ __forceinline__ void operator()(const f32x4 (&acc)[2][2][4][2], const Unit& u, int wr, int wc, int fr_in, int fq_in) const {
        int fr = fr_in, fq = fq_in; asm volatile("" : "+v"(fr), "+v"(fq));
        const int colt = wc * 32 + 8 * fq, gcol = u.pn * 128 + colt;
        const bool tail = (u.pm >= tail_pm);
#pragma unroll
        for (int ai = 0; ai < 2; ++ai) {
            if (fr >= 14) { PG8_LAS float* d = xb + ((ai * 2 + wr) * 2 + (fr - 14)) * 128 + colt;
                *(PG8_LAS f32x4*)d = acc[ai][0][3][0]; *(PG8_LAS f32x4*)(d + 4) = acc[ai][0][3][1]; }
        }
        if (!tail) {
            if (wr == 1 && fr >= 14) { float* d = LAST + ((size_t)u.pm * 2 + (fr - 14)) * 4096 + gcol; *(f32x4*)d = acc[1][0][3][0]; *(f32x4*)(d + 4) = acc[1][0][3][1]; }
            if (wr == 0 && fr < 2) { float* d = HALO + ((size_t)u.pm * 2 + fr) * 8192 + gcol;
                *(f32x4*)d = acc[0][0][0][0]; *(f32x4*)(d + 4) = acc[0][0][0][1]; *(f32x4*)(d + 4096) = acc[0][1][0][0]; *(f32x4*)(d + 4096 + 4) = acc[0][1][0][1]; }
        } else {
#pragma unroll
            for (int ai = 0; ai < 2; ++ai)
#pragma unroll
                for (int m = 0; m < 4; ++m) { float* d = RAW + ((size_t)(u.kt0 / (u.nt ? u.nt : 1)) * BM + ai * HALF + wr * 64 + m * 16 + fr) * 8192 + gcol;
                    *(f32x4*)d = acc[ai][0][m][0]; *(f32x4*)(d + 4) = acc[ai][0][m][1]; *(f32x4*)(d + 4096) = acc[ai][1][m][0]; *(f32x4*)(d + 4096 + 4) = acc[ai][1][m][1]; }
        }
        asm volatile("s_waitcnt lgkmcnt(0)" ::: "memory");
        __builtin_amdgcn_s_barrier();
        if (tail) return;
#pragma unroll
        for (int n = 0; n < 2; ++n) {
            const f32x4 w0 = *(const f32x4*)(cw + gcol + 4 * n), w1 = *(const f32x4*)(cw + 4096 + gcol + 4 * n), w2 = *(const f32x4*)(cw + 8192 + gcol + 4 * n), bb = *(const f32x4*)(cb + gcol + 4 * n);
#pragma unroll
            for (int ai = 0; ai < 2; ++ai) {
                const int pgrp = (wr == 1) ? (ai * 2 + 0) : (0 * 2 + 1);
                const f32x4 pv = *(const PG8_LAS f32x4*)(xb + (pgrp * 2 + (fr == 15 ? 1 : 0)) * 128 + colt + 4 * n);
#pragma unroll
                for (int m = 0; m < 4; ++m) {
                    float a4[4];
#pragma unroll
                    for (int k = 0; k < 4; ++k) {
                        const float cur = acc[ai][0][m][n][k]; const float prm = (m > 0) ? acc[ai][0][m > 0 ? m - 1 : 0][n][k] : pv[k];
                        const float p1 = dpp_shr1(dpp_ror1(prm), cur), p2 = dpp_shr2(dpp_ror2(prm), cur);
                        const float pre = w0[k] * p2 + w1[k] * p1 + w2[k] * cur + bb[k];
                        a4[k] = gelu_t(pre) * acc[ai][1][m][n][k];
                    }
                    const bool deferred = (ai == 0 && wr == 0 && m == 0 && fr < 2);
                    if (!deferred) *(unsigned long long*)(ACT + (size_t)(u.pm * BM + ai * HALF + wr * 64 + m * 16 + fr) * 4096 + gcol + 4 * n) =
                        (unsigned long long)cvt_pk_bf16(a4[0], a4[1]) | ((unsigned long long)cvt_pk_bf16(a4[2], a4[3]) << 32);
                }
            }
        }
    }
};
template <class Epi, class Sched, bool ALIGN_EPI = false, bool SP2 = false>
__device__ __forceinline__ void gemm_phase(PG8_LAS unsigned char* lds, const Gemm g, const Sched& S, const Epi& E, const int tid_in) {
    int tid_ = tid_in; asm volatile("" : "+v"(tid_));
    const int tid = tid_, wid = __builtin_amdgcn_readfirstlane(tid >> 6), lane = tid & 63, wr = wid >> 2, wc = wid & 3, fr = lane & 15, fq = lane >> 4;
    const int K = g.K, ntf = K / BK;
    unsigned voffA[2], voffB[2];
#pragma unroll
    for (int i = 0; i < 2; ++i) { int R, C; stage_rc(tid * 16 + i * 8192, R, C); const int Rb = Epi::PERM ? ((R & ~31) + perm32(R & 31)) : R;
        voffA[i] = (unsigned)(R * K + C) * 2u; voffB[i] = (unsigned)(Rb * K + C) * 2u; }
    const size_t kstep = (size_t)(BK * 2);
    const size_t hstep = (size_t)HALF * K * 2;
    const size_t tstep = 2 * hstep;
    const unsigned ldsw = (unsigned)wid * 1024u;
    const int aoff = lds_byte(wr * 64 + fr, fq * 8), boff = lds_byte(wc * 32 + fr, fq * 8);
#define PG8_SA(b, h) (((b) * 2 + (h)) * HTB)
#define PG8_SB(b, h) ((4 + (b) * 2 + (h)) * HTB)
#define PG8_STAGE(bufoff, gbase, voff) do { _Pragma("unroll") for (int _i = 0; _i < 2; ++_i) \
        __builtin_amdgcn_global_load_lds((const unsigned*)((const char*)(gbase) + (voff)[_i]), (PG8_LAS unsigned*)(lds + (bufoff) + ldsw + _i * 8192), 16, 0, 0); } while (0)
#define PG8_LDA(dst, b, h) do { _Pragma("unroll") for (int m = 0; m < 4; ++m) _Pragma("unroll") for (int k = 0; k < 2; ++k) dst[m][k] = *(const PG8_LAS bf16x8*)(lds + PG8_SA(b, h) + aoff + m * 2048 + k * 1024); } while (0)
#define PG8_LDB(dst, b, h) do { _Pragma("unroll") for (int n = 0; n < 2; ++n) _Pragma("unroll") for (int k = 0; k < 2; ++k) dst[n][k] = *(const PG8_LAS bf16x8*)(lds + PG8_SB(b, h) + boff + n * 2048 + k * 1024); } while (0)
#define PG8_MMA(ai, bj, At, Bt) do { __builtin_amdgcn_s_setprio(1); _Pragma("unroll") for (int m = 0; m < 4; ++m) _Pragma("unroll") for (int n = 0; n < 2; ++n) _Pragma("unroll") for (int k = 0; k < 2; ++k) \
        acc[ai][bj][m][n] = __builtin_amdgcn_mfma_f32_16x16x32_bf16(Bt[n][k], At[m][k], acc[ai][bj][m][n], 0, 0, 0); __builtin_amdgcn_s_setprio(0); } while (0)
#define PG8_WAIT_V(n) asm volatile("s_waitcnt vmcnt(" #n ")" ::: "memory")
#define PG8_WAIT_L(n) asm volatile("s_waitcnt lgkmcnt(" #n ")" ::: "memory")
#define PG8_BAR __builtin_amdgcn_s_barrier()
#define PG8_SCHED __builtin_amdgcn_sched_barrier(0)
    Unit cur = {0, 0, 0, 0}, nxt = {0, 0, 0, 0}; int ui = 0;
    if (!S.next(0, cur)) return;
    f32x4 acc[2][2][4][2];
#pragma unroll
    for (int a = 0; a < 2; ++a)
#pragma unroll
        for (int b = 0; b < 2; ++b)
#pragma unroll
            for (int m = 0; m < 4; ++m)
#pragma unroll
                for (int n = 0; n < 2; ++n) acc[a][b][m][n] = (f32x4){0.f, 0.f, 0.f, 0.f};
    bf16x8 At[4][2], B0[2][2], B1[2][2];
    const char* cA = (const char*)g.A + (size_t)cur.pm * tstep + (size_t)cur.kt0 * kstep; const char* cB = (const char*)g.Bt + (size_t)cur.pn * tstep + (size_t)cur.kt0 * kstep;
    S.a_ready(cur);
    if constexpr (SP2) {
        PG8_STAGE(PG8_SB(0, 0), cB, voffB); PG8_STAGE(PG8_SB(0, 1), cB + hstep, voffB); PG8_STAGE(PG8_SA(0, 0), cA, voffA); PG8_STAGE(PG8_SA(0, 1), cA + hstep, voffA);
        if (wr == 1) PG8_BAR;
        PG8_WAIT_V(2); PG8_BAR;
        PG8_STAGE(PG8_SB(1, 0), cB + kstep, voffB); PG8_STAGE(PG8_SA(1, 0), cA + kstep, voffA); PG8_STAGE(PG8_SB(1, 1), cB + hstep + kstep, voffB);
        PG8_WAIT_V(6); PG8_BAR;
    } else {
        PG8_STAGE(PG8_SB(0, 0), cB, voffB); PG8_STAGE(PG8_SA(0, 0), cA, voffA); PG8_STAGE(PG8_SB(0, 1), cB + hstep, voffB); PG8_STAGE(PG8_SA(0, 1), cA + hstep, voffA);
        if (wr == 1) PG8_BAR;
        PG8_WAIT_V(4); PG8_BAR;
        PG8_STAGE(PG8_SB(1, 0), cB + kstep, voffB); PG8_STAGE(PG8_SA(1, 0), cA + kstep, voffA); PG8_STAGE(PG8_SB(1, 1), cB + hstep + kstep, voffB);
        PG8_WAIT_V(6); PG8_BAR;
    }
    for (;;) {
        const bool has_next = S.next(ui + 1, nxt);
        const char* nA = has_next ? (const char*)g.A + (size_t)nxt.pm * tstep + (size_t)nxt.kt0 * kstep : cA; const char* nB = has_next ? (const char*)g.Bt + (size_t)nxt.pn * tstep + (size_t)nxt.kt0 * kstep : cB;
        const int nt = cur.nt ? cur.nt : ntf;
        for (int t = 0; t < nt; t += 2) {
            const bool last = (t == nt - 2);
            const char* a1 = cA + (size_t)(t + 1) * kstep;
            const char* a2 = last ? nA : cA + (size_t)(t + 2) * kstep; const char* b2 = last ? nB : cB + (size_t)(t + 2) * kstep;
            const char* a3 = a2 + kstep; const char* b3 = b2 + kstep;
            if (last && has_next) S.a_ready(nxt);
            if constexpr (SP2) {
            PG8_LDB(B0, 0, 0); PG8_LDB(B1, 0, 1); PG8_SCHED; PG8_LDA(At, 0, 0); PG8_STAGE(PG8_SA(1, 1), a1 + hstep, voffA);
            PG8_WAIT_V(8); PG8_WAIT_L(0); PG8_BAR; PG8_MMA(0, 0, At, B0); PG8_MMA(0, 1, At, B1); PG8_BAR; PG8_SCHED;
            PG8_LDA(At, 0, 1); PG8_STAGE(PG8_SB(0, 0), b2, voffB); PG8_STAGE(PG8_SB(0, 1), b2 + hstep, voffB); PG8_STAGE(PG8_SA(0, 0), a2, voffA);
            PG8_WAIT_V(8); PG8_WAIT_L(0); PG8_BAR; PG8_MMA(1, 0, At, B0); PG8_MMA(1, 1, At, B1); PG8_BAR; PG8_SCHED;
            PG8_LDB(B0, 1, 0); PG8_LDB(B1, 1, 1); PG8_SCHED; PG8_LDA(At, 1, 0); PG8_STAGE(PG8_SA(0, 1), a2 + hstep, voffA);
            PG8_WAIT_V(8); PG8_WAIT_L(0); PG8_BAR; PG8_MMA(0, 0, At, B0); PG8_MMA(0, 1, At, B1); PG8_BAR; PG8_SCHED;
            PG8_LDA(At, 1, 1); PG8_STAGE(PG8_SB(1, 0), b3, voffB); PG8_STAGE(PG8_SB(1, 1), b3 + hstep, voffB); PG8_STAGE(PG8_SA(1, 0), a3, voffA);
            PG8_WAIT_V(8); PG8_WAIT_L(0); PG8_BAR; PG8_MMA(1, 0, At, B0); PG8_MMA(1, 1, At, B1); PG8_BAR; PG8_SCHED;
            } else {
            PG8_LDB(B0, 0, 0); PG8_SCHED; PG8_LDA(At, 0, 0); PG8_STAGE(PG8_SA(1, 1), a1 + hstep, voffA);
            PG8_WAIT_L(8); PG8_BAR; PG8_WAIT_L(0); PG8_MMA(0, 0, At, B0); PG8_BAR; PG8_SCHED;
            PG8_LDB(B1, 0, 1); PG8_STAGE(PG8_SB(0, 0), b2, voffB);
            PG8_BAR; PG8_WAIT_L(0); PG8_MMA(0, 1, At, B1); PG8_BAR;
            PG8_LDA(At, 0, 1); PG8_STAGE(PG8_SA(0, 0), a2, voffA);
            PG8_BAR; PG8_WAIT_L(0); PG8_MMA(1, 0, At, B0); PG8_BAR; PG8_SCHED;
            PG8_STAGE(PG8_SB(0, 1), b2 + hstep, voffB);
            PG8_WAIT_V(6); PG8_BAR; PG8_MMA(1, 1, At, B1); PG8_BAR;
            PG8_LDB(B0, 1, 0); PG8_SCHED; PG8_LDA(At, 1, 0); PG8_STAGE(PG8_SA(0, 1), a2 + hstep, voffA);
            PG8_WAIT_L(8); PG8_BAR; PG8_WAIT_L(0); PG8_MMA(0, 0, At, B0); PG8_BAR; PG8_SCHED;
            PG8_LDB(B1, 1, 1); PG8_STAGE(PG8_SB(1, 0), b3, voffB);
            PG8_BAR; PG8_WAIT_L(0); PG8_MMA(0, 1, At, B1); PG8_BAR;
            PG8_LDA(At, 1, 1); PG8_STAGE(PG8_SA(1, 0), a3, voffA);
            PG8_BAR; PG8_WAIT_L(0); PG8_MMA(1, 0, At, B0); PG8_BAR; PG8_SCHED;
            PG8_STAGE(PG8_SB(1, 1), b3 + hstep, voffB);
            PG8_WAIT_V(6); PG8_BAR; PG8_MMA(1, 1, At, B1); PG8_BAR;
            }
        }
        if constexpr (ALIGN_EPI) { if (wr == 0) PG8_BAR; }
        if constexpr (!Epi::AFTER_DRAIN) { E(acc, cur, wr, wc, fr, fq); S.done(cur); }
        if (!has_next) break;
#pragma unroll
        for (int a = 0; a < 2; ++a)
#pragma unroll
            for (int b = 0; b < 2; ++b)
#pragma unroll
                for (int m = 0; m < 4; ++m)
#pragma unroll
                    for (int n = 0; n < 2; ++n) acc[a][b][m][n] = (f32x4){0.f, 0.f, 0.f, 0.f};
        cur = nxt; cA = nA; cB = nB; ++ui;
        if constexpr (ALIGN_EPI) { if (wr == 1) PG8_BAR; }
    }
    PG8_WAIT_V(0);
    if constexpr (!ALIGN_EPI) { if (wr == 0) PG8_BAR; }
    PG8_BAR;
    if constexpr (Epi::AFTER_DRAIN) { E.fused(acc, cur, wr, wc, fr, fq, lds, wid, lane); S.done(cur); }
#undef PG8_SA
#undef PG8_SB
#undef PG8_STAGE
#undef PG8_LDA
#undef PG8_LDB
#undef PG8_MMA
#undef PG8_WAIT_V
#undef PG8_WAIT_L
#undef PG8_BAR
#undef PG8_SCHED
}
}

#define GAS __attribute__((address_space(1)))
#define LAS __attribute__((address_space(3)))
typedef unsigned short bf16;
typedef unsigned v4u __attribute__((ext_vector_type(4)));
typedef float f32x4 __attribute__((ext_vector_type(4)));
typedef short bf16x8 __attribute__((ext_vector_type(8)));

constexpr int DM = 1024, BP = 8, TP = 2048, DEPTH = 4, BS = 32, TS = 8, PAST = 8192, PAGE = 128;
constexpr int NP = BP * TP, NS = BS * TS, MROWS = NP + NS;
constexpr int NSEQ = BP + BS;
constexpr int SSD_W = 512, SSD_H = 8, SSD_HD = 64, SSD_N = 128, CONV_DIM = 1024;
constexpr int POOL_W = 256, POOL_KEEP = 15;
constexpr int NSA_H = 4, NSA_HD = 64;
constexpr int OFF_XBC = 512, OFF_DT = 1536, OFF_POOL = 1544, OFF_Q = 1800, OFF_KV = 2056, OFF_G = 2440, IN_W = 2452, IN_WP = 2560;
constexpr int PROJ_LD = IN_WP + 64;
constexpr int DFF = 4096;
constexpr int NPHYS = 2560, NPAGES = 64;
constexpr int NCMP_P = 127, NCMP_S = 511;
constexpr float RMS_EPS = 1e-6f;

constexpr size_t O_YP = 0;
constexpr size_t O_YS = O_YP + (size_t)NP * DM;
constexpr size_t O_KVP = O_YS + (size_t)NS * DM;
constexpr size_t O_KVS = O_KVP + (size_t)DEPTH * NP * 256;
constexpr size_t O_WINP = O_KVS + (size_t)DEPTH * NS * 256;
constexpr size_t O_WINS = O_WINP + (size_t)DEPTH * BP * 512 * 128;
constexpr size_t O_CONVP = O_WINS + (size_t)DEPTH * BS * 512 * 128;
constexpr size_t O_CONVS = O_CONVP + (size_t)DEPTH * BP * 3 * 1024;
constexpr size_t O_SSMP = O_CONVS + (size_t)DEPTH * BS * 3 * 1024;
constexpr size_t O_SSMS = O_SSMP + (size_t)DEPTH * BP * 8 * 64 * 128;
constexpr size_t O_POOLP = O_SSMS + (size_t)DEPTH * BS * 8 * 64 * 128;
constexpr size_t O_POOLS = O_POOLP + (size_t)DEPTH * BP * 15 * 256;
constexpr size_t O_FFNP = O_POOLS + (size_t)DEPTH * BS * 15 * 256;
constexpr size_t O_FFNS = O_FFNP + (size_t)DEPTH * BP * 2 * 4096;
constexpr size_t O_END = O_FFNS + (size_t)DEPTH * BS * 2 * 4096;

enum { I_XP = 0, I_XS, I_CACHE, I_PT, I_SWIN, I_SCONV, I_SSM, I_SPOOL, I_SFFN, I_NMPRE, I_WIN, I_CONVW, I_CONVB, I_DTB, I_ALOG, I_SSDD, I_SSDNORM,
       I_POOLW, I_POOLSC, I_PEK, I_PEV, I_W1K, I_W1V, I_W2K, I_W2V, I_WOUT, I_NMPOST, I_NFPRE, I_WGATE, I_WVAL, I_FCW, I_FCB, I_WDOWN, I_NFPOST, N_IN };

constexpr size_t al256(size_t x) { return (x + 255) & ~(size_t)255; }
constexpr size_t WS_CTL = 0, CTL_BYTES = 1u << 20;
constexpr size_t WS_WTIN = WS_CTL + CTL_BYTES;
constexpr size_t WS_WTOUT = WS_WTIN + (size_t)DEPTH * IN_WP * DM * 2;
constexpr size_t WS_WTUP = WS_WTOUT + (size_t)DEPTH * DM * DM * 2;
constexpr size_t WS_WTDN = WS_WTUP + (size_t)DEPTH * 2 * DFF * DM * 2;
constexpr size_t WS_ROPE = WS_WTDN + (size_t)DEPTH * DM * DFF * 2;
constexpr size_t WS_X = WS_ROPE + al256((size_t)2056 * 16 * 4);
constexpr size_t WS_XN = WS_X + (size_t)MROWS * DM * 4;
constexpr size_t WS_PROJ = WS_XN + (size_t)MROWS * DM * 2;
constexpr size_t WS_YSSD = WS_PROJ + (size_t)MROWS * PROJ_LD * 4;
constexpr size_t WS_Q = WS_YSSD + (size_t)MROWS * SSD_W * 4;
constexpr size_t WS_KWIN = WS_Q + (size_t)MROWS * 256 * 4;
constexpr size_t WS_CKP = WS_KWIN + (size_t)MROWS * 128 * 4;
constexpr size_t WS_CVP = WS_CKP + al256((size_t)BP * NCMP_P * 64 * 4);
constexpr size_t WS_CKS = WS_CVP + al256((size_t)BP * NCMP_P * 64 * 4);
constexpr size_t WS_CVS = WS_CKS + al256((size_t)DEPTH * BS * NCMP_S * 64 * 4);
constexpr size_t WS_MIX = WS_CVS + al256((size_t)DEPTH * BS * NCMP_S * 64 * 4);
constexpr size_t WS_MIXO = WS_MIX + (size_t)MROWS * DM * 2;
constexpr size_t WS_GV = WS_MIXO + (size_t)MROWS * DM * 4;
constexpr size_t WS_ACT = WS_GV + (size_t)MROWS * 2 * DFF * 4;
constexpr size_t WS_QB = WS_ACT + (size_t)MROWS * DFF * 2;
constexpr size_t WS_SAC = WS_QB + (size_t)MROWS * 256 * 2;
constexpr size_t WS_SCD = WS_SAC + (size_t)NP * 8 * 4;
constexpr size_t WS_SCB = WS_SCD + al256((size_t)BP * 16 * 8 * 4);
constexpr size_t WS_SCS = WS_SCB + (size_t)NP * 256 * 2;
constexpr size_t WS_SHS = WS_SCS + (size_t)BP * 16 * 8 * 8192 * 4;
constexpr size_t WS_WTC = WS_SHS + (size_t)BP * 16 * 8 * 8192 * 2;
constexpr size_t WS_CBIAS = WS_WTC + (size_t)8 * 256 * 1024 * 2;
constexpr size_t WS_AS = WS_GV;
constexpr size_t WS_HS = WS_AS + (size_t)8 * BS * 512 * 1024 * 2;
static_assert(WS_HS + (size_t)8 * BS * 512 * 256 * 4 <= WS_GV + (size_t)MROWS * 2 * DFF * 4, "prologue buffers must fit inside the GV region");
constexpr size_t WS_SLAB = WS_CBIAS + 8 * 128 * 4;
constexpr size_t WS_W2T = WS_SLAB + (size_t)8 * 256 * DM * 4;
constexpr size_t WS_FRAW = WS_W2T + (size_t)8 * 64 * 128 * 2;
constexpr int SPLIT_UP = 1;
constexpr size_t WS_FHALO = WS_FRAW + (size_t)SPLIT_UP * 256 * 2 * DFF * 4;
constexpr size_t WS_FLAST = WS_FHALO + (size_t)64 * 2 * 2 * DFF * 4;
constexpr size_t WS_END = WS_FLAST + (size_t)64 * 2 * DFF * 4;
constexpr int SPLIT_OUT = 4, SPLIT_DOWN = 8;

constexpr int RING_BYTES = 131072;
constexpr int MISC_OFF = RING_BYTES + 320;
constexpr int LDS_BYTES = 147456;
constexpr int NWAVES = 8, NTHR = 512;
constexpr int XB_OFF = RING_BYTES + 1024;
static_assert(XB_OFF + 4096 <= LDS_BYTES, "LDS map");

constexpr int PH_PER_LAYER = 10, N_PRO = 3, N_PHASES = N_PRO + DEPTH * PH_PER_LAYER;

struct Params { const float* in[N_IN]; float* out; unsigned char* ws; int ph_lo, ph_hi; };

__device__ __forceinline__ unsigned f2bf(float f) { unsigned u = __builtin_bit_cast(unsigned, f); return (u + 0x7fffu + ((u >> 16) & 1u)) >> 16; }
__device__ __forceinline__ unsigned pk2(float lo, float hi) { return f2bf(lo) | (f2bf(hi) << 16); }
__device__ __forceinline__ f32x4 bf4_to_f32(unsigned long long u) {
    return (f32x4){__uint_as_float((unsigned)u << 16), __uint_as_float((unsigned)u & 0xffff0000u), __uint_as_float((unsigned)(u >> 32) << 16), __uint_as_float((unsigned)(u >> 32) & 0xffff0000u)};
}
__device__ __forceinline__ float wave_sum(float v) {
#pragma unroll
    for (int o = 1; o < 64; o <<= 1) v += __shfl_xor(v, o);
    return v;
}
__device__ __forceinline__ float sum16(float v) {
#pragma unroll
    for (int o = 1; o < 16; o <<= 1) v += __shfl_xor(v, o);
    return v;
}
__device__ __forceinline__ float sigmoidf_(float x) { return 1.f / (1.f + expf(-x)); }
__device__ __forceinline__ float siluf_(float x) { return x / (1.f + expf(-x)); }
__device__ __forceinline__ float softplusf_(float x) { return x > 0.f ? x + log1pf(expf(-x)) : log1pf(expf(x)); }
__device__ __forceinline__ float gelu_tanh(float x) {
    const float u = 0.7978845608028654f * (x + 0.044715f * x * x * x);
    const float t = 1.f - 2.f / (expf(2.f * u) + 1.f);
    return 0.5f * x * (1.f + t);
}
__device__ __forceinline__ void cossin_d(float angf, float& c, float& s) {
    const double a = (double)angf;
    const double k = rint(a * 0.63661977236758134308);
    const double r = (a - k * 1.57079632679489655800) - k * 6.123233995736766036e-17;
    const double r2 = r * r;
    double sp = r * (1.0 + r2 * (-1.0 / 6 + r2 * (1.0 / 120 + r2 * (-1.0 / 5040 + r2 * (1.0 / 362880 + r2 * (-1.0 / 39916800 + r2 * (1.0 / 6227020800.0)))))));
    double cp = 1.0 + r2 * (-0.5 + r2 * (1.0 / 24 + r2 * (-1.0 / 720 + r2 * (1.0 / 40320 + r2 * (-1.0 / 3628800 + r2 * (1.0 / 479001600.0 + r2 * (-1.0 / 87178291200.0)))))));
    const int q = ((int)k) & 3;
    double cc = (q == 0) ? cp : (q == 1) ? -sp : (q == 2) ? -cp : sp;
    double ss = (q == 0) ? sp : (q == 1) ? cp : (q == 2) ? -sp : -cp;
    c = (float)cc; s = (float)ss;
}

struct Seq { int T, row0, pos0, b, samp; };
__device__ __forceinline__ Seq seq_of(int s) {
    Seq q;
    if (s < BP) { q.T = TP; q.row0 = s * TP; q.pos0 = 0; q.b = s; q.samp = 0; }
    else { q.T = TS; q.row0 = NP + (s - BP) * TS; q.pos0 = PAST; q.b = s - BP; q.samp = 1; }
    return q;
}
__device__ __forceinline__ void row_to_seq(int r, int& s, int& t) {
    if (r < NP) { s = r >> 11; t = r & (TP - 1); } else { const int q = r - NP; s = BP + (q >> 3); t = q & 7; }
}

#define XB_TMO      128
#define XB_XCNT(j)  (256  + 64 * (j))
#define XB_XSUB(j)  (1280 + 64 * (j))
#define XB_XGEN(j)  (2304 + 64 * (j))
#define XB_TOP      3328
#define XB_TOPGEN   3392
#define XCD_BAR_WORDS 3456
#define XB_SPIN_CAP (1u << 21)
__device__ __forceinline__ unsigned xb_ld(unsigned* p)              { return __hip_atomic_load(p, __ATOMIC_RELAXED, __HIP_MEMORY_SCOPE_AGENT); }
__device__ __forceinline__ unsigned xb_add(unsigned* p, unsigned v) { return __hip_atomic_fetch_add(p, v, __ATOMIC_RELAXED, __HIP_MEMORY_SCOPE_AGENT); }
__device__ __forceinline__ unsigned xb_xcc_id() { return (unsigned)__builtin_amdgcn_s_getreg((3 << 11) | 20) & 0xFu; }
#define XB_SPIN(cond, bar) do { unsigned _sp = 0; while (cond) { __builtin_amdgcn_s_sleep(1); \
    if ((++_sp & 255u) == 0u) { if (xb_ld(&(bar)[XB_TMO])) break; if (_sp > XB_SPIN_CAP) { atomicAdd(&(bar)[XB_TMO], 1u); break; } } } } while (0)
struct XcdBarrier { unsigned* bar; unsigned x; volatile LAS unsigned* st; };
__device__ __forceinline__ XcdBarrier xcd_barrier_post(unsigned* bar, volatile LAS unsigned* st) {
    XcdBarrier b; b.bar = bar; b.x = xb_xcc_id(); b.st = st;
    if (threadIdx.x == 0) (void)xb_add(&bar[XB_XCNT(b.x)], 1u);
    return b;
}
__device__ __forceinline__ void xcd_barrier_complete(unsigned* bar, unsigned x, unsigned& nloc, unsigned& nx) {
    const unsigned G = gridDim.x * gridDim.y * gridDim.z;
    unsigned sum, cnt, mine, sp = 0u;
    for (;;) {
        sum = 0u; cnt = 0u; mine = 0u;
#pragma unroll
        for (unsigned j = 0; j < 16; ++j) { const unsigned c = xb_ld(&bar[XB_XCNT(j)]); sum += c; cnt += (c > 0u) ? 1u : 0u; mine = (j == x) ? c : mine; }
        if (sum == G) break;
        __builtin_amdgcn_s_sleep(1);
        if ((++sp & 255u) == 0u) { if (xb_ld(&bar[XB_TMO])) break; if (sp > XB_SPIN_CAP) { atomicAdd(&bar[XB_TMO], 1u); break; } }
    }
    nloc = mine > 0u ? mine : 1u; nx = cnt > 0u ? cnt : 1u;
}
__device__ __forceinline__ void xcd_barrier(const XcdBarrier& b, const bool lead) {
    asm volatile("s_waitcnt vmcnt(0)" ::: "memory");
    __syncthreads();
    if (lead) {
        unsigned* bar = b.bar;
        __builtin_amdgcn_s_waitcnt(0);
        unsigned nloc = b.st[0], nx = b.st[1];
        if (nloc == 0u) { xcd_barrier_complete(bar, b.x, nloc, nx); b.st[0] = nloc; b.st[1] = nx; }
        const unsigned old = xb_add(&bar[XB_XSUB(b.x)], 1u);
        const unsigned gen = old / nloc;
        if (old + 1u == (gen + 1u) * nloc) {
            __builtin_amdgcn_fence(__ATOMIC_RELEASE, "agent");
            asm volatile("s_waitcnt vmcnt(0)" ::: "memory");
            const unsigned og = xb_add(&bar[XB_TOP], 1u);
            const unsigned tg = og / nx;
            if (og + 1u == (tg + 1u) * nx) xb_add(&bar[XB_TOPGEN], 1u);
            else XB_SPIN(xb_ld(&bar[XB_TOPGEN]) == tg, bar);
            __builtin_amdgcn_fence(__ATOMIC_ACQUIRE, "agent");
            xb_add(&bar[XB_XGEN(b.x)], 1u);
            asm volatile("s_waitcnt vmcnt(0)" ::: "memory");
        } else {
            XB_SPIN(xb_ld(&bar[XB_XGEN(b.x)]) == gen, bar);
            __builtin_amdgcn_fence(__ATOMIC_ACQUIRE, "agent");
            asm volatile("s_waitcnt vmcnt(0)" ::: "memory");
        }
    }
    __syncthreads();
}

struct Frame {
    LAS unsigned char* lds;
    int tid, lane, wave, gw, ngw, G;
    const __attribute__((address_space(4))) Params* p;
    unsigned char* ws;
    float* out;
};
#define INP(F, i) ((F).p->in[(i)])
#define WSP(F, T, off) ((T*)((F).ws + (off)))

__device__ __forceinline__ const float* x_in_row(const Frame& F, int r) {
    return r < NP ? INP(F, I_XP) + (size_t)r * DM : INP(F, I_XS) + (size_t)(r - NP) * DM;
}

template <bool ILV = false>
__device__ __forceinline__ void transpose_item(const float* W, int K, int N, int nblk, bf16* WT, int row_off, LAS float* scr, int item, int lane) {
    const int kb = item / nblk, nb = item % nblk, k0 = 64 * kb, n0 = 32 * nb;
    const int r0 = ILV ? 256 * (n0 >> 7) + (n0 & 127) : n0;
    const int n = n0 + (lane & 31);
    float tv[32];
#pragma unroll
    for (int i = 0; i < 32; ++i) { const int kk = 2 * i + (lane >> 5); tv[i] = (n < N) ? W[(size_t)(k0 + kk) * N + n] : 0.f; }
#pragma unroll
    for (int i = 0; i < 32; ++i) { const int kk = 2 * i + (lane >> 5); scr[kk * 33 + (lane & 31)] = tv[i]; }
    asm volatile("s_waitcnt lgkmcnt(0)" ::: "memory");
    const int c = lane & 7;
#pragma unroll
    for (int j = 0; j < 4; ++j) { const int nn = (lane >> 3) + 8 * j; const LAS float* s = scr + (8 * c) * 33 + nn;
        v4u o; o.x = pk2(s[0 * 33], s[1 * 33]); o.y = pk2(s[2 * 33], s[3 * 33]); o.z = pk2(s[4 * 33], s[5 * 33]); o.w = pk2(s[6 * 33], s[7 * 33]);
        *(v4u*)(WT + (size_t)(row_off + r0 + nn) * K + k0 + 8 * c) = o; }
    asm volatile("s_waitcnt lgkmcnt(0)" ::: "memory");
}
__device__ __forceinline__ void norm_row_to_bf16(const Frame& F, const float* xrow, const float* w, bf16* orow) {
    const f32x4* xr = (const f32x4*)xrow + F.lane; const f32x4* wr = (const f32x4*)w + F.lane;
    f32x4 v[4]; float ss = 0.f;
#pragma unroll
    for (int j = 0; j < 4; ++j) { v[j] = xr[64 * j]; ss += (v[j].x * v[j].x + v[j].y * v[j].y) + (v[j].z * v[j].z + v[j].w * v[j].w); }
    const float rs = 1.f / sqrtf(wave_sum(ss) * (1.f / DM) + RMS_EPS);
    unsigned long long* o8 = (unsigned long long*)orow + F.lane;
#pragma unroll
    for (int j = 0; j < 4; ++j) { const f32x4 g = wr[64 * j];
        o8[64 * j] = (unsigned long long)pk2(v[j].x * rs * g.x, v[j].y * rs * g.y) | ((unsigned long long)pk2(v[j].z * rs * g.z, v[j].w * rs * g.w) << 32); }
}
__device__ __forceinline__ void phase_prologue(const Frame& F) {
    LAS float* scr = (LAS float*)(F.lds + F.wave * 16384);
    constexpr int IT_IN = 16 * (IN_WP / 32), IT_OUT = 16 * 32, IT_UP = 16 * 128, IT_DN = 64 * 32, IT_L = IT_IN + IT_OUT + 2 * IT_UP + IT_DN;
    for (int it = F.gw; it < DEPTH * IT_L; it += F.ngw) {
        const int l = it / IT_L; int r = it % IT_L;
        if (r < IT_IN) { transpose_item(INP(F, I_WIN) + (size_t)l * DM * IN_W, DM, IN_W, IN_WP / 32, WSP(F, bf16, WS_WTIN) + (size_t)l * IN_WP * DM, 0, scr, r, F.lane); continue; } r -= IT_IN;
        if (r < IT_OUT) { transpose_item(INP(F, I_WOUT) + (size_t)l * DM * DM, DM, DM, 32, WSP(F, bf16, WS_WTOUT) + (size_t)l * DM * DM, 0, scr, r, F.lane); continue; } r -= IT_OUT;
        if (r < IT_UP) { transpose_item<true>(INP(F, I_WGATE) + (size_t)l * DM * DFF, DM, DFF, 128, WSP(F, bf16, WS_WTUP) + (size_t)l * 2 * DFF * DM, 0, scr, r, F.lane); continue; } r -= IT_UP;
        if (r < IT_UP) { transpose_item<true>(INP(F, I_WVAL) + (size_t)l * DM * DFF, DM, DFF, 128, WSP(F, bf16, WS_WTUP) + (size_t)l * 2 * DFF * DM, 128, scr, r, F.lane); continue; } r -= IT_UP;
        transpose_item(INP(F, I_WDOWN) + (size_t)l * DFF * DM, DFF, DM, 32, WSP(F, bf16, WS_WTDN) + (size_t)l * DM * DFF, 0, scr, r, F.lane);
    }
    for (int it = F.gw; it < 8 * 2 * 64; it += F.ngw) {
        const int i = it >> 7, half = (it >> 6) & 1, r = it & 63; const int lyr = i >> 1, kv = i & 1;
        const float* w1 = INP(F, kv ? I_W1V : I_W1K) + (size_t)lyr * 32 * 64 * 128 + (size_t)half * 1024 * 128;
        transpose_item(w1, 1024, 128, 4, WSP(F, bf16, WS_WTC) + (size_t)i * 256 * 1024, half * 128, scr, r, F.lane);
    }
    for (int idx = blockIdx.x * NTHR + F.tid; idx < 8 * 64 * 128; idx += F.G * NTHR) {
        const int i = idx >> 13, d = (idx >> 7) & 63, e = idx & 127;
        WSP(F, bf16, WS_W2T)[idx] = (bf16)f2bf((INP(F, (i & 1) ? I_W2V : I_W2K) + (size_t)(i >> 1) * 128 * 64)[e * 64 + d]);
    }
    for (int idx = blockIdx.x * NTHR + F.tid; idx < 8 * 128; idx += F.G * NTHR) {
        const int i = idx >> 7, e = idx & 127; const int lyr = i >> 1, kv = i & 1;
        const float* w1 = INP(F, kv ? I_W1V : I_W1K) + (size_t)lyr * 32 * 64 * 128; const float* pe = INP(F, kv ? I_PEV : I_PEK) + (size_t)lyr * 32 * 64;
        float a = 0.f; for (int k = 0; k < 2048; ++k) a += pe[k] * w1[(size_t)k * 128 + e];
        WSP(F, float, WS_CBIAS)[idx] = a;
    }
    for (int it2 = F.gw; it2 < DEPTH * BS * 256; it2 += F.ngw) {
        f32x4 a[2][2][4]; int lyrv[2], bv[2], cv[2];
#pragma unroll
        for (int u = 0; u < 2; ++u) {
            const int it = 2 * it2 + u; const int lyr = it >> 14, b = (it >> 9) & 31, c = it & 511; lyrv[u] = lyr; bv[u] = b; cv[u] = c;
            const int page = ((const int*)INP(F, I_PT))[b * NPAGES + (c >> 3)];
            const int row = F.lane >> 2, qd = F.lane & 3;
            const float* src = INP(F, I_CACHE) + ((((size_t)lyr * NPHYS + page) * PAGE + (c & 7) * 16 + row) * 4) * 64 + qd * 16;
#pragma unroll
            for (int kv = 0; kv < 2; ++kv)
#pragma unroll
                for (int k = 0; k < 4; ++k) a[u][kv][k] = *(const f32x4*)(src + kv * 64 + 4 * k);
        }
#pragma unroll
        for (int u = 0; u < 2; ++u) {
            const int row = F.lane >> 2, qd = F.lane & 3;
#pragma unroll
            for (int kv = 0; kv < 2; ++kv) {
                const f32x4 a0 = a[u][kv][0], a1 = a[u][kv][1], a2 = a[u][kv][2], a3 = a[u][kv][3];
                v4u o0, o1; o0.x = pk2(a0.x, a0.y); o0.y = pk2(a0.z, a0.w); o0.z = pk2(a1.x, a1.y); o0.w = pk2(a1.z, a1.w); o1.x = pk2(a2.x, a2.y); o1.y = pk2(a2.z, a2.w); o1.z = pk2(a3.x, a3.y); o1.w = pk2(a3.z, a3.w);
                bf16* dst = WSP(F, bf16, WS_AS) + ((((size_t)(lyrv[u] * 2 + kv) * BS + bv[u]) * 512 + cv[u]) * 1024) + row * 64 + qd * 16;
                *(v4u*)dst = o0; *(v4u*)(dst + 8) = o1;
            }
        }
    }
    {
        const float inv[8] = {1.0f, 0.193922758102417f, 0.03760603070259094f, 0.00729266507551074f, 0.001414213445968926f, 0.00027424818836152554f, 5.318296462064609e-05f, 1.0313385246263351e-05f};
        float* rope = WSP(F, float, WS_ROPE);
        for (int i = blockIdx.x * NTHR + F.tid; i < 2056 * 8; i += F.G * NTHR) {
            const int pi = i >> 3, f = i & 7; const int pos = pi < TP ? pi : PAST + (pi - TP);
            float iv = inv[0];
#pragma unroll
            for (int k = 1; k < 8; ++k) iv = (f == k) ? inv[k] : iv;
            const float ang = (float)pos * iv; float c, s; cossin_d(ang, c, s);
            rope[pi * 16 + f] = c; rope[pi * 16 + 8 + f] = s;
        }
    }
    for (int r = F.gw; r < MROWS; r += F.ngw) norm_row_to_bf16(F, x_in_row(F, r), INP(F, I_NMPRE), WSP(F, bf16, WS_XN) + (size_t)r * DM);
}

typedef float f32x16p __attribute__((ext_vector_type(16)));
__device__ __forceinline__ void phase_cmp_finish(const Frame& F) {
    const float* H = WSP(F, float, WS_HS);
    const int lane = F.lane, r32 = lane & 31, hp = lane >> 5;
    for (int it = F.gw; it < 8 * BS * 16; it += F.ngw) {
        const int i = it >> 9, b = (it >> 4) & 31, n0 = (it & 15) * 32; const int lyr = i >> 1, kv = i & 1;
        const int n = n0 + r32; const int n1 = (n + 1 < 512) ? n + 1 : 511;
        const float* h0 = H + (((size_t)i * BS + b) * 512 + n) * 256; const float* h1 = H + (((size_t)i * BS + b) * 512 + n1) * 256 + 128;
        const float* bias = WSP(F, float, WS_CBIAS) + i * 128;
        const bf16* w2t = WSP(F, bf16, WS_W2T) + (size_t)i * 64 * 128;
        f32x16p acc0, acc1;
#pragma unroll
        for (int k = 0; k < 16; ++k) { acc0[k] = 0.f; acc1[k] = 0.f; }
#pragma unroll
        for (int ks = 0; ks < 8; ++ks) {
            const int e = 16 * ks + 8 * hp;
            const f32x4 a0 = *(const f32x4*)(h0 + e), a1 = *(const f32x4*)(h0 + e + 4), c0 = *(const f32x4*)(h1 + e), c1 = *(const f32x4*)(h1 + e + 4);
            const f32x4 b0 = *(const f32x4*)(bias + e), b1 = *(const f32x4*)(bias + e + 4);
            const f32x4 x0 = a0 + c0 + b0, x1 = a1 + c1 + b1;
            v4u av; av.x = pk2(gelu_tanh(x0.x), gelu_tanh(x0.y)); av.y = pk2(gelu_tanh(x0.z), gelu_tanh(x0.w)); av.z = pk2(gelu_tanh(x1.x), gelu_tanh(x1.y)); av.w = pk2(gelu_tanh(x1.z), gelu_tanh(x1.w));
            const bf16x8 bf0 = *(const bf16x8*)(w2t + (size_t)r32 * 128 + e), bf1 = *(const bf16x8*)(w2t + (size_t)(32 + r32) * 128 + e);
            acc0 = __builtin_amdgcn_mfma_f32_32x32x16_bf16(__builtin_bit_cast(bf16x8, av), bf0, acc0, 0, 0, 0);
            acc1 = __builtin_amdgcn_mfma_f32_32x32x16_bf16(__builtin_bit_cast(bf16x8, av), bf1, acc1, 0, 0, 0);
        }
        float* dst = WSP(F, float, kv ? WS_CVS : WS_CKS) + (((size_t)lyr * BS + b) * NCMP_S) * 64;
#pragma unroll
        for (int k = 0; k < 16; ++k) { const int nn = n0 + (k & 3) + 8 * (k >> 2) + 4 * hp;
            if (nn < NCMP_S) { dst[(size_t)nn * 64 + r32] = acc0[k]; dst[(size_t)nn * 64 + 32 + r32] = acc1[k]; } }
    }
}

__device__ __forceinline__ float rope_lane(float x, int lane, float cs_c, float cs_s) {
    const float other = __shfl_xor(x, 8);
    const float rot = (lane < 8) ? x * cs_c - other * cs_s : x * cs_c + other * cs_s;
    return (lane < 16) ? rot : x;
}
__device__ __forceinline__ void token_prep4(const Frame& F, int l, int r0, const LAS float* pw_lds, LAS float* pl) {
    constexpr int NR = 4;
    int s, t0; row_to_seq(r0, s, t0); const Seq q = seq_of(s);
    const int lane = F.lane;
    const float* spool = INP(F, I_SPOOL) + ((size_t)l * BS + q.b) * POOL_KEEP * POOL_W;
    const float* proj0 = WSP(F, float, WS_PROJ) + (size_t)r0 * PROJ_LD;
    float qx[NR][4], kx[NR][6], csc[NR], css[NR];
#pragma unroll
    for (int u = 0; u < NR; ++u) {
        const float* proj = proj0 + (size_t)u * PROJ_LD; const int t = t0 + u;
        const float* rp = WSP(F, float, WS_ROPE) + (size_t)(q.samp ? TP + t : t) * 16;
#pragma unroll
        for (int j = 0; j < 4; ++j) qx[u][j] = proj[OFF_Q + j * 64 + lane];
#pragma unroll
        for (int j = 0; j < 6; ++j) kx[u][j] = proj[OFF_KV + j * 64 + lane];
        csc[u] = rp[lane & 7]; css[u] = rp[8 + (lane & 7)];
    }
    float e0[2 + 3], e1[4 + 3], e2[8 + 3], e3[16 + 3];
#define LOAD_EXT(EARR, G, W) do { _Pragma("unroll") for (int k = 0; k < (W) + 3; ++k) { const int tt = t0 - ((W) - 1) + k; const int c = (G) * 64 + lane; \
          \
        const float* pa = (tt >= 0) ? proj0 + (long)(tt - t0) * PROJ_LD + OFF_POOL + c : (q.samp ? spool + (POOL_KEEP + tt) * POOL_W + c : proj0 + OFF_POOL + c); \
        const float v = *pa; EARR[k] = (tt >= 0 || q.samp) ? v : 0.f; } } while (0)
    LOAD_EXT(e0, 0, 2); LOAD_EXT(e1, 1, 4); LOAD_EXT(e2, 2, 8); LOAD_EXT(e3, 3, 16);
#undef LOAD_EXT
    float pooled[NR][4], pu[NR][4];
#pragma unroll
    for (int u = 0; u < NR; ++u) {
        const int pos = q.pos0 + t0 + u;
        float s0 = 0.f, s1 = 0.f, s2 = 0.f, s3 = 0.f;
#pragma unroll
        for (int i = 0; i < 2; ++i) s0 += e0[u + i];
#pragma unroll
        for (int i = 0; i < 4; ++i) s1 += e1[u + i];
#pragma unroll
        for (int i = 0; i < 8; ++i) s2 += e2[u + i];
#pragma unroll
        for (int i = 0; i < 16; ++i) s3 += e3[u + i];
        pu[u][0] = e0[u + 1]; pu[u][1] = e1[u + 3]; pu[u][2] = e2[u + 7]; pu[u][3] = e3[u + 15];
        pooled[u][0] = s0 / (float)((pos + 1 < 2) ? pos + 1 : 2) - pu[u][0];
        pooled[u][1] = s1 / (float)((pos + 1 < 4) ? pos + 1 : 4) - pu[u][1];
        pooled[u][2] = s2 / (float)((pos + 1 < 8) ? pos + 1 : 8) - pu[u][2];
        pooled[u][3] = s3 / (float)((pos + 1 < 16) ? pos + 1 : 16) - pu[u][3];
    }
#pragma unroll
    for (int u = 0; u < NR; ++u) {
        const int r = r0 + u, t = t0 + u;
        bf16* qb = WSP(F, bf16, WS_QB) + (size_t)r * 256;
#pragma unroll
        for (int j = 0; j < 4; ++j) qb[j * 64 + lane] = (bf16)f2bf(rope_lane(qx[u][j], lane, csc[u], css[u]) * (0.125f * 1.4426950408889634f));
        float* kvout = q.samp ? F.out + O_KVS + ((size_t)l * NS + (r - NP)) * 256 : F.out + O_KVP + ((size_t)l * NP + r) * 256;
        float* kwin = WSP(F, float, WS_KWIN) + (size_t)r * 128;
#pragma unroll
        for (int j = 0; j < 6; ++j) {
            const float v = (j & 1) ? kx[u][j] : rope_lane(kx[u][j], lane, csc[u], css[u]);
            if (j < 4) kvout[j * 64 + lane] = v;
            else {
                kwin[(j - 4) * 64 + lane] = v;
                if (!q.samp) { if (t >= TP - 512) F.out[O_WINP + (((size_t)l * BP + q.b) * 512 + (t - (TP - 512))) * 128 + (j - 4) * 64 + lane] = v; }
                else F.out[O_WINS + (((size_t)l * BS + q.b) * 512 + 504 + t) * 128 + (j - 4) * 64 + lane] = v;
            }
        }
#pragma unroll
        for (int g = 0; g < 4; ++g) pl[u * 256 + g * 64 + lane] = pooled[u][g];
    }
    asm volatile("s_waitcnt lgkmcnt(0)" ::: "memory");
    const float* psc = INP(F, I_POOLSC) + (size_t)l * POOL_W;
#pragma unroll
    for (int g = 0; g < 4; ++g) {
        float y[NR];
#pragma unroll
        for (int u = 0; u < NR; ++u) y[u] = 0.f;
#pragma unroll 4
        for (int c = 0; c < 64; c += 4) { const LAS float* wv = pw_lds + (g * 64 + c) * 64 + lane;
            const float w0 = wv[0], w1 = wv[64], w2 = wv[128], w3 = wv[192];
#pragma unroll
            for (int u = 0; u < NR; ++u) { const f32x4 pa = *(const LAS f32x4*)(pl + u * 256 + g * 64 + c); y[u] += pa.x * w0 + pa.y * w1 + pa.z * w2 + pa.w * w3; } }
        const float sc = psc[g * 64 + lane];
#pragma unroll
        for (int u = 0; u < NR; ++u) (WSP(F, bf16, WS_MIX) + (size_t)(r0 + u) * DM)[512 + g * 64 + lane] = (bf16)f2bf(y[u] * sc);
    }
    asm volatile("s_waitcnt lgkmcnt(0)" ::: "memory");
#pragma unroll
    for (int u = 0; u < NR; ++u) {
        const int r = r0 + u, t = t0 + u; const float* proj = WSP(F, float, WS_PROJ) + (size_t)r * PROJ_LD;
        if (!q.samp) {
            if (t >= TP - 15) { float* o = F.out + O_POOLP + (((size_t)l * BP + q.b) * 15 + (t - (TP - 15))) * POOL_W;
#pragma unroll
                for (int j = 0; j < 4; ++j) o[j * 64 + lane] = pu[u][j]; }
            if (t >= TP - 3) { float* o = F.out + O_CONVP + (((size_t)l * BP + q.b) * 3 + (t - (TP - 3))) * CONV_DIM;
                for (int j = 0; j < 16; ++j) o[j * 64 + lane] = proj[OFF_XBC + j * 64 + lane]; }
        } else {
            { float* o = F.out + O_POOLS + (((size_t)l * BS + q.b) * 15 + 7 + t) * POOL_W;
#pragma unroll
                for (int j = 0; j < 4; ++j) o[j * 64 + lane] = pu[u][j]; }
            if (t < 7) { float* o = F.out + O_POOLS + (((size_t)l * BS + q.b) * 15 + t) * POOL_W;
#pragma unroll
                for (int j = 0; j < 4; ++j) o[j * 64 + lane] = spool[(8 + t) * POOL_W + j * 64 + lane]; }
            if (t >= TS - 3) { float* o = F.out + O_CONVS + (((size_t)l * BS + q.b) * 3 + (t - (TS - 3))) * CONV_DIM;
                for (int j = 0; j < 16; ++j) o[j * 64 + lane] = proj[OFF_XBC + j * 64 + lane]; }
        }
    }
}

__device__ __forceinline__ float xbc_conv(const Frame& F, int l, const Seq& q, int t, int c) {
    const float* cw = INP(F, I_CONVW) + (size_t)l * 4 * CONV_DIM; const float* cb = INP(F, I_CONVB) + (size_t)l * CONV_DIM;
    const float* proj = WSP(F, float, WS_PROJ);
    const float* sconv = INP(F, I_SCONV) + ((size_t)l * BS + q.b) * 3 * CONV_DIM;
    float acc = cb[c];
#pragma unroll
    for (int k = 0; k < 4; ++k) { const int tt = t - 3 + k; float e = 0.f;
        if (tt >= 0) e = proj[(size_t)(q.row0 + tt) * PROJ_LD + OFF_XBC + c];
        else if (q.samp) e = sconv[(3 + tt) * CONV_DIM + c];
        acc += e * cw[k * CONV_DIM + c]; }
    return siluf_(acc);
}
__device__ __forceinline__ void ssd_item(const Frame& F, int l, int s, int h) {
    const Seq q = seq_of(s);
    constexpr int TSTG = 16;
    LAS float* xs = (LAS float*)F.lds;
    LAS float* Bs = xs + TSTG * 64;
    LAS float* Cs = Bs + TSTG * 128;
    LAS float* dts = Cs + TSTG * 128;
    LAS float* dAs = dts + TSTG;
    const int tid = F.tid, p = tid >> 3, nq = tid & 7, g = h >> 2;
    const float a = -expf(INP(F, I_ALOG)[l * SSD_H + h]), dtb = INP(F, I_DTB)[l * SSD_H + h], dsk = INP(F, I_SSDD)[l * SSD_H + h];
    float st[16];
    if (q.samp) { const float* s0 = INP(F, I_SSM) + ((((size_t)l * BS + q.b) * SSD_H + h) * SSD_HD + p) * SSD_N + nq * 16;
#pragma unroll
        for (int i = 0; i < 16; ++i) st[i] = s0[i]; }
    else {
#pragma unroll
        for (int i = 0; i < 16; ++i) st[i] = 0.f; }
    const float* proj = WSP(F, float, WS_PROJ);
    float* yssd = WSP(F, float, WS_YSSD);
    for (int t0 = 0; t0 < q.T; t0 += TSTG) {
        const int nt = (q.T - t0 < TSTG) ? q.T - t0 : TSTG;
        __syncthreads();
        for (int i = tid; i < nt * 320; i += NTHR) { const int tt = i / 320, c = i % 320; const int t = t0 + tt;
            if (c < 64) xs[tt * 64 + c] = xbc_conv(F, l, q, t, h * 64 + c);
            else if (c < 192) Bs[tt * 128 + (c - 64)] = xbc_conv(F, l, q, t, 512 + g * 128 + (c - 64));
            else Cs[tt * 128 + (c - 192)] = xbc_conv(F, l, q, t, 768 + g * 128 + (c - 192)); }
        if (tid < nt) { const float dt = softplusf_(proj[(size_t)(q.row0 + t0 + tid) * PROJ_LD + OFF_DT + h] + dtb); dts[tid] = dt; dAs[tid] = expf(dt * a); }
        __syncthreads();
        for (int tt = 0; tt < nt; ++tt) {
            const float dt = dts[tt], dA = dAs[tt], x = xs[tt * 64 + p], xd = x * dt;
            float y = 0.f;
#pragma unroll
            for (int i = 0; i < 16; ++i) { st[i] = st[i] * dA + xd * Bs[tt * 128 + nq * 16 + i]; y += st[i] * Cs[tt * 128 + nq * 16 + i]; }
            y += __shfl_xor(y, 1); y += __shfl_xor(y, 2); y += __shfl_xor(y, 4);
            if (nq == 0) yssd[(size_t)(q.row0 + t0 + tt) * SSD_W + h * 64 + p] = y + dsk * x;
        }
    }
    float* so = q.samp ? F.out + O_SSMS + ((((size_t)l * BS + q.b) * SSD_H + h) * SSD_HD + p) * SSD_N + nq * 16
                       : F.out + O_SSMP + ((((size_t)l * BP + q.b) * SSD_H + h) * SSD_HD + p) * SSD_N + nq * 16;
#pragma unroll
    for (int i = 0; i < 16; ++i) so[i] = st[i];
    __syncthreads();
}
__device__ __forceinline__ void ssd_chunk_unit(const Frame& F, int l, int b, int c, int g);
__device__ __forceinline__ void ssd_scan(const Frame& F, int l);
__device__ __forceinline__ void ssd_out_unit(const Frame& F, int l, int b, int hc);
__device__ __forceinline__ void phase_prep(const Frame& F, int l) {
    for (int u = blockIdx.x; u < BP * 16 * 2; u += F.G) ssd_chunk_unit(F, l, u >> 5, (u >> 1) & 15, u & 1);
    for (int it = BP * SSD_H + blockIdx.x; it < NSEQ * SSD_H; it += F.G) ssd_item(F, l, it >> 3, it & 7);
    {
        __syncthreads();
        LAS float* pw_lds = (LAS float*)F.lds; const float* pw = INP(F, I_POOLW) + (size_t)l * 4 * 64 * 64;
        for (int i = F.tid; i < 4 * 64 * 64 / 4; i += NTHR) *(LAS f32x4*)(pw_lds + i * 4) = *(const f32x4*)(pw + i * 4);
        __syncthreads();
        LAS float* pl = (LAS float*)(F.lds + 65536) + F.wave * 1024;
        for (int rp = F.gw; rp < MROWS / 4; rp += F.ngw) token_prep4(F, l, 4 * rp, pw_lds, pl);
        __syncthreads();
    }
    {
        const f32x4* src = (const f32x4*)(INP(F, I_SWIN) + (size_t)l * BS * 512 * 128);
        f32x4* dst = (f32x4*)(F.out + O_WINS + (size_t)l * BS * 512 * 128);
        const int nth = F.G * NTHR, i0 = blockIdx.x * NTHR + F.tid;
        f32x4 v[4]; size_t o[4]; bool ok[4];
#pragma unroll
        for (int k = 0; k < 4; ++k) { const int i = i0 + k * nth; ok[k] = i < BS * 504 * 32; const int ic = ok[k] ? i : 0; const int b = ic / (504 * 32), rem = ic % (504 * 32);
            o[k] = (size_t)b * 512 * 32 + rem; v[k] = src[o[k] + 8 * 32]; }
#pragma unroll
        for (int k = 0; k < 4; ++k) if (ok[k]) dst[o[k]] = v[k];
        for (int i = i0 + 4 * nth; i < BS * 504 * 32; i += nth) { const int b = i / (504 * 32), rem = i % (504 * 32);
            dst[(size_t)b * 512 * 32 + rem] = src[(size_t)b * 512 * 32 + 8 * 32 + rem]; }
    }
}

__device__ __forceinline__ const float* kv_row(const Frame& F, int l, const Seq& q, int tok, int kind) {
    if (!q.samp) return F.out + O_KVP + ((size_t)l * NP + q.row0 + tok) * 256 + kind * 64;
    if (tok >= PAST) return F.out + O_KVS + ((size_t)l * NS + (q.row0 - NP) + (tok - PAST)) * 256 + kind * 64;
    const int page = ((const int*)INP(F, I_PT))[q.b * NPAGES + (tok >> 7)];
    return INP(F, I_CACHE) + ((((size_t)l * NPHYS + page) * PAGE + (tok & 127)) * 4 + kind) * 64;
}
typedef float f32x4c __attribute__((ext_vector_type(4)));
__device__ __forceinline__ void compress_item(const Frame& F, int l, int s, int grp, int kv) {
    const Seq q = seq_of(s);
    const int ncmp = NCMP_P;
    const int n0 = grp * 16; const int nb = (ncmp - n0 < 16) ? ncmp - n0 : 16;
    constexpr int CST = 2064;
    LAS unsigned char* rows = F.lds;
    LAS float* hid = (LAS float*)(F.lds + 36864);
    const int tid = F.tid, lane = F.lane, wave = F.wave;
    __syncthreads();
    for (int i = tid; i < 17 * 16 * 8; i += NTHR) { const int rr = i >> 3, dc = i & 7; const int tok = n0 * 16 + rr;
        v4u o = (v4u){0u, 0u, 0u, 0u};
        if (tok < TP) { const float* p = kv_row(F, l, q, tok, kv) + dc * 8; const f32x4 a = *(const f32x4*)p, b = *(const f32x4*)(p + 4);
            o.x = pk2(a.x, a.y); o.y = pk2(a.z, a.w); o.z = pk2(b.x, b.y); o.w = pk2(b.z, b.w); }
        *(LAS v4u*)(rows + (rr >> 4) * CST + (rr & 15) * 128 + dc * 16) = o; }
    __syncthreads();
    const int i2 = l * 2 + kv;
    const bf16* wt = WSP(F, bf16, WS_WTC) + (size_t)i2 * 256 * 1024;
    const int e = 16 * wave + (lane & 15), kq = lane >> 4, blk = lane & 15;
    f32x4c acc = (f32x4c){0.f, 0.f, 0.f, 0.f};
#pragma unroll 8
    for (int ks = 0; ks < 64; ++ks) {
        const int half = ks >> 5, kk = (ks & 31) * 32 + 8 * kq;
        const bf16x8 bfrag = *(const bf16x8*)(wt + (size_t)(half * 128 + e) * 1024 + kk);
        const bf16x8 afrag = *(const LAS bf16x8*)(rows + (blk + half) * CST + kk * 2);
        acc = __builtin_amdgcn_mfma_f32_16x16x32_bf16(afrag, bfrag, acc, 0, 0, 0);
    }
    { const float bias = WSP(F, float, WS_CBIAS)[i2 * 128 + e];
#pragma unroll
      for (int k = 0; k < 4; ++k) hid[(kq * 4 + k) * 128 + e] = gelu_tanh(acc[k] + bias); }
    __syncthreads();
    const float* w2 = INP(F, kv ? I_W2V : I_W2K) + (size_t)l * 128 * 64;
    float* dst = WSP(F, float, kv ? WS_CVP : WS_CKP) + (size_t)q.b * NCMP_P * 64;
    { const int bi = tid >> 5, d0 = (tid & 31) * 2;
        if (bi < nb) { float o0 = 0.f, o1 = 0.f;
#pragma unroll 8
            for (int k = 0; k < 128; ++k) { const float hv = hid[bi * 128 + k]; o0 += hv * w2[k * 64 + d0]; o1 += hv * w2[k * 64 + d0 + 1]; }
            dst[(size_t)(n0 + bi) * 64 + d0] = o0; dst[(size_t)(n0 + bi) * 64 + d0 + 1] = o1; } }
    __syncthreads();
}
__device__ __forceinline__ void attn_sample_unit(const Frame& F, int l, int b, int t0);
__device__ __forceinline__ void phase_compress(const Frame& F, int l) {
    constexpr int NI_P = BP * 8 * 2;
    for (int it = blockIdx.x; it < NI_P; it += F.G) compress_item(F, l, it >> 4, (it >> 1) & 7, it & 1);
    ssd_scan(F, l);
    { Frame G2 = F; { int ln = G2.lane; asm volatile("" : "+v"(ln)); G2.lane = ln; G2.tid = G2.wave * 64 + ln; }
      for (int u = blockIdx.x; u < NS; u += F.G) attn_sample_unit(G2, l, u >> 3, u & 7); }
}

__device__ __forceinline__ void osm_step(float sc, const f32x4 v, float& m, float& lsum, f32x4& o) {
    const float mn = fmaxf(m, sc); const float al = expf(m - mn), pp = expf(sc - mn);
    lsum = lsum * al + pp; o = o * al + v * pp; m = mn;
}
__device__ __forceinline__ void nsa_token(const Frame& F, int l, int r) {
    int s, t; row_to_seq(r, s, t); const Seq q = seq_of(s);
    const int lane = F.lane, hh = lane >> 4, sub = lane & 15;
    const int tpos = q.pos0 + t;
    LAS float* sc = (LAS float*)(F.lds + F.wave * 12288);
    LAS float* impv = sc + 2048;
    LAS int* sel = (LAS int*)(impv + 192);
    const f32x4 qv = *(const f32x4*)(WSP(F, float, WS_Q) + (size_t)r * 256 + hh * 64 + sub * 4);
    const int ncmp = q.samp ? NCMP_S : NCMP_P;
    const float* ck = q.samp ? WSP(F, float, WS_CKS) + (size_t)q.b * NCMP_S * 64 : WSP(F, float, WS_CKP) + (size_t)q.b * NCMP_P * 64;
    const float* cv = q.samp ? WSP(F, float, WS_CVS) + (size_t)q.b * NCMP_S * 64 : WSP(F, float, WS_CVP) + (size_t)q.b * NCMP_P * 64;
    int nvis = 0; if (tpos >= 31) { nvis = (tpos - 31) / 16 + 1; if (nvis > ncmp) nvis = ncmp; }
    float mx = -INFINITY;
    for (int n = 0; n < nvis; ++n) { const f32x4 kk = *(const f32x4*)(ck + (size_t)n * 64 + sub * 4);
        const float d = sum16(qv.x * kk.x + qv.y * kk.y + qv.z * kk.z + qv.w * kk.w);
        if (sub == 0) sc[hh * 512 + n] = d; mx = fmaxf(mx, d); }
    asm volatile("s_waitcnt lgkmcnt(0)" ::: "memory");
    float ls = 0.f;
    for (int n = sub; n < nvis; n += 16) { const float e = expf(sc[hh * 512 + n] - mx); sc[hh * 512 + n] = e; ls += e; }
    ls = sum16(ls);
    const float rl = ls > 0.f ? 1.f / ls : 0.f;
    for (int n = sub; n < nvis; n += 16) sc[hh * 512 + n] *= rl;
    asm volatile("s_waitcnt lgkmcnt(0)" ::: "memory");
    f32x4 ocmp = (f32x4){0.f, 0.f, 0.f, 0.f};
    for (int n = 0; n < nvis; ++n) { const float pp = sc[hh * 512 + n]; ocmp += *(const f32x4*)(cv + (size_t)n * 64 + sub * 4) * pp; }
    const int nslc = q.samp ? 129 : 32, cur = tpos >> 6;
    for (int j = lane; j < nslc; j += 64) {
        float v;
        if (j > cur) v = -INFINITY;
        else if (j == 0 || j == cur || j == cur - 1) v = INFINITY;
        else { v = 0.f;
            for (int n = 4 * j - 1; n <= 4 * j + 3; ++n) if (n >= 0 && n < nvis) v += (sc[n] + sc[512 + n]) + (sc[1024 + n] + sc[1536 + n]); }
        impv[j] = v;
    }
    asm volatile("s_waitcnt lgkmcnt(0)" ::: "memory");
    int nsel = 0;
    for (int j0 = 0; j0 < nslc; j0 += 64) {
        const int j = j0 + lane; bool selj = false;
        if (j < nslc) { const float vj = impv[j]; int rank = 0;
            for (int k = 0; k < nslc; ++k) { const float vk = impv[k]; rank += (vk > vj || (vk == vj && k < j)) ? 1 : 0; }
            selj = (rank < 16) && (j <= cur); }
        const unsigned long long bal = __ballot(selj);
        if (selj) sel[nsel + __popcll(bal & ((1ull << lane) - 1ull))] = j;
        nsel += __popcll(bal);
    }
    asm volatile("s_waitcnt lgkmcnt(0)" ::: "memory");
    float m2 = -INFINITY, l2 = 0.f; f32x4 o2 = (f32x4){0.f, 0.f, 0.f, 0.f};
    for (int si = 0; si < nsel; ++si) {
        const int j = sel[si]; int ntok = tpos - 64 * j + 1; if (ntok > 64) ntok = 64;
        for (int i = 0; i < ntok; ++i) { const int tok = 64 * j + i;
            const float* kr = kv_row(F, l, q, tok, 2);
            const f32x4 kk = *(const f32x4*)(kr + sub * 4); const f32x4 vv = *(const f32x4*)(kr + 64 + sub * 4);
            const float d = sum16(qv.x * kk.x + qv.y * kk.y + qv.z * kk.z + qv.w * kk.w);
            osm_step(d, vv, m2, l2, o2); }
    }
    float m3 = -INFINITY, l3 = 0.f; f32x4 o3 = (f32x4){0.f, 0.f, 0.f, 0.f};
    {
        int k0 = tpos - 511; if (k0 < 0) k0 = 0;
        const float* swin = INP(F, I_SWIN) + ((size_t)l * BS + q.b) * 512 * 128;
        const float* kwin = WSP(F, float, WS_KWIN);
        for (int kp = k0; kp <= tpos; ++kp) {
            const float* kr;
            if (!q.samp) kr = kwin + (size_t)(q.row0 + kp) * 128;
            else if (kp >= PAST) kr = kwin + (size_t)(q.row0 + kp - PAST) * 128;
            else kr = swin + (size_t)(kp - (PAST - 512)) * 128;
            const f32x4 kk = *(const f32x4*)(kr + sub * 4); const f32x4 vv = *(const f32x4*)(kr + 64 + sub * 4);
            const float d = sum16(qv.x * kk.x + qv.y * kk.y + qv.z * kk.z + qv.w * kk.w);
            osm_step(d, vv, m3, l3, o3); }
    }
    const float* gp = WSP(F, float, WS_PROJ) + (size_t)r * PROJ_LD + OFF_G + hh * 3;
    const float g0 = sigmoidf_(gp[0]), g1 = sigmoidf_(gp[1]), g2 = sigmoidf_(gp[2]);
    const float r2 = l2 > 0.f ? 1.f / l2 : 0.f, r3 = l3 > 0.f ? 1.f / l3 : 0.f;
    const f32x4 y = ocmp * g0 + o2 * (g1 * r2) + o3 * (g2 * r3);
    unsigned long long* mo = (unsigned long long*)(WSP(F, bf16, WS_MIX) + (size_t)r * DM + 768 + hh * 64 + sub * 4);
    *mo = (unsigned long long)pk2(y.x, y.y) | ((unsigned long long)pk2(y.z, y.w) << 32);
}
__device__ __forceinline__ void ssd_finish_token(const Frame& F, int l, int r) {
    const float* y = WSP(F, float, WS_YSSD) + (size_t)r * SSD_W; const float* z = WSP(F, float, WS_PROJ) + (size_t)r * PROJ_LD;
    const float* nw = INP(F, I_SSDNORM) + (size_t)l * SSD_W;
    float v[8]; float ss = 0.f;
#pragma unroll
    for (int j = 0; j < 8; ++j) { const int c = j * 64 + F.lane; v[j] = y[c] * siluf_(z[c]); ss += v[j] * v[j]; }
    const float rs = 1.f / sqrtf(wave_sum(ss) * (1.f / SSD_W) + RMS_EPS);
    bf16* mix = WSP(F, bf16, WS_MIX) + (size_t)r * DM;
#pragma unroll
    for (int j = 0; j < 8; ++j) { const int c = j * 64 + F.lane; mix[c] = (bf16)f2bf(v[j] * rs * nw[c]); }
}
__device__ __forceinline__ void phase_attn(const Frame& F, int l) {
    for (int r = F.gw; r < MROWS; r += F.ngw) { nsa_token(F, l, r); ssd_finish_token(F, l, r); }
}


typedef short bf16x8 __attribute__((ext_vector_type(8)));
typedef float f32x16 __attribute__((ext_vector_type(16)));
typedef float f32x2_t __attribute__((ext_vector_type(2))); typedef __bf16 bf16x2_t __attribute__((ext_vector_type(2)));
__device__ __forceinline__ unsigned cvtpk(float lo, float hi) { f32x2_t v = {lo, hi}; bf16x2_t b = __builtin_convertvector(v, bf16x2_t); return __builtin_bit_cast(unsigned, b); }
__device__ __forceinline__ float half_sum(float v) { auto rr = __builtin_amdgcn_permlane32_swap(__float_as_uint(v), __float_as_uint(v), false, false); return __uint_as_float(rr[0]) + __uint_as_float(rr[1]); }
__device__ __forceinline__ float half_max(float v) { auto rr = __builtin_amdgcn_permlane32_swap(__float_as_uint(v), __float_as_uint(v), false, false); return fmaxf(__uint_as_float(rr[0]), __uint_as_float(rr[1])); }

constexpr float QSCALE_B = 0.125f * 1.4426950408889634f;
constexpr int AT_K = 0, AT_V = 16384, AT_IMPG = 32768, AT_IMPE = AT_IMPG + 8192, AT_SEL = AT_IMPE + 8192, AT_UNI = AT_SEL + 2048, AT_LIST = AT_UNI + 64, AT_NLIST = AT_LIST + 768,
              AT_PAGE = AT_NLIST + 64, AT_RANK = AT_PAGE + 768, AT_OUT = AT_RANK + 8 * 1024, AT_END = AT_OUT + 8 * 8192;
static_assert(AT_END <= RING_BYTES, "attention LDS map");
enum { KIND_CMP1 = 0, KIND_CMP2 = 1, KIND_SLC = 2, KIND_WIN = 3 };

struct TileRegs { f32x4 k0, k1, v0, v1; };
__device__ __forceinline__ void tile_load(const Frame& F, int l, const Seq& q, int kind, int tile, int pg, TileRegs& R) {
    int t_ = F.tid; asm volatile("" : "+v"(t_));
    const int key = tile * 64 + (t_ >> 3), dc = t_ & 7;
    const float* kr = nullptr; const float* vr = nullptr;
    if (kind <= KIND_CMP2) {
        const int ncmp = q.samp ? NCMP_S : NCMP_P;
        if (key < ncmp) {
            kr = (q.samp ? WSP(F, float, WS_CKS) + ((size_t)l * BS + q.b) * NCMP_S * 64 : WSP(F, float, WS_CKP) + (size_t)q.b * NCMP_P * 64) + (size_t)key * 64;
            vr = (q.samp ? WSP(F, float, WS_CVS) + ((size_t)l * BS + q.b) * NCMP_S * 64 : WSP(F, float, WS_CVP) + (size_t)q.b * NCMP_P * 64) + (size_t)key * 64; }
    } else if (kind == KIND_SLC) {
        if (key < q.pos0 + q.T) {
            if (!q.samp) kr = F.out + O_KVP + ((size_t)l * NP + q.row0 + key) * 256 + 2 * 64;
            else if (key < PAST) kr = INP(F, I_CACHE) + ((((size_t)l * NPHYS + pg) * PAGE + (key & 127)) * 4 + 2) * 64;
            else kr = F.out + O_KVS + ((size_t)l * NS + (q.row0 - NP) + (key - PAST)) * 256 + 2 * 64;
            vr = kr + 64; }
    } else {
        if (key < q.pos0 + q.T) {
            if (!q.samp) kr = WSP(F, float, WS_KWIN) + (size_t)(q.row0 + key) * 128;
            else if (key >= PAST) kr = WSP(F, float, WS_KWIN) + (size_t)(q.row0 + key - PAST) * 128;
            else if (key >= PAST - 512) kr = INP(F, I_SWIN) + (((size_t)l * BS + q.b) * 512 + (key - (PAST - 512))) * 128;
            if (kr) vr = kr + 64; }
    }
    const f32x4 z = (f32x4){0.f, 0.f, 0.f, 0.f};
    if (kr) { R.k0 = *(const f32x4*)(kr + dc * 8); R.k1 = *(const f32x4*)(kr + dc * 8 + 4); R.v0 = *(const f32x4*)(vr + dc * 8); R.v1 = *(const f32x4*)(vr + dc * 8 + 4); }
    else { R.k0 = z; R.k1 = z; R.v0 = z; R.v1 = z; }
}
__device__ __forceinline__ void tile_store(const Frame& F, LAS unsigned char* kb, LAS unsigned char* vb, const TileRegs& R) {
    int t_ = F.tid; asm volatile("" : "+v"(t_));
    const int key = t_ >> 3, dc = t_ & 7;
    v4u kk; kk.x = cvtpk(R.k0.x, R.k0.y); kk.y = cvtpk(R.k0.z, R.k0.w); kk.z = cvtpk(R.k1.x, R.k1.y); kk.w = cvtpk(R.k1.z, R.k1.w);
    *(LAS v4u*)(kb + key * 128 + ((dc ^ (key & 7)) << 4)) = kk;
    const float vv[8] = {R.v0.x, R.v0.y, R.v0.z, R.v0.w, R.v1.x, R.v1.y, R.v1.z, R.v1.w};
#pragma unroll
    for (int i = 0; i < 8; ++i) { const int d = dc * 8 + i; const int ch = (key >> 2) ^ ((d >> 1) & 15);
        *(LAS unsigned short*)(vb + d * 128 + ch * 8 + (key & 3) * 2) = (unsigned short)f2bf(vv[i]); }
}
__device__ __forceinline__ void qk_tile(const LAS unsigned char* kb, const bf16x8 (&qf)[4], f32x16& s0, f32x16& s1, int lane, float init = 0.f) {
    const int r = lane & 31, h = lane >> 5;
#pragma unroll
    for (int i = 0; i < 16; ++i) { s0[i] = init; s1[i] = init; }
#pragma unroll
    for (int ks = 0; ks < 4; ++ks) {
        const bf16x8 a0 = *(const LAS bf16x8*)(kb + r * 128 + (((2 * ks + h) ^ (r & 7)) << 4));
        const bf16x8 a1 = *(const LAS bf16x8*)(kb + (32 + r) * 128 + (((2 * ks + h) ^ (r & 7)) << 4));
        s0 = __builtin_amdgcn_mfma_f32_32x32x16_bf16(a0, qf[ks], s0, 0, 0, 0);
        s1 = __builtin_amdgcn_mfma_f32_32x32x16_bf16(a1, qf[ks], s1, 0, 0, 0);
    }
}
__device__ __forceinline__ void mask_tile(f32x16& s0, f32x16& s1, int kbase, int lo, int hi) {
#pragma unroll
    for (int i = 0; i < 16; ++i) { const int k = kbase + (i & 3) + 8 * (i >> 2);
        if (k < lo || k > hi) s0[i] = -INFINITY;
        if (k + 32 < lo || k + 32 > hi) s1[i] = -INFINITY; }
}
__device__ __forceinline__ float max3_(float x, float y, float z) { float r; asm("v_max3_f32 %0, %1, %2, %3" : "=v"(r) : "v"(x), "v"(y), "v"(z)); return r; }
__device__ __forceinline__ float tile_max(const f32x16& s0, const f32x16& s1) {
    float a = max3_(s0[0], s0[1], s0[2]), b = max3_(s1[0], s1[1], s1[2]);
#pragma unroll
    for (int i = 3; i < 15; i += 2) { a = max3_(a, s0[i], s0[i + 1]); b = max3_(b, s1[i], s1[i + 1]); }
    return half_max(max3_(a, b, fmaxf(s0[15], s1[15])));
}
__device__ __forceinline__ void pv_tile(const LAS unsigned char* vb, const f32x16& s0, const f32x16& s1, f32x16 (&O)[2], int lane) {
    const int r = lane & 31, h = lane >> 5;
    bf16x8 pf[2][2];
#pragma unroll
    for (int sp = 0; sp < 2; ++sp) {
        v4u a; a.x = cvtpk(s0[8 * sp + 0], s0[8 * sp + 1]); a.y = cvtpk(s0[8 * sp + 2], s0[8 * sp + 3]); a.z = cvtpk(s0[8 * sp + 4], s0[8 * sp + 5]); a.w = cvtpk(s0[8 * sp + 6], s0[8 * sp + 7]);
        v4u b; b.x = cvtpk(s1[8 * sp + 0], s1[8 * sp + 1]); b.y = cvtpk(s1[8 * sp + 2], s1[8 * sp + 3]); b.z = cvtpk(s1[8 * sp + 4], s1[8 * sp + 5]); b.w = cvtpk(s1[8 * sp + 6], s1[8 * sp + 7]);
        pf[0][sp] = __builtin_bit_cast(bf16x8, a); pf[1][sp] = __builtin_bit_cast(bf16x8, b);
    }
#pragma unroll
    for (int dh = 0; dh < 2; ++dh) {
        const int d = dh * 32 + r, sw = (d >> 1) & 15; const LAS unsigned char* rb = vb + d * 128;
#pragma unroll
        for (int kh = 0; kh < 2; ++kh)
#pragma unroll
            for (int sp = 0; sp < 2; ++sp) {
                const int q0 = kh * 8 + 4 * sp + h;
                const unsigned long long lo8 = *(const LAS unsigned long long*)(rb + ((q0 ^ sw) << 3));
                const unsigned long long hi8 = *(const LAS unsigned long long*)(rb + (((q0 + 2) ^ sw) << 3));
                v4u av; av.x = (unsigned)lo8; av.y = (unsigned)(lo8 >> 32); av.z = (unsigned)hi8; av.w = (unsigned)(hi8 >> 32);
                O[dh] = __builtin_amdgcn_mfma_f32_32x32x16_bf16(__builtin_bit_cast(bf16x8, av), pf[kh][sp], O[dh], 0, 0, 0);
            }
        __builtin_amdgcn_sched_barrier(0);
    }
}

__device__ __forceinline__ void attn_unit(const Frame& F, int l, int s, int t0, int ntok) {
    const Seq q = seq_of(s);
    int lane_ = F.lane; asm volatile("" : "+v"(lane_));
    int wave_ = F.wave; asm volatile("" : "+s"(wave_));
    const int lane = lane_, wave = wave_, tid = wave * 64 + lane, h = lane >> 5;
    LAS unsigned char* lds = F.lds;
    LAS float* impG = (LAS float*)(lds + AT_IMPG); LAS float* impE = (LAS float*)(lds + AT_IMPE);
    LAS unsigned* selw = (LAS unsigned*)(lds + AT_SEL);
    LAS unsigned* uni = (LAS unsigned*)(lds + AT_UNI);
    LAS int* list = (LAS int*)(lds + AT_LIST);
    LAS int* nlist = (LAS int*)(lds + AT_NLIST);
    LAS int* lpage = (LAS int*)(lds + AT_PAGE);
    LAS float* rankv = (LAS float*)(lds + AT_RANK + wave * 1024);
    const int nslc = q.samp ? 129 : 32, njs = q.samp ? 128 : 32;
    const int ncmp = q.samp ? NCMP_S : NCMP_P;
    const int tl = wave * 8 + ((lane & 31) >> 2), head = lane & 3;
    const bool vcol = tl < ntok; const bool wact = (wave * 8) < ntok;
    const int tlc = vcol ? tl : 0;
    const int r = q.row0 + t0 + tlc, tpos = q.pos0 + t0 + tlc;
    int nvis = 0; if (vcol && tpos >= 31) { nvis = (tpos - 31) / 16 + 1; if (nvis > ncmp) nvis = ncmp; }
    const int tpos_last = q.pos0 + t0 + ntok - 1;
    int nvis_max = 0; if (tpos_last >= 31) { nvis_max = (tpos_last - 31) / 16 + 1; if (nvis_max > ncmp) nvis_max = ncmp; }
    const int nct = (nvis_max + 63) >> 6;
    bf16x8 qf[4];
    { const bf16* qb = WSP(F, bf16, WS_QB) + ((size_t)r * 4 + head) * 64;
#pragma unroll
      for (int ks = 0; ks < 4; ++ks) qf[ks] = *(const bf16x8*)(qb + 16 * ks + 8 * h); }
    const float* gp = WSP(F, float, WS_PROJ) + (size_t)r * PROJ_LD + OFF_G + head * 3;
    const float g0 = sigmoidf_(gp[0]), g1 = sigmoidf_(gp[1]), g2 = sigmoidf_(gp[2]);
#define GATE(k) sigmoidf_((WSP(F, float, WS_PROJ) + (size_t)r * PROJ_LD + OFF_G + head * 3)[(k)])
    f32x16 O[2];
    LAS float* outl = (LAS float*)(lds + AT_OUT + wave * 8192) + lane;
#pragma unroll
    for (int i = 0; i < 16; ++i) { O[0][i] = 0.f; O[1][i] = 0.f; }
    float m = -1e30f, lsum = 0.f, rinv = 0.f;

    __syncthreads();
    if (tid < 2 * nct) list[tid] = (tid < nct ? KIND_CMP1 : KIND_CMP2) | ((tid < nct ? tid : tid - nct) << 4);
    for (int i = tid; i < 64 * 8; i += NTHR) selw[i] = 0u;
    __syncthreads();
    {
        const int n = 2 * nct; TileRegs R;
        if (n > 0) tile_load(F, l, q, KIND_CMP1, 0, 0, R);
        for (int i = 0; i < n; ++i) {
            LAS unsigned char* kb = lds + AT_K + (i & 1) * 8192; LAS unsigned char* vb = lds + AT_V + (i & 1) * 8192;
            tile_store(F, kb, vb, R);
            const int e = __builtin_amdgcn_readfirstlane(list[i]); const int kind = e & 15, tile = e >> 4;
            if (i + 1 < n) { const int e2 = __builtin_amdgcn_readfirstlane(list[i + 1]); tile_load(F, l, q, e2 & 15, e2 >> 4, 0, R); }
            __syncthreads();
            if (wact) {
                if (i == nct) { const float L = half_sum(lsum); rinv = L > 0.f ? 1.f / L : 0.f; }
                f32x16 s0, s1; qk_tile(kb, qf, s0, s1, lane);
                mask_tile(s0, s1, tile * 64 + 4 * h, 0, nvis - 1);
                if (kind == KIND_CMP1) {
                    const float mt = tile_max(s0, s1); const float mn = fmaxf(m, mt); const float al = __builtin_amdgcn_exp2f(m - mn);
                    float rs = 0.f;
#pragma unroll
                    for (int k = 0; k < 16; ++k) rs += __builtin_amdgcn_exp2f(s0[k] - mn) + __builtin_amdgcn_exp2f(s1[k] - mn);
                    lsum = lsum * al + rs; m = mn;
                } else {
#pragma unroll
                    for (int k = 0; k < 16; ++k) { s0[k] = __builtin_amdgcn_exp2f(s0[k] - m) * rinv; s1[k] = __builtin_amdgcn_exp2f(s1[k] - m) * rinv; }
                    pv_tile(vb, s0, s1, O, lane);
#pragma unroll
                    for (int kh = 0; kh < 2; ++kh)
#pragma unroll
                        for (int gq = 0; gq < 4; ++gq) {
                            const f32x16& sv = kh ? s1 : s0;
                            float G = (sv[4 * gq] + sv[4 * gq + 1]) + (sv[4 * gq + 2] + sv[4 * gq + 3]), E = sv[4 * gq + 3];
                            G += __shfl_xor(G, 1); G += __shfl_xor(G, 2); E += __shfl_xor(E, 1); E += __shfl_xor(E, 2);
                            const int j = 16 * tile + 8 * kh + 2 * gq + h;
                            if (head == 0 && vcol && j < njs) { impG[tl * njs + j] = G; impE[tl * njs + j] = E; }
                        }
                }
            }
        }
    }
    const float g0v = GATE(0);
#pragma unroll
    for (int i = 0; i < 16; ++i) { outl[i * 64] = O[0][i] * g0v; outl[(16 + i) * 64] = O[1][i] * g0v; O[0][i] = 0.f; O[1][i] = 0.f; }
    m = 0.f; lsum = 0.f;
    bool started = false;
    asm volatile("s_waitcnt lgkmcnt(0)" ::: "memory");
    if (wact) {
        const int ntw = (ntok - wave * 8 < 8) ? ntok - wave * 8 : 8;
        for (int tt = 0; tt < ntw; ++tt) {
            const int tk = wave * 8 + tt; const int tp = q.pos0 + t0 + tk; const int cur = tp >> 6;
            int nv = 0; if (tp >= 31) { nv = (tp - 31) / 16 + 1; if (nv > ncmp) nv = ncmp; }
            const int jcov = (nv + 3) >> 2;
            for (int j = lane; j < nslc; j += 64) {
                float v;
                if (j > cur) v = -INFINITY;
                else if (j == 0 || j == cur || j == cur - 1) v = INFINITY;
                else { v = 0.f; if (j < jcov) v += impG[tk * njs + j]; if (j - 1 < jcov) v += impE[tk * njs + j - 1]; }
                rankv[j] = v;
            }
            asm volatile("s_waitcnt lgkmcnt(0)" ::: "memory");
            for (int j0 = 0; j0 < nslc; j0 += 64) {
                const int j = j0 + lane; bool selj = false;
                if (j < nslc) { const float vj = rankv[j]; int rank = 0;
                    for (int k = 0; k < nslc; ++k) { const float vk = rankv[k]; rank += (vk > vj || (vk == vj && k < j)) ? 1 : 0; }
                    selj = (rank < 16) && (j <= cur); }
                const unsigned long long bal = __ballot(selj);
                if (lane == 0) { selw[tk * 8 + (j0 >> 5)] = (unsigned)bal; selw[tk * 8 + (j0 >> 5) + 1] = (unsigned)(bal >> 32); }
            }
            asm volatile("s_waitcnt lgkmcnt(0)" ::: "memory");
        }
    }
    __syncthreads();
    if (tid < 8) { unsigned u = 0u; for (int k = 0; k < ntok; ++k) u |= selw[k * 8 + tid]; uni[tid] = u; }
    __syncthreads();
    if (wave == 0) {
        int n = 0;
        for (int j0 = 0; j0 < nslc; j0 += 64) {
            const int j = j0 + lane; const bool sj = (j < nslc) && ((uni[j >> 5] >> (j & 31)) & 1u);
            int pg = 0; if (sj && q.samp && j * 64 < PAST) pg = ((const int*)INP(F, I_PT))[q.b * NPAGES + (j >> 1)];
            const unsigned long long bal = __ballot(sj);
            if (sj) { const int idx = n + __popcll(bal & ((1ull << lane) - 1ull)); list[idx] = KIND_SLC | (j << 4); lpage[idx] = pg; }
            n += __popcll(bal);
        }
        const int p0 = q.pos0 + t0; int w0 = (p0 - 511) >> 6; if (w0 < 0) w0 = 0; if (q.samp && w0 < (PAST - 512) / 64) w0 = (PAST - 512) / 64;
        const int w1 = (p0 + ntok - 1) >> 6;
        if (lane <= w1 - w0) { list[n + lane] = KIND_WIN | ((w0 + lane) << 4); lpage[n + lane] = 0; }
        if (lane == 0) nlist[0] = n + (w1 - w0 + 1);
    }
    __syncthreads();
    {
        const int n = nlist[0]; TileRegs R0, R1; int pkind = KIND_SLC;
        { const int e0 = __builtin_amdgcn_readfirstlane(list[0]); tile_load(F, l, q, e0 & 15, e0 >> 4, __builtin_amdgcn_readfirstlane(lpage[0]), R0); }
        if (n > 1) { const int e1 = __builtin_amdgcn_readfirstlane(list[1]); tile_load(F, l, q, e1 & 15, e1 >> 4, __builtin_amdgcn_readfirstlane(lpage[1]), R1); }
#define ATTN_STEP(RR, BI, II) do { \
            LAS unsigned char* kb = lds + AT_K + (BI) * 8192; LAS unsigned char* vb = lds + AT_V + (BI) * 8192; \
            tile_store(F, kb, vb, RR); \
            const int e = __builtin_amdgcn_readfirstlane(list[(II)]); const int kind = e & 15, tile = e >> 4; \
            if ((II) + 2 < n) { const int e2 = __builtin_amdgcn_readfirstlane(list[(II) + 2]); tile_load(F, l, q, e2 & 15, e2 >> 4, __builtin_amdgcn_readfirstlane(lpage[(II) + 2]), RR); } \
            __syncthreads(); \
            if (wact) { \
                if (kind != pkind) { \
                    const float L = half_sum(lsum); const float sc = L > 0.f ? GATE(1) / L : 0.f; \
                    _Pragma("unroll") for (int k = 0; k < 16; ++k) { outl[k * 64] += O[0][k] * sc; outl[(16 + k) * 64] += O[1][k] * sc; O[0][k] = 0.f; O[1][k] = 0.f; } \
                    m = 0.f; lsum = 0.f; started = false; pkind = kind; \
                } \
                int lo, hi; \
                if (kind == KIND_SLC) { const bool sb = (selw[tlc * 8 + (tile >> 5)] >> (tile & 31)) & 1u; lo = 0; hi = (sb && vcol) ? tpos : -1; } \
                else { lo = tpos - 511; hi = vcol ? tpos : -1; } \
                const bool any = (hi >= tile * 64) && (lo <= tile * 64 + 63); \
                if (__ballot(any) != 0ull) { \
                      \
                      \
                    const bool part = any && !((lo <= tile * 64) && (hi >= tile * 64 + 63)); \
                      \
                      \
                    f32x16 s0, s1; qk_tile(kb, qf, s0, s1, lane, any ? -m : -INFINITY); \
                    if (__ballot(part) != 0ull) mask_tile(s0, s1, tile * 64 + 4 * h, lo, hi); \
                    const float mt = tile_max(s0, s1); \
                    const bool seen = mt > -INFINITY; const bool need = (mt > 8.f) || (seen && !started); started = started || seen; \
                    if (__ballot(need) != 0ull) { \
                        const float dl = need ? mt : 0.f; const float al = __builtin_amdgcn_exp2f(-dl); m += dl; lsum *= al; \
                        _Pragma("unroll") for (int k = 0; k < 16; ++k) { s0[k] -= dl; s1[k] -= dl; O[0][k] *= al; O[1][k] *= al; } } \
                    float rs = 0.f; \
                    _Pragma("unroll") for (int k = 0; k < 16; ++k) { s0[k] = __builtin_amdgcn_exp2f(s0[k]); s1[k] = __builtin_amdgcn_exp2f(s1[k]); rs += s0[k] + s1[k]; } \
                    lsum += rs; \
                    pv_tile(vb, s0, s1, O, lane); \
                } \
            } } while (0)
        for (int i = 0; i < n; i += 2) {
            ATTN_STEP(R0, 0, i);
            if (i + 1 < n) ATTN_STEP(R1, 1, i + 1);
        }
#undef ATTN_STEP
        if (wact) {
            const float L = half_sum(lsum); const float sc = L > 0.f ? (pkind == KIND_SLC ? GATE(1) : GATE(2)) / L : 0.f;
#pragma unroll
            for (int k = 0; k < 16; ++k) { O[0][k] = outl[k * 64] + O[0][k] * sc; O[1][k] = outl[(16 + k) * 64] + O[1][k] * sc; }
        }
    }
    if (vcol) {
        bf16* mo = WSP(F, bf16, WS_MIX) + (size_t)r * DM + 768 + head * 64;
#pragma unroll
        for (int dh = 0; dh < 2; ++dh)
#pragma unroll
            for (int gq = 0; gq < 4; ++gq) {
                const int d = dh * 32 + 8 * gq + 4 * h;
                *(unsigned long long*)(mo + d) = (unsigned long long)cvtpk(O[dh][4 * gq], O[dh][4 * gq + 1]) | ((unsigned long long)cvtpk(O[dh][4 * gq + 2], O[dh][4 * gq + 3]) << 32);
            }
    }
}

#undef GATE
constexpr int SW_T = 0, SW_ML = 65536, SW_IMPG = SW_ML + 4096, SW_IMPE = SW_IMPG + 4096, SW_SEL = SW_IMPE + 4096, SW_UNI = SW_SEL + 256, SW_LIST = SW_UNI + 64,
              SW_PAGE = SW_LIST + 1280, SW_NL = SW_PAGE + 1280, SW_RANK = SW_NL + 64, SW_OUT = SW_RANK + 8 * 1024, SW_END = SW_OUT + 8192;
static_assert(SW_END <= RING_BYTES, "sample attention LDS map");
struct HRegs { f32x4 v[8]; };
__device__ __forceinline__ void h_load(const Frame& F, int l, int b, int kind, int ht, int pg, int which, int lane_in, HRegs& R) {
    int lane = lane_in; asm volatile("" : "+v"(lane));
    const int key = ht * 32 + (lane >> 1), hv = lane & 1;
    const float* base; size_t off; bool ok;
    if (kind <= KIND_CMP2) { ok = key < NCMP_S; const int kc = ok ? key : 0;
        base = WSP(F, float, which ? WS_CVS : WS_CKS); off = (((size_t)l * BS + b) * NCMP_S + kc) * 64; }
    else if (kind == KIND_SLC) { ok = key < PAST + TS;
        if (key < PAST) { base = INP(F, I_CACHE); off = ((((size_t)l * NPHYS + pg) * PAGE + (key & 127)) * 4 + 2 + which) * 64; }
        else { const int kk = ok ? key - PAST : 0; base = F.out + O_KVS; off = ((size_t)l * NS + b * TS + kk) * 256 + (2 + which) * 64; } }
    else { ok = (key >= PAST - 512) && (key < PAST + TS);
        if (key < PAST) { const int kk = ok ? key - (PAST - 512) : 0; base = INP(F, I_SWIN); off = (((size_t)l * BS + b) * 512 + kk) * 128 + which * 64; }
        else { const int kk = ok ? key - PAST : 0; base = WSP(F, float, WS_KWIN); off = ((size_t)NP + b * TS + kk) * 128 + which * 64; } }
    const float* p = base + off + hv * 32;
#pragma unroll
    for (int i = 0; i < 8; ++i) { const f32x4 x = *(const f32x4*)(p + 4 * i); R.v[i] = ok ? x : (f32x4){0.f, 0.f, 0.f, 0.f}; }
}
__device__ __forceinline__ void h_store_k(LAS unsigned char* kb, const HRegs& R, int lane_in) {
    int lane = lane_in; asm volatile("" : "+v"(lane));
    const int key = lane >> 1, hv = lane & 1;
#pragma unroll
    for (int i = 0; i < 4; ++i) { v4u o; o.x = cvtpk(R.v[2 * i].x, R.v[2 * i].y); o.y = cvtpk(R.v[2 * i].z, R.v[2 * i].w); o.z = cvtpk(R.v[2 * i + 1].x, R.v[2 * i + 1].y); o.w = cvtpk(R.v[2 * i + 1].z, R.v[2 * i + 1].w);
        *(LAS v4u*)(kb + key * 128 + (((4 * hv + i) ^ (key & 7)) << 4)) = o; }
}
__device__ __forceinline__ void h_store_v(LAS unsigned char* vb, const HRegs& R, int lane_in) {
    int lane = lane_in; asm volatile("" : "+v"(lane));
    const int key = lane >> 1, hv = lane & 1;
#pragma unroll
    for (int i = 0; i < 8; ++i) {
        const float xs[4] = {R.v[i].x, R.v[i].y, R.v[i].z, R.v[i].w};
#pragma unroll
        for (int k = 0; k < 4; ++k) { const int d = 32 * hv + 4 * i + k;
            *(LAS unsigned short*)(vb + d * 64 + (((key >> 2) ^ ((d >> 2) & 7)) << 3) + (key & 3) * 2) = (unsigned short)f2bf(xs[k]); }
    }
}
__device__ __forceinline__ void qk_half(const LAS unsigned char* kb, const bf16x8 (&qf)[4], f32x16& s0, int lane_in) {
    int lane = lane_in; asm volatile("" : "+v"(lane));
    const int r = lane & 31, h = lane >> 5;
#pragma unroll
    for (int i = 0; i < 16; ++i) s0[i] = 0.f;
#pragma unroll
    for (int ks = 0; ks < 4; ++ks) { const bf16x8 a0 = *(const LAS bf16x8*)(kb + r * 128 + (((2 * ks + h) ^ (r & 7)) << 4));
        s0 = __builtin_amdgcn_mfma_f32_32x32x16_bf16(a0, qf[ks], s0, 0, 0, 0); }
}
__device__ __forceinline__ void pv_half(const LAS unsigned char* vb, const f32x16& s0, f32x16 (&O)[2], int lane_in) {
    int lane = lane_in; asm volatile("" : "+v"(lane));
    const int r = lane & 31, h = lane >> 5;
    bf16x8 pf[2];
#pragma unroll
    for (int sp = 0; sp < 2; ++sp) { v4u a; a.x = cvtpk(s0[8 * sp + 0], s0[8 * sp + 1]); a.y = cvtpk(s0[8 * sp + 2], s0[8 * sp + 3]); a.z = cvtpk(s0[8 * sp + 4], s0[8 * sp + 5]); a.w = cvtpk(s0[8 * sp + 6], s0[8 * sp + 7]);
        pf[sp] = __builtin_bit_cast(bf16x8, a); }
#pragma unroll
    for (int dh = 0; dh < 2; ++dh) { const int d = dh * 32 + r, sw = (d >> 2) & 7; const LAS unsigned char* rb = vb + d * 64;
#pragma unroll
        for (int sp = 0; sp < 2; ++sp) { const int q0 = 4 * sp + h;
            const unsigned long long lo8 = *(const LAS unsigned long long*)(rb + ((q0 ^ sw) << 3)), hi8 = *(const LAS unsigned long long*)(rb + (((q0 + 2) ^ sw) << 3));
            v4u av; av.x = (unsigned)lo8; av.y = (unsigned)(lo8 >> 32); av.z = (unsigned)hi8; av.w = (unsigned)(hi8 >> 32);
            O[dh] = __builtin_amdgcn_mfma_f32_32x32x16_bf16(__builtin_bit_cast(bf16x8, av), pf[sp], O[dh], 0, 0, 0); } }
}
__device__ __forceinline__ void mask_half(f32x16& s0, int kbase, int lo, int hi) {
#pragma unroll
    for (int i = 0; i < 16; ++i) { const int k = kbase + (i & 3) + 8 * (i >> 2); if (k < lo || k > hi) s0[i] = -INFINITY; }
}
__device__ __forceinline__ float max16(const f32x16& s0) {
    float a = s0[0];
#pragma unroll
    for (int i = 1; i < 16; ++i) a = fmaxf(a, s0[i]);
    return half_max(a);
}
__device__ __forceinline__ void merge_branch(LAS unsigned char* lds, int wave, int lane, float m, float lsum, f32x16 (&O)[2], float gate) {
    LAS float* ml = (LAS float*)(lds + SW_ML); LAS float* outl = (LAS float*)(lds + SW_OUT) + lane;
    LAS float* slot = (LAS float*)(lds + SW_T + wave * 8192) + lane;
    const float lw = half_sum(lsum);
    ml[wave * 64 + lane] = m; ml[512 + wave * 64 + lane] = lw;
#pragma unroll
    for (int i = 0; i < 16; ++i) { slot[i * 64] = O[0][i]; slot[(16 + i) * 64] = O[1][i]; O[0][i] = 0.f; O[1][i] = 0.f; }
    __syncthreads();
    float M = -1e30f;
#pragma unroll
    for (int w = 0; w < 8; ++w) M = fmaxf(M, ml[w * 64 + lane]);
    float L = 0.f, sc[8];
#pragma unroll
    for (int w = 0; w < 8; ++w) { sc[w] = __builtin_amdgcn_exp2f(ml[w * 64 + lane] - M); L += ml[512 + w * 64 + lane] * sc[w]; }
    const float gl = (L > 0.f) ? gate / L : 0.f;
#pragma unroll
    for (int k = 0; k < 4; ++k) { const int i = wave * 4 + k; float a = 0.f;
#pragma unroll
        for (int w = 0; w < 8; ++w) a += ((LAS float*)(lds + SW_T + w * 8192))[i * 64 + lane] * sc[w];
        outl[i * 64] += a * gl; }
    __syncthreads();
}

__device__ __forceinline__ void attn_sample_unit(const Frame& F, int l, int b, int t0) {
    int lane_ = F.lane; asm volatile("" : "+v"(lane_));
    const int lane = lane_, wave = F.wave, tid = wave * 64 + lane, h = lane >> 5;
    LAS unsigned char* lds = F.lds;
    LAS unsigned char* kb = lds + SW_T + wave * 8192; LAS unsigned char* vb = kb + 4096;
    LAS float* impG = (LAS float*)(lds + SW_IMPG); LAS float* impE = (LAS float*)(lds + SW_IMPE);
    LAS unsigned* selw = (LAS unsigned*)(lds + SW_SEL); LAS unsigned* uni = (LAS unsigned*)(lds + SW_UNI);
    LAS int* list = (LAS int*)(lds + SW_LIST); LAS int* lpage = (LAS int*)(lds + SW_PAGE); LAS int* nlist = (LAS int*)(lds + SW_NL);
    LAS float* rankv = (LAS float*)(lds + SW_RANK + wave * 1024);
    LAS float* outl = (LAS float*)(lds + SW_OUT);
    const int tl = 0, head = lane & 3; const bool wcol = ((lane & 31) >> 2) == 0;
    const int r = NP + b * TS + t0, tpos = PAST + t0;
    bf16x8 qf[4];
    { const bf16* qb = WSP(F, bf16, WS_QB) + ((size_t)r * 4 + head) * 64;
#pragma unroll
      for (int ks = 0; ks < 4; ++ks) qf[ks] = *(const bf16x8*)(qb + 16 * ks + 8 * h); }
    const float* gp = WSP(F, float, WS_PROJ) + (size_t)r * PROJ_LD + OFF_G + head * 3;
    const float g0 = sigmoidf_(gp[0]), g1 = sigmoidf_(gp[1]), g2 = sigmoidf_(gp[2]);
    f32x16 O[2];
#pragma unroll
    for (int i = 0; i < 16; ++i) { O[0][i] = 0.f; O[1][i] = 0.f; }
    __syncthreads();
    if (tid < 64) selw[tid] = 0u;
    f32x16 sa, sb; float m = -1e30f, lsum = 0.f;
    {
        HRegs Ra, Rb; h_load(F, l, b, KIND_CMP1, wave, 0, 0, lane, Ra); h_load(F, l, b, KIND_CMP1, wave + 8, 0, 0, lane, Rb);
        h_store_k(kb, Ra, lane); asm volatile("s_waitcnt lgkmcnt(0)" ::: "memory");
        qk_half(kb, qf, sa, lane); mask_half(sa, wave * 32 + 4 * h, 0, NCMP_S - 1);
        asm volatile("s_waitcnt lgkmcnt(0)" ::: "memory");
        h_store_k(kb, Rb, lane); asm volatile("s_waitcnt lgkmcnt(0)" ::: "memory");
        qk_half(kb, qf, sb, lane); mask_half(sb, (wave + 8) * 32 + 4 * h, 0, NCMP_S - 1);
        m = fmaxf(max16(sa), max16(sb));
#pragma unroll
        for (int k = 0; k < 16; ++k) lsum += __builtin_amdgcn_exp2f(sa[k] - m) + __builtin_amdgcn_exp2f(sb[k] - m);
    }
    {
        LAS float* ml = (LAS float*)(lds + SW_ML);
        const float lw = half_sum(lsum);
        ml[wave * 64 + lane] = m; ml[512 + wave * 64 + lane] = lw;
        HRegs Ra, Rb; h_load(F, l, b, KIND_CMP2, wave, 0, 1, lane, Ra); h_load(F, l, b, KIND_CMP2, wave + 8, 0, 1, lane, Rb);
        __syncthreads();
        float M = -1e30f;
#pragma unroll
        for (int w = 0; w < 8; ++w) M = fmaxf(M, ml[w * 64 + lane]);
        float L = 0.f;
#pragma unroll
        for (int w = 0; w < 8; ++w) L += ml[512 + w * 64 + lane] * __builtin_amdgcn_exp2f(ml[w * 64 + lane] - M);
        const float rinv = L > 0.f ? 1.f / L : 0.f;
#pragma unroll
        for (int pass = 0; pass < 2; ++pass) {
            f32x16& sv = pass ? sb : sa; const int ht = pass ? wave + 8 : wave;
#pragma unroll
            for (int k = 0; k < 16; ++k) sv[k] = __builtin_amdgcn_exp2f(sv[k] - M) * rinv;
            if (pass) h_store_v(vb, Rb, lane); else h_store_v(vb, Ra, lane);
            asm volatile("s_waitcnt lgkmcnt(0)" ::: "memory");
            pv_half(vb, sv, O, lane);
            asm volatile("s_waitcnt lgkmcnt(0)" ::: "memory");
#pragma unroll
            for (int gq = 0; gq < 4; ++gq) {
                float G = (sv[4 * gq] + sv[4 * gq + 1]) + (sv[4 * gq + 2] + sv[4 * gq + 3]), E = sv[4 * gq + 3];
                G += __shfl_xor(G, 1); G += __shfl_xor(G, 2); E += __shfl_xor(E, 1); E += __shfl_xor(E, 2);
                const int j = 8 * ht + 2 * gq + h;
                if (head == 0) { impG[tl * 128 + j] = G; impE[tl * 128 + j] = E; }
            }
        }
        { LAS float* slot = (LAS float*)(lds + SW_T + wave * 8192) + lane;
#pragma unroll
          for (int i = 0; i < 16; ++i) { slot[i * 64] = O[0][i]; slot[(16 + i) * 64] = O[1][i]; O[0][i] = 0.f; O[1][i] = 0.f; } }
    }
    __syncthreads();
#pragma unroll
    for (int k = 0; k < 4; ++k) { const int i = wave * 4 + k; float a = 0.f;
#pragma unroll
        for (int w = 0; w < 8; ++w) a += ((LAS float*)(lds + SW_T + w * 8192))[i * 64 + lane];
        outl[i * 64 + lane] = a * g0; }
    __syncthreads();
    if (wave == 0) {
        const int tk = 0, cur = tpos >> 6;
        for (int j = lane; j < 132; j += 64) {
            float v;
            if (j > cur) v = -INFINITY;
            else if (j == 0 || j == cur || j == cur - 1) v = INFINITY;
            else v = impG[tk * 128 + j] + impE[tk * 128 + j - 1];
            rankv[j] = v;
        }
        asm volatile("s_waitcnt lgkmcnt(0)" ::: "memory");
        const float v0 = rankv[lane], v1 = rankv[64 + lane], v2 = (lane < 1) ? rankv[128 + lane] : -INFINITY;
        int r0 = 0, r1 = 0, r2 = 0;
        for (int k4 = 0; k4 < 132; k4 += 4) {
            const f32x4 vk = *(const LAS f32x4*)(rankv + k4);
#pragma unroll
            for (int u = 0; u < 4; ++u) { const float x = vk[u]; const int k = k4 + u;
                r0 += (x > v0 || (x == v0 && k < lane)) ? 1 : 0; r1 += (x > v1 || (x == v1 && k < 64 + lane)) ? 1 : 0; r2 += (x > v2 || (x == v2 && k < 128 + lane)) ? 1 : 0; }
        }
        const unsigned long long b0 = __ballot(r0 < 16 && lane <= cur), b1 = __ballot(r1 < 16 && 64 + lane <= cur), b2 = __ballot(lane < 1 && r2 < 16 && 128 + lane <= cur);
        if (lane == 0) { selw[tk * 8 + 0] = (unsigned)b0; selw[tk * 8 + 1] = (unsigned)(b0 >> 32); selw[tk * 8 + 2] = (unsigned)b1; selw[tk * 8 + 3] = (unsigned)(b1 >> 32); selw[tk * 8 + 4] = (unsigned)b2; }
    }
    __syncthreads();
    if (tid < 8) uni[tid] = selw[tid];
    __syncthreads();
    if (wave == 0) {
        int n = 0;
        for (int j0 = 0; j0 < 129; j0 += 64) {
            const int j = j0 + lane; const bool sj = (j < 129) && ((uni[j >> 5] >> (j & 31)) & 1u);
            int pg = 0; if (sj && j * 64 < PAST) pg = ((const int*)INP(F, I_PT))[b * NPAGES + (j >> 1)];
            const unsigned long long bal = __ballot(sj);
            if (sj) { const int idx = n + 2 * __popcll(bal & ((1ull << lane) - 1ull)); list[idx] = KIND_SLC | ((2 * j) << 4); list[idx + 1] = KIND_SLC | ((2 * j + 1) << 4); lpage[idx] = pg; lpage[idx + 1] = pg; }
            n += 2 * __popcll(bal);
        }
        if (lane == 0) nlist[0] = n;
        const int w0 = (PAST - 512) / 32, w1 = (PAST + TS - 1) / 32;
        if (lane <= w1 - w0) { list[n + lane] = KIND_WIN | ((w0 + lane) << 4); lpage[n + lane] = 0; }
        if (lane == 0) nlist[1] = n + (w1 - w0 + 1);
    }
    __syncthreads();
    const int n_slc = nlist[0], n_all = nlist[1];
#pragma unroll 1
    for (int br = 0; br < 2; ++br) {
        const int i0 = br ? n_slc : 0, i1 = br ? n_all : n_slc;
        m = -1e30f; lsum = 0.f;
        HRegs Rk, Rv;
        int it = i0 + wave;
        if (it < i1) { const int e = list[it], pg = lpage[it]; h_load(F, l, b, e & 15, e >> 4, pg, 0, lane, Rk); h_load(F, l, b, e & 15, e >> 4, pg, 1, lane, Rv); }
#pragma unroll 1
        for (; it < i1; it += 8) {
            const int e = __builtin_amdgcn_readfirstlane(list[it]); const int kind = e & 15, ht = e >> 4;
            h_store_k(kb, Rk, lane); h_store_v(vb, Rv, lane);
            if (it + 8 < i1) { const int e2 = list[it + 8], pg2 = lpage[it + 8]; h_load(F, l, b, e2 & 15, e2 >> 4, pg2, 0, lane, Rk); h_load(F, l, b, e2 & 15, e2 >> 4, pg2, 1, lane, Rv); }
            asm volatile("s_waitcnt lgkmcnt(0)" ::: "memory");
            int lo, hi;
            if (kind == KIND_SLC) { const int j = ht >> 1; const bool sbit = (selw[tl * 8 + (j >> 5)] >> (j & 31)) & 1u; lo = 0; hi = sbit ? tpos : -1; }
            else { lo = tpos - 511; hi = tpos; }
            f32x16 s0; qk_half(kb, qf, s0, lane);
            mask_half(s0, ht * 32 + 4 * h, lo, hi);
            const float mt = max16(s0); const float mn = fmaxf(m, mt); const float al = __builtin_amdgcn_exp2f(m - mn);
            float rs = 0.f;
#pragma unroll
            for (int k = 0; k < 16; ++k) { s0[k] = __builtin_amdgcn_exp2f(s0[k] - mn); rs += s0[k]; }
            lsum = lsum * al + rs; m = mn;
#pragma unroll
            for (int k = 0; k < 16; ++k) { O[0][k] *= al; O[1][k] *= al; }
            pv_half(vb, s0, O, lane);
            asm volatile("s_waitcnt lgkmcnt(0)" ::: "memory");
        }
        merge_branch(lds, wave, lane, m, lsum, O, br ? g2 : g1);
    }
    if (wave == 0 && wcol) {
        bf16* mo = WSP(F, bf16, WS_MIX) + (size_t)r * DM + 768 + head * 64;
#pragma unroll
        for (int dh = 0; dh < 2; ++dh)
#pragma unroll
            for (int gq = 0; gq < 4; ++gq) { const int d = dh * 32 + 8 * gq + 4 * h; const LAS float* o = outl + (dh * 16 + 4 * gq) * 64 + lane;
                *(unsigned long long*)(mo + d) = (unsigned long long)cvtpk(o[0], o[64]) | ((unsigned long long)cvtpk(o[128], o[192]) << 32); }
    }
    __syncthreads();
}


__device__ __forceinline__ void phase_attn2(const Frame& F, int l) {
    for (int u = blockIdx.x; u < 256; u += F.G) attn_unit(F, l, u & 7, (u >> 3) * 64, 64);
    Frame G2 = F; { int ln = G2.lane; asm volatile("" : "+v"(ln)); G2.lane = ln; G2.tid = G2.wave * 64 + ln; }
    if (F.G == 256) { if (blockIdx.x < 128) { ssd_out_unit(G2, l, (int)blockIdx.x >> 5, (int)blockIdx.x & 31); ssd_out_unit(G2, l, ((int)blockIdx.x + 128) >> 5, ((int)blockIdx.x + 128) & 31); } }
    else for (int u = blockIdx.x; u < BP * 32; u += F.G) ssd_out_unit(G2, l, u >> 5, u & 31);
    for (int r = NP + G2.gw; r < MROWS; r += G2.ngw) ssd_finish_token(G2, l, r);
}


constexpr float LOG2E = 1.4426950408889634f;
constexpr int SD_B = 0, SD_BT = 32768, SD_C = 65536, SD_AC = 98304, SD_DT = SD_AC + 2048, SD_W = SD_DT + 2048, SD_END = SD_W + 2048;
static_assert(SD_END <= RING_BYTES, "ssd LDS map");
__device__ __forceinline__ int crow16(int i, int hp) { return (i & 3) + 8 * (i >> 2) + 4 * hp; }
__device__ __forceinline__ unsigned long long pack4bf(float a, float b, float c, float d) { return (unsigned long long)cvtpk(a, b) | ((unsigned long long)cvtpk(c, d) << 32); }

__device__ __forceinline__ void ssd_chunk_unit(const Frame& F, int l, int b, int c, int g) {
    const int tid = F.tid, lane = F.lane, wave = F.wave;
    LAS unsigned char* lds = F.lds;
    const float* proj = WSP(F, float, WS_PROJ);
    const size_t rbase = (size_t)b * TP + (size_t)c * 128;
    const float* cw = INP(F, I_CONVW) + (size_t)l * 4 * CONV_DIM; const float* cbv = INP(F, I_CONVB) + (size_t)l * CONV_DIM;
    LAS float* acs = (LAS float*)(lds + SD_AC); LAS float* dts = (LAS float*)(lds + SD_DT); LAS float* wts = (LAS float*)(lds + SD_W);
    __syncthreads();
    if (wave < 4) {
        const int hh = wave, head = 4 * g + hh;
        const float a2 = -expf(INP(F, I_ALOG)[l * SSD_H + head]) * LOG2E, dtb = INP(F, I_DTB)[l * SSD_H + head];
        const float d0 = softplusf_(proj[(rbase + 2 * lane) * PROJ_LD + OFF_DT + head] + dtb), d1 = softplusf_(proj[(rbase + 2 * lane + 1) * PROJ_LD + OFF_DT + head] + dtb);
        float sc = (d0 + d1) * a2;
#pragma unroll
        for (int o = 1; o < 64; o <<= 1) { const float t = __shfl_up(sc, o); if (lane >= o) sc += t; }
        const float ac1 = sc, ac0 = sc - d1 * a2; const float tot = __uint_as_float(__builtin_amdgcn_readlane(__float_as_uint(sc), 63));
        acs[hh * 128 + 2 * lane] = ac0; acs[hh * 128 + 2 * lane + 1] = ac1; dts[hh * 128 + 2 * lane] = d0; dts[hh * 128 + 2 * lane + 1] = d1;
        wts[hh * 128 + 2 * lane] = __builtin_amdgcn_exp2f(tot - ac0); wts[hh * 128 + 2 * lane + 1] = __builtin_amdgcn_exp2f(tot - ac1);
        float* acg = WSP(F, float, WS_SAC); acg[(rbase + 2 * lane) * SSD_H + head] = ac0; acg[(rbase + 2 * lane + 1) * SSD_H + head] = ac1;
        if (lane == 63) WSP(F, float, WS_SCD)[((size_t)b * 16 + c) * SSD_H + head] = __builtin_amdgcn_exp2f(tot);
    }
    {
        const int ch = tid & 255, th = tid >> 8;
        const int chan = (ch < 128) ? 512 + g * 128 + ch : 768 + g * 128 + (ch - 128);
        const float w0 = cw[chan], w1 = cw[CONV_DIM + chan], w2 = cw[2 * CONV_DIM + chan], w3 = cw[3 * CONV_DIM + chan], bb = cbv[chan];
        const int tl0 = th * 64;
        const float* src = proj + (rbase + tl0) * PROJ_LD + OFF_XBC + chan;
        const bool hasp = (c > 0) || (th > 0);
        float x0 = hasp ? src[-3 * PROJ_LD] : 0.f, x1 = hasp ? src[-2 * PROJ_LD] : 0.f, x2 = hasp ? src[-PROJ_LD] : 0.f;
        const int n = ch & 127;
        bf16* cbg = WSP(F, bf16, WS_SCB) + (rbase + tl0) * 256 + g * 128 + n;
        for (int i1 = 0; i1 < 64; i1 += 16) {
          float rawv[16];
#pragma unroll
          for (int k = 0; k < 16; ++k) rawv[k] = src[(size_t)(i1 + k) * PROJ_LD];
#pragma unroll
          for (int i2 = 0; i2 < 16; i2 += 4) { const int i0 = i1 + i2;
            float v[4];
#pragma unroll
            for (int k = 0; k < 4; ++k) { const float cur = rawv[i2 + k]; v[k] = siluf_(bb + w0 * x0 + w1 * x1 + w2 * x2 + w3 * cur); x0 = x1; x1 = x2; x2 = cur; }
            const int s = tl0 + i0;
            if (ch < 128) {
#pragma unroll
                for (int k = 0; k < 4; ++k) *(LAS unsigned short*)(lds + SD_B + (s + k) * 256 + (((n >> 3) ^ ((s + k) & 15)) << 4) + (n & 7) * 2) = (unsigned short)f2bf(v[k]);
                *(LAS unsigned long long*)(lds + SD_BT + n * 256 + (((s >> 2) ^ (n & 31)) << 3)) = pack4bf(v[0], v[1], v[2], v[3]);
            } else {
#pragma unroll
                for (int k = 0; k < 4; ++k) { const unsigned short hv = (unsigned short)f2bf(v[k]);
                    *(LAS unsigned short*)(lds + SD_C + (s + k) * 256 + (((n >> 3) ^ ((s + k) & 15)) << 4) + (n & 7) * 2) = hv; cbg[(size_t)(i0 + k) * 256] = hv; }
            }
          }
        }
    }
    __syncthreads();
    const int lb = wave & 3, hw = wave >> 2;
    int lane_g = lane; asm volatile("" : "+v"(lane_g));
    f32x16 Gt[4];
    {
        const int r32 = lane_g & 31, hp = lane_g >> 5, lloc = lb * 32 + r32;
        bf16x8 cf[8];
#pragma unroll
        for (int ks = 0; ks < 8; ++ks) cf[ks] = *(const LAS bf16x8*)(lds + SD_C + lloc * 256 + (((2 * ks + hp) ^ (lloc & 15)) << 4));
#pragma unroll
        for (int sb = 0; sb < 4; ++sb) {
#pragma unroll
            for (int i = 0; i < 16; ++i) Gt[sb][i] = 0.f;
            if (sb <= lb) {
                int s = sb * 32 + r32; asm volatile("" : "+v"(s));
#pragma unroll
                for (int ks = 0; ks < 8; ++ks) { const bf16x8 a = *(const LAS bf16x8*)(lds + SD_B + s * 256 + (((2 * ks + hp) ^ (s & 15)) << 4));
                    Gt[sb] = __builtin_amdgcn_mfma_f32_32x32x16_bf16(a, cf[ks], Gt[sb], 0, 0, 0); }
            }
            __builtin_amdgcn_sched_barrier(0);
        }
    }
    __syncthreads();
    for (int rd = 0; rd < 2; ++rd) {
        {
            int tid_r = tid; asm volatile("" : "+v"(tid_r));
            const int ch = tid_r & 127, tq = tid_r >> 7; const int hh2 = ch >> 6, p = ch & 63, hh = 2 * rd + hh2;
            const int chan = (4 * g + hh) * 64 + p;
            const float w0 = cw[chan], w1 = cw[CONV_DIM + chan], w2 = cw[2 * CONV_DIM + chan], w3 = cw[3 * CONV_DIM + chan], bb = cbv[chan];
            const int tl0 = tq * 32;
            const float* src = proj + (rbase + tl0) * PROJ_LD + OFF_XBC + chan;
            const bool hasp = (c > 0) || (tq > 0);
            float x0 = hasp ? src[-3 * PROJ_LD] : 0.f, x1 = hasp ? src[-2 * PROJ_LD] : 0.f, x2 = hasp ? src[-PROJ_LD] : 0.f;
            for (int i1 = 0; i1 < 32; i1 += 16) {
              float rawv[16];
#pragma unroll
              for (int k = 0; k < 16; ++k) rawv[k] = src[(size_t)(i1 + k) * PROJ_LD];
#pragma unroll
              for (int i2 = 0; i2 < 16; i2 += 4) { const int i0 = i1 + i2;
                float v[4]; const int s = tl0 + i0;
#pragma unroll
                for (int k = 0; k < 4; ++k) { const float cur = rawv[i2 + k]; v[k] = siluf_(bb + w0 * x0 + w1 * x1 + w2 * x2 + w3 * cur) * dts[hh * 128 + s + k]; x0 = x1; x1 = x2; x2 = cur; }
                *(LAS unsigned long long*)(lds + SD_C + hh2 * 16384 + p * 256 + (((s >> 2) ^ (p & 31)) << 3)) = pack4bf(v[0], v[1], v[2], v[3]);
              }
            }
        }
        __syncthreads();
        int lane_r = lane; asm volatile("" : "+v"(lane_r));
        const int r32 = lane_r & 31, hp = lane_r >> 5, lloc = lb * 32 + r32;
        const int hh = 2 * rd + hw, head = 4 * g + hh;
        const LAS float* ac = acs + hh * 128; const LAS float* wp = wts + hh * 128;
        const LAS unsigned char* xt = lds + SD_C + hw * 16384;
        const float acl = ac[lloc], ddt = INP(F, I_SSDD)[l * SSD_H + head] / dts[hh * 128 + lloc];
        f32x16 Y[2];
#pragma unroll
        for (int i = 0; i < 16; ++i) { Y[0][i] = 0.f; Y[1][i] = 0.f; }
#pragma unroll
        for (int sb = 0; sb < 4; ++sb) {
            if (sb <= lb) {
                f32x16 mt;
#pragma unroll
                for (int i = 0; i < 16; ++i) { const int s = sb * 32 + crow16(i, hp);
                    float mv = Gt[sb][i] * __builtin_amdgcn_exp2f(acl - ac[s]);
                    if (sb == lb) { mv = (s > lloc) ? 0.f : mv; mv += (s == lloc) ? ddt : 0.f; }
                    mt[i] = mv; }
                bf16x8 pf[2];
#pragma unroll
                for (int sp = 0; sp < 2; ++sp) { v4u a; a.x = cvtpk(mt[8 * sp + 0], mt[8 * sp + 1]); a.y = cvtpk(mt[8 * sp + 2], mt[8 * sp + 3]); a.z = cvtpk(mt[8 * sp + 4], mt[8 * sp + 5]); a.w = cvtpk(mt[8 * sp + 6], mt[8 * sp + 7]);
                    pf[sp] = __builtin_bit_cast(bf16x8, a); }
#pragma unroll
                for (int pt = 0; pt < 2; ++pt) { int p = pt * 32 + r32; asm volatile("" : "+v"(p)); const int sw = p & 31; const LAS unsigned char* rb = xt + p * 256;
#pragma unroll
                    for (int sp = 0; sp < 2; ++sp) { const int q0 = sb * 8 + 4 * sp + hp;
                        const unsigned long long lo8 = *(const LAS unsigned long long*)(rb + ((q0 ^ sw) << 3)), hi8 = *(const LAS unsigned long long*)(rb + (((q0 + 2) ^ sw) << 3));
                        v4u av; av.x = (unsigned)lo8; av.y = (unsigned)(lo8 >> 32); av.z = (unsigned)hi8; av.w = (unsigned)(hi8 >> 32);
                        Y[pt] = __builtin_amdgcn_mfma_f32_32x32x16_bf16(__builtin_bit_cast(bf16x8, av), pf[sp], Y[pt], 0, 0, 0); } }
            }
            __builtin_amdgcn_sched_barrier(0);
        }
        {
            float* yo = WSP(F, float, WS_YSSD) + (rbase + lloc) * SSD_W + head * 64;
#pragma unroll
            for (int pt = 0; pt < 2; ++pt)
#pragma unroll
                for (int qd = 0; qd < 4; ++qd) *(f32x4*)(yo + pt * 32 + 8 * qd + 4 * hp) = (f32x4){Y[pt][4 * qd], Y[pt][4 * qd + 1], Y[pt][4 * qd + 2], Y[pt][4 * qd + 3]};
        }
        {
            f32x16 St[2];
#pragma unroll
            for (int i = 0; i < 16; ++i) { St[0][i] = 0.f; St[1][i] = 0.f; }
            const int n = lb * 32 + r32;
#pragma unroll
            for (int ks = 0; ks < 8; ++ks) {
                const int cb0 = 4 * ks + 2 * hp; int nn = n; asm volatile("" : "+v"(nn));
                const unsigned long long blo = *(const LAS unsigned long long*)(lds + SD_BT + nn * 256 + ((cb0 ^ (nn & 31)) << 3)), bhi = *(const LAS unsigned long long*)(lds + SD_BT + nn * 256 + (((cb0 + 1) ^ (nn & 31)) << 3));
                v4u bv; bv.x = (unsigned)blo; bv.y = (unsigned)(blo >> 32); bv.z = (unsigned)bhi; bv.w = (unsigned)(bhi >> 32);
                const f32x4 wa = *(const LAS f32x4*)(wp + 16 * ks + 8 * hp), wb = *(const LAS f32x4*)(wp + 16 * ks + 8 * hp + 4);
#pragma unroll
                for (int pt = 0; pt < 2; ++pt) { const int p = pt * 32 + (nn & 31); const LAS unsigned char* rb = xt + p * 256;
                    const unsigned long long alo = *(const LAS unsigned long long*)(rb + ((cb0 ^ (p & 31)) << 3)), ahi = *(const LAS unsigned long long*)(rb + (((cb0 + 1) ^ (p & 31)) << 3));
                    const unsigned a0 = (unsigned)alo, a1 = (unsigned)(alo >> 32), a2 = (unsigned)ahi, a3 = (unsigned)(ahi >> 32);
                    v4u av;
                    av.x = cvtpk(__uint_as_float(a0 << 16) * wa.x, __uint_as_float(a0 & 0xffff0000u) * wa.y); av.y = cvtpk(__uint_as_float(a1 << 16) * wa.z, __uint_as_float(a1 & 0xffff0000u) * wa.w);
                    av.z = cvtpk(__uint_as_float(a2 << 16) * wb.x, __uint_as_float(a2 & 0xffff0000u) * wb.y); av.w = cvtpk(__uint_as_float(a3 << 16) * wb.z, __uint_as_float(a3 & 0xffff0000u) * wb.w);
                    St[pt] = __builtin_amdgcn_mfma_f32_32x32x16_bf16(__builtin_bit_cast(bf16x8, av), __builtin_bit_cast(bf16x8, bv), St[pt], 0, 0, 0); }
                __builtin_amdgcn_sched_barrier(0);
            }
            float* cs = WSP(F, float, WS_SCS) + (((size_t)b * 16 + c) * SSD_H + head) * (SSD_HD * SSD_N) + n;
#pragma unroll
            for (int pt = 0; pt < 2; ++pt)
#pragma unroll
                for (int i = 0; i < 16; ++i) cs[(size_t)(pt * 32 + crow16(i, hp)) * SSD_N] = St[pt][i];
        }
        __syncthreads();
    }
}

__device__ __forceinline__ void ssd_scan(const Frame& F, int l) {
    const float* cs = WSP(F, float, WS_SCS); const float* cd = WSP(F, float, WS_SCD); bf16* hs = WSP(F, bf16, WS_SHS);
    for (int idx = blockIdx.x * NTHR + F.tid; idx < BP * SSD_H * 2048; idx += F.G * NTHR) {
        const int e4 = idx & 2047, bh = idx >> 11, b = bh >> 3, h = bh & 7;
        f32x4 st = (f32x4){0.f, 0.f, 0.f, 0.f};
#pragma unroll 8
        for (int c = 0; c < 16; ++c) {
            const size_t o = (((size_t)b * 16 + c) * SSD_H + h) * (SSD_HD * SSD_N) + e4 * 4;
            *(unsigned long long*)(hs + o) = pack4bf(st.x, st.y, st.z, st.w);
            const f32x4 sv = *(const f32x4*)(cs + o); const float d = cd[((size_t)b * 16 + c) * SSD_H + h];
            st = st * d + sv;
        }
        *(f32x4*)(F.out + O_SSMP + (((size_t)l * BP + b) * SSD_H + h) * (SSD_HD * SSD_N) + e4 * 4) = st;
    }
}

__device__ __forceinline__ void ssd_out_unit(const Frame& F, int l, int b, int hc) {
    const int lane = F.lane, h = F.wave, g = h >> 2, c = hc >> 1, l0 = hc * 64, r32 = lane & 31, hp = lane >> 5;
    LAS float* ssq = (LAS float*)F.lds;
    const bf16* Hs = WSP(F, bf16, WS_SHS) + (((size_t)b * 16 + c) * SSD_H + h) * (SSD_HD * SSD_N);
    const bf16* Cb = WSP(F, bf16, WS_SCB) + ((size_t)b * TP + l0) * 256 + g * 128;
    f32x16 Yo[2][2];
#pragma unroll
    for (int i = 0; i < 16; ++i) { Yo[0][0][i] = 0.f; Yo[0][1][i] = 0.f; Yo[1][0][i] = 0.f; Yo[1][1][i] = 0.f; }
#pragma unroll
    for (int ks = 0; ks < 8; ++ks) {
        bf16x8 af[2], bfr[2];
#pragma unroll
        for (int pt = 0; pt < 2; ++pt) af[pt] = *(const bf16x8*)(Hs + (size_t)(pt * 32 + r32) * SSD_N + 16 * ks + 8 * hp);
#pragma unroll
        for (int lt = 0; lt < 2; ++lt) bfr[lt] = *(const bf16x8*)(Cb + (size_t)(lt * 32 + r32) * 256 + 16 * ks + 8 * hp);
#pragma unroll
        for (int lt = 0; lt < 2; ++lt)
#pragma unroll
            for (int pt = 0; pt < 2; ++pt) Yo[lt][pt] = __builtin_amdgcn_mfma_f32_32x32x16_bf16(af[pt], bfr[lt], Yo[lt][pt], 0, 0, 0);
    }
    __syncthreads();
#pragma unroll
    for (int lt = 0; lt < 2; ++lt) {
        const size_t row = (size_t)b * TP + l0 + lt * 32 + r32;
        const float sc = __builtin_amdgcn_exp2f(WSP(F, float, WS_SAC)[row * SSD_H + h]);
        const float* yd = WSP(F, float, WS_YSSD) + row * SSD_W + h * 64; const float* zz = WSP(F, float, WS_PROJ) + row * PROJ_LD + h * 64;
        float ss = 0.f;
#pragma unroll
        for (int pt = 0; pt < 2; ++pt) {
            f32x4 y4v[4], z4v[4];
#pragma unroll
            for (int i = 0; i < 4; ++i) { const int p = pt * 32 + 8 * i + 4 * hp; y4v[i] = *(const f32x4*)(yd + p); z4v[i] = *(const f32x4*)(zz + p); }
#pragma unroll
            for (int qd = 0; qd < 4; ++qd) { const f32x4 y4 = y4v[qd], z4 = z4v[qd];
#pragma unroll
                for (int k = 0; k < 4; ++k) { const float v = (y4[k] + sc * Yo[lt][pt][4 * qd + k]) * siluf_(z4[k]); Yo[lt][pt][4 * qd + k] = v; ss += v * v; } }
        }
        ss = half_sum(ss);
        if (hp == 0) ssq[(lt * 32 + r32) * 8 + h] = ss;
    }
    __syncthreads();
    const float* nw = INP(F, I_SSDNORM) + (size_t)l * SSD_W + h * 64;
#pragma unroll
    for (int lt = 0; lt < 2; ++lt) {
        const size_t row = (size_t)b * TP + l0 + lt * 32 + r32;
        const LAS float* sq = ssq + (lt * 32 + r32) * 8;
        const float tot = ((sq[0] + sq[1]) + (sq[2] + sq[3])) + ((sq[4] + sq[5]) + (sq[6] + sq[7]));
        const float rs = 1.f / sqrtf(tot * (1.f / SSD_W) + RMS_EPS);
        bf16* mo = WSP(F, bf16, WS_MIX) + row * DM + h * 64;
#pragma unroll
        for (int pt = 0; pt < 2; ++pt)
#pragma unroll
            for (int qd = 0; qd < 4; ++qd) { const int p = pt * 32 + 8 * qd + 4 * hp; const f32x4 w4 = *(const f32x4*)(nw + p);
                *(unsigned long long*)(mo + p) = pack4bf(Yo[lt][pt][4 * qd] * rs * w4.x, Yo[lt][pt][4 * qd + 1] * rs * w4.y, Yo[lt][pt][4 * qd + 2] * rs * w4.z, Yo[lt][pt][4 * qd + 3] * rs * w4.w); }
    }
    __syncthreads();
}

__device__ __forceinline__ void resid_row(const Frame& F, const float* xold, const float* f, const bf16* fb, int nsl, size_t slstride, const float* w_post, float* xnew, const float* w_next, bf16* xn) {
    const f32x4* xo = (const f32x4*)xold + F.lane; const f32x4* fr = (const f32x4*)f + F.lane; const f32x4* wp = (const f32x4*)w_post + F.lane;
    f32x4 fv[4]; float ss = 0.f;
#pragma unroll
    for (int j = 0; j < 4; ++j) {
        if (fb) fv[j] = bf4_to_f32(((const unsigned long long*)fb + F.lane)[64 * j]); else fv[j] = fr[64 * j];
        for (int s = 1; s < nsl; ++s) fv[j] += ((const f32x4*)(f + s * slstride) + F.lane)[64 * j];
        ss += (fv[j].x * fv[j].x + fv[j].y * fv[j].y) + (fv[j].z * fv[j].z + fv[j].w * fv[j].w); }
    const float rs = 1.f / sqrtf(wave_sum(ss) * (1.f / DM) + RMS_EPS);
    f32x4 xv[4]; float s2 = 0.f;
#pragma unroll
    for (int j = 0; j < 4; ++j) { xv[j] = xo[64 * j] + fv[j] * rs * wp[64 * j]; s2 += (xv[j].x * xv[j].x + xv[j].y * xv[j].y) + (xv[j].z * xv[j].z + xv[j].w * xv[j].w);
        ((f32x4*)xnew + F.lane)[64 * j] = xv[j]; }
    if (w_next) {
        const float r2 = 1.f / sqrtf(wave_sum(s2) * (1.f / DM) + RMS_EPS);
        const f32x4* wn = (const f32x4*)w_next + F.lane; unsigned long long* o8 = (unsigned long long*)xn + F.lane;
#pragma unroll
        for (int j = 0; j < 4; ++j) { const f32x4 g = wn[64 * j];
            o8[64 * j] = (unsigned long long)pk2(xv[j].x * r2 * g.x, xv[j].y * r2 * g.y) | ((unsigned long long)pk2(xv[j].z * r2 * g.z, xv[j].w * r2 * g.w) << 32); }
    }
}
template <int NR>
__device__ __forceinline__ void resid_rowsN(const Frame& F, const float* xold, const bf16* f, const float* w_post, float* xnew, const float* w_next, bf16* xn) {
    const int lane = F.lane;
    unsigned long long fr[NR][4]; f32x4 xv[NR][4];
#pragma unroll
    for (int r = 0; r < NR; ++r)
#pragma unroll
        for (int j = 0; j < 4; ++j) { fr[r][j] = ((const unsigned long long*)(f + (size_t)r * DM) + lane)[64 * j]; xv[r][j] = ((const f32x4*)(xold + (size_t)r * DM) + lane)[64 * j]; }
    float rs[NR];
#pragma unroll
    for (int r = 0; r < NR; ++r) { float s = 0.f;
#pragma unroll
        for (int j = 0; j < 4; ++j) { const f32x4 v = bf4_to_f32(fr[r][j]); s += (v.x * v.x + v.y * v.y) + (v.z * v.z + v.w * v.w); }
        rs[r] = s; }
#pragma unroll
    for (int r = 0; r < NR; ++r) rs[r] = 1.f / sqrtf(wave_sum(rs[r]) * (1.f / DM) + RMS_EPS);
    float s2[NR];
#pragma unroll
    for (int r = 0; r < NR; ++r) s2[r] = 0.f;
#pragma unroll
    for (int j = 0; j < 4; ++j) { const f32x4 wp = ((const f32x4*)w_post + lane)[64 * j];
#pragma unroll
        for (int r = 0; r < NR; ++r) { xv[r][j] = xv[r][j] + bf4_to_f32(fr[r][j]) * rs[r] * wp;
            s2[r] += (xv[r][j].x * xv[r][j].x + xv[r][j].y * xv[r][j].y) + (xv[r][j].z * xv[r][j].z + xv[r][j].w * xv[r][j].w);
            ((f32x4*)(xnew + (size_t)r * DM) + lane)[64 * j] = xv[r][j]; } }
    if (w_next) {
#pragma unroll
        for (int r = 0; r < NR; ++r) s2[r] = 1.f / sqrtf(wave_sum(s2[r]) * (1.f / DM) + RMS_EPS);
#pragma unroll
        for (int j = 0; j < 4; ++j) { const f32x4 g = ((const f32x4*)w_next + lane)[64 * j];
#pragma unroll
            for (int r = 0; r < NR; ++r) { const float q = s2[r];
                ((unsigned long long*)(xn + (size_t)r * DM) + lane)[64 * j] = (unsigned long long)pk2(xv[r][j].x * q * g.x, xv[r][j].y * q * g.y) | ((unsigned long long)pk2(xv[r][j].z * q * g.z, xv[r][j].w * q * g.w) << 32); } }
    }
}
constexpr int RES_NR = 4;
__device__ __forceinline__ void phase_resid_mix(const Frame& F, int l) {
    for (int rp = F.gw; rp < NP / RES_NR; rp += F.ngw) { const int r = RES_NR * rp;
        const float* x0 = (l == 0) ? x_in_row(F, r) : WSP(F, float, WS_X) + (size_t)r * DM;
        resid_rowsN<RES_NR>(F, x0, WSP(F, bf16, WS_MIXO) + (size_t)r * DM, INP(F, I_NMPOST) + (size_t)l * DM, WSP(F, float, WS_X) + (size_t)r * DM,
                            INP(F, I_NFPRE) + (size_t)l * DM, WSP(F, bf16, WS_XN) + (size_t)r * DM);
    }
    for (int r = NP + F.gw; r < MROWS; r += F.ngw) {
        const float* xold = (l == 0) ? x_in_row(F, r) : WSP(F, float, WS_X) + (size_t)r * DM;
        resid_row(F, xold, WSP(F, float, WS_SLAB) + (size_t)(r - NP) * DM, nullptr, SPLIT_OUT, (size_t)256 * DM, INP(F, I_NMPOST) + (size_t)l * DM, WSP(F, float, WS_X) + (size_t)r * DM,
                  INP(F, I_NFPRE) + (size_t)l * DM, WSP(F, bf16, WS_XN) + (size_t)r * DM);
    }
}
__device__ __forceinline__ void phase_resid_ffn(const Frame& F, int l) {
    const float* wn = (l == DEPTH - 1) ? nullptr : INP(F, I_NMPRE) + (size_t)(l + 1) * DM;
    for (int rp = F.gw; rp < NP / RES_NR; rp += F.ngw) { const int r = RES_NR * rp;
        float* xn = (l == DEPTH - 1) ? F.out + O_YP + (size_t)r * DM : WSP(F, float, WS_X) + (size_t)r * DM;
        resid_rowsN<RES_NR>(F, WSP(F, float, WS_X) + (size_t)r * DM, WSP(F, bf16, WS_MIXO) + (size_t)r * DM, INP(F, I_NFPOST) + (size_t)l * DM, xn, wn, WSP(F, bf16, WS_XN) + (size_t)r * DM);
    }
    for (int r = NP + F.gw; r < MROWS; r += F.ngw) {
        float* xnew = (l == DEPTH - 1) ? F.out + O_YS + (size_t)(r - NP) * DM : WSP(F, float, WS_X) + (size_t)r * DM;
        resid_row(F, WSP(F, float, WS_X) + (size_t)r * DM, WSP(F, float, WS_SLAB) + (size_t)(r - NP) * DM, nullptr, SPLIT_DOWN, (size_t)256 * DM, INP(F, I_NFPOST) + (size_t)l * DM, xnew,
                  wn, WSP(F, bf16, WS_XN) + (size_t)r * DM);
    }
}

__device__ __forceinline__ void phase_ffn_act(const Frame& F, int l) {
    bf16* act = WSP(F, bf16, WS_ACT);
    const float* cw = INP(F, I_FCW) + (size_t)l * 3 * DFF; const float* cb = INP(F, I_FCB) + (size_t)l * DFF;
    const float* halo = WSP(F, float, WS_FHALO); const float* last = WSP(F, float, WS_FLAST); const float* raw = WSP(F, float, WS_FRAW);
    for (int it = F.gw; it < 64 * 2 * 16; it += F.ngw) {
        const int pm = it >> 5, j = (it >> 4) & 1, c = (it & 15) * 256 + F.lane * 4;
        const bool first = (pm & 7) == 0;
        const f32x4 z = (f32x4){0.f, 0.f, 0.f, 0.f};
        const f32x4 ga = *(const f32x4*)(halo + ((size_t)pm * 2 + j) * 8192 + c), vv = *(const f32x4*)(halo + ((size_t)pm * 2 + j) * 8192 + 4096 + c);
        f32x4 gb, gc;
        if (j == 0) { gb = first ? z : *(const f32x4*)(last + ((size_t)(pm - 1) * 2 + 1) * 4096 + c); gc = first ? z : *(const f32x4*)(last + ((size_t)(pm - 1) * 2 + 0) * 4096 + c); }
        else { gb = *(const f32x4*)(halo + ((size_t)pm * 2 + 0) * 8192 + c); gc = first ? z : *(const f32x4*)(last + ((size_t)(pm - 1) * 2 + 1) * 4096 + c); }
        const f32x4 w0 = *(const f32x4*)(cw + c), w1 = *(const f32x4*)(cw + DFF + c), w2 = *(const f32x4*)(cw + 2 * DFF + c), bb = *(const f32x4*)(cb + c);
        const f32x4 pre = gc * w0 + gb * w1 + ga * w2 + bb;
        const float a0 = gelu_tanh(pre.x) * vv.x, a1 = gelu_tanh(pre.y) * vv.y, a2 = gelu_tanh(pre.z) * vv.z, a3 = gelu_tanh(pre.w) * vv.w;
        *(unsigned long long*)(act + (size_t)(pm * 256 + j) * DFF + c) = (unsigned long long)pk2(a0, a1) | ((unsigned long long)pk2(a2, a3) << 32);
    }
    for (int it = F.gw; it < BP * 2 * 16; it += F.ngw) {
        const int b = it >> 5, j = (it >> 4) & 1, c = (it & 15) * 256 + F.lane * 4;
        *(f32x4*)(F.out + O_FFNP + (((size_t)l * BP + b) * 2 + j) * DFF + c) = *(const f32x4*)(last + ((size_t)(8 * b + 7) * 2 + j) * 4096 + c);
    }
    for (int it = F.gw; it < NS * 16; it += F.ngw) {
        const int r = NP + (it >> 4), j = it & 15;
        const int qq = r - NP, b = qq >> 3, t = qq & 7;
        const float* sffn = INP(F, I_SFFN) + ((size_t)l * BS + b) * 2 * DFF;
        const float* g0 = raw + (size_t)qq * 2 * DFF;
        { const int c = j * 256 + F.lane * 4;
            constexpr size_t SL = (size_t)256 * 2 * DFF;
            f32x4 ga = *(const f32x4*)(g0 + c), gb, gc, vv = *(const f32x4*)(g0 + DFF + c);
            if (t >= 1) gb = *(const f32x4*)(g0 - (size_t)2 * DFF + c); else gb = *(const f32x4*)(sffn + DFF + c);
            if (t >= 2) gc = *(const f32x4*)(g0 - (size_t)4 * DFF + c); else gc = *(const f32x4*)(sffn + (size_t)t * DFF + c);
#pragma unroll
            for (int sl = 1; sl < SPLIT_UP; ++sl) { ga += *(const f32x4*)(g0 + sl * SL + c); vv += *(const f32x4*)(g0 + sl * SL + DFF + c);
                if (t >= 1) gb += *(const f32x4*)(g0 + sl * SL - (size_t)2 * DFF + c);
                if (t >= 2) gc += *(const f32x4*)(g0 + sl * SL - (size_t)4 * DFF + c); }
            const f32x4 w0 = *(const f32x4*)(cw + c), w1 = *(const f32x4*)(cw + DFF + c), w2 = *(const f32x4*)(cw + 2 * DFF + c), bb = *(const f32x4*)(cb + c);
            const f32x4 pre = gc * w0 + gb * w1 + ga * w2 + bb;
            const float a0 = gelu_tanh(pre.x) * vv.x, a1 = gelu_tanh(pre.y) * vv.y, a2 = gelu_tanh(pre.z) * vv.z, a3 = gelu_tanh(pre.w) * vv.w;
            *(unsigned long long*)(act + (size_t)r * DFF + c) = (unsigned long long)pk2(a0, a1) | ((unsigned long long)pk2(a2, a3) << 32);
            if (t >= TS - 2) *(f32x4*)(F.out + O_FFNS + (((size_t)l * BS + b) * 2 + (t - (TS - 2))) * DFF + c) = ga;
        }
    }
}

__global__ void __launch_bounds__(NTHR, 2) hymba_fwd(Params prm) {
    extern __shared__ __attribute__((aligned(16))) unsigned char lds_raw[];
    Frame F;
    F.lds = (LAS unsigned char*)lds_raw;
#define REFRESH() do { unsigned z_ = 0u; asm volatile("" : "+v"(z_)); int ln_ = (int)__builtin_amdgcn_mbcnt_hi(~0u, __builtin_amdgcn_mbcnt_lo(~0u, z_)); F.lane = ln_; F.wave = wave_s; F.tid = wave_s * 64 + ln_; \
        F.gw = blockIdx.x * NWAVES + F.wave; \
        const __attribute__((address_space(4))) void* kp_ = (const __attribute__((address_space(4))) void*)__builtin_amdgcn_kernarg_segment_ptr(); asm volatile("" : "+s"(kp_)); \
        F.p = (const __attribute__((address_space(4))) Params*)kp_; F.ws = F.p->ws; F.out = F.p->out; } while (0)
    F.G = gridDim.x; F.ngw = F.G * NWAVES;
    const int wave_s = __builtin_amdgcn_readfirstlane((int)threadIdx.x >> 6);
    REFRESH();
    volatile LAS unsigned* MISC = (volatile LAS unsigned*)(F.lds + MISC_OFF);
    for (int u = F.tid; u < (LDS_BYTES - RING_BYTES) / 4; u += NTHR) ((LAS unsigned*)(F.lds + RING_BYTES))[u] = 0u;
    __syncthreads();
    const int lo = F.p->ph_lo, hi = F.p->ph_hi;
    const bool use_bar = (hi - lo) > 1;
    XcdBarrier bar; bar.bar = (unsigned*)(F.ws + WS_CTL) + 4096; bar.x = 0; bar.st = nullptr;
    if (use_bar) bar = xcd_barrier_post((unsigned*)(F.ws + WS_CTL) + 4096, MISC + 8);
#define IN(k) (lo <= (k) && (k) < hi)
#define SEAM(k) do { if (IN((k) + 1)) { REFRESH(); xcd_barrier(bar, F.tid == 0); } } while (0)

    if (IN(0)) { REFRESH(); phase_prologue(F); SEAM(0); }
    if (IN(1)) { REFRESH();
        pg8::Gemm g{WSP(F, pg8::bf16_t, WS_AS), WSP(F, pg8::bf16_t, WS_WTC), 8 * BS * 512, 256, 1024};
        pg8::CmpOrder S; S.G = F.G; S.c = (int)blockIdx.x;
        pg8::EpiCmp E{WSP(F, float, WS_HS)};
        pg8::gemm_phase<pg8::EpiCmp, pg8::CmpOrder, true, true>(F.lds, g, S, E, F.tid);
        SEAM(1);
    }
    if (IN(2)) { REFRESH(); phase_cmp_finish(F); SEAM(2); }
    for (int l = 0; l < DEPTH; ++l) {
        const int pb = N_PRO + l * PH_PER_LAYER;
        if (IN(pb + 0)) { REFRESH();
            pg8::Gemm g{WSP(F, pg8::bf16_t, WS_XN), WSP(F, pg8::bf16_t, WS_WTIN) + (size_t)l * IN_WP * DM, MROWS, IN_WP, DM};
            pg8::StaticOrder S; S.init(MROWS, IN_WP, F.G, (int)blockIdx.x);
            pg8::EpiF32 E{WSP(F, float, WS_PROJ), PROJ_LD};
            pg8::gemm_phase<pg8::EpiF32, pg8::StaticOrder, true, true>(F.lds, g, S, E, F.tid);
            SEAM(pb + 0);
        }
        if (IN(pb + 1)) { REFRESH(); phase_prep(F, l); SEAM(pb + 1); }
        if (IN(pb + 2)) { REFRESH(); phase_compress(F, l); SEAM(pb + 2); }
        if (IN(pb + 3)) { REFRESH(); phase_attn2(F, l); SEAM(pb + 3); }
        if (IN(pb + 4)) { REFRESH();
            pg8::Gemm g{WSP(F, pg8::bf16_t, WS_MIX), WSP(F, pg8::bf16_t, WS_WTOUT) + (size_t)l * DM * DM, MROWS, DM, DM};
            pg8::TailSplitOrder S; S.init(NP, DM, DM, SPLIT_OUT, F.G, (int)blockIdx.x);
            pg8::EpiB16Split E{WSP(F, pg8::bf16_t, WS_MIXO), WSP(F, float, WS_SLAB), DM, NP / 256};
            pg8::gemm_phase<pg8::EpiB16Split, pg8::TailSplitOrder, true, true>(F.lds, g, S, E, F.tid);
            SEAM(pb + 4);
        }
        if (IN(pb + 5)) { REFRESH(); phase_resid_mix(F, l); SEAM(pb + 5); }
        if (IN(pb + 6)) { REFRESH();
            pg8::Gemm g{WSP(F, pg8::bf16_t, WS_XN), WSP(F, pg8::bf16_t, WS_WTUP) + (size_t)l * 2 * DFF * DM, MROWS, 2 * DFF, DM};
            pg8::StaticOrder S; S.init(MROWS, 2 * DFF, F.G, (int)blockIdx.x);
            pg8::EpiFfn E{WSP(F, pg8::bf16_t, WS_ACT), WSP(F, float, WS_FRAW), WSP(F, float, WS_FHALO), WSP(F, float, WS_FLAST),
                          INP(F, I_FCW) + (size_t)l * 3 * DFF, INP(F, I_FCB) + (size_t)l * DFF, (LAS float*)(F.lds + XB_OFF), NP / 256};
            pg8::gemm_phase<pg8::EpiFfn, pg8::StaticOrder, true, true>(F.lds, g, S, E, F.tid);
            SEAM(pb + 6);
        }
        if (IN(pb + 7)) { REFRESH(); phase_ffn_act(F, l); SEAM(pb + 7); }
        if (IN(pb + 8)) { REFRESH();
            pg8::Gemm g{WSP(F, pg8::bf16_t, WS_ACT), WSP(F, pg8::bf16_t, WS_WTDN) + (size_t)l * DM * DFF, MROWS, DM, DFF};
            pg8::TailSplitOrder S; S.init(NP, DM, DFF, SPLIT_DOWN, F.G, (int)blockIdx.x);
            pg8::EpiB16Split E{WSP(F, pg8::bf16_t, WS_MIXO), WSP(F, float, WS_SLAB), DM, NP / 256};
            pg8::gemm_phase<pg8::EpiB16Split, pg8::TailSplitOrder, true, true>(F.lds, g, S, E, F.tid);
            SEAM(pb + 8);
        }
        if (IN(pb + 9)) { REFRESH(); phase_resid_ffn(F, l); SEAM(pb + 9); }
    }
#undef IN
#undef SEAM
}

#ifndef N_LAUNCH_MODE
#define N_LAUNCH_MODE 1
#endif
extern "C" void kernel_launch(void* const* d_in, const int* in_sizes, int n_in, void* d_out, int out_size, void* d_ws, size_t ws_size, hipStream_t stream) {
    static int grid = 0;
    if (grid == 0) {
        if (n_in != N_IN || (size_t)out_size != O_END || ws_size < WS_END) {
            fprintf(stderr, "kernel_launch: unexpected shapes: n_in %d (want %d), out %d (want %zu), ws %zu (want >= %zu); nothing launched\n", n_in, (int)N_IN, out_size, (size_t)O_END, ws_size, (size_t)WS_END);
            grid = -1; return; }
        int dev = 0, cus = 0, per_cu = 0;
        if (hipGetDevice(&dev) != hipSuccess || hipDeviceGetAttribute(&cus, hipDeviceAttributeMultiprocessorCount, dev) != hipSuccess) { grid = -1; return; }
        if (hipFuncSetAttribute((const void*)hymba_fwd, hipFuncAttributeMaxDynamicSharedMemorySize, LDS_BYTES) != hipSuccess) { fprintf(stderr, "kernel_launch: hipFuncSetAttribute failed\n"); grid = -1; return; }
        if (hipOccupancyMaxActiveBlocksPerMultiprocessor(&per_cu, (const void*)hymba_fwd, NTHR, LDS_BYTES) != hipSuccess || per_cu < 1)
            fprintf(stderr, "kernel_launch: note: occupancy query reports %d workgroups per CU\n", per_cu);
        (void)hipGetLastError();
        grid = cus;
    }
    if (grid < 0) return;
    (void)hipMemsetAsync((char*)d_ws + WS_CTL, 0, CTL_BYTES, stream);
    Params prm{};
    for (int i = 0; i < N_IN; ++i) prm.in[i] = (const float*)d_in[i];
    prm.out = (float*)d_out; prm.ws = (unsigned char*)d_ws;
#if N_LAUNCH_MODE == 1
    prm.ph_lo = 0; prm.ph_hi = N_PHASES;
    hipLaunchKernelGGL(hymba_fwd, dim3(grid), dim3(NTHR), LDS_BYTES, stream, prm);
#else
    for (int ph = 0; ph < N_PHASES; ++ph) {
        prm.ph_lo = ph; prm.ph_hi = ph + 1;
        hipLaunchKernelGGL(hymba_fwd, dim3(grid), dim3(NTHR), LDS_BYTES, stream, prm);
    }
#endif
}
```

```cpp
#include <hip/hip_runtime.h>
#include <cstdio>
#include <cstdint>

namespace pg8 {
#define PG8_LAS __attribute__((address_space(3)))
typedef unsigned short bf16_t;
typedef short bf16x8 __attribute__((ext_vector_type(8)));
typedef float f32x4 __attribute__((ext_vector_type(4)));
typedef unsigned u32x4 __attribute__((ext_vector_type(4)));
constexpr int BM = 256, BK = 64, HALF = 128, HTB = HALF * BK * 2  , STAGE_BYTES = 8 * HTB, NXCD = 8, WGM = 8;

__host__ __device__ __forceinline__ int lds_byte(int r, int c) { const int st = (r >> 4) * 2 + (c >> 5), rr = r & 15, cc = c & 31, ob = rr * 64 + cc * 2; return st * 1024 + (ob ^ (((ob >> 9) & 1) << 5)); }
__host__ __device__ __forceinline__ void stage_rc(int b, int& R, int& C) { const int st = b / 1024, sb = b % 1024, swz = sb ^ (((sb >> 9) & 1) << 5); R = (st >> 1) * 16 + swz / 64; C = (st & 1) * 32 + (swz % 64) / 2; }
__host__ __device__ __forceinline__ int perm32(int rho) { const int n = rho >> 4, i = rho & 15; return 8 * (i >> 2) + 4 * n + (i & 3); }

struct Unit { int pm, pn, kt0, nt; };
struct Gemm { const bf16_t* A; const bf16_t* Bt; int M, N, K; };

struct StaticOrder {
    int nM, nN, nwg, G, c;
    __host__ __device__ __forceinline__ void init(int M, int N, int G_, int c_) { nM = M / BM; nN = N / BM; nwg = nM * nN; G = G_; c = c_; }
    __host__ __device__ __forceinline__ bool next(int i, Unit& u) const {
        const long L = (long)i * G + c; if (L >= nwg) return false;
        int wgid = (int)L; { const int q = nwg / NXCD, r = nwg % NXCD, xcd = wgid % NXCD, off = wgid / NXCD; wgid = (xcd < r ? xcd * (q + 1) : r * (q + 1) + (xcd - r) * q) + off; }
        const int nig = WGM * nN, gid = wgid / nig, fm = gid * WGM, gsz = (nM - fm) < WGM ? (nM - fm) : WGM;
        u.pm = fm + ((wgid % nig) % gsz); u.pn = (wgid % nig) / gsz; u.kt0 = 0; u.nt = 0; return true;
    }
    __device__ __forceinline__ void a_ready(const Unit&) const {}
    __device__ __forceinline__ void done(const Unit&) const {}
};

__device__ __forceinline__ unsigned cvt_pk_bf16(float lo, float hi) { unsigned r; asm volatile("v_cvt_pk_bf16_f32 %0, %1, %2" : "=v"(r) : "v"(lo), "v"(hi)); return r; }
struct EpiF32 {
    static constexpr bool PERM = true, AFTER_DRAIN = false;
    float* O; int ldc;
    __device__ __forceinline__ void operator()(const f32x4 (&acc)[2][2][4][2], const Unit& u, int wr, int wc, int fr, int fq) const {
        const int row0 = u.pm * BM + wr * 64 + fr; const int col0 = u.pn * BM + wc * 32 + 8 * fq;
#pragma unroll
        for (int ai = 0; ai < 2; ++ai)
#pragma unroll
            for (int m = 0; m < 4; ++m) { float* rowp = O + (size_t)(row0 + ai * HALF + m * 16) * ldc + col0;
#pragma unroll
                for (int bj = 0; bj < 2; ++bj) { *(f32x4*)(rowp + bj * HALF) = acc[ai][bj][m][0]; *(f32x4*)(rowp + bj * HALF + 4) = acc[ai][bj][m][1]; } }
    }
};

struct CmpOrder {
    int G, c;
    __device__ __forceinline__ bool next(int i, Unit& u) const { const int L = i * G + c; if (L >= 512) return false; u.pm = L; u.pn = L >> 6; u.kt0 = 0; u.nt = 0; return true; }
    __device__ __forceinline__ void a_ready(const Unit&) const {}
    __device__ __forceinline__ void done(const Unit&) const {}
};
struct EpiCmp {
    static constexpr bool PERM = true, AFTER_DRAIN = false;
    float* O;
    __device__ __forceinline__ void operator()(const f32x4 (&acc)[2][2][4][2], const Unit& u, int wr, int wc, int fr, int fq) const {
        const int row0 = u.pm * BM + wr * 64 + fr; const int col0 = wc * 32 + 8 * fq;
#pragma unroll
        for (int ai = 0; ai < 2; ++ai)
#pragma unroll
            for (int m = 0; m < 4; ++m) { float* rowp = O + (size_t)(row0 + ai * HALF + m * 16) * 256 + col0;
#pragma unroll
                for (int bj = 0; bj < 2; ++bj) { *(f32x4*)(rowp + bj * HALF) = acc[ai][bj][m][0]; *(f32x4*)(rowp + bj * HALF + 4) = acc[ai][bj][m][1]; } }
    }
};

struct EpiB16 {
    static constexpr bool PERM = true, AFTER_DRAIN = false;
    bf16_t* O; int ldc;
    __device__ __forceinline__ void operator()(const f32x4 (&acc)[2][2][4][2], const Unit& u, int wr, int wc, int fr, int fq) const {
        const int row0 = u.pm * BM + wr * 64 + fr; const int col0 = u.pn * BM + wc * 32 + 8 * fq;
#pragma unroll
        for (int ai = 0; ai < 2; ++ai)
#pragma unroll
            for (int m = 0; m < 4; ++m) { bf16_t* rowp = O + (size_t)(row0 + ai * HALF + m * 16) * ldc + col0;
#pragma unroll
                for (int bj = 0; bj < 2; ++bj) { const f32x4 v0 = acc[ai][bj][m][0], v1 = acc[ai][bj][m][1];
                    u32x4 w; w.x = cvt_pk_bf16(v0[0], v0[1]); w.y = cvt_pk_bf16(v0[2], v0[3]); w.z = cvt_pk_bf16(v1[0], v1[1]); w.w = cvt_pk_bf16(v1[2], v1[3]);
                    *(u32x4*)(rowp + bj * HALF) = w; } }
    }
};

struct TailSplitOrder {
    StaticOrder P; int nN, ntf, split;
    __device__ __forceinline__ void init(int Mp, int N, int K, int split_, int G, int c) { P.init(Mp, N, G, c); nN = N / BM; ntf = K / BK; split = split_; }
    __device__ __forceinline__ bool next(int i, Unit& u) const {
        const int L = i * P.G + P.c; const bool isp = L < P.nwg;
        int wgid = isp ? L : 0; { const int q = P.nwg / NXCD, r = P.nwg % NXCD, xcd = wgid % NXCD, off = wgid / NXCD; wgid = (xcd < r ? xcd * (q + 1) : r * (q + 1) + (xcd - r) * q) + off; }
        const int nig = WGM * P.nN, gid = wgid / nig, fm = gid * WGM, gsz = (P.nM - fm) < WGM ? (P.nM - fm) : WGM;
        const int ppm = fm + ((wgid % nig) % gsz), ppn = (wgid % nig) / gsz;
        const int t = L - P.nwg, nts = ntf / split;
        u.pm = isp ? ppm : P.nM; u.pn = isp ? ppn : t % nN; u.nt = isp ? 0 : nts; u.kt0 = isp ? 0 : (t / nN) * nts;
        return isp || t < nN * split;
    }
    __device__ __forceinline__ void a_ready(const Unit&) const {}
    __device__ __forceinline__ void done(const Unit&) const {}
};
struct EpiB16Split {
    static constexpr bool PERM = true, AFTER_DRAIN = false;
    bf16_t* O; float* S; int ldc; int tail_pm;
    __device__ __forceinline__ void operator()(const f32x4 (&acc)[2][2][4][2], const Unit& u, int wr, int wc, int fr, int fq) const {
        const int col0 = u.pn * BM + wc * 32 + 8 * fq;
        if (u.pm < tail_pm) {
            bf16_t* base = O + (size_t)(u.pm * BM + wr * 64 + fr) * ldc + col0;
#pragma unroll
            for (int ai = 0; ai < 2; ++ai)
#pragma unroll
                for (int m = 0; m < 4; ++m) { bf16_t* rowp = base + (size_t)(ai * HALF + m * 16) * ldc;
#pragma unroll
                    for (int bj = 0; bj < 2; ++bj) { const f32x4 v0 = acc[ai][bj][m][0], v1 = acc[ai][bj][m][1];
                        u32x4 w; w.x = cvt_pk_bf16(v0[0], v0[1]); w.y = cvt_pk_bf16(v0[2], v0[3]); w.z = cvt_pk_bf16(v1[0], v1[1]); w.w = cvt_pk_bf16(v1[2], v1[3]);
                        *(u32x4*)(rowp + bj * HALF) = w; } }
        } else {
            float* base = S + ((size_t)(u.kt0 / (u.nt ? u.nt : 1)) * BM + wr * 64 + fr) * ldc + col0;
#pragma unroll
            for (int ai = 0; ai < 2; ++ai)
#pragma unroll
                for (int m = 0; m < 4; ++m) { float* rowp = base + (size_t)(ai * HALF + m * 16) * ldc;
#pragma unroll
                    for (int bj = 0; bj < 2; ++bj) { *(f32x4*)(rowp + bj * HALF) = acc[ai][bj][m][0]; *(f32x4*)(rowp + bj * HALF + 4) = acc[ai][bj][m][1]; } }
        }
    }
};
struct EpiF32Split {
    static constexpr bool PERM = true, AFTER_DRAIN = false;
    float* O; float* S; int ldc; int tail_pm;
    __device__ __forceinline__ void operator()(const f32x4 (&acc)[2][2][4][2], const Unit& u, int wr, int wc, int fr, int fq) const {
        const int col0 = u.pn * BM + wc * 32 + 8 * fq;
        float* base = (u.pm < tail_pm) ? O + (size_t)(u.pm * BM + wr * 64 + fr) * ldc : S + ((size_t)(u.kt0 / (u.nt ? u.nt : 1)) * BM + wr * 64 + fr) * ldc;
#pragma unroll
        for (int ai = 0; ai < 2; ++ai)
#pragma unroll
            for (int m = 0; m < 4; ++m) { float* rowp = base + (size_t)(ai * HALF + m * 16) * ldc + col0;
#pragma unroll
                for (int bj = 0; bj < 2; ++bj) { *(f32x4*)(rowp + bj * HALF) = acc[ai][bj][m][0]; *(f32x4*)(rowp + bj * HALF + 4) = acc[ai][bj][m][1]; } }
    }
};

__device__ __forceinline__ float dpp_ror1(float v) { return __builtin_bit_cast(float, __builtin_amdgcn_update_dpp(0, __builtin_bit_cast(int, v), 0x121, 0xf, 0xf, false)); }
__device__ __forceinline__ float dpp_ror2(float v) { return __builtin_bit_cast(float, __builtin_amdgcn_update_dpp(0, __builtin_bit_cast(int, v), 0x122, 0xf, 0xf, false)); }
__device__ __forceinline__ float dpp_shr1(float old, float v) { return __builtin_bit_cast(float, __builtin_amdgcn_update_dpp(__builtin_bit_cast(int, old), __builtin_bit_cast(int, v), 0x111, 0xf, 0xf, false)); }
__device__ __forceinline__ float dpp_shr2(float old, float v) { return __builtin_bit_cast(float, __builtin_amdgcn_update_dpp(__builtin_bit_cast(int, old), __builtin_bit_cast(int, v), 0x112, 0xf, 0xf, false)); }
__device__ __forceinline__ float gelu_t(float x) {
    const float p = x * __builtin_fmaf(x * x, 0.044715f * 2.302208198f, 2.302208198f);
    return x * __builtin_amdgcn_rcpf(1.f + __builtin_amdgcn_exp2f(-p));
}
struct EpiFfn {
    static constexpr bool PERM = true, AFTER_DRAIN = false;
    bf16_t* ACT;
    float* RAW;
    float* HALO;
    float* LAST;
    const float* cw; const float* cb;
    PG8_LAS float* xb;
    int tail_pm;
    __device__ __forceinline__ void operator()(const f32x4 (&acc)[2][2][4][2], const Unit& u, int wr, int wc, int fr_in, int fq_in) const {
        int fr = fr_in, fq = fq_in; asm volatile("" : "+v"(fr), "+v"(fq));
        const int colt = wc * 32 + 8 * fq, gcol = u.pn * 128 + colt;
        const bool tail = (u.pm >= tail_pm);
#pragma unroll
        for (int ai = 0; ai < 2; ++ai) {
            if (fr >= 14) { PG8_LAS float* d = xb + ((ai * 2 + wr) * 2 + (fr - 14)) * 128 + colt;
                *(PG8_LAS f32x4*)d = acc[ai][0][3][0]; *(PG8_LAS f32x4*)(d + 4) = acc[ai][0][3][1]; }
        }
        if (!tail) {
            if (wr == 1 && fr >= 14) { float* d = LAST + ((size_t)u.pm * 2 + (fr - 14)) * 4096 + gcol; *(f32x4*)d = acc[1][0][3][0]; *(f32x4*)(d + 4) = acc[1][0][3][1]; }
            if (wr == 0 && fr < 2) { float* d = HALO + ((size_t)u.pm * 2 + fr) * 8192 + gcol;
                *(f32x4*)d = acc[0][0][0][0]; *(f32x4*)(d + 4) = acc[0][0][0][1]; *(f32x4*)(d + 4096) = acc[0][1][0][0]; *(f32x4*)(d + 4096 + 4) = acc[0][1][0][1]; }
        } else {
#pragma unroll
            for (int ai = 0; ai < 2; ++ai)
#pragma unroll
                for (int m = 0; m < 4; ++m) { float* d = RAW + ((size_t)(u.kt0 / (u.nt ? u.nt : 1)) * BM + ai * HALF + wr * 64 + m * 16 + fr) * 8192 + gcol;
                    *(f32x4*)d = acc[ai][0][m][0]; *(f32x4*)(d + 4) = acc[ai][0][m][1]; *(f32x4*)(d + 4096) = acc[ai][1][m][0]; *(f32x4*)(d + 4096 + 4) = acc[ai][1][m][1]; }
        }
        asm volatile("s_waitcnt lgkmcnt(0)" ::: "memory");
        __builtin_amdgcn_s_barrier();
        if (tail) return;
#pragma unroll
        for (int n = 0; n < 2; ++n) {
            const f32x4 w0 = *(const f32x4*)(cw + gcol + 4 * n), w1 = *(const f32x4*)(cw + 4096 + gcol + 4 * n), w2 = *(const f32x4*)(cw + 8192 + gcol + 4 * n), bb = *(const f32x4*)(cb + gcol + 4 * n);
#pragma unroll
            for (int ai = 0; ai < 2; ++ai) {
                const int pgrp = (wr == 1) ? (ai * 2 + 0) : (0 * 2 + 1);
                const f32x4 pv = *(const PG8_LAS f32x4*)(xb + (pgrp * 2 + (fr == 15 ? 1 : 0)) * 128 + colt + 4 * n);
#pragma unroll
                for (int m = 0; m < 4; ++m) {
                    float a4[4];
#pragma unroll
                    for (int k = 0; k < 4; ++k) {
                        const float cur = acc[ai][0][m][n][k]; const float prm = (m > 0) ? acc[ai][0][m > 0 ? m - 1 : 0][n][k] : pv[k];
                        const float p1 = dpp_shr1(dpp_ror1(prm), cur), p2 = dpp_shr2(dpp_ror2(prm), cur);
                        const float pre = w0[k] * p2 + w1[k] * p1 + w2[k] * cur + bb[k];
                        a4[k] = gelu_t(pre) * acc[ai][1][m][n][k];
                    }
                    const bool deferred = (ai == 0 && wr == 0 && m == 0 && fr < 2);
                    if (!deferred) *(unsigned long long*)(ACT + (size_t)(u.pm * BM + ai * HALF + wr * 64 + m * 16 + fr) * 4096 + gcol + 4 * n) =
                        (unsigned long long)cvt_pk_bf16(a4[0], a4[1]) | ((unsigned long long)cvt_pk_bf16(a4[2], a4[3]) << 32);
                }
            }
        }
    }
};
template <class Epi, class Sched, bool ALIGN_EPI = false, bool SP2 = false>
__device__ __forceinline__ void gemm_phase(PG8_LAS unsigned char* lds, const Gemm g, const Sched& S, const Epi& E, const int tid_in) {
    int tid_ = tid_in; asm volatile("" : "+v"(tid_));
    const int tid = tid_, wid = __builtin_amdgcn_readfirstlane(tid >> 6), lane = tid & 63, wr = wid >> 2, wc = wid & 3, fr = lane & 15, fq = lane >> 4;
    const int K = g.K, ntf = K / BK;
    unsigned voffA[2], voffB[2];
#pragma unroll
    for (int i = 0; i < 2; ++i) { int R, C; stage_rc(tid * 16 + i * 8192, R, C); const int Rb = Epi::PERM ? ((R & ~31) + perm32(R & 31)) : R;
        voffA[i] = (unsigned)(R * K + C) * 2u; voffB[i] = (unsigned)(Rb * K + C) * 2u; }
    const size_t kstep = (size_t)(BK * 2);
    const size_t hstep = (size_t)HALF * K * 2;
    const size_t tstep = 2 * hstep;
    const unsigned ldsw = (unsigned)wid * 1024u;
    const int aoff = lds_byte(wr * 64 + fr, fq * 8), boff = lds_byte(wc * 32 + fr, fq * 8);
#define PG8_SA(b, h) (((b) * 2 + (h)) * HTB)
#define PG8_SB(b, h) ((4 + (b) * 2 + (h)) * HTB)
#define PG8_STAGE(bufoff, gbase, voff) do { _Pragma("unroll") for (int _i = 0; _i < 2; ++_i) \
        __builtin_amdgcn_global_load_lds((const unsigned*)((const char*)(gbase) + (voff)[_i]), (PG8_LAS unsigned*)(lds + (bufoff) + ldsw + _i * 8192), 16, 0, 0); } while (0)
#define PG8_LDA(dst, b, h) do { _Pragma("unroll") for (int m = 0; m < 4; ++m) _Pragma("unroll") for (int k = 0; k < 2; ++k) dst[m][k] = *(const PG8_LAS bf16x8*)(lds + PG8_SA(b, h) + aoff + m * 2048 + k * 1024); } while (0)
#define PG8_LDB(dst, b, h) do { _Pragma("unroll") for (int n = 0; n < 2; ++n) _Pragma("unroll") for (int k = 0; k < 2; ++k) dst[n][k] = *(const PG8_LAS bf16x8*)(lds + PG8_SB(b, h) + boff + n * 2048 + k * 1024); } while (0)
#define PG8_MMA(ai, bj, At, Bt) do { __builtin_amdgcn_s_setprio(1); _Pragma("unroll") for (int m = 0; m < 4; ++m) _Pragma("unroll") for (int n = 0; n < 2; ++n) _Pragma("unroll") for (int k = 0; k < 2; ++k) \
        acc[ai][bj][m][n] = __builtin_amdgcn_mfma_f32_16x16x32_bf16(Bt[n][k], At[m][k], acc[ai][bj][m][n], 0, 0, 0); __builtin_amdgcn_s_setprio(0); } while (0)
#define PG8_WAIT_V(n) asm volatile("s_waitcnt vmcnt(" #n ")" ::: "memory")
#define PG8_WAIT_L(n) asm volatile("s_waitcnt lgkmcnt(" #n ")" ::: "memory")
#define PG8_BAR __builtin_amdgcn_s_barrier()
#define PG8_SCHED __builtin_amdgcn_sched_barrier(0)
    Unit cur = {0, 0, 0, 0}, nxt = {0, 0, 0, 0}; int ui = 0;
    if (!S.next(0, cur)) return;
    f32x4 acc[2][2][4][2];
#pragma unroll
    for (int a = 0; a < 2; ++a)
#pragma unroll
        for (int b = 0; b < 2; ++b)
#pragma unroll
            for (int m = 0; m < 4; ++m)
#pragma unroll
                for (int n = 0; n < 2; ++n) acc[a][b][m][n] = (f32x4){0.f, 0.f, 0.f, 0.f};
    bf16x8 At[4][2], B0[2][2], B1[2][2];
    const char* cA = (const char*)g.A + (size_t)cur.pm * tstep + (size_t)cur.kt0 * kstep; const char* cB = (const char*)g.Bt + (size_t)cur.pn * tstep + (size_t)cur.kt0 * kstep;
    S.a_ready(cur);
    if constexpr (SP2) {
        PG8_STAGE(PG8_SB(0, 0), cB, voffB); PG8_STAGE(PG8_SB(0, 1), cB + hstep, voffB); PG8_STAGE(PG8_SA(0, 0), cA, voffA); PG8_STAGE(PG8_SA(0, 1), cA + hstep, voffA);
        if (wr == 1) PG8_BAR;
        PG8_WAIT_V(2); PG8_BAR;
        PG8_STAGE(PG8_SB(1, 0), cB + kstep, voffB); PG8_STAGE(PG8_SA(1, 0), cA + kstep, voffA); PG8_STAGE(PG8_SB(1, 1), cB + hstep + kstep, voffB);
        PG8_WAIT_V(6); PG8_BAR;
    } else {
        PG8_STAGE(PG8_SB(0, 0), cB, voffB); PG8_STAGE(PG8_SA(0, 0), cA, voffA); PG8_STAGE(PG8_SB(0, 1), cB + hstep, voffB); PG8_STAGE(PG8_SA(0, 1), cA + hstep, voffA);
        if (wr == 1) PG8_BAR;
        PG8_WAIT_V(4); PG8_BAR;
        PG8_STAGE(PG8_SB(1, 0), cB + kstep, voffB); PG8_STAGE(PG8_SA(1, 0), cA + kstep, voffA); PG8_STAGE(PG8_SB(1, 1), cB + hstep + kstep, voffB);
        PG8_WAIT_V(6); PG8_BAR;
    }
    for (;;) {
        const bool has_next = S.next(ui + 1, nxt);
        const char* nA = has_next ? (const char*)g.A + (size_t)nxt.pm * tstep + (size_t)nxt.kt0 * kstep : cA; const char* nB = has_next ? (const char*)g.Bt + (size_t)nxt.pn * tstep + (size_t)nxt.kt0 * kstep : cB;
        const int nt = cur.nt ? cur.nt : ntf;
        for (int t = 0; t < nt; t += 2) {
            const bool last = (t == nt - 2);
            const char* a1 = cA + (size_t)(t + 1) * kstep;
            const char* a2 = last ? nA : cA + (size_t)(t + 2) * kstep; const char* b2 = last ? nB : cB + (size_t)(t + 2) * kstep;
            const char* a3 = a2 + kstep; const char* b3 = b2 + kstep;
            if (last && has_next) S.a_ready(nxt);
            if constexpr (SP2) {
            PG8_LDB(B0, 0, 0); PG8_LDB(B1, 0, 1); PG8_SCHED; PG8_LDA(At, 0, 0); PG8_STAGE(PG8_SA(1, 1), a1 + hstep, voffA);
            PG8_WAIT_V(8); PG8_WAIT_L(0); PG8_BAR; PG8_MMA(0, 0, At, B0); PG8_MMA(0, 1, At, B1); PG8_BAR; PG8_SCHED;
            PG8_LDA(At, 0, 1); PG8_STAGE(PG8_SB(0, 0), b2, voffB); PG8_STAGE(PG8_SB(0, 1), b2 + hstep, voffB); PG8_STAGE(PG8_SA(0, 0), a2, voffA);
            PG8_WAIT_V(8); PG8_WAIT_L(0); PG8_BAR; PG8_MMA(1, 0, At, B0); PG8_MMA(1, 1, At, B1); PG8_BAR; PG8_SCHED;
            PG8_LDB(B0, 1, 0); PG8_LDB(B1, 1, 1); PG8_SCHED; PG8_LDA(At, 1, 0); PG8_STAGE(PG8_SA(0, 1), a2 + hstep, voffA);
            PG8_WAIT_V(8); PG8_WAIT_L(0); PG8_BAR; PG8_MMA(0, 0, At, B0); PG8_MMA(0, 1, At, B1); PG8_BAR; PG8_SCHED;
            PG8_LDA(At, 1, 1); PG8_STAGE(PG8_SB(1, 0), b3, voffB); PG8_STAGE(PG8_SB(1, 1), b3 + hstep, voffB); PG8_STAGE(PG8_SA(1, 0), a3, voffA);
            PG8_WAIT_V(8); PG8_WAIT_L(0); PG8_BAR; PG8_MMA(1, 0, At, B0); PG8_MMA(1, 1, At, B1); PG8_BAR; PG8_SCHED;
            } else {
            PG8_LDB(B0, 0, 0); PG8_SCHED; PG8_LDA(At, 0, 0); PG8_STAGE(PG8_SA(1, 1), a1 + hstep, voffA);
            PG8_WAIT_L(8); PG8_BAR; PG8_WAIT_L(0); PG8_MMA(0, 0, At, B0); PG8_BAR; PG8_SCHED;
            PG8_LDB(B1, 0, 1); PG8_STAGE(PG8_SB(0, 0), b2, voffB);
            PG8_BAR; PG8_WAIT_L(0); PG8_MMA(0, 1, At, B1); PG8_BAR;
            PG8_LDA(At, 0, 1); PG8_STAGE(PG8_SA(0, 0), a2, voffA);
            PG8_BAR; PG8_WAIT_L(0); PG8_MMA(1, 0, At, B0); PG8_BAR; PG8_SCHED;
            PG8_STAGE(PG8_SB(0, 1), b2 + hstep, voffB);
            PG8_WAIT_V(6); PG8_BAR; PG8_MMA(1, 1, At, B1); PG8_BAR;
            PG8_LDB(B0, 1, 0); PG8_SCHED; PG8_LDA(At, 1, 0); PG8_STAGE(PG8_SA(0, 1), a2 + hstep, voffA);
            PG8_WAIT_L(8); PG8_BAR; PG8_WAIT_L(0); PG8_MMA(0, 0, At, B0); PG8_BAR; PG8_SCHED;
            PG8_LDB(B1, 1, 1); PG8_STAGE(PG8_SB(1, 0), b3, voffB);
            PG8_BAR; PG8_WAIT_L(0); PG8_MMA(0, 1, At, B1); PG8_BAR;
            PG8_LDA(At, 1, 1); PG8_STAGE(PG8_SA(1, 0), a3, voffA);
            PG8_BAR; PG8_WAIT_L(0); PG8_MMA(1, 0, At, B0); PG8_BAR; PG8_SCHED;
            PG8_STAGE(PG8_SB(1, 1), b3 + hstep, voffB);
            PG8_WAIT_V(6); PG8_BAR; PG8_MMA(1, 1, At, B1); PG8_BAR;
            }
        }
        if constexpr (ALIGN_EPI) { if (wr == 0) PG8_BAR; }
        if constexpr (!Epi::AFTER_DRAIN) { E(acc, cur, wr, wc, fr, fq); S.done(cur); }
        if (!has_next) break;
#pragma unroll
        for (int a = 0; a < 2; ++a)
#pragma unroll
            for (int b = 0; b < 2; ++b)
#pragma unroll
                for (int m = 0; m < 4; ++m)
#pragma unroll
                    for (int n = 0; n < 2; ++n) acc[a][b][m][n] = (f32x4){0.f, 0.f, 0.f, 0.f};
        cur = nxt; cA = nA; cB = nB; ++ui;
        if constexpr (ALIGN_EPI) { if (wr == 1) PG8_BAR; }
    }
    PG8_WAIT_V(0);
    if constexpr (!ALIGN_EPI) { if (wr == 0) PG8_BAR; }
    PG8_BAR;
    if constexpr (Epi::AFTER_DRAIN) { E.fused(acc, cur, wr, wc, fr, fq, lds, wid, lane); S.done(cur); }
#undef PG8_SA
#undef PG8_SB
#undef PG8_STAGE
#undef PG8_LDA
#undef PG8_LDB
#undef PG8_MMA
#undef PG8_WAIT_V
#undef PG8_WAIT_L
#undef PG8_BAR
#undef PG8_SCHED
}
}

#define GAS __attribute__((address_space(1)))
#define LAS __attribute__((address_space(3)))
typedef unsigned short bf16;
typedef unsigned v4u __attribute__((ext_vector_type(4)));
typedef float f32x4 __attribute__((ext_vector_type(4)));
typedef short bf16x8 __attribute__((ext_vector_type(8)));

constexpr int DM = 1024, BP = 8, TP = 2048, DEPTH = 4, BS = 32, TS = 8, PAST = 8192, PAGE = 128;
constexpr int NP = BP * TP, NS = BS * TS, MROWS = NP + NS;
constexpr int NSEQ = BP + BS;
constexpr int SSD_W = 512, SSD_H = 8, SSD_HD = 64, SSD_N = 128, CONV_DIM = 1024;
constexpr int POOL_W = 256, POOL_KEEP = 15;
constexpr int NSA_H = 4, NSA_HD = 64;
constexpr int OFF_XBC = 512, OFF_DT = 1536, OFF_POOL = 1544, OFF_Q = 1800, OFF_KV = 2056, OFF_G = 2440, IN_W = 2452, IN_WP = 2560;
constexpr int DFF = 4096;
constexpr int NPHYS = 2560, NPAGES = 64;
constexpr int NCMP_P = 127, NCMP_S = 511;
constexpr float RMS_EPS = 1e-6f;

constexpr size_t O_YP = 0;
constexpr size_t O_YS = O_YP + (size_t)NP * DM;
constexpr size_t O_KVP = O_YS + (size_t)NS * DM;
constexpr size_t O_KVS = O_KVP + (size_t)DEPTH * NP * 256;
constexpr size_t O_WINP = O_KVS + (size_t)DEPTH * NS * 256;
constexpr size_t O_WINS = O_WINP + (size_t)DEPTH * BP * 512 * 128;
constexpr size_t O_CONVP = O_WINS + (size_t)DEPTH * BS * 512 * 128;
constexpr size_t O_CONVS = O_CONVP + (size_t)DEPTH * BP * 3 * 1024;
constexpr size_t O_SSMP = O_CONVS + (size_t)DEPTH * BS * 3 * 1024;
constexpr size_t O_SSMS = O_SSMP + (size_t)DEPTH * BP * 8 * 64 * 128;
constexpr size_t O_POOLP = O_SSMS + (size_t)DEPTH * BS * 8 * 64 * 128;
constexpr size_t O_POOLS = O_POOLP + (size_t)DEPTH * BP * 15 * 256;
constexpr size_t O_FFNP = O_POOLS + (size_t)DEPTH * BS * 15 * 256;
constexpr size_t O_FFNS = O_FFNP + (size_t)DEPTH * BP * 2 * 4096;
constexpr size_t O_END = O_FFNS + (size_t)DEPTH * BS * 2 * 4096;

enum { I_XP = 0, I_XS, I_CACHE, I_PT, I_SWIN, I_SCONV, I_SSM, I_SPOOL, I_SFFN, I_NMPRE, I_WIN, I_CONVW, I_CONVB, I_DTB, I_ALOG, I_SSDD, I_SSDNORM,
       I_POOLW, I_POOLSC, I_PEK, I_PEV, I_W1K, I_W1V, I_W2K, I_W2V, I_WOUT, I_NMPOST, I_NFPRE, I_WGATE, I_WVAL, I_FCW, I_FCB, I_WDOWN, I_NFPOST, N_IN };

constexpr size_t al256(size_t x) { return (x + 255) & ~(size_t)255; }
constexpr size_t WS_CTL = 0, CTL_BYTES = 1u << 20;
constexpr size_t WS_WTIN = WS_CTL + CTL_BYTES;
constexpr size_t WS_WTOUT = WS_WTIN + (size_t)DEPTH * IN_WP * DM * 2;
constexpr size_t WS_WTUP = WS_WTOUT + (size_t)DEPTH * DM * DM * 2;
constexpr size_t WS_WTDN = WS_WTUP + (size_t)DEPTH * 2 * DFF * DM * 2;
constexpr size_t WS_ROPE = WS_WTDN + (size_t)DEPTH * DM * DFF * 2;
constexpr size_t WS_X = WS_ROPE + al256((size_t)2056 * 16 * 4);
constexpr size_t WS_XN = WS_X + (size_t)MROWS * DM * 4;
constexpr size_t WS_PROJ = WS_XN + (size_t)MROWS * DM * 2;
constexpr size_t WS_YSSD = WS_PROJ + (size_t)MROWS * IN_WP * 4;
constexpr size_t WS_Q = WS_YSSD + (size_t)MROWS * SSD_W * 4;
constexpr size_t WS_KWIN = WS_Q + (size_t)MROWS * 256 * 4;
constexpr size_t WS_CKP = WS_KWIN + (size_t)MROWS * 128 * 4;
constexpr size_t WS_CVP = WS_CKP + al256((size_t)BP * NCMP_P * 64 * 4);
constexpr size_t WS_CKS = WS_CVP + al256((size_t)BP * NCMP_P * 64 * 4);
constexpr size_t WS_CVS = WS_CKS + al256((size_t)DEPTH * BS * NCMP_S * 64 * 4);
constexpr size_t WS_MIX = WS_CVS + al256((size_t)DEPTH * BS * NCMP_S * 64 * 4);
constexpr size_t WS_MIXO = WS_MIX + (size_t)MROWS * DM * 2;
constexpr size_t WS_GV = WS_MIXO + (size_t)MROWS * DM * 4;
constexpr size_t WS_ACT = WS_GV + (size_t)MROWS * 2 * DFF * 4;
constexpr size_t WS_QB = WS_ACT + (size_t)MROWS * DFF * 2;
constexpr size_t WS_SAC = WS_QB + (size_t)MROWS * 256 * 2;
constexpr size_t WS_SCD = WS_SAC + (size_t)NP * 8 * 4;
constexpr size_t WS_SCB = WS_SCD + al256((size_t)BP * 16 * 8 * 4);
constexpr size_t WS_SCS = WS_SCB + (size_t)NP * 256 * 2;
constexpr size_t WS_SHS = WS_SCS + (size_t)BP * 16 * 8 * 8192 * 4;
constexpr size_t WS_WTC = WS_SHS + (size_t)BP * 16 * 8 * 8192 * 2;
constexpr size_t WS_CBIAS = WS_WTC + (size_t)8 * 256 * 1024 * 2;
constexpr size_t WS_AS = WS_GV;
constexpr size_t WS_HS = WS_AS + (size_t)8 * BS * 512 * 1024 * 2;
static_assert(WS_HS + (size_t)8 * BS * 512 * 256 * 4 <= WS_GV + (size_t)MROWS * 2 * DFF * 4, "prologue buffers must fit inside the GV region");
constexpr size_t WS_SLAB = WS_CBIAS + 8 * 128 * 4;
constexpr size_t WS_W2T = WS_SLAB + (size_t)8 * 256 * DM * 4;
constexpr size_t WS_FRAW = WS_W2T + (size_t)8 * 64 * 128 * 2;
constexpr int SPLIT_UP = 1;
constexpr size_t WS_FHALO = WS_FRAW + (size_t)SPLIT_UP * 256 * 2 * DFF * 4;
constexpr size_t WS_FLAST = WS_FHALO + (size_t)64 * 2 * 2 * DFF * 4;
constexpr size_t WS_END = WS_FLAST + (size_t)64 * 2 * DFF * 4;
constexpr int SPLIT_OUT = 4, SPLIT_DOWN = 8;

constexpr int RING_BYTES = 131072;
constexpr int MISC_OFF = RING_BYTES + 320;
constexpr int LDS_BYTES = 147456;
constexpr int NWAVES = 8, NTHR = 512;
constexpr int XB_OFF = RING_BYTES + 1024;
static_assert(XB_OFF + 4096 <= LDS_BYTES, "LDS map");

constexpr int PH_PER_LAYER = 10, N_PRO = 3, N_PHASES = N_PRO + DEPTH * PH_PER_LAYER;

struct Params { const float* in[N_IN]; float* out; unsigned char* ws; int ph_lo, ph_hi; };

__device__ __forceinline__ unsigned f2bf(float f) { unsigned u = __builtin_bit_cast(unsigned, f); return (u + 0x7fffu + ((u >> 16) & 1u)) >> 16; }
__device__ __forceinline__ unsigned pk2(float lo, float hi) { return f2bf(lo) | (f2bf(hi) << 16); }
__device__ __forceinline__ f32x4 bf4_to_f32(unsigned long long u) {
    return (f32x4){__uint_as_float((unsigned)u << 16), __uint_as_float((unsigned)u & 0xffff0000u), __uint_as_float((unsigned)(u >> 32) << 16), __uint_as_float((unsigned)(u >> 32) & 0xffff0000u)};
}
__device__ __forceinline__ float wave_sum(float v) {
#pragma unroll
    for (int o = 1; o < 64; o <<= 1) v += __shfl_xor(v, o);
    return v;
}
__device__ __forceinline__ float sum16(float v) {
#pragma unroll
    for (int o = 1; o < 16; o <<= 1) v += __shfl_xor(v, o);
    return v;
}
__device__ __forceinline__ float sigmoidf_(float x) { return 1.f / (1.f + expf(-x)); }
__device__ __forceinline__ float siluf_(float x) { return x / (1.f + expf(-x)); }
__device__ __forceinline__ float softplusf_(float x) { return x > 0.f ? x + log1pf(expf(-x)) : log1pf(expf(x)); }
__device__ __forceinline__ float gelu_tanh(float x) {
    const float u = 0.7978845608028654f * (x + 0.044715f * x * x * x);
    const float t = 1.f - 2.f / (expf(2.f * u) + 1.f);
    return 0.5f * x * (1.f + t);
}
__device__ __forceinline__ void cossin_d(float angf, float& c, float& s) {
    const double a = (double)angf;
    const double k = rint(a * 0.63661977236758134308);
    const double r = (a - k * 1.57079632679489655800) - k * 6.123233995736766036e-17;
    const double r2 = r * r;
    double sp = r * (1.0 + r2 * (-1.0 / 6 + r2 * (1.0 / 120 + r2 * (-1.0 / 5040 + r2 * (1.0 / 362880 + r2 * (-1.0 / 39916800 + r2 * (1.0 / 6227020800.0)))))));
    double cp = 1.0 + r2 * (-0.5 + r2 * (1.0 / 24 + r2 * (-1.0 / 720 + r2 * (1.0 / 40320 + r2 * (-1.0 / 3628800 + r2 * (1.0 / 479001600.0 + r2 * (-1.0 / 87178291200.0)))))));
    const int q = ((int)k) & 3;
    double cc = (q == 0) ? cp : (q == 1) ? -sp : (q == 2) ? -cp : sp;
    double ss = (q == 0) ? sp : (q == 1) ? cp : (q == 2) ? -sp : -cp;
    c = (float)cc; s = (float)ss;
}

struct Seq { int T, row0, pos0, b, samp; };
__device__ __forceinline__ Seq seq_of(int s) {
    Seq q;
    if (s < BP) { q.T = TP; q.row0 = s * TP; q.pos0 = 0; q.b = s; q.samp = 0; }
    else { q.T = TS; q.row0 = NP + (s - BP) * TS; q.pos0 = PAST; q.b = s - BP; q.samp = 1; }
    return q;
}
__device__ __forceinline__ void row_to_seq(int r, int& s, int& t) {
    if (r < NP) { s = r >> 11; t = r & (TP - 1); } else { const int q = r - NP; s = BP + (q >> 3); t = q & 7; }
}

#define XB_TMO      128
#define XB_XCNT(j)  (256  + 64 * (j))
#define XB_XSUB(j)  (1280 + 64 * (j))
#define XB_XGEN(j)  (2304 + 64 * (j))
#define XB_TOP      3328
#define XB_TOPGEN   3392
#define XCD_BAR_WORDS 3456
#define XB_SPIN_CAP (1u << 21)
__device__ __forceinline__ unsigned xb_ld(unsigned* p)              { return __hip_atomic_load(p, __ATOMIC_RELAXED, __HIP_MEMORY_SCOPE_AGENT); }
__device__ __forceinline__ unsigned xb_add(unsigned* p, unsigned v) { return __hip_atomic_fetch_add(p, v, __ATOMIC_RELAXED, __HIP_MEMORY_SCOPE_AGENT); }
__device__ __forceinline__ unsigned xb_xcc_id() { return (unsigned)__builtin_amdgcn_s_getreg((3 << 11) | 20) & 0xFu; }
#define XB_SPIN(cond, bar) do { unsigned _sp = 0; while (cond) { __builtin_amdgcn_s_sleep(1); \
    if ((++_sp & 255u) == 0u) { if (xb_ld(&(bar)[XB_TMO])) break; if (_sp > XB_SPIN_CAP) { atomicAdd(&(bar)[XB_TMO], 1u); break; } } } } while (0)
struct XcdBarrier { unsigned* bar; unsigned x; volatile LAS unsigned* st; };
__device__ __forceinline__ XcdBarrier xcd_barrier_post(unsigned* bar, volatile LAS unsigned* st) {
    XcdBarrier b; b.bar = bar; b.x = xb_xcc_id(); b.st = st;
    if (threadIdx.x == 0) (void)xb_add(&bar[XB_XCNT(b.x)], 1u);
    return b;
}
__device__ __forceinline__ void xcd_barrier_complete(unsigned* bar, unsigned x, unsigned& nloc, unsigned& nx) {
    const unsigned G = gridDim.x * gridDim.y * gridDim.z;
    unsigned sum, cnt, mine, sp = 0u;
    for (;;) {
        sum = 0u; cnt = 0u; mine = 0u;
#pragma unroll
        for (unsigned j = 0; j < 16; ++j) { const unsigned c = xb_ld(&bar[XB_XCNT(j)]); sum += c; cnt += (c > 0u) ? 1u : 0u; mine = (j == x) ? c : mine; }
        if (sum == G) break;
        __builtin_amdgcn_s_sleep(1);
        if ((++sp & 255u) == 0u) { if (xb_ld(&bar[XB_TMO])) break; if (sp > XB_SPIN_CAP) { atomicAdd(&bar[XB_TMO], 1u); break; } }
    }
    nloc = mine > 0u ? mine : 1u; nx = cnt > 0u ? cnt : 1u;
}
__device__ __forceinline__ void xcd_barrier(const XcdBarrier& b, const bool lead) {
    asm volatile("s_waitcnt vmcnt(0)" ::: "memory");
    __syncthreads();
    if (lead) {
        unsigned* bar = b.bar;
        __builtin_amdgcn_s_waitcnt(0);
        unsigned nloc = b.st[0], nx = b.st[1];
        if (nloc == 0u) { xcd_barrier_complete(bar, b.x, nloc, nx); b.st[0] = nloc; b.st[1] = nx; }
        const unsigned old = xb_add(&bar[XB_XSUB(b.x)], 1u);
        const unsigned gen = old / nloc;
        if (old + 1u == (gen + 1u) * nloc) {
            __builtin_amdgcn_fence(__ATOMIC_RELEASE, "agent");
            asm volatile("s_waitcnt vmcnt(0)" ::: "memory");
            const unsigned og = xb_add(&bar[XB_TOP], 1u);
            const unsigned tg = og / nx;
            if (og + 1u == (tg + 1u) * nx) xb_add(&bar[XB_TOPGEN], 1u);
            else XB_SPIN(xb_ld(&bar[XB_TOPGEN]) == tg, bar);
            __builtin_amdgcn_fence(__ATOMIC_ACQUIRE, "agent");
            xb_add(&bar[XB_XGEN(b.x)], 1u);
            asm volatile("s_waitcnt vmcnt(0)" ::: "memory");
        } else {
            XB_SPIN(xb_ld(&bar[XB_XGEN(b.x)]) == gen, bar);
            __builtin_amdgcn_fence(__ATOMIC_ACQUIRE, "agent");
            asm volatile("s_waitcnt vmcnt(0)" ::: "memory");
        }
    }
    __syncthreads();
}

struct Frame {
    LAS unsigned char* lds;
    int tid, lane, wave, gw, ngw, G;
    const __attribute__((address_space(4))) Params* p;
    unsigned char* ws;
    float* out;
};
#define INP(F, i) ((F).p->in[(i)])
#define WSP(F, T, off) ((T*)((F).ws + (off)))

__device__ __forceinline__ const float* x_in_row(const Frame& F, int r) {
    return r < NP ? INP(F, I_XP) + (size_t)r * DM : INP(F, I_XS) + (size_t)(r - NP) * DM;
}

template <bool ILV = false>
__device__ __forceinline__ void transpose_item(const float* W, int K, int N, int nblk, bf16* WT, int row_off, LAS float* scr, int item, int lane) {
    const int kb = item / nblk, nb = item % nblk, k0 = 64 * kb, n0 = 32 * nb;
    const int r0 = ILV ? 256 * (n0 >> 7) + (n0 & 127) : n0;
    const int n = n0 + (lane & 31);
    float tv[32];
#pragma unroll
    for (int i = 0; i < 32; ++i) { const int kk = 2 * i + (lane >> 5); tv[i] = (n < N) ? W[(size_t)(k0 + kk) * N + n] : 0.f; }
#pragma unroll
    for (int i = 0; i < 32; ++i) { const int kk = 2 * i + (lane >> 5); scr[kk * 33 + (lane & 31)] = tv[i]; }
    asm volatile("s_waitcnt lgkmcnt(0)" ::: "memory");
    const int c = lane & 7;
#pragma unroll
    for (int j = 0; j < 4; ++j) { const int nn = (lane >> 3) + 8 * j; const LAS float* s = scr + (8 * c) * 33 + nn;
        v4u o; o.x = pk2(s[0 * 33], s[1 * 33]); o.y = pk2(s[2 * 33], s[3 * 33]); o.z = pk2(s[4 * 33], s[5 * 33]); o.w = pk2(s[6 * 33], s[7 * 33]);
        *(v4u*)(WT + (size_t)(row_off + r0 + nn) * K + k0 + 8 * c) = o; }
    asm volatile("s_waitcnt lgkmcnt(0)" ::: "memory");
}
__device__ __forceinline__ void norm_row_to_bf16(const Frame& F, const float* xrow, const float* w, bf16* orow) {
    const f32x4* xr = (const f32x4*)xrow + F.lane; const f32x4* wr = (const f32x4*)w + F.lane;
    f32x4 v[4]; float ss = 0.f;
#pragma unroll
    for (int j = 0; j < 4; ++j) { v[j] = xr[64 * j]; ss += (v[j].x * v[j].x + v[j].y * v[j].y) + (v[j].z * v[j].z + v[j].w * v[j].w); }
    const float rs = 1.f / sqrtf(wave_sum(ss) * (1.f / DM) + RMS_EPS);
    unsigned long long* o8 = (unsigned long long*)orow + F.lane;
#pragma unroll
    for (int j = 0; j < 4; ++j) { const f32x4 g = wr[64 * j];
        o8[64 * j] = (unsigned long long)pk2(v[j].x * rs * g.x, v[j].y * rs * g.y) | ((unsigned long long)pk2(v[j].z * rs * g.z, v[j].w * rs * g.w) << 32); }
}
__device__ __forceinline__ void phase_prologue(const Frame& F) {
    LAS float* scr = (LAS float*)(F.lds + F.wave * 16384);
    constexpr int IT_IN = 16 * (IN_WP / 32), IT_OUT = 16 * 32, IT_UP = 16 * 128, IT_DN = 64 * 32, IT_L = IT_IN + IT_OUT + 2 * IT_UP + IT_DN;
    for (int it = F.gw; it < DEPTH * IT_L; it += F.ngw) {
        const int l = it / IT_L; int r = it % IT_L;
        if (r < IT_IN) { transpose_item(INP(F, I_WIN) + (size_t)l * DM * IN_W, DM, IN_W, IN_WP / 32, WSP(F, bf16, WS_WTIN) + (size_t)l * IN_WP * DM, 0, scr, r, F.lane); continue; } r -= IT_IN;
        if (r < IT_OUT) { transpose_item(INP(F, I_WOUT) + (size_t)l * DM * DM, DM, DM, 32, WSP(F, bf16, WS_WTOUT) + (size_t)l * DM * DM, 0, scr, r, F.lane); continue; } r -= IT_OUT;
        if (r < IT_UP) { transpose_item<true>(INP(F, I_WGATE) + (size_t)l * DM * DFF, DM, DFF, 128, WSP(F, bf16, WS_WTUP) + (size_t)l * 2 * DFF * DM, 0, scr, r, F.lane); continue; } r -= IT_UP;
        if (r < IT_UP) { transpose_item<true>(INP(F, I_WVAL) + (size_t)l * DM * DFF, DM, DFF, 128, WSP(F, bf16, WS_WTUP) + (size_t)l * 2 * DFF * DM, 128, scr, r, F.lane); continue; } r -= IT_UP;
        transpose_item(INP(F, I_WDOWN) + (size_t)l * DFF * DM, DFF, DM, 32, WSP(F, bf16, WS_WTDN) + (size_t)l * DM * DFF, 0, scr, r, F.lane);
    }
    for (int it = F.gw; it < 8 * 2 * 64; it += F.ngw) {
        const int i = it >> 7, half = (it >> 6) & 1, r = it & 63; const int lyr = i >> 1, kv = i & 1;
        const float* w1 = INP(F, kv ? I_W1V : I_W1K) + (size_t)lyr * 32 * 64 * 128 + (size_t)half * 1024 * 128;
        transpose_item(w1, 1024, 128, 4, WSP(F, bf16, WS_WTC) + (size_t)i * 256 * 1024, half * 128, scr, r, F.lane);
    }
    for (int idx = blockIdx.x * NTHR + F.tid; idx < 8 * 64 * 128; idx += F.G * NTHR) {
        const int i = idx >> 13, d = (idx >> 7) & 63, e = idx & 127;
        WSP(F, bf16, WS_W2T)[idx] = (bf16)f2bf((INP(F, (i & 1) ? I_W2V : I_W2K) + (size_t)(i >> 1) * 128 * 64)[e * 64 + d]);
    }
    for (int idx = blockIdx.x * NTHR + F.tid; idx < 8 * 128; idx += F.G * NTHR) {
        const int i = idx >> 7, e = idx & 127; const int lyr = i >> 1, kv = i & 1;
        const float* w1 = INP(F, kv ? I_W1V : I_W1K) + (size_t)lyr * 32 * 64 * 128; const float* pe = INP(F, kv ? I_PEV : I_PEK) + (size_t)lyr * 32 * 64;
        float a = 0.f; for (int k = 0; k < 2048; ++k) a += pe[k] * w1[(size_t)k * 128 + e];
        WSP(F, float, WS_CBIAS)[idx] = a;
    }
    for (int it2 = F.gw; it2 < DEPTH * BS * 256; it2 += F.ngw) {
        f32x4 a[2][2][4]; int lyrv[2], bv[2], cv[2];
#pragma unroll
        for (int u = 0; u < 2; ++u) {
            const int it = 2 * it2 + u; const int lyr = it >> 14, b = (it >> 9) & 31, c = it & 511; lyrv[u] = lyr; bv[u] = b; cv[u] = c;
            const int page = ((const int*)INP(F, I_PT))[b * NPAGES + (c >> 3)];
            const int row = F.lane >> 2, qd = F.lane & 3;
            const float* src = INP(F, I_CACHE) + ((((size_t)lyr * NPHYS + page) * PAGE + (c & 7) * 16 + row) * 4) * 64 + qd * 16;
#pragma unroll
            for (int kv = 0; kv < 2; ++kv)
#pragma unroll
                for (int k = 0; k < 4; ++k) a[u][kv][k] = *(const f32x4*)(src + kv * 64 + 4 * k);
        }
#pragma unroll
        for (int u = 0; u < 2; ++u) {
            const int row = F.lane >> 2, qd = F.lane & 3;
#pragma unroll
            for (int kv = 0; kv < 2; ++kv) {
                const f32x4 a0 = a[u][kv][0], a1 = a[u][kv][1], a2 = a[u][kv][2], a3 = a[u][kv][3];
                v4u o0, o1; o0.x = pk2(a0.x, a0.y); o0.y = pk2(a0.z, a0.w); o0.z = pk2(a1.x, a1.y); o0.w = pk2(a1.z, a1.w); o1.x = pk2(a2.x, a2.y); o1.y = pk2(a2.z, a2.w); o1.z = pk2(a3.x, a3.y); o1.w = pk2(a3.z, a3.w);
                bf16* dst = WSP(F, bf16, WS_AS) + ((((size_t)(lyrv[u] * 2 + kv) * BS + bv[u]) * 512 + cv[u]) * 1024) + row * 64 + qd * 16;
                *(v4u*)dst = o0; *(v4u*)(dst + 8) = o1;
            }
        }
    }
    {
        const float inv[8] = {1.0f, 0.193922758102417f, 0.03760603070259094f, 0.00729266507551074f, 0.001414213445968926f, 0.00027424818836152554f, 5.318296462064609e-05f, 1.0313385246263351e-05f};
        float* rope = WSP(F, float, WS_ROPE);
        for (int i = blockIdx.x * NTHR + F.tid; i < 2056 * 8; i += F.G * NTHR) {
            const int pi = i >> 3, f = i & 7; const int pos = pi < TP ? pi : PAST + (pi - TP);
            float iv = inv[0];
#pragma unroll
            for (int k = 1; k < 8; ++k) iv = (f == k) ? inv[k] : iv;
            const float ang = (float)pos * iv; float c, s; cossin_d(ang, c, s);
            rope[pi * 16 + f] = c; rope[pi * 16 + 8 + f] = s;
        }
    }
    for (int r = F.gw; r < MROWS; r += F.ngw) norm_row_to_bf16(F, x_in_row(F, r), INP(F, I_NMPRE), WSP(F, bf16, WS_XN) + (size_t)r * DM);
}

typedef float f32x16p __attribute__((ext_vector_type(16)));
__device__ __forceinline__ void phase_cmp_finish(const Frame& F) {
    const float* H = WSP(F, float, WS_HS);
    const int lane = F.lane, r32 = lane & 31, hp = lane >> 5;
    for (int it = F.gw; it < 8 * BS * 16; it += F.ngw) {
        const int i = it >> 9, b = (it >> 4) & 31, n0 = (it & 15) * 32; const int lyr = i >> 1, kv = i & 1;
        const int n = n0 + r32; const int n1 = (n + 1 < 512) ? n + 1 : 511;
        const float* h0 = H + (((size_t)i * BS + b) * 512 + n) * 256; const float* h1 = H + (((size_t)i * BS + b) * 512 + n1) * 256 + 128;
        const float* bias = WSP(F, float, WS_CBIAS) + i * 128;
        const bf16* w2t = WSP(F, bf16, WS_W2T) + (size_t)i * 64 * 128;
        f32x16p acc0, acc1;
#pragma unroll
        for (int k = 0; k < 16; ++k) { acc0[k] = 0.f; acc1[k] = 0.f; }
#pragma unroll
        for (int ks = 0; ks < 8; ++ks) {
            const int e = 16 * ks + 8 * hp;
            const f32x4 a0 = *(const f32x4*)(h0 + e), a1 = *(const f32x4*)(h0 + e + 4), c0 = *(const f32x4*)(h1 + e), c1 = *(const f32x4*)(h1 + e + 4);
            const f32x4 b0 = *(const f32x4*)(bias + e), b1 = *(const f32x4*)(bias + e + 4);
            const f32x4 x0 = a0 + c0 + b0, x1 = a1 + c1 + b1;
            v4u av; av.x = pk2(gelu_tanh(x0.x), gelu_tanh(x0.y)); av.y = pk2(gelu_tanh(x0.z), gelu_tanh(x0.w)); av.z = pk2(gelu_tanh(x1.x), gelu_tanh(x1.y)); av.w = pk2(gelu_tanh(x1.z), gelu_tanh(x1.w));
            const bf16x8 bf0 = *(const bf16x8*)(w2t + (size_t)r32 * 128 + e), bf1 = *(const bf16x8*)(w2t + (size_t)(32 + r32) * 128 + e);
            acc0 = __builtin_amdgcn_mfma_f32_32x32x16_bf16(__builtin_bit_cast(bf16x8, av), bf0, acc0, 0, 0, 0);
            acc1 = __builtin_amdgcn_mfma_f32_32x32x16_bf16(__builtin_bit_cast(bf16x8, av), bf1, acc1, 0, 0, 0);
        }
        float* dst = WSP(F, float, kv ? WS_CVS : WS_CKS) + (((size_t)lyr * BS + b) * NCMP_S) * 64;
#pragma unroll
        for (int k = 0; k < 16; ++k) { const int nn = n0 + (k & 3) + 8 * (k >> 2) + 4 * hp;
            if (nn < NCMP_S) { dst[(size_t)nn * 64 + r32] = acc0[k]; dst[(size_t)nn * 64 + 32 + r32] = acc1[k]; } }
    }
}

__device__ __forceinline__ float rope_lane(float x, int lane, float cs_c, float cs_s) {
    const float other = __shfl_xor(x, 8);
    const float rot = (lane < 8) ? x * cs_c - other * cs_s : x * cs_c + other * cs_s;
    return (lane < 16) ? rot : x;
}
__device__ __forceinline__ void token_prep4(const Frame& F, int l, int r0, const LAS float* pw_lds, LAS float* pl) {
    constexpr int NR = 4;
    int s, t0; row_to_seq(r0, s, t0); const Seq q = seq_of(s);
    const int lane = F.lane;
    const float* spool = INP(F, I_SPOOL) + ((size_t)l * BS + q.b) * POOL_KEEP * POOL_W;
    const float* proj0 = WSP(F, float, WS_PROJ) + (size_t)r0 * IN_WP;
    float qx[NR][4], kx[NR][6], csc[NR], css[NR];
#pragma unroll
    for (int u = 0; u < NR; ++u) {
        const float* proj = proj0 + (size_t)u * IN_WP; const int t = t0 + u;
        const float* rp = WSP(F, float, WS_ROPE) + (size_t)(q.samp ? TP + t : t) * 16;
#pragma unroll
        for (int j = 0; j < 4; ++j) qx[u][j] = proj[OFF_Q + j * 64 + lane];
#pragma unroll
        for (int j = 0; j < 6; ++j) kx[u][j] = proj[OFF_KV + j * 64 + lane];
        csc[u] = rp[lane & 7]; css[u] = rp[8 + (lane & 7)];
    }
    float e0[2 + 3], e1[4 + 3], e2[8 + 3], e3[16 + 3];
#define LOAD_EXT(EARR, G, W) do { _Pragma("unroll") for (int k = 0; k < (W) + 3; ++k) { const int tt = t0 - ((W) - 1) + k; const int c = (G) * 64 + lane; \
          \
        const float* pa = (tt >= 0) ? proj0 + (long)(tt - t0) * IN_WP + OFF_POOL + c : (q.samp ? spool + (POOL_KEEP + tt) * POOL_W + c : proj0 + OFF_POOL + c); \
        const float v = *pa; EARR[k] = (tt >= 0 || q.samp) ? v : 0.f; } } while (0)
    LOAD_EXT(e0, 0, 2); LOAD_EXT(e1, 1, 4); LOAD_EXT(e2, 2, 8); LOAD_EXT(e3, 3, 16);
#undef LOAD_EXT
    float pooled[NR][4], pu[NR][4];
#pragma unroll
    for (int u = 0; u < NR; ++u) {
        const int pos = q.pos0 + t0 + u;
        float s0 = 0.f, s1 = 0.f, s2 = 0.f, s3 = 0.f;
#pragma unroll
        for (int i = 0; i < 2; ++i) s0 += e0[u + i];
#pragma unroll
        for (int i = 0; i < 4; ++i) s1 += e1[u + i];
#pragma unroll
        for (int i = 0; i < 8; ++i) s2 += e2[u + i];
#pragma unroll
        for (int i = 0; i < 16; ++i) s3 += e3[u + i];
        pu[u][0] = e0[u + 1]; pu[u][1] = e1[u + 3]; pu[u][2] = e2[u + 7]; pu[u][3] = e3[u + 15];
        pooled[u][0] = s0 / (float)((pos + 1 < 2) ? pos + 1 : 2) - pu[u][0];
        pooled[u][1] = s1 / (float)((pos + 1 < 4) ? pos + 1 : 4) - pu[u][1];
        pooled[u][2] = s2 / (float)((pos + 1 < 8) ? pos + 1 : 8) - pu[u][2];
        pooled[u][3] = s3 / (float)((pos + 1 < 16) ? pos + 1 : 16) - pu[u][3];
    }
#pragma unroll
    for (int u = 0; u < NR; ++u) {
        const int r = r0 + u, t = t0 + u;
        bf16* qb = WSP(F, bf16, WS_QB) + (size_t)r * 256;
#pragma unroll
        for (int j = 0; j < 4; ++j) qb[j * 64 + lane] = (bf16)f2bf(rope_lane(qx[u][j], lane, csc[u], css[u]) * (0.125f * 1.4426950408889634f));
        float* kvout = q.samp ? F.out + O_KVS + ((size_t)l * NS + (r - NP)) * 256 : F.out + O_KVP + ((size_t)l * NP + r) * 256;
        float* kwin = WSP(F, float, WS_KWIN) + (size_t)r * 128;
#pragma unroll
        for (int j = 0; j < 6; ++j) {
            const float v = (j & 1) ? kx[u][j] : rope_lane(kx[u][j], lane, csc[u], css[u]);
            if (j < 4) kvout[j * 64 + lane] = v;
            else {
                kwin[(j - 4) * 64 + lane] = v;
                if (!q.samp) { if (t >= TP - 512) F.out[O_WINP + (((size_t)l * BP + q.b) * 512 + (t - (TP - 512))) * 128 + (j - 4) * 64 + lane] = v; }
                else F.out[O_WINS + (((size_t)l * BS + q.b) * 512 + 504 + t) * 128 + (j - 4) * 64 + lane] = v;
            }
        }
#pragma unroll
        for (int g = 0; g < 4; ++g) pl[u * 256 + g * 64 + lane] = pooled[u][g];
    }
    asm volatile("s_waitcnt lgkmcnt(0)" ::: "memory");
    const float* psc = INP(F, I_POOLSC) + (size_t)l * POOL_W;
#pragma unroll
    for (int g = 0; g < 4; ++g) {
        float y[NR];
#pragma unroll
        for (int u = 0; u < NR; ++u) y[u] = 0.f;
#pragma unroll 4
        for (int c = 0; c < 64; c += 4) { const LAS float* wv = pw_lds + (g * 64 + c) * 64 + lane;
            const float w0 = wv[0], w1 = wv[64], w2 = wv[128], w3 = wv[192];
#pragma unroll
            for (int u = 0; u < NR; ++u) { const f32x4 pa = *(const LAS f32x4*)(pl + u * 256 + g * 64 + c); y[u] += pa.x * w0 + pa.y * w1 + pa.z * w2 + pa.w * w3; } }
        const float sc = psc[g * 64 + lane];
#pragma unroll
        for (int u = 0; u < NR; ++u) (WSP(F, bf16, WS_MIX) + (size_t)(r0 + u) * DM)[512 + g * 64 + lane] = (bf16)f2bf(y[u] * sc);
    }
    asm volatile("s_waitcnt lgkmcnt(0)" ::: "memory");
#pragma unroll
    for (int u = 0; u < NR; ++u) {
        const int r = r0 + u, t = t0 + u; const float* proj = WSP(F, float, WS_PROJ) + (size_t)r * IN_WP;
        if (!q.samp) {
            if (t >= TP - 15) { float* o = F.out + O_POOLP + (((size_t)l * BP + q.b) * 15 + (t - (TP - 15))) * POOL_W;
#pragma unroll
                for (int j = 0; j < 4; ++j) o[j * 64 + lane] = pu[u][j]; }
            if (t >= TP - 3) { float* o = F.out + O_CONVP + (((size_t)l * BP + q.b) * 3 + (t - (TP - 3))) * CONV_DIM;
                for (int j = 0; j < 16; ++j) o[j * 64 + lane] = proj[OFF_XBC + j * 64 + lane]; }
        } else {
            { float* o = F.out + O_POOLS + (((size_t)l * BS + q.b) * 15 + 7 + t) * POOL_W;
#pragma unroll
                for (int j = 0; j < 4; ++j) o[j * 64 + lane] = pu[u][j]; }
            if (t < 7) { float* o = F.out + O_POOLS + (((size_t)l * BS + q.b) * 15 + t) * POOL_W;
#pragma unroll
                for (int j = 0; j < 4; ++j) o[j * 64 + lane] = spool[(8 + t) * POOL_W + j * 64 + lane]; }
            if (t >= TS - 3) { float* o = F.out + O_CONVS + (((size_t)l * BS + q.b) * 3 + (t - (TS - 3))) * CONV_DIM;
                for (int j = 0; j < 16; ++j) o[j * 64 + lane] = proj[OFF_XBC + j * 64 + lane]; }
        }
    }
}

__device__ __forceinline__ float xbc_conv(const Frame& F, int l, const Seq& q, int t, int c) {
    const float* cw = INP(F, I_CONVW) + (size_t)l * 4 * CONV_DIM; const float* cb = INP(F, I_CONVB) + (size_t)l * CONV_DIM;
    const float* proj = WSP(F, float, WS_PROJ);
    const float* sconv = INP(F, I_SCONV) + ((size_t)l * BS + q.b) * 3 * CONV_DIM;
    float acc = cb[c];
#pragma unroll
    for (int k = 0; k < 4; ++k) { const int tt = t - 3 + k; float e = 0.f;
        if (tt >= 0) e = proj[(size_t)(q.row0 + tt) * IN_WP + OFF_XBC + c];
        else if (q.samp) e = sconv[(3 + tt) * CONV_DIM + c];
        acc += e * cw[k * CONV_DIM + c]; }
    return siluf_(acc);
}
__device__ __forceinline__ void ssd_item(const Frame& F, int l, int s, int h) {
    const Seq q = seq_of(s);
    constexpr int TSTG = 16;
    LAS float* xs = (LAS float*)F.lds;
    LAS float* Bs = xs + TSTG * 64;
    LAS float* Cs = Bs + TSTG * 128;
    LAS float* dts = Cs + TSTG * 128;
    LAS float* dAs = dts + TSTG;
    const int tid = F.tid, p = tid >> 3, nq = tid & 7, g = h >> 2;
    const float a = -expf(INP(F, I_ALOG)[l * SSD_H + h]), dtb = INP(F, I_DTB)[l * SSD_H + h], dsk = INP(F, I_SSDD)[l * SSD_H + h];
    float st[16];
    if (q.samp) { const float* s0 = INP(F, I_SSM) + ((((size_t)l * BS + q.b) * SSD_H + h) * SSD_HD + p) * SSD_N + nq * 16;
#pragma unroll
        for (int i = 0; i < 16; ++i) st[i] = s0[i]; }
    else {
#pragma unroll
        for (int i = 0; i < 16; ++i) st[i] = 0.f; }
    const float* proj = WSP(F, float, WS_PROJ);
    float* yssd = WSP(F, float, WS_YSSD);
    for (int t0 = 0; t0 < q.T; t0 += TSTG) {
        const int nt = (q.T - t0 < TSTG) ? q.T - t0 : TSTG;
        __syncthreads();
        for (int i = tid; i < nt * 320; i += NTHR) { const int tt = i / 320, c = i % 320; const int t = t0 + tt;
            if (c < 64) xs[tt * 64 + c] = xbc_conv(F, l, q, t, h * 64 + c);
            else if (c < 192) Bs[tt * 128 + (c - 64)] = xbc_conv(F, l, q, t, 512 + g * 128 + (c - 64));
            else Cs[tt * 128 + (c - 192)] = xbc_conv(F, l, q, t, 768 + g * 128 + (c - 192)); }
        if (tid < nt) { const float dt = softplusf_(proj[(size_t)(q.row0 + t0 + tid) * IN_WP + OFF_DT + h] + dtb); dts[tid] = dt; dAs[tid] = expf(dt * a); }
        __syncthreads();
        for (int tt = 0; tt < nt; ++tt) {
            const float dt = dts[tt], dA = dAs[tt], x = xs[tt * 64 + p], xd = x * dt;
            float y = 0.f;
#pragma unroll
            for (int i = 0; i < 16; ++i) { st[i] = st[i] * dA + xd * Bs[tt * 128 + nq * 16 + i]; y += st[i] * Cs[tt * 128 + nq * 16 + i]; }
            y += __shfl_xor(y, 1); y += __shfl_xor(y, 2); y += __shfl_xor(y, 4);
            if (nq == 0) yssd[(size_t)(q.row0 + t0 + tt) * SSD_W + h * 64 + p] = y + dsk * x;
        }
    }
    float* so = q.samp ? F.out + O_SSMS + ((((size_t)l * BS + q.b) * SSD_H + h) * SSD_HD + p) * SSD_N + nq * 16
                       : F.out + O_SSMP + ((((size_t)l * BP + q.b) * SSD_H + h) * SSD_HD + p) * SSD_N + nq * 16;
#pragma unroll
    for (int i = 0; i < 16; ++i) so[i] = st[i];
    __syncthreads();
}
__device__ __forceinline__ void ssd_chunk_unit(const Frame& F, int l, int b, int c, int g);
__device__ __forceinline__ void ssd_scan(const Frame& F, int l);
__device__ __forceinline__ void ssd_out_unit(const Frame& F, int l, int b, int hc);
__device__ __forceinline__ void phase_prep(const Frame& F, int l) {
    for (int u = blockIdx.x; u < BP * 16 * 2; u += F.G) ssd_chunk_unit(F, l, u >> 5, (u >> 1) & 15, u & 1);
    for (int it = BP * SSD_H + blockIdx.x; it < NSEQ * SSD_H; it += F.G) ssd_item(F, l, it >> 3, it & 7);
    {
        __syncthreads();
        LAS float* pw_lds = (LAS float*)F.lds; const float* pw = INP(F, I_POOLW) + (size_t)l * 4 * 64 * 64;
        for (int i = F.tid; i < 4 * 64 * 64 / 4; i += NTHR) *(LAS f32x4*)(pw_lds + i * 4) = *(const f32x4*)(pw + i * 4);
        __syncthreads();
        LAS float* pl = (LAS float*)(F.lds + 65536) + F.wave * 1024;
        for (int rp = F.gw; rp < MROWS / 4; rp += F.ngw) token_prep4(F, l, 4 * rp, pw_lds, pl);
        __syncthreads();
    }
    {
        const f32x4* src = (const f32x4*)(INP(F, I_SWIN) + (size_t)l * BS * 512 * 128);
        f32x4* dst = (f32x4*)(F.out + O_WINS + (size_t)l * BS * 512 * 128);
        const int nth = F.G * NTHR, i0 = blockIdx.x * NTHR + F.tid;
        f32x4 v[4]; size_t o[4]; bool ok[4];
#pragma unroll
        for (int k = 0; k < 4; ++k) { const int i = i0 + k * nth; ok[k] = i < BS * 504 * 32; const int ic = ok[k] ? i : 0; const int b = ic / (504 * 32), rem = ic % (504 * 32);
            o[k] = (size_t)b * 512 * 32 + rem; v[k] = src[o[k] + 8 * 32]; }
#pragma unroll
        for (int k = 0; k < 4; ++k) if (ok[k]) dst[o[k]] = v[k];
        for (int i = i0 + 4 * nth; i < BS * 504 * 32; i += nth) { const int b = i / (504 * 32), rem = i % (504 * 32);
            dst[(size_t)b * 512 * 32 + rem] = src[(size_t)b * 512 * 32 + 8 * 32 + rem]; }
    }
}

__device__ __forceinline__ const float* kv_row(const Frame& F, int l, const Seq& q, int tok, int kind) {
    if (!q.samp) return F.out + O_KVP + ((size_t)l * NP + q.row0 + tok) * 256 + kind * 64;
    if (tok >= PAST) return F.out + O_KVS + ((size_t)l * NS + (q.row0 - NP) + (tok - PAST)) * 256 + kind * 64;
    const int page = ((const int*)INP(F, I_PT))[q.b * NPAGES + (tok >> 7)];
    return INP(F, I_CACHE) + ((((size_t)l * NPHYS + page) * PAGE + (tok & 127)) * 4 + kind) * 64;
}
typedef float f32x4c __attribute__((ext_vector_type(4)));
__device__ __forceinline__ void compress_item(const Frame& F, int l, int s, int grp, int kv) {
    const Seq q = seq_of(s);
    const int ncmp = NCMP_P;
    const int n0 = grp * 16; const int nb = (ncmp - n0 < 16) ? ncmp - n0 : 16;
    constexpr int CST = 2064;
    LAS unsigned char* rows = F.lds;
    LAS float* hid = (LAS float*)(F.lds + 36864);
    const int tid = F.tid, lane = F.lane, wave = F.wave;
    __syncthreads();
    for (int i = tid; i < 17 * 16 * 8; i += NTHR) { const int rr = i >> 3, dc = i & 7; const int tok = n0 * 16 + rr;
        v4u o = (v4u){0u, 0u, 0u, 0u};
        if (tok < TP) { const float* p = kv_row(F, l, q, tok, kv) + dc * 8; const f32x4 a = *(const f32x4*)p, b = *(const f32x4*)(p + 4);
            o.x = pk2(a.x, a.y); o.y = pk2(a.z, a.w); o.z = pk2(b.x, b.y); o.w = pk2(b.z, b.w); }
        *(LAS v4u*)(rows + (rr >> 4) * CST + (rr & 15) * 128 + dc * 16) = o; }
    __syncthreads();
    const int i2 = l * 2 + kv;
    const bf16* wt = WSP(F, bf16, WS_WTC) + (size_t)i2 * 256 * 1024;
    const int e = 16 * wave + (lane & 15), kq = lane >> 4, blk = lane & 15;
    f32x4c acc = (f32x4c){0.f, 0.f, 0.f, 0.f};
#pragma unroll 8
    for (int ks = 0; ks < 64; ++ks) {
        const int half = ks >> 5, kk = (ks & 31) * 32 + 8 * kq;
        const bf16x8 bfrag = *(const bf16x8*)(wt + (size_t)(half * 128 + e) * 1024 + kk);
        const bf16x8 afrag = *(const LAS bf16x8*)(rows + (blk + half) * CST + kk * 2);
        acc = __builtin_amdgcn_mfma_f32_16x16x32_bf16(afrag, bfrag, acc, 0, 0, 0);
    }
    { const float bias = WSP(F, float, WS_CBIAS)[i2 * 128 + e];
#pragma unroll
      for (int k = 0; k < 4; ++k) hid[(kq * 4 + k) * 128 + e] = gelu_tanh(acc[k] + bias); }
    __syncthreads();
    const float* w2 = INP(F, kv ? I_W2V : I_W2K) + (size_t)l * 128 * 64;
    float* dst = WSP(F, float, kv ? WS_CVP : WS_CKP) + (size_t)q.b * NCMP_P * 64;
    { const int bi = tid >> 5, d0 = (tid & 31) * 2;
        if (bi < nb) { float o0 = 0.f, o1 = 0.f;
#pragma unroll 8
            for (int k = 0; k < 128; ++k) { const float hv = hid[bi * 128 + k]; o0 += hv * w2[k * 64 + d0]; o1 += hv * w2[k * 64 + d0 + 1]; }
            dst[(size_t)(n0 + bi) * 64 + d0] = o0; dst[(size_t)(n0 + bi) * 64 + d0 + 1] = o1; } }
    __syncthreads();
}
__device__ __forceinline__ void attn_sample_unit(const Frame& F, int l, int b, int t0);
__device__ __forceinline__ void phase_compress(const Frame& F, int l) {
    constexpr int NI_P = BP * 8 * 2;
    for (int it = blockIdx.x; it < NI_P; it += F.G) compress_item(F, l, it >> 4, (it >> 1) & 7, it & 1);
    ssd_scan(F, l);
    { Frame G2 = F; { int ln = G2.lane; asm volatile("" : "+v"(ln)); G2.lane = ln; G2.tid = G2.wave * 64 + ln; }
      for (int u = blockIdx.x; u < NS; u += F.G) attn_sample_unit(G2, l, u >> 3, u & 7); }
}

__device__ __forceinline__ void osm_step(float sc, const f32x4 v, float& m, float& lsum, f32x4& o) {
    const float mn = fmaxf(m, sc); const float al = expf(m - mn), pp = expf(sc - mn);
    lsum = lsum * al + pp; o = o * al + v * pp; m = mn;
}
__device__ __forceinline__ void nsa_token(const Frame& F, int l, int r) {
    int s, t; row_to_seq(r, s, t); const Seq q = seq_of(s);
    const int lane = F.lane, hh = lane >> 4, sub = lane & 15;
    const int tpos = q.pos0 + t;
    LAS float* sc = (LAS float*)(F.lds + F.wave * 12288);
    LAS float* impv = sc + 2048;
    LAS int* sel = (LAS int*)(impv + 192);
    const f32x4 qv = *(const f32x4*)(WSP(F, float, WS_Q) + (size_t)r * 256 + hh * 64 + sub * 4);
    const int ncmp = q.samp ? NCMP_S : NCMP_P;
    const float* ck = q.samp ? WSP(F, float, WS_CKS) + (size_t)q.b * NCMP_S * 64 : WSP(F, float, WS_CKP) + (size_t)q.b * NCMP_P * 64;
    const float* cv = q.samp ? WSP(F, float, WS_CVS) + (size_t)q.b * NCMP_S * 64 : WSP(F, float, WS_CVP) + (size_t)q.b * NCMP_P * 64;
    int nvis = 0; if (tpos >= 31) { nvis = (tpos - 31) / 16 + 1; if (nvis > ncmp) nvis = ncmp; }
    float mx = -INFINITY;
    for (int n = 0; n < nvis; ++n) { const f32x4 kk = *(const f32x4*)(ck + (size_t)n * 64 + sub * 4);
        const float d = sum16(qv.x * kk.x + qv.y * kk.y + qv.z * kk.z + qv.w * kk.w);
        if (sub == 0) sc[hh * 512 + n] = d; mx = fmaxf(mx, d); }
    asm volatile("s_waitcnt lgkmcnt(0)" ::: "memory");
    float ls = 0.f;
    for (int n = sub; n < nvis; n += 16) { const float e = expf(sc[hh * 512 + n] - mx); sc[hh * 512 + n] = e; ls += e; }
    ls = sum16(ls);
    const float rl = ls > 0.f ? 1.f / ls : 0.f;
    for (int n = sub; n < nvis; n += 16) sc[hh * 512 + n] *= rl;
    asm volatile("s_waitcnt lgkmcnt(0)" ::: "memory");
    f32x4 ocmp = (f32x4){0.f, 0.f, 0.f, 0.f};
    for (int n = 0; n < nvis; ++n) { const float pp = sc[hh * 512 + n]; ocmp += *(const f32x4*)(cv + (size_t)n * 64 + sub * 4) * pp; }
    const int nslc = q.samp ? 129 : 32, cur = tpos >> 6;
    for (int j = lane; j < nslc; j += 64) {
        float v;
        if (j > cur) v = -INFINITY;
        else if (j == 0 || j == cur || j == cur - 1) v = INFINITY;
        else { v = 0.f;
            for (int n = 4 * j - 1; n <= 4 * j + 3; ++n) if (n >= 0 && n < nvis) v += (sc[n] + sc[512 + n]) + (sc[1024 + n] + sc[1536 + n]); }
        impv[j] = v;
    }
    asm volatile("s_waitcnt lgkmcnt(0)" ::: "memory");
    int nsel = 0;
    for (int j0 = 0; j0 < nslc; j0 += 64) {
        const int j = j0 + lane; bool selj = false;
        if (j < nslc) { const float vj = impv[j]; int rank = 0;
            for (int k = 0; k < nslc; ++k) { const float vk = impv[k]; rank += (vk > vj || (vk == vj && k < j)) ? 1 : 0; }
            selj = (rank < 16) && (j <= cur); }
        const unsigned long long bal = __ballot(selj);
        if (selj) sel[nsel + __popcll(bal & ((1ull << lane) - 1ull))] = j;
        nsel += __popcll(bal);
    }
    asm volatile("s_waitcnt lgkmcnt(0)" ::: "memory");
    float m2 = -INFINITY, l2 = 0.f; f32x4 o2 = (f32x4){0.f, 0.f, 0.f, 0.f};
    for (int si = 0; si < nsel; ++si) {
        const int j = sel[si]; int ntok = tpos - 64 * j + 1; if (ntok > 64) ntok = 64;
        for (int i = 0; i < ntok; ++i) { const int tok = 64 * j + i;
            const float* kr = kv_row(F, l, q, tok, 2);
            const f32x4 kk = *(const f32x4*)(kr + sub * 4); const f32x4 vv = *(const f32x4*)(kr + 64 + sub * 4);
            const float d = sum16(qv.x * kk.x + qv.y * kk.y + qv.z * kk.z + qv.w * kk.w);
            osm_step(d, vv, m2, l2, o2); }
    }
    float m3 = -INFINITY, l3 = 0.f; f32x4 o3 = (f32x4){0.f, 0.f, 0.f, 0.f};
    {
        int k0 = tpos - 511; if (k0 < 0) k0 = 0;
        const float* swin = INP(F, I_SWIN) + ((size_t)l * BS + q.b) * 512 * 128;
        const float* kwin = WSP(F, float, WS_KWIN);
        for (int kp = k0; kp <= tpos; ++kp) {
            const float* kr;
            if (!q.samp) kr = kwin + (size_t)(q.row0 + kp) * 128;
            else if (kp >= PAST) kr = kwin + (size_t)(q.row0 + kp - PAST) * 128;
            else kr = swin + (size_t)(kp - (PAST - 512)) * 128;
            const f32x4 kk = *(const f32x4*)(kr + sub * 4); const f32x4 vv = *(const f32x4*)(kr + 64 + sub * 4);
            const float d = sum16(qv.x * kk.x + qv.y * kk.y + qv.z * kk.z + qv.w * kk.w);
            osm_step(d, vv, m3, l3, o3); }
    }
    const float* gp = WSP(F, float, WS_PROJ) + (size_t)r * IN_WP + OFF_G + hh * 3;
    const float g0 = sigmoidf_(gp[0]), g1 = sigmoidf_(gp[1]), g2 = sigmoidf_(gp[2]);
    const float r2 = l2 > 0.f ? 1.f / l2 : 0.f, r3 = l3 > 0.f ? 1.f / l3 : 0.f;
    const f32x4 y = ocmp * g0 + o2 * (g1 * r2) + o3 * (g2 * r3);
    unsigned long long* mo = (unsigned long long*)(WSP(F, bf16, WS_MIX) + (size_t)r * DM + 768 + hh * 64 + sub * 4);
    *mo = (unsigned long long)pk2(y.x, y.y) | ((unsigned long long)pk2(y.z, y.w) << 32);
}
__device__ __forceinline__ void ssd_finish_token(const Frame& F, int l, int r) {
    const float* y = WSP(F, float, WS_YSSD) + (size_t)r * SSD_W; const float* z = WSP(F, float, WS_PROJ) + (size_t)r * IN_WP;
    const float* nw = INP(F, I_SSDNORM) + (size_t)l * SSD_W;
    float v[8]; float ss = 0.f;
#pragma unroll
    for (int j = 0; j < 8; ++j) { const int c = j * 64 + F.lane; v[j] = y[c] * siluf_(z[c]); ss += v[j] * v[j]; }
    const float rs = 1.f / sqrtf(wave_sum(ss) * (1.f / SSD_W) + RMS_EPS);
    bf16* mix = WSP(F, bf16, WS_MIX) + (size_t)r * DM;
#pragma unroll
    for (int j = 0; j < 8; ++j) { const int c = j * 64 + F.lane; mix[c] = (bf16)f2bf(v[j] * rs * nw[c]); }
}
__device__ __forceinline__ void phase_attn(const Frame& F, int l) {
    for (int r = F.gw; r < MROWS; r += F.ngw) { nsa_token(F, l, r); ssd_finish_token(F, l, r); }
}


typedef short bf16x8 __attribute__((ext_vector_type(8)));
typedef float f32x16 __attribute__((ext_vector_type(16)));
typedef float f32x2_t __attribute__((ext_vector_type(2))); typedef __bf16 bf16x2_t __attribute__((ext_vector_type(2)));
__device__ __forceinline__ unsigned cvtpk(float lo, float hi) { f32x2_t v = {lo, hi}; bf16x2_t b = __builtin_convertvector(v, bf16x2_t); return __builtin_bit_cast(unsigned, b); }
__device__ __forceinline__ float half_sum(float v) { auto rr = __builtin_amdgcn_permlane32_swap(__float_as_uint(v), __float_as_uint(v), false, false); return __uint_as_float(rr[0]) + __uint_as_float(rr[1]); }
__device__ __forceinline__ float half_max(float v) { auto rr = __builtin_amdgcn_permlane32_swap(__float_as_uint(v), __float_as_uint(v), false, false); return fmaxf(__uint_as_float(rr[0]), __uint_as_float(rr[1])); }

constexpr float QSCALE_B = 0.125f * 1.4426950408889634f;
constexpr int AT_K = 0, AT_V = 16384, AT_IMPG = 32768, AT_IMPE = AT_IMPG + 8192, AT_SEL = AT_IMPE + 8192, AT_UNI = AT_SEL + 2048, AT_LIST = AT_UNI + 64, AT_NLIST = AT_LIST + 768,
              AT_PAGE = AT_NLIST + 64, AT_RANK = AT_PAGE + 768, AT_OUT = AT_RANK + 8 * 1024, AT_END = AT_OUT + 8 * 8192;
static_assert(AT_END <= RING_BYTES, "attention LDS map");
enum { KIND_CMP1 = 0, KIND_CMP2 = 1, KIND_SLC = 2, KIND_WIN = 3 };

struct TileRegs { f32x4 k0, k1, v0, v1; };
__device__ __forceinline__ void tile_load(const Frame& F, int l, const Seq& q, int kind, int tile, int pg, TileRegs& R) {
    int t_ = F.tid; asm volatile("" : "+v"(t_));
    const int key = tile * 64 + (t_ >> 3), dc = t_ & 7;
    const float* kr = nullptr; const float* vr = nullptr;
    if (kind <= KIND_CMP2) {
        const int ncmp = q.samp ? NCMP_S : NCMP_P;
        if (key < ncmp) {
            kr = (q.samp ? WSP(F, float, WS_CKS) + ((size_t)l * BS + q.b) * NCMP_S * 64 : WSP(F, float, WS_CKP) + (size_t)q.b * NCMP_P * 64) + (size_t)key * 64;
            vr = (q.samp ? WSP(F, float, WS_CVS) + ((size_t)l * BS + q.b) * NCMP_S * 64 : WSP(F, float, WS_CVP) + (size_t)q.b * NCMP_P * 64) + (size_t)key * 64; }
    } else if (kind == KIND_SLC) {
        if (key < q.pos0 + q.T) {
            if (!q.samp) kr = F.out + O_KVP + ((size_t)l * NP + q.row0 + key) * 256 + 2 * 64;
            else if (key < PAST) kr = INP(F, I_CACHE) + ((((size_t)l * NPHYS + pg) * PAGE + (key & 127)) * 4 + 2) * 64;
            else kr = F.out + O_KVS + ((size_t)l * NS + (q.row0 - NP) + (key - PAST)) * 256 + 2 * 64;
            vr = kr + 64; }
    } else {
        if (key < q.pos0 + q.T) {
            if (!q.samp) kr = WSP(F, float, WS_KWIN) + (size_t)(q.row0 + key) * 128;
            else if (key >= PAST) kr = WSP(F, float, WS_KWIN) + (size_t)(q.row0 + key - PAST) * 128;
            else if (key >= PAST - 512) kr = INP(F, I_SWIN) + (((size_t)l * BS + q.b) * 512 + (key - (PAST - 512))) * 128;
            if (kr) vr = kr + 64; }
    }
    const f32x4 z = (f32x4){0.f, 0.f, 0.f, 0.f};
    if (kr) { R.k0 = *(const f32x4*)(kr + dc * 8); R.k1 = *(const f32x4*)(kr + dc * 8 + 4); R.v0 = *(const f32x4*)(vr + dc * 8); R.v1 = *(const f32x4*)(vr + dc * 8 + 4); }
    else { R.k0 = z; R.k1 = z; R.v0 = z; R.v1 = z; }
}
__device__ __forceinline__ void tile_store(const Frame& F, LAS unsigned char* kb, LAS unsigned char* vb, const TileRegs& R) {
    int t_ = F.tid; asm volatile("" : "+v"(t_));
    const int key = t_ >> 3, dc = t_ & 7;
    v4u kk; kk.x = cvtpk(R.k0.x, R.k0.y); kk.y = cvtpk(R.k0.z, R.k0.w); kk.z = cvtpk(R.k1.x, R.k1.y); kk.w = cvtpk(R.k1.z, R.k1.w);
    *(LAS v4u*)(kb + key * 128 + ((dc ^ (key & 7)) << 4)) = kk;
    const float vv[8] = {R.v0.x, R.v0.y, R.v0.z, R.v0.w, R.v1.x, R.v1.y, R.v1.z, R.v1.w};
#pragma unroll
    for (int i = 0; i < 8; ++i) { const int d = dc * 8 + i; const int ch = (key >> 2) ^ ((d >> 1) & 15);
        *(LAS unsigned short*)(vb + d * 128 + ch * 8 + (key & 3) * 2) = (unsigned short)f2bf(vv[i]); }
}
__device__ __forceinline__ void qk_tile(const LAS unsigned char* kb, const bf16x8 (&qf)[4], f32x16& s0, f32x16& s1, int lane, float init = 0.f) {
    const int r = lane & 31, h = lane >> 5;
#pragma unroll
    for (int i = 0; i < 16; ++i) { s0[i] = init; s1[i] = init; }
#pragma unroll
    for (int ks = 0; ks < 4; ++ks) {
        const bf16x8 a0 = *(const LAS bf16x8*)(kb + r * 128 + (((2 * ks + h) ^ (r & 7)) << 4));
        const bf16x8 a1 = *(const LAS bf16x8*)(kb + (32 + r) * 128 + (((2 * ks + h) ^ (r & 7)) << 4));
        s0 = __builtin_amdgcn_mfma_f32_32x32x16_bf16(a0, qf[ks], s0, 0, 0, 0);
        s1 = __builtin_amdgcn_mfma_f32_32x32x16_bf16(a1, qf[ks], s1, 0, 0, 0);
    }
}
__device__ __forceinline__ void mask_tile(f32x16& s0, f32x16& s1, int kbase, int lo, int hi) {
#pragma unroll
    for (int i = 0; i < 16; ++i) { const int k = kbase + (i & 3) + 8 * (i >> 2);
        if (k < lo || k > hi) s0[i] = -INFINITY;
        if (k + 32 < lo || k + 32 > hi) s1[i] = -INFINITY; }
}
__device__ __forceinline__ float max3_(float x, float y, float z) { float r; asm("v_max3_f32 %0, %1, %2, %3" : "=v"(r) : "v"(x), "v"(y), "v"(z)); return r; }
__device__ __forceinline__ float tile_max(const f32x16& s0, const f32x16& s1) {
    float a = max3_(s0[0], s0[1], s0[2]), b = max3_(s1[0], s1[1], s1[2]);
#pragma unroll
    for (int i = 3; i < 15; i += 2) { a = max3_(a, s0[i], s0[i + 1]); b = max3_(b, s1[i], s1[i + 1]); }
    return half_max(max3_(a, b, fmaxf(s0[15], s1[15])));
}
__device__ __forceinline__ void pv_tile(const LAS unsigned char* vb, const f32x16& s0, const f32x16& s1, f32x16 (&O)[2], int lane) {
    const int r = lane & 31, h = lane >> 5;
    bf16x8 pf[2][2];
#pragma unroll
    for (int sp = 0; sp < 2; ++sp) {
        v4u a; a.x = cvtpk(s0[8 * sp + 0], s0[8 * sp + 1]); a.y = cvtpk(s0[8 * sp + 2], s0[8 * sp + 3]); a.z = cvtpk(s0[8 * sp + 4], s0[8 * sp + 5]); a.w = cvtpk(s0[8 * sp + 6], s0[8 * sp + 7]);
        v4u b; b.x = cvtpk(s1[8 * sp + 0], s1[8 * sp + 1]); b.y = cvtpk(s1[8 * sp + 2], s1[8 * sp + 3]); b.z = cvtpk(s1[8 * sp + 4], s1[8 * sp + 5]); b.w = cvtpk(s1[8 * sp + 6], s1[8 * sp + 7]);
        pf[0][sp] = __builtin_bit_cast(bf16x8, a); pf[1][sp] = __builtin_bit_cast(bf16x8, b);
    }
#pragma unroll
    for (int dh = 0; dh < 2; ++dh) {
        const int d = dh * 32 + r, sw = (d >> 1) & 15; const LAS unsigned char* rb = vb + d * 128;
#pragma unroll
        for (int kh = 0; kh < 2; ++kh)
#pragma unroll
            for (int sp = 0; sp < 2; ++sp) {
                const int q0 = kh * 8 + 4 * sp + h;
                const unsigned long long lo8 = *(const LAS unsigned long long*)(rb + ((q0 ^ sw) << 3));
                const unsigned long long hi8 = *(const LAS unsigned long long*)(rb + (((q0 + 2) ^ sw) << 3));
                v4u av; av.x = (unsigned)lo8; av.y = (unsigned)(lo8 >> 32); av.z = (unsigned)hi8; av.w = (unsigned)(hi8 >> 32);
                O[dh] = __builtin_amdgcn_mfma_f32_32x32x16_bf16(__builtin_bit_cast(bf16x8, av), pf[kh][sp], O[dh], 0, 0, 0);
            }
        __builtin_amdgcn_sched_barrier(0);
    }
}

__device__ __forceinline__ void attn_unit(const Frame& F, int l, int s, int t0, int ntok) {
    const Seq q = seq_of(s);
    int lane_ = F.lane; asm volatile("" : "+v"(lane_));
    int wave_ = F.wave; asm volatile("" : "+s"(wave_));
    const int lane = lane_, wave = wave_, tid = wave * 64 + lane, h = lane >> 5;
    LAS unsigned char* lds = F.lds;
    LAS float* impG = (LAS float*)(lds + AT_IMPG); LAS float* impE = (LAS float*)(lds + AT_IMPE);
    LAS unsigned* selw = (LAS unsigned*)(lds + AT_SEL);
    LAS unsigned* uni = (LAS unsigned*)(lds + AT_UNI);
    LAS int* list = (LAS int*)(lds + AT_LIST);
    LAS int* nlist = (LAS int*)(lds + AT_NLIST);
    LAS int* lpage = (LAS int*)(lds + AT_PAGE);
    LAS float* rankv = (LAS float*)(lds + AT_RANK + wave * 1024);
    const int nslc = q.samp ? 129 : 32, njs = q.samp ? 128 : 32;
    const int ncmp = q.samp ? NCMP_S : NCMP_P;
    const int tl = wave * 8 + ((lane & 31) >> 2), head = lane & 3;
    const bool vcol = tl < ntok; const bool wact = (wave * 8) < ntok;
    const int tlc = vcol ? tl : 0;
    const int r = q.row0 + t0 + tlc, tpos = q.pos0 + t0 + tlc;
    int nvis = 0; if (vcol && tpos >= 31) { nvis = (tpos - 31) / 16 + 1; if (nvis > ncmp) nvis = ncmp; }
    const int tpos_last = q.pos0 + t0 + ntok - 1;
    int nvis_max = 0; if (tpos_last >= 31) { nvis_max = (tpos_last - 31) / 16 + 1; if (nvis_max > ncmp) nvis_max = ncmp; }
    const int nct = (nvis_max + 63) >> 6;
    bf16x8 qf[4];
    { const bf16* qb = WSP(F, bf16, WS_QB) + ((size_t)r * 4 + head) * 64;
#pragma unroll
      for (int ks = 0; ks < 4; ++ks) qf[ks] = *(const bf16x8*)(qb + 16 * ks + 8 * h); }
    const float* gp = WSP(F, float, WS_PROJ) + (size_t)r * IN_WP + OFF_G + head * 3;
    const float g0 = sigmoidf_(gp[0]), g1 = sigmoidf_(gp[1]), g2 = sigmoidf_(gp[2]);
#define GATE(k) sigmoidf_((WSP(F, float, WS_PROJ) + (size_t)r * IN_WP + OFF_G + head * 3)[(k)])
    f32x16 O[2];
    LAS float* outl = (LAS float*)(lds + AT_OUT + wave * 8192) + lane;
#pragma unroll
    for (int i = 0; i < 16; ++i) { O[0][i] = 0.f; O[1][i] = 0.f; }
    float m = -1e30f, lsum = 0.f, rinv = 0.f;

    __syncthreads();
    if (tid < 2 * nct) list[tid] = (tid < nct ? KIND_CMP1 : KIND_CMP2) | ((tid < nct ? tid : tid - nct) << 4);
    for (int i = tid; i < 64 * 8; i += NTHR) selw[i] = 0u;
    __syncthreads();
    {
        const int n = 2 * nct; TileRegs R;
        if (n > 0) tile_load(F, l, q, KIND_CMP1, 0, 0, R);
        for (int i = 0; i < n; ++i) {
            LAS unsigned char* kb = lds + AT_K + (i & 1) * 8192; LAS unsigned char* vb = lds + AT_V + (i & 1) * 8192;
            tile_store(F, kb, vb, R);
            const int e = __builtin_amdgcn_readfirstlane(list[i]); const int kind = e & 15, tile = e >> 4;
            if (i + 1 < n) { const int e2 = __builtin_amdgcn_readfirstlane(list[i + 1]); tile_load(F, l, q, e2 & 15, e2 >> 4, 0, R); }
            __syncthreads();
            if (wact) {
                if (i == nct) { const float L = half_sum(lsum); rinv = L > 0.f ? 1.f / L : 0.f; }
                f32x16 s0, s1; qk_tile(kb, qf, s0, s1, lane);
                mask_tile(s0, s1, tile * 64 + 4 * h, 0, nvis - 1);
                if (kind == KIND_CMP1) {
                    const float mt = tile_max(s0, s1); const float mn = fmaxf(m, mt); const float al = __builtin_amdgcn_exp2f(m - mn);
                    float rs = 0.f;
#pragma unroll
                    for (int k = 0; k < 16; ++k) rs += __builtin_amdgcn_exp2f(s0[k] - mn) + __builtin_amdgcn_exp2f(s1[k] - mn);
                    lsum = lsum * al + rs; m = mn;
                } else {
#pragma unroll
                    for (int k = 0; k < 16; ++k) { s0[k] = __builtin_amdgcn_exp2f(s0[k] - m) * rinv; s1[k] = __builtin_amdgcn_exp2f(s1[k] - m) * rinv; }
                    pv_tile(vb, s0, s1, O, lane);
#pragma unroll
                    for (int kh = 0; kh < 2; ++kh)
#pragma unroll
                        for (int gq = 0; gq < 4; ++gq) {
                            const f32x16& sv = kh ? s1 : s0;
                            float G = (sv[4 * gq] + sv[4 * gq + 1]) + (sv[4 * gq + 2] + sv[4 * gq + 3]), E = sv[4 * gq + 3];
                            G += __shfl_xor(G, 1); G += __shfl_xor(G, 2); E += __shfl_xor(E, 1); E += __shfl_xor(E, 2);
                            const int j = 16 * tile + 8 * kh + 2 * gq + h;
                            if (head == 0 && vcol && j < njs) { impG[tl * njs + j] = G; impE[tl * njs + j] = E; }
                        }
                }
            }
        }
    }
    const float g0v = GATE(0);
#pragma unroll
    for (int i = 0; i < 16; ++i) { outl[i * 64] = O[0][i] * g0v; outl[(16 + i) * 64] = O[1][i] * g0v; O[0][i] = 0.f; O[1][i] = 0.f; }
    m = 0.f; lsum = 0.f;
    bool started = false;
    asm volatile("s_waitcnt lgkmcnt(0)" ::: "memory");
    if (wact) {
        const int ntw = (ntok - wave * 8 < 8) ? ntok - wave * 8 : 8;
        for (int tt = 0; tt < ntw; ++tt) {
            const int tk = wave * 8 + tt; const int tp = q.pos0 + t0 + tk; const int cur = tp >> 6;
            int nv = 0; if (tp >= 31) { nv = (tp - 31) / 16 + 1; if (nv > ncmp) nv = ncmp; }
            const int jcov = (nv + 3) >> 2;
            for (int j = lane; j < nslc; j += 64) {
                float v;
                if (j > cur) v = -INFINITY;
                else if (j == 0 || j == cur || j == cur - 1) v = INFINITY;
                else { v = 0.f; if (j < jcov) v += impG[tk * njs + j]; if (j - 1 < jcov) v += impE[tk * njs + j - 1]; }
                rankv[j] = v;
            }
            asm volatile("s_waitcnt lgkmcnt(0)" ::: "memory");
            for (int j0 = 0; j0 < nslc; j0 += 64) {
                const int j = j0 + lane; bool selj = false;
                if (j < nslc) { const float vj = rankv[j]; int rank = 0;
                    for (int k = 0; k < nslc; ++k) { const float vk = rankv[k]; rank += (vk > vj || (vk == vj && k < j)) ? 1 : 0; }
                    selj = (rank < 16) && (j <= cur); }
                const unsigned long long bal = __ballot(selj);
                if (lane == 0) { selw[tk * 8 + (j0 >> 5)] = (unsigned)bal; selw[tk * 8 + (j0 >> 5) + 1] = (unsigned)(bal >> 32); }
            }
            asm volatile("s_waitcnt lgkmcnt(0)" ::: "memory");
        }
    }
    __syncthreads();
    if (tid < 8) { unsigned u = 0u; for (int k = 0; k < ntok; ++k) u |= selw[k * 8 + tid]; uni[tid] = u; }
    __syncthreads();
    if (wave == 0) {
        int n = 0;
        for (int j0 = 0; j0 < nslc; j0 += 64) {
            const int j = j0 + lane; const bool sj = (j < nslc) && ((uni[j >> 5] >> (j & 31)) & 1u);
            int pg = 0; if (sj && q.samp && j * 64 < PAST) pg = ((const int*)INP(F, I_PT))[q.b * NPAGES + (j >> 1)];
            const unsigned long long bal = __ballot(sj);
            if (sj) { const int idx = n + __popcll(bal & ((1ull << lane) - 1ull)); list[idx] = KIND_SLC | (j << 4); lpage[idx] = pg; }
            n += __popcll(bal);
        }
        const int p0 = q.pos0 + t0; int w0 = (p0 - 511) >> 6; if (w0 < 0) w0 = 0; if (q.samp && w0 < (PAST - 512) / 64) w0 = (PAST - 512) / 64;
        const int w1 = (p0 + ntok - 1) >> 6;
        if (lane <= w1 - w0) { list[n + lane] = KIND_WIN | ((w0 + lane) << 4); lpage[n + lane] = 0; }
        if (lane == 0) nlist[0] = n + (w1 - w0 + 1);
    }
    __syncthreads();
    {
        const int n = nlist[0]; TileRegs R0, R1; int pkind = KIND_SLC;
        { const int e0 = __builtin_amdgcn_readfirstlane(list[0]); tile_load(F, l, q, e0 & 15, e0 >> 4, __builtin_amdgcn_readfirstlane(lpage[0]), R0); }
        if (n > 1) { const int e1 = __builtin_amdgcn_readfirstlane(list[1]); tile_load(F, l, q, e1 & 15, e1 >> 4, __builtin_amdgcn_readfirstlane(lpage[1]), R1); }
#define ATTN_STEP(RR, BI, II) do { \
            LAS unsigned char* kb = lds + AT_K + (BI) * 8192; LAS unsigned char* vb = lds + AT_V + (BI) * 8192; \
            tile_store(F, kb, vb, RR); \
            const int e = __builtin_amdgcn_readfirstlane(list[(II)]); const int kind = e & 15, tile = e >> 4; \
            if ((II) + 2 < n) { const int e2 = __builtin_amdgcn_readfirstlane(list[(II) + 2]); tile_load(F, l, q, e2 & 15, e2 >> 4, __builtin_amdgcn_readfirstlane(lpage[(II) + 2]), RR); } \
            __syncthreads(); \
            if (wact) { \
                if (kind != pkind) { \
                    const float L = half_sum(lsum); const float sc = L > 0.f ? GATE(1) / L : 0.f; \
                    _Pragma("unroll") for (int k = 0; k < 16; ++k) { outl[k * 64] += O[0][k] * sc; outl[(16 + k) * 64] += O[1][k] * sc; O[0][k] = 0.f; O[1][k] = 0.f; } \
                    m = 0.f; lsum = 0.f; started = false; pkind = kind; \
                } \
                int lo, hi; \
                if (kind == KIND_SLC) { const bool sb = (selw[tlc * 8 + (tile >> 5)] >> (tile & 31)) & 1u; lo = 0; hi = (sb && vcol) ? tpos : -1; } \
                else { lo = tpos - 511; hi = vcol ? tpos : -1; } \
                const bool any = (hi >= tile * 64) && (lo <= tile * 64 + 63); \
                if (__ballot(any) != 0ull) { \
                      \
                      \
                    const bool part = any && !((lo <= tile * 64) && (hi >= tile * 64 + 63)); \
                      \
                      \
                    f32x16 s0, s1; qk_tile(kb, qf, s0, s1, lane, any ? -m : -INFINITY); \
                    if (__ballot(part) != 0ull) mask_tile(s0, s1, tile * 64 + 4 * h, lo, hi); \
                    const float mt = tile_max(s0, s1); \
                    const bool seen = mt > -INFINITY; const bool need = (mt > 8.f) || (seen && !started); started = started || seen; \
                    if (__ballot(need) != 0ull) { \
                        const float dl = need ? mt : 0.f; const float al = __builtin_amdgcn_exp2f(-dl); m += dl; lsum *= al; \
                        _Pragma("unroll") for (int k = 0; k < 16; ++k) { s0[k] -= dl; s1[k] -= dl; O[0][k] *= al; O[1][k] *= al; } } \
                    float rs = 0.f; \
                    _Pragma("unroll") for (int k = 0; k < 16; ++k) { s0[k] = __builtin_amdgcn_exp2f(s0[k]); s1[k] = __builtin_amdgcn_exp2f(s1[k]); rs += s0[k] + s1[k]; } \
                    lsum += rs; \
                    pv_tile(vb, s0, s1, O, lane); \
                } \
            } } while (0)
        for (int i = 0; i < n; i += 2) {
            ATTN_STEP(R0, 0, i);
            if (i + 1 < n) ATTN_STEP(R1, 1, i + 1);
        }
#undef ATTN_STEP
        if (wact) {
            const float L = half_sum(lsum); const float sc = L > 0.f ? (pkind == KIND_SLC ? GATE(1) : GATE(2)) / L : 0.f;
#pragma unroll
            for (int k = 0; k < 16; ++k) { O[0][k] = outl[k * 64] + O[0][k] * sc; O[1][k] = outl[(16 + k) * 64] + O[1][k] * sc; }
        }
    }
    if (vcol) {
        bf16* mo = WSP(F, bf16, WS_MIX) + (size_t)r * DM + 768 + head * 64;
#pragma unroll
        for (int dh = 0; dh < 2; ++dh)
#pragma unroll
            for (int gq = 0; gq < 4; ++gq) {
                const int d = dh * 32 + 8 * gq + 4 * h;
                *(unsigned long long*)(mo + d) = (unsigned long long)cvtpk(O[dh][4 * gq], O[dh][4 * gq + 1]) | ((unsigned long long)cvtpk(O[dh][4 * gq + 2], O[dh][4 * gq + 3]) << 32);
            }
    }
}

#undef GATE
constexpr int SW_T = 0, SW_ML = 65536, SW_IMPG = SW_ML + 4096, SW_IMPE = SW_IMPG + 4096, SW_SEL = SW_IMPE + 4096, SW_UNI = SW_SEL + 256, SW_LIST = SW_UNI + 64,
              SW_PAGE = SW_LIST + 1280, SW_NL = SW_PAGE + 1280, SW_RANK = SW_NL + 64, SW_OUT = SW_RANK + 8 * 1024, SW_END = SW_OUT + 8192;
static_assert(SW_END <= RING_BYTES, "sample attention LDS map");
struct HRegs { f32x4 v[8]; };
__device__ __forceinline__ void h_load(const Frame& F, int l, int b, int kind, int ht, int pg, int which, int lane_in, HRegs& R) {
    int lane = lane_in; asm volatile("" : "+v"(lane));
    const int key = ht * 32 + (lane >> 1), hv = lane & 1;
    const float* base; size_t off; bool ok;
    if (kind <= KIND_CMP2) { ok = key < NCMP_S; const int kc = ok ? key : 0;
        base = WSP(F, float, which ? WS_CVS : WS_CKS); off = (((size_t)l * BS + b) * NCMP_S + kc) * 64; }
    else if (kind == KIND_SLC) { ok = key < PAST + TS;
        if (key < PAST) { base = INP(F, I_CACHE); off = ((((size_t)l * NPHYS + pg) * PAGE + (key & 127)) * 4 + 2 + which) * 64; }
        else { const int kk = ok ? key - PAST : 0; base = F.out + O_KVS; off = ((size_t)l * NS + b * TS + kk) * 256 + (2 + which) * 64; } }
    else { ok = (key >= PAST - 512) && (key < PAST + TS);
        if (key < PAST) { const int kk = ok ? key - (PAST - 512) : 0; base = INP(F, I_SWIN); off = (((size_t)l * BS + b) * 512 + kk) * 128 + which * 64; }
        else { const int kk = ok ? key - PAST : 0; base = WSP(F, float, WS_KWIN); off = ((size_t)NP + b * TS + kk) * 128 + which * 64; } }
    const float* p = base + off + hv * 32;
#pragma unroll
    for (int i = 0; i < 8; ++i) { const f32x4 x = *(const f32x4*)(p + 4 * i); R.v[i] = ok ? x : (f32x4){0.f, 0.f, 0.f, 0.f}; }
}
__device__ __forceinline__ void h_store_k(LAS unsigned char* kb, const HRegs& R, int lane_in) {
    int lane = lane_in; asm volatile("" : "+v"(lane));
    const int key = lane >> 1, hv = lane & 1;
#pragma unroll
    for (int i = 0; i < 4; ++i) { v4u o; o.x = cvtpk(R.v[2 * i].x, R.v[2 * i].y); o.y = cvtpk(R.v[2 * i].z, R.v[2 * i].w); o.z = cvtpk(R.v[2 * i + 1].x, R.v[2 * i + 1].y); o.w = cvtpk(R.v[2 * i + 1].z, R.v[2 * i + 1].w);
        *(LAS v4u*)(kb + key * 128 + (((4 * hv + i) ^ (key & 7)) << 4)) = o; }
}
__device__ __forceinline__ void h_store_v(LAS unsigned char* vb, const HRegs& R, int lane_in) {
    int lane = lane_in; asm volatile("" : "+v"(lane));
    const int key = lane >> 1, hv = lane & 1;
#pragma unroll
    for (int i = 0; i < 8; ++i) {
        const float xs[4] = {R.v[i].x, R.v[i].y, R.v[i].z, R.v[i].w};
#pragma unroll
        for (int k = 0; k < 4; ++k) { const int d = 32 * hv + 4 * i + k;
            *(LAS unsigned short*)(vb + d * 64 + (((key >> 2) ^ ((d >> 2) & 7)) << 3) + (key & 3) * 2) = (unsigned short)f2bf(xs[k]); }
    }
}
__device__ __forceinline__ void qk_half(const LAS unsigned char* kb, const bf16x8 (&qf)[4], f32x16& s0, int lane_in) {
    int lane = lane_in; asm volatile("" : "+v"(lane));
    const int r = lane & 31, h = lane >> 5;
#pragma unroll
    for (int i = 0; i < 16; ++i) s0[i] = 0.f;
#pragma unroll
    for (int ks = 0; ks < 4; ++ks) { const bf16x8 a0 = *(const LAS bf16x8*)(kb + r * 128 + (((2 * ks + h) ^ (r & 7)) << 4));
        s0 = __builtin_amdgcn_mfma_f32_32x32x16_bf16(a0, qf[ks], s0, 0, 0, 0); }
}
__device__ __forceinline__ void pv_half(const LAS unsigned char* vb, const f32x16& s0, f32x16 (&O)[2], int lane_in) {
    int lane = lane_in; asm volatile("" : "+v"(lane));
    const int r = lane & 31, h = lane >> 5;
    bf16x8 pf[2];
#pragma unroll
    for (int sp = 0; sp < 2; ++sp) { v4u a; a.x = cvtpk(s0[8 * sp + 0], s0[8 * sp + 1]); a.y = cvtpk(s0[8 * sp + 2], s0[8 * sp + 3]); a.z = cvtpk(s0[8 * sp + 4], s0[8 * sp + 5]); a.w = cvtpk(s0[8 * sp + 6], s0[8 * sp + 7]);
        pf[sp] = __builtin_bit_cast(bf16x8, a); }
#pragma unroll
    for (int dh = 0; dh < 2; ++dh) { const int d = dh * 32 + r, sw = (d >> 2) & 7; const LAS unsigned char* rb = vb + d * 64;
#pragma unroll
        for (int sp = 0; sp < 2; ++sp) { const int q0 = 4 * sp + h;
            const unsigned long long lo8 = *(const LAS unsigned long long*)(rb + ((q0 ^ sw) << 3)), hi8 = *(const LAS unsigned long long*)(rb + (((q0 + 2) ^ sw) << 3));
            v4u av; av.x = (unsigned)lo8; av.y = (unsigned)(lo8 >> 32); av.z = (unsigned)hi8; av.w = (unsigned)(hi8 >> 32);
            O[dh] = __builtin_amdgcn_mfma_f32_32x32x16_bf16(__builtin_bit_cast(bf16x8, av), pf[sp], O[dh], 0, 0, 0); } }
}
__device__ __forceinline__ void mask_half(f32x16& s0, int kbase, int lo, int hi) {
#pragma unroll
    for (int i = 0; i < 16; ++i) { const int k = kbase + (i & 3) + 8 * (i >> 2); if (k < lo || k > hi) s0[i] = -INFINITY; }
}
__device__ __forceinline__ float max16(const f32x16& s0) {
    float a = s0[0];
#pragma unroll
    for (int i = 1; i < 16; ++i) a = fmaxf(a, s0[i]);
    return half_max(a);
}
__device__ __forceinline__ void merge_branch(LAS unsigned char* lds, int wave, int lane, float m, float lsum, f32x16 (&O)[2], float gate) {
    LAS float* ml = (LAS float*)(lds + SW_ML); LAS float* outl = (LAS float*)(lds + SW_OUT) + lane;
    LAS float* slot = (LAS float*)(lds + SW_T + wave * 8192) + lane;
    const float lw = half_sum(lsum);
    ml[wave * 64 + lane] = m; ml[512 + wave * 64 + lane] = lw;
#pragma unroll
    for (int i = 0; i < 16; ++i) { slot[i * 64] = O[0][i]; slot[(16 + i) * 64] = O[1][i]; O[0][i] = 0.f; O[1][i] = 0.f; }
    __syncthreads();
    float M = -1e30f;
#pragma unroll
    for (int w = 0; w < 8; ++w) M = fmaxf(M, ml[w * 64 + lane]);
    float L = 0.f, sc[8];
#pragma unroll
    for (int w = 0; w < 8; ++w) { sc[w] = __builtin_amdgcn_exp2f(ml[w * 64 + lane] - M); L += ml[512 + w * 64 + lane] * sc[w]; }
    const float gl = (L > 0.f) ? gate / L : 0.f;
#pragma unroll
    for (int k = 0; k < 4; ++k) { const int i = wave * 4 + k; float a = 0.f;
#pragma unroll
        for (int w = 0; w < 8; ++w) a += ((LAS float*)(lds + SW_T + w * 8192))[i * 64 + lane] * sc[w];
        outl[i * 64] += a * gl; }
    __syncthreads();
}

__device__ __forceinline__ void attn_sample_unit(const Frame& F, int l, int b, int t0) {
    int lane_ = F.lane; asm volatile("" : "+v"(lane_));
    const int lane = lane_, wave = F.wave, tid = wave * 64 + lane, h = lane >> 5;
    LAS unsigned char* lds = F.lds;
    LAS unsigned char* kb = lds + SW_T + wave * 8192; LAS unsigned char* vb = kb + 4096;
    LAS float* impG = (LAS float*)(lds + SW_IMPG); LAS float* impE = (LAS float*)(lds + SW_IMPE);
    LAS unsigned* selw = (LAS unsigned*)(lds + SW_SEL); LAS unsigned* uni = (LAS unsigned*)(lds + SW_UNI);
    LAS int* list = (LAS int*)(lds + SW_LIST); LAS int* lpage = (LAS int*)(lds + SW_PAGE); LAS int* nlist = (LAS int*)(lds + SW_NL);
    LAS float* rankv = (LAS float*)(lds + SW_RANK + wave * 1024);
    LAS float* outl = (LAS float*)(lds + SW_OUT);
    const int tl = 0, head = lane & 3; const bool wcol = ((lane & 31) >> 2) == 0;
    const int r = NP + b * TS + t0, tpos = PAST + t0;
    bf16x8 qf[4];
    { const bf16* qb = WSP(F, bf16, WS_QB) + ((size_t)r * 4 + head) * 64;
#pragma unroll
      for (int ks = 0; ks < 4; ++ks) qf[ks] = *(const bf16x8*)(qb + 16 * ks + 8 * h); }
    const float* gp = WSP(F, float, WS_PROJ) + (size_t)r * IN_WP + OFF_G + head * 3;
    const float g0 = sigmoidf_(gp[0]), g1 = sigmoidf_(gp[1]), g2 = sigmoidf_(gp[2]);
    f32x16 O[2];
#pragma unroll
    for (int i = 0; i < 16; ++i) { O[0][i] = 0.f; O[1][i] = 0.f; }
    __syncthreads();
    if (tid < 64) selw[tid] = 0u;
    f32x16 sa, sb; float m = -1e30f, lsum = 0.f;
    {
        HRegs Ra, Rb; h_load(F, l, b, KIND_CMP1, wave, 0, 0, lane, Ra); h_load(F, l, b, KIND_CMP1, wave + 8, 0, 0, lane, Rb);
        h_store_k(kb, Ra, lane); asm volatile("s_waitcnt lgkmcnt(0)" ::: "memory");
        qk_half(kb, qf, sa, lane); mask_half(sa, wave * 32 + 4 * h, 0, NCMP_S - 1);
        asm volatile("s_waitcnt lgkmcnt(0)" ::: "memory");
        h_store_k(kb, Rb, lane); asm volatile("s_waitcnt lgkmcnt(0)" ::: "memory");
        qk_half(kb, qf, sb, lane); mask_half(sb, (wave + 8) * 32 + 4 * h, 0, NCMP_S - 1);
        m = fmaxf(max16(sa), max16(sb));
#pragma unroll
        for (int k = 0; k < 16; ++k) lsum += __builtin_amdgcn_exp2f(sa[k] - m) + __builtin_amdgcn_exp2f(sb[k] - m);
    }
    {
        LAS float* ml = (LAS float*)(lds + SW_ML);
        const float lw = half_sum(lsum);
        ml[wave * 64 + lane] = m; ml[512 + wave * 64 + lane] = lw;
        HRegs Ra, Rb; h_load(F, l, b, KIND_CMP2, wave, 0, 1, lane, Ra); h_load(F, l, b, KIND_CMP2, wave + 8, 0, 1, lane, Rb);
        __syncthreads();
        float M = -1e30f;
#pragma unroll
        for (int w = 0; w < 8; ++w) M = fmaxf(M, ml[w * 64 + lane]);
        float L = 0.f;
#pragma unroll
        for (int w = 0; w < 8; ++w) L += ml[512 + w * 64 + lane] * __builtin_amdgcn_exp2f(ml[w * 64 + lane] - M);
        const float rinv = L > 0.f ? 1.f / L : 0.f;
#pragma unroll
        for (int pass = 0; pass < 2; ++pass) {
            f32x16& sv = pass ? sb : sa; const int ht = pass ? wave + 8 : wave;
#pragma unroll
            for (int k = 0; k < 16; ++k) sv[k] = __builtin_amdgcn_exp2f(sv[k] - M) * rinv;
            if (pass) h_store_v(vb, Rb, lane); else h_store_v(vb, Ra, lane);
            asm volatile("s_waitcnt lgkmcnt(0)" ::: "memory");
            pv_half(vb, sv, O, lane);
            asm volatile("s_waitcnt lgkmcnt(0)" ::: "memory");
#pragma unroll
            for (int gq = 0; gq < 4; ++gq) {
                float G = (sv[4 * gq] + sv[4 * gq + 1]) + (sv[4 * gq + 2] + sv[4 * gq + 3]), E = sv[4 * gq + 3];
                G += __shfl_xor(G, 1); G += __shfl_xor(G, 2); E += __shfl_xor(E, 1); E += __shfl_xor(E, 2);
                const int j = 8 * ht + 2 * gq + h;
                if (head == 0) { impG[tl * 128 + j] = G; impE[tl * 128 + j] = E; }
            }
        }
        { LAS float* slot = (LAS float*)(lds + SW_T + wave * 8192) + lane;
#pragma unroll
          for (int i = 0; i < 16; ++i) { slot[i * 64] = O[0][i]; slot[(16 + i) * 64] = O[1][i]; O[0][i] = 0.f; O[1][i] = 0.f; } }
    }
    __syncthreads();
#pragma unroll
    for (int k = 0; k < 4; ++k) { const int i = wave * 4 + k; float a = 0.f;
#pragma unroll
        for (int w = 0; w < 8; ++w) a += ((LAS float*)(lds + SW_T + w * 8192))[i * 64 + lane];
        outl[i * 64 + lane] = a * g0; }
    __syncthreads();
    if (wave == 0) {
        const int tk = 0, cur = tpos >> 6;
        for (int j = lane; j < 132; j += 64) {
            float v;
            if (j > cur) v = -INFINITY;
            else if (j == 0 || j == cur || j == cur - 1) v = INFINITY;
            else v = impG[tk * 128 + j] + impE[tk * 128 + j - 1];
            rankv[j] = v;
        }
        asm volatile("s_waitcnt lgkmcnt(0)" ::: "memory");
        const float v0 = rankv[lane], v1 = rankv[64 + lane], v2 = (lane < 1) ? rankv[128 + lane] : -INFINITY;
        int r0 = 0, r1 = 0, r2 = 0;
        for (int k4 = 0; k4 < 132; k4 += 4) {
            const f32x4 vk = *(const LAS f32x4*)(rankv + k4);
#pragma unroll
            for (int u = 0; u < 4; ++u) { const float x = vk[u]; const int k = k4 + u;
                r0 += (x > v0 || (x == v0 && k < lane)) ? 1 : 0; r1 += (x > v1 || (x == v1 && k < 64 + lane)) ? 1 : 0; r2 += (x > v2 || (x == v2 && k < 128 + lane)) ? 1 : 0; }
        }
        const unsigned long long b0 = __ballot(r0 < 16 && lane <= cur), b1 = __ballot(r1 < 16 && 64 + lane <= cur), b2 = __ballot(lane < 1 && r2 < 16 && 128 + lane <= cur);
        if (lane == 0) { selw[tk * 8 + 0] = (unsigned)b0; selw[tk * 8 + 1] = (unsigned)(b0 >> 32); selw[tk * 8 + 2] = (unsigned)b1; selw[tk * 8 + 3] = (unsigned)(b1 >> 32); selw[tk * 8 + 4] = (unsigned)b2; }
    }
    __syncthreads();
    if (tid < 8) uni[tid] = selw[tid];
    __syncthreads();
    if (wave == 0) {
        int n = 0;
        for (int j0 = 0; j0 < 129; j0 += 64) {
            const int j = j0 + lane; const bool sj = (j < 129) && ((uni[j >> 5] >> (j & 31)) & 1u);
            int pg = 0; if (sj && j * 64 < PAST) pg = ((const int*)INP(F, I_PT))[b * NPAGES + (j >> 1)];
            const unsigned long long bal = __ballot(sj);
            if (sj) { const int idx = n + 2 * __popcll(bal & ((1ull << lane) - 1ull)); list[idx] = KIND_SLC | ((2 * j) << 4); list[idx + 1] = KIND_SLC | ((2 * j + 1) << 4); lpage[idx] = pg; lpage[idx + 1] = pg; }
            n += 2 * __popcll(bal);
        }
        if (lane == 0) nlist[0] = n;
        const int w0 = (PAST - 512) / 32, w1 = (PAST + TS - 1) / 32;
        if (lane <= w1 - w0) { list[n + lane] = KIND_WIN | ((w0 + lane) << 4); lpage[n + lane] = 0; }
        if (lane == 0) nlist[1] = n + (w1 - w0 + 1);
    }
    __syncthreads();
    const int n_slc = nlist[0], n_all = nlist[1];
#pragma unroll 1
    for (int br = 0; br < 2; ++br) {
        const int i0 = br ? n_slc : 0, i1 = br ? n_all : n_slc;
        m = -1e30f; lsum = 0.f;
        HRegs Rk, Rv;
        int it = i0 + wave;
        if (it < i1) { const int e = list[it], pg = lpage[it]; h_load(F, l, b, e & 15, e >> 4, pg, 0, lane, Rk); h_load(F, l, b, e & 15, e >> 4, pg, 1, lane, Rv); }
#pragma unroll 1
        for (; it < i1; it += 8) {
            const int e = __builtin_amdgcn_readfirstlane(list[it]); const int kind = e & 15, ht = e >> 4;
            h_store_k(kb, Rk, lane); h_store_v(vb, Rv, lane);
            if (it + 8 < i1) { const int e2 = list[it + 8], pg2 = lpage[it + 8]; h_load(F, l, b, e2 & 15, e2 >> 4, pg2, 0, lane, Rk); h_load(F, l, b, e2 & 15, e2 >> 4, pg2, 1, lane, Rv); }
            asm volatile("s_waitcnt lgkmcnt(0)" ::: "memory");
            int lo, hi;
            if (kind == KIND_SLC) { const int j = ht >> 1; const bool sbit = (selw[tl * 8 + (j >> 5)] >> (j & 31)) & 1u; lo = 0; hi = sbit ? tpos : -1; }
            else { lo = tpos - 511; hi = tpos; }
            f32x16 s0; qk_half(kb, qf, s0, lane);
            mask_half(s0, ht * 32 + 4 * h, lo, hi);
            const float mt = max16(s0); const float mn = fmaxf(m, mt); const float al = __builtin_amdgcn_exp2f(m - mn);
            float rs = 0.f;
#pragma unroll
            for (int k = 0; k < 16; ++k) { s0[k] = __builtin_amdgcn_exp2f(s0[k] - mn); rs += s0[k]; }
            lsum = lsum * al + rs; m = mn;
#pragma unroll
            for (int k = 0; k < 16; ++k) { O[0][k] *= al; O[1][k] *= al; }
            pv_half(vb, s0, O, lane);
            asm volatile("s_waitcnt lgkmcnt(0)" ::: "memory");
        }
        merge_branch(lds, wave, lane, m, lsum, O, br ? g2 : g1);
    }
    if (wave == 0 && wcol) {
        bf16* mo = WSP(F, bf16, WS_MIX) + (size_t)r * DM + 768 + head * 64;
#pragma unroll
        for (int dh = 0; dh < 2; ++dh)
#pragma unroll
            for (int gq = 0; gq < 4; ++gq) { const int d = dh * 32 + 8 * gq + 4 * h; const LAS float* o = outl + (dh * 16 + 4 * gq) * 64 + lane;
                *(unsigned long long*)(mo + d) = (unsigned long long)cvtpk(o[0], o[64]) | ((unsigned long long)cvtpk(o[128], o[192]) << 32); }
    }
    __syncthreads();
}


__device__ __forceinline__ void phase_attn2(const Frame& F, int l) {
    for (int u = blockIdx.x; u < 256; u += F.G) attn_unit(F, l, u & 7, (u >> 3) * 64, 64);
    Frame G2 = F; { int ln = G2.lane; asm volatile("" : "+v"(ln)); G2.lane = ln; G2.tid = G2.wave * 64 + ln; }
    if (F.G == 256) { if (blockIdx.x < 128) { ssd_out_unit(G2, l, (int)blockIdx.x >> 5, (int)blockIdx.x & 31); ssd_out_unit(G2, l, ((int)blockIdx.x + 128) >> 5, ((int)blockIdx.x + 128) & 31); } }
    else for (int u = blockIdx.x; u < BP * 32; u += F.G) ssd_out_unit(G2, l, u >> 5, u & 31);
    for (int r = NP + G2.gw; r < MROWS; r += G2.ngw) ssd_finish_token(G2, l, r);
}


constexpr float LOG2E = 1.4426950408889634f;
constexpr int SD_B = 0, SD_BT = 32768, SD_C = 65536, SD_AC = 98304, SD_DT = SD_AC + 2048, SD_W = SD_DT + 2048, SD_END = SD_W + 2048;
static_assert(SD_END <= RING_BYTES, "ssd LDS map");
__device__ __forceinline__ int crow16(int i, int hp) { return (i & 3) + 8 * (i >> 2) + 4 * hp; }
__device__ __forceinline__ unsigned long long pack4bf(float a, float b, float c, float d) { return (unsigned long long)cvtpk(a, b) | ((unsigned long long)cvtpk(c, d) << 32); }

__device__ __forceinline__ void ssd_chunk_unit(const Frame& F, int l, int b, int c, int g) {
    const int tid = F.tid, lane = F.lane, wave = F.wave;
    LAS unsigned char* lds = F.lds;
    const float* proj = WSP(F, float, WS_PROJ);
    const size_t rbase = (size_t)b * TP + (size_t)c * 128;
    const float* cw = INP(F, I_CONVW) + (size_t)l * 4 * CONV_DIM; const float* cbv = INP(F, I_CONVB) + (size_t)l * CONV_DIM;
    LAS float* acs = (LAS float*)(lds + SD_AC); LAS float* dts = (LAS float*)(lds + SD_DT); LAS float* wts = (LAS float*)(lds + SD_W);
    __syncthreads();
    if (wave < 4) {
        const int hh = wave, head = 4 * g + hh;
        const float a2 = -expf(INP(F, I_ALOG)[l * SSD_H + head]) * LOG2E, dtb = INP(F, I_DTB)[l * SSD_H + head];
        const float d0 = softplusf_(proj[(rbase + 2 * lane) * IN_WP + OFF_DT + head] + dtb), d1 = softplusf_(proj[(rbase + 2 * lane + 1) * IN_WP + OFF_DT + head] + dtb);
        float sc = (d0 + d1) * a2;
#pragma unroll
        for (int o = 1; o < 64; o <<= 1) { const float t = __shfl_up(sc, o); if (lane >= o) sc += t; }
        const float ac1 = sc, ac0 = sc - d1 * a2; const float tot = __uint_as_float(__builtin_amdgcn_readlane(__float_as_uint(sc), 63));
        acs[hh * 128 + 2 * lane] = ac0; acs[hh * 128 + 2 * lane + 1] = ac1; dts[hh * 128 + 2 * lane] = d0; dts[hh * 128 + 2 * lane + 1] = d1;
        wts[hh * 128 + 2 * lane] = __builtin_amdgcn_exp2f(tot - ac0); wts[hh * 128 + 2 * lane + 1] = __builtin_amdgcn_exp2f(tot - ac1);
        float* acg = WSP(F, float, WS_SAC); acg[(rbase + 2 * lane) * SSD_H + head] = ac0; acg[(rbase + 2 * lane + 1) * SSD_H + head] = ac1;
        if (lane == 63) WSP(F, float, WS_SCD)[((size_t)b * 16 + c) * SSD_H + head] = __builtin_amdgcn_exp2f(tot);
    }
    {
        const int ch = tid & 255, th = tid >> 8;
        const int chan = (ch < 128) ? 512 + g * 128 + ch : 768 + g * 128 + (ch - 128);
        const float w0 = cw[chan], w1 = cw[CONV_DIM + chan], w2 = cw[2 * CONV_DIM + chan], w3 = cw[3 * CONV_DIM + chan], bb = cbv[chan];
        const int tl0 = th * 64;
        const float* src = proj + (rbase + tl0) * IN_WP + OFF_XBC + chan;
        const bool hasp = (c > 0) || (th > 0);
        float x0 = hasp ? src[-3 * IN_WP] : 0.f, x1 = hasp ? src[-2 * IN_WP] : 0.f, x2 = hasp ? src[-IN_WP] : 0.f;
        const int n = ch & 127;
        bf16* cbg = WSP(F, bf16, WS_SCB) + (rbase + tl0) * 256 + g * 128 + n;
        for (int i1 = 0; i1 < 64; i1 += 16) {
          float rawv[16];
#pragma unroll
          for (int k = 0; k < 16; ++k) rawv[k] = src[(size_t)(i1 + k) * IN_WP];
#pragma unroll
          for (int i2 = 0; i2 < 16; i2 += 4) { const int i0 = i1 + i2;
            float v[4];
#pragma unroll
            for (int k = 0; k < 4; ++k) { const float cur = rawv[i2 + k]; v[k] = siluf_(bb + w0 * x0 + w1 * x1 + w2 * x2 + w3 * cur); x0 = x1; x1 = x2; x2 = cur; }
            const int s = tl0 + i0;
            if (ch < 128) {
#pragma unroll
                for (int k = 0; k < 4; ++k) *(LAS unsigned short*)(lds + SD_B + (s + k) * 256 + (((n >> 3) ^ ((s + k) & 15)) << 4) + (n & 7) * 2) = (unsigned short)f2bf(v[k]);
                *(LAS unsigned long long*)(lds + SD_BT + n * 256 + (((s >> 2) ^ (n & 31)) << 3)) = pack4bf(v[0], v[1], v[2], v[3]);
            } else {
#pragma unroll
                for (int k = 0; k < 4; ++k) { const unsigned short hv = (unsigned short)f2bf(v[k]);
                    *(LAS unsigned short*)(lds + SD_C + (s + k) * 256 + (((n >> 3) ^ ((s + k) & 15)) << 4) + (n & 7) * 2) = hv; cbg[(size_t)(i0 + k) * 256] = hv; }
            }
          }
        }
    }
    __syncthreads();
    const int lb = wave & 3, hw = wave >> 2;
    int lane_g = lane; asm volatile("" : "+v"(lane_g));
    f32x16 Gt[4];
    {
        const int r32 = lane_g & 31, hp = lane_g >> 5, lloc = lb * 32 + r32;
        bf16x8 cf[8];
#pragma unroll
        for (int ks = 0; ks < 8; ++ks) cf[ks] = *(const LAS bf16x8*)(lds + SD_C + lloc * 256 + (((2 * ks + hp) ^ (lloc & 15)) << 4));
#pragma unroll
        for (int sb = 0; sb < 4; ++sb) {
#pragma unroll
            for (int i = 0; i < 16; ++i) Gt[sb][i] = 0.f;
            if (sb <= lb) {
                int s = sb * 32 + r32; asm volatile("" : "+v"(s));
#pragma unroll
                for (int ks = 0; ks < 8; ++ks) { const bf16x8 a = *(const LAS bf16x8*)(lds + SD_B + s * 256 + (((2 * ks + hp) ^ (s & 15)) << 4));
                    Gt[sb] = __builtin_amdgcn_mfma_f32_32x32x16_bf16(a, cf[ks], Gt[sb], 0, 0, 0); }
            }
            __builtin_amdgcn_sched_barrier(0);
        }
    }
    __syncthreads();
    for (int rd = 0; rd < 2; ++rd) {
        {
            int tid_r = tid; asm volatile("" : "+v"(tid_r));
            const int ch = tid_r & 127, tq = tid_r >> 7; const int hh2 = ch >> 6, p = ch & 63, hh = 2 * rd + hh2;
            const int chan = (4 * g + hh) * 64 + p;
            const float w0 = cw[chan], w1 = cw[CONV_DIM + chan], w2 = cw[2 * CONV_DIM + chan], w3 = cw[3 * CONV_DIM + chan], bb = cbv[chan];
            const int tl0 = tq * 32;
            const float* src = proj + (rbase + tl0) * IN_WP + OFF_XBC + chan;
            const bool hasp = (c > 0) || (tq > 0);
            float x0 = hasp ? src[-3 * IN_WP] : 0.f, x1 = hasp ? src[-2 * IN_WP] : 0.f, x2 = hasp ? src[-IN_WP] : 0.f;
            for (int i1 = 0; i1 < 32; i1 += 16) {
              float rawv[16];
#pragma unroll
              for (int k = 0; k < 16; ++k) rawv[k] = src[(size_t)(i1 + k) * IN_WP];
#pragma unroll
              for (int i2 = 0; i2 < 16; i2 += 4) { const int i0 = i1 + i2;
                float v[4]; const int s = tl0 + i0;
#pragma unroll
                for (int k = 0; k < 4; ++k) { const float cur = rawv[i2 + k]; v[k] = siluf_(bb + w0 * x0 + w1 * x1 + w2 * x2 + w3 * cur) * dts[hh * 128 + s + k]; x0 = x1; x1 = x2; x2 = cur; }
                *(LAS unsigned long long*)(lds + SD_C + hh2 * 16384 + p * 256 + (((s >> 2) ^ (p & 31)) << 3)) = pack4bf(v[0], v[1], v[2], v[3]);
              }
            }
        }
        __syncthreads();
        int lane_r = lane; asm volatile("" : "+v"(lane_r));
        const int r32 = lane_r & 31, hp = lane_r >> 5, lloc = lb * 32 + r32;
        const int hh = 2 * rd + hw, head = 4 * g + hh;
        const LAS float* ac = acs + hh * 128; const LAS float* wp = wts + hh * 128;
        const LAS unsigned char* xt = lds + SD_C + hw * 16384;
        const float acl = ac[lloc], ddt = INP(F, I_SSDD)[l * SSD_H + head] / dts[hh * 128 + lloc];
        f32x16 Y[2];
#pragma unroll
        for (int i = 0; i < 16; ++i) { Y[0][i] = 0.f; Y[1][i] = 0.f; }
#pragma unroll
        for (int sb = 0; sb < 4; ++sb) {
            if (sb <= lb) {
                f32x16 mt;
#pragma unroll
                for (int i = 0; i < 16; ++i) { const int s = sb * 32 + crow16(i, hp);
                    float mv = Gt[sb][i] * __builtin_amdgcn_exp2f(acl - ac[s]);
                    if (sb == lb) { mv = (s > lloc) ? 0.f : mv; mv += (s == lloc) ? ddt : 0.f; }
                    mt[i] = mv; }
                bf16x8 pf[2];
#pragma unroll
                for (int sp = 0; sp < 2; ++sp) { v4u a; a.x = cvtpk(mt[8 * sp + 0], mt[8 * sp + 1]); a.y = cvtpk(mt[8 * sp + 2], mt[8 * sp + 3]); a.z = cvtpk(mt[8 * sp + 4], mt[8 * sp + 5]); a.w = cvtpk(mt[8 * sp + 6], mt[8 * sp + 7]);
                    pf[sp] = __builtin_bit_cast(bf16x8, a); }
#pragma unroll
                for (int pt = 0; pt < 2; ++pt) { int p = pt * 32 + r32; asm volatile("" : "+v"(p)); const int sw = p & 31; const LAS unsigned char* rb = xt + p * 256;
#pragma unroll
                    for (int sp = 0; sp < 2; ++sp) { const int q0 = sb * 8 + 4 * sp + hp;
                        const unsigned long long lo8 = *(const LAS unsigned long long*)(rb + ((q0 ^ sw) << 3)), hi8 = *(const LAS unsigned long long*)(rb + (((q0 + 2) ^ sw) << 3));
                        v4u av; av.x = (unsigned)lo8; av.y = (unsigned)(lo8 >> 32); av.z = (unsigned)hi8; av.w = (unsigned)(hi8 >> 32);
                        Y[pt] = __builtin_amdgcn_mfma_f32_32x32x16_bf16(__builtin_bit_cast(bf16x8, av), pf[sp], Y[pt], 0, 0, 0); } }
            }
            __builtin_amdgcn_sched_barrier(0);
        }
        {
            float* yo = WSP(F, float, WS_YSSD) + (rbase + lloc) * SSD_W + head * 64;
#pragma unroll
            for (int pt = 0; pt < 2; ++pt)
#pragma unroll
                for (int qd = 0; qd < 4; ++qd) *(f32x4*)(yo + pt * 32 + 8 * qd + 4 * hp) = (f32x4){Y[pt][4 * qd], Y[pt][4 * qd + 1], Y[pt][4 * qd + 2], Y[pt][4 * qd + 3]};
        }
        {
            f32x16 St[2];
#pragma unroll
            for (int i = 0; i < 16; ++i) { St[0][i] = 0.f; St[1][i] = 0.f; }
            const int n = lb * 32 + r32;
#pragma unroll
            for (int ks = 0; ks < 8; ++ks) {
                const int cb0 = 4 * ks + 2 * hp; int nn = n; asm volatile("" : "+v"(nn));
                const unsigned long long blo = *(const LAS unsigned long long*)(lds + SD_BT + nn * 256 + ((cb0 ^ (nn & 31)) << 3)), bhi = *(const LAS unsigned long long*)(lds + SD_BT + nn * 256 + (((cb0 + 1) ^ (nn & 31)) << 3));
                v4u bv; bv.x = (unsigned)blo; bv.y = (unsigned)(blo >> 32); bv.z = (unsigned)bhi; bv.w = (unsigned)(bhi >> 32);
                const f32x4 wa = *(const LAS f32x4*)(wp + 16 * ks + 8 * hp), wb = *(const LAS f32x4*)(wp + 16 * ks + 8 * hp + 4);
#pragma unroll
                for (int pt = 0; pt < 2; ++pt) { const int p = pt * 32 + (nn & 31); const LAS unsigned char* rb = xt + p * 256;
                    const unsigned long long alo = *(const LAS unsigned long long*)(rb + ((cb0 ^ (p & 31)) << 3)), ahi = *(const LAS unsigned long long*)(rb + (((cb0 + 1) ^ (p & 31)) << 3));
                    const unsigned a0 = (unsigned)alo, a1 = (unsigned)(alo >> 32), a2 = (unsigned)ahi, a3 = (unsigned)(ahi >> 32);
                    v4u av;
                    av.x = cvtpk(__uint_as_float(a0 << 16) * wa.x, __uint_as_float(a0 & 0xffff0000u) * wa.y); av.y = cvtpk(__uint_as_float(a1 << 16) * wa.z, __uint_as_float(a1 & 0xffff0000u) * wa.w);
                    av.z = cvtpk(__uint_as_float(a2 << 16) * wb.x, __uint_as_float(a2 & 0xffff0000u) * wb.y); av.w = cvtpk(__uint_as_float(a3 << 16) * wb.z, __uint_as_float(a3 & 0xffff0000u) * wb.w);
                    St[pt] = __builtin_amdgcn_mfma_f32_32x32x16_bf16(__builtin_bit_cast(bf16x8, av), __builtin_bit_cast(bf16x8, bv), St[pt], 0, 0, 0); }
                __builtin_amdgcn_sched_barrier(0);
            }
            float* cs = WSP(F, float, WS_SCS) + (((size_t)b * 16 + c) * SSD_H + head) * (SSD_HD * SSD_N) + n;
#pragma unroll
            for (int pt = 0; pt < 2; ++pt)
#pragma unroll
                for (int i = 0; i < 16; ++i) cs[(size_t)(pt * 32 + crow16(i, hp)) * SSD_N] = St[pt][i];
        }
        __syncthreads();
    }
}

__device__ __forceinline__ void ssd_scan(const Frame& F, int l) {
    const float* cs = WSP(F, float, WS_SCS); const float* cd = WSP(F, float, WS_SCD); bf16* hs = WSP(F, bf16, WS_SHS);
    const bool upper = (F.G == 256);
    for (int idx0 = blockIdx.x * NTHR + F.tid; idx0 < BP * SSD_H * 2048; idx0 += F.G * NTHR) {
        if (upper && blockIdx.x < 128) continue;
#pragma unroll 1
        for (int rep = 0; rep < (upper ? 2 : 1); ++rep) {
            const int idx = upper ? idx0 - (1 - rep) * 65536 : idx0;
            const int e4 = idx & 2047, bh = idx >> 11, b = bh >> 3, h = bh & 7;
            f32x4 st = (f32x4){0.f, 0.f, 0.f, 0.f};
#pragma unroll 8
            for (int c = 0; c < 16; ++c) {
                const size_t o = (((size_t)b * 16 + c) * SSD_H + h) * (SSD_HD * SSD_N) + e4 * 4;
                *(unsigned long long*)(hs + o) = pack4bf(st.x, st.y, st.z, st.w);
                const f32x4 sv = *(const f32x4*)(cs + o); const float d = cd[((size_t)b * 16 + c) * SSD_H + h];
                st = st * d + sv;
            }
            *(f32x4*)(F.out + O_SSMP + (((size_t)l * BP + b) * SSD_H + h) * (SSD_HD * SSD_N) + e4 * 4) = st;
        }
    }
}

__device__ __forceinline__ void ssd_out_unit(const Frame& F, int l, int b, int hc) {
    const int lane = F.lane, h = F.wave, g = h >> 2, c = hc >> 1, l0 = hc * 64, r32 = lane & 31, hp = lane >> 5;
    LAS float* ssq = (LAS float*)F.lds;
    const bf16* Hs = WSP(F, bf16, WS_SHS) + (((size_t)b * 16 + c) * SSD_H + h) * (SSD_HD * SSD_N);
    const bf16* Cb = WSP(F, bf16, WS_SCB) + ((size_t)b * TP + l0) * 256 + g * 128;
    f32x16 Yo[2][2];
#pragma unroll
    for (int i = 0; i < 16; ++i) { Yo[0][0][i] = 0.f; Yo[0][1][i] = 0.f; Yo[1][0][i] = 0.f; Yo[1][1][i] = 0.f; }
#pragma unroll
    for (int ks = 0; ks < 8; ++ks) {
        bf16x8 af[2], bfr[2];
#pragma unroll
        for (int pt = 0; pt < 2; ++pt) af[pt] = *(const bf16x8*)(Hs + (size_t)(pt * 32 + r32) * SSD_N + 16 * ks + 8 * hp);
#pragma unroll
        for (int lt = 0; lt < 2; ++lt) bfr[lt] = *(const bf16x8*)(Cb + (size_t)(lt * 32 + r32) * 256 + 16 * ks + 8 * hp);
#pragma unroll
        for (int lt = 0; lt < 2; ++lt)
#pragma unroll
            for (int pt = 0; pt < 2; ++pt) Yo[lt][pt] = __builtin_amdgcn_mfma_f32_32x32x16_bf16(af[pt], bfr[lt], Yo[lt][pt], 0, 0, 0);
    }
    __syncthreads();
#pragma unroll
    for (int lt = 0; lt < 2; ++lt) {
        const size_t row = (size_t)b * TP + l0 + lt * 32 + r32;
        const float sc = __builtin_amdgcn_exp2f(WSP(F, float, WS_SAC)[row * SSD_H + h]);
        const float* yd = WSP(F, float, WS_YSSD) + row * SSD_W + h * 64; const float* zz = WSP(F, float, WS_PROJ) + row * IN_WP + h * 64;
        float ss = 0.f;
#pragma unroll
        for (int pt = 0; pt < 2; ++pt) {
            f32x4 y4v[4], z4v[4];
#pragma unroll
            for (int i = 0; i < 4; ++i) { const int p = pt * 32 + 8 * i + 4 * hp; y4v[i] = *(const f32x4*)(yd + p); z4v[i] = *(const f32x4*)(zz + p); }
#pragma unroll
            for (int qd = 0; qd < 4; ++qd) { const f32x4 y4 = y4v[qd], z4 = z4v[qd];
#pragma unroll
                for (int k = 0; k < 4; ++k) { const float v = (y4[k] + sc * Yo[lt][pt][4 * qd + k]) * siluf_(z4[k]); Yo[lt][pt][4 * qd + k] = v; ss += v * v; } }
        }
        ss = half_sum(ss);
        if (hp == 0) ssq[(lt * 32 + r32) * 8 + h] = ss;
    }
    __syncthreads();
    const float* nw = INP(F, I_SSDNORM) + (size_t)l * SSD_W + h * 64;
#pragma unroll
    for (int lt = 0; lt < 2; ++lt) {
        const size_t row = (size_t)b * TP + l0 + lt * 32 + r32;
        const LAS float* sq = ssq + (lt * 32 + r32) * 8;
        const float tot = ((sq[0] + sq[1]) + (sq[2] + sq[3])) + ((sq[4] + sq[5]) + (sq[6] + sq[7]));
        const float rs = 1.f / sqrtf(tot * (1.f / SSD_W) + RMS_EPS);
        bf16* mo = WSP(F, bf16, WS_MIX) + row * DM + h * 64;
#pragma unroll
        for (int pt = 0; pt < 2; ++pt)
#pragma unroll
            for (int qd = 0; qd < 4; ++qd) { const int p = pt * 32 + 8 * qd + 4 * hp; const f32x4 w4 = *(const f32x4*)(nw + p);
                *(unsigned long long*)(mo + p) = pack4bf(Yo[lt][pt][4 * qd] * rs * w4.x, Yo[lt][pt][4 * qd + 1] * rs * w4.y, Yo[lt][pt][4 * qd + 2] * rs * w4.z, Yo[lt][pt][4 * qd + 3] * rs * w4.w); }
    }
    __syncthreads();
}

__device__ __forceinline__ void resid_row(const Frame& F, const float* xold, const float* f, const bf16* fb, int nsl, size_t slstride, const float* w_post, float* xnew, const float* w_next, bf16* xn) {
    const f32x4* xo = (const f32x4*)xold + F.lane; const f32x4* fr = (const f32x4*)f + F.lane; const f32x4* wp = (const f32x4*)w_post + F.lane;
    f32x4 fv[4]; float ss = 0.f;
#pragma unroll
    for (int j = 0; j < 4; ++j) {
        if (fb) fv[j] = bf4_to_f32(((const unsigned long long*)fb + F.lane)[64 * j]); else fv[j] = fr[64 * j];
        for (int s = 1; s < nsl; ++s) fv[j] += ((const f32x4*)(f + s * slstride) + F.lane)[64 * j];
        ss += (fv[j].x * fv[j].x + fv[j].y * fv[j].y) + (fv[j].z * fv[j].z + fv[j].w * fv[j].w); }
    const float rs = 1.f / sqrtf(wave_sum(ss) * (1.f / DM) + RMS_EPS);
    f32x4 xv[4]; float s2 = 0.f;
#pragma unroll
    for (int j = 0; j < 4; ++j) { xv[j] = xo[64 * j] + fv[j] * rs * wp[64 * j]; s2 += (xv[j].x * xv[j].x + xv[j].y * xv[j].y) + (xv[j].z * xv[j].z + xv[j].w * xv[j].w);
        ((f32x4*)xnew + F.lane)[64 * j] = xv[j]; }
    if (w_next) {
        const float r2 = 1.f / sqrtf(wave_sum(s2) * (1.f / DM) + RMS_EPS);
        const f32x4* wn = (const f32x4*)w_next + F.lane; unsigned long long* o8 = (unsigned long long*)xn + F.lane;
#pragma unroll
        for (int j = 0; j < 4; ++j) { const f32x4 g = wn[64 * j];
            o8[64 * j] = (unsigned long long)pk2(xv[j].x * r2 * g.x, xv[j].y * r2 * g.y) | ((unsigned long long)pk2(xv[j].z * r2 * g.z, xv[j].w * r2 * g.w) << 32); }
    }
}
template <int NR>
__device__ __forceinline__ void resid_rowsN(const Frame& F, const float* xold, const bf16* f, const float* w_post, float* xnew, const float* w_next, bf16* xn) {
    const int lane = F.lane;
    unsigned long long fr[NR][4]; f32x4 xv[NR][4];
#pragma unroll
    for (int r = 0; r < NR; ++r)
#pragma unroll
        for (int j = 0; j < 4; ++j) { fr[r][j] = ((const unsigned long long*)(f + (size_t)r * DM) + lane)[64 * j]; xv[r][j] = ((const f32x4*)(xold + (size_t)r * DM) + lane)[64 * j]; }
    float rs[NR];
#pragma unroll
    for (int r = 0; r < NR; ++r) { float s = 0.f;
#pragma unroll
        for (int j = 0; j < 4; ++j) { const f32x4 v = bf4_to_f32(fr[r][j]); s += (v.x * v.x + v.y * v.y) + (v.z * v.z + v.w * v.w); }
        rs[r] = s; }
#pragma unroll
    for (int r = 0; r < NR; ++r) rs[r] = 1.f / sqrtf(wave_sum(rs[r]) * (1.f / DM) + RMS_EPS);
    float s2[NR];
#pragma unroll
    for (int r = 0; r < NR; ++r) s2[r] = 0.f;
#pragma unroll
    for (int j = 0; j < 4; ++j) { const f32x4 wp = ((const f32x4*)w_post + lane)[64 * j];
#pragma unroll
        for (int r = 0; r < NR; ++r) { xv[r][j] = xv[r][j] + bf4_to_f32(fr[r][j]) * rs[r] * wp;
            s2[r] += (xv[r][j].x * xv[r][j].x + xv[r][j].y * xv[r][j].y) + (xv[r][j].z * xv[r][j].z + xv[r][j].w * xv[r][j].w);
            ((f32x4*)(xnew + (size_t)r * DM) + lane)[64 * j] = xv[r][j]; } }
    if (w_next) {
#pragma unroll
        for (int r = 0; r < NR; ++r) s2[r] = 1.f / sqrtf(wave_sum(s2[r]) * (1.f / DM) + RMS_EPS);
#pragma unroll
        for (int j = 0; j < 4; ++j) { const f32x4 g = ((const f32x4*)w_next + lane)[64 * j];
#pragma unroll
            for (int r = 0; r < NR; ++r) { const float q = s2[r];
                ((unsigned long long*)(xn + (size_t)r * DM) + lane)[64 * j] = (unsigned long long)pk2(xv[r][j].x * q * g.x, xv[r][j].y * q * g.y) | ((unsigned long long)pk2(xv[r][j].z * q * g.z, xv[r][j].w * q * g.w) << 32); } }
    }
}
constexpr int RES_NR = 4;
__device__ __forceinline__ void phase_resid_mix(const Frame& F, int l) {
    for (int rp = F.gw; rp < NP / RES_NR; rp += F.ngw) { const int r = RES_NR * rp;
        const float* x0 = (l == 0) ? x_in_row(F, r) : WSP(F, float, WS_X) + (size_t)r * DM;
        resid_rowsN<RES_NR>(F, x0, WSP(F, bf16, WS_MIXO) + (size_t)r * DM, INP(F, I_NMPOST) + (size_t)l * DM, WSP(F, float, WS_X) + (size_t)r * DM,
                            INP(F, I_NFPRE) + (size_t)l * DM, WSP(F, bf16, WS_XN) + (size_t)r * DM);
    }
    for (int r = NP + F.gw; r < MROWS; r += F.ngw) {
        const float* xold = (l == 0) ? x_in_row(F, r) : WSP(F, float, WS_X) + (size_t)r * DM;
        resid_row(F, xold, WSP(F, float, WS_SLAB) + (size_t)(r - NP) * DM, nullptr, SPLIT_OUT, (size_t)256 * DM, INP(F, I_NMPOST) + (size_t)l * DM, WSP(F, float, WS_X) + (size_t)r * DM,
                  INP(F, I_NFPRE) + (size_t)l * DM, WSP(F, bf16, WS_XN) + (size_t)r * DM);
    }
}
__device__ __forceinline__ void phase_resid_ffn(const Frame& F, int l) {
    const float* wn = (l == DEPTH - 1) ? nullptr : INP(F, I_NMPRE) + (size_t)(l + 1) * DM;
    for (int rp = F.gw; rp < NP / RES_NR; rp += F.ngw) { const int r = RES_NR * rp;
        float* xn = (l == DEPTH - 1) ? F.out + O_YP + (size_t)r * DM : WSP(F, float, WS_X) + (size_t)r * DM;
        resid_rowsN<RES_NR>(F, WSP(F, float, WS_X) + (size_t)r * DM, WSP(F, bf16, WS_MIXO) + (size_t)r * DM, INP(F, I_NFPOST) + (size_t)l * DM, xn, wn, WSP(F, bf16, WS_XN) + (size_t)r * DM);
    }
    for (int r = NP + F.gw; r < MROWS; r += F.ngw) {
        float* xnew = (l == DEPTH - 1) ? F.out + O_YS + (size_t)(r - NP) * DM : WSP(F, float, WS_X) + (size_t)r * DM;
        resid_row(F, WSP(F, float, WS_X) + (size_t)r * DM, WSP(F, float, WS_SLAB) + (size_t)(r - NP) * DM, nullptr, SPLIT_DOWN, (size_t)256 * DM, INP(F, I_NFPOST) + (size_t)l * DM, xnew,
                  wn, WSP(F, bf16, WS_XN) + (size_t)r * DM);
    }
}

__device__ __forceinline__ void phase_ffn_act(const Frame& F, int l) {
    bf16* act = WSP(F, bf16, WS_ACT);
    const float* cw = INP(F, I_FCW) + (size_t)l * 3 * DFF; const float* cb = INP(F, I_FCB) + (size_t)l * DFF;
    const float* halo = WSP(F, float, WS_FHALO); const float* last = WSP(F, float, WS_FLAST); const float* raw = WSP(F, float, WS_FRAW);
    for (int it = F.gw; it < 64 * 2 * 16; it += F.ngw) {
        const int pm = it >> 5, j = (it >> 4) & 1, c = (it & 15) * 256 + F.lane * 4;
        const bool first = (pm & 7) == 0;
        const f32x4 z = (f32x4){0.f, 0.f, 0.f, 0.f};
        const f32x4 ga = *(const f32x4*)(halo + ((size_t)pm * 2 + j) * 8192 + c), vv = *(const f32x4*)(halo + ((size_t)pm * 2 + j) * 8192 + 4096 + c);
        f32x4 gb, gc;
        if (j == 0) { gb = first ? z : *(const f32x4*)(last + ((size_t)(pm - 1) * 2 + 1) * 4096 + c); gc = first ? z : *(const f32x4*)(last + ((size_t)(pm - 1) * 2 + 0) * 4096 + c); }
        else { gb = *(const f32x4*)(halo + ((size_t)pm * 2 + 0) * 8192 + c); gc = first ? z : *(const f32x4*)(last + ((size_t)(pm - 1) * 2 + 1) * 4096 + c); }
        const f32x4 w0 = *(const f32x4*)(cw + c), w1 = *(const f32x4*)(cw + DFF + c), w2 = *(const f32x4*)(cw + 2 * DFF + c), bb = *(const f32x4*)(cb + c);
        const f32x4 pre = gc * w0 + gb * w1 + ga * w2 + bb;
        const float a0 = gelu_tanh(pre.x) * vv.x, a1 = gelu_tanh(pre.y) * vv.y, a2 = gelu_tanh(pre.z) * vv.z, a3 = gelu_tanh(pre.w) * vv.w;
        *(unsigned long long*)(act + (size_t)(pm * 256 + j) * DFF + c) = (unsigned long long)pk2(a0, a1) | ((unsigned long long)pk2(a2, a3) << 32);
    }
    for (int it = F.gw; it < BP * 2 * 16; it += F.ngw) {
        const int b = it >> 5, j = (it >> 4) & 1, c = (it & 15) * 256 + F.lane * 4;
        *(f32x4*)(F.out + O_FFNP + (((size_t)l * BP + b) * 2 + j) * DFF + c) = *(const f32x4*)(last + ((size_t)(8 * b + 7) * 2 + j) * 4096 + c);
    }
    for (int it = F.gw; it < NS * 16; it += F.ngw) {
        const int r = NP + (it >> 4), j = it & 15;
        const int qq = r - NP, b = qq >> 3, t = qq & 7;
        const float* sffn = INP(F, I_SFFN) + ((size_t)l * BS + b) * 2 * DFF;
        const float* g0 = raw + (size_t)qq * 2 * DFF;
        { const int c = j * 256 + F.lane * 4;
            constexpr size_t SL = (size_t)256 * 2 * DFF;
            f32x4 ga = *(const f32x4*)(g0 + c), gb, gc, vv = *(const f32x4*)(g0 + DFF + c);
            if (t >= 1) gb = *(const f32x4*)(g0 - (size_t)2 * DFF + c); else gb = *(const f32x4*)(sffn + DFF + c);
            if (t >= 2) gc = *(const f32x4*)(g0 - (size_t)4 * DFF + c); else gc = *(const f32x4*)(sffn + (size_t)t * DFF + c);
#pragma unroll
            for (int sl = 1; sl < SPLIT_UP; ++sl) { ga += *(const f32x4*)(g0 + sl * SL + c); vv += *(const f32x4*)(g0 + sl * SL + DFF + c);
                if (t >= 1) gb += *(const f32x4*)(g0 + sl * SL - (size_t)2 * DFF + c);
                if (t >= 2) gc += *(const f32x4*)(g0 + sl * SL - (size_t)4 * DFF + c); }
            const f32x4 w0 = *(const f32x4*)(cw + c), w1 = *(const f32x4*)(cw + DFF + c), w2 = *(const f32x4*)(cw + 2 * DFF + c), bb = *(const f32x4*)(cb + c);
            const f32x4 pre = gc * w0 + gb * w1 + ga * w2 + bb;
            const float a0 = gelu_tanh(pre.x) * vv.x, a1 = gelu_tanh(pre.y) * vv.y, a2 = gelu_tanh(pre.z) * vv.z, a3 = gelu_tanh(pre.w) * vv.w;
            *(unsigned long long*)(act + (size_t)r * DFF + c) = (unsigned long long)pk2(a0, a1) | ((unsigned long long)pk2(a2, a3) << 32);
            if (t >= TS - 2) *(f32x4*)(F.out + O_FFNS + (((size_t)l * BS + b) * 2 + (t - (TS - 2))) * DFF + c) = ga;
        }
    }
}

__global__ void __launch_bounds__(NTHR, 2) hymba_fwd(Params prm) {
    extern __shared__ __attribute__((aligned(16))) unsigned char lds_raw[];
    Frame F;
    F.lds = (LAS unsigned char*)lds_raw;
#define REFRESH() do { unsigned z_ = 0u; asm volatile("" : "+v"(z_)); int ln_ = (int)__builtin_amdgcn_mbcnt_hi(~0u, __builtin_amdgcn_mbcnt_lo(~0u, z_)); F.lane = ln_; F.wave = wave_s; F.tid = wave_s * 64 + ln_; \
        F.gw = blockIdx.x * NWAVES + F.wave; \
        const __attribute__((address_space(4))) void* kp_ = (const __attribute__((address_space(4))) void*)__builtin_amdgcn_kernarg_segment_ptr(); asm volatile("" : "+s"(kp_)); \
        F.p = (const __attribute__((address_space(4))) Params*)kp_; F.ws = F.p->ws; F.out = F.p->out; } while (0)
    F.G = gridDim.x; F.ngw = F.G * NWAVES;
    const int wave_s = __builtin_amdgcn_readfirstlane((int)threadIdx.x >> 6);
    REFRESH();
    volatile LAS unsigned* MISC = (volatile LAS unsigned*)(F.lds + MISC_OFF);
    for (int u = F.tid; u < (LDS_BYTES - RING_BYTES) / 4; u += NTHR) ((LAS unsigned*)(F.lds + RING_BYTES))[u] = 0u;
    __syncthreads();
    const int lo = F.p->ph_lo, hi = F.p->ph_hi;
    const bool use_bar = (hi - lo) > 1;
    XcdBarrier bar; bar.bar = (unsigned*)(F.ws + WS_CTL) + 4096; bar.x = 0; bar.st = nullptr;
    if (use_bar) bar = xcd_barrier_post((unsigned*)(F.ws + WS_CTL) + 4096, MISC + 8);
#define IN(k) (lo <= (k) && (k) < hi)
#define SEAM(k) do { if (IN((k) + 1)) { REFRESH(); xcd_barrier(bar, F.tid == 0); } } while (0)

    if (IN(0)) { REFRESH(); phase_prologue(F); SEAM(0); }
    if (IN(1)) { REFRESH();
        pg8::Gemm g{WSP(F, pg8::bf16_t, WS_AS), WSP(F, pg8::bf16_t, WS_WTC), 8 * BS * 512, 256, 1024};
        pg8::CmpOrder S; S.G = F.G; S.c = (int)blockIdx.x;
        pg8::EpiCmp E{WSP(F, float, WS_HS)};
        pg8::gemm_phase<pg8::EpiCmp, pg8::CmpOrder, true, true>(F.lds, g, S, E, F.tid);
        SEAM(1);
    }
    if (IN(2)) { REFRESH(); phase_cmp_finish(F); SEAM(2); }
    for (int l = 0; l < DEPTH; ++l) {
        const int pb = N_PRO + l * PH_PER_LAYER;
        if (IN(pb + 0)) { REFRESH();
            pg8::Gemm g{WSP(F, pg8::bf16_t, WS_XN), WSP(F, pg8::bf16_t, WS_WTIN) + (size_t)l * IN_WP * DM, MROWS, IN_WP, DM};
            pg8::StaticOrder S; S.init(MROWS, IN_WP, F.G, (int)blockIdx.x);
            pg8::EpiF32 E{WSP(F, float, WS_PROJ), IN_WP};
            pg8::gemm_phase<pg8::EpiF32, pg8::StaticOrder, true, true>(F.lds, g, S, E, F.tid);
            SEAM(pb + 0);
        }
        if (IN(pb + 1)) { REFRESH(); phase_prep(F, l); SEAM(pb + 1); }
        if (IN(pb + 2)) { REFRESH(); phase_compress(F, l); SEAM(pb + 2); }
        if (IN(pb + 3)) { REFRESH(); phase_attn2(F, l); SEAM(pb + 3); }
        if (IN(pb + 4)) { REFRESH();
            pg8::Gemm g{WSP(F, pg8::bf16_t, WS_MIX), WSP(F, pg8::bf16_t, WS_WTOUT) + (size_t)l * DM * DM, MROWS, DM, DM};
            pg8::TailSplitOrder S; S.init(NP, DM, DM, SPLIT_OUT, F.G, (int)blockIdx.x);
            pg8::EpiB16Split E{WSP(F, pg8::bf16_t, WS_MIXO), WSP(F, float, WS_SLAB), DM, NP / 256};
            pg8::gemm_phase<pg8::EpiB16Split, pg8::TailSplitOrder, true, true>(F.lds, g, S, E, F.tid);
            SEAM(pb + 4);
        }
        if (IN(pb + 5)) { REFRESH(); phase_resid_mix(F, l); SEAM(pb + 5); }
        if (IN(pb + 6)) { REFRESH();
            pg8::Gemm g{WSP(F, pg8::bf16_t, WS_XN), WSP(F, pg8::bf16_t, WS_WTUP) + (size_t)l * 2 * DFF * DM, MROWS, 2 * DFF, DM};
            pg8::StaticOrder S; S.init(MROWS, 2 * DFF, F.G, (int)blockIdx.x);
            pg8::EpiFfn E{WSP(F, pg8::bf16_t, WS_ACT), WSP(F, float, WS_FRAW), WSP(F, float, WS_FHALO), WSP(F, float, WS_FLAST),
                          INP(F, I_FCW) + (size_t)l * 3 * DFF, INP(F, I_FCB) + (size_t)l * DFF, (LAS float*)(F.lds + XB_OFF), NP / 256};
            pg8::gemm_phase<pg8::EpiFfn, pg8::StaticOrder, true, true>(F.lds, g, S, E, F.tid);
            SEAM(pb + 6);
        }
        if (IN(pb + 7)) { REFRESH(); phase_ffn_act(F, l); SEAM(pb + 7); }
        if (IN(pb + 8)) { REFRESH();
            pg8::Gemm g{WSP(F, pg8::bf16_t, WS_ACT), WSP(F, pg8::bf16_t, WS_WTDN) + (size_t)l * DM * DFF, MROWS, DM, DFF};
            pg8::TailSplitOrder S; S.init(NP, DM, DFF, SPLIT_DOWN, F.G, (int)blockIdx.x);
            pg8::EpiB16Split E{WSP(F, pg8::bf16_t, WS_MIXO), WSP(F, float, WS_SLAB), DM, NP / 256};
            pg8::gemm_phase<pg8::EpiB16Split, pg8::TailSplitOrder, true, true>(F.lds, g, S, E, F.tid);
            SEAM(pb + 8);
        }
        if (IN(pb + 9)) { REFRESH(); phase_resid_ffn(F, l); SEAM(pb + 9); }
    }
#undef IN
#undef SEAM
}

#ifndef N_LAUNCH_MODE
#define N_LAUNCH_MODE 1
#endif
extern "C" void kernel_launch(void* const* d_in, const int* in_sizes, int n_in, void* d_out, int out_size, void* d_ws, size_t ws_size, hipStream_t stream) {
    static int grid = 0;
    if (grid == 0) {
        if (n_in != N_IN || (size_t)out_size != O_END || ws_size < WS_END) {
            fprintf(stderr, "kernel_launch: unexpected shapes: n_in %d (want %d), out %d (want %zu), ws %zu (want >= %zu); nothing launched\n", n_in, (int)N_IN, out_size, (size_t)O_END, ws_size, (size_t)WS_END);
            grid = -1; return; }
        int dev = 0, cus = 0, per_cu = 0;
        if (hipGetDevice(&dev) != hipSuccess || hipDeviceGetAttribute(&cus, hipDeviceAttributeMultiprocessorCount, dev) != hipSuccess) { grid = -1; return; }
        if (hipFuncSetAttribute((const void*)hymba_fwd, hipFuncAttributeMaxDynamicSharedMemorySize, LDS_BYTES) != hipSuccess) { fprintf(stderr, "kernel_launch: hipFuncSetAttribute failed\n"); grid = -1; return; }
        if (hipOccupancyMaxActiveBlocksPerMultiprocessor(&per_cu, (const void*)hymba_fwd, NTHR, LDS_BYTES) != hipSuccess || per_cu < 1)
            fprintf(stderr, "kernel_launch: note: occupancy query reports %d workgroups per CU\n", per_cu);
        (void)hipGetLastError();
        grid = cus;
    }
    if (grid < 0) return;
    (void)hipMemsetAsync((char*)d_ws + WS_CTL, 0, CTL_BYTES, stream);
    Params prm{};
    for (int i = 0; i < N_IN; ++i) prm.in[i] = (const float*)d_in[i];
    prm.out = (float*)d_out; prm.ws = (unsigned char*)d_ws;
#if N_LAUNCH_MODE == 1
    prm.ph_lo = 0; prm.ph_hi = N_PHASES;
    hipLaunchKernelGGL(hymba_fwd, dim3(grid), dim3(NTHR), LDS_BYTES, stream, prm);
#else
    for (int ph = 0; ph < N_PHASES; ++ph) {
        prm.ph_lo = ph; prm.ph_hi = ph + 1;
        hipLaunchKernelGGL(hymba_fwd, dim3(grid), dim3(NTHR), LDS_BYTES, stream, prm);
    }
#endif
}
```

```cpp
#include <hip/hip_runtime.h>
#include <cstdio>
#include <cstdint>

namespace pg8 {
#define PG8_LAS __attribute__((address_space(3)))
typedef unsigned short bf16_t;
typedef short bf16x8 __attribute__((ext_vector_type(8)));
typedef float f32x4 __attribute__((ext_vector_type(4)));
typedef unsigned u32x4 __attribute__((ext_vector_type(4)));
constexpr int BM = 256, BK = 64, HALF = 128, HTB = HALF * BK * 2  , STAGE_BYTES = 8 * HTB, NXCD = 8, WGM = 8;

__host__ __device__ __forceinline__ int lds_byte(int r, int c) { const int st = (r >> 4) * 2 + (c >> 5), rr = r & 15, cc = c & 31, ob = rr * 64 + cc * 2; return st * 1024 + (ob ^ (((ob >> 9) & 1) << 5)); }
__host__ __device__ __forceinline__ void stage_rc(int b, int& R, int& C) { const int st = b / 1024, sb = b % 1024, swz = sb ^ (((sb >> 9) & 1) << 5); R = (st >> 1) * 16 + swz / 64; C = (st & 1) * 32 + (swz % 64) / 2; }
__host__ __device__ __forceinline__ int perm32(int rho) { const int n = rho >> 4, i = rho & 15; return 8 * (i >> 2) + 4 * n + (i & 3); }

struct Unit { int pm, pn, kt0, nt; };
struct Gemm { const bf16_t* A; const bf16_t* Bt; int M, N, K; };

struct StaticOrder {
    int nM, nN, nwg, G, c;
    __host__ __device__ __forceinline__ void init(int M, int N, int G_, int c_) { nM = M / BM; nN = N / BM; nwg = nM * nN; G = G_; c = c_; }
    __host__ __device__ __forceinline__ bool next(int i, Unit& u) const {
        const long L = (long)i * G + c; if (L >= nwg) return false;
        int wgid = (int)L; { const int q = nwg / NXCD, r = nwg % NXCD, xcd = wgid % NXCD, off = wgid / NXCD; wgid = (xcd < r ? xcd * (q + 1) : r * (q + 1) + (xcd - r) * q) + off; }
        const int nig = WGM * nN, gid = wgid / nig, fm = gid * WGM, gsz = (nM - fm) < WGM ? (nM - fm) : WGM;
        u.pm = fm + ((wgid % nig) % gsz); u.pn = (wgid % nig) / gsz; u.kt0 = 0; u.nt = 0; return true;
    }
    __device__ __forceinline__ void a_ready(const Unit&) const {}
    __device__ __forceinline__ void done(const Unit&) const {}
};

__device__ __forceinline__ unsigned cvt_pk_bf16(float lo, float hi) { unsigned r; asm volatile("v_cvt_pk_bf16_f32 %0, %1, %2" : "=v"(r) : "v"(lo), "v"(hi)); return r; }
struct EpiF32 {
    static constexpr bool PERM = true, AFTER_DRAIN = false;
    float* O; int ldc;
    __device__ __forceinline__ void operator()(const f32x4 (&acc)[2][2][4][2], const Unit& u, int wr, int wc, int fr, int fq) const {
        const int row0 = u.pm * BM + wr * 64 + fr; const int col0 = u.pn * BM + wc * 32 + 8 * fq;
#pragma unroll
        for (int ai = 0; ai < 2; ++ai)
#pragma unroll
            for (int m = 0; m < 4; ++m) { float* rowp = O + (size_t)(row0 + ai * HALF + m * 16) * ldc + col0;
#pragma unroll
                for (int bj = 0; bj < 2; ++bj) { *(f32x4*)(rowp + bj * HALF) = acc[ai][bj][m][0]; *(f32x4*)(rowp + bj * HALF + 4) = acc[ai][bj][m][1]; } }
    }
};

struct CmpOrder {
    int G, c;
    __device__ __forceinline__ bool next(int i, Unit& u) const { const int L = i * G + c; if (L >= 512) return false; u.pm = L; u.pn = L >> 6; u.kt0 = 0; u.nt = 0; return true; }
    __device__ __forceinline__ void a_ready(const Unit&) const {}
    __device__ __forceinline__ void done(const Unit&) const {}
};
struct EpiCmp {
    static constexpr bool PERM = true, AFTER_DRAIN = false;
    float* O;
    __device__ __forceinline__ void operator()(const f32x4 (&acc)[2][2][4][2], const Unit& u, int wr, int wc, int fr, int fq) const {
        const int row0 = u.pm * BM + wr * 64 + fr; const int col0 = wc * 32 + 8 * fq;
#pragma unroll
        for (int ai = 0; ai < 2; ++ai)
#pragma unroll
            for (int m = 0; m < 4; ++m) { float* rowp = O + (size_t)(row0 + ai * HALF + m * 16) * 256 + col0;
#pragma unroll
                for (int bj = 0; bj < 2; ++bj) { *(f32x4*)(rowp + bj * HALF) = acc[ai][bj][m][0]; *(f32x4*)(rowp + bj * HALF + 4) = acc[ai][bj][m][1]; } }
    }
};

struct EpiB16 {
    static constexpr bool PERM = true, AFTER_DRAIN = false;
    bf16_t* O; int ldc;
    __device__ __forceinline__ void operator()(const f32x4 (&acc)[2][2][4][2], const Unit& u, int wr, int wc, int fr, int fq) const {
        const int row0 = u.pm * BM + wr * 64 + fr; const int col0 = u.pn * BM + wc * 32 + 8 * fq;
#pragma unroll
        for (int ai = 0; ai < 2; ++ai)
#pragma unroll
            for (int m = 0; m < 4; ++m) { bf16_t* rowp = O + (size_t)(row0 + ai * HALF + m * 16) * ldc + col0;
#pragma unroll
                for (int bj = 0; bj < 2; ++bj) { const f32x4 v0 = acc[ai][bj][m][0], v1 = acc[ai][bj][m][1];
                    u32x4 w; w.x = cvt_pk_bf16(v0[0], v0[1]); w.y = cvt_pk_bf16(v0[2], v0[3]); w.z = cvt_pk_bf16(v1[0], v1[1]); w.w = cvt_pk_bf16(v1[2], v1[3]);
                    *(u32x4*)(rowp + bj * HALF) = w; } }
    }
};

struct TailSplitOrder {
    StaticOrder P; int nN, ntf, split;
    __device__ __forceinline__ void init(int Mp, int N, int K, int split_, int G, int c) { P.init(Mp, N, G, c); nN = N / BM; ntf = K / BK; split = split_; }
    __device__ __forceinline__ bool next(int i, Unit& u) const {
        const int L = i * P.G + P.c; const bool isp = L < P.nwg;
        int wgid = isp ? L : 0; { const int q = P.nwg / NXCD, r = P.nwg % NXCD, xcd = wgid % NXCD, off = wgid / NXCD; wgid = (xcd < r ? xcd * (q + 1) : r * (q + 1) + (xcd - r) * q) + off; }
        const int nig = WGM * P.nN, gid = wgid / nig, fm = gid * WGM, gsz = (P.nM - fm) < WGM ? (P.nM - fm) : WGM;
        const int ppm = fm + ((wgid % nig) % gsz), ppn = (wgid % nig) / gsz;
        const int t = L - P.nwg, nts = ntf / split;
        u.pm = isp ? ppm : P.nM; u.pn = isp ? ppn : t % nN; u.nt = isp ? 0 : nts; u.kt0 = isp ? 0 : (t / nN) * nts;
        return isp || t < nN * split;
    }
    __device__ __forceinline__ void a_ready(const Unit&) const {}
    __device__ __forceinline__ void done(const Unit&) const {}
};
struct EpiB16Split {
    static constexpr bool PERM = true, AFTER_DRAIN = false;
    bf16_t* O; float* S; int ldc; int tail_pm;
    __device__ __forceinline__ void operator()(const f32x4 (&acc)[2][2][4][2], const Unit& u, int wr, int wc, int fr, int fq) const {
        const int col0 = u.pn * BM + wc * 32 + 8 * fq;
        if (u.pm < tail_pm) {
            bf16_t* base = O + (size_t)(u.pm * BM + wr * 64 + fr) * ldc + col0;
#pragma unroll
            for (int ai = 0; ai < 2; ++ai)
#pragma unroll
                for (int m = 0; m < 4; ++m) { bf16_t* rowp = base + (size_t)(ai * HALF + m * 16) * ldc;
#pragma unroll
                    for (int bj = 0; bj < 2; ++bj) { const f32x4 v0 = acc[ai][bj][m][0], v1 = acc[ai][bj][m][1];
                        u32x4 w; w.x = cvt_pk_bf16(v0[0], v0[1]); w.y = cvt_pk_bf16(v0[2], v0[3]); w.z = cvt_pk_bf16(v1[0], v1[1]); w.w = cvt_pk_bf16(v1[2], v1[3]);
                        *(u32x4*)(rowp + bj * HALF) = w; } }
        } else {
            float* base = S + ((size_t)(u.kt0 / (u.nt ? u.nt : 1)) * BM + wr * 64 + fr) * ldc + col0;
#pragma unroll
            for (int ai = 0; ai < 2; ++ai)
#pragma unroll
                for (int m = 0; m < 4; ++m) { float* rowp = base + (size_t)(ai * HALF + m * 16) * ldc;
#pragma unroll
                    for (int bj = 0; bj < 2; ++bj) { *(f32x4*)(rowp + bj * HALF) = acc[ai][bj][m][0]; *(f32x4*)(rowp + bj * HALF + 4) = acc[ai][bj][m][1]; } }
        }
    }
};
struct EpiF32Split {
    static constexpr bool PERM = true, AFTER_DRAIN = false;
    float* O; float* S; int ldc; int tail_pm;
    __device__ __forceinline__ void operator()(const f32x4 (&acc)[2][2][4][2], const Unit& u, int wr, int wc, int fr, int fq) const {
        const int col0 = u.pn * BM + wc * 32 + 8 * fq;
        float* base = (u.pm < tail_pm) ? O + (size_t)(u.pm * BM + wr * 64 + fr) * ldc : S + ((size_t)(u.kt0 / (u.nt ? u.nt : 1)) * BM + wr * 64 + fr) * ldc;
#pragma unroll
        for (int ai = 0; ai < 2; ++ai)
#pragma unroll
            for (int m = 0; m < 4; ++m) { float* rowp = base + (size_t)(ai * HALF + m * 16) * ldc + col0;
#pragma unroll
                for (int bj = 0; bj < 2; ++bj) { *(f32x4*)(rowp + bj * HALF) = acc[ai][bj][m][0]; *(f32x4*)(rowp + bj * HALF + 4) = acc[ai][bj][m][1]; } }
    }
};

__device__ __forceinline__ float dpp_ror1(float v) { return __builtin_bit_cast(float, __builtin_amdgcn_update_dpp(0, __builtin_bit_cast(int, v), 0x121, 0xf, 0xf, false)); }
__device__ __forceinline__ float dpp_ror2(float v) { return __builtin_bit_cast(float, __builtin_amdgcn_update_dpp(0, __builtin_bit_cast(int, v), 0x122, 0xf, 0xf, false)); }
__device__ __forceinline__ float dpp_shr1(float old, float v) { return __builtin_bit_cast(float, __builtin_amdgcn_update_dpp(__builtin_bit_cast(int, old), __builtin_bit_cast(int, v), 0x111, 0xf, 0xf, false)); }
__device__ __forceinline__ float dpp_shr2(float old, float v) { return __builtin_bit_cast(float, __builtin_amdgcn_update_dpp(__builtin_bit_cast(int, old), __builtin_bit_cast(int, v), 0x112, 0xf, 0xf, false)); }
__device__ __forceinline__ float gelu_t(float x) {
    const float p = x * __builtin_fmaf(x * x, 0.044715f * 2.302208198f, 2.302208198f);
    return x * __builtin_amdgcn_rcpf(1.f + __builtin_amdgcn_exp2f(-p));
}
struct EpiFfn {
    static constexpr bool PERM = true, AFTER_DRAIN = false;
    bf16_t* ACT;
    float* RAW;
    float* HALO;
    float* LAST;
    const float* cw; const float* cb;
    PG8_LAS float* xb;
    int tail_pm;
    __device__ __forceinline__ void operator()(const f32x4 (&acc)[2][2][4][2], const Unit& u, int wr, int wc, int fr_in, int fq_in) const {
        int fr = fr_in, fq = fq_in; asm volatile("" : "+v"(fr), "+v"(fq));
        const int colt = wc * 32 + 8 * fq, gcol = u.pn * 128 + colt;
        const bool tail = (u.pm >= tail_pm);
#pragma unroll
        for (int ai = 0; ai < 2; ++ai) {
            if (fr >= 14) { PG8_LAS float* d = xb + ((ai * 2 + wr) * 2 + (fr - 14)) * 128 + colt;
                *(PG8_LAS f32x4*)d = acc[ai][0][3][0]; *(PG8_LAS f32x4*)(d + 4) = acc[ai][0][3][1]; }
        }
        if (!tail) {
            if (wr == 1 && fr >= 14) { float* d = LAST + ((size_t)u.pm * 2 + (fr - 14)) * 4096 + gcol; *(f32x4*)d = acc[1][0][3][0]; *(f32x4*)(d + 4) = acc[1][0][3][1]; }
            if (wr == 0 && fr < 2) { float* d = HALO + ((size_t)u.pm * 2 + fr) * 8192 + gcol;
                *(f32x4*)d = acc[0][0][0][0]; *(f32x4*)(d + 4) = acc[0][0][0][1]; *(f32x4*)(d + 4096) = acc[0][1][0][0]; *(f32x4*)(d + 4096 + 4) = acc[0][1][0][1]; }
        } else {
#pragma unroll
            for (int ai = 0; ai < 2; ++ai)
#pragma unroll
                for (int m = 0; m < 4; ++m) { float* d = RAW + ((size_t)(u.kt0 / (u.nt ? u.nt : 1)) * BM + ai * HALF + wr * 64 + m * 16 + fr) * 8192 + gcol;
                    *(f32x4*)d = acc[ai][0][m][0]; *(f32x4*)(d + 4) = acc[ai][0][m][1]; *(f32x4*)(d + 4096) = acc[ai][1][m][0]; *(f32x4*)(d + 4096 + 4) = acc[ai][1][m][1]; }
        }
        asm volatile("s_waitcnt lgkmcnt(0)" ::: "memory");
        __builtin_amdgcn_s_barrier();
        if (tail) return;
#pragma unroll
        for (int n = 0; n < 2; ++n) {
            const f32x4 w0 = *(const f32x4*)(cw + gcol + 4 * n), w1 = *(const f32x4*)(cw + 4096 + gcol + 4 * n), w2 = *(const f32x4*)(cw + 8192 + gcol + 4 * n), bb = *(const f32x4*)(cb + gcol + 4 * n);
#pragma unroll
            for (int ai = 0; ai < 2; ++ai) {
                const int pgrp = (wr == 1) ? (ai * 2 + 0) : (0 * 2 + 1);
                const f32x4 pv = *(const PG8_LAS f32x4*)(xb + (pgrp * 2 + (fr == 15 ? 1 : 0)) * 128 + colt + 4 * n);
#pragma unroll
                for (int m = 0; m < 4; ++m) {
                    float a4[4];
#pragma unroll
                    for (int k = 0; k < 4; ++k) {
                        const float cur = acc[ai][0][m][n][k]; const float prm = (m > 0) ? acc[ai][0][m > 0 ? m - 1 : 0][n][k] : pv[k];
                        const float p1 = dpp_shr1(dpp_ror1(prm), cur), p2 = dpp_shr2(dpp_ror2(prm), cur);
                        const float pre = w0[k] * p2 + w1[k] * p1 + w2[k] * cur + bb[k];
                        a4[k] = gelu_t(pre) * acc[ai][1][m][n][k];
                    }
                    const bool deferred = (ai == 0 && wr == 0 && m == 0 && fr < 2);
                    if (!deferred) *(unsigned long long*)(ACT + (size_t)(u.pm * BM + ai * HALF + wr * 64 + m * 16 + fr) * 4096 + gcol + 4 * n) =
                        (unsigned long long)cvt_pk_bf16(a4[0], a4[1]) | ((unsigned long long)cvt_pk_bf16(a4[2], a4[3]) << 32);
                }
            }
        }
    }
};
template <class Epi, class Sched, bool ALIGN_EPI = false, bool SP2 = false>
__device__ __forceinline__ void gemm_phase(PG8_LAS unsigned char* lds, const Gemm g, const Sched& S, const Epi& E, const int tid_in) {
    int tid_ = tid_in; asm volatile("" : "+v"(tid_));
    const int tid = tid_, wid = __builtin_amdgcn_readfirstlane(tid >> 6), lane = tid & 63, wr = wid >> 2, wc = wid & 3, fr = lane & 15, fq = lane >> 4;
    const int K = g.K, ntf = K / BK;
    unsigned voffA[2], voffB[2];
#pragma unroll
    for (int i = 0; i < 2; ++i) { int R, C; stage_rc(tid * 16 + i * 8192, R, C); const int Rb = Epi::PERM ? ((R & ~31) + perm32(R & 31)) : R;
        voffA[i] = (unsigned)(R * K + C) * 2u; voffB[i] = (unsigned)(Rb * K + C) * 2u; }
    const size_t kstep = (size_t)(BK * 2);
    const size_t hstep = (size_t)HALF * K * 2;
    const size_t tstep = 2 * hstep;
    const unsigned ldsw = (unsigned)wid * 1024u;
    const int aoff = lds_byte(wr * 64 + fr, fq * 8), boff = lds_byte(wc * 32 + fr, fq * 8);
#define PG8_SA(b, h) (((b) * 2 + (h)) * HTB)
#define PG8_SB(b, h) ((4 + (b) * 2 + (h)) * HTB)
#define PG8_STAGE(bufoff, gbase, voff) do { _Pragma("unroll") for (int _i = 0; _i < 2; ++_i) \
        __builtin_amdgcn_global_load_lds((const unsigned*)((const char*)(gbase) + (voff)[_i]), (PG8_LAS unsigned*)(lds + (bufoff) + ldsw + _i * 8192), 16, 0, 0); } while (0)
#define PG8_LDA(dst, b, h) do { _Pragma("unroll") for (int m = 0; m < 4; ++m) _Pragma("unroll") for (int k = 0; k < 2; ++k) dst[m][k] = *(const PG8_LAS bf16x8*)(lds + PG8_SA(b, h) + aoff + m * 2048 + k * 1024); } while (0)
#define PG8_LDB(dst, b, h) do { _Pragma("unroll") for (int n = 0; n < 2; ++n) _Pragma("unroll") for (int k = 0; k < 2; ++k) dst[n][k] = *(const PG8_LAS bf16x8*)(lds + PG8_SB(b, h) + boff + n * 2048 + k * 1024); } while (0)
#define PG8_MMA(ai, bj, At, Bt) do { __builtin_amdgcn_s_setprio(1); _Pragma("unroll") for (int m = 0; m < 4; ++m) _Pragma("unroll") for (int n = 0; n < 2; ++n) _Pragma("unroll") for (int k = 0; k < 2; ++k) \
        acc[ai][bj][m][n] = __builtin_amdgcn_mfma_f32_16x16x32_bf16(Bt[n][k], At[m][k], acc[ai][bj][m][n], 0, 0, 0); __builtin_amdgcn_s_setprio(0); } while (0)
#define PG8_WAIT_V(n) asm volatile("s_waitcnt vmcnt(" #n ")" ::: "memory")
#define PG8_WAIT_L(n) asm volatile("s_waitcnt lgkmcnt(" #n ")" ::: "memory")
#define PG8_BAR __builtin_amdgcn_s_barrier()
#define PG8_SCHED __builtin_amdgcn_sched_barrier(0)
    Unit cur = {0, 0, 0, 0}, nxt = {0, 0, 0, 0}; int ui = 0;
    if (!S.next(0, cur)) return;
    f32x4 acc[2][2][4][2];
#pragma unroll
    for (int a = 0; a < 2; ++a)
#pragma unroll
        for (int b = 0; b < 2; ++b)
#pragma unroll
            for (int m = 0; m < 4; ++m)
#pragma unroll
                for (int n = 0; n < 2; ++n) acc[a][b][m][n] = (f32x4){0.f, 0.f, 0.f, 0.f};
    bf16x8 At[4][2], B0[2][2], B1[2][2];
    const char* cA = (const char*)g.A + (size_t)cur.pm * tstep + (size_t)cur.kt0 * kstep; const char* cB = (const char*)g.Bt + (size_t)cur.pn * tstep + (size_t)cur.kt0 * kstep;
    S.a_ready(cur);
    if constexpr (SP2) {
        PG8_STAGE(PG8_SB(0, 0), cB, voffB); PG8_STAGE(PG8_SB(0, 1), cB + hstep, voffB); PG8_STAGE(PG8_SA(0, 0), cA, voffA); PG8_STAGE(PG8_SA(0, 1), cA + hstep, voffA);
        if (wr == 1) PG8_BAR;
        PG8_WAIT_V(2); PG8_BAR;
        PG8_STAGE(PG8_SB(1, 0), cB + kstep, voffB); PG8_STAGE(PG8_SA(1, 0), cA + kstep, voffA); PG8_STAGE(PG8_SB(1, 1), cB + hstep + kstep, voffB);
        PG8_WAIT_V(6); PG8_BAR;
    } else {
        PG8_STAGE(PG8_SB(0, 0), cB, voffB); PG8_STAGE(PG8_SA(0, 0), cA, voffA); PG8_STAGE(PG8_SB(0, 1), cB + hstep, voffB); PG8_STAGE(PG8_SA(0, 1), cA + hstep, voffA);
        if (wr == 1) PG8_BAR;
        PG8_WAIT_V(4); PG8_BAR;
        PG8_STAGE(PG8_SB(1, 0), cB + kstep, voffB); PG8_STAGE(PG8_SA(1, 0), cA + kstep, voffA); PG8_STAGE(PG8_SB(1, 1), cB + hstep + kstep, voffB);
        PG8_WAIT_V(6); PG8_BAR;
    }
    for (;;) {
        const bool has_next = S.next(ui + 1, nxt);
        const char* nA = has_next ? (const char*)g.A + (size_t)nxt.pm * tstep + (size_t)nxt.kt0 * kstep : cA; const char* nB = has_next ? (const char*)g.Bt + (size_t)nxt.pn * tstep + (size_t)nxt.kt0 * kstep : cB;
        const int nt = cur.nt ? cur.nt : ntf;
        for (int t = 0; t < nt; t += 2) {
            const bool last = (t == nt - 2);
            const char* a1 = cA + (size_t)(t + 1) * kstep;
            const char* a2 = last ? nA : cA + (size_t)(t + 2) * kstep; const char* b2 = last ? nB : cB + (size_t)(t + 2) * kstep;
            const char* a3 = a2 + kstep; const char* b3 = b2 + kstep;
            if (last && has_next) S.a_ready(nxt);
            if constexpr (SP2) {
            PG8_LDB(B0, 0, 0); PG8_LDB(B1, 0, 1); PG8_SCHED; PG8_LDA(At, 0, 0); PG8_STAGE(PG8_SA(1, 1), a1 + hstep, voffA);
            PG8_WAIT_V(8); PG8_WAIT_L(0); PG8_BAR; PG8_MMA(0, 0, At, B0); PG8_MMA(0, 1, At, B1); PG8_BAR; PG8_SCHED;
            PG8_LDA(At, 0, 1); PG8_STAGE(PG8_SB(0, 0), b2, voffB); PG8_STAGE(PG8_SB(0, 1), b2 + hstep, voffB); PG8_STAGE(PG8_SA(0, 0), a2, voffA);
            PG8_WAIT_V(8); PG8_WAIT_L(0); PG8_BAR; PG8_MMA(1, 0, At, B0); PG8_MMA(1, 1, At, B1); PG8_BAR; PG8_SCHED;
            PG8_LDB(B0, 1, 0); PG8_LDB(B1, 1, 1); PG8_SCHED; PG8_LDA(At, 1, 0); PG8_STAGE(PG8_SA(0, 1), a2 + hstep, voffA);
            PG8_WAIT_V(8); PG8_WAIT_L(0); PG8_BAR; PG8_MMA(0, 0, At, B0); PG8_MMA(0, 1, At, B1); PG8_BAR; PG8_SCHED;
            PG8_LDA(At, 1, 1); PG8_STAGE(PG8_SB(1, 0), b3, voffB); PG8_STAGE(PG8_SB(1, 1), b3 + hstep, voffB); PG8_STAGE(PG8_SA(1, 0), a3, voffA);
            PG8_WAIT_V(8); PG8_WAIT_L(0); PG8_BAR; PG8_MMA(1, 0, At, B0); PG8_MMA(1, 1, At, B1); PG8_BAR; PG8_SCHED;
            } else {
            PG8_LDB(B0, 0, 0); PG8_SCHED; PG8_LDA(At, 0, 0); PG8_STAGE(PG8_SA(1, 1), a1 + hstep, voffA);
            PG8_WAIT_L(8); PG8_BAR; PG8_WAIT_L(0); PG8_MMA(0, 0, At, B0); PG8_BAR; PG8_SCHED;
            PG8_LDB(B1, 0, 1); PG8_STAGE(PG8_SB(0, 0), b2, voffB);
            PG8_BAR; PG8_WAIT_L(0); PG8_MMA(0, 1, At, B1); PG8_BAR;
            PG8_LDA(At, 0, 1); PG8_STAGE(PG8_SA(0, 0), a2, voffA);
            PG8_BAR; PG8_WAIT_L(0); PG8_MMA(1, 0, At, B0); PG8_BAR; PG8_SCHED;
            PG8_STAGE(PG8_SB(0, 1), b2 + hstep, voffB);
            PG8_WAIT_V(6); PG8_BAR; PG8_MMA(1, 1, At, B1); PG8_BAR;
            PG8_LDB(B0, 1, 0); PG8_SCHED; PG8_LDA(At, 1, 0); PG8_STAGE(PG8_SA(0, 1), a2 + hstep, voffA);
            PG8_WAIT_L(8); PG8_BAR; PG8_WAIT_L(0); PG8_MMA(0, 0, At, B0); PG8_BAR; PG8_SCHED;
            PG8_LDB(B1, 1, 1); PG8_STAGE(PG8_SB(1, 0), b3, voffB);
            PG8_BAR; PG8_WAIT_L(0); PG8_MMA(0, 1, At, B1); PG8_BAR;
            PG8_LDA(At, 1, 1); PG8_STAGE(PG8_SA(1, 0), a3, voffA);
            PG8_BAR; PG8_WAIT_L(0); PG8_MMA(1, 0, At, B0); PG8_BAR; PG8_SCHED;
            PG8_STAGE(PG8_SB(1, 1), b3 + hstep, voffB);
            PG8_WAIT_V(6); PG8_BAR; PG8_MMA(1, 1, At, B1); PG8_BAR;
            }
        }
        if constexpr (ALIGN_EPI) { if (wr == 0) PG8_BAR; }
        if constexpr (!Epi::AFTER_DRAIN) { E(acc, cur, wr, wc, fr, fq); S.done(cur); }
        if (!has_next) break;
#pragma unroll
        for (int a = 0; a < 2; ++a)
#pragma unroll
            for (int b = 0; b < 2; ++b)
#pragma unroll
                for (int m = 0; m < 4; ++m)
#pragma unroll
                    for (int n = 0; n < 2; ++n) acc[a][b][m][n] = (f32x4){0.f, 0.f, 0.f, 0.f};
        cur = nxt; cA = nA; cB = nB; ++ui;
        if constexpr (ALIGN_EPI) { if (wr == 1) PG8_BAR; }
    }
    PG8_WAIT_V(0);
    if constexpr (!ALIGN_EPI) { if (wr == 0) PG8_BAR; }
    PG8_BAR;
    if constexpr (Epi::AFTER_DRAIN) { E.fused(acc, cur, wr, wc, fr, fq, lds, wid, lane); S.done(cur); }
#undef PG8_SA
#undef PG8_SB
#undef PG8_STAGE
#undef PG8_LDA
#undef PG8_LDB
#undef PG8_MMA
#undef PG8_WAIT_V
#undef PG8_WAIT_L
#undef PG8_BAR
#undef PG8_SCHED
}
}

#define GAS __attribute__((address_space(1)))
#define LAS __attribute__((address_space(3)))
typedef unsigned short bf16;
typedef unsigned v4u __attribute__((ext_vector_type(4)));
typedef float f32x4 __attribute__((ext_vector_type(4)));
typedef short bf16x8 __attribute__((ext_vector_type(8)));

constexpr int DM = 1024, BP = 8, TP = 2048, DEPTH = 4, BS = 32, TS = 8, PAST = 8192, PAGE = 128;
constexpr int NP = BP * TP, NS = BS * TS, MROWS = NP + NS;
constexpr int NSEQ = BP + BS;
constexpr int SSD_W = 512, SSD_H = 8, SSD_HD = 64, SSD_N = 128, CONV_DIM = 1024;
constexpr int POOL_W = 256, POOL_KEEP = 15;
constexpr int NSA_H = 4, NSA_HD = 64;
constexpr int OFF_XBC = 512, OFF_DT = 1536, OFF_POOL = 1544, OFF_Q = 1800, OFF_KV = 2056, OFF_G = 2440, IN_W = 2452, IN_WP = 2560;
constexpr int DFF = 4096;
constexpr int NPHYS = 2560, NPAGES = 64;
constexpr int NCMP_P = 127, NCMP_S = 511;
constexpr float RMS_EPS = 1e-6f;

constexpr size_t O_YP = 0;
constexpr size_t O_YS = O_YP + (size_t)NP * DM;
constexpr size_t O_KVP = O_YS + (size_t)NS * DM;
constexpr size_t O_KVS = O_KVP + (size_t)DEPTH * NP * 256;
constexpr size_t O_WINP = O_KVS + (size_t)DEPTH * NS * 256;
constexpr size_t O_WINS = O_WINP + (size_t)DEPTH * BP * 512 * 128;
constexpr size_t O_CONVP = O_WINS + (size_t)DEPTH * BS * 512 * 128;
constexpr size_t O_CONVS = O_CONVP + (size_t)DEPTH * BP * 3 * 1024;
constexpr size_t O_SSMP = O_CONVS + (size_t)DEPTH * BS * 3 * 1024;
constexpr size_t O_SSMS = O_SSMP + (size_t)DEPTH * BP * 8 * 64 * 128;
constexpr size_t O_POOLP = O_SSMS + (size_t)DEPTH * BS * 8 * 64 * 128;
constexpr size_t O_POOLS = O_POOLP + (size_t)DEPTH * BP * 15 * 256;
constexpr size_t O_FFNP = O_POOLS + (size_t)DEPTH * BS * 15 * 256;
constexpr size_t O_FFNS = O_FFNP + (size_t)DEPTH * BP * 2 * 4096;
constexpr size_t O_END = O_FFNS + (size_t)DEPTH * BS * 2 * 4096;

enum { I_XP = 0, I_XS, I_CACHE, I_PT, I_SWIN, I_SCONV, I_SSM, I_SPOOL, I_SFFN, I_NMPRE, I_WIN, I_CONVW, I_CONVB, I_DTB, I_ALOG, I_SSDD, I_SSDNORM,
       I_POOLW, I_POOLSC, I_PEK, I_PEV, I_W1K, I_W1V, I_W2K, I_W2V, I_WOUT, I_NMPOST, I_NFPRE, I_WGATE, I_WVAL, I_FCW, I_FCB, I_WDOWN, I_NFPOST, N_IN };

constexpr size_t al256(size_t x) { return (x + 255) & ~(size_t)255; }
constexpr size_t WS_CTL = 0, CTL_BYTES = 1u << 20;
constexpr size_t WS_WTIN = WS_CTL + CTL_BYTES;
constexpr size_t WS_WTOUT = WS_WTIN + (size_t)DEPTH * IN_WP * DM * 2;
constexpr size_t WS_WTUP = WS_WTOUT + (size_t)DEPTH * DM * DM * 2;
constexpr size_t WS_WTDN = WS_WTUP + (size_t)DEPTH * 2 * DFF * DM * 2;
constexpr size_t WS_ROPE = WS_WTDN + (size_t)DEPTH * DM * DFF * 2;
constexpr size_t WS_X = WS_ROPE + al256((size_t)2056 * 16 * 4);
constexpr size_t WS_XN = WS_X + (size_t)MROWS * DM * 4;
constexpr size_t WS_PROJ = WS_XN + (size_t)MROWS * DM * 2;
constexpr size_t WS_YSSD = WS_PROJ + (size_t)MROWS * IN_WP * 4;
constexpr size_t WS_Q = WS_YSSD + (size_t)MROWS * SSD_W * 4;
constexpr size_t WS_KWIN = WS_Q + (size_t)MROWS * 256 * 4;
constexpr size_t WS_CKP = WS_KWIN + (size_t)MROWS * 128 * 4;
constexpr size_t WS_CVP = WS_CKP + al256((size_t)BP * NCMP_P * 64 * 4);
constexpr size_t WS_CKS = WS_CVP + al256((size_t)BP * NCMP_P * 64 * 4);
constexpr size_t WS_CVS = WS_CKS + al256((size_t)DEPTH * BS * NCMP_S * 64 * 4);
constexpr size_t WS_MIX = WS_CVS + al256((size_t)DEPTH * BS * NCMP_S * 64 * 4);
constexpr size_t WS_MIXO = WS_MIX + (size_t)MROWS * DM * 2;
constexpr size_t WS_GV = WS_MIXO + (size_t)MROWS * DM * 4;
constexpr size_t WS_ACT = WS_GV + (size_t)MROWS * 2 * DFF * 4;
constexpr size_t WS_QB = WS_ACT + (size_t)MROWS * DFF * 2;
constexpr size_t WS_SAC = WS_QB + (size_t)MROWS * 256 * 2;
constexpr size_t WS_SCD = WS_SAC + (size_t)NP * 8 * 4;
constexpr size_t WS_SCB = WS_SCD + al256((size_t)BP * 16 * 8 * 4);
constexpr size_t WS_SCS = WS_SCB + (size_t)NP * 256 * 2;
constexpr size_t WS_SHS = WS_SCS + (size_t)BP * 16 * 8 * 8192 * 4;
constexpr size_t WS_WTC = WS_SHS + (size_t)BP * 16 * 8 * 8192 * 2;
constexpr size_t WS_CBIAS = WS_WTC + (size_t)8 * 256 * 1024 * 2;
constexpr size_t WS_AS = WS_GV;
constexpr size_t WS_HS = WS_AS + (size_t)8 * BS * 512 * 1024 * 2;
static_assert(WS_HS + (size_t)8 * BS * 512 * 256 * 4 <= WS_GV + (size_t)MROWS * 2 * DFF * 4, "prologue buffers must fit inside the GV region");
constexpr size_t WS_SLAB = WS_CBIAS + 8 * 128 * 4;
constexpr size_t WS_W2T = WS_SLAB + (size_t)8 * 256 * DM * 4;
constexpr size_t WS_FRAW = WS_W2T + (size_t)8 * 64 * 128 * 2;
constexpr int SPLIT_UP = 1;
constexpr size_t WS_FHALO = WS_FRAW + (size_t)SPLIT_UP * 256 * 2 * DFF * 4;
constexpr size_t WS_FLAST = WS_FHALO + (size_t)64 * 2 * 2 * DFF * 4;
constexpr size_t WS_END = WS_FLAST + (size_t)64 * 2 * DFF * 4;
constexpr int SPLIT_OUT = 4, SPLIT_DOWN = 8;

constexpr int RING_BYTES = 131072;
constexpr int MISC_OFF = RING_BYTES + 320;
constexpr int LDS_BYTES = 147456;
constexpr int NWAVES = 8, NTHR = 512;
constexpr int XB_OFF = RING_BYTES + 1024;
static_assert(XB_OFF + 4096 <= LDS_BYTES, "LDS map");

constexpr int PH_PER_LAYER = 10, N_PRO = 3, N_PHASES = N_PRO + DEPTH * PH_PER_LAYER;

struct Params { const float* in[N_IN]; float* out; unsigned char* ws; int ph_lo, ph_hi; };

__device__ __forceinline__ unsigned f2bf(float f) { unsigned u = __builtin_bit_cast(unsigned, f); return (u + 0x7fffu + ((u >> 16) & 1u)) >> 16; }
__device__ __forceinline__ unsigned pk2(float lo, float hi) { return f2bf(lo) | (f2bf(hi) << 16); }
__device__ __forceinline__ f32x4 bf4_to_f32(unsigned long long u) {
    return (f32x4){__uint_as_float((unsigned)u << 16), __uint_as_float((unsigned)u & 0xffff0000u), __uint_as_float((unsigned)(u >> 32) << 16), __uint_as_float((unsigned)(u >> 32) & 0xffff0000u)};
}
__device__ __forceinline__ float wave_sum(float v) {
#pragma unroll
    for (int o = 1; o < 64; o <<= 1) v += __shfl_xor(v, o);
    return v;
}
__device__ __forceinline__ float sum16(float v) {
#pragma unroll
    for (int o = 1; o < 16; o <<= 1) v += __shfl_xor(v, o);
    return v;
}
__device__ __forceinline__ float sigmoidf_(float x) { return 1.f / (1.f + expf(-x)); }
__device__ __forceinline__ float siluf_(float x) { return x / (1.f + expf(-x)); }
__device__ __forceinline__ float softplusf_(float x) { return x > 0.f ? x + log1pf(expf(-x)) : log1pf(expf(x)); }
__device__ __forceinline__ float gelu_tanh(float x) {
    const float u = 0.7978845608028654f * (x + 0.044715f * x * x * x);
    const float t = 1.f - 2.f / (expf(2.f * u) + 1.f);
    return 0.5f * x * (1.f + t);
}
__device__ __forceinline__ void cossin_d(float angf, float& c, float& s) {
    const double a = (double)angf;
    const double k = rint(a * 0.63661977236758134308);
    const double r = (a - k * 1.57079632679489655800) - k * 6.123233995736766036e-17;
    const double r2 = r * r;
    double sp = r * (1.0 + r2 * (-1.0 / 6 + r2 * (1.0 / 120 + r2 * (-1.0 / 5040 + r2 * (1.0 / 362880 + r2 * (-1.0 / 39916800 + r2 * (1.0 / 6227020800.0)))))));
    double cp = 1.0 + r2 * (-0.5 + r2 * (1.0 / 24 + r2 * (-1.0 / 720 + r2 * (1.0 / 40320 + r2 * (-1.0 / 3628800 + r2 * (1.0 / 479001600.0 + r2 * (-1.0 / 87178291200.0)))))));
    const int q = ((int)k) & 3;
    double cc = (q == 0) ? cp : (q == 1) ? -sp : (q == 2) ? -cp : sp;
    double ss = (q == 0) ? sp : (q == 1) ? cp : (q == 2) ? -sp : -cp;
    c = (float)cc; s = (float)ss;
}

struct Seq { int T, row0, pos0, b, samp; };
__device__ __forceinline__ Seq seq_of(int s) {
    Seq q;
    if (s < BP) { q.T = TP; q.row0 = s * TP; q.pos0 = 0; q.b = s; q.samp = 0; }
    else { q.T = TS; q.row0 = NP + (s - BP) * TS; q.pos0 = PAST; q.b = s - BP; q.samp = 1; }
    return q;
}
__device__ __forceinline__ void row_to_seq(int r, int& s, int& t) {
    if (r < NP) { s = r >> 11; t = r & (TP - 1); } else { const int q = r - NP; s = BP + (q >> 3); t = q & 7; }
}

#define XB_TMO      128
#define XB_XCNT(j)  (256  + 64 * (j))
#define XB_XSUB(j)  (1280 + 64 * (j))
#define XB_XGEN(j)  (2304 + 64 * (j))
#define XB_TOP      3328
#define XB_TOPGEN   3392
#define XCD_BAR_WORDS 3456
#define XB_SPIN_CAP (1u << 21)
__device__ __forceinline__ unsigned xb_ld(unsigned* p)              { return __hip_atomic_load(p, __ATOMIC_RELAXED, __HIP_MEMORY_SCOPE_AGENT); }
__device__ __forceinline__ unsigned xb_add(unsigned* p, unsigned v) { return __hip_atomic_fetch_add(p, v, __ATOMIC_RELAXED, __HIP_MEMORY_SCOPE_AGENT); }
__device__ __forceinline__ unsigned xb_xcc_id() { return (unsigned)__builtin_amdgcn_s_getreg((3 << 11) | 20) & 0xFu; }
#define XB_SPIN(cond, bar) do { unsigned _sp = 0; while (cond) { __builtin_amdgcn_s_sleep(1); \
    if ((++_sp & 255u) == 0u) { if (xb_ld(&(bar)[XB_TMO])) break; if (_sp > XB_SPIN_CAP) { atomicAdd(&(bar)[XB_TMO], 1u); break; } } } } while (0)
struct XcdBarrier { unsigned* bar; unsigned x; volatile LAS unsigned* st; };
__device__ __forceinline__ XcdBarrier xcd_barrier_post(unsigned* bar, volatile LAS unsigned* st) {
    XcdBarrier b; b.bar = bar; b.x = xb_xcc_id(); b.st = st;
    if (threadIdx.x == 0) (void)xb_add(&bar[XB_XCNT(b.x)], 1u);
    return b;
}
__device__ __forceinline__ void xcd_barrier_complete(unsigned* bar, unsigned x, unsigned& nloc, unsigned& nx) {
    const unsigned G = gridDim.x * gridDim.y * gridDim.z;
    unsigned sum, cnt, mine, sp = 0u;
    for (;;) {
        sum = 0u; cnt = 0u; mine = 0u;
#pragma unroll
        for (unsigned j = 0; j < 16; ++j) { const unsigned c = xb_ld(&bar[XB_XCNT(j)]); sum += c; cnt += (c > 0u) ? 1u : 0u; mine = (j == x) ? c : mine; }
        if (sum == G) break;
        __builtin_amdgcn_s_sleep(1);
        if ((++sp & 255u) == 0u) { if (xb_ld(&bar[XB_TMO])) break; if (sp > XB_SPIN_CAP) { atomicAdd(&bar[XB_TMO], 1u); break; } }
    }
    nloc = mine > 0u ? mine : 1u; nx = cnt > 0u ? cnt : 1u;
}
__device__ __forceinline__ void xcd_barrier(const XcdBarrier& b, const bool lead) {
    asm volatile("s_waitcnt vmcnt(0)" ::: "memory");
    __syncthreads();
    if (lead) {
        unsigned* bar = b.bar;
        __builtin_amdgcn_s_waitcnt(0);
        unsigned nloc = b.st[0], nx = b.st[1];
        if (nloc == 0u) { xcd_barrier_complete(bar, b.x, nloc, nx); b.st[0] = nloc; b.st[1] = nx; }
        const unsigned old = xb_add(&bar[XB_XSUB(b.x)], 1u);
        const unsigned gen = old / nloc;
        if (old + 1u == (gen + 1u) * nloc) {
            __builtin_amdgcn_fence(__ATOMIC_RELEASE, "agent");
            asm volatile("s_waitcnt vmcnt(0)" ::: "memory");
            const unsigned og = xb_add(&bar[XB_TOP], 1u);
            const unsigned tg = og / nx;
            if (og + 1u == (tg + 1u) * nx) xb_add(&bar[XB_TOPGEN], 1u);
            else XB_SPIN(xb_ld(&bar[XB_TOPGEN]) == tg, bar);
            __builtin_amdgcn_fence(__ATOMIC_ACQUIRE, "agent");
            xb_add(&bar[XB_XGEN(b.x)], 1u);
            asm volatile("s_waitcnt vmcnt(0)" ::: "memory");
        } else {
            XB_SPIN(xb_ld(&bar[XB_XGEN(b.x)]) == gen, bar);
            __builtin_amdgcn_fence(__ATOMIC_ACQUIRE, "agent");
            asm volatile("s_waitcnt vmcnt(0)" ::: "memory");
        }
    }
    __syncthreads();
}

struct Frame {
    LAS unsigned char* lds;
    int tid, lane, wave, gw, ngw, G;
    const __attribute__((address_space(4))) Params* p;
    unsigned char* ws;
    float* out;
};
#define INP(F, i) ((F).p->in[(i)])
#define WSP(F, T, off) ((T*)((F).ws + (off)))

__device__ __forceinline__ const float* x_in_row(const Frame& F, int r) {
    return r < NP ? INP(F, I_XP) + (size_t)r * DM : INP(F, I_XS) + (size_t)(r - NP) * DM;
}

template <bool ILV = false>
__device__ __forceinline__ void transpose_item(const float* W, int K, int N, int nblk, bf16* WT, int row_off, LAS float* scr, int item, int lane) {
    const int kb = item / nblk, nb = item % nblk, k0 = 64 * kb, n0 = 32 * nb;
    const int r0 = ILV ? 256 * (n0 >> 7) + (n0 & 127) : n0;
    const int n = n0 + (lane & 31);
    float tv[32];
#pragma unroll
    for (int i = 0; i < 32; ++i) { const int kk = 2 * i + (lane >> 5); tv[i] = (n < N) ? W[(size_t)(k0 + kk) * N + n] : 0.f; }
#pragma unroll
    for (int i = 0; i < 32; ++i) { const int kk = 2 * i + (lane >> 5); scr[kk * 33 + (lane & 31)] = tv[i]; }
    asm volatile("s_waitcnt lgkmcnt(0)" ::: "memory");
    const int c = lane & 7;
#pragma unroll
    for (int j = 0; j < 4; ++j) { const int nn = (lane >> 3) + 8 * j; const LAS float* s = scr + (8 * c) * 33 + nn;
        v4u o; o.x = pk2(s[0 * 33], s[1 * 33]); o.y = pk2(s[2 * 33], s[3 * 33]); o.z = pk2(s[4 * 33], s[5 * 33]); o.w = pk2(s[6 * 33], s[7 * 33]);
        *(v4u*)(WT + (size_t)(row_off + r0 + nn) * K + k0 + 8 * c) = o; }
    asm volatile("s_waitcnt lgkmcnt(0)" ::: "memory");
}
__device__ __forceinline__ void norm_row_to_bf16(const Frame& F, const float* xrow, const float* w, bf16* orow) {
    const f32x4* xr = (const f32x4*)xrow + F.lane; const f32x4* wr = (const f32x4*)w + F.lane;
    f32x4 v[4]; float ss = 0.f;
#pragma unroll
    for (int j = 0; j < 4; ++j) { v[j] = xr[64 * j]; ss += (v[j].x * v[j].x + v[j].y * v[j].y) + (v[j].z * v[j].z + v[j].w * v[j].w); }
    const float rs = 1.f / sqrtf(wave_sum(ss) * (1.f / DM) + RMS_EPS);
    unsigned long long* o8 = (unsigned long long*)orow + F.lane;
#pragma unroll
    for (int j = 0; j < 4; ++j) { const f32x4 g = wr[64 * j];
        o8[64 * j] = (unsigned long long)pk2(v[j].x * rs * g.x, v[j].y * rs * g.y) | ((unsigned long long)pk2(v[j].z * rs * g.z, v[j].w * rs * g.w) << 32); }
}
__device__ __forceinline__ void phase_prologue(const Frame& F) {
    LAS float* scr = (LAS float*)(F.lds + F.wave * 16384);
    constexpr int IT_IN = 16 * (IN_WP / 32), IT_OUT = 16 * 32, IT_UP = 16 * 128, IT_DN = 64 * 32, IT_L = IT_IN + IT_OUT + 2 * IT_UP + IT_DN;
    for (int it = F.gw; it < DEPTH * IT_L; it += F.ngw) {
        const int l = it / IT_L; int r = it % IT_L;
        if (r < IT_IN) { transpose_item(INP(F, I_WIN) + (size_t)l * DM * IN_W, DM, IN_W, IN_WP / 32, WSP(F, bf16, WS_WTIN) + (size_t)l * IN_WP * DM, 0, scr, r, F.lane); continue; } r -= IT_IN;
        if (r < IT_OUT) { transpose_item(INP(F, I_WOUT) + (size_t)l * DM * DM, DM, DM, 32, WSP(F, bf16, WS_WTOUT) + (size_t)l * DM * DM, 0, scr, r, F.lane); continue; } r -= IT_OUT;
        if (r < IT_UP) { transpose_item<true>(INP(F, I_WGATE) + (size_t)l * DM * DFF, DM, DFF, 128, WSP(F, bf16, WS_WTUP) + (size_t)l * 2 * DFF * DM, 0, scr, r, F.lane); continue; } r -= IT_UP;
        if (r < IT_UP) { transpose_item<true>(INP(F, I_WVAL) + (size_t)l * DM * DFF, DM, DFF, 128, WSP(F, bf16, WS_WTUP) + (size_t)l * 2 * DFF * DM, 128, scr, r, F.lane); continue; } r -= IT_UP;
        transpose_item(INP(F, I_WDOWN) + (size_t)l * DFF * DM, DFF, DM, 32, WSP(F, bf16, WS_WTDN) + (size_t)l * DM * DFF, 0, scr, r, F.lane);
    }
    for (int it = F.gw; it < 8 * 2 * 64; it += F.ngw) {
        const int i = it >> 7, half = (it >> 6) & 1, r = it & 63; const int lyr = i >> 1, kv = i & 1;
        const float* w1 = INP(F, kv ? I_W1V : I_W1K) + (size_t)lyr * 32 * 64 * 128 + (size_t)half * 1024 * 128;
        transpose_item(w1, 1024, 128, 4, WSP(F, bf16, WS_WTC) + (size_t)i * 256 * 1024, half * 128, scr, r, F.lane);
    }
    for (int idx = blockIdx.x * NTHR + F.tid; idx < 8 * 64 * 128; idx += F.G * NTHR) {
        const int i = idx >> 13, d = (idx >> 7) & 63, e = idx & 127;
        WSP(F, bf16, WS_W2T)[idx] = (bf16)f2bf((INP(F, (i & 1) ? I_W2V : I_W2K) + (size_t)(i >> 1) * 128 * 64)[e * 64 + d]);
    }
    for (int idx = blockIdx.x * NTHR + F.tid; idx < 8 * 128; idx += F.G * NTHR) {
        const int i = idx >> 7, e = idx & 127; const int lyr = i >> 1, kv = i & 1;
        const float* w1 = INP(F, kv ? I_W1V : I_W1K) + (size_t)lyr * 32 * 64 * 128; const float* pe = INP(F, kv ? I_PEV : I_PEK) + (size_t)lyr * 32 * 64;
        float a = 0.f; for (int k = 0; k < 2048; ++k) a += pe[k] * w1[(size_t)k * 128 + e];
        WSP(F, float, WS_CBIAS)[idx] = a;
    }
    for (int it2 = F.gw; it2 < DEPTH * BS * 256; it2 += F.ngw) {
        f32x4 a[2][2][4]; int lyrv[2], bv[2], cv[2];
#pragma unroll
        for (int u = 0; u < 2; ++u) {
            const int it = 2 * it2 + u; const int lyr = it >> 14, b = (it >> 9) & 31, c = it & 511; lyrv[u] = lyr; bv[u] = b; cv[u] = c;
            const int page = ((const int*)INP(F, I_PT))[b * NPAGES + (c >> 3)];
            const int row = F.lane >> 2, qd = F.lane & 3;
            const float* src = INP(F, I_CACHE) + ((((size_t)lyr * NPHYS + page) * PAGE + (c & 7) * 16 + row) * 4) * 64 + qd * 16;
#pragma unroll
            for (int kv = 0; kv < 2; ++kv)
#pragma unroll
                for (int k = 0; k < 4; ++k) a[u][kv][k] = *(const f32x4*)(src + kv * 64 + 4 * k);
        }
#pragma unroll
        for (int u = 0; u < 2; ++u) {
            const int row = F.lane >> 2, qd = F.lane & 3;
#pragma unroll
            for (int kv = 0; kv < 2; ++kv) {
                const f32x4 a0 = a[u][kv][0], a1 = a[u][kv][1], a2 = a[u][kv][2], a3 = a[u][kv][3];
                v4u o0, o1; o0.x = pk2(a0.x, a0.y); o0.y = pk2(a0.z, a0.w); o0.z = pk2(a1.x, a1.y); o0.w = pk2(a1.z, a1.w); o1.x = pk2(a2.x, a2.y); o1.y = pk2(a2.z, a2.w); o1.z = pk2(a3.x, a3.y); o1.w = pk2(a3.z, a3.w);
                bf16* dst = WSP(F, bf16, WS_AS) + ((((size_t)(lyrv[u] * 2 + kv) * BS + bv[u]) * 512 + cv[u]) * 1024) + row * 64 + qd * 16;
                *(v4u*)dst = o0; *(v4u*)(dst + 8) = o1;
            }
        }
    }
    {
        const float inv[8] = {1.0f, 0.193922758102417f, 0.03760603070259094f, 0.00729266507551074f, 0.001414213445968926f, 0.00027424818836152554f, 5.318296462064609e-05f, 1.0313385246263351e-05f};
        float* rope = WSP(F, float, WS_ROPE);
        for (int i = blockIdx.x * NTHR + F.tid; i < 2056 * 8; i += F.G * NTHR) {
            const int pi = i >> 3, f = i & 7; const int pos = pi < TP ? pi : PAST + (pi - TP);
            float iv = inv[0];
#pragma unroll
            for (int k = 1; k < 8; ++k) iv = (f == k) ? inv[k] : iv;
            const float ang = (float)pos * iv; float c, s; cossin_d(ang, c, s);
            rope[pi * 16 + f] = c; rope[pi * 16 + 8 + f] = s;
        }
    }
    for (int r = F.gw; r < MROWS; r += F.ngw) norm_row_to_bf16(F, x_in_row(F, r), INP(F, I_NMPRE), WSP(F, bf16, WS_XN) + (size_t)r * DM);
}

typedef float f32x16p __attribute__((ext_vector_type(16)));
__device__ __forceinline__ void phase_cmp_finish(const Frame& F) {
    const float* H = WSP(F, float, WS_HS);
    const int lane = F.lane, r32 = lane & 31, hp = lane >> 5;
    for (int it = F.gw; it < 8 * BS * 16; it += F.ngw) {
        const int i = it >> 9, b = (it >> 4) & 31, n0 = (it & 15) * 32; const int lyr = i >> 1, kv = i & 1;
        const int n = n0 + r32; const int n1 = (n + 1 < 512) ? n + 1 : 511;
        const float* h0 = H + (((size_t)i * BS + b) * 512 + n) * 256; const float* h1 = H + (((size_t)i * BS + b) * 512 + n1) * 256 + 128;
        const float* bias = WSP(F, float, WS_CBIAS) + i * 128;
        const bf16* w2t = WSP(F, bf16, WS_W2T) + (size_t)i * 64 * 128;
        f32x16p acc0, acc1;
#pragma unroll
        for (int k = 0; k < 16; ++k) { acc0[k] = 0.f; acc1[k] = 0.f; }
#pragma unroll
        for (int ks = 0; ks < 8; ++ks) {
            const int e = 16 * ks + 8 * hp;
            const f32x4 a0 = *(const f32x4*)(h0 + e), a1 = *(const f32x4*)(h0 + e + 4), c0 = *(const f32x4*)(h1 + e), c1 = *(const f32x4*)(h1 + e + 4);
            const f32x4 b0 = *(const f32x4*)(bias + e), b1 = *(const f32x4*)(bias + e + 4);
            const f32x4 x0 = a0 + c0 + b0, x1 = a1 + c1 + b1;
            v4u av; av.x = pk2(gelu_tanh(x0.x), gelu_tanh(x0.y)); av.y = pk2(gelu_tanh(x0.z), gelu_tanh(x0.w)); av.z = pk2(gelu_tanh(x1.x), gelu_tanh(x1.y)); av.w = pk2(gelu_tanh(x1.z), gelu_tanh(x1.w));
            const bf16x8 bf0 = *(const bf16x8*)(w2t + (size_t)r32 * 128 + e), bf1 = *(const bf16x8*)(w2t + (size_t)(32 + r32) * 128 + e);
            acc0 = __builtin_amdgcn_mfma_f32_32x32x16_bf16(__builtin_bit_cast(bf16x8, av), bf0, acc0, 0, 0, 0);
            acc1 = __builtin_amdgcn_mfma_f32_32x32x16_bf16(__builtin_bit_cast(bf16x8, av), bf1, acc1, 0, 0, 0);
        }
        float* dst = WSP(F, float, kv ? WS_CVS : WS_CKS) + (((size_t)lyr * BS + b) * NCMP_S) * 64;
#pragma unroll
        for (int k = 0; k < 16; ++k) { const int nn = n0 + (k & 3) + 8 * (k >> 2) + 4 * hp;
            if (nn < NCMP_S) { dst[(size_t)nn * 64 + r32] = acc0[k]; dst[(size_t)nn * 64 + 32 + r32] = acc1[k]; } }
    }
}

__device__ __forceinline__ float rope_lane(float x, int lane, float cs_c, float cs_s) {
    const float other = __shfl_xor(x, 8);
    const float rot = (lane < 8) ? x * cs_c - other * cs_s : x * cs_c + other * cs_s;
    return (lane < 16) ? rot : x;
}
__device__ __forceinline__ void token_prep4(const Frame& F, int l, int r0, const LAS float* pw_lds, LAS float* pl) {
    constexpr int NR = 4;
    int s, t0; row_to_seq(r0, s, t0); const Seq q = seq_of(s);
    const int lane = F.lane;
    const float* spool = INP(F, I_SPOOL) + ((size_t)l * BS + q.b) * POOL_KEEP * POOL_W;
    const float* proj0 = WSP(F, float, WS_PROJ) + (size_t)r0 * IN_WP;
    float qx[NR][4], kx[NR][6], csc[NR], css[NR];
#pragma unroll
    for (int u = 0; u < NR; ++u) {
        const float* proj = proj0 + (size_t)u * IN_WP; const int t = t0 + u;
        const float* rp = WSP(F, float, WS_ROPE) + (size_t)(q.samp ? TP + t : t) * 16;
#pragma unroll
        for (int j = 0; j < 4; ++j) qx[u][j] = proj[OFF_Q + j * 64 + lane];
#pragma unroll
        for (int j = 0; j < 6; ++j) kx[u][j] = proj[OFF_KV + j * 64 + lane];
        csc[u] = rp[lane & 7]; css[u] = rp[8 + (lane & 7)];
    }
    float e0[2 + 3], e1[4 + 3], e2[8 + 3], e3[16 + 3];
#define LOAD_EXT(EARR, G, W) do { _Pragma("unroll") for (int k = 0; k < (W) + 3; ++k) { const int tt = t0 - ((W) - 1) + k; const int c = (G) * 64 + lane; \
          \
        const float* pa = (tt >= 0) ? proj0 + (long)(tt - t0) * IN_WP + OFF_POOL + c : (q.samp ? spool + (POOL_KEEP + tt) * POOL_W + c : proj0 + OFF_POOL + c); \
        const float v = *pa; EARR[k] = (tt >= 0 || q.samp) ? v : 0.f; } } while (0)
    LOAD_EXT(e0, 0, 2); LOAD_EXT(e1, 1, 4); LOAD_EXT(e2, 2, 8); LOAD_EXT(e3, 3, 16);
#undef LOAD_EXT
    float pooled[NR][4], pu[NR][4];
#pragma unroll
    for (int u = 0; u < NR; ++u) {
        const int pos = q.pos0 + t0 + u;
        float s0 = 0.f, s1 = 0.f, s2 = 0.f, s3 = 0.f;
#pragma unroll
        for (int i = 0; i < 2; ++i) s0 += e0[u + i];
#pragma unroll
        for (int i = 0; i < 4; ++i) s1 += e1[u + i];
#pragma unroll
        for (int i = 0; i < 8; ++i) s2 += e2[u + i];
#pragma unroll
        for (int i = 0; i < 16; ++i) s3 += e3[u + i];
        pu[u][0] = e0[u + 1]; pu[u][1] = e1[u + 3]; pu[u][2] = e2[u + 7]; pu[u][3] = e3[u + 15];
        pooled[u][0] = s0 / (float)((pos + 1 < 2) ? pos + 1 : 2) - pu[u][0];
        pooled[u][1] = s1 / (float)((pos + 1 < 4) ? pos + 1 : 4) - pu[u][1];
        pooled[u][2] = s2 / (float)((pos + 1 < 8) ? pos + 1 : 8) - pu[u][2];
        pooled[u][3] = s3 / (float)((pos + 1 < 16) ? pos + 1 : 16) - pu[u][3];
    }
#pragma unroll
    for (int u = 0; u < NR; ++u) {
        const int r = r0 + u, t = t0 + u;
        bf16* qb = WSP(F, bf16, WS_QB) + (size_t)r * 256;
#pragma unroll
        for (int j = 0; j < 4; ++j) qb[j * 64 + lane] = (bf16)f2bf(rope_lane(qx[u][j], lane, csc[u], css[u]) * (0.125f * 1.4426950408889634f));
        float* kvout = q.samp ? F.out + O_KVS + ((size_t)l * NS + (r - NP)) * 256 : F.out + O_KVP + ((size_t)l * NP + r) * 256;
        float* kwin = WSP(F, float, WS_KWIN) + (size_t)r * 128;
#pragma unroll
        for (int j = 0; j < 6; ++j) {
            const float v = (j & 1) ? kx[u][j] : rope_lane(kx[u][j], lane, csc[u], css[u]);
            if (j < 4) kvout[j * 64 + lane] = v;
            else {
                kwin[(j - 4) * 64 + lane] = v;
                if (!q.samp) { if (t >= TP - 512) F.out[O_WINP + (((size_t)l * BP + q.b) * 512 + (t - (TP - 512))) * 128 + (j - 4) * 64 + lane] = v; }
                else F.out[O_WINS + (((size_t)l * BS + q.b) * 512 + 504 + t) * 128 + (j - 4) * 64 + lane] = v;
            }
        }
#pragma unroll
        for (int g = 0; g < 4; ++g) pl[u * 256 + g * 64 + lane] = pooled[u][g];
    }
    asm volatile("s_waitcnt lgkmcnt(0)" ::: "memory");
    const float* psc = INP(F, I_POOLSC) + (size_t)l * POOL_W;
#pragma unroll
    for (int g = 0; g < 4; ++g) {
        float y[NR];
#pragma unroll
        for (int u = 0; u < NR; ++u) y[u] = 0.f;
#pragma unroll 4
        for (int c = 0; c < 64; c += 4) { const LAS float* wv = pw_lds + (g * 64 + c) * 64 + lane;
            const float w0 = wv[0], w1 = wv[64], w2 = wv[128], w3 = wv[192];
#pragma unroll
            for (int u = 0; u < NR; ++u) { const f32x4 pa = *(const LAS f32x4*)(pl + u * 256 + g * 64 + c); y[u] += pa.x * w0 + pa.y * w1 + pa.z * w2 + pa.w * w3; } }
        const float sc = psc[g * 64 + lane];
#pragma unroll
        for (int u = 0; u < NR; ++u) (WSP(F, bf16, WS_MIX) + (size_t)(r0 + u) * DM)[512 + g * 64 + lane] = (bf16)f2bf(y[u] * sc);
    }
    asm volatile("s_waitcnt lgkmcnt(0)" ::: "memory");
#pragma unroll
    for (int u = 0; u < NR; ++u) {
        const int r = r0 + u, t = t0 + u; const float* proj = WSP(F, float, WS_PROJ) + (size_t)r * IN_WP;
        if (!q.samp) {
            if (t >= TP - 15) { float* o = F.out + O_POOLP + (((size_t)l * BP + q.b) * 15 + (t - (TP - 15))) * POOL_W;
#pragma unroll
                for (int j = 0; j < 4; ++j) o[j * 64 + lane] = pu[u][j]; }
            if (t >= TP - 3) { float* o = F.out + O_CONVP + (((size_t)l * BP + q.b) * 3 + (t - (TP - 3))) * CONV_DIM;
                for (int j = 0; j < 16; ++j) o[j * 64 + lane] = proj[OFF_XBC + j * 64 + lane]; }
        } else {
            { float* o = F.out + O_POOLS + (((size_t)l * BS + q.b) * 15 + 7 + t) * POOL_W;
#pragma unroll
                for (int j = 0; j < 4; ++j) o[j * 64 + lane] = pu[u][j]; }
            if (t < 7) { float* o = F.out + O_POOLS + (((size_t)l * BS + q.b) * 15 + t) * POOL_W;
#pragma unroll
                for (int j = 0; j < 4; ++j) o[j * 64 + lane] = spool[(8 + t) * POOL_W + j * 64 + lane]; }
            if (t >= TS - 3) { float* o = F.out + O_CONVS + (((size_t)l * BS + q.b) * 3 + (t - (TS - 3))) * CONV_DIM;
                for (int j = 0; j < 16; ++j) o[j * 64 + lane] = proj[OFF_XBC + j * 64 + lane]; }
        }
    }
}

__device__ __forceinline__ float xbc_conv(const Frame& F, int l, const Seq& q, int t, int c) {
    const float* cw = INP(F, I_CONVW) + (size_t)l * 4 * CONV_DIM; const float* cb = INP(F, I_CONVB) + (size_t)l * CONV_DIM;
    const float* proj = WSP(F, float, WS_PROJ);
    const float* sconv = INP(F, I_SCONV) + ((size_t)l * BS + q.b) * 3 * CONV_DIM;
    float acc = cb[c];
#pragma unroll
    for (int k = 0; k < 4; ++k) { const int tt = t - 3 + k; float e = 0.f;
        if (tt >= 0) e = proj[(size_t)(q.row0 + tt) * IN_WP + OFF_XBC + c];
        else if (q.samp) e = sconv[(3 + tt) * CONV_DIM + c];
        acc += e * cw[k * CONV_DIM + c]; }
    return siluf_(acc);
}
__device__ __forceinline__ void ssd_item(const Frame& F, int l, int s, int h) {
    const Seq q = seq_of(s);
    constexpr int TSTG = 16;
    LAS float* xs = (LAS float*)F.lds;
    LAS float* Bs = xs + TSTG * 64;
    LAS float* Cs = Bs + TSTG * 128;
    LAS float* dts = Cs + TSTG * 128;
    LAS float* dAs = dts + TSTG;
    const int tid = F.tid, p = tid >> 3, nq = tid & 7, g = h >> 2;
    const float a = -expf(INP(F, I_ALOG)[l * SSD_H + h]), dtb = INP(F, I_DTB)[l * SSD_H + h], dsk = INP(F, I_SSDD)[l * SSD_H + h];
    float st[16];
    if (q.samp) { const float* s0 = INP(F, I_SSM) + ((((size_t)l * BS + q.b) * SSD_H + h) * SSD_HD + p) * SSD_N + nq * 16;
#pragma unroll
        for (int i = 0; i < 16; ++i) st[i] = s0[i]; }
    else {
#pragma unroll
        for (int i = 0; i < 16; ++i) st[i] = 0.f; }
    const float* proj = WSP(F, float, WS_PROJ);
    float* yssd = WSP(F, float, WS_YSSD);
    for (int t0 = 0; t0 < q.T; t0 += TSTG) {
        const int nt = (q.T - t0 < TSTG) ? q.T - t0 : TSTG;
        __syncthreads();
        for (int i = tid; i < nt * 320; i += NTHR) { const int tt = i / 320, c = i % 320; const int t = t0 + tt;
            if (c < 64) xs[tt * 64 + c] = xbc_conv(F, l, q, t, h * 64 + c);
            else if (c < 192) Bs[tt * 128 + (c - 64)] = xbc_conv(F, l, q, t, 512 + g * 128 + (c - 64));
            else Cs[tt * 128 + (c - 192)] = xbc_conv(F, l, q, t, 768 + g * 128 + (c - 192)); }
        if (tid < nt) { const float dt = softplusf_(proj[(size_t)(q.row0 + t0 + tid) * IN_WP + OFF_DT + h] + dtb); dts[tid] = dt; dAs[tid] = expf(dt * a); }
        __syncthreads();
        for (int tt = 0; tt < nt; ++tt) {
            const float dt = dts[tt], dA = dAs[tt], x = xs[tt * 64 + p], xd = x * dt;
            float y = 0.f;
#pragma unroll
            for (int i = 0; i < 16; ++i) { st[i] = st[i] * dA + xd * Bs[tt * 128 + nq * 16 + i]; y += st[i] * Cs[tt * 128 + nq * 16 + i]; }
            y += __shfl_xor(y, 1); y += __shfl_xor(y, 2); y += __shfl_xor(y, 4);
            if (nq == 0) yssd[(size_t)(q.row0 + t0 + tt) * SSD_W + h * 64 + p] = y + dsk * x;
        }
    }
    float* so = q.samp ? F.out + O_SSMS + ((((size_t)l * BS + q.b) * SSD_H + h) * SSD_HD + p) * SSD_N + nq * 16
                       : F.out + O_SSMP + ((((size_t)l * BP + q.b) * SSD_H + h) * SSD_HD + p) * SSD_N + nq * 16;
#pragma unroll
    for (int i = 0; i < 16; ++i) so[i] = st[i];
    __syncthreads();
}
__device__ __forceinline__ void ssd_chunk_unit(const Frame& F, int l, int b, int c, int g);
__device__ __forceinline__ void ssd_scan(const Frame& F, int l);
__device__ __forceinline__ void ssd_out_unit(const Frame& F, int l, int b, int hc);
__device__ __forceinline__ void phase_prep(const Frame& F, int l) {
    for (int u = blockIdx.x; u < BP * 16 * 2; u += F.G) ssd_chunk_unit(F, l, u >> 5, (u >> 1) & 15, u & 1);
    {
        __syncthreads();
        LAS float* pw_lds = (LAS float*)F.lds; const float* pw = INP(F, I_POOLW) + (size_t)l * 4 * 64 * 64;
        for (int i = F.tid; i < 4 * 64 * 64 / 4; i += NTHR) *(LAS f32x4*)(pw_lds + i * 4) = *(const f32x4*)(pw + i * 4);
        __syncthreads();
        LAS float* pl = (LAS float*)(F.lds + 65536) + F.wave * 1024;
        for (int rp = F.gw; rp < MROWS / 4; rp += F.ngw) token_prep4(F, l, 4 * rp, pw_lds, pl);
        __syncthreads();
    }
}

__device__ __forceinline__ const float* kv_row(const Frame& F, int l, const Seq& q, int tok, int kind) {
    if (!q.samp) return F.out + O_KVP + ((size_t)l * NP + q.row0 + tok) * 256 + kind * 64;
    if (tok >= PAST) return F.out + O_KVS + ((size_t)l * NS + (q.row0 - NP) + (tok - PAST)) * 256 + kind * 64;
    const int page = ((const int*)INP(F, I_PT))[q.b * NPAGES + (tok >> 7)];
    return INP(F, I_CACHE) + ((((size_t)l * NPHYS + page) * PAGE + (tok & 127)) * 4 + kind) * 64;
}
typedef float f32x4c __attribute__((ext_vector_type(4)));
__device__ __forceinline__ void compress_item(const Frame& F, int l, int s, int grp, int kv) {
    const Seq q = seq_of(s);
    const int ncmp = NCMP_P;
    const int n0 = grp * 16; const int nb = (ncmp - n0 < 16) ? ncmp - n0 : 16;
    constexpr int CST = 2064;
    LAS unsigned char* rows = F.lds;
    LAS float* hid = (LAS float*)(F.lds + 36864);
    const int tid = F.tid, lane = F.lane, wave = F.wave;
    __syncthreads();
    for (int i = tid; i < 17 * 16 * 8; i += NTHR) { const int rr = i >> 3, dc = i & 7; const int tok = n0 * 16 + rr;
        v4u o = (v4u){0u, 0u, 0u, 0u};
        if (tok < TP) { const float* p = kv_row(F, l, q, tok, kv) + dc * 8; const f32x4 a = *(const f32x4*)p, b = *(const f32x4*)(p + 4);
            o.x = pk2(a.x, a.y); o.y = pk2(a.z, a.w); o.z = pk2(b.x, b.y); o.w = pk2(b.z, b.w); }
        *(LAS v4u*)(rows + (rr >> 4) * CST + (rr & 15) * 128 + dc * 16) = o; }
    __syncthreads();
    const int i2 = l * 2 + kv;
    const bf16* wt = WSP(F, bf16, WS_WTC) + (size_t)i2 * 256 * 1024;
    const int e = 16 * wave + (lane & 15), kq = lane >> 4, blk = lane & 15;
    f32x4c acc = (f32x4c){0.f, 0.f, 0.f, 0.f};
#pragma unroll 8
    for (int ks = 0; ks < 64; ++ks) {
        const int half = ks >> 5, kk = (ks & 31) * 32 + 8 * kq;
        const bf16x8 bfrag = *(const bf16x8*)(wt + (size_t)(half * 128 + e) * 1024 + kk);
        const bf16x8 afrag = *(const LAS bf16x8*)(rows + (blk + half) * CST + kk * 2);
        acc = __builtin_amdgcn_mfma_f32_16x16x32_bf16(afrag, bfrag, acc, 0, 0, 0);
    }
    { const float bias = WSP(F, float, WS_CBIAS)[i2 * 128 + e];
#pragma unroll
      for (int k = 0; k < 4; ++k) hid[(kq * 4 + k) * 128 + e] = gelu_tanh(acc[k] + bias); }
    __syncthreads();
    const float* w2 = INP(F, kv ? I_W2V : I_W2K) + (size_t)l * 128 * 64;
    float* dst = WSP(F, float, kv ? WS_CVP : WS_CKP) + (size_t)q.b * NCMP_P * 64;
    { const int bi = tid >> 5, d0 = (tid & 31) * 2;
        if (bi < nb) { float o0 = 0.f, o1 = 0.f;
#pragma unroll 8
            for (int k = 0; k < 128; ++k) { const float hv = hid[bi * 128 + k]; o0 += hv * w2[k * 64 + d0]; o1 += hv * w2[k * 64 + d0 + 1]; }
            dst[(size_t)(n0 + bi) * 64 + d0] = o0; dst[(size_t)(n0 + bi) * 64 + d0 + 1] = o1; } }
    __syncthreads();
}
__device__ __forceinline__ void attn_sample_unit(const Frame& F, int l, int b, int t0);
__device__ __forceinline__ void phase_compress(const Frame& F, int l) {
    constexpr int NI_P = BP * 8 * 2;
    for (int it = blockIdx.x; it < NI_P; it += F.G) compress_item(F, l, it >> 4, (it >> 1) & 7, it & 1);
    ssd_scan(F, l);
    { int bi = (int)blockIdx.x, nb = F.G; if (nb == 256) { bi -= 128; nb = 128; }
      if (bi >= 0) for (int it = BP * SSD_H + bi; it < NSEQ * SSD_H; it += nb) ssd_item(F, l, it >> 3, it & 7); }
    { Frame G2 = F; { int ln = G2.lane; asm volatile("" : "+v"(ln)); G2.lane = ln; G2.tid = G2.wave * 64 + ln; }
      for (int u = blockIdx.x; u < NS; u += F.G) attn_sample_unit(G2, l, u >> 3, u & 7); }
}

__device__ __forceinline__ void osm_step(float sc, const f32x4 v, float& m, float& lsum, f32x4& o) {
    const float mn = fmaxf(m, sc); const float al = expf(m - mn), pp = expf(sc - mn);
    lsum = lsum * al + pp; o = o * al + v * pp; m = mn;
}
__device__ __forceinline__ void nsa_token(const Frame& F, int l, int r) {
    int s, t; row_to_seq(r, s, t); const Seq q = seq_of(s);
    const int lane = F.lane, hh = lane >> 4, sub = lane & 15;
    const int tpos = q.pos0 + t;
    LAS float* sc = (LAS float*)(F.lds + F.wave * 12288);
    LAS float* impv = sc + 2048;
    LAS int* sel = (LAS int*)(impv + 192);
    const f32x4 qv = *(const f32x4*)(WSP(F, float, WS_Q) + (size_t)r * 256 + hh * 64 + sub * 4);
    const int ncmp = q.samp ? NCMP_S : NCMP_P;
    const float* ck = q.samp ? WSP(F, float, WS_CKS) + (size_t)q.b * NCMP_S * 64 : WSP(F, float, WS_CKP) + (size_t)q.b * NCMP_P * 64;
    const float* cv = q.samp ? WSP(F, float, WS_CVS) + (size_t)q.b * NCMP_S * 64 : WSP(F, float, WS_CVP) + (size_t)q.b * NCMP_P * 64;
    int nvis = 0; if (tpos >= 31) { nvis = (tpos - 31) / 16 + 1; if (nvis > ncmp) nvis = ncmp; }
    float mx = -INFINITY;
    for (int n = 0; n < nvis; ++n) { const f32x4 kk = *(const f32x4*)(ck + (size_t)n * 64 + sub * 4);
        const float d = sum16(qv.x * kk.x + qv.y * kk.y + qv.z * kk.z + qv.w * kk.w);
        if (sub == 0) sc[hh * 512 + n] = d; mx = fmaxf(mx, d); }
    asm volatile("s_waitcnt lgkmcnt(0)" ::: "memory");
    float ls = 0.f;
    for (int n = sub; n < nvis; n += 16) { const float e = expf(sc[hh * 512 + n] - mx); sc[hh * 512 + n] = e; ls += e; }
    ls = sum16(ls);
    const float rl = ls > 0.f ? 1.f / ls : 0.f;
    for (int n = sub; n < nvis; n += 16) sc[hh * 512 + n] *= rl;
    asm volatile("s_waitcnt lgkmcnt(0)" ::: "memory");
    f32x4 ocmp = (f32x4){0.f, 0.f, 0.f, 0.f};
    for (int n = 0; n < nvis; ++n) { const float pp = sc[hh * 512 + n]; ocmp += *(const f32x4*)(cv + (size_t)n * 64 + sub * 4) * pp; }
    const int nslc = q.samp ? 129 : 32, cur = tpos >> 6;
    for (int j = lane; j < nslc; j += 64) {
        float v;
        if (j > cur) v = -INFINITY;
        else if (j == 0 || j == cur || j == cur - 1) v = INFINITY;
        else { v = 0.f;
            for (int n = 4 * j - 1; n <= 4 * j + 3; ++n) if (n >= 0 && n < nvis) v += (sc[n] + sc[512 + n]) + (sc[1024 + n] + sc[1536 + n]); }
        impv[j] = v;
    }
    asm volatile("s_waitcnt lgkmcnt(0)" ::: "memory");
    int nsel = 0;
    for (int j0 = 0; j0 < nslc; j0 += 64) {
        const int j = j0 + lane; bool selj = false;
        if (j < nslc) { const float vj = impv[j]; int rank = 0;
            for (int k = 0; k < nslc; ++k) { const float vk = impv[k]; rank += (vk > vj || (vk == vj && k < j)) ? 1 : 0; }
            selj = (rank < 16) && (j <= cur); }
        const unsigned long long bal = __ballot(selj);
        if (selj) sel[nsel + __popcll(bal & ((1ull << lane) - 1ull))] = j;
        nsel += __popcll(bal);
    }
    asm volatile("s_waitcnt lgkmcnt(0)" ::: "memory");
    float m2 = -INFINITY, l2 = 0.f; f32x4 o2 = (f32x4){0.f, 0.f, 0.f, 0.f};
    for (int si = 0; si < nsel; ++si) {
        const int j = sel[si]; int ntok = tpos - 64 * j + 1; if (ntok > 64) ntok = 64;
        for (int i = 0; i < ntok; ++i) { const int tok = 64 * j + i;
            const float* kr = kv_row(F, l, q, tok, 2);
            const f32x4 kk = *(const f32x4*)(kr + sub * 4); const f32x4 vv = *(const f32x4*)(kr + 64 + sub * 4);
            const float d = sum16(qv.x * kk.x + qv.y * kk.y + qv.z * kk.z + qv.w * kk.w);
            osm_step(d, vv, m2, l2, o2); }
    }
    float m3 = -INFINITY, l3 = 0.f; f32x4 o3 = (f32x4){0.f, 0.f, 0.f, 0.f};
    {
        int k0 = tpos - 511; if (k0 < 0) k0 = 0;
        const float* swin = INP(F, I_SWIN) + ((size_t)l * BS + q.b) * 512 * 128;
        const float* kwin = WSP(F, float, WS_KWIN);
        for (int kp = k0; kp <= tpos; ++kp) {
            const float* kr;
            if (!q.samp) kr = kwin + (size_t)(q.row0 + kp) * 128;
            else if (kp >= PAST) kr = kwin + (size_t)(q.row0 + kp - PAST) * 128;
            else kr = swin + (size_t)(kp - (PAST - 512)) * 128;
            const f32x4 kk = *(const f32x4*)(kr + sub * 4); const f32x4 vv = *(const f32x4*)(kr + 64 + sub * 4);
            const float d = sum16(qv.x * kk.x + qv.y * kk.y + qv.z * kk.z + qv.w * kk.w);
            osm_step(d, vv, m3, l3, o3); }
    }
    const float* gp = WSP(F, float, WS_PROJ) + (size_t)r * IN_WP + OFF_G + hh * 3;
    const float g0 = sigmoidf_(gp[0]), g1 = sigmoidf_(gp[1]), g2 = sigmoidf_(gp[2]);
    const float r2 = l2 > 0.f ? 1.f / l2 : 0.f, r3 = l3 > 0.f ? 1.f / l3 : 0.f;
    const f32x4 y = ocmp * g0 + o2 * (g1 * r2) + o3 * (g2 * r3);
    unsigned long long* mo = (unsigned long long*)(WSP(F, bf16, WS_MIX) + (size_t)r * DM + 768 + hh * 64 + sub * 4);
    *mo = (unsigned long long)pk2(y.x, y.y) | ((unsigned long long)pk2(y.z, y.w) << 32);
}
__device__ __forceinline__ void ssd_finish_token(const Frame& F, int l, int r) {
    const float* y = WSP(F, float, WS_YSSD) + (size_t)r * SSD_W; const float* z = WSP(F, float, WS_PROJ) + (size_t)r * IN_WP;
    const float* nw = INP(F, I_SSDNORM) + (size_t)l * SSD_W;
    float v[8]; float ss = 0.f;
#pragma unroll
    for (int j = 0; j < 8; ++j) { const int c = j * 64 + F.lane; v[j] = y[c] * siluf_(z[c]); ss += v[j] * v[j]; }
    const float rs = 1.f / sqrtf(wave_sum(ss) * (1.f / SSD_W) + RMS_EPS);
    bf16* mix = WSP(F, bf16, WS_MIX) + (size_t)r * DM;
#pragma unroll
    for (int j = 0; j < 8; ++j) { const int c = j * 64 + F.lane; mix[c] = (bf16)f2bf(v[j] * rs * nw[c]); }
}
__device__ __forceinline__ void phase_attn(const Frame& F, int l) {
    for (int r = F.gw; r < MROWS; r += F.ngw) { nsa_token(F, l, r); ssd_finish_token(F, l, r); }
}


typedef short bf16x8 __attribute__((ext_vector_type(8)));
typedef float f32x16 __attribute__((ext_vector_type(16)));
typedef float f32x2_t __attribute__((ext_vector_type(2))); typedef __bf16 bf16x2_t __attribute__((ext_vector_type(2)));
__device__ __forceinline__ unsigned cvtpk(float lo, float hi) { f32x2_t v = {lo, hi}; bf16x2_t b = __builtin_convertvector(v, bf16x2_t); return __builtin_bit_cast(unsigned, b); }
__device__ __forceinline__ float half_sum(float v) { auto rr = __builtin_amdgcn_permlane32_swap(__float_as_uint(v), __float_as_uint(v), false, false); return __uint_as_float(rr[0]) + __uint_as_float(rr[1]); }
__device__ __forceinline__ float half_max(float v) { auto rr = __builtin_amdgcn_permlane32_swap(__float_as_uint(v), __float_as_uint(v), false, false); return fmaxf(__uint_as_float(rr[0]), __uint_as_float(rr[1])); }

constexpr float QSCALE_B = 0.125f * 1.4426950408889634f;
constexpr int AT_K = 0, AT_V = 16384, AT_IMPG = 32768, AT_IMPE = AT_IMPG + 8192, AT_SEL = AT_IMPE + 8192, AT_UNI = AT_SEL + 2048, AT_LIST = AT_UNI + 64, AT_NLIST = AT_LIST + 768,
              AT_PAGE = AT_NLIST + 64, AT_RANK = AT_PAGE + 768, AT_OUT = AT_RANK + 8 * 1024, AT_END = AT_OUT + 8 * 8192;
static_assert(AT_END <= RING_BYTES, "attention LDS map");
enum { KIND_CMP1 = 0, KIND_CMP2 = 1, KIND_SLC = 2, KIND_WIN = 3 };

struct TileRegs { f32x4 k0, k1, v0, v1; };
__device__ __forceinline__ void tile_load(const Frame& F, int l, const Seq& q, int kind, int tile, int pg, TileRegs& R) {
    int t_ = F.tid; asm volatile("" : "+v"(t_));
    const int key = tile * 64 + (t_ >> 3), dc = t_ & 7;
    const float* kr = nullptr; const float* vr = nullptr;
    if (kind <= KIND_CMP2) {
        const int ncmp = q.samp ? NCMP_S : NCMP_P;
        if (key < ncmp) {
            kr = (q.samp ? WSP(F, float, WS_CKS) + ((size_t)l * BS + q.b) * NCMP_S * 64 : WSP(F, float, WS_CKP) + (size_t)q.b * NCMP_P * 64) + (size_t)key * 64;
            vr = (q.samp ? WSP(F, float, WS_CVS) + ((size_t)l * BS + q.b) * NCMP_S * 64 : WSP(F, float, WS_CVP) + (size_t)q.b * NCMP_P * 64) + (size_t)key * 64; }
    } else if (kind == KIND_SLC) {
        if (key < q.pos0 + q.T) {
            if (!q.samp) kr = F.out + O_KVP + ((size_t)l * NP + q.row0 + key) * 256 + 2 * 64;
            else if (key < PAST) kr = INP(F, I_CACHE) + ((((size_t)l * NPHYS + pg) * PAGE + (key & 127)) * 4 + 2) * 64;
            else kr = F.out + O_KVS + ((size_t)l * NS + (q.row0 - NP) + (key - PAST)) * 256 + 2 * 64;
            vr = kr + 64; }
    } else {
        if (key < q.pos0 + q.T) {
            if (!q.samp) kr = WSP(F, float, WS_KWIN) + (size_t)(q.row0 + key) * 128;
            else if (key >= PAST) kr = WSP(F, float, WS_KWIN) + (size_t)(q.row0 + key - PAST) * 128;
            else if (key >= PAST - 512) kr = INP(F, I_SWIN) + (((size_t)l * BS + q.b) * 512 + (key - (PAST - 512))) * 128;
            if (kr) vr = kr + 64; }
    }
    const f32x4 z = (f32x4){0.f, 0.f, 0.f, 0.f};
    if (kr) { R.k0 = *(const f32x4*)(kr + dc * 8); R.k1 = *(const f32x4*)(kr + dc * 8 + 4); R.v0 = *(const f32x4*)(vr + dc * 8); R.v1 = *(const f32x4*)(vr + dc * 8 + 4); }
    else { R.k0 = z; R.k1 = z; R.v0 = z; R.v1 = z; }
}
__device__ __forceinline__ void tile_store(const Frame& F, LAS unsigned char* kb, LAS unsigned char* vb, const TileRegs& R) {
    int t_ = F.tid; asm volatile("" : "+v"(t_));
    const int key = t_ >> 3, dc = t_ & 7;
    v4u kk; kk.x = cvtpk(R.k0.x, R.k0.y); kk.y = cvtpk(R.k0.z, R.k0.w); kk.z = cvtpk(R.k1.x, R.k1.y); kk.w = cvtpk(R.k1.z, R.k1.w);
    *(LAS v4u*)(kb + key * 128 + ((dc ^ (key & 7)) << 4)) = kk;
    const float vv[8] = {R.v0.x, R.v0.y, R.v0.z, R.v0.w, R.v1.x, R.v1.y, R.v1.z, R.v1.w};
#pragma unroll
    for (int i = 0; i < 8; ++i) { const int d = dc * 8 + i; const int ch = (key >> 2) ^ ((d >> 1) & 15);
        *(LAS unsigned short*)(vb + d * 128 + ch * 8 + (key & 3) * 2) = (unsigned short)f2bf(vv[i]); }
}
__device__ __forceinline__ void qk_tile(const LAS unsigned char* kb, const bf16x8 (&qf)[4], f32x16& s0, f32x16& s1, int lane, float init = 0.f) {
    const int r = lane & 31, h = lane >> 5;
#pragma unroll
    for (int i = 0; i < 16; ++i) { s0[i] = init; s1[i] = init; }
#pragma unroll
    for (int ks = 0; ks < 4; ++ks) {
        const bf16x8 a0 = *(const LAS bf16x8*)(kb + r * 128 + (((2 * ks + h) ^ (r & 7)) << 4));
        const bf16x8 a1 = *(const LAS bf16x8*)(kb + (32 + r) * 128 + (((2 * ks + h) ^ (r & 7)) << 4));
        s0 = __builtin_amdgcn_mfma_f32_32x32x16_bf16(a0, qf[ks], s0, 0, 0, 0);
        s1 = __builtin_amdgcn_mfma_f32_32x32x16_bf16(a1, qf[ks], s1, 0, 0, 0);
    }
}
__device__ __forceinline__ void mask_tile(f32x16& s0, f32x16& s1, int kbase, int lo, int hi) {
#pragma unroll
    for (int i = 0; i < 16; ++i) { const int k = kbase + (i & 3) + 8 * (i >> 2);
        if (k < lo || k > hi) s0[i] = -INFINITY;
        if (k + 32 < lo || k + 32 > hi) s1[i] = -INFINITY; }
}
__device__ __forceinline__ float max3_(float x, float y, float z) { float r; asm("v_max3_f32 %0, %1, %2, %3" : "=v"(r) : "v"(x), "v"(y), "v"(z)); return r; }
__device__ __forceinline__ float tile_max(const f32x16& s0, const f32x16& s1) {
    float a = max3_(s0[0], s0[1], s0[2]), b = max3_(s1[0], s1[1], s1[2]);
#pragma unroll
    for (int i = 3; i < 15; i += 2) { a = max3_(a, s0[i], s0[i + 1]); b = max3_(b, s1[i], s1[i + 1]); }
    return half_max(max3_(a, b, fmaxf(s0[15], s1[15])));
}
__device__ __forceinline__ void pv_tile(const LAS unsigned char* vb, const f32x16& s0, const f32x16& s1, f32x16 (&O)[2], int lane) {
    const int r = lane & 31, h = lane >> 5;
    bf16x8 pf[2][2];
#pragma unroll
    for (int sp = 0; sp < 2; ++sp) {
        v4u a; a.x = cvtpk(s0[8 * sp + 0], s0[8 * sp + 1]); a.y = cvtpk(s0[8 * sp + 2], s0[8 * sp + 3]); a.z = cvtpk(s0[8 * sp + 4], s0[8 * sp + 5]); a.w = cvtpk(s0[8 * sp + 6], s0[8 * sp + 7]);
        v4u b; b.x = cvtpk(s1[8 * sp + 0], s1[8 * sp + 1]); b.y = cvtpk(s1[8 * sp + 2], s1[8 * sp + 3]); b.z = cvtpk(s1[8 * sp + 4], s1[8 * sp + 5]); b.w = cvtpk(s1[8 * sp + 6], s1[8 * sp + 7]);
        pf[0][sp] = __builtin_bit_cast(bf16x8, a); pf[1][sp] = __builtin_bit_cast(bf16x8, b);
    }
#pragma unroll
    for (int dh = 0; dh < 2; ++dh) {
        const int d = dh * 32 + r, sw = (d >> 1) & 15; const LAS unsigned char* rb = vb + d * 128;
#pragma unroll
        for (int kh = 0; kh < 2; ++kh)
#pragma unroll
            for (int sp = 0; sp < 2; ++sp) {
                const int q0 = kh * 8 + 4 * sp + h;
                const unsigned long long lo8 = *(const LAS unsigned long long*)(rb + ((q0 ^ sw) << 3));
                const unsigned long long hi8 = *(const LAS unsigned long long*)(rb + (((q0 + 2) ^ sw) << 3));
                v4u av; av.x = (unsigned)lo8; av.y = (unsigned)(lo8 >> 32); av.z = (unsigned)hi8; av.w = (unsigned)(hi8 >> 32);
                O[dh] = __builtin_amdgcn_mfma_f32_32x32x16_bf16(__builtin_bit_cast(bf16x8, av), pf[kh][sp], O[dh], 0, 0, 0);
            }
        __builtin_amdgcn_sched_barrier(0);
    }
}

__device__ __forceinline__ void attn_unit(const Frame& F, int l, int s, int t0, int ntok) {
    const Seq q = seq_of(s);
    int lane_ = F.lane; asm volatile("" : "+v"(lane_));
    int wave_ = F.wave; asm volatile("" : "+s"(wave_));
    const int lane = lane_, wave = wave_, tid = wave * 64 + lane, h = lane >> 5;
    LAS unsigned char* lds = F.lds;
    LAS float* impG = (LAS float*)(lds + AT_IMPG); LAS float* impE = (LAS float*)(lds + AT_IMPE);
    LAS unsigned* selw = (LAS unsigned*)(lds + AT_SEL);
    LAS unsigned* uni = (LAS unsigned*)(lds + AT_UNI);
    LAS int* list = (LAS int*)(lds + AT_LIST);
    LAS int* nlist = (LAS int*)(lds + AT_NLIST);
    LAS int* lpage = (LAS int*)(lds + AT_PAGE);
    LAS float* rankv = (LAS float*)(lds + AT_RANK + wave * 1024);
    const int nslc = q.samp ? 129 : 32, njs = q.samp ? 128 : 32;
    const int ncmp = q.samp ? NCMP_S : NCMP_P;
    const int tl = wave * 8 + ((lane & 31) >> 2), head = lane & 3;
    const bool vcol = tl < ntok; const bool wact = (wave * 8) < ntok;
    const int tlc = vcol ? tl : 0;
    const int r = q.row0 + t0 + tlc, tpos = q.pos0 + t0 + tlc;
    int nvis = 0; if (vcol && tpos >= 31) { nvis = (tpos - 31) / 16 + 1; if (nvis > ncmp) nvis = ncmp; }
    const int tpos_last = q.pos0 + t0 + ntok - 1;
    int nvis_max = 0; if (tpos_last >= 31) { nvis_max = (tpos_last - 31) / 16 + 1; if (nvis_max > ncmp) nvis_max = ncmp; }
    const int nct = (nvis_max + 63) >> 6;
    bf16x8 qf[4];
    { const bf16* qb = WSP(F, bf16, WS_QB) + ((size_t)r * 4 + head) * 64;
#pragma unroll
      for (int ks = 0; ks < 4; ++ks) qf[ks] = *(const bf16x8*)(qb + 16 * ks + 8 * h); }
    const float* gp = WSP(F, float, WS_PROJ) + (size_t)r * IN_WP + OFF_G + head * 3;
    const float g0 = sigmoidf_(gp[0]), g1 = sigmoidf_(gp[1]), g2 = sigmoidf_(gp[2]);
#define GATE(k) sigmoidf_((WSP(F, float, WS_PROJ) + (size_t)r * IN_WP + OFF_G + head * 3)[(k)])
    f32x16 O[2];
    LAS float* outl = (LAS float*)(lds + AT_OUT + wave * 8192) + lane;
#pragma unroll
    for (int i = 0; i < 16; ++i) { O[0][i] = 0.f; O[1][i] = 0.f; }
    float m = -1e30f, lsum = 0.f, rinv = 0.f;

    __syncthreads();
    if (tid < 2 * nct) list[tid] = (tid < nct ? KIND_CMP1 : KIND_CMP2) | ((tid < nct ? tid : tid - nct) << 4);
    for (int i = tid; i < 64 * 8; i += NTHR) selw[i] = 0u;
    __syncthreads();
    {
        const int n = 2 * nct; TileRegs R;
        if (n > 0) tile_load(F, l, q, KIND_CMP1, 0, 0, R);
        for (int i = 0; i < n; ++i) {
            LAS unsigned char* kb = lds + AT_K + (i & 1) * 8192; LAS unsigned char* vb = lds + AT_V + (i & 1) * 8192;
            tile_store(F, kb, vb, R);
            const int e = __builtin_amdgcn_readfirstlane(list[i]); const int kind = e & 15, tile = e >> 4;
            if (i + 1 < n) { const int e2 = __builtin_amdgcn_readfirstlane(list[i + 1]); tile_load(F, l, q, e2 & 15, e2 >> 4, 0, R); }
            __syncthreads();
            if (wact) {
                if (i == nct) { const float L = half_sum(lsum); rinv = L > 0.f ? 1.f / L : 0.f; }
                f32x16 s0, s1; qk_tile(kb, qf, s0, s1, lane);
                mask_tile(s0, s1, tile * 64 + 4 * h, 0, nvis - 1);
                if (kind == KIND_CMP1) {
                    const float mt = tile_max(s0, s1); const float mn = fmaxf(m, mt); const float al = __builtin_amdgcn_exp2f(m - mn);
                    float rs = 0.f;
#pragma unroll
                    for (int k = 0; k < 16; ++k) rs += __builtin_amdgcn_exp2f(s0[k] - mn) + __builtin_amdgcn_exp2f(s1[k] - mn);
                    lsum = lsum * al + rs; m = mn;
                } else {
#pragma unroll
                    for (int k = 0; k < 16; ++k) { s0[k] = __builtin_amdgcn_exp2f(s0[k] - m) * rinv; s1[k] = __builtin_amdgcn_exp2f(s1[k] - m) * rinv; }
                    pv_tile(vb, s0, s1, O, lane);
#pragma unroll
                    for (int kh = 0; kh < 2; ++kh)
#pragma unroll
                        for (int gq = 0; gq < 4; ++gq) {
                            const f32x16& sv = kh ? s1 : s0;
                            float G = (sv[4 * gq] + sv[4 * gq + 1]) + (sv[4 * gq + 2] + sv[4 * gq + 3]), E = sv[4 * gq + 3];
                            G += __shfl_xor(G, 1); G += __shfl_xor(G, 2); E += __shfl_xor(E, 1); E += __shfl_xor(E, 2);
                            const int j = 16 * tile + 8 * kh + 2 * gq + h;
                            if (head == 0 && vcol && j < njs) { impG[tl * njs + j] = G; impE[tl * njs + j] = E; }
                        }
                }
            }
        }
    }
    const float g0v = GATE(0);
#pragma unroll
    for (int i = 0; i < 16; ++i) { outl[i * 64] = O[0][i] * g0v; outl[(16 + i) * 64] = O[1][i] * g0v; O[0][i] = 0.f; O[1][i] = 0.f; }
    m = 0.f; lsum = 0.f;
    bool started = false;
    asm volatile("s_waitcnt lgkmcnt(0)" ::: "memory");
    if (wact) {
        const int ntw = (ntok - wave * 8 < 8) ? ntok - wave * 8 : 8;
        for (int tt = 0; tt < ntw; ++tt) {
            const int tk = wave * 8 + tt; const int tp = q.pos0 + t0 + tk; const int cur = tp >> 6;
            int nv = 0; if (tp >= 31) { nv = (tp - 31) / 16 + 1; if (nv > ncmp) nv = ncmp; }
            const int jcov = (nv + 3) >> 2;
            for (int j = lane; j < nslc; j += 64) {
                float v;
                if (j > cur) v = -INFINITY;
                else if (j == 0 || j == cur || j == cur - 1) v = INFINITY;
                else { v = 0.f; if (j < jcov) v += impG[tk * njs + j]; if (j - 1 < jcov) v += impE[tk * njs + j - 1]; }
                rankv[j] = v;
            }
            asm volatile("s_waitcnt lgkmcnt(0)" ::: "memory");
            for (int j0 = 0; j0 < nslc; j0 += 64) {
                const int j = j0 + lane; bool selj = false;
                if (j < nslc) { const float vj = rankv[j]; int rank = 0;
                    for (int k = 0; k < nslc; ++k) { const float vk = rankv[k]; rank += (vk > vj || (vk == vj && k < j)) ? 1 : 0; }
                    selj = (rank < 16) && (j <= cur); }
                const unsigned long long bal = __ballot(selj);
                if (lane == 0) { selw[tk * 8 + (j0 >> 5)] = (unsigned)bal; selw[tk * 8 + (j0 >> 5) + 1] = (unsigned)(bal >> 32); }
            }
            asm volatile("s_waitcnt lgkmcnt(0)" ::: "memory");
        }
    }
    __syncthreads();
    if (tid < 8) { unsigned u = 0u; for (int k = 0; k < ntok; ++k) u |= selw[k * 8 + tid]; uni[tid] = u; }
    __syncthreads();
    if (wave == 0) {
        int n = 0;
        for (int j0 = 0; j0 < nslc; j0 += 64) {
            const int j = j0 + lane; const bool sj = (j < nslc) && ((uni[j >> 5] >> (j & 31)) & 1u);
            int pg = 0; if (sj && q.samp && j * 64 < PAST) pg = ((const int*)INP(F, I_PT))[q.b * NPAGES + (j >> 1)];
            const unsigned long long bal = __ballot(sj);
            if (sj) { const int idx = n + __popcll(bal & ((1ull << lane) - 1ull)); list[idx] = KIND_SLC | (j << 4); lpage[idx] = pg; }
            n += __popcll(bal);
        }
        const int p0 = q.pos0 + t0; int w0 = (p0 - 511) >> 6; if (w0 < 0) w0 = 0; if (q.samp && w0 < (PAST - 512) / 64) w0 = (PAST - 512) / 64;
        const int w1 = (p0 + ntok - 1) >> 6;
        if (lane <= w1 - w0) { list[n + lane] = KIND_WIN | ((w0 + lane) << 4); lpage[n + lane] = 0; }
        if (lane == 0) nlist[0] = n + (w1 - w0 + 1);
    }
    __syncthreads();
    {
        const int n = nlist[0]; TileRegs R0, R1; int pkind = KIND_SLC;
        { const int e0 = __builtin_amdgcn_readfirstlane(list[0]); tile_load(F, l, q, e0 & 15, e0 >> 4, __builtin_amdgcn_readfirstlane(lpage[0]), R0); }
        if (n > 1) { const int e1 = __builtin_amdgcn_readfirstlane(list[1]); tile_load(F, l, q, e1 & 15, e1 >> 4, __builtin_amdgcn_readfirstlane(lpage[1]), R1); }
#define ATTN_STEP(RR, BI, II) do { \
            LAS unsigned char* kb = lds + AT_K + (BI) * 8192; LAS unsigned char* vb = lds + AT_V + (BI) * 8192; \
            tile_store(F, kb, vb, RR); \
            const int e = __builtin_amdgcn_readfirstlane(list[(II)]); const int kind = e & 15, tile = e >> 4; \
            if ((II) + 2 < n) { const int e2 = __builtin_amdgcn_readfirstlane(list[(II) + 2]); tile_load(F, l, q, e2 & 15, e2 >> 4, __builtin_amdgcn_readfirstlane(lpage[(II) + 2]), RR); } \
            __syncthreads(); \
            if (wact) { \
                if (kind != pkind) { \
                    const float L = half_sum(lsum); const float sc = L > 0.f ? GATE(1) / L : 0.f; \
                    _Pragma("unroll") for (int k = 0; k < 16; ++k) { outl[k * 64] += O[0][k] * sc; outl[(16 + k) * 64] += O[1][k] * sc; O[0][k] = 0.f; O[1][k] = 0.f; } \
                    m = 0.f; lsum = 0.f; started = false; pkind = kind; \
                } \
                int lo, hi; \
                if (kind == KIND_SLC) { const bool sb = (selw[tlc * 8 + (tile >> 5)] >> (tile & 31)) & 1u; lo = 0; hi = (sb && vcol) ? tpos : -1; } \
                else { lo = tpos - 511; hi = vcol ? tpos : -1; } \
                const bool any = (hi >= tile * 64) && (lo <= tile * 64 + 63); \
                if (__ballot(any) != 0ull) { \
                      \
                      \
                    const bool part = any && !((lo <= tile * 64) && (hi >= tile * 64 + 63)); \
                      \
                      \
                    f32x16 s0, s1; qk_tile(kb, qf, s0, s1, lane, any ? -m : -INFINITY); \
                    if (__ballot(part) != 0ull) mask_tile(s0, s1, tile * 64 + 4 * h, lo, hi); \
                    const float mt = tile_max(s0, s1); \
                    const bool seen = mt > -INFINITY; const bool need = (mt > 8.f) || (seen && !started); started = started || seen; \
                    if (__ballot(need) != 0ull) { \
                        const float dl = need ? mt : 0.f; const float al = __builtin_amdgcn_exp2f(-dl); m += dl; lsum *= al; \
                        _Pragma("unroll") for (int k = 0; k < 16; ++k) { s0[k] -= dl; s1[k] -= dl; O[0][k] *= al; O[1][k] *= al; } } \
                    float rs = 0.f; \
                    _Pragma("unroll") for (int k = 0; k < 16; ++k) { s0[k] = __builtin_amdgcn_exp2f(s0[k]); s1[k] = __builtin_amdgcn_exp2f(s1[k]); rs += s0[k] + s1[k]; } \
                    lsum += rs; \
                    pv_tile(vb, s0, s1, O, lane); \
                } \
            } } while (0)
        for (int i = 0; i < n; i += 2) {
            ATTN_STEP(R0, 0, i);
            if (i + 1 < n) ATTN_STEP(R1, 1, i + 1);
        }
#undef ATTN_STEP
        if (wact) {
            const float L = half_sum(lsum); const float sc = L > 0.f ? (pkind == KIND_SLC ? GATE(1) : GATE(2)) / L : 0.f;
#pragma unroll
            for (int k = 0; k < 16; ++k) { O[0][k] = outl[k * 64] + O[0][k] * sc; O[1][k] = outl[(16 + k) * 64] + O[1][k] * sc; }
        }
    }
    if (vcol) {
        bf16* mo = WSP(F, bf16, WS_MIX) + (size_t)r * DM + 768 + head * 64;
#pragma unroll
        for (int dh = 0; dh < 2; ++dh)
#pragma unroll
            for (int gq = 0; gq < 4; ++gq) {
                const int d = dh * 32 + 8 * gq + 4 * h;
                *(unsigned long long*)(mo + d) = (unsigned long long)cvtpk(O[dh][4 * gq], O[dh][4 * gq + 1]) | ((unsigned long long)cvtpk(O[dh][4 * gq + 2], O[dh][4 * gq + 3]) << 32);
            }
    }
}

#undef GATE
constexpr int SW_T = 0, SW_ML = 65536, SW_IMPG = SW_ML + 4096, SW_IMPE = SW_IMPG + 4096, SW_SEL = SW_IMPE + 4096, SW_UNI = SW_SEL + 256, SW_LIST = SW_UNI + 64,
              SW_PAGE = SW_LIST + 1280, SW_NL = SW_PAGE + 1280, SW_RANK = SW_NL + 64, SW_OUT = SW_RANK + 8 * 1024, SW_END = SW_OUT + 8192;
static_assert(SW_END <= RING_BYTES, "sample attention LDS map");
struct HRegs { f32x4 v[8]; };
__device__ __forceinline__ void h_load(const Frame& F, int l, int b, int kind, int ht, int pg, int which, int lane_in, HRegs& R) {
    int lane = lane_in; asm volatile("" : "+v"(lane));
    const int key = ht * 32 + (lane >> 1), hv = lane & 1;
    const float* base; size_t off; bool ok;
    if (kind <= KIND_CMP2) { ok = key < NCMP_S; const int kc = ok ? key : 0;
        base = WSP(F, float, which ? WS_CVS : WS_CKS); off = (((size_t)l * BS + b) * NCMP_S + kc) * 64; }
    else if (kind == KIND_SLC) { ok = key < PAST + TS;
        if (key < PAST) { base = INP(F, I_CACHE); off = ((((size_t)l * NPHYS + pg) * PAGE + (key & 127)) * 4 + 2 + which) * 64; }
        else { const int kk = ok ? key - PAST : 0; base = F.out + O_KVS; off = ((size_t)l * NS + b * TS + kk) * 256 + (2 + which) * 64; } }
    else { ok = (key >= PAST - 512) && (key < PAST + TS);
        if (key < PAST) { const int kk = ok ? key - (PAST - 512) : 0; base = INP(F, I_SWIN); off = (((size_t)l * BS + b) * 512 + kk) * 128 + which * 64; }
        else { const int kk = ok ? key - PAST : 0; base = WSP(F, float, WS_KWIN); off = ((size_t)NP + b * TS + kk) * 128 + which * 64; } }
    const float* p = base + off + hv * 32;
#pragma unroll
    for (int i = 0; i < 8; ++i) { const f32x4 x = *(const f32x4*)(p + 4 * i); R.v[i] = ok ? x : (f32x4){0.f, 0.f, 0.f, 0.f}; }
}
__device__ __forceinline__ void h_store_k(LAS unsigned char* kb, const HRegs& R, int lane_in) {
    int lane = lane_in; asm volatile("" : "+v"(lane));
    const int key = lane >> 1, hv = lane & 1;
#pragma unroll
    for (int i = 0; i < 4; ++i) { v4u o; o.x = cvtpk(R.v[2 * i].x, R.v[2 * i].y); o.y = cvtpk(R.v[2 * i].z, R.v[2 * i].w); o.z = cvtpk(R.v[2 * i + 1].x, R.v[2 * i + 1].y); o.w = cvtpk(R.v[2 * i + 1].z, R.v[2 * i + 1].w);
        *(LAS v4u*)(kb + key * 128 + (((4 * hv + i) ^ (key & 7)) << 4)) = o; }
}
__device__ __forceinline__ void h_store_v(LAS unsigned char* vb, const HRegs& R, int lane_in) {
    int lane = lane_in; asm volatile("" : "+v"(lane));
    const int key = lane >> 1, hv = lane & 1;
#pragma unroll
    for (int i = 0; i < 8; ++i) {
        const float xs[4] = {R.v[i].x, R.v[i].y, R.v[i].z, R.v[i].w};
#pragma unroll
        for (int k = 0; k < 4; ++k) { const int d = 32 * hv + 4 * i + k;
            *(LAS unsigned short*)(vb + d * 64 + (((key >> 2) ^ ((d >> 2) & 7)) << 3) + (key & 3) * 2) = (unsigned short)f2bf(xs[k]); }
    }
}
__device__ __forceinline__ void qk_half(const LAS unsigned char* kb, const bf16x8 (&qf)[4], f32x16& s0, int lane_in) {
    int lane = lane_in; asm volatile("" : "+v"(lane));
    const int r = lane & 31, h = lane >> 5;
#pragma unroll
    for (int i = 0; i < 16; ++i) s0[i] = 0.f;
#pragma unroll
    for (int ks = 0; ks < 4; ++ks) { const bf16x8 a0 = *(const LAS bf16x8*)(kb + r * 128 + (((2 * ks + h) ^ (r & 7)) << 4));
        s0 = __builtin_amdgcn_mfma_f32_32x32x16_bf16(a0, qf[ks], s0, 0, 0, 0); }
}
__device__ __forceinline__ void pv_half(const LAS unsigned char* vb, const f32x16& s0, f32x16 (&O)[2], int lane_in) {
    int lane = lane_in; asm volatile("" : "+v"(lane));
    const int r = lane & 31, h = lane >> 5;
    bf16x8 pf[2];
#pragma unroll
    for (int sp = 0; sp < 2; ++sp) { v4u a; a.x = cvtpk(s0[8 * sp + 0], s0[8 * sp + 1]); a.y = cvtpk(s0[8 * sp + 2], s0[8 * sp + 3]); a.z = cvtpk(s0[8 * sp + 4], s0[8 * sp + 5]); a.w = cvtpk(s0[8 * sp + 6], s0[8 * sp + 7]);
        pf[sp] = __builtin_bit_cast(bf16x8, a); }
#pragma unroll
    for (int dh = 0; dh < 2; ++dh) { const int d = dh * 32 + r, sw = (d >> 2) & 7; const LAS unsigned char* rb = vb + d * 64;
#pragma unroll
        for (int sp = 0; sp < 2; ++sp) { const int q0 = 4 * sp + h;
            const unsigned long long lo8 = *(const LAS unsigned long long*)(rb + ((q0 ^ sw) << 3)), hi8 = *(const LAS unsigned long long*)(rb + (((q0 + 2) ^ sw) << 3));
            v4u av; av.x = (unsigned)lo8; av.y = (unsigned)(lo8 >> 32); av.z = (unsigned)hi8; av.w = (unsigned)(hi8 >> 32);
            O[dh] = __builtin_amdgcn_mfma_f32_32x32x16_bf16(__builtin_bit_cast(bf16x8, av), pf[sp], O[dh], 0, 0, 0); } }
}
__device__ __forceinline__ void mask_half(f32x16& s0, int kbase, int lo, int hi) {
#pragma unroll
    for (int i = 0; i < 16; ++i) { const int k = kbase + (i & 3) + 8 * (i >> 2); if (k < lo || k > hi) s0[i] = -INFINITY; }
}
__device__ __forceinline__ float max16(const f32x16& s0) {
    float a = s0[0];
#pragma unroll
    for (int i = 1; i < 16; ++i) a = fmaxf(a, s0[i]);
    return half_max(a);
}
__device__ __forceinline__ void merge_branch(LAS unsigned char* lds, int wave, int lane, float m, float lsum, f32x16 (&O)[2], float gate) {
    LAS float* ml = (LAS float*)(lds + SW_ML); LAS float* outl = (LAS float*)(lds + SW_OUT) + lane;
    LAS float* slot = (LAS float*)(lds + SW_T + wave * 8192) + lane;
    const float lw = half_sum(lsum);
    ml[wave * 64 + lane] = m; ml[512 + wave * 64 + lane] = lw;
#pragma unroll
    for (int i = 0; i < 16; ++i) { slot[i * 64] = O[0][i]; slot[(16 + i) * 64] = O[1][i]; O[0][i] = 0.f; O[1][i] = 0.f; }
    __syncthreads();
    float M = -1e30f;
#pragma unroll
    for (int w = 0; w < 8; ++w) M = fmaxf(M, ml[w * 64 + lane]);
    float L = 0.f, sc[8];
#pragma unroll
    for (int w = 0; w < 8; ++w) { sc[w] = __builtin_amdgcn_exp2f(ml[w * 64 + lane] - M); L += ml[512 + w * 64 + lane] * sc[w]; }
    const float gl = (L > 0.f) ? gate / L : 0.f;
#pragma unroll
    for (int k = 0; k < 4; ++k) { const int i = wave * 4 + k; float a = 0.f;
#pragma unroll
        for (int w = 0; w < 8; ++w) a += ((LAS float*)(lds + SW_T + w * 8192))[i * 64 + lane] * sc[w];
        outl[i * 64] += a * gl; }
    __syncthreads();
}

__device__ __forceinline__ void attn_sample_unit(const Frame& F, int l, int b, int t0) {
    int lane_ = F.lane; asm volatile("" : "+v"(lane_));
    const int lane = lane_, wave = F.wave, tid = wave * 64 + lane, h = lane >> 5;
    LAS unsigned char* lds = F.lds;
    LAS unsigned char* kb = lds + SW_T + wave * 8192; LAS unsigned char* vb = kb + 4096;
    LAS float* impG = (LAS float*)(lds + SW_IMPG); LAS float* impE = (LAS float*)(lds + SW_IMPE);
    LAS unsigned* selw = (LAS unsigned*)(lds + SW_SEL); LAS unsigned* uni = (LAS unsigned*)(lds + SW_UNI);
    LAS int* list = (LAS int*)(lds + SW_LIST); LAS int* lpage = (LAS int*)(lds + SW_PAGE); LAS int* nlist = (LAS int*)(lds + SW_NL);
    LAS float* rankv = (LAS float*)(lds + SW_RANK + wave * 1024);
    LAS float* outl = (LAS float*)(lds + SW_OUT);
    const int tl = 0, head = lane & 3; const bool wcol = ((lane & 31) >> 2) == 0;
    const int r = NP + b * TS + t0, tpos = PAST + t0;
    bf16x8 qf[4];
    { const bf16* qb = WSP(F, bf16, WS_QB) + ((size_t)r * 4 + head) * 64;
#pragma unroll
      for (int ks = 0; ks < 4; ++ks) qf[ks] = *(const bf16x8*)(qb + 16 * ks + 8 * h); }
    const float* gp = WSP(F, float, WS_PROJ) + (size_t)r * IN_WP + OFF_G + head * 3;
    const float g0 = sigmoidf_(gp[0]), g1 = sigmoidf_(gp[1]), g2 = sigmoidf_(gp[2]);
    f32x16 O[2];
#pragma unroll
    for (int i = 0; i < 16; ++i) { O[0][i] = 0.f; O[1][i] = 0.f; }
    __syncthreads();
    if (tid < 64) selw[tid] = 0u;
    f32x16 sa, sb; float m = -1e30f, lsum = 0.f;
    {
        HRegs Ra, Rb; h_load(F, l, b, KIND_CMP1, wave, 0, 0, lane, Ra); h_load(F, l, b, KIND_CMP1, wave + 8, 0, 0, lane, Rb);
        h_store_k(kb, Ra, lane); asm volatile("s_waitcnt lgkmcnt(0)" ::: "memory");
        qk_half(kb, qf, sa, lane); mask_half(sa, wave * 32 + 4 * h, 0, NCMP_S - 1);
        asm volatile("s_waitcnt lgkmcnt(0)" ::: "memory");
        h_store_k(kb, Rb, lane); asm volatile("s_waitcnt lgkmcnt(0)" ::: "memory");
        qk_half(kb, qf, sb, lane); mask_half(sb, (wave + 8) * 32 + 4 * h, 0, NCMP_S - 1);
        m = fmaxf(max16(sa), max16(sb));
#pragma unroll
        for (int k = 0; k < 16; ++k) lsum += __builtin_amdgcn_exp2f(sa[k] - m) + __builtin_amdgcn_exp2f(sb[k] - m);
    }
    {
        LAS float* ml = (LAS float*)(lds + SW_ML);
        const float lw = half_sum(lsum);
        ml[wave * 64 + lane] = m; ml[512 + wave * 64 + lane] = lw;
        HRegs Ra, Rb; h_load(F, l, b, KIND_CMP2, wave, 0, 1, lane, Ra); h_load(F, l, b, KIND_CMP2, wave + 8, 0, 1, lane, Rb);
        __syncthreads();
        float M = -1e30f;
#pragma unroll
        for (int w = 0; w < 8; ++w) M = fmaxf(M, ml[w * 64 + lane]);
        float L = 0.f;
#pragma unroll
        for (int w = 0; w < 8; ++w) L += ml[512 + w * 64 + lane] * __builtin_amdgcn_exp2f(ml[w * 64 + lane] - M);
        const float rinv = L > 0.f ? 1.f / L : 0.f;
#pragma unroll
        for (int pass = 0; pass < 2; ++pass) {
            f32x16& sv = pass ? sb : sa; const int ht = pass ? wave + 8 : wave;
#pragma unroll
            for (int k = 0; k < 16; ++k) sv[k] = __builtin_amdgcn_exp2f(sv[k] - M) * rinv;
            if (pass) h_store_v(vb, Rb, lane); else h_store_v(vb, Ra, lane);
            asm volatile("s_waitcnt lgkmcnt(0)" ::: "memory");
            pv_half(vb, sv, O, lane);
            asm volatile("s_waitcnt lgkmcnt(0)" ::: "memory");
#pragma unroll
            for (int gq = 0; gq < 4; ++gq) {
                float G = (sv[4 * gq] + sv[4 * gq + 1]) + (sv[4 * gq + 2] + sv[4 * gq + 3]), E = sv[4 * gq + 3];
                G += __shfl_xor(G, 1); G += __shfl_xor(G, 2); E += __shfl_xor(E, 1); E += __shfl_xor(E, 2);
                const int j = 8 * ht + 2 * gq + h;
                if (head == 0) { impG[tl * 128 + j] = G; impE[tl * 128 + j] = E; }
            }
        }
        { LAS float* slot = (LAS float*)(lds + SW_T + wave * 8192) + lane;
#pragma unroll
          for (int i = 0; i < 16; ++i) { slot[i * 64] = O[0][i]; slot[(16 + i) * 64] = O[1][i]; O[0][i] = 0.f; O[1][i] = 0.f; } }
    }
    __syncthreads();
#pragma unroll
    for (int k = 0; k < 4; ++k) { const int i = wave * 4 + k; float a = 0.f;
#pragma unroll
        for (int w = 0; w < 8; ++w) a += ((LAS float*)(lds + SW_T + w * 8192))[i * 64 + lane];
        outl[i * 64 + lane] = a * g0; }
    __syncthreads();
    if (wave == 0) {
        const int tk = 0, cur = tpos >> 6;
        for (int j = lane; j < 132; j += 64) {
            float v;
            if (j > cur) v = -INFINITY;
            else if (j == 0 || j == cur || j == cur - 1) v = INFINITY;
            else v = impG[tk * 128 + j] + impE[tk * 128 + j - 1];
            rankv[j] = v;
        }
        asm volatile("s_waitcnt lgkmcnt(0)" ::: "memory");
        const float v0 = rankv[lane], v1 = rankv[64 + lane], v2 = (lane < 1) ? rankv[128 + lane] : -INFINITY;
        int r0 = 0, r1 = 0, r2 = 0;
        for (int k4 = 0; k4 < 132; k4 += 4) {
            const f32x4 vk = *(const LAS f32x4*)(rankv + k4);
#pragma unroll
            for (int u = 0; u < 4; ++u) { const float x = vk[u]; const int k = k4 + u;
                r0 += (x > v0 || (x == v0 && k < lane)) ? 1 : 0; r1 += (x > v1 || (x == v1 && k < 64 + lane)) ? 1 : 0; r2 += (x > v2 || (x == v2 && k < 128 + lane)) ? 1 : 0; }
        }
        const unsigned long long b0 = __ballot(r0 < 16 && lane <= cur), b1 = __ballot(r1 < 16 && 64 + lane <= cur), b2 = __ballot(lane < 1 && r2 < 16 && 128 + lane <= cur);
        if (lane == 0) { selw[tk * 8 + 0] = (unsigned)b0; selw[tk * 8 + 1] = (unsigned)(b0 >> 32); selw[tk * 8 + 2] = (unsigned)b1; selw[tk * 8 + 3] = (unsigned)(b1 >> 32); selw[tk * 8 + 4] = (unsigned)b2; }
    }
    __syncthreads();
    if (tid < 8) uni[tid] = selw[tid];
    __syncthreads();
    if (wave == 0) {
        int n = 0;
        for (int j0 = 0; j0 < 129; j0 += 64) {
            const int j = j0 + lane; const bool sj = (j < 129) && ((uni[j >> 5] >> (j & 31)) & 1u);
            int pg = 0; if (sj && j * 64 < PAST) pg = ((const int*)INP(F, I_PT))[b * NPAGES + (j >> 1)];
            const unsigned long long bal = __ballot(sj);
            if (sj) { const int idx = n + 2 * __popcll(bal & ((1ull << lane) - 1ull)); list[idx] = KIND_SLC | ((2 * j) << 4); list[idx + 1] = KIND_SLC | ((2 * j + 1) << 4); lpage[idx] = pg; lpage[idx + 1] = pg; }
            n += 2 * __popcll(bal);
        }
        if (lane == 0) nlist[0] = n;
        const int w0 = (PAST - 512) / 32, w1 = (PAST + TS - 1) / 32;
        if (lane <= w1 - w0) { list[n + lane] = KIND_WIN | ((w0 + lane) << 4); lpage[n + lane] = 0; }
        if (lane == 0) nlist[1] = n + (w1 - w0 + 1);
    }
    __syncthreads();
    const int n_slc = nlist[0], n_all = nlist[1];
#pragma unroll 1
    for (int br = 0; br < 2; ++br) {
        const int i0 = br ? n_slc : 0, i1 = br ? n_all : n_slc;
        m = -1e30f; lsum = 0.f;
        HRegs Rk, Rv;
        int it = i0 + wave;
        if (it < i1) { const int e = list[it], pg = lpage[it]; h_load(F, l, b, e & 15, e >> 4, pg, 0, lane, Rk); h_load(F, l, b, e & 15, e >> 4, pg, 1, lane, Rv); }
#pragma unroll 1
        for (; it < i1; it += 8) {
            const int e = __builtin_amdgcn_readfirstlane(list[it]); const int kind = e & 15, ht = e >> 4;
            h_store_k(kb, Rk, lane); h_store_v(vb, Rv, lane);
            if (it + 8 < i1) { const int e2 = list[it + 8], pg2 = lpage[it + 8]; h_load(F, l, b, e2 & 15, e2 >> 4, pg2, 0, lane, Rk); h_load(F, l, b, e2 & 15, e2 >> 4, pg2, 1, lane, Rv); }
            asm volatile("s_waitcnt lgkmcnt(0)" ::: "memory");
            int lo, hi;
            if (kind == KIND_SLC) { const int j = ht >> 1; const bool sbit = (selw[tl * 8 + (j >> 5)] >> (j & 31)) & 1u; lo = 0; hi = sbit ? tpos : -1; }
            else { lo = tpos - 511; hi = tpos; }
            f32x16 s0; qk_half(kb, qf, s0, lane);
            mask_half(s0, ht * 32 + 4 * h, lo, hi);
            const float mt = max16(s0); const float mn = fmaxf(m, mt); const float al = __builtin_amdgcn_exp2f(m - mn);
            float rs = 0.f;
#pragma unroll
            for (int k = 0; k < 16; ++k) { s0[k] = __builtin_amdgcn_exp2f(s0[k] - mn); rs += s0[k]; }
            lsum = lsum * al + rs; m = mn;
#pragma unroll
            for (int k = 0; k < 16; ++k) { O[0][k] *= al; O[1][k] *= al; }
            pv_half(vb, s0, O, lane);
            asm volatile("s_waitcnt lgkmcnt(0)" ::: "memory");
        }
        merge_branch(lds, wave, lane, m, lsum, O, br ? g2 : g1);
    }
    if (wave == 0 && wcol) {
        bf16* mo = WSP(F, bf16, WS_MIX) + (size_t)r * DM + 768 + head * 64;
#pragma unroll
        for (int dh = 0; dh < 2; ++dh)
#pragma unroll
            for (int gq = 0; gq < 4; ++gq) { const int d = dh * 32 + 8 * gq + 4 * h; const LAS float* o = outl + (dh * 16 + 4 * gq) * 64 + lane;
                *(unsigned long long*)(mo + d) = (unsigned long long)cvtpk(o[0], o[64]) | ((unsigned long long)cvtpk(o[128], o[192]) << 32); }
    }
    __syncthreads();
}


__device__ __forceinline__ void phase_attn2(const Frame& F, int l) {
    for (int u = blockIdx.x; u < 256; u += F.G) attn_unit(F, l, u & 7, (u >> 3) * 64, 64);
    Frame G2 = F; { int ln = G2.lane; asm volatile("" : "+v"(ln)); G2.lane = ln; G2.tid = G2.wave * 64 + ln; }
    if (F.G == 256) { if (blockIdx.x < 128) { ssd_out_unit(G2, l, (int)blockIdx.x >> 5, (int)blockIdx.x & 31); ssd_out_unit(G2, l, ((int)blockIdx.x + 128) >> 5, ((int)blockIdx.x + 128) & 31); } }
    else for (int u = blockIdx.x; u < BP * 32; u += F.G) ssd_out_unit(G2, l, u >> 5, u & 31);
    for (int r = NP + G2.gw; r < MROWS; r += G2.ngw) ssd_finish_token(G2, l, r);
    {
        const int ncb = (F.G == 256) ? 64 : F.G;
        if ((int)blockIdx.x < ncb) {
            const f32x4* src = (const f32x4*)(INP(F, I_SWIN) + (size_t)l * BS * 512 * 128);
            f32x4* dst = (f32x4*)(F.out + O_WINS + (size_t)l * BS * 512 * 128);
            const int nth = ncb * NTHR;
            for (int i0 = blockIdx.x * NTHR + G2.tid; i0 < BS * 504 * 32; i0 += 4 * nth) {
                f32x4 v[4]; size_t o[4]; bool ok[4];
#pragma unroll
                for (int k = 0; k < 4; ++k) { const int i = i0 + k * nth; ok[k] = i < BS * 504 * 32; const int ic = ok[k] ? i : 0; const int b = ic / (504 * 32), rem = ic % (504 * 32);
                    o[k] = (size_t)b * 512 * 32 + rem; v[k] = src[o[k] + 8 * 32]; }
#pragma unroll
                for (int k = 0; k < 4; ++k) if (ok[k]) dst[o[k]] = v[k];
            }
        }
    }
}


constexpr float LOG2E = 1.4426950408889634f;
constexpr int SD_B = 0, SD_BT = 32768, SD_C = 65536, SD_AC = 98304, SD_DT = SD_AC + 2048, SD_W = SD_DT + 2048, SD_END = SD_W + 2048;
static_assert(SD_END <= RING_BYTES, "ssd LDS map");
__device__ __forceinline__ int crow16(int i, int hp) { return (i & 3) + 8 * (i >> 2) + 4 * hp; }
__device__ __forceinline__ unsigned long long pack4bf(float a, float b, float c, float d) { return (unsigned long long)cvtpk(a, b) | ((unsigned long long)cvtpk(c, d) << 32); }

__device__ __forceinline__ void ssd_chunk_unit(const Frame& F, int l, int b, int c, int g) {
    const int tid = F.tid, lane = F.lane, wave = F.wave;
    LAS unsigned char* lds = F.lds;
    const float* proj = WSP(F, float, WS_PROJ);
    const size_t rbase = (size_t)b * TP + (size_t)c * 128;
    const float* cw = INP(F, I_CONVW) + (size_t)l * 4 * CONV_DIM; const float* cbv = INP(F, I_CONVB) + (size_t)l * CONV_DIM;
    LAS float* acs = (LAS float*)(lds + SD_AC); LAS float* dts = (LAS float*)(lds + SD_DT); LAS float* wts = (LAS float*)(lds + SD_W);
    __syncthreads();
    if (wave < 4) {
        const int hh = wave, head = 4 * g + hh;
        const float a2 = -expf(INP(F, I_ALOG)[l * SSD_H + head]) * LOG2E, dtb = INP(F, I_DTB)[l * SSD_H + head];
        const float d0 = softplusf_(proj[(rbase + 2 * lane) * IN_WP + OFF_DT + head] + dtb), d1 = softplusf_(proj[(rbase + 2 * lane + 1) * IN_WP + OFF_DT + head] + dtb);
        float sc = (d0 + d1) * a2;
#pragma unroll
        for (int o = 1; o < 64; o <<= 1) { const float t = __shfl_up(sc, o); if (lane >= o) sc += t; }
        const float ac1 = sc, ac0 = sc - d1 * a2; const float tot = __uint_as_float(__builtin_amdgcn_readlane(__float_as_uint(sc), 63));
        acs[hh * 128 + 2 * lane] = ac0; acs[hh * 128 + 2 * lane + 1] = ac1; dts[hh * 128 + 2 * lane] = d0; dts[hh * 128 + 2 * lane + 1] = d1;
        wts[hh * 128 + 2 * lane] = __builtin_amdgcn_exp2f(tot - ac0); wts[hh * 128 + 2 * lane + 1] = __builtin_amdgcn_exp2f(tot - ac1);
        float* acg = WSP(F, float, WS_SAC); acg[(rbase + 2 * lane) * SSD_H + head] = ac0; acg[(rbase + 2 * lane + 1) * SSD_H + head] = ac1;
        if (lane == 63) WSP(F, float, WS_SCD)[((size_t)b * 16 + c) * SSD_H + head] = __builtin_amdgcn_exp2f(tot);
    }
    {
        const int ch = tid & 255, th = tid >> 8;
        const int chan = (ch < 128) ? 512 + g * 128 + ch : 768 + g * 128 + (ch - 128);
        const float w0 = cw[chan], w1 = cw[CONV_DIM + chan], w2 = cw[2 * CONV_DIM + chan], w3 = cw[3 * CONV_DIM + chan], bb = cbv[chan];
        const int tl0 = th * 64;
        const float* src = proj + (rbase + tl0) * IN_WP + OFF_XBC + chan;
        const bool hasp = (c > 0) || (th > 0);
        float x0 = hasp ? src[-3 * IN_WP] : 0.f, x1 = hasp ? src[-2 * IN_WP] : 0.f, x2 = hasp ? src[-IN_WP] : 0.f;
        const int n = ch & 127;
        bf16* cbg = WSP(F, bf16, WS_SCB) + (rbase + tl0) * 256 + g * 128 + n;
        for (int i1 = 0; i1 < 64; i1 += 16) {
          float rawv[16];
#pragma unroll
          for (int k = 0; k < 16; ++k) rawv[k] = src[(size_t)(i1 + k) * IN_WP];
#pragma unroll
          for (int i2 = 0; i2 < 16; i2 += 4) { const int i0 = i1 + i2;
            float v[4];
#pragma unroll
            for (int k = 0; k < 4; ++k) { const float cur = rawv[i2 + k]; v[k] = siluf_(bb + w0 * x0 + w1 * x1 + w2 * x2 + w3 * cur); x0 = x1; x1 = x2; x2 = cur; }
            const int s = tl0 + i0;
            if (ch < 128) {
#pragma unroll
                for (int k = 0; k < 4; ++k) *(LAS unsigned short*)(lds + SD_B + (s + k) * 256 + (((n >> 3) ^ ((s + k) & 15)) << 4) + (n & 7) * 2) = (unsigned short)f2bf(v[k]);
                *(LAS unsigned long long*)(lds + SD_BT + n * 256 + (((s >> 2) ^ (n & 31)) << 3)) = pack4bf(v[0], v[1], v[2], v[3]);
            } else {
#pragma unroll
                for (int k = 0; k < 4; ++k) { const unsigned short hv = (unsigned short)f2bf(v[k]);
                    *(LAS unsigned short*)(lds + SD_C + (s + k) * 256 + (((n >> 3) ^ ((s + k) & 15)) << 4) + (n & 7) * 2) = hv; cbg[(size_t)(i0 + k) * 256] = hv; }
            }
          }
        }
    }
    __syncthreads();
    const int lb = wave & 3, hw = wave >> 2;
    int lane_g = lane; asm volatile("" : "+v"(lane_g));
    f32x16 Gt[4];
    {
        const int r32 = lane_g & 31, hp = lane_g >> 5, lloc = lb * 32 + r32;
        bf16x8 cf[8];
#pragma unroll
        for (int ks = 0; ks < 8; ++ks) cf[ks] = *(const LAS bf16x8*)(lds + SD_C + lloc * 256 + (((2 * ks + hp) ^ (lloc & 15)) << 4));
#pragma unroll
        for (int sb = 0; sb < 4; ++sb) {
#pragma unroll
            for (int i = 0; i < 16; ++i) Gt[sb][i] = 0.f;
            if (sb <= lb) {
                int s = sb * 32 + r32; asm volatile("" : "+v"(s));
#pragma unroll
                for (int ks = 0; ks < 8; ++ks) { const bf16x8 a = *(const LAS bf16x8*)(lds + SD_B + s * 256 + (((2 * ks + hp) ^ (s & 15)) << 4));
                    Gt[sb] = __builtin_amdgcn_mfma_f32_32x32x16_bf16(a, cf[ks], Gt[sb], 0, 0, 0); }
            }
            __builtin_amdgcn_sched_barrier(0);
        }
    }
    __syncthreads();
    for (int rd = 0; rd < 2; ++rd) {
        {
            int tid_r = tid; asm volatile("" : "+v"(tid_r));
            const int ch = tid_r & 127, tq = tid_r >> 7; const int hh2 = ch >> 6, p = ch & 63, hh = 2 * rd + hh2;
            const int chan = (4 * g + hh) * 64 + p;
            const float w0 = cw[chan], w1 = cw[CONV_DIM + chan], w2 = cw[2 * CONV_DIM + chan], w3 = cw[3 * CONV_DIM + chan], bb = cbv[chan];
            const int tl0 = tq * 32;
            const float* src = proj + (rbase + tl0) * IN_WP + OFF_XBC + chan;
            const bool hasp = (c > 0) || (tq > 0);
            float x0 = hasp ? src[-3 * IN_WP] : 0.f, x1 = hasp ? src[-2 * IN_WP] : 0.f, x2 = hasp ? src[-IN_WP] : 0.f;
            for (int i1 = 0; i1 < 32; i1 += 16) {
              float rawv[16];
#pragma unroll
              for (int k = 0; k < 16; ++k) rawv[k] = src[(size_t)(i1 + k) * IN_WP];
#pragma unroll
              for (int i2 = 0; i2 < 16; i2 += 4) { const int i0 = i1 + i2;
                float v[4]; const int s = tl0 + i0;
#pragma unroll
                for (int k = 0; k < 4; ++k) { const float cur = rawv[i2 + k]; v[k] = siluf_(bb + w0 * x0 + w1 * x1 + w2 * x2 + w3 * cur) * dts[hh * 128 + s + k]; x0 = x1; x1 = x2; x2 = cur; }
                *(LAS unsigned long long*)(lds + SD_C + hh2 * 16384 + p * 256 + (((s >> 2) ^ (p & 31)) << 3)) = pack4bf(v[0], v[1], v[2], v[3]);
              }
            }
        }
        __syncthreads();
        int lane_r = lane; asm volatile("" : "+v"(lane_r));
        const int r32 = lane_r & 31, hp = lane_r >> 5, lloc = lb * 32 + r32;
        const int hh = 2 * rd + hw, head = 4 * g + hh;
        const LAS float* ac = acs + hh * 128; const LAS float* wp = wts + hh * 128;
        const LAS unsigned char* xt = lds + SD_C + hw * 16384;
        const float acl = ac[lloc], ddt = INP(F, I_SSDD)[l * SSD_H + head] / dts[hh * 128 + lloc];
        f32x16 Y[2];
#pragma unroll
        for (int i = 0; i < 16; ++i) { Y[0][i] = 0.f; Y[1][i] = 0.f; }
#pragma unroll
        for (int sb = 0; sb < 4; ++sb) {
            if (sb <= lb) {
                f32x16 mt;
#pragma unroll
                for (int i = 0; i < 16; ++i) { const int s = sb * 32 + crow16(i, hp);
                    float mv = Gt[sb][i] * __builtin_amdgcn_exp2f(acl - ac[s]);
                    if (sb == lb) { mv = (s > lloc) ? 0.f : mv; mv += (s == lloc) ? ddt : 0.f; }
                    mt[i] = mv; }
                bf16x8 pf[2];
#pragma unroll
                for (int sp = 0; sp < 2; ++sp) { v4u a; a.x = cvtpk(mt[8 * sp + 0], mt[8 * sp + 1]); a.y = cvtpk(mt[8 * sp + 2], mt[8 * sp + 3]); a.z = cvtpk(mt[8 * sp + 4], mt[8 * sp + 5]); a.w = cvtpk(mt[8 * sp + 6], mt[8 * sp + 7]);
                    pf[sp] = __builtin_bit_cast(bf16x8, a); }
#pragma unroll
                for (int pt = 0; pt < 2; ++pt) { int p = pt * 32 + r32; asm volatile("" : "+v"(p)); const int sw = p & 31; const LAS unsigned char* rb = xt + p * 256;
#pragma unroll
                    for (int sp = 0; sp < 2; ++sp) { const int q0 = sb * 8 + 4 * sp + hp;
                        const unsigned long long lo8 = *(const LAS unsigned long long*)(rb + ((q0 ^ sw) << 3)), hi8 = *(const LAS unsigned long long*)(rb + (((q0 + 2) ^ sw) << 3));
                        v4u av; av.x = (unsigned)lo8; av.y = (unsigned)(lo8 >> 32); av.z = (unsigned)hi8; av.w = (unsigned)(hi8 >> 32);
                        Y[pt] = __builtin_amdgcn_mfma_f32_32x32x16_bf16(__builtin_bit_cast(bf16x8, av), pf[sp], Y[pt], 0, 0, 0); } }
            }
            __builtin_amdgcn_sched_barrier(0);
        }
        {
            float* yo = WSP(F, float, WS_YSSD) + (rbase + lloc) * SSD_W + head * 64;
#pragma unroll
            for (int pt = 0; pt < 2; ++pt)
#pragma unroll
                for (int qd = 0; qd < 4; ++qd) *(f32x4*)(yo + pt * 32 + 8 * qd + 4 * hp) = (f32x4){Y[pt][4 * qd], Y[pt][4 * qd + 1], Y[pt][4 * qd + 2], Y[pt][4 * qd + 3]};
        }
        {
            f32x16 St[2];
#pragma unroll
            for (int i = 0; i < 16; ++i) { St[0][i] = 0.f; St[1][i] = 0.f; }
            const int n = lb * 32 + r32;
#pragma unroll
            for (int ks = 0; ks < 8; ++ks) {
                const int cb0 = 4 * ks + 2 * hp; int nn = n; asm volatile("" : "+v"(nn));
                const unsigned long long blo = *(const LAS unsigned long long*)(lds + SD_BT + nn * 256 + ((cb0 ^ (nn & 31)) << 3)), bhi = *(const LAS unsigned long long*)(lds + SD_BT + nn * 256 + (((cb0 + 1) ^ (nn & 31)) << 3));
                v4u bv; bv.x = (unsigned)blo; bv.y = (unsigned)(blo >> 32); bv.z = (unsigned)bhi; bv.w = (unsigned)(bhi >> 32);
                const f32x4 wa = *(const LAS f32x4*)(wp + 16 * ks + 8 * hp), wb = *(const LAS f32x4*)(wp + 16 * ks + 8 * hp + 4);
#pragma unroll
                for (int pt = 0; pt < 2; ++pt) { const int p = pt * 32 + (nn & 31); const LAS unsigned char* rb = xt + p * 256;
                    const unsigned long long alo = *(const LAS unsigned long long*)(rb + ((cb0 ^ (p & 31)) << 3)), ahi = *(const LAS unsigned long long*)(rb + (((cb0 + 1) ^ (p & 31)) << 3));
                    const unsigned a0 = (unsigned)alo, a1 = (unsigned)(alo >> 32), a2 = (unsigned)ahi, a3 = (unsigned)(ahi >> 32);
                    v4u av;
                    av.x = cvtpk(__uint_as_float(a0 << 16) * wa.x, __uint_as_float(a0 & 0xffff0000u) * wa.y); av.y = cvtpk(__uint_as_float(a1 << 16) * wa.z, __uint_as_float(a1 & 0xffff0000u) * wa.w);
                    av.z = cvtpk(__uint_as_float(a2 << 16) * wb.x, __uint_as_float(a2 & 0xffff0000u) * wb.y); av.w = cvtpk(__uint_as_float(a3 << 16) * wb.z, __uint_as_float(a3 & 0xffff0000u) * wb.w);
                    St[pt] = __builtin_amdgcn_mfma_f32_32x32x16_bf16(__builtin_bit_cast(bf16x8, av), __builtin_bit_cast(bf16x8, bv), St[pt], 0, 0, 0); }
                __builtin_amdgcn_sched_barrier(0);
            }
            float* cs = WSP(F, float, WS_SCS) + (((size_t)b * 16 + c) * SSD_H + head) * (SSD_HD * SSD_N) + n;
#pragma unroll
            for (int pt = 0; pt < 2; ++pt)
#pragma unroll
                for (int i = 0; i < 16; ++i) cs[(size_t)(pt * 32 + crow16(i, hp)) * SSD_N] = St[pt][i];
        }
        __syncthreads();
    }
}

__device__ __forceinline__ void ssd_scan(const Frame& F, int l) {
    const float* cs = WSP(F, float, WS_SCS); const float* cd = WSP(F, float, WS_SCD); bf16* hs = WSP(F, bf16, WS_SHS);
    const bool upper = (F.G == 256);
    for (int idx0 = blockIdx.x * NTHR + F.tid; idx0 < BP * SSD_H * 2048; idx0 += F.G * NTHR) {
        if (upper && blockIdx.x < 128) continue;
#pragma unroll 1
        for (int rep = 0; rep < (upper ? 2 : 1); ++rep) {
            const int idx = upper ? idx0 - (1 - rep) * 65536 : idx0;
            const int e4 = idx & 2047, bh = idx >> 11, b = bh >> 3, h = bh & 7;
            f32x4 st = (f32x4){0.f, 0.f, 0.f, 0.f};
#pragma unroll 8
            for (int c = 0; c < 16; ++c) {
                const size_t o = (((size_t)b * 16 + c) * SSD_H + h) * (SSD_HD * SSD_N) + e4 * 4;
                *(unsigned long long*)(hs + o) = pack4bf(st.x, st.y, st.z, st.w);
                const f32x4 sv = *(const f32x4*)(cs + o); const float d = cd[((size_t)b * 16 + c) * SSD_H + h];
                st = st * d + sv;
            }
            *(f32x4*)(F.out + O_SSMP + (((size_t)l * BP + b) * SSD_H + h) * (SSD_HD * SSD_N) + e4 * 4) = st;
        }
    }
}

__device__ __forceinline__ void ssd_out_unit(const Frame& F, int l, int b, int hc) {
    const int lane = F.lane, h = F.wave, g = h >> 2, c = hc >> 1, l0 = hc * 64, r32 = lane & 31, hp = lane >> 5;
    LAS float* ssq = (LAS float*)F.lds;
    const bf16* Hs = WSP(F, bf16, WS_SHS) + (((size_t)b * 16 + c) * SSD_H + h) * (SSD_HD * SSD_N);
    const bf16* Cb = WSP(F, bf16, WS_SCB) + ((size_t)b * TP + l0) * 256 + g * 128;
    f32x16 Yo[2][2];
#pragma unroll
    for (int i = 0; i < 16; ++i) { Yo[0][0][i] = 0.f; Yo[0][1][i] = 0.f; Yo[1][0][i] = 0.f; Yo[1][1][i] = 0.f; }
#pragma unroll
    for (int ks = 0; ks < 8; ++ks) {
        bf16x8 af[2], bfr[2];
#pragma unroll
        for (int pt = 0; pt < 2; ++pt) af[pt] = *(const bf16x8*)(Hs + (size_t)(pt * 32 + r32) * SSD_N + 16 * ks + 8 * hp);
#pragma unroll
        for (int lt = 0; lt < 2; ++lt) bfr[lt] = *(const bf16x8*)(Cb + (size_t)(lt * 32 + r32) * 256 + 16 * ks + 8 * hp);
#pragma unroll
        for (int lt = 0; lt < 2; ++lt)
#pragma unroll
            for (int pt = 0; pt < 2; ++pt) Yo[lt][pt] = __builtin_amdgcn_mfma_f32_32x32x16_bf16(af[pt], bfr[lt], Yo[lt][pt], 0, 0, 0);
    }
    __syncthreads();
#pragma unroll
    for (int lt = 0; lt < 2; ++lt) {
        const size_t row = (size_t)b * TP + l0 + lt * 32 + r32;
        const float sc = __builtin_amdgcn_exp2f(WSP(F, float, WS_SAC)[row * SSD_H + h]);
        const float* yd = WSP(F, float, WS_YSSD) + row * SSD_W + h * 64; const float* zz = WSP(F, float, WS_PROJ) + row * IN_WP + h * 64;
        float ss = 0.f;
#pragma unroll
        for (int pt = 0; pt < 2; ++pt) {
            f32x4 y4v[4], z4v[4];
#pragma unroll
            for (int i = 0; i < 4; ++i) { const int p = pt * 32 + 8 * i + 4 * hp; y4v[i] = *(const f32x4*)(yd + p); z4v[i] = *(const f32x4*)(zz + p); }
#pragma unroll
            for (int qd = 0; qd < 4; ++qd) { const f32x4 y4 = y4v[qd], z4 = z4v[qd];
#pragma unroll
                for (int k = 0; k < 4; ++k) { const float v = (y4[k] + sc * Yo[lt][pt][4 * qd + k]) * siluf_(z4[k]); Yo[lt][pt][4 * qd + k] = v; ss += v * v; } }
        }
        ss = half_sum(ss);
        if (hp == 0) ssq[(lt * 32 + r32) * 8 + h] = ss;
    }
    __syncthreads();
    const float* nw = INP(F, I_SSDNORM) + (size_t)l * SSD_W + h * 64;
#pragma unroll
    for (int lt = 0; lt < 2; ++lt) {
        const size_t row = (size_t)b * TP + l0 + lt * 32 + r32;
        const LAS float* sq = ssq + (lt * 32 + r32) * 8;
        const float tot = ((sq[0] + sq[1]) + (sq[2] + sq[3])) + ((sq[4] + sq[5]) + (sq[6] + sq[7]));
        const float rs = 1.f / sqrtf(tot * (1.f / SSD_W) + RMS_EPS);
        bf16* mo = WSP(F, bf16, WS_MIX) + row * DM + h * 64;
#pragma unroll
        for (int pt = 0; pt < 2; ++pt)
#pragma unroll
            for (int qd = 0; qd < 4; ++qd) { const int p = pt * 32 + 8 * qd + 4 * hp; const f32x4 w4 = *(const f32x4*)(nw + p);
                *(unsigned long long*)(mo + p) = pack4bf(Yo[lt][pt][4 * qd] * rs * w4.x, Yo[lt][pt][4 * qd + 1] * rs * w4.y, Yo[lt][pt][4 * qd + 2] * rs * w4.z, Yo[lt][pt][4 * qd + 3] * rs * w4.w); }
    }
    __syncthreads();
}

__device__ __forceinline__ void resid_row(const Frame& F, const float* xold, const float* f, const bf16* fb, int nsl, size_t slstride, const float* w_post, float* xnew, const float* w_next, bf16* xn) {
    const f32x4* xo = (const f32x4*)xold + F.lane; const f32x4* fr = (const f32x4*)f + F.lane; const f32x4* wp = (const f32x4*)w_post + F.lane;
    f32x4 fv[4]; float ss = 0.f;
#pragma unroll
    for (int j = 0; j < 4; ++j) {
        if (fb) fv[j] = bf4_to_f32(((const unsigned long long*)fb + F.lane)[64 * j]); else fv[j] = fr[64 * j];
        for (int s = 1; s < nsl; ++s) fv[j] += ((const f32x4*)(f + s * slstride) + F.lane)[64 * j];
        ss += (fv[j].x * fv[j].x + fv[j].y * fv[j].y) + (fv[j].z * fv[j].z + fv[j].w * fv[j].w); }
    const float rs = 1.f / sqrtf(wave_sum(ss) * (1.f / DM) + RMS_EPS);
    f32x4 xv[4]; float s2 = 0.f;
#pragma unroll
    for (int j = 0; j < 4; ++j) { xv[j] = xo[64 * j] + fv[j] * rs * wp[64 * j]; s2 += (xv[j].x * xv[j].x + xv[j].y * xv[j].y) + (xv[j].z * xv[j].z + xv[j].w * xv[j].w);
        ((f32x4*)xnew + F.lane)[64 * j] = xv[j]; }
    if (w_next) {
        const float r2 = 1.f / sqrtf(wave_sum(s2) * (1.f / DM) + RMS_EPS);
        const f32x4* wn = (const f32x4*)w_next + F.lane; unsigned long long* o8 = (unsigned long long*)xn + F.lane;
#pragma unroll
        for (int j = 0; j < 4; ++j) { const f32x4 g = wn[64 * j];
            o8[64 * j] = (unsigned long long)pk2(xv[j].x * r2 * g.x, xv[j].y * r2 * g.y) | ((unsigned long long)pk2(xv[j].z * r2 * g.z, xv[j].w * r2 * g.w) << 32); }
    }
}
template <int NR>
__device__ __forceinline__ void resid_rowsN(const Frame& F, const float* xold, const bf16* f, const float* w_post, float* xnew, const float* w_next, bf16* xn) {
    const int lane = F.lane;
    unsigned long long fr[NR][4]; f32x4 xv[NR][4];
#pragma unroll
    for (int r = 0; r < NR; ++r)
#pragma unroll
        for (int j = 0; j < 4; ++j) { fr[r][j] = ((const unsigned long long*)(f + (size_t)r * DM) + lane)[64 * j]; xv[r][j] = ((const f32x4*)(xold + (size_t)r * DM) + lane)[64 * j]; }
    float rs[NR];
#pragma unroll
    for (int r = 0; r < NR; ++r) { float s = 0.f;
#pragma unroll
        for (int j = 0; j < 4; ++j) { const f32x4 v = bf4_to_f32(fr[r][j]); s += (v.x * v.x + v.y * v.y) + (v.z * v.z + v.w * v.w); }
        rs[r] = s; }
#pragma unroll
    for (int r = 0; r < NR; ++r) rs[r] = 1.f / sqrtf(wave_sum(rs[r]) * (1.f / DM) + RMS_EPS);
    float s2[NR];
#pragma unroll
    for (int r = 0; r < NR; ++r) s2[r] = 0.f;
#pragma unroll
    for (int j = 0; j < 4; ++j) { const f32x4 wp = ((const f32x4*)w_post + lane)[64 * j];
#pragma unroll
        for (int r = 0; r < NR; ++r) { xv[r][j] = xv[r][j] + bf4_to_f32(fr[r][j]) * rs[r] * wp;
            s2[r] += (xv[r][j].x * xv[r][j].x + xv[r][j].y * xv[r][j].y) + (xv[r][j].z * xv[r][j].z + xv[r][j].w * xv[r][j].w);
            ((f32x4*)(xnew + (size_t)r * DM) + lane)[64 * j] = xv[r][j]; } }
    if (w_next) {
#pragma unroll
        for (int r = 0; r < NR; ++r) s2[r] = 1.f / sqrtf(wave_sum(s2[r]) * (1.f / DM) + RMS_EPS);
#pragma unroll
        for (int j = 0; j < 4; ++j) { const f32x4 g = ((const f32x4*)w_next + lane)[64 * j];
#pragma unroll
            for (int r = 0; r < NR; ++r) { const float q = s2[r];
                ((unsigned long long*)(xn + (size_t)r * DM) + lane)[64 * j] = (unsigned long long)pk2(xv[r][j].x * q * g.x, xv[r][j].y * q * g.y) | ((unsigned long long)pk2(xv[r][j].z * q * g.z, xv[r][j].w * q * g.w) << 32); } }
    }
}
constexpr int RES_NR = 4;
__device__ __forceinline__ void phase_resid_mix(const Frame& F, int l) {
    for (int rp = F.gw; rp < NP / RES_NR; rp += F.ngw) { const int r = RES_NR * rp;
        const float* x0 = (l == 0) ? x_in_row(F, r) : WSP(F, float, WS_X) + (size_t)r * DM;
        resid_rowsN<RES_NR>(F, x0, WSP(F, bf16, WS_MIXO) + (size_t)r * DM, INP(F, I_NMPOST) + (size_t)l * DM, WSP(F, float, WS_X) + (size_t)r * DM,
                            INP(F, I_NFPRE) + (size_t)l * DM, WSP(F, bf16, WS_XN) + (size_t)r * DM);
    }
    for (int r = NP + F.gw; r < MROWS; r += F.ngw) {
        const float* xold = (l == 0) ? x_in_row(F, r) : WSP(F, float, WS_X) + (size_t)r * DM;
        resid_row(F, xold, WSP(F, float, WS_SLAB) + (size_t)(r - NP) * DM, nullptr, SPLIT_OUT, (size_t)256 * DM, INP(F, I_NMPOST) + (size_t)l * DM, WSP(F, float, WS_X) + (size_t)r * DM,
                  INP(F, I_NFPRE) + (size_t)l * DM, WSP(F, bf16, WS_XN) + (size_t)r * DM);
    }
}
__device__ __forceinline__ void phase_resid_ffn(const Frame& F, int l) {
    const float* wn = (l == DEPTH - 1) ? nullptr : INP(F, I_NMPRE) + (size_t)(l + 1) * DM;
    for (int rp = F.gw; rp < NP / RES_NR; rp += F.ngw) { const int r = RES_NR * rp;
        float* xn = (l == DEPTH - 1) ? F.out + O_YP + (size_t)r * DM : WSP(F, float, WS_X) + (size_t)r * DM;
        resid_rowsN<RES_NR>(F, WSP(F, float, WS_X) + (size_t)r * DM, WSP(F, bf16, WS_MIXO) + (size_t)r * DM, INP(F, I_NFPOST) + (size_t)l * DM, xn, wn, WSP(F, bf16, WS_XN) + (size_t)r * DM);
    }
    for (int r = NP + F.gw; r < MROWS; r += F.ngw) {
        float* xnew = (l == DEPTH - 1) ? F.out + O_YS + (size_t)(r - NP) * DM : WSP(F, float, WS_X) + (size_t)r * DM;
        resid_row(F, WSP(F, float, WS_X) + (size_t)r * DM, WSP(F, float, WS_SLAB) + (size_t)(r - NP) * DM, nullptr, SPLIT_DOWN, (size_t)256 * DM, INP(F, I_NFPOST) + (size_t)l * DM, xnew,
                  wn, WSP(F, bf16, WS_XN) + (size_t)r * DM);
    }
}

__device__ __forceinline__ void phase_ffn_act(const Frame& F, int l) {
    bf16* act = WSP(F, bf16, WS_ACT);
    const float* cw = INP(F, I_FCW) + (size_t)l * 3 * DFF; const float* cb = INP(F, I_FCB) + (size_t)l * DFF;
    const float* halo = WSP(F, float, WS_FHALO); const float* last = WSP(F, float, WS_FLAST); const float* raw = WSP(F, float, WS_FRAW);
    for (int it = F.gw; it < 64 * 2 * 16; it += F.ngw) {
        const int pm = it >> 5, j = (it >> 4) & 1, c = (it & 15) * 256 + F.lane * 4;
        const bool first = (pm & 7) == 0;
        const f32x4 z = (f32x4){0.f, 0.f, 0.f, 0.f};
        const f32x4 ga = *(const f32x4*)(halo + ((size_t)pm * 2 + j) * 8192 + c), vv = *(const f32x4*)(halo + ((size_t)pm * 2 + j) * 8192 + 4096 + c);
        f32x4 gb, gc;
        if (j == 0) { gb = first ? z : *(const f32x4*)(last + ((size_t)(pm - 1) * 2 + 1) * 4096 + c); gc = first ? z : *(const f32x4*)(last + ((size_t)(pm - 1) * 2 + 0) * 4096 + c); }
        else { gb = *(const f32x4*)(halo + ((size_t)pm * 2 + 0) * 8192 + c); gc = first ? z : *(const f32x4*)(last + ((size_t)(pm - 1) * 2 + 1) * 4096 + c); }
        const f32x4 w0 = *(const f32x4*)(cw + c), w1 = *(const f32x4*)(cw + DFF + c), w2 = *(const f32x4*)(cw + 2 * DFF + c), bb = *(const f32x4*)(cb + c);
        const f32x4 pre = gc * w0 + gb * w1 + ga * w2 + bb;
        const float a0 = gelu_tanh(pre.x) * vv.x, a1 = gelu_tanh(pre.y) * vv.y, a2 = gelu_tanh(pre.z) * vv.z, a3 = gelu_tanh(pre.w) * vv.w;
        *(unsigned long long*)(act + (size_t)(pm * 256 + j) * DFF + c) = (unsigned long long)pk2(a0, a1) | ((unsigned long long)pk2(a2, a3) << 32);
    }
    for (int it = F.gw; it < BP * 2 * 16; it += F.ngw) {
        const int b = it >> 5, j = (it >> 4) & 1, c = (it & 15) * 256 + F.lane * 4;
        *(f32x4*)(F.out + O_FFNP + (((size_t)l * BP + b) * 2 + j) * DFF + c) = *(const f32x4*)(last + ((size_t)(8 * b + 7) * 2 + j) * 4096 + c);
    }
    for (int it = F.gw; it < NS * 16; it += F.ngw) {
        const int r = NP + (it >> 4), j = it & 15;
        const int qq = r - NP, b = qq >> 3, t = qq & 7;
        const float* sffn = INP(F, I_SFFN) + ((size_t)l * BS + b) * 2 * DFF;
        const float* g0 = raw + (size_t)qq * 2 * DFF;
        { const int c = j * 256 + F.lane * 4;
            constexpr size_t SL = (size_t)256 * 2 * DFF;
            f32x4 ga = *(const f32x4*)(g0 + c), gb, gc, vv = *(const f32x4*)(g0 + DFF + c);
            if (t >= 1) gb = *(const f32x4*)(g0 - (size_t)2 * DFF + c); else gb = *(const f32x4*)(sffn + DFF + c);
            if (t >= 2) gc = *(const f32x4*)(g0 - (size_t)4 * DFF + c); else gc = *(const f32x4*)(sffn + (size_t)t * DFF + c);
#pragma unroll
            for (int sl = 1; sl < SPLIT_UP; ++sl) { ga += *(const f32x4*)(g0 + sl * SL + c); vv += *(const f32x4*)(g0 + sl * SL + DFF + c);
                if (t >= 1) gb += *(const f32x4*)(g0 + sl * SL - (size_t)2 * DFF + c);
                if (t >= 2) gc += *(const f32x4*)(g0 + sl * SL - (size_t)4 * DFF + c); }
            const f32x4 w0 = *(const f32x4*)(cw + c), w1 = *(const f32x4*)(cw + DFF + c), w2 = *(const f32x4*)(cw + 2 * DFF + c), bb = *(const f32x4*)(cb + c);
            const f32x4 pre = gc * w0 + gb * w1 + ga * w2 + bb;
            const float a0 = gelu_tanh(pre.x) * vv.x, a1 = gelu_tanh(pre.y) * vv.y, a2 = gelu_tanh(pre.z) * vv.z, a3 = gelu_tanh(pre.w) * vv.w;
            *(unsigned long long*)(act + (size_t)r * DFF + c) = (unsigned long long)pk2(a0, a1) | ((unsigned long long)pk2(a2, a3) << 32);
            if (t >= TS - 2) *(f32x4*)(F.out + O_FFNS + (((size_t)l * BS + b) * 2 + (t - (TS - 2))) * DFF + c) = ga;
        }
    }
}

__global__ void __launch_bounds__(NTHR, 2) hymba_fwd(Params prm) {
    extern __shared__ __attribute__((aligned(16))) unsigned char lds_raw[];
    Frame F;
    F.lds = (LAS unsigned char*)lds_raw;
#define REFRESH() do { unsigned z_ = 0u; asm volatile("" : "+v"(z_)); int ln_ = (int)__builtin_amdgcn_mbcnt_hi(~0u, __builtin_amdgcn_mbcnt_lo(~0u, z_)); F.lane = ln_; F.wave = wave_s; F.tid = wave_s * 64 + ln_; \
        F.gw = blockIdx.x * NWAVES + F.wave; \
        const __attribute__((address_space(4))) void* kp_ = (const __attribute__((address_space(4))) void*)__builtin_amdgcn_kernarg_segment_ptr(); asm volatile("" : "+s"(kp_)); \
        F.p = (const __attribute__((address_space(4))) Params*)kp_; F.ws = F.p->ws; F.out = F.p->out; } while (0)
    F.G = gridDim.x; F.ngw = F.G * NWAVES;
    const int wave_s = __builtin_amdgcn_readfirstlane((int)threadIdx.x >> 6);
    REFRESH();
    volatile LAS unsigned* MISC = (volatile LAS unsigned*)(F.lds + MISC_OFF);
    for (int u = F.tid; u < (LDS_BYTES - RING_BYTES) / 4; u += NTHR) ((LAS unsigned*)(F.lds + RING_BYTES))[u] = 0u;
    __syncthreads();
    const int lo = F.p->ph_lo, hi = F.p->ph_hi;
    const bool use_bar = (hi - lo) > 1;
    XcdBarrier bar; bar.bar = (unsigned*)(F.ws + WS_CTL) + 4096; bar.x = 0; bar.st = nullptr;
    if (use_bar) bar = xcd_barrier_post((unsigned*)(F.ws + WS_CTL) + 4096, MISC + 8);
#define IN(k) (lo <= (k) && (k) < hi)
#define SEAM(k) do { if (IN((k) + 1)) { REFRESH(); xcd_barrier(bar, F.tid == 0); } } while (0)

    if (IN(0)) { REFRESH(); phase_prologue(F); SEAM(0); }
    if (IN(1)) { REFRESH();
        pg8::Gemm g{WSP(F, pg8::bf16_t, WS_AS), WSP(F, pg8::bf16_t, WS_WTC), 8 * BS * 512, 256, 1024};
        pg8::CmpOrder S; S.G = F.G; S.c = (int)blockIdx.x;
        pg8::EpiCmp E{WSP(F, float, WS_HS)};
        pg8::gemm_phase<pg8::EpiCmp, pg8::CmpOrder, true, true>(F.lds, g, S, E, F.tid);
        SEAM(1);
    }
    if (IN(2)) { REFRESH(); phase_cmp_finish(F); SEAM(2); }
    for (int l = 0; l < DEPTH; ++l) {
        const int pb = N_PRO + l * PH_PER_LAYER;
        if (IN(pb + 0)) { REFRESH();
            pg8::Gemm g{WSP(F, pg8::bf16_t, WS_XN), WSP(F, pg8::bf16_t, WS_WTIN) + (size_t)l * IN_WP * DM, MROWS, IN_WP, DM};
            pg8::StaticOrder S; S.init(MROWS, IN_WP, F.G, (int)blockIdx.x);
            pg8::EpiF32 E{WSP(F, float, WS_PROJ), IN_WP};
            pg8::gemm_phase<pg8::EpiF32, pg8::StaticOrder, true, true>(F.lds, g, S, E, F.tid);
            SEAM(pb + 0);
        }
        if (IN(pb + 1)) { REFRESH(); phase_prep(F, l); SEAM(pb + 1); }
        if (IN(pb + 2)) { REFRESH(); phase_compress(F, l); SEAM(pb + 2); }
        if (IN(pb + 3)) { REFRESH(); phase_attn2(F, l); SEAM(pb + 3); }
        if (IN(pb + 4)) { REFRESH();
            pg8::Gemm g{WSP(F, pg8::bf16_t, WS_MIX), WSP(F, pg8::bf16_t, WS_WTOUT) + (size_t)l * DM * DM, MROWS, DM, DM};
            pg8::TailSplitOrder S; S.init(NP, DM, DM, SPLIT_OUT, F.G, (int)blockIdx.x);
            pg8::EpiB16Split E{WSP(F, pg8::bf16_t, WS_MIXO), WSP(F, float, WS_SLAB), DM, NP / 256};
            pg8::gemm_phase<pg8::EpiB16Split, pg8::TailSplitOrder, true, true>(F.lds, g, S, E, F.tid);
            SEAM(pb + 4);
        }
        if (IN(pb + 5)) { REFRESH(); phase_resid_mix(F, l); SEAM(pb + 5); }
        if (IN(pb + 6)) { REFRESH();
            pg8::Gemm g{WSP(F, pg8::bf16_t, WS_XN), WSP(F, pg8::bf16_t, WS_WTUP) + (size_t)l * 2 * DFF * DM, MROWS, 2 * DFF, DM};
            pg8::StaticOrder S; S.init(MROWS, 2 * DFF, F.G, (int)blockIdx.x);
            pg8::EpiFfn E{WSP(F, pg8::bf16_t, WS_ACT), WSP(F, float, WS_FRAW), WSP(F, float, WS_FHALO), WSP(F, float, WS_FLAST),
                          INP(F, I_FCW) + (size_t)l * 3 * DFF, INP(F, I_FCB) + (size_t)l * DFF, (LAS float*)(F.lds + XB_OFF), NP / 256};
            pg8::gemm_phase<pg8::EpiFfn, pg8::StaticOrder, true, true>(F.lds, g, S, E, F.tid);
            SEAM(pb + 6);
        }
        if (IN(pb + 7)) { REFRESH(); phase_ffn_act(F, l); SEAM(pb + 7); }
        if (IN(pb + 8)) { REFRESH();
            pg8::Gemm g{WSP(F, pg8::bf16_t, WS_ACT), WSP(F, pg8::bf16_t, WS_WTDN) + (size_t)l * DM * DFF, MROWS, DM, DFF};
            pg8::TailSplitOrder S; S.init(NP, DM, DFF, SPLIT_DOWN, F.G, (int)blockIdx.x);
            pg8::EpiB16Split E{WSP(F, pg8::bf16_t, WS_MIXO), WSP(F, float, WS_SLAB), DM, NP / 256};
            pg8::gemm_phase<pg8::EpiB16Split, pg8::TailSplitOrder, true, true>(F.lds, g, S, E, F.tid);
            SEAM(pb + 8);
        }
        if (IN(pb + 9)) { REFRESH(); phase_resid_ffn(F, l); SEAM(pb + 9); }
    }
#undef IN
#undef SEAM
}

#ifndef N_LAUNCH_MODE
#define N_LAUNCH_MODE 1
#endif
extern "C" void kernel_launch(void* const* d_in, const int* in_sizes, int n_in, void* d_out, int out_size, void* d_ws, size_t ws_size, hipStream_t stream) {
    static int grid = 0;
    if (grid == 0) {
        if (n_in != N_IN || (size_t)out_size != O_END || ws_size < WS_END) {
            fprintf(stderr, "kernel_launch: unexpected shapes: n_in %d (want %d), out %d (want %zu), ws %zu (want >= %zu); nothing launched\n", n_in, (int)N_IN, out_size, (size_t)O_END, ws_size, (size_t)WS_END);
            grid = -1; return; }
        int dev = 0, cus = 0, per_cu = 0;
        if (hipGetDevice(&dev) != hipSuccess || hipDeviceGetAttribute(&cus, hipDeviceAttributeMultiprocessorCount, dev) != hipSuccess) { grid = -1; return; }
        if (hipFuncSetAttribute((const void*)hymba_fwd, hipFuncAttributeMaxDynamicSharedMemorySize, LDS_BYTES) != hipSuccess) { fprintf(stderr, "kernel_launch: hipFuncSetAttribute failed\n"); grid = -1; return; }
        if (hipOccupancyMaxActiveBlocksPerMultiprocessor(&per_cu, (const void*)hymba_fwd, NTHR, LDS_BYTES) != hipSuccess || per_cu < 1)
            fprintf(stderr, "kernel_launch: note: occupancy query reports %d workgroups per CU\n", per_cu);
        (void)hipGetLastError();
        grid = cus;
    }
    if (grid < 0) return;
    (void)hipMemsetAsync((char*)d_ws + WS_CTL, 0, CTL_BYTES, stream);
    Params prm{};
    for (int i = 0; i < N_IN; ++i) prm.in[i] = (const float*)d_in[i];
    prm.out = (float*)d_out; prm.ws = (unsigned char*)d_ws;
#if N_LAUNCH_MODE == 1
    prm.ph_lo = 0; prm.ph_hi = N_PHASES;
    hipLaunchKernelGGL(hymba_fwd, dim3(grid), dim3(NTHR), LDS_BYTES, stream, prm);
#else
    for (int ph = 0; ph < N_PHASES; ++ph) {
        prm.ph_lo = ph; prm.ph_hi = ph + 1;
        hipLaunchKernelGGL(hymba_fwd, dim3(grid), dim3(NTHR), LDS_BYTES, stream, prm);
    }
#endif
}
```

```cpp
#include <hip/hip_runtime.h>
#include <cstdio>
#include <cstdint>

namespace pg8 {
#define PG8_LAS __attribute__((address_space(3)))
typedef unsigned short bf16_t;
typedef short bf16x8 __attribute__((ext_vector_type(8)));
typedef float f32x4 __attribute__((ext_vector_type(4)));
typedef unsigned u32x4 __attribute__((ext_vector_type(4)));
constexpr int BM = 256, BK = 64, HALF = 128, HTB = HALF * BK * 2  , STAGE_BYTES = 8 * HTB, NXCD = 8, WGM = 8;

__host__ __device__ __forceinline__ int lds_byte(int r, int c) { const int st = (r >> 4) * 2 + (c >> 5), rr = r & 15, cc = c & 31, ob = rr * 64 + cc * 2; return st * 1024 + (ob ^ (((ob >> 9) & 1) << 5)); }
__host__ __device__ __forceinline__ void stage_rc(int b, int& R, int& C) { const int st = b / 1024, sb = b % 1024, swz = sb ^ (((sb >> 9) & 1) << 5); R = (st >> 1) * 16 + swz / 64; C = (st & 1) * 32 + (swz % 64) / 2; }
__host__ __device__ __forceinline__ int perm32(int rho) { const int n = rho >> 4, i = rho & 15; return 8 * (i >> 2) + 4 * n + (i & 3); }

struct Unit { int pm, pn, kt0, nt; };
struct Gemm { const bf16_t* A; const bf16_t* Bt; int M, N, K; };

struct StaticOrder {
    int nM, nN, nwg, G, c;
    __host__ __device__ __forceinline__ void init(int M, int N, int G_, int c_) { nM = M / BM; nN = N / BM; nwg = nM * nN; G = G_; c = c_; }
    __host__ __device__ __forceinline__ bool next(int i, Unit& u) const {
        const long L = (long)i * G + c; if (L >= nwg) return false;
        int wgid = (int)L; { const int q = nwg / NXCD, r = nwg % NXCD, xcd = wgid % NXCD, off = wgid / NXCD; wgid = (xcd < r ? xcd * (q + 1) : r * (q + 1) + (xcd - r) * q) + off; }
        const int nig = WGM * nN, gid = wgid / nig, fm = gid * WGM, gsz = (nM - fm) < WGM ? (nM - fm) : WGM;
        u.pm = fm + ((wgid % nig) % gsz); u.pn = (wgid % nig) / gsz; u.kt0 = 0; u.nt = 0; return true;
    }
    __device__ __forceinline__ void a_ready(const Unit&) const {}
    __device__ __forceinline__ void done(const Unit&) const {}
};

__device__ __forceinline__ unsigned cvt_pk_bf16(float lo, float hi) { unsigned r; asm volatile("v_cvt_pk_bf16_f32 %0, %1, %2" : "=v"(r) : "v"(lo), "v"(hi)); return r; }
struct EpiF32 {
    static constexpr bool PERM = true, AFTER_DRAIN = false;
    float* O; int ldc;
    __device__ __forceinline__ void operator()(const f32x4 (&acc)[2][2][4][2], const Unit& u, int wr, int wc, int fr, int fq) const {
        const int row0 = u.pm * BM + wr * 64 + fr; const int col0 = u.pn * BM + wc * 32 + 8 * fq;
#pragma unroll
        for (int ai = 0; ai < 2; ++ai)
#pragma unroll
            for (int m = 0; m < 4; ++m) { float* rowp = O + (size_t)(row0 + ai * HALF + m * 16) * ldc + col0;
#pragma unroll
                for (int bj = 0; bj < 2; ++bj) { *(f32x4*)(rowp + bj * HALF) = acc[ai][bj][m][0]; *(f32x4*)(rowp + bj * HALF + 4) = acc[ai][bj][m][1]; } }
    }
};

struct CmpOrder {
    int G, c;
    __device__ __forceinline__ bool next(int i, Unit& u) const { const int L = i * G + c; if (L >= 512) return false; u.pm = L; u.pn = L >> 6; u.kt0 = 0; u.nt = 0; return true; }
    __device__ __forceinline__ void a_ready(const Unit&) const {}
    __device__ __forceinline__ void done(const Unit&) const {}
};
struct EpiCmp {
    static constexpr bool PERM = true, AFTER_DRAIN = false;
    float* O;
    __device__ __forceinline__ void operator()(const f32x4 (&acc)[2][2][4][2], const Unit& u, int wr, int wc, int fr, int fq) const {
        const int row0 = u.pm * BM + wr * 64 + fr; const int col0 = wc * 32 + 8 * fq;
#pragma unroll
        for (int ai = 0; ai < 2; ++ai)
#pragma unroll
            for (int m = 0; m < 4; ++m) { float* rowp = O + (size_t)(row0 + ai * HALF + m * 16) * 256 + col0;
#pragma unroll
                for (int bj = 0; bj < 2; ++bj) { *(f32x4*)(rowp + bj * HALF) = acc[ai][bj][m][0]; *(f32x4*)(rowp + bj * HALF + 4) = acc[ai][bj][m][1]; } }
    }
};

struct EpiB16 {
    static constexpr bool PERM = true, AFTER_DRAIN = false;
    bf16_t* O; int ldc;
    __device__ __forceinline__ void operator()(const f32x4 (&acc)[2][2][4][2], const Unit& u, int wr, int wc, int fr, int fq) const {
        const int row0 = u.pm * BM + wr * 64 + fr; const int col0 = u.pn * BM + wc * 32 + 8 * fq;
#pragma unroll
        for (int ai = 0; ai < 2; ++ai)
#pragma unroll
            for (int m = 0; m < 4; ++m) { bf16_t* rowp = O + (size_t)(row0 + ai * HALF + m * 16) * ldc + col0;
#pragma unroll
                for (int bj = 0; bj < 2; ++bj) { const f32x4 v0 = acc[ai][bj][m][0], v1 = acc[ai][bj][m][1];
                    u32x4 w; w.x = cvt_pk_bf16(v0[0], v0[1]); w.y = cvt_pk_bf16(v0[2], v0[3]); w.z = cvt_pk_bf16(v1[0], v1[1]); w.w = cvt_pk_bf16(v1[2], v1[3]);
                    *(u32x4*)(rowp + bj * HALF) = w; } }
    }
};

struct TailSplitOrder {
    StaticOrder P; int nN, ntf, split;
    __device__ __forceinline__ void init(int Mp, int N, int K, int split_, int G, int c) { P.init(Mp, N, G, c); nN = N / BM; ntf = K / BK; split = split_; }
    __device__ __forceinline__ bool next(int i, Unit& u) const {
        const int L = i * P.G + P.c; const bool isp = L < P.nwg;
        int wgid = isp ? L : 0; { const int q = P.nwg / NXCD, r = P.nwg % NXCD, xcd = wgid % NXCD, off = wgid / NXCD; wgid = (xcd < r ? xcd * (q + 1) : r * (q + 1) + (xcd - r) * q) + off; }
        const int nig = WGM * P.nN, gid = wgid / nig, fm = gid * WGM, gsz = (P.nM - fm) < WGM ? (P.nM - fm) : WGM;
        const int ppm = fm + ((wgid % nig) % gsz), ppn = (wgid % nig) / gsz;
        const int t = L - P.nwg, nts = ntf / split;
        u.pm = isp ? ppm : P.nM; u.pn = isp ? ppn : t % nN; u.nt = isp ? 0 : nts; u.kt0 = isp ? 0 : (t / nN) * nts;
        return isp || t < nN * split;
    }
    __device__ __forceinline__ void a_ready(const Unit&) const {}
    __device__ __forceinline__ void done(const Unit&) const {}
};
struct EpiB16Split {
    static constexpr bool PERM = true, AFTER_DRAIN = false;
    bf16_t* O; float* S; int ldc; int tail_pm;
    __device__ __forceinline__ void operator()(const f32x4 (&acc)[2][2][4][2], const Unit& u, int wr, int wc, int fr, int fq) const {
        const int col0 = u.pn * BM + wc * 32 + 8 * fq;
        if (u.pm < tail_pm) {
            bf16_t* base = O + (size_t)(u.pm * BM + wr * 64 + fr) * ldc + col0;
#pragma unroll
            for (int ai = 0; ai < 2; ++ai)
#pragma unroll
                for (int m = 0; m < 4; ++m) { bf16_t* rowp = base + (size_t)(ai * HALF + m * 16) * ldc;
#pragma unroll
                    for (int bj = 0; bj < 2; ++bj) { const f32x4 v0 = acc[ai][bj][m][0], v1 = acc[ai][bj][m][1];
                        u32x4 w; w.x = cvt_pk_bf16(v0[0], v0[1]); w.y = cvt_pk_bf16(v0[2], v0[3]); w.z = cvt_pk_bf16(v1[0], v1[1]); w.w = cvt_pk_bf16(v1[2], v1[3]);
                        *(u32x4*)(rowp + bj * HALF) = w; } }
        } else {
            float* base = S + ((size_t)(u.kt0 / (u.nt ? u.nt : 1)) * BM + wr * 64 + fr) * ldc + col0;
#pragma unroll
            for (int ai = 0; ai < 2; ++ai)
#pragma unroll
                for (int m = 0; m < 4; ++m) { float* rowp = base + (size_t)(ai * HALF + m * 16) * ldc;
#pragma unroll
                    for (int bj = 0; bj < 2; ++bj) { *(f32x4*)(rowp + bj * HALF) = acc[ai][bj][m][0]; *(f32x4*)(rowp + bj * HALF + 4) = acc[ai][bj][m][1]; } }
        }
    }
};
struct EpiF32Split {
    static constexpr bool PERM = true, AFTER_DRAIN = false;
    float* O; float* S; int ldc; int tail_pm;
    __device__ __forceinline__ void operator()(const f32x4 (&acc)[2][2][4][2], const Unit& u, int wr, int wc, int fr, int fq) const {
        const int col0 = u.pn * BM + wc * 32 + 8 * fq;
        float* base = (u.pm < tail_pm) ? O + (size_t)(u.pm * BM + wr * 64 + fr) * ldc : S + ((size_t)(u.kt0 / (u.nt ? u.nt : 1)) * BM + wr * 64 + fr) * ldc;
#pragma unroll
        for (int ai = 0; ai < 2; ++ai)
#pragma unroll
            for (int m = 0; m < 4; ++m) { float* rowp = base + (size_t)(ai * HALF + m * 16) * ldc + col0;
#pragma unroll
                for (int bj = 0; bj < 2; ++bj) { *(f32x4*)(rowp + bj * HALF) = acc[ai][bj][m][0]; *(f32x4*)(rowp + bj * HALF + 4) = acc[ai][bj][m][1]; } }
    }
};

__device__ __forceinline__ float dpp_ror1(float v) { return __builtin_bit_cast(float, __builtin_amdgcn_update_dpp(0, __builtin_bit_cast(int, v), 0x121, 0xf, 0xf, false)); }
__device__ __forceinline__ float dpp_ror2(float v) { return __builtin_bit_cast(float, __builtin_amdgcn_update_dpp(0, __builtin_bit_cast(int, v), 0x122, 0xf, 0xf, false)); }
__device__ __forceinline__ float dpp_shr1(float old, float v) { return __builtin_bit_cast(float, __builtin_amdgcn_update_dpp(__builtin_bit_cast(int, old), __builtin_bit_cast(int, v), 0x111, 0xf, 0xf, false)); }
__device__ __forceinline__ float dpp_shr2(float old, float v) { return __builtin_bit_cast(float, __builtin_amdgcn_update_dpp(__builtin_bit_cast(int, old), __builtin_bit_cast(int, v), 0x112, 0xf, 0xf, false)); }
__device__ __forceinline__ float gelu_t(float x) {
    const float p = x * __builtin_fmaf(x * x, 0.044715f * 2.302208198f, 2.302208198f);
    return x * __builtin_amdgcn_rcpf(1.f + __builtin_amdgcn_exp2f(-p));
}
struct EpiFfn {
    static constexpr bool PERM = true, AFTER_DRAIN = false;
    bf16_t* ACT;
    float* RAW;
    float* HALO;
    float* LAST;
    const float* cw; const float* cb;
    PG8_LAS float* xb;
    int tail_pm;
    __device__ __forceinline__ void operator()(const f32x4 (&acc)[2][2][4][2], const Unit& u, int wr, int wc, int fr_in, int fq_in) const {
        int fr = fr_in, fq = fq_in; asm volatile("" : "+v"(fr), "+v"(fq));
        const int colt = wc * 32 + 8 * fq, gcol = u.pn * 128 + colt;
        const bool tail = (u.pm >= tail_pm);
#pragma unroll
        for (int ai = 0; ai < 2; ++ai) {
            if (fr >= 14) { PG8_LAS float* d = xb + ((ai * 2 + wr) * 2 + (fr - 14)) * 128 + colt;
                *(PG8_LAS f32x4*)d = acc[ai][0][3][0]; *(PG8_LAS f32x4*)(d + 4) = acc[ai][0][3][1]; }
        }
        if (!tail) {
            if (wr == 1 && fr >= 14) { float* d = LAST + ((size_t)u.pm * 2 + (fr - 14)) * 4096 + gcol; *(f32x4*)d = acc[1][0][3][0]; *(f32x4*)(d + 4) = acc[1][0][3][1]; }
            if (wr == 0 && fr < 2) { float* d = HALO + ((size_t)u.pm * 2 + fr) * 8192 + gcol;
                *(f32x4*)d = acc[0][0][0][0]; *(f32x4*)(d + 4) = acc[0][0][0][1]; *(f32x4*)(d + 4096) = acc[0][1][0][0]; *(f32x4*)(d + 4096 + 4) = acc[0][1][0][1]; }
        } else {
#pragma unroll
            for (int ai = 0; ai < 2; ++ai)
#pragma unroll
                for (int m = 0; m < 4; ++m) { float* d = RAW + ((size_t)(u.kt0 / (u.nt ? u.nt : 1)) * BM + ai * HALF + wr * 64 + m * 16 + fr) * 8192 + gcol;
                    *(f32x4*)d = acc[ai][0][m][0]; *(f32x4*)(d + 4) = acc[ai][0][m][1]; *(f32x4*)(d + 4096) = acc[ai][1][m][0]; *(f32x4*)(d + 4096 + 4) = acc[ai][1][m][1]; }
        }
        asm volatile("s_waitcnt lgkmcnt(0)" ::: "memory");
        __builtin_amdgcn_s_barrier();
        if (tail) return;
#pragma unroll
        for (int n = 0; n < 2; ++n) {
            const f32x4 w0 = *(const f32x4*)(cw + gcol + 4 * n), w1 = *(const f32x4*)(cw + 4096 + gcol + 4 * n), w2 = *(const f32x4*)(cw + 8192 + gcol + 4 * n), bb = *(const f32x4*)(cb + gcol + 4 * n);
#pragma unroll
            for (int ai = 0; ai < 2; ++ai) {
                const int pgrp = (wr == 1) ? (ai * 2 + 0) : (0 * 2 + 1);
                const f32x4 pv = *(const PG8_LAS f32x4*)(xb + (pgrp * 2 + (fr == 15 ? 1 : 0)) * 128 + colt + 4 * n);
#pragma unroll
                for (int m = 0; m < 4; ++m) {
                    float a4[4];
#pragma unroll
                    for (int k = 0; k < 4; ++k) {
                        const float cur = acc[ai][0][m][n][k]; const float prm = (m > 0) ? acc[ai][0][m > 0 ? m - 1 : 0][n][k] : pv[k];
                        const float p1 = dpp_shr1(dpp_ror1(prm), cur), p2 = dpp_shr2(dpp_ror2(prm), cur);
                        const float pre = w0[k] * p2 + w1[k] * p1 + w2[k] * cur + bb[k];
                        a4[k] = gelu_t(pre) * acc[ai][1][m][n][k];
                    }
                    const bool deferred = (ai == 0 && wr == 0 && m == 0 && fr < 2);
                    if (!deferred) *(unsigned long long*)(ACT + (size_t)(u.pm * BM + ai * HALF + wr * 64 + m * 16 + fr) * 4096 + gcol + 4 * n) =
                        (unsigned long long)cvt_pk_bf16(a4[0], a4[1]) | ((unsigned long long)cvt_pk_bf16(a4[2], a4[3]) << 32);
                }
            }
        }
    }
};
template <class Epi, class Sched, bool ALIGN_EPI = false, bool SP2 = false>
__device__ __forceinline__ void gemm_phase(PG8_LAS unsigned char* lds, const Gemm g, const Sched& S, const Epi& E, const int tid_in) {
    int tid_ = tid_in; asm volatile("" : "+v"(tid_));
    const int tid = tid_, wid = __builtin_amdgcn_readfirstlane(tid >> 6), lane = tid & 63, wr = wid >> 2, wc = wid & 3, fr = lane & 15, fq = lane >> 4;
    const int K = g.K, ntf = K / BK;
    unsigned voffA[2], voffB[2];
#pragma unroll
    for (int i = 0; i < 2; ++i) { int R, C; stage_rc(tid * 16 + i * 8192, R, C); const int Rb = Epi::PERM ? ((R & ~31) + perm32(R & 31)) : R;
        voffA[i] = (unsigned)(R * K + C) * 2u; voffB[i] = (unsigned)(Rb * K + C) * 2u; }
    const size_t kstep = (size_t)(BK * 2);
    const size_t hstep = (size_t)HALF * K * 2;
    const size_t tstep = 2 * hstep;
    const unsigned ldsw = (unsigned)wid * 1024u;
    const int aoff = lds_byte(wr * 64 + fr, fq * 8), boff = lds_byte(wc * 32 + fr, fq * 8);
#define PG8_SA(b, h) (((b) * 2 + (h)) * HTB)
#define PG8_SB(b, h) ((4 + (b) * 2 + (h)) * HTB)
#define PG8_STAGE(bufoff, gbase, voff) do { _Pragma("unroll") for (int _i = 0; _i < 2; ++_i) \
        __builtin_amdgcn_global_load_lds((const unsigned*)((const char*)(gbase) + (voff)[_i]), (PG8_LAS unsigned*)(lds + (bufoff) + ldsw + _i * 8192), 16, 0, 0); } while (0)
#define PG8_LDA(dst, b, h) do { _Pragma("unroll") for (int m = 0; m < 4; ++m) _Pragma("unroll") for (int k = 0; k < 2; ++k) dst[m][k] = *(const PG8_LAS bf16x8*)(lds + PG8_SA(b, h) + aoff + m * 2048 + k * 1024); } while (0)
#define PG8_LDB(dst, b, h) do { _Pragma("unroll") for (int n = 0; n < 2; ++n) _Pragma("unroll") for (int k = 0; k < 2; ++k) dst[n][k] = *(const PG8_LAS bf16x8*)(lds + PG8_SB(b, h) + boff + n * 2048 + k * 1024); } while (0)
#define PG8_MMA(ai, bj, At, Bt) do { __builtin_amdgcn_s_setprio(1); _Pragma("unroll") for (int m = 0; m < 4; ++m) _Pragma("unroll") for (int n = 0; n < 2; ++n) _Pragma("unroll") for (int k = 0; k < 2; ++k) \
        acc[ai][bj][m][n] = __builtin_amdgcn_mfma_f32_16x16x32_bf16(Bt[n][k], At[m][k], acc[ai][bj][m][n], 0, 0, 0); __builtin_amdgcn_s_setprio(0); } while (0)
#define PG8_WAIT_V(n) asm volatile("s_waitcnt vmcnt(" #n ")" ::: "memory")
#define PG8_WAIT_L(n) asm volatile("s_waitcnt lgkmcnt(" #n ")" ::: "memory")
#define PG8_BAR __builtin_amdgcn_s_barrier()
#define PG8_SCHED __builtin_amdgcn_sched_barrier(0)
    Unit cur = {0, 0, 0, 0}, nxt = {0, 0, 0, 0}; int ui = 0;
    if (!S.next(0, cur)) return;
    f32x4 acc[2][2][4][2];
#pragma unroll
    for (int a = 0; a < 2; ++a)
#pragma unroll
        for (int b = 0; b < 2; ++b)
#pragma unroll
            for (int m = 0; m < 4; ++m)
#pragma unroll
                for (int n = 0; n < 2; ++n) acc[a][b][m][n] = (f32x4){0.f, 0.f, 0.f, 0.f};
    bf16x8 At[4][2], B0[2][2], B1[2][2];
    const char* cA = (const char*)g.A + (size_t)cur.pm * tstep + (size_t)cur.kt0 * kstep; const char* cB = (const char*)g.Bt + (size_t)cur.pn * tstep + (size_t)cur.kt0 * kstep;
    S.a_ready(cur);
    if constexpr (SP2) {
        PG8_STAGE(PG8_SB(0, 0), cB, voffB); PG8_STAGE(PG8_SB(0, 1), cB + hstep, voffB); PG8_STAGE(PG8_SA(0, 0), cA, voffA); PG8_STAGE(PG8_SA(0, 1), cA + hstep, voffA);
        if (wr == 1) PG8_BAR;
        PG8_WAIT_V(2); PG8_BAR;
        PG8_STAGE(PG8_SB(1, 0), cB + kstep, voffB); PG8_STAGE(PG8_SA(1, 0), cA + kstep, voffA); PG8_STAGE(PG8_SB(1, 1), cB + hstep + kstep, voffB);
        PG8_WAIT_V(6); PG8_BAR;
    } else {
        PG8_STAGE(PG8_SB(0, 0), cB, voffB); PG8_STAGE(PG8_SA(0, 0), cA, voffA); PG8_STAGE(PG8_SB(0, 1), cB + hstep, voffB); PG8_STAGE(PG8_SA(0, 1), cA + hstep, voffA);
        if (wr == 1) PG8_BAR;
        PG8_WAIT_V(4); PG8_BAR;
        PG8_STAGE(PG8_SB(1, 0), cB + kstep, voffB); PG8_STAGE(PG8_SA(1, 0), cA + kstep, voffA); PG8_STAGE(PG8_SB(1, 1), cB + hstep + kstep, voffB);
        PG8_WAIT_V(6); PG8_BAR;
    }
    for (;;) {
        const bool has_next = S.next(ui + 1, nxt);
        const char* nA = has_next ? (const char*)g.A + (size_t)nxt.pm * tstep + (size_t)nxt.kt0 * kstep : cA; const char* nB = has_next ? (const char*)g.Bt + (size_t)nxt.pn * tstep + (size_t)nxt.kt0 * kstep : cB;
        const int nt = cur.nt ? cur.nt : ntf;
        for (int t = 0; t < nt; t += 2) {
            const bool last = (t == nt - 2);
            const char* a1 = cA + (size_t)(t + 1) * kstep;
            const char* a2 = last ? nA : cA + (size_t)(t + 2) * kstep; const char* b2 = last ? nB : cB + (size_t)(t + 2) * kstep;
            const char* a3 = a2 + kstep; const char* b3 = b2 + kstep;
            if (last && has_next) S.a_ready(nxt);
            if constexpr (SP2) {
            PG8_LDB(B0, 0, 0); PG8_LDB(B1, 0, 1); PG8_SCHED; PG8_LDA(At, 0, 0); PG8_STAGE(PG8_SA(1, 1), a1 + hstep, voffA);
            PG8_WAIT_V(8); PG8_WAIT_L(0); PG8_BAR; PG8_MMA(0, 0, At, B0); PG8_MMA(0, 1, At, B1); PG8_BAR; PG8_SCHED;
            PG8_LDA(At, 0, 1); PG8_STAGE(PG8_SB(0, 0), b2, voffB); PG8_STAGE(PG8_SB(0, 1), b2 + hstep, voffB); PG8_STAGE(PG8_SA(0, 0), a2, voffA);
            PG8_WAIT_V(8); PG8_WAIT_L(0); PG8_BAR; PG8_MMA(1, 0, At, B0); PG8_MMA(1, 1, At, B1); PG8_BAR; PG8_SCHED;
            PG8_LDB(B0, 1, 0); PG8_LDB(B1, 1, 1); PG8_SCHED; PG8_LDA(At, 1, 0); PG8_STAGE(PG8_SA(0, 1), a2 + hstep, voffA);
            PG8_WAIT_V(8); PG8_WAIT_L(0); PG8_BAR; PG8_MMA(0, 0, At, B0); PG8_MMA(0, 1, At, B1); PG8_BAR; PG8_SCHED;
            PG8_LDA(At, 1, 1); PG8_STAGE(PG8_SB(1, 0), b3, voffB); PG8_STAGE(PG8_SB(1, 1), b3 + hstep, voffB); PG8_STAGE(PG8_SA(1, 0), a3, voffA);
            PG8_WAIT_V(8); PG8_WAIT_L(0); PG8_BAR; PG8_MMA(1, 0, At, B0); PG8_MMA(1, 1, At, B1); PG8_BAR; PG8_SCHED;
            } else {
            PG8_LDB(B0, 0, 0); PG8_SCHED; PG8_LDA(At, 0, 0); PG8_STAGE(PG8_SA(1, 1), a1 + hstep, voffA);
            PG8_WAIT_L(8); PG8_BAR; PG8_WAIT_L(0); PG8_MMA(0, 0, At, B0); PG8_BAR; PG8_SCHED;
            PG8_LDB(B1, 0, 1); PG8_STAGE(PG8_SB(0, 0), b2, voffB);
            PG8_BAR; PG8_WAIT_L(0); PG8_MMA(0, 1, At, B1); PG8_BAR;
            PG8_LDA(At, 0, 1); PG8_STAGE(PG8_SA(0, 0), a2, voffA);
            PG8_BAR; PG8_WAIT_L(0); PG8_MMA(1, 0, At, B0); PG8_BAR; PG8_SCHED;
            PG8_STAGE(PG8_SB(0, 1), b2 + hstep, voffB);
            PG8_WAIT_V(6); PG8_BAR; PG8_MMA(1, 1, At, B1); PG8_BAR;
            PG8_LDB(B0, 1, 0); PG8_SCHED; PG8_LDA(At, 1, 0); PG8_STAGE(PG8_SA(0, 1), a2 + hstep, voffA);
            PG8_WAIT_L(8); PG8_BAR; PG8_WAIT_L(0); PG8_MMA(0, 0, At, B0); PG8_BAR; PG8_SCHED;
            PG8_LDB(B1, 1, 1); PG8_STAGE(PG8_SB(1, 0), b3, voffB);
            PG8_BAR; PG8_WAIT_L(0); PG8_MMA(0, 1, At, B1); PG8_BAR;
            PG8_LDA(At, 1, 1); PG8_STAGE(PG8_SA(1, 0), a3, voffA);
            PG8_BAR; PG8_WAIT_L(0); PG8_MMA(1, 0, At, B0); PG8_BAR; PG8_SCHED;
            PG8_STAGE(PG8_SB(1, 1), b3 + hstep, voffB);
            PG8_WAIT_V(6); PG8_BAR; PG8_MMA(1, 1, At, B1); PG8_BAR;
            }
        }
        if constexpr (ALIGN_EPI) { if (wr == 0) PG8_BAR; }
        if constexpr (!Epi::AFTER_DRAIN) { E(acc, cur, wr, wc, fr, fq); S.done(cur); }
        if (!has_next) break;
#pragma unroll
        for (int a = 0; a < 2; ++a)
#pragma unroll
            for (int b = 0; b < 2; ++b)
#pragma unroll
                for (int m = 0; m < 4; ++m)
#pragma unroll
                    for (int n = 0; n < 2; ++n) acc[a][b][m][n] = (f32x4){0.f, 0.f, 0.f, 0.f};
        cur = nxt; cA = nA; cB = nB; ++ui;
        if constexpr (ALIGN_EPI) { if (wr == 1) PG8_BAR; }
    }
    PG8_WAIT_V(0);
    if constexpr (!ALIGN_EPI) { if (wr == 0) PG8_BAR; }
    PG8_BAR;
    if constexpr (Epi::AFTER_DRAIN) { E.fused(acc, cur, wr, wc, fr, fq, lds, wid, lane); S.done(cur); }
#undef PG8_SA
#undef PG8_SB
#undef PG8_STAGE
#undef PG8_LDA
#undef PG8_LDB
#undef PG8_MMA
#undef PG8_WAIT_V
#undef PG8_WAIT_L
#undef PG8_BAR
#undef PG8_SCHED
}
}

#define GAS __attribute__((address_space(1)))
#define LAS __attribute__((address_space(3)))
typedef unsigned short bf16;
typedef unsigned v4u __attribute__((ext_vector_type(4)));
typedef float f32x4 __attribute__((ext_vector_type(4)));
typedef short bf16x8 __attribute__((ext_vector_type(8)));

constexpr int DM = 1024, BP = 8, TP = 2048, DEPTH = 4, BS = 32, TS = 8, PAST = 8192, PAGE = 128;
constexpr int NP = BP * TP, NS = BS * TS, MROWS = NP + NS;
constexpr int NSEQ = BP + BS;
constexpr int SSD_W = 512, SSD_H = 8, SSD_HD = 64, SSD_N = 128, CONV_DIM = 1024;
constexpr int POOL_W = 256, POOL_KEEP = 15;
constexpr int NSA_H = 4, NSA_HD = 64;
constexpr int OFF_XBC = 512, OFF_DT = 1536, OFF_POOL = 1544, OFF_Q = 1800, OFF_KV = 2056, OFF_G = 2440, IN_W = 2452, IN_WP = 2560;
constexpr int DFF = 4096;
constexpr int NPHYS = 2560, NPAGES = 64;
constexpr int NCMP_P = 127, NCMP_S = 511;
constexpr float RMS_EPS = 1e-6f;

constexpr size_t O_YP = 0;
constexpr size_t O_YS = O_YP + (size_t)NP * DM;
constexpr size_t O_KVP = O_YS + (size_t)NS * DM;
constexpr size_t O_KVS = O_KVP + (size_t)DEPTH * NP * 256;
constexpr size_t O_WINP = O_KVS + (size_t)DEPTH * NS * 256;
constexpr size_t O_WINS = O_WINP + (size_t)DEPTH * BP * 512 * 128;
constexpr size_t O_CONVP = O_WINS + (size_t)DEPTH * BS * 512 * 128;
constexpr size_t O_CONVS = O_CONVP + (size_t)DEPTH * BP * 3 * 1024;
constexpr size_t O_SSMP = O_CONVS + (size_t)DEPTH * BS * 3 * 1024;
constexpr size_t O_SSMS = O_SSMP + (size_t)DEPTH * BP * 8 * 64 * 128;
constexpr size_t O_POOLP = O_SSMS + (size_t)DEPTH * BS * 8 * 64 * 128;
constexpr size_t O_POOLS = O_POOLP + (size_t)DEPTH * BP * 15 * 256;
constexpr size_t O_FFNP = O_POOLS + (size_t)DEPTH * BS * 15 * 256;
constexpr size_t O_FFNS = O_FFNP + (size_t)DEPTH * BP * 2 * 4096;
constexpr size_t O_END = O_FFNS + (size_t)DEPTH * BS * 2 * 4096;

enum { I_XP = 0, I_XS, I_CACHE, I_PT, I_SWIN, I_SCONV, I_SSM, I_SPOOL, I_SFFN, I_NMPRE, I_WIN, I_CONVW, I_CONVB, I_DTB, I_ALOG, I_SSDD, I_SSDNORM,
       I_POOLW, I_POOLSC, I_PEK, I_PEV, I_W1K, I_W1V, I_W2K, I_W2V, I_WOUT, I_NMPOST, I_NFPRE, I_WGATE, I_WVAL, I_FCW, I_FCB, I_WDOWN, I_NFPOST, N_IN };

constexpr size_t al256(size_t x) { return (x + 255) & ~(size_t)255; }
constexpr size_t WS_CTL = 0, CTL_BYTES = 1u << 20;
constexpr size_t WS_WTIN = WS_CTL + CTL_BYTES;
constexpr size_t WS_WTOUT = WS_WTIN + (size_t)DEPTH * IN_WP * DM * 2;
constexpr size_t WS_WTUP = WS_WTOUT + (size_t)DEPTH * DM * DM * 2;
constexpr size_t WS_WTDN = WS_WTUP + (size_t)DEPTH * 2 * DFF * DM * 2;
constexpr size_t WS_ROPE = WS_WTDN + (size_t)DEPTH * DM * DFF * 2;
constexpr size_t WS_X = WS_ROPE + al256((size_t)2056 * 16 * 4);
constexpr size_t WS_XN = WS_X + (size_t)MROWS * DM * 4;
constexpr size_t WS_PROJ = WS_XN + (size_t)MROWS * DM * 2;
constexpr size_t WS_YSSD = WS_PROJ + (size_t)MROWS * IN_WP * 4;
constexpr size_t WS_Q = WS_YSSD + (size_t)MROWS * SSD_W * 4;
constexpr size_t WS_KWIN = WS_Q + (size_t)MROWS * 256 * 4;
constexpr size_t WS_CKP = WS_KWIN + (size_t)MROWS * 128 * 4;
constexpr size_t WS_CVP = WS_CKP + al256((size_t)BP * NCMP_P * 64 * 4);
constexpr size_t WS_CKS = WS_CVP + al256((size_t)BP * NCMP_P * 64 * 4);
constexpr size_t WS_CVS = WS_CKS + al256((size_t)DEPTH * BS * NCMP_S * 64 * 4);
constexpr size_t WS_MIX = WS_CVS + al256((size_t)DEPTH * BS * NCMP_S * 64 * 4);
constexpr size_t WS_MIXO = WS_MIX + (size_t)MROWS * DM * 2;
constexpr size_t WS_GV = WS_MIXO + (size_t)MROWS * DM * 4;
constexpr size_t WS_ACT = WS_GV + (size_t)MROWS * 2 * DFF * 4;
constexpr size_t WS_QB = WS_ACT + (size_t)MROWS * DFF * 2;
constexpr size_t WS_SAC = WS_QB + (size_t)MROWS * 256 * 2;
constexpr size_t WS_SCD = WS_SAC + (size_t)NP * 8 * 4;
constexpr size_t WS_SCB = WS_SCD + al256((size_t)BP * 16 * 8 * 4);
constexpr size_t WS_SCS = WS_SCB + (size_t)NP * 256 * 2;
constexpr size_t WS_SHS = WS_SCS + (size_t)BP * 16 * 8 * 8192 * 4;
constexpr size_t WS_WTC = WS_SHS + (size_t)BP * 16 * 8 * 8192 * 2;
constexpr size_t WS_CBIAS = WS_WTC + (size_t)8 * 256 * 1024 * 2;
constexpr size_t WS_AS = WS_GV;
constexpr size_t WS_HS = WS_AS + (size_t)8 * BS * 512 * 1024 * 2;
static_assert(WS_HS + (size_t)8 * BS * 512 * 256 * 4 <= WS_GV + (size_t)MROWS * 2 * DFF * 4, "prologue buffers must fit inside the GV region");
constexpr size_t WS_SLAB = WS_CBIAS + 8 * 128 * 4;
constexpr size_t WS_W2T = WS_SLAB + (size_t)8 * 256 * DM * 4;
constexpr size_t WS_FRAW = WS_W2T + (size_t)8 * 64 * 128 * 2;
constexpr int SPLIT_UP = 1;
constexpr size_t WS_FHALO = WS_FRAW + (size_t)SPLIT_UP * 256 * 2 * DFF * 4;
constexpr size_t WS_FLAST = WS_FHALO + (size_t)64 * 2 * 2 * DFF * 4;
constexpr size_t WS_END = WS_FLAST + (size_t)64 * 2 * DFF * 4;
constexpr int SPLIT_OUT = 4, SPLIT_DOWN = 8;

constexpr int RING_BYTES = 131072;
constexpr int MISC_OFF = RING_BYTES + 320;
constexpr int LDS_BYTES = 147456;
constexpr int NWAVES = 8, NTHR = 512;
constexpr int XB_OFF = RING_BYTES + 1024;
static_assert(XB_OFF + 4096 <= LDS_BYTES, "LDS map");

constexpr int PH_PER_LAYER = 10, N_PRO = 3, N_PHASES = N_PRO + DEPTH * PH_PER_LAYER;

struct Params { const float* in[N_IN]; float* out; unsigned char* ws; int ph_lo, ph_hi; };

__device__ __forceinline__ unsigned f2bf(float f) { unsigned u = __builtin_bit_cast(unsigned, f); return (u + 0x7fffu + ((u >> 16) & 1u)) >> 16; }
__device__ __forceinline__ unsigned pk2(float lo, float hi) { return f2bf(lo) | (f2bf(hi) << 16); }
__device__ __forceinline__ f32x4 bf4_to_f32(unsigned long long u) {
    return (f32x4){__uint_as_float((unsigned)u << 16), __uint_as_float((unsigned)u & 0xffff0000u), __uint_as_float((unsigned)(u >> 32) << 16), __uint_as_float((unsigned)(u >> 32) & 0xffff0000u)};
}
__device__ __forceinline__ float wave_sum(float v) {
#pragma unroll
    for (int o = 1; o < 64; o <<= 1) v += __shfl_xor(v, o);
    return v;
}
__device__ __forceinline__ float sum16(float v) {
#pragma unroll
    for (int o = 1; o < 16; o <<= 1) v += __shfl_xor(v, o);
    return v;
}
__device__ __forceinline__ float sigmoidf_(float x) { return 1.f / (1.f + expf(-x)); }
__device__ __forceinline__ float siluf_(float x) { return x / (1.f + expf(-x)); }
__device__ __forceinline__ float softplusf_(float x) { return x > 0.f ? x + log1pf(expf(-x)) : log1pf(expf(x)); }
__device__ __forceinline__ float gelu_tanh(float x) {
    const float u = 0.7978845608028654f * (x + 0.044715f * x * x * x);
    const float t = 1.f - 2.f / (expf(2.f * u) + 1.f);
    return 0.5f * x * (1.f + t);
}
__device__ __forceinline__ void cossin_d(float angf, float& c, float& s) {
    const double a = (double)angf;
    const double k = rint(a * 0.63661977236758134308);
    const double r = (a - k * 1.57079632679489655800) - k * 6.123233995736766036e-17;
    const double r2 = r * r;
    double sp = r * (1.0 + r2 * (-1.0 / 6 + r2 * (1.0 / 120 + r2 * (-1.0 / 5040 + r2 * (1.0 / 362880 + r2 * (-1.0 / 39916800 + r2 * (1.0 / 6227020800.0)))))));
    double cp = 1.0 + r2 * (-0.5 + r2 * (1.0 / 24 + r2 * (-1.0 / 720 + r2 * (1.0 / 40320 + r2 * (-1.0 / 3628800 + r2 * (1.0 / 479001600.0 + r2 * (-1.0 / 87178291200.0)))))));
    const int q = ((int)k) & 3;
    double cc = (q == 0) ? cp : (q == 1) ? -sp : (q == 2) ? -cp : sp;
    double ss = (q == 0) ? sp : (q == 1) ? cp : (q == 2) ? -sp : -cp;
    c = (float)cc; s = (float)ss;
}

struct Seq { int T, row0, pos0, b, samp; };
__device__ __forceinline__ Seq seq_of(int s) {
    Seq q;
    if (s < BP) { q.T = TP; q.row0 = s * TP; q.pos0 = 0; q.b = s; q.samp = 0; }
    else { q.T = TS; q.row0 = NP + (s - BP) * TS; q.pos0 = PAST; q.b = s - BP; q.samp = 1; }
    return q;
}
__device__ __forceinline__ void row_to_seq(int r, int& s, int& t) {
    if (r < NP) { s = r >> 11; t = r & (TP - 1); } else { const int q = r - NP; s = BP + (q >> 3); t = q & 7; }
}

#define XB_TMO      128
#define XB_XCNT(j)  (256  + 64 * (j))
#define XB_XSUB(j)  (1280 + 64 * (j))
#define XB_XGEN(j)  (2304 + 64 * (j))
#define XB_TOP      3328
#define XB_TOPGEN   3392
#define XCD_BAR_WORDS 3456
#define XB_SPIN_CAP (1u << 21)
__device__ __forceinline__ unsigned xb_ld(unsigned* p)              { return __hip_atomic_load(p, __ATOMIC_RELAXED, __HIP_MEMORY_SCOPE_AGENT); }
__device__ __forceinline__ unsigned xb_add(unsigned* p, unsigned v) { return __hip_atomic_fetch_add(p, v, __ATOMIC_RELAXED, __HIP_MEMORY_SCOPE_AGENT); }
__device__ __forceinline__ unsigned xb_xcc_id() { return (unsigned)__builtin_amdgcn_s_getreg((3 << 11) | 20) & 0xFu; }
#define XB_SPIN(cond, bar) do { unsigned _sp = 0; while (cond) { __builtin_amdgcn_s_sleep(1); \
    if ((++_sp & 255u) == 0u) { if (xb_ld(&(bar)[XB_TMO])) break; if (_sp > XB_SPIN_CAP) { atomicAdd(&(bar)[XB_TMO], 1u); break; } } } } while (0)
struct XcdBarrier { unsigned* bar; unsigned x; volatile LAS unsigned* st; };
__device__ __forceinline__ XcdBarrier xcd_barrier_post(unsigned* bar, volatile LAS unsigned* st) {
    XcdBarrier b; b.bar = bar; b.x = xb_xcc_id(); b.st = st;
    if (threadIdx.x == 0) (void)xb_add(&bar[XB_XCNT(b.x)], 1u);
    return b;
}
__device__ __forceinline__ void xcd_barrier_complete(unsigned* bar, unsigned x, unsigned& nloc, unsigned& nx) {
    const unsigned G = gridDim.x * gridDim.y * gridDim.z;
    unsigned sum, cnt, mine, sp = 0u;
    for (;;) {
        sum = 0u; cnt = 0u; mine = 0u;
#pragma unroll
        for (unsigned j = 0; j < 16; ++j) { const unsigned c = xb_ld(&bar[XB_XCNT(j)]); sum += c; cnt += (c > 0u) ? 1u : 0u; mine = (j == x) ? c : mine; }
        if (sum == G) break;
        __builtin_amdgcn_s_sleep(1);
        if ((++sp & 255u) == 0u) { if (xb_ld(&bar[XB_TMO])) break; if (sp > XB_SPIN_CAP) { atomicAdd(&bar[XB_TMO], 1u); break; } }
    }
    nloc = mine > 0u ? mine : 1u; nx = cnt > 0u ? cnt : 1u;
}
__device__ __forceinline__ void xcd_barrier(const XcdBarrier& b, const bool lead) {
    asm volatile("s_waitcnt vmcnt(0)" ::: "memory");
    __syncthreads();
    if (lead) {
        unsigned* bar = b.bar;
        __builtin_amdgcn_s_waitcnt(0);
        unsigned nloc = b.st[0], nx = b.st[1];
        if (nloc == 0u) { xcd_barrier_complete(bar, b.x, nloc, nx); b.st[0] = nloc; b.st[1] = nx; }
        const unsigned old = xb_add(&bar[XB_XSUB(b.x)], 1u);
        const unsigned gen = old / nloc;
        if (old + 1u == (gen + 1u) * nloc) {
            __builtin_amdgcn_fence(__ATOMIC_RELEASE, "agent");
            asm volatile("s_waitcnt vmcnt(0)" ::: "memory");
            const unsigned og = xb_add(&bar[XB_TOP], 1u);
            const unsigned tg = og / nx;
            if (og + 1u == (tg + 1u) * nx) xb_add(&bar[XB_TOPGEN], 1u);
            else XB_SPIN(xb_ld(&bar[XB_TOPGEN]) == tg, bar);
            __builtin_amdgcn_fence(__ATOMIC_ACQUIRE, "agent");
            xb_add(&bar[XB_XGEN(b.x)], 1u);
            asm volatile("s_waitcnt vmcnt(0)" ::: "memory");
        } else {
            XB_SPIN(xb_ld(&bar[XB_XGEN(b.x)]) == gen, bar);
            __builtin_amdgcn_fence(__ATOMIC_ACQUIRE, "agent");
            asm volatile("s_waitcnt vmcnt(0)" ::: "memory");
        }
    }
    __syncthreads();
}

struct Frame {
    LAS unsigned char* lds;
    int tid, lane, wave, gw, ngw, G;
    const __attribute__((address_space(4))) Params* p;
    unsigned char* ws;
    float* out;
};
#define INP(F, i) ((F).p->in[(i)])
#define WSP(F, T, off) ((T*)((F).ws + (off)))

__device__ __forceinline__ const float* x_in_row(const Frame& F, int r) {
    return r < NP ? INP(F, I_XP) + (size_t)r * DM : INP(F, I_XS) + (size_t)(r - NP) * DM;
}

template <bool ILV = false>
__device__ __forceinline__ void transpose_item(const float* W, int K, int N, int nblk, bf16* WT, int row_off, LAS float* scr, int item, int lane) {
    const int kb = item / nblk, nb = item % nblk, k0 = 64 * kb, n0 = 32 * nb;
    const int r0 = ILV ? 256 * (n0 >> 7) + (n0 & 127) : n0;
    const int n = n0 + (lane & 31);
    float tv[32];
#pragma unroll
    for (int i = 0; i < 32; ++i) { const int kk = 2 * i + (lane >> 5); tv[i] = (n < N) ? W[(size_t)(k0 + kk) * N + n] : 0.f; }
#pragma unroll
    for (int i = 0; i < 32; ++i) { const int kk = 2 * i + (lane >> 5); scr[kk * 33 + (lane & 31)] = tv[i]; }
    asm volatile("s_waitcnt lgkmcnt(0)" ::: "memory");
    const int c = lane & 7;
#pragma unroll
    for (int j = 0; j < 4; ++j) { const int nn = (lane >> 3) + 8 * j; const LAS float* s = scr + (8 * c) * 33 + nn;
        v4u o; o.x = pk2(s[0 * 33], s[1 * 33]); o.y = pk2(s[2 * 33], s[3 * 33]); o.z = pk2(s[4 * 33], s[5 * 33]); o.w = pk2(s[6 * 33], s[7 * 33]);
        *(v4u*)(WT + (size_t)(row_off + r0 + nn) * K + k0 + 8 * c) = o; }
    asm volatile("s_waitcnt lgkmcnt(0)" ::: "memory");
}
__device__ __forceinline__ void norm_row_to_bf16(const Frame& F, const float* xrow, const float* w, bf16* orow) {
    const f32x4* xr = (const f32x4*)xrow + F.lane; const f32x4* wr = (const f32x4*)w + F.lane;
    f32x4 v[4]; float ss = 0.f;
#pragma unroll
    for (int j = 0; j < 4; ++j) { v[j] = xr[64 * j]; ss += (v[j].x * v[j].x + v[j].y * v[j].y) + (v[j].z * v[j].z + v[j].w * v[j].w); }
    const float rs = 1.f / sqrtf(wave_sum(ss) * (1.f / DM) + RMS_EPS);
    unsigned long long* o8 = (unsigned long long*)orow + F.lane;
#pragma unroll
    for (int j = 0; j < 4; ++j) { const f32x4 g = wr[64 * j];
        o8[64 * j] = (unsigned long long)pk2(v[j].x * rs * g.x, v[j].y * rs * g.y) | ((unsigned long long)pk2(v[j].z * rs * g.z, v[j].w * rs * g.w) << 32); }
}
__device__ __forceinline__ void phase_prologue(const Frame& F) {
    LAS float* scr = (LAS float*)(F.lds + F.wave * 16384);
    constexpr int IT_IN = 16 * (IN_WP / 32), IT_OUT = 16 * 32, IT_UP = 16 * 128, IT_DN = 64 * 32, IT_L = IT_IN + IT_OUT + 2 * IT_UP + IT_DN;
    for (int it = F.gw; it < DEPTH * IT_L; it += F.ngw) {
        const int l = it / IT_L; int r = it % IT_L;
        if (r < IT_IN) { transpose_item(INP(F, I_WIN) + (size_t)l * DM * IN_W, DM, IN_W, IN_WP / 32, WSP(F, bf16, WS_WTIN) + (size_t)l * IN_WP * DM, 0, scr, r, F.lane); continue; } r -= IT_IN;
        if (r < IT_OUT) { transpose_item(INP(F, I_WOUT) + (size_t)l * DM * DM, DM, DM, 32, WSP(F, bf16, WS_WTOUT) + (size_t)l * DM * DM, 0, scr, r, F.lane); continue; } r -= IT_OUT;
        if (r < IT_UP) { transpose_item<true>(INP(F, I_WGATE) + (size_t)l * DM * DFF, DM, DFF, 128, WSP(F, bf16, WS_WTUP) + (size_t)l * 2 * DFF * DM, 0, scr, r, F.lane); continue; } r -= IT_UP;
        if (r < IT_UP) { transpose_item<true>(INP(F, I_WVAL) + (size_t)l * DM * DFF, DM, DFF, 128, WSP(F, bf16, WS_WTUP) + (size_t)l * 2 * DFF * DM, 128, scr, r, F.lane); continue; } r -= IT_UP;
        transpose_item(INP(F, I_WDOWN) + (size_t)l * DFF * DM, DFF, DM, 32, WSP(F, bf16, WS_WTDN) + (size_t)l * DM * DFF, 0, scr, r, F.lane);
    }
    for (int it = F.gw; it < 8 * 2 * 64; it += F.ngw) {
        const int i = it >> 7, half = (it >> 6) & 1, r = it & 63; const int lyr = i >> 1, kv = i & 1;
        const float* w1 = INP(F, kv ? I_W1V : I_W1K) + (size_t)lyr * 32 * 64 * 128 + (size_t)half * 1024 * 128;
        transpose_item(w1, 1024, 128, 4, WSP(F, bf16, WS_WTC) + (size_t)i * 256 * 1024, half * 128, scr, r, F.lane);
    }
    for (int idx = blockIdx.x * NTHR + F.tid; idx < 8 * 64 * 128; idx += F.G * NTHR) {
        const int i = idx >> 13, d = (idx >> 7) & 63, e = idx & 127;
        WSP(F, bf16, WS_W2T)[idx] = (bf16)f2bf((INP(F, (i & 1) ? I_W2V : I_W2K) + (size_t)(i >> 1) * 128 * 64)[e * 64 + d]);
    }
    for (int idx = blockIdx.x * NTHR + F.tid; idx < 8 * 128; idx += F.G * NTHR) {
        const int i = idx >> 7, e = idx & 127; const int lyr = i >> 1, kv = i & 1;
        const float* w1 = INP(F, kv ? I_W1V : I_W1K) + (size_t)lyr * 32 * 64 * 128; const float* pe = INP(F, kv ? I_PEV : I_PEK) + (size_t)lyr * 32 * 64;
        float a = 0.f; for (int k = 0; k < 2048; ++k) a += pe[k] * w1[(size_t)k * 128 + e];
        WSP(F, float, WS_CBIAS)[idx] = a;
    }
    for (int it2 = F.gw; it2 < DEPTH * BS * 256; it2 += F.ngw) {
        f32x4 a[2][2][4]; int lyrv[2], bv[2], cv[2];
#pragma unroll
        for (int u = 0; u < 2; ++u) {
            const int it = 2 * it2 + u; const int lyr = it >> 14, b = (it >> 9) & 31, c = it & 511; lyrv[u] = lyr; bv[u] = b; cv[u] = c;
            const int page = ((const int*)INP(F, I_PT))[b * NPAGES + (c >> 3)];
            const int row = F.lane >> 2, qd = F.lane & 3;
            const float* src = INP(F, I_CACHE) + ((((size_t)lyr * NPHYS + page) * PAGE + (c & 7) * 16 + row) * 4) * 64 + qd * 16;
#pragma unroll
            for (int kv = 0; kv < 2; ++kv)
#pragma unroll
                for (int k = 0; k < 4; ++k) a[u][kv][k] = *(const f32x4*)(src + kv * 64 + 4 * k);
        }
#pragma unroll
        for (int u = 0; u < 2; ++u) {
            const int row = F.lane >> 2, qd = F.lane & 3;
#pragma unroll
            for (int kv = 0; kv < 2; ++kv) {
                const f32x4 a0 = a[u][kv][0], a1 = a[u][kv][1], a2 = a[u][kv][2], a3 = a[u][kv][3];
                v4u o0, o1; o0.x = pk2(a0.x, a0.y); o0.y = pk2(a0.z, a0.w); o0.z = pk2(a1.x, a1.y); o0.w = pk2(a1.z, a1.w); o1.x = pk2(a2.x, a2.y); o1.y = pk2(a2.z, a2.w); o1.z = pk2(a3.x, a3.y); o1.w = pk2(a3.z, a3.w);
                bf16* dst = WSP(F, bf16, WS_AS) + ((((size_t)(lyrv[u] * 2 + kv) * BS + bv[u]) * 512 + cv[u]) * 1024) + row * 64 + qd * 16;
                *(v4u*)dst = o0; *(v4u*)(dst + 8) = o1;
            }
        }
    }
    {
        const float inv[8] = {1.0f, 0.193922758102417f, 0.03760603070259094f, 0.00729266507551074f, 0.001414213445968926f, 0.00027424818836152554f, 5.318296462064609e-05f, 1.0313385246263351e-05f};
        float* rope = WSP(F, float, WS_ROPE);
        for (int i = blockIdx.x * NTHR + F.tid; i < 2056 * 8; i += F.G * NTHR) {
            const int pi = i >> 3, f = i & 7; const int pos = pi < TP ? pi : PAST + (pi - TP);
            float iv = inv[0];
#pragma unroll
            for (int k = 1; k < 8; ++k) iv = (f == k) ? inv[k] : iv;
            const float ang = (float)pos * iv; float c, s; cossin_d(ang, c, s);
            rope[pi * 16 + f] = c; rope[pi * 16 + 8 + f] = s;
        }
    }
    for (int r = F.gw; r < MROWS; r += F.ngw) norm_row_to_bf16(F, x_in_row(F, r), INP(F, I_NMPRE), WSP(F, bf16, WS_XN) + (size_t)r * DM);
}

typedef float f32x16p __attribute__((ext_vector_type(16)));
__device__ __forceinline__ void phase_cmp_finish(const Frame& F) {
    const float* H = WSP(F, float, WS_HS);
    const int lane = F.lane, r32 = lane & 31, hp = lane >> 5;
    for (int it = F.gw; it < 8 * BS * 16; it += F.ngw) {
        const int i = it >> 9, b = (it >> 4) & 31, n0 = (it & 15) * 32; const int lyr = i >> 1, kv = i & 1;
        const int n = n0 + r32; const int n1 = (n + 1 < 512) ? n + 1 : 511;
        const float* h0 = H + (((size_t)i * BS + b) * 512 + n) * 256; const float* h1 = H + (((size_t)i * BS + b) * 512 + n1) * 256 + 128;
        const float* bias = WSP(F, float, WS_CBIAS) + i * 128;
        const bf16* w2t = WSP(F, bf16, WS_W2T) + (size_t)i * 64 * 128;
        f32x16p acc0, acc1;
#pragma unroll
        for (int k = 0; k < 16; ++k) { acc0[k] = 0.f; acc1[k] = 0.f; }
#pragma unroll
        for (int ks = 0; ks < 8; ++ks) {
            const int e = 16 * ks + 8 * hp;
            const f32x4 a0 = *(const f32x4*)(h0 + e), a1 = *(const f32x4*)(h0 + e + 4), c0 = *(const f32x4*)(h1 + e), c1 = *(const f32x4*)(h1 + e + 4);
            const f32x4 b0 = *(const f32x4*)(bias + e), b1 = *(const f32x4*)(bias + e + 4);
            const f32x4 x0 = a0 + c0 + b0, x1 = a1 + c1 + b1;
            v4u av; av.x = pk2(gelu_tanh(x0.x), gelu_tanh(x0.y)); av.y = pk2(gelu_tanh(x0.z), gelu_tanh(x0.w)); av.z = pk2(gelu_tanh(x1.x), gelu_tanh(x1.y)); av.w = pk2(gelu_tanh(x1.z), gelu_tanh(x1.w));
            const bf16x8 bf0 = *(const bf16x8*)(w2t + (size_t)r32 * 128 + e), bf1 = *(const bf16x8*)(w2t + (size_t)(32 + r32) * 128 + e);
            acc0 = __builtin_amdgcn_mfma_f32_32x32x16_bf16(__builtin_bit_cast(bf16x8, av), bf0, acc0, 0, 0, 0);
            acc1 = __builtin_amdgcn_mfma_f32_32x32x16_bf16(__builtin_bit_cast(bf16x8, av), bf1, acc1, 0, 0, 0);
        }
        float* dst = WSP(F, float, kv ? WS_CVS : WS_CKS) + (((size_t)lyr * BS + b) * NCMP_S) * 64;
#pragma unroll
        for (int k = 0; k < 16; ++k) { const int nn = n0 + (k & 3) + 8 * (k >> 2) + 4 * hp;
            if (nn < NCMP_S) { dst[(size_t)nn * 64 + r32] = acc0[k]; dst[(size_t)nn * 64 + 32 + r32] = acc1[k]; } }
    }
}

__device__ __forceinline__ float rope_lane(float x, int lane, float cs_c, float cs_s) {
    const float other = __shfl_xor(x, 8);
    const float rot = (lane < 8) ? x * cs_c - other * cs_s : x * cs_c + other * cs_s;
    return (lane < 16) ? rot : x;
}
template <int NR>
__device__ __forceinline__ void token_prep4(const Frame& F, int l, int r0, const LAS float* pw_lds, LAS float* pl) {
    int s, t0; row_to_seq(r0, s, t0); const Seq q = seq_of(s);
    const int lane = F.lane;
    const float* spool = INP(F, I_SPOOL) + ((size_t)l * BS + q.b) * POOL_KEEP * POOL_W;
    const float* proj0 = WSP(F, float, WS_PROJ) + (size_t)r0 * IN_WP;
    float qx[NR][4], kx[NR][6], csc[NR], css[NR];
#pragma unroll
    for (int u = 0; u < NR; ++u) {
        const float* proj = proj0 + (size_t)u * IN_WP; const int t = t0 + u;
        const float* rp = WSP(F, float, WS_ROPE) + (size_t)(q.samp ? TP + t : t) * 16;
#pragma unroll
        for (int j = 0; j < 4; ++j) qx[u][j] = proj[OFF_Q + j * 64 + lane];
#pragma unroll
        for (int j = 0; j < 6; ++j) kx[u][j] = proj[OFF_KV + j * 64 + lane];
        csc[u] = rp[lane & 7]; css[u] = rp[8 + (lane & 7)];
    }
    float e0[2 + NR - 1], e1[4 + NR - 1], e2[8 + NR - 1], e3[16 + NR - 1];
#define LOAD_EXT(EARR, G, W) do { _Pragma("unroll") for (int k = 0; k < (W) + NR - 1; ++k) { const int tt = t0 - ((W) - 1) + k; const int c = (G) * 64 + lane; \
          \
        const float* pa = (tt >= 0) ? proj0 + (long)(tt - t0) * IN_WP + OFF_POOL + c : (q.samp ? spool + (POOL_KEEP + tt) * POOL_W + c : proj0 + OFF_POOL + c); \
        const float v = *pa; EARR[k] = (tt >= 0 || q.samp) ? v : 0.f; } } while (0)
    LOAD_EXT(e0, 0, 2); LOAD_EXT(e1, 1, 4); LOAD_EXT(e2, 2, 8); LOAD_EXT(e3, 3, 16);
#undef LOAD_EXT
    float pooled[NR][4], pu[NR][4];
#pragma unroll
    for (int u = 0; u < NR; ++u) {
        const int pos = q.pos0 + t0 + u;
        float s0 = 0.f, s1 = 0.f, s2 = 0.f, s3 = 0.f;
#pragma unroll
        for (int i = 0; i < 2; ++i) s0 += e0[u + i];
#pragma unroll
        for (int i = 0; i < 4; ++i) s1 += e1[u + i];
#pragma unroll
        for (int i = 0; i < 8; ++i) s2 += e2[u + i];
#pragma unroll
        for (int i = 0; i < 16; ++i) s3 += e3[u + i];
        pu[u][0] = e0[u + 1]; pu[u][1] = e1[u + 3]; pu[u][2] = e2[u + 7]; pu[u][3] = e3[u + 15];
        pooled[u][0] = s0 / (float)((pos + 1 < 2) ? pos + 1 : 2) - pu[u][0];
        pooled[u][1] = s1 / (float)((pos + 1 < 4) ? pos + 1 : 4) - pu[u][1];
        pooled[u][2] = s2 / (float)((pos + 1 < 8) ? pos + 1 : 8) - pu[u][2];
        pooled[u][3] = s3 / (float)((pos + 1 < 16) ? pos + 1 : 16) - pu[u][3];
    }
#pragma unroll
    for (int u = 0; u < NR; ++u) {
        const int r = r0 + u, t = t0 + u;
        bf16* qb = WSP(F, bf16, WS_QB) + (size_t)r * 256;
#pragma unroll
        for (int j = 0; j < 4; ++j) qb[j * 64 + lane] = (bf16)f2bf(rope_lane(qx[u][j], lane, csc[u], css[u]) * (0.125f * 1.4426950408889634f));
        float* kvout = q.samp ? F.out + O_KVS + ((size_t)l * NS + (r - NP)) * 256 : F.out + O_KVP + ((size_t)l * NP + r) * 256;
        float* kwin = WSP(F, float, WS_KWIN) + (size_t)r * 128;
#pragma unroll
        for (int j = 0; j < 6; ++j) {
            const float v = (j & 1) ? kx[u][j] : rope_lane(kx[u][j], lane, csc[u], css[u]);
            if (j < 4) kvout[j * 64 + lane] = v;
            else {
                kwin[(j - 4) * 64 + lane] = v;
                if (!q.samp) { if (t >= TP - 512) F.out[O_WINP + (((size_t)l * BP + q.b) * 512 + (t - (TP - 512))) * 128 + (j - 4) * 64 + lane] = v; }
                else F.out[O_WINS + (((size_t)l * BS + q.b) * 512 + 504 + t) * 128 + (j - 4) * 64 + lane] = v;
            }
        }
#pragma unroll
        for (int g = 0; g < 4; ++g) pl[u * 256 + g * 64 + lane] = pooled[u][g];
    }
    asm volatile("s_waitcnt lgkmcnt(0)" ::: "memory");
    const float* psc = INP(F, I_POOLSC) + (size_t)l * POOL_W;
#pragma unroll
    for (int g = 0; g < 4; ++g) {
        float y[NR];
#pragma unroll
        for (int u = 0; u < NR; ++u) y[u] = 0.f;
#pragma unroll 4
        for (int c = 0; c < 64; c += 4) { const LAS float* wv = pw_lds + (g * 64 + c) * 64 + lane;
            const float w0 = wv[0], w1 = wv[64], w2 = wv[128], w3 = wv[192];
#pragma unroll
            for (int u = 0; u < NR; ++u) { const f32x4 pa = *(const LAS f32x4*)(pl + u * 256 + g * 64 + c); y[u] += pa.x * w0 + pa.y * w1 + pa.z * w2 + pa.w * w3; } }
        const float sc = psc[g * 64 + lane];
#pragma unroll
        for (int u = 0; u < NR; ++u) (WSP(F, bf16, WS_MIX) + (size_t)(r0 + u) * DM)[512 + g * 64 + lane] = (bf16)f2bf(y[u] * sc);
    }
    asm volatile("s_waitcnt lgkmcnt(0)" ::: "memory");
#pragma unroll
    for (int u = 0; u < NR; ++u) {
        const int r = r0 + u, t = t0 + u; const float* proj = WSP(F, float, WS_PROJ) + (size_t)r * IN_WP;
        if (!q.samp) {
            if (t >= TP - 15) { float* o = F.out + O_POOLP + (((size_t)l * BP + q.b) * 15 + (t - (TP - 15))) * POOL_W;
#pragma unroll
                for (int j = 0; j < 4; ++j) o[j * 64 + lane] = pu[u][j]; }
            if (t >= TP - 3) { float* o = F.out + O_CONVP + (((size_t)l * BP + q.b) * 3 + (t - (TP - 3))) * CONV_DIM;
                for (int j = 0; j < 16; ++j) o[j * 64 + lane] = proj[OFF_XBC + j * 64 + lane]; }
        } else {
            { float* o = F.out + O_POOLS + (((size_t)l * BS + q.b) * 15 + 7 + t) * POOL_W;
#pragma unroll
                for (int j = 0; j < 4; ++j) o[j * 64 + lane] = pu[u][j]; }
            if (t < 7) { float* o = F.out + O_POOLS + (((size_t)l * BS + q.b) * 15 + t) * POOL_W;
#pragma unroll
                for (int j = 0; j < 4; ++j) o[j * 64 + lane] = spool[(8 + t) * POOL_W + j * 64 + lane]; }
            if (t >= TS - 3) { float* o = F.out + O_CONVS + (((size_t)l * BS + q.b) * 3 + (t - (TS - 3))) * CONV_DIM;
                for (int j = 0; j < 16; ++j) o[j * 64 + lane] = proj[OFF_XBC + j * 64 + lane]; }
        }
    }
}

__device__ __forceinline__ float xbc_conv(const Frame& F, int l, const Seq& q, int t, int c) {
    const float* cw = INP(F, I_CONVW) + (size_t)l * 4 * CONV_DIM; const float* cb = INP(F, I_CONVB) + (size_t)l * CONV_DIM;
    const float* proj = WSP(F, float, WS_PROJ);
    const float* sconv = INP(F, I_SCONV) + ((size_t)l * BS + q.b) * 3 * CONV_DIM;
    float acc = cb[c];
#pragma unroll
    for (int k = 0; k < 4; ++k) { const int tt = t - 3 + k; float e = 0.f;
        if (tt >= 0) e = proj[(size_t)(q.row0 + tt) * IN_WP + OFF_XBC + c];
        else if (q.samp) e = sconv[(3 + tt) * CONV_DIM + c];
        acc += e * cw[k * CONV_DIM + c]; }
    return siluf_(acc);
}
__device__ __forceinline__ void ssd_item(const Frame& F, int l, int s, int h) {
    const Seq q = seq_of(s);
    constexpr int TSTG = 16;
    LAS float* xs = (LAS float*)F.lds;
    LAS float* Bs = xs + TSTG * 64;
    LAS float* Cs = Bs + TSTG * 128;
    LAS float* dts = Cs + TSTG * 128;
    LAS float* dAs = dts + TSTG;
    const int tid = F.tid, p = tid >> 3, nq = tid & 7, g = h >> 2;
    const float a = -expf(INP(F, I_ALOG)[l * SSD_H + h]), dtb = INP(F, I_DTB)[l * SSD_H + h], dsk = INP(F, I_SSDD)[l * SSD_H + h];
    float st[16];
    if (q.samp) { const float* s0 = INP(F, I_SSM) + ((((size_t)l * BS + q.b) * SSD_H + h) * SSD_HD + p) * SSD_N + nq * 16;
#pragma unroll
        for (int i = 0; i < 16; ++i) st[i] = s0[i]; }
    else {
#pragma unroll
        for (int i = 0; i < 16; ++i) st[i] = 0.f; }
    const float* proj = WSP(F, float, WS_PROJ);
    float* yssd = WSP(F, float, WS_YSSD);
    for (int t0 = 0; t0 < q.T; t0 += TSTG) {
        const int nt = (q.T - t0 < TSTG) ? q.T - t0 : TSTG;
        __syncthreads();
        for (int i = tid; i < nt * 320; i += NTHR) { const int tt = i / 320, c = i % 320; const int t = t0 + tt;
            if (c < 64) xs[tt * 64 + c] = xbc_conv(F, l, q, t, h * 64 + c);
            else if (c < 192) Bs[tt * 128 + (c - 64)] = xbc_conv(F, l, q, t, 512 + g * 128 + (c - 64));
            else Cs[tt * 128 + (c - 192)] = xbc_conv(F, l, q, t, 768 + g * 128 + (c - 192)); }
        if (tid < nt) { const float dt = softplusf_(proj[(size_t)(q.row0 + t0 + tid) * IN_WP + OFF_DT + h] + dtb); dts[tid] = dt; dAs[tid] = expf(dt * a); }
        __syncthreads();
        for (int tt = 0; tt < nt; ++tt) {
            const float dt = dts[tt], dA = dAs[tt], x = xs[tt * 64 + p], xd = x * dt;
            float y = 0.f;
#pragma unroll
            for (int i = 0; i < 16; ++i) { st[i] = st[i] * dA + xd * Bs[tt * 128 + nq * 16 + i]; y += st[i] * Cs[tt * 128 + nq * 16 + i]; }
            y += __shfl_xor(y, 1); y += __shfl_xor(y, 2); y += __shfl_xor(y, 4);
            if (nq == 0) yssd[(size_t)(q.row0 + t0 + tt) * SSD_W + h * 64 + p] = y + dsk * x;
        }
    }
    float* so = q.samp ? F.out + O_SSMS + ((((size_t)l * BS + q.b) * SSD_H + h) * SSD_HD + p) * SSD_N + nq * 16
                       : F.out + O_SSMP + ((((size_t)l * BP + q.b) * SSD_H + h) * SSD_HD + p) * SSD_N + nq * 16;
#pragma unroll
    for (int i = 0; i < 16; ++i) so[i] = st[i];
    __syncthreads();
}
__device__ __forceinline__ void ssd_chunk_unit(const Frame& F, int l, int b, int c, int g);
__device__ __forceinline__ void ssd_scan(const Frame& F, int l);
__device__ __forceinline__ void ssd_out_unit(const Frame& F, int l, int b, int hc);
__device__ __forceinline__ void phase_prep(const Frame& F, int l) {
    for (int u = blockIdx.x; u < BP * 16 * 2; u += F.G) ssd_chunk_unit(F, l, u >> 5, (u >> 1) & 15, u & 1);
    {
        __syncthreads();
        LAS float* pw_lds = (LAS float*)F.lds; const float* pw = INP(F, I_POOLW) + (size_t)l * 4 * 64 * 64;
        for (int i = F.tid; i < 4 * 64 * 64 / 4; i += NTHR) *(LAS f32x4*)(pw_lds + i * 4) = *(const f32x4*)(pw + i * 4);
        __syncthreads();
        LAS float* pl = (LAS float*)(F.lds + 65536) + F.wave * 1024;
        for (int rp = F.gw; rp < NP / 4; rp += F.ngw) token_prep4<4>(F, l, 4 * rp, pw_lds, pl);
        for (int j = blockIdx.x * 8 + F.wave; j < NS * 8; j += F.G * 8) if ((j & 7) == 0) token_prep4<1>(F, l, NP + (j >> 3), pw_lds, pl);
        __syncthreads();
    }
}

__device__ __forceinline__ const float* kv_row(const Frame& F, int l, const Seq& q, int tok, int kind) {
    if (!q.samp) return F.out + O_KVP + ((size_t)l * NP + q.row0 + tok) * 256 + kind * 64;
    if (tok >= PAST) return F.out + O_KVS + ((size_t)l * NS + (q.row0 - NP) + (tok - PAST)) * 256 + kind * 64;
    const int page = ((const int*)INP(F, I_PT))[q.b * NPAGES + (tok >> 7)];
    return INP(F, I_CACHE) + ((((size_t)l * NPHYS + page) * PAGE + (tok & 127)) * 4 + kind) * 64;
}
typedef float f32x4c __attribute__((ext_vector_type(4)));
__device__ __forceinline__ void compress_item(const Frame& F, int l, int s, int grp, int kv) {
    const Seq q = seq_of(s);
    const int ncmp = NCMP_P;
    const int n0 = grp * 16; const int nb = (ncmp - n0 < 16) ? ncmp - n0 : 16;
    constexpr int CST = 2064;
    LAS unsigned char* rows = F.lds;
    LAS float* hid = (LAS float*)(F.lds + 36864);
    const int tid = F.tid, lane = F.lane, wave = F.wave;
    __syncthreads();
    for (int i = tid; i < 17 * 16 * 8; i += NTHR) { const int rr = i >> 3, dc = i & 7; const int tok = n0 * 16 + rr;
        v4u o = (v4u){0u, 0u, 0u, 0u};
        if (tok < TP) { const float* p = kv_row(F, l, q, tok, kv) + dc * 8; const f32x4 a = *(const f32x4*)p, b = *(const f32x4*)(p + 4);
            o.x = pk2(a.x, a.y); o.y = pk2(a.z, a.w); o.z = pk2(b.x, b.y); o.w = pk2(b.z, b.w); }
        *(LAS v4u*)(rows + (rr >> 4) * CST + (rr & 15) * 128 + dc * 16) = o; }
    __syncthreads();
    const int i2 = l * 2 + kv;
    const bf16* wt = WSP(F, bf16, WS_WTC) + (size_t)i2 * 256 * 1024;
    const int e = 16 * wave + (lane & 15), kq = lane >> 4, blk = lane & 15;
    f32x4c acc = (f32x4c){0.f, 0.f, 0.f, 0.f};
#pragma unroll 8
    for (int ks = 0; ks < 64; ++ks) {
        const int half = ks >> 5, kk = (ks & 31) * 32 + 8 * kq;
        const bf16x8 bfrag = *(const bf16x8*)(wt + (size_t)(half * 128 + e) * 1024 + kk);
        const bf16x8 afrag = *(const LAS bf16x8*)(rows + (blk + half) * CST + kk * 2);
        acc = __builtin_amdgcn_mfma_f32_16x16x32_bf16(afrag, bfrag, acc, 0, 0, 0);
    }
    { const float bias = WSP(F, float, WS_CBIAS)[i2 * 128 + e];
#pragma unroll
      for (int k = 0; k < 4; ++k) hid[(kq * 4 + k) * 128 + e] = gelu_tanh(acc[k] + bias); }
    __syncthreads();
    const float* w2 = INP(F, kv ? I_W2V : I_W2K) + (size_t)l * 128 * 64;
    float* dst = WSP(F, float, kv ? WS_CVP : WS_CKP) + (size_t)q.b * NCMP_P * 64;
    { const int bi = tid >> 5, d0 = (tid & 31) * 2;
        if (bi < nb) { float o0 = 0.f, o1 = 0.f;
#pragma unroll 8
            for (int k = 0; k < 128; ++k) { const float hv = hid[bi * 128 + k]; o0 += hv * w2[k * 64 + d0]; o1 += hv * w2[k * 64 + d0 + 1]; }
            dst[(size_t)(n0 + bi) * 64 + d0] = o0; dst[(size_t)(n0 + bi) * 64 + d0 + 1] = o1; } }
    __syncthreads();
}
__device__ __forceinline__ void attn_sample_unit(const Frame& F, int l, int b, int t0);
__device__ __forceinline__ void phase_compress(const Frame& F, int l) {
    constexpr int NI_P = BP * 8 * 2;
    for (int it = blockIdx.x; it < NI_P; it += F.G) compress_item(F, l, it >> 4, (it >> 1) & 7, it & 1);
    ssd_scan(F, l);
    { int bi = (int)blockIdx.x, nb = F.G; if (nb == 256) { bi -= 128; nb = 128; }
      if (bi >= 0) for (int it = BP * SSD_H + bi; it < NSEQ * SSD_H; it += nb) ssd_item(F, l, it >> 3, it & 7); }
    { Frame G2 = F; { int ln = G2.lane; asm volatile("" : "+v"(ln)); G2.lane = ln; G2.tid = G2.wave * 64 + ln; }
      for (int u = blockIdx.x; u < NS; u += F.G) attn_sample_unit(G2, l, u >> 3, u & 7); }
}

__device__ __forceinline__ void osm_step(float sc, const f32x4 v, float& m, float& lsum, f32x4& o) {
    const float mn = fmaxf(m, sc); const float al = expf(m - mn), pp = expf(sc - mn);
    lsum = lsum * al + pp; o = o * al + v * pp; m = mn;
}
__device__ __forceinline__ void nsa_token(const Frame& F, int l, int r) {
    int s, t; row_to_seq(r, s, t); const Seq q = seq_of(s);
    const int lane = F.lane, hh = lane >> 4, sub = lane & 15;
    const int tpos = q.pos0 + t;
    LAS float* sc = (LAS float*)(F.lds + F.wave * 12288);
    LAS float* impv = sc + 2048;
    LAS int* sel = (LAS int*)(impv + 192);
    const f32x4 qv = *(const f32x4*)(WSP(F, float, WS_Q) + (size_t)r * 256 + hh * 64 + sub * 4);
    const int ncmp = q.samp ? NCMP_S : NCMP_P;
    const float* ck = q.samp ? WSP(F, float, WS_CKS) + (size_t)q.b * NCMP_S * 64 : WSP(F, float, WS_CKP) + (size_t)q.b * NCMP_P * 64;
    const float* cv = q.samp ? WSP(F, float, WS_CVS) + (size_t)q.b * NCMP_S * 64 : WSP(F, float, WS_CVP) + (size_t)q.b * NCMP_P * 64;
    int nvis = 0; if (tpos >= 31) { nvis = (tpos - 31) / 16 + 1; if (nvis > ncmp) nvis = ncmp; }
    float mx = -INFINITY;
    for (int n = 0; n < nvis; ++n) { const f32x4 kk = *(const f32x4*)(ck + (size_t)n * 64 + sub * 4);
        const float d = sum16(qv.x * kk.x + qv.y * kk.y + qv.z * kk.z + qv.w * kk.w);
        if (sub == 0) sc[hh * 512 + n] = d; mx = fmaxf(mx, d); }
    asm volatile("s_waitcnt lgkmcnt(0)" ::: "memory");
    float ls = 0.f;
    for (int n = sub; n < nvis; n += 16) { const float e = expf(sc[hh * 512 + n] - mx); sc[hh * 512 + n] = e; ls += e; }
    ls = sum16(ls);
    const float rl = ls > 0.f ? 1.f / ls : 0.f;
    for (int n = sub; n < nvis; n += 16) sc[hh * 512 + n] *= rl;
    asm volatile("s_waitcnt lgkmcnt(0)" ::: "memory");
    f32x4 ocmp = (f32x4){0.f, 0.f, 0.f, 0.f};
    for (int n = 0; n < nvis; ++n) { const float pp = sc[hh * 512 + n]; ocmp += *(const f32x4*)(cv + (size_t)n * 64 + sub * 4) * pp; }
    const int nslc = q.samp ? 129 : 32, cur = tpos >> 6;
    for (int j = lane; j < nslc; j += 64) {
        float v;
        if (j > cur) v = -INFINITY;
        else if (j == 0 || j == cur || j == cur - 1) v = INFINITY;
        else { v = 0.f;
            for (int n = 4 * j - 1; n <= 4 * j + 3; ++n) if (n >= 0 && n < nvis) v += (sc[n] + sc[512 + n]) + (sc[1024 + n] + sc[1536 + n]); }
        impv[j] = v;
    }
    asm volatile("s_waitcnt lgkmcnt(0)" ::: "memory");
    int nsel = 0;
    for (int j0 = 0; j0 < nslc; j0 += 64) {
        const int j = j0 + lane; bool selj = false;
        if (j < nslc) { const float vj = impv[j]; int rank = 0;
            for (int k = 0; k < nslc; ++k) { const float vk = impv[k]; rank += (vk > vj || (vk == vj && k < j)) ? 1 : 0; }
            selj = (rank < 16) && (j <= cur); }
        const unsigned long long bal = __ballot(selj);
        if (selj) sel[nsel + __popcll(bal & ((1ull << lane) - 1ull))] = j;
        nsel += __popcll(bal);
    }
    asm volatile("s_waitcnt lgkmcnt(0)" ::: "memory");
    float m2 = -INFINITY, l2 = 0.f; f32x4 o2 = (f32x4){0.f, 0.f, 0.f, 0.f};
    for (int si = 0; si < nsel; ++si) {
        const int j = sel[si]; int ntok = tpos - 64 * j + 1; if (ntok > 64) ntok = 64;
        for (int i = 0; i < ntok; ++i) { const int tok = 64 * j + i;
            const float* kr = kv_row(F, l, q, tok, 2);
            const f32x4 kk = *(const f32x4*)(kr + sub * 4); const f32x4 vv = *(const f32x4*)(kr + 64 + sub * 4);
            const float d = sum16(qv.x * kk.x + qv.y * kk.y + qv.z * kk.z + qv.w * kk.w);
            osm_step(d, vv, m2, l2, o2); }
    }
    float m3 = -INFINITY, l3 = 0.f; f32x4 o3 = (f32x4){0.f, 0.f, 0.f, 0.f};
    {
        int k0 = tpos - 511; if (k0 < 0) k0 = 0;
        const float* swin = INP(F, I_SWIN) + ((size_t)l * BS + q.b) * 512 * 128;
        const float* kwin = WSP(F, float, WS_KWIN);
        for (int kp = k0; kp <= tpos; ++kp) {
            const float* kr;
            if (!q.samp) kr = kwin + (size_t)(q.row0 + kp) * 128;
            else if (kp >= PAST) kr = kwin + (size_t)(q.row0 + kp - PAST) * 128;
            else kr = swin + (size_t)(kp - (PAST - 512)) * 128;
            const f32x4 kk = *(const f32x4*)(kr + sub * 4); const f32x4 vv = *(const f32x4*)(kr + 64 + sub * 4);
            const float d = sum16(qv.x * kk.x + qv.y * kk.y + qv.z * kk.z + qv.w * kk.w);
            osm_step(d, vv, m3, l3, o3); }
    }
    const float* gp = WSP(F, float, WS_PROJ) + (size_t)r * IN_WP + OFF_G + hh * 3;
    const float g0 = sigmoidf_(gp[0]), g1 = sigmoidf_(gp[1]), g2 = sigmoidf_(gp[2]);
    const float r2 = l2 > 0.f ? 1.f / l2 : 0.f, r3 = l3 > 0.f ? 1.f / l3 : 0.f;
    const f32x4 y = ocmp * g0 + o2 * (g1 * r2) + o3 * (g2 * r3);
    unsigned long long* mo = (unsigned long long*)(WSP(F, bf16, WS_MIX) + (size_t)r * DM + 768 + hh * 64 + sub * 4);
    *mo = (unsigned long long)pk2(y.x, y.y) | ((unsigned long long)pk2(y.z, y.w) << 32);
}
__device__ __forceinline__ void ssd_finish_token(const Frame& F, int l, int r) {
    const float* y = WSP(F, float, WS_YSSD) + (size_t)r * SSD_W; const float* z = WSP(F, float, WS_PROJ) + (size_t)r * IN_WP;
    const float* nw = INP(F, I_SSDNORM) + (size_t)l * SSD_W;
    float v[8]; float ss = 0.f;
#pragma unroll
    for (int j = 0; j < 8; ++j) { const int c = j * 64 + F.lane; v[j] = y[c] * siluf_(z[c]); ss += v[j] * v[j]; }
    const float rs = 1.f / sqrtf(wave_sum(ss) * (1.f / SSD_W) + RMS_EPS);
    bf16* mix = WSP(F, bf16, WS_MIX) + (size_t)r * DM;
#pragma unroll
    for (int j = 0; j < 8; ++j) { const int c = j * 64 + F.lane; mix[c] = (bf16)f2bf(v[j] * rs * nw[c]); }
}
__device__ __forceinline__ void phase_attn(const Frame& F, int l) {
    for (int r = F.gw; r < MROWS; r += F.ngw) { nsa_token(F, l, r); ssd_finish_token(F, l, r); }
}


typedef short bf16x8 __attribute__((ext_vector_type(8)));
typedef float f32x16 __attribute__((ext_vector_type(16)));
typedef float f32x2_t __attribute__((ext_vector_type(2))); typedef __bf16 bf16x2_t __attribute__((ext_vector_type(2)));
__device__ __forceinline__ unsigned cvtpk(float lo, float hi) { f32x2_t v = {lo, hi}; bf16x2_t b = __builtin_convertvector(v, bf16x2_t); return __builtin_bit_cast(unsigned, b); }
__device__ __forceinline__ float half_sum(float v) { auto rr = __builtin_amdgcn_permlane32_swap(__float_as_uint(v), __float_as_uint(v), false, false); return __uint_as_float(rr[0]) + __uint_as_float(rr[1]); }
__device__ __forceinline__ float half_max(float v) { auto rr = __builtin_amdgcn_permlane32_swap(__float_as_uint(v), __float_as_uint(v), false, false); return fmaxf(__uint_as_float(rr[0]), __uint_as_float(rr[1])); }

constexpr float QSCALE_B = 0.125f * 1.4426950408889634f;
constexpr int AT_K = 0, AT_V = 16384, AT_IMPG = 32768, AT_IMPE = AT_IMPG + 8192, AT_SEL = AT_IMPE + 8192, AT_UNI = AT_SEL + 2048, AT_LIST = AT_UNI + 64, AT_NLIST = AT_LIST + 768,
              AT_PAGE = AT_NLIST + 64, AT_RANK = AT_PAGE + 768, AT_OUT = AT_RANK + 8 * 1024, AT_END = AT_OUT + 8 * 8192;
static_assert(AT_END <= RING_BYTES, "attention LDS map");
enum { KIND_CMP1 = 0, KIND_CMP2 = 1, KIND_SLC = 2, KIND_WIN = 3 };

struct TileRegs { f32x4 k0, k1, v0, v1; };
__device__ __forceinline__ void tile_load(const Frame& F, int l, const Seq& q, int kind, int tile, int pg, TileRegs& R) {
    int t_ = F.tid; asm volatile("" : "+v"(t_));
    const int key = tile * 64 + (t_ >> 3), dc = t_ & 7;
    const float* kr = nullptr; const float* vr = nullptr;
    if (kind <= KIND_CMP2) {
        const int ncmp = q.samp ? NCMP_S : NCMP_P;
        if (key < ncmp) {
            kr = (q.samp ? WSP(F, float, WS_CKS) + ((size_t)l * BS + q.b) * NCMP_S * 64 : WSP(F, float, WS_CKP) + (size_t)q.b * NCMP_P * 64) + (size_t)key * 64;
            vr = (q.samp ? WSP(F, float, WS_CVS) + ((size_t)l * BS + q.b) * NCMP_S * 64 : WSP(F, float, WS_CVP) + (size_t)q.b * NCMP_P * 64) + (size_t)key * 64; }
    } else if (kind == KIND_SLC) {
        if (key < q.pos0 + q.T) {
            if (!q.samp) kr = F.out + O_KVP + ((size_t)l * NP + q.row0 + key) * 256 + 2 * 64;
            else if (key < PAST) kr = INP(F, I_CACHE) + ((((size_t)l * NPHYS + pg) * PAGE + (key & 127)) * 4 + 2) * 64;
            else kr = F.out + O_KVS + ((size_t)l * NS + (q.row0 - NP) + (key - PAST)) * 256 + 2 * 64;
            vr = kr + 64; }
    } else {
        if (key < q.pos0 + q.T) {
            if (!q.samp) kr = WSP(F, float, WS_KWIN) + (size_t)(q.row0 + key) * 128;
            else if (key >= PAST) kr = WSP(F, float, WS_KWIN) + (size_t)(q.row0 + key - PAST) * 128;
            else if (key >= PAST - 512) kr = INP(F, I_SWIN) + (((size_t)l * BS + q.b) * 512 + (key - (PAST - 512))) * 128;
            if (kr) vr = kr + 64; }
    }
    const f32x4 z = (f32x4){0.f, 0.f, 0.f, 0.f};
    if (kr) { R.k0 = *(const f32x4*)(kr + dc * 8); R.k1 = *(const f32x4*)(kr + dc * 8 + 4); R.v0 = *(const f32x4*)(vr + dc * 8); R.v1 = *(const f32x4*)(vr + dc * 8 + 4); }
    else { R.k0 = z; R.k1 = z; R.v0 = z; R.v1 = z; }
}
__device__ __forceinline__ void tile_store(const Frame& F, LAS unsigned char* kb, LAS unsigned char* vb, const TileRegs& R) {
    int t_ = F.tid; asm volatile("" : "+v"(t_));
    const int key = t_ >> 3, dc = t_ & 7;
    v4u kk; kk.x = cvtpk(R.k0.x, R.k0.y); kk.y = cvtpk(R.k0.z, R.k0.w); kk.z = cvtpk(R.k1.x, R.k1.y); kk.w = cvtpk(R.k1.z, R.k1.w);
    *(LAS v4u*)(kb + key * 128 + ((dc ^ (key & 7)) << 4)) = kk;
    const float vv[8] = {R.v0.x, R.v0.y, R.v0.z, R.v0.w, R.v1.x, R.v1.y, R.v1.z, R.v1.w};
#pragma unroll
    for (int i = 0; i < 8; ++i) { const int d = dc * 8 + i; const int ch = (key >> 2) ^ ((d >> 1) & 15);
        *(LAS unsigned short*)(vb + d * 128 + ch * 8 + (key & 3) * 2) = (unsigned short)f2bf(vv[i]); }
}
__device__ __forceinline__ void qk_tile(const LAS unsigned char* kb, const bf16x8 (&qf)[4], f32x16& s0, f32x16& s1, int lane, float init = 0.f) {
    const int r = lane & 31, h = lane >> 5;
#pragma unroll
    for (int i = 0; i < 16; ++i) { s0[i] = init; s1[i] = init; }
#pragma unroll
    for (int ks = 0; ks < 4; ++ks) {
        const bf16x8 a0 = *(const LAS bf16x8*)(kb + r * 128 + (((2 * ks + h) ^ (r & 7)) << 4));
        const bf16x8 a1 = *(const LAS bf16x8*)(kb + (32 + r) * 128 + (((2 * ks + h) ^ (r & 7)) << 4));
        s0 = __builtin_amdgcn_mfma_f32_32x32x16_bf16(a0, qf[ks], s0, 0, 0, 0);
        s1 = __builtin_amdgcn_mfma_f32_32x32x16_bf16(a1, qf[ks], s1, 0, 0, 0);
    }
}
__device__ __forceinline__ void mask_tile(f32x16& s0, f32x16& s1, int kbase, int lo, int hi) {
#pragma unroll
    for (int i = 0; i < 16; ++i) { const int k = kbase + (i & 3) + 8 * (i >> 2);
        if (k < lo || k > hi) s0[i] = -INFINITY;
        if (k + 32 < lo || k + 32 > hi) s1[i] = -INFINITY; }
}
__device__ __forceinline__ float max3_(float x, float y, float z) { float r; asm("v_max3_f32 %0, %1, %2, %3" : "=v"(r) : "v"(x), "v"(y), "v"(z)); return r; }
__device__ __forceinline__ float tile_max(const f32x16& s0, const f32x16& s1) {
    float a = max3_(s0[0], s0[1], s0[2]), b = max3_(s1[0], s1[1], s1[2]);
#pragma unroll
    for (int i = 3; i < 15; i += 2) { a = max3_(a, s0[i], s0[i + 1]); b = max3_(b, s1[i], s1[i + 1]); }
    return half_max(max3_(a, b, fmaxf(s0[15], s1[15])));
}
__device__ __forceinline__ void pv_tile(const LAS unsigned char* vb, const f32x16& s0, const f32x16& s1, f32x16 (&O)[2], int lane) {
    const int r = lane & 31, h = lane >> 5;
    bf16x8 pf[2][2];
#pragma unroll
    for (int sp = 0; sp < 2; ++sp) {
        v4u a; a.x = cvtpk(s0[8 * sp + 0], s0[8 * sp + 1]); a.y = cvtpk(s0[8 * sp + 2], s0[8 * sp + 3]); a.z = cvtpk(s0[8 * sp + 4], s0[8 * sp + 5]); a.w = cvtpk(s0[8 * sp + 6], s0[8 * sp + 7]);
        v4u b; b.x = cvtpk(s1[8 * sp + 0], s1[8 * sp + 1]); b.y = cvtpk(s1[8 * sp + 2], s1[8 * sp + 3]); b.z = cvtpk(s1[8 * sp + 4], s1[8 * sp + 5]); b.w = cvtpk(s1[8 * sp + 6], s1[8 * sp + 7]);
        pf[0][sp] = __builtin_bit_cast(bf16x8, a); pf[1][sp] = __builtin_bit_cast(bf16x8, b);
    }
#pragma unroll
    for (int dh = 0; dh < 2; ++dh) {
        const int d = dh * 32 + r, sw = (d >> 1) & 15; const LAS unsigned char* rb = vb + d * 128;
#pragma unroll
        for (int kh = 0; kh < 2; ++kh)
#pragma unroll
            for (int sp = 0; sp < 2; ++sp) {
                const int q0 = kh * 8 + 4 * sp + h;
                const unsigned long long lo8 = *(const LAS unsigned long long*)(rb + ((q0 ^ sw) << 3));
                const unsigned long long hi8 = *(const LAS unsigned long long*)(rb + (((q0 + 2) ^ sw) << 3));
                v4u av; av.x = (unsigned)lo8; av.y = (unsigned)(lo8 >> 32); av.z = (unsigned)hi8; av.w = (unsigned)(hi8 >> 32);
                O[dh] = __builtin_amdgcn_mfma_f32_32x32x16_bf16(__builtin_bit_cast(bf16x8, av), pf[kh][sp], O[dh], 0, 0, 0);
            }
        __builtin_amdgcn_sched_barrier(0);
    }
}

__device__ __forceinline__ void attn_unit(const Frame& F, int l, int s, int t0, int ntok) {
    const Seq q = seq_of(s);
    int lane_ = F.lane; asm volatile("" : "+v"(lane_));
    int wave_ = F.wave; asm volatile("" : "+s"(wave_));
    const int lane = lane_, wave = wave_, tid = wave * 64 + lane, h = lane >> 5;
    LAS unsigned char* lds = F.lds;
    LAS float* impG = (LAS float*)(lds + AT_IMPG); LAS float* impE = (LAS float*)(lds + AT_IMPE);
    LAS unsigned* selw = (LAS unsigned*)(lds + AT_SEL);
    LAS unsigned* uni = (LAS unsigned*)(lds + AT_UNI);
    LAS int* list = (LAS int*)(lds + AT_LIST);
    LAS int* nlist = (LAS int*)(lds + AT_NLIST);
    LAS int* lpage = (LAS int*)(lds + AT_PAGE);
    LAS float* rankv = (LAS float*)(lds + AT_RANK + wave * 1024);
    const int nslc = q.samp ? 129 : 32, njs = q.samp ? 128 : 32;
    const int ncmp = q.samp ? NCMP_S : NCMP_P;
    const int tl = wave * 8 + ((lane & 31) >> 2), head = lane & 3;
    const bool vcol = tl < ntok; const bool wact = (wave * 8) < ntok;
    const int tlc = vcol ? tl : 0;
    const int r = q.row0 + t0 + tlc, tpos = q.pos0 + t0 + tlc;
    int nvis = 0; if (vcol && tpos >= 31) { nvis = (tpos - 31) / 16 + 1; if (nvis > ncmp) nvis = ncmp; }
    const int tpos_last = q.pos0 + t0 + ntok - 1;
    int nvis_max = 0; if (tpos_last >= 31) { nvis_max = (tpos_last - 31) / 16 + 1; if (nvis_max > ncmp) nvis_max = ncmp; }
    const int nct = (nvis_max + 63) >> 6;
    bf16x8 qf[4];
    { const bf16* qb = WSP(F, bf16, WS_QB) + ((size_t)r * 4 + head) * 64;
#pragma unroll
      for (int ks = 0; ks < 4; ++ks) qf[ks] = *(const bf16x8*)(qb + 16 * ks + 8 * h); }
    const float* gp = WSP(F, float, WS_PROJ) + (size_t)r * IN_WP + OFF_G + head * 3;
    const float g0 = sigmoidf_(gp[0]), g1 = sigmoidf_(gp[1]), g2 = sigmoidf_(gp[2]);
#define GATE(k) sigmoidf_((WSP(F, float, WS_PROJ) + (size_t)r * IN_WP + OFF_G + head * 3)[(k)])
    f32x16 O[2];
    LAS float* outl = (LAS float*)(lds + AT_OUT + wave * 8192) + lane;
#pragma unroll
    for (int i = 0; i < 16; ++i) { O[0][i] = 0.f; O[1][i] = 0.f; }
    float m = -1e30f, lsum = 0.f, rinv = 0.f;

    __syncthreads();
    if (tid < 2 * nct) list[tid] = (tid < nct ? KIND_CMP1 : KIND_CMP2) | ((tid < nct ? tid : tid - nct) << 4);
    for (int i = tid; i < 64 * 8; i += NTHR) selw[i] = 0u;
    __syncthreads();
    {
        const int n = 2 * nct; TileRegs R;
        if (n > 0) tile_load(F, l, q, KIND_CMP1, 0, 0, R);
        for (int i = 0; i < n; ++i) {
            LAS unsigned char* kb = lds + AT_K + (i & 1) * 8192; LAS unsigned char* vb = lds + AT_V + (i & 1) * 8192;
            tile_store(F, kb, vb, R);
            const int e = __builtin_amdgcn_readfirstlane(list[i]); const int kind = e & 15, tile = e >> 4;
            if (i + 1 < n) { const int e2 = __builtin_amdgcn_readfirstlane(list[i + 1]); tile_load(F, l, q, e2 & 15, e2 >> 4, 0, R); }
            __syncthreads();
            if (wact) {
                if (i == nct) { const float L = half_sum(lsum); rinv = L > 0.f ? 1.f / L : 0.f; }
                f32x16 s0, s1; qk_tile(kb, qf, s0, s1, lane);
                mask_tile(s0, s1, tile * 64 + 4 * h, 0, nvis - 1);
                if (kind == KIND_CMP1) {
                    const float mt = tile_max(s0, s1); const float mn = fmaxf(m, mt); const float al = __builtin_amdgcn_exp2f(m - mn);
                    float rs = 0.f;
#pragma unroll
                    for (int k = 0; k < 16; ++k) rs += __builtin_amdgcn_exp2f(s0[k] - mn) + __builtin_amdgcn_exp2f(s1[k] - mn);
                    lsum = lsum * al + rs; m = mn;
                } else {
#pragma unroll
                    for (int k = 0; k < 16; ++k) { s0[k] = __builtin_amdgcn_exp2f(s0[k] - m) * rinv; s1[k] = __builtin_amdgcn_exp2f(s1[k] - m) * rinv; }
                    pv_tile(vb, s0, s1, O, lane);
#pragma unroll
                    for (int kh = 0; kh < 2; ++kh)
#pragma unroll
                        for (int gq = 0; gq < 4; ++gq) {
                            const f32x16& sv = kh ? s1 : s0;
                            float G = (sv[4 * gq] + sv[4 * gq + 1]) + (sv[4 * gq + 2] + sv[4 * gq + 3]), E = sv[4 * gq + 3];
                            G += __shfl_xor(G, 1); G += __shfl_xor(G, 2); E += __shfl_xor(E, 1); E += __shfl_xor(E, 2);
                            const int j = 16 * tile + 8 * kh + 2 * gq + h;
                            if (head == 0 && vcol && j < njs) { impG[tl * njs + j] = G; impE[tl * njs + j] = E; }
                        }
                }
            }
        }
    }
    const float g0v = GATE(0);
#pragma unroll
    for (int i = 0; i < 16; ++i) { outl[i * 64] = O[0][i] * g0v; outl[(16 + i) * 64] = O[1][i] * g0v; O[0][i] = 0.f; O[1][i] = 0.f; }
    m = 0.f; lsum = 0.f;
    bool started = false;
    asm volatile("s_waitcnt lgkmcnt(0)" ::: "memory");
    if (wact) {
        const int ntw = (ntok - wave * 8 < 8) ? ntok - wave * 8 : 8;
        for (int tt = 0; tt < ntw; ++tt) {
            const int tk = wave * 8 + tt; const int tp = q.pos0 + t0 + tk; const int cur = tp >> 6;
            int nv = 0; if (tp >= 31) { nv = (tp - 31) / 16 + 1; if (nv > ncmp) nv = ncmp; }
            const int jcov = (nv + 3) >> 2;
            for (int j = lane; j < nslc; j += 64) {
                float v;
                if (j > cur) v = -INFINITY;
                else if (j == 0 || j == cur || j == cur - 1) v = INFINITY;
                else { v = 0.f; if (j < jcov) v += impG[tk * njs + j]; if (j - 1 < jcov) v += impE[tk * njs + j - 1]; }
                rankv[j] = v;
            }
            asm volatile("s_waitcnt lgkmcnt(0)" ::: "memory");
            for (int j0 = 0; j0 < nslc; j0 += 64) {
                const int j = j0 + lane; bool selj = false;
                if (j < nslc) { const float vj = rankv[j]; int rank = 0;
                    for (int k = 0; k < nslc; ++k) { const float vk = rankv[k]; rank += (vk > vj || (vk == vj && k < j)) ? 1 : 0; }
                    selj = (rank < 16) && (j <= cur); }
                const unsigned long long bal = __ballot(selj);
                if (lane == 0) { selw[tk * 8 + (j0 >> 5)] = (unsigned)bal; selw[tk * 8 + (j0 >> 5) + 1] = (unsigned)(bal >> 32); }
            }
            asm volatile("s_waitcnt lgkmcnt(0)" ::: "memory");
        }
    }
    __syncthreads();
    if (tid < 8) { unsigned u = 0u; for (int k = 0; k < ntok; ++k) u |= selw[k * 8 + tid]; uni[tid] = u; }
    __syncthreads();
    if (wave == 0) {
        int n = 0;
        for (int j0 = 0; j0 < nslc; j0 += 64) {
            const int j = j0 + lane; const bool sj = (j < nslc) && ((uni[j >> 5] >> (j & 31)) & 1u);
            int pg = 0; if (sj && q.samp && j * 64 < PAST) pg = ((const int*)INP(F, I_PT))[q.b * NPAGES + (j >> 1)];
            const unsigned long long bal = __ballot(sj);
            if (sj) { const int idx = n + __popcll(bal & ((1ull << lane) - 1ull)); list[idx] = KIND_SLC | (j << 4); lpage[idx] = pg; }
            n += __popcll(bal);
        }
        const int p0 = q.pos0 + t0; int w0 = (p0 - 511) >> 6; if (w0 < 0) w0 = 0; if (q.samp && w0 < (PAST - 512) / 64) w0 = (PAST - 512) / 64;
        const int w1 = (p0 + ntok - 1) >> 6;
        if (lane <= w1 - w0) { list[n + lane] = KIND_WIN | ((w0 + lane) << 4); lpage[n + lane] = 0; }
        if (lane == 0) nlist[0] = n + (w1 - w0 + 1);
    }
    __syncthreads();
    {
        const int n = nlist[0]; TileRegs R0, R1; int pkind = KIND_SLC;
        { const int e0 = __builtin_amdgcn_readfirstlane(list[0]); tile_load(F, l, q, e0 & 15, e0 >> 4, __builtin_amdgcn_readfirstlane(lpage[0]), R0); }
        if (n > 1) { const int e1 = __builtin_amdgcn_readfirstlane(list[1]); tile_load(F, l, q, e1 & 15, e1 >> 4, __builtin_amdgcn_readfirstlane(lpage[1]), R1); }
#define ATTN_STEP(RR, BI, II) do { \
            LAS unsigned char* kb = lds + AT_K + (BI) * 8192; LAS unsigned char* vb = lds + AT_V + (BI) * 8192; \
            tile_store(F, kb, vb, RR); \
            const int e = __builtin_amdgcn_readfirstlane(list[(II)]); const int kind = e & 15, tile = e >> 4; \
            if ((II) + 2 < n) { const int e2 = __builtin_amdgcn_readfirstlane(list[(II) + 2]); tile_load(F, l, q, e2 & 15, e2 >> 4, __builtin_amdgcn_readfirstlane(lpage[(II) + 2]), RR); } \
            __syncthreads(); \
            if (wact) { \
                if (kind != pkind) { \
                    const float L = half_sum(lsum); const float sc = L > 0.f ? GATE(1) / L : 0.f; \
                    _Pragma("unroll") for (int k = 0; k < 16; ++k) { outl[k * 64] += O[0][k] * sc; outl[(16 + k) * 64] += O[1][k] * sc; O[0][k] = 0.f; O[1][k] = 0.f; } \
                    m = 0.f; lsum = 0.f; started = false; pkind = kind; \
                } \
                int lo, hi; \
                if (kind == KIND_SLC) { const bool sb = (selw[tlc * 8 + (tile >> 5)] >> (tile & 31)) & 1u; lo = 0; hi = (sb && vcol) ? tpos : -1; } \
                else { lo = tpos - 511; hi = vcol ? tpos : -1; } \
                const bool any = (hi >= tile * 64) && (lo <= tile * 64 + 63); \
                if (__ballot(any) != 0ull) { \
                      \
                      \
                    const bool part = any && !((lo <= tile * 64) && (hi >= tile * 64 + 63)); \
                      \
                      \
                    f32x16 s0, s1; qk_tile(kb, qf, s0, s1, lane, any ? -m : -INFINITY); \
                    if (__ballot(part) != 0ull) mask_tile(s0, s1, tile * 64 + 4 * h, lo, hi); \
                    const float mt = tile_max(s0, s1); \
                    const bool seen = mt > -INFINITY; const bool need = (mt > 8.f) || (seen && !started); started = started || seen; \
                    if (__ballot(need) != 0ull) { \
                        const float dl = need ? mt : 0.f; const float al = __builtin_amdgcn_exp2f(-dl); m += dl; lsum *= al; \
                        _Pragma("unroll") for (int k = 0; k < 16; ++k) { s0[k] -= dl; s1[k] -= dl; O[0][k] *= al; O[1][k] *= al; } } \
                    float rs = 0.f; \
                    _Pragma("unroll") for (int k = 0; k < 16; ++k) { s0[k] = __builtin_amdgcn_exp2f(s0[k]); s1[k] = __builtin_amdgcn_exp2f(s1[k]); rs += s0[k] + s1[k]; } \
                    lsum += rs; \
                    pv_tile(vb, s0, s1, O, lane); \
                } \
            } } while (0)
        for (int i = 0; i < n; i += 2) {
            ATTN_STEP(R0, 0, i);
            if (i + 1 < n) ATTN_STEP(R1, 1, i + 1);
        }
#undef ATTN_STEP
        if (wact) {
            const float L = half_sum(lsum); const float sc = L > 0.f ? (pkind == KIND_SLC ? GATE(1) : GATE(2)) / L : 0.f;
#pragma unroll
            for (int k = 0; k < 16; ++k) { O[0][k] = outl[k * 64] + O[0][k] * sc; O[1][k] = outl[(16 + k) * 64] + O[1][k] * sc; }
        }
    }
    if (vcol) {
        bf16* mo = WSP(F, bf16, WS_MIX) + (size_t)r * DM + 768 + head * 64;
#pragma unroll
        for (int dh = 0; dh < 2; ++dh)
#pragma unroll
            for (int gq = 0; gq < 4; ++gq) {
                const int d = dh * 32 + 8 * gq + 4 * h;
                *(unsigned long long*)(mo + d) = (unsigned long long)cvtpk(O[dh][4 * gq], O[dh][4 * gq + 1]) | ((unsigned long long)cvtpk(O[dh][4 * gq + 2], O[dh][4 * gq + 3]) << 32);
            }
    }
}

#undef GATE
constexpr int SW_T = 0, SW_ML = 65536, SW_IMPG = SW_ML + 4096, SW_IMPE = SW_IMPG + 4096, SW_SEL = SW_IMPE + 4096, SW_UNI = SW_SEL + 256, SW_LIST = SW_UNI + 64,
              SW_PAGE = SW_LIST + 1280, SW_NL = SW_PAGE + 1280, SW_RANK = SW_NL + 64, SW_OUT = SW_RANK + 8 * 1024, SW_END = SW_OUT + 8192;
static_assert(SW_END <= RING_BYTES, "sample attention LDS map");
struct HRegs { f32x4 v[8]; };
__device__ __forceinline__ void h_load(const Frame& F, int l, int b, int kind, int ht, int pg, int which, int lane_in, HRegs& R) {
    int lane = lane_in; asm volatile("" : "+v"(lane));
    const int key = ht * 32 + (lane >> 1), hv = lane & 1;
    const float* base; size_t off; bool ok;
    if (kind <= KIND_CMP2) { ok = key < NCMP_S; const int kc = ok ? key : 0;
        base = WSP(F, float, which ? WS_CVS : WS_CKS); off = (((size_t)l * BS + b) * NCMP_S + kc) * 64; }
    else if (kind == KIND_SLC) { ok = key < PAST + TS;
        if (key < PAST) { base = INP(F, I_CACHE); off = ((((size_t)l * NPHYS + pg) * PAGE + (key & 127)) * 4 + 2 + which) * 64; }
        else { const int kk = ok ? key - PAST : 0; base = F.out + O_KVS; off = ((size_t)l * NS + b * TS + kk) * 256 + (2 + which) * 64; } }
    else { ok = (key >= PAST - 512) && (key < PAST + TS);
        if (key < PAST) { const int kk = ok ? key - (PAST - 512) : 0; base = INP(F, I_SWIN); off = (((size_t)l * BS + b) * 512 + kk) * 128 + which * 64; }
        else { const int kk = ok ? key - PAST : 0; base = WSP(F, float, WS_KWIN); off = ((size_t)NP + b * TS + kk) * 128 + which * 64; } }
    const float* p = base + off + hv * 32;
#pragma unroll
    for (int i = 0; i < 8; ++i) { const f32x4 x = *(const f32x4*)(p + 4 * i); R.v[i] = ok ? x : (f32x4){0.f, 0.f, 0.f, 0.f}; }
}
__device__ __forceinline__ void h_store_k(LAS unsigned char* kb, const HRegs& R, int lane_in) {
    int lane = lane_in; asm volatile("" : "+v"(lane));
    const int key = lane >> 1, hv = lane & 1;
#pragma unroll
    for (int i = 0; i < 4; ++i) { v4u o; o.x = cvtpk(R.v[2 * i].x, R.v[2 * i].y); o.y = cvtpk(R.v[2 * i].z, R.v[2 * i].w); o.z = cvtpk(R.v[2 * i + 1].x, R.v[2 * i + 1].y); o.w = cvtpk(R.v[2 * i + 1].z, R.v[2 * i + 1].w);
        *(LAS v4u*)(kb + key * 128 + (((4 * hv + i) ^ (key & 7)) << 4)) = o; }
}
__device__ __forceinline__ void h_store_v(LAS unsigned char* vb, const HRegs& R, int lane_in) {
    int lane = lane_in; asm volatile("" : "+v"(lane));
    const int key = lane >> 1, hv = lane & 1;
#pragma unroll
    for (int i = 0; i < 8; ++i) {
        const float xs[4] = {R.v[i].x, R.v[i].y, R.v[i].z, R.v[i].w};
#pragma unroll
        for (int k = 0; k < 4; ++k) { const int d = 32 * hv + 4 * i + k;
            *(LAS unsigned short*)(vb + d * 64 + (((key >> 2) ^ ((d >> 2) & 7)) << 3) + (key & 3) * 2) = (unsigned short)f2bf(xs[k]); }
    }
}
__device__ __forceinline__ void qk_half(const LAS unsigned char* kb, const bf16x8 (&qf)[4], f32x16& s0, int lane_in) {
    int lane = lane_in; asm volatile("" : "+v"(lane));
    const int r = lane & 31, h = lane >> 5;
#pragma unroll
    for (int i = 0; i < 16; ++i) s0[i] = 0.f;
#pragma unroll
    for (int ks = 0; ks < 4; ++ks) { const bf16x8 a0 = *(const LAS bf16x8*)(kb + r * 128 + (((2 * ks + h) ^ (r & 7)) << 4));
        s0 = __builtin_amdgcn_mfma_f32_32x32x16_bf16(a0, qf[ks], s0, 0, 0, 0); }
}
__device__ __forceinline__ void pv_half(const LAS unsigned char* vb, const f32x16& s0, f32x16 (&O)[2], int lane_in) {
    int lane = lane_in; asm volatile("" : "+v"(lane));
    const int r = lane & 31, h = lane >> 5;
    bf16x8 pf[2];
#pragma unroll
    for (int sp = 0; sp < 2; ++sp) { v4u a; a.x = cvtpk(s0[8 * sp + 0], s0[8 * sp + 1]); a.y = cvtpk(s0[8 * sp + 2], s0[8 * sp + 3]); a.z = cvtpk(s0[8 * sp + 4], s0[8 * sp + 5]); a.w = cvtpk(s0[8 * sp + 6], s0[8 * sp + 7]);
        pf[sp] = __builtin_bit_cast(bf16x8, a); }
#pragma unroll
    for (int dh = 0; dh < 2; ++dh) { const int d = dh * 32 + r, sw = (d >> 2) & 7; const LAS unsigned char* rb = vb + d * 64;
#pragma unroll
        for (int sp = 0; sp < 2; ++sp) { const int q0 = 4 * sp + h;
            const unsigned long long lo8 = *(const LAS unsigned long long*)(rb + ((q0 ^ sw) << 3)), hi8 = *(const LAS unsigned long long*)(rb + (((q0 + 2) ^ sw) << 3));
            v4u av; av.x = (unsigned)lo8; av.y = (unsigned)(lo8 >> 32); av.z = (unsigned)hi8; av.w = (unsigned)(hi8 >> 32);
            O[dh] = __builtin_amdgcn_mfma_f32_32x32x16_bf16(__builtin_bit_cast(bf16x8, av), pf[sp], O[dh], 0, 0, 0); } }
}
__device__ __forceinline__ void mask_half(f32x16& s0, int kbase, int lo, int hi) {
#pragma unroll
    for (int i = 0; i < 16; ++i) { const int k = kbase + (i & 3) + 8 * (i >> 2); if (k < lo || k > hi) s0[i] = -INFINITY; }
}
__device__ __forceinline__ float max16(const f32x16& s0) {
    float a = s0[0];
#pragma unroll
    for (int i = 1; i < 16; ++i) a = fmaxf(a, s0[i]);
    return half_max(a);
}
__device__ __forceinline__ void merge_branch(LAS unsigned char* lds, int wave, int lane, float m, float lsum, f32x16 (&O)[2], float gate) {
    LAS float* ml = (LAS float*)(lds + SW_ML); LAS float* outl = (LAS float*)(lds + SW_OUT) + lane;
    LAS float* slot = (LAS float*)(lds + SW_T + wave * 8192) + lane;
    const float lw = half_sum(lsum);
    ml[wave * 64 + lane] = m; ml[512 + wave * 64 + lane] = lw;
#pragma unroll
    for (int i = 0; i < 16; ++i) { slot[i * 64] = O[0][i]; slot[(16 + i) * 64] = O[1][i]; O[0][i] = 0.f; O[1][i] = 0.f; }
    __syncthreads();
    float M = -1e30f;
#pragma unroll
    for (int w = 0; w < 8; ++w) M = fmaxf(M, ml[w * 64 + lane]);
    float L = 0.f, sc[8];
#pragma unroll
    for (int w = 0; w < 8; ++w) { sc[w] = __builtin_amdgcn_exp2f(ml[w * 64 + lane] - M); L += ml[512 + w * 64 + lane] * sc[w]; }
    const float gl = (L > 0.f) ? gate / L : 0.f;
#pragma unroll
    for (int k = 0; k < 4; ++k) { const int i = wave * 4 + k; float a = 0.f;
#pragma unroll
        for (int w = 0; w < 8; ++w) a += ((LAS float*)(lds + SW_T + w * 8192))[i * 64 + lane] * sc[w];
        outl[i * 64] += a * gl; }
    __syncthreads();
}

__device__ __forceinline__ void attn_sample_unit(const Frame& F, int l, int b, int t0) {
    int lane_ = F.lane; asm volatile("" : "+v"(lane_));
    const int lane = lane_, wave = F.wave, tid = wave * 64 + lane, h = lane >> 5;
    LAS unsigned char* lds = F.lds;
    LAS unsigned char* kb = lds + SW_T + wave * 8192; LAS unsigned char* vb = kb + 4096;
    LAS float* impG = (LAS float*)(lds + SW_IMPG); LAS float* impE = (LAS float*)(lds + SW_IMPE);
    LAS unsigned* selw = (LAS unsigned*)(lds + SW_SEL); LAS unsigned* uni = (LAS unsigned*)(lds + SW_UNI);
    LAS int* list = (LAS int*)(lds + SW_LIST); LAS int* lpage = (LAS int*)(lds + SW_PAGE); LAS int* nlist = (LAS int*)(lds + SW_NL);
    LAS float* rankv = (LAS float*)(lds + SW_RANK + wave * 1024);
    LAS float* outl = (LAS float*)(lds + SW_OUT);
    const int tl = 0, head = lane & 3; const bool wcol = ((lane & 31) >> 2) == 0;
    const int r = NP + b * TS + t0, tpos = PAST + t0;
    bf16x8 qf[4];
    { const bf16* qb = WSP(F, bf16, WS_QB) + ((size_t)r * 4 + head) * 64;
#pragma unroll
      for (int ks = 0; ks < 4; ++ks) qf[ks] = *(const bf16x8*)(qb + 16 * ks + 8 * h); }
    const float* gp = WSP(F, float, WS_PROJ) + (size_t)r * IN_WP + OFF_G + head * 3;
    const float g0 = sigmoidf_(gp[0]), g1 = sigmoidf_(gp[1]), g2 = sigmoidf_(gp[2]);
    f32x16 O[2];
#pragma unroll
    for (int i = 0; i < 16; ++i) { O[0][i] = 0.f; O[1][i] = 0.f; }
    __syncthreads();
    if (tid < 64) selw[tid] = 0u;
    f32x16 sa, sb; float m = -1e30f, lsum = 0.f;
    {
        HRegs Ra, Rb; h_load(F, l, b, KIND_CMP1, wave, 0, 0, lane, Ra); h_load(F, l, b, KIND_CMP1, wave + 8, 0, 0, lane, Rb);
        h_store_k(kb, Ra, lane); asm volatile("s_waitcnt lgkmcnt(0)" ::: "memory");
        qk_half(kb, qf, sa, lane); mask_half(sa, wave * 32 + 4 * h, 0, NCMP_S - 1);
        asm volatile("s_waitcnt lgkmcnt(0)" ::: "memory");
        h_store_k(kb, Rb, lane); asm volatile("s_waitcnt lgkmcnt(0)" ::: "memory");
        qk_half(kb, qf, sb, lane); mask_half(sb, (wave + 8) * 32 + 4 * h, 0, NCMP_S - 1);
        m = fmaxf(max16(sa), max16(sb));
#pragma unroll
        for (int k = 0; k < 16; ++k) lsum += __builtin_amdgcn_exp2f(sa[k] - m) + __builtin_amdgcn_exp2f(sb[k] - m);
    }
    {
        LAS float* ml = (LAS float*)(lds + SW_ML);
        const float lw = half_sum(lsum);
        ml[wave * 64 + lane] = m; ml[512 + wave * 64 + lane] = lw;
        HRegs Ra, Rb; h_load(F, l, b, KIND_CMP2, wave, 0, 1, lane, Ra); h_load(F, l, b, KIND_CMP2, wave + 8, 0, 1, lane, Rb);
        __syncthreads();
        float M = -1e30f;
#pragma unroll
        for (int w = 0; w < 8; ++w) M = fmaxf(M, ml[w * 64 + lane]);
        float L = 0.f;
#pragma unroll
        for (int w = 0; w < 8; ++w) L += ml[512 + w * 64 + lane] * __builtin_amdgcn_exp2f(ml[w * 64 + lane] - M);
        const float rinv = L > 0.f ? 1.f / L : 0.f;
#pragma unroll
        for (int pass = 0; pass < 2; ++pass) {
            f32x16& sv = pass ? sb : sa; const int ht = pass ? wave + 8 : wave;
#pragma unroll
            for (int k = 0; k < 16; ++k) sv[k] = __builtin_amdgcn_exp2f(sv[k] - M) * rinv;
            if (pass) h_store_v(vb, Rb, lane); else h_store_v(vb, Ra, lane);
            asm volatile("s_waitcnt lgkmcnt(0)" ::: "memory");
            pv_half(vb, sv, O, lane);
            asm volatile("s_waitcnt lgkmcnt(0)" ::: "memory");
#pragma unroll
            for (int gq = 0; gq < 4; ++gq) {
                float G = (sv[4 * gq] + sv[4 * gq + 1]) + (sv[4 * gq + 2] + sv[4 * gq + 3]), E = sv[4 * gq + 3];
                G += __shfl_xor(G, 1); G += __shfl_xor(G, 2); E += __shfl_xor(E, 1); E += __shfl_xor(E, 2);
                const int j = 8 * ht + 2 * gq + h;
                if (head == 0) { impG[tl * 128 + j] = G; impE[tl * 128 + j] = E; }
            }
        }
        { LAS float* slot = (LAS float*)(lds + SW_T + wave * 8192) + lane;
#pragma unroll
          for (int i = 0; i < 16; ++i) { slot[i * 64] = O[0][i]; slot[(16 + i) * 64] = O[1][i]; O[0][i] = 0.f; O[1][i] = 0.f; } }
    }
    __syncthreads();
#pragma unroll
    for (int k = 0; k < 4; ++k) { const int i = wave * 4 + k; float a = 0.f;
#pragma unroll
        for (int w = 0; w < 8; ++w) a += ((LAS float*)(lds + SW_T + w * 8192))[i * 64 + lane];
        outl[i * 64 + lane] = a * g0; }
    __syncthreads();
    if (wave == 0) {
        const int tk = 0, cur = tpos >> 6;
        for (int j = lane; j < 132; j += 64) {
            float v;
            if (j > cur) v = -INFINITY;
            else if (j == 0 || j == cur || j == cur - 1) v = INFINITY;
            else v = impG[tk * 128 + j] + impE[tk * 128 + j - 1];
            rankv[j] = v;
        }
        asm volatile("s_waitcnt lgkmcnt(0)" ::: "memory");
        const float v0 = rankv[lane], v1 = rankv[64 + lane], v2 = (lane < 1) ? rankv[128 + lane] : -INFINITY;
        int r0 = 0, r1 = 0, r2 = 0;
        for (int k4 = 0; k4 < 132; k4 += 4) {
            const f32x4 vk = *(const LAS f32x4*)(rankv + k4);
#pragma unroll
            for (int u = 0; u < 4; ++u) { const float x = vk[u]; const int k = k4 + u;
                r0 += (x > v0 || (x == v0 && k < lane)) ? 1 : 0; r1 += (x > v1 || (x == v1 && k < 64 + lane)) ? 1 : 0; r2 += (x > v2 || (x == v2 && k < 128 + lane)) ? 1 : 0; }
        }
        const unsigned long long b0 = __ballot(r0 < 16 && lane <= cur), b1 = __ballot(r1 < 16 && 64 + lane <= cur), b2 = __ballot(lane < 1 && r2 < 16 && 128 + lane <= cur);
        if (lane == 0) { selw[tk * 8 + 0] = (unsigned)b0; selw[tk * 8 + 1] = (unsigned)(b0 >> 32); selw[tk * 8 + 2] = (unsigned)b1; selw[tk * 8 + 3] = (unsigned)(b1 >> 32); selw[tk * 8 + 4] = (unsigned)b2; }
    }
    __syncthreads();
    if (tid < 8) uni[tid] = selw[tid];
    __syncthreads();
    if (wave == 0) {
        int n = 0;
        for (int j0 = 0; j0 < 129; j0 += 64) {
            const int j = j0 + lane; const bool sj = (j < 129) && ((uni[j >> 5] >> (j & 31)) & 1u);
            int pg = 0; if (sj && j * 64 < PAST) pg = ((const int*)INP(F, I_PT))[b * NPAGES + (j >> 1)];
            const unsigned long long bal = __ballot(sj);
            if (sj) { const int idx = n + 2 * __popcll(bal & ((1ull << lane) - 1ull)); list[idx] = KIND_SLC | ((2 * j) << 4); list[idx + 1] = KIND_SLC | ((2 * j + 1) << 4); lpage[idx] = pg; lpage[idx + 1] = pg; }
            n += 2 * __popcll(bal);
        }
        if (lane == 0) nlist[0] = n;
        const int w0 = (PAST - 512) / 32, w1 = (PAST + TS - 1) / 32;
        if (lane <= w1 - w0) { list[n + lane] = KIND_WIN | ((w0 + lane) << 4); lpage[n + lane] = 0; }
        if (lane == 0) nlist[1] = n + (w1 - w0 + 1);
    }
    __syncthreads();
    const int n_slc = nlist[0], n_all = nlist[1];
#pragma unroll 1
    for (int br = 0; br < 2; ++br) {
        const int i0 = br ? n_slc : 0, i1 = br ? n_all : n_slc;
        m = -1e30f; lsum = 0.f;
        HRegs Rk, Rv;
        int it = i0 + wave;
        if (it < i1) { const int e = list[it], pg = lpage[it]; h_load(F, l, b, e & 15, e >> 4, pg, 0, lane, Rk); h_load(F, l, b, e & 15, e >> 4, pg, 1, lane, Rv); }
#pragma unroll 1
        for (; it < i1; it += 8) {
            const int e = __builtin_amdgcn_readfirstlane(list[it]); const int kind = e & 15, ht = e >> 4;
            h_store_k(kb, Rk, lane); h_store_v(vb, Rv, lane);
            if (it + 8 < i1) { const int e2 = list[it + 8], pg2 = lpage[it + 8]; h_load(F, l, b, e2 & 15, e2 >> 4, pg2, 0, lane, Rk); h_load(F, l, b, e2 & 15, e2 >> 4, pg2, 1, lane, Rv); }
            asm volatile("s_waitcnt lgkmcnt(0)" ::: "memory");
            int lo, hi;
            if (kind == KIND_SLC) { const int j = ht >> 1; const bool sbit = (selw[tl * 8 + (j >> 5)] >> (j & 31)) & 1u; lo = 0; hi = sbit ? tpos : -1; }
            else { lo = tpos - 511; hi = tpos; }
            f32x16 s0; qk_half(kb, qf, s0, lane);
            mask_half(s0, ht * 32 + 4 * h, lo, hi);
            const float mt = max16(s0); const float mn = fmaxf(m, mt); const float al = __builtin_amdgcn_exp2f(m - mn);
            float rs = 0.f;
#pragma unroll
            for (int k = 0; k < 16; ++k) { s0[k] = __builtin_amdgcn_exp2f(s0[k] - mn); rs += s0[k]; }
            lsum = lsum * al + rs; m = mn;
#pragma unroll
            for (int k = 0; k < 16; ++k) { O[0][k] *= al; O[1][k] *= al; }
            pv_half(vb, s0, O, lane);
            asm volatile("s_waitcnt lgkmcnt(0)" ::: "memory");
        }
        merge_branch(lds, wave, lane, m, lsum, O, br ? g2 : g1);
    }
    if (wave == 0 && wcol) {
        bf16* mo = WSP(F, bf16, WS_MIX) + (size_t)r * DM + 768 + head * 64;
#pragma unroll
        for (int dh = 0; dh < 2; ++dh)
#pragma unroll
            for (int gq = 0; gq < 4; ++gq) { const int d = dh * 32 + 8 * gq + 4 * h; const LAS float* o = outl + (dh * 16 + 4 * gq) * 64 + lane;
                *(unsigned long long*)(mo + d) = (unsigned long long)cvtpk(o[0], o[64]) | ((unsigned long long)cvtpk(o[128], o[192]) << 32); }
    }
    __syncthreads();
}


__device__ __forceinline__ void phase_attn2(const Frame& F, int l) {
    for (int u = blockIdx.x; u < 256; u += F.G) attn_unit(F, l, u & 7, (u >> 3) * 64, 64);
    Frame G2 = F; { int ln = G2.lane; asm volatile("" : "+v"(ln)); G2.lane = ln; G2.tid = G2.wave * 64 + ln; }
    if (F.G == 256) { if (blockIdx.x < 128) { ssd_out_unit(G2, l, (int)blockIdx.x >> 5, (int)blockIdx.x & 31); ssd_out_unit(G2, l, ((int)blockIdx.x + 128) >> 5, ((int)blockIdx.x + 128) & 31); } }
    else for (int u = blockIdx.x; u < BP * 32; u += F.G) ssd_out_unit(G2, l, u >> 5, u & 31);
    for (int r = NP + G2.gw; r < MROWS; r += G2.ngw) ssd_finish_token(G2, l, r);
    {
        const int ncb = (F.G == 256) ? 64 : F.G;
        if ((int)blockIdx.x < ncb) {
            const f32x4* src = (const f32x4*)(INP(F, I_SWIN) + (size_t)l * BS * 512 * 128);
            f32x4* dst = (f32x4*)(F.out + O_WINS + (size_t)l * BS * 512 * 128);
            const int nth = ncb * NTHR;
            for (int i0 = blockIdx.x * NTHR + G2.tid; i0 < BS * 504 * 32; i0 += 4 * nth) {
                f32x4 v[4]; size_t o[4]; bool ok[4];
#pragma unroll
                for (int k = 0; k < 4; ++k) { const int i = i0 + k * nth; ok[k] = i < BS * 504 * 32; const int ic = ok[k] ? i : 0; const int b = ic / (504 * 32), rem = ic % (504 * 32);
                    o[k] = (size_t)b * 512 * 32 + rem; v[k] = src[o[k] + 8 * 32]; }
#pragma unroll
                for (int k = 0; k < 4; ++k) if (ok[k]) dst[o[k]] = v[k];
            }
        }
    }
}


constexpr float LOG2E = 1.4426950408889634f;
constexpr int SD_B = 0, SD_BT = 32768, SD_C = 65536, SD_AC = 98304, SD_DT = SD_AC + 2048, SD_W = SD_DT + 2048, SD_END = SD_W + 2048;
static_assert(SD_END <= RING_BYTES, "ssd LDS map");
__device__ __forceinline__ int crow16(int i, int hp) { return (i & 3) + 8 * (i >> 2) + 4 * hp; }
__device__ __forceinline__ unsigned long long pack4bf(float a, float b, float c, float d) { return (unsigned long long)cvtpk(a, b) | ((unsigned long long)cvtpk(c, d) << 32); }

__device__ __forceinline__ void ssd_chunk_unit(const Frame& F, int l, int b, int c, int g) {
    const int tid = F.tid, lane = F.lane, wave = F.wave;
    LAS unsigned char* lds = F.lds;
    const float* proj = WSP(F, float, WS_PROJ);
    const size_t rbase = (size_t)b * TP + (size_t)c * 128;
    const float* cw = INP(F, I_CONVW) + (size_t)l * 4 * CONV_DIM; const float* cbv = INP(F, I_CONVB) + (size_t)l * CONV_DIM;
    LAS float* acs = (LAS float*)(lds + SD_AC); LAS float* dts = (LAS float*)(lds + SD_DT); LAS float* wts = (LAS float*)(lds + SD_W);
    __syncthreads();
    if (wave < 4) {
        const int hh = wave, head = 4 * g + hh;
        const float a2 = -expf(INP(F, I_ALOG)[l * SSD_H + head]) * LOG2E, dtb = INP(F, I_DTB)[l * SSD_H + head];
        const float d0 = softplusf_(proj[(rbase + 2 * lane) * IN_WP + OFF_DT + head] + dtb), d1 = softplusf_(proj[(rbase + 2 * lane + 1) * IN_WP + OFF_DT + head] + dtb);
        float sc = (d0 + d1) * a2;
#pragma unroll
        for (int o = 1; o < 64; o <<= 1) { const float t = __shfl_up(sc, o); if (lane >= o) sc += t; }
        const float ac1 = sc, ac0 = sc - d1 * a2; const float tot = __uint_as_float(__builtin_amdgcn_readlane(__float_as_uint(sc), 63));
        acs[hh * 128 + 2 * lane] = ac0; acs[hh * 128 + 2 * lane + 1] = ac1; dts[hh * 128 + 2 * lane] = d0; dts[hh * 128 + 2 * lane + 1] = d1;
        wts[hh * 128 + 2 * lane] = __builtin_amdgcn_exp2f(tot - ac0); wts[hh * 128 + 2 * lane + 1] = __builtin_amdgcn_exp2f(tot - ac1);
        float* acg = WSP(F, float, WS_SAC); acg[(rbase + 2 * lane) * SSD_H + head] = ac0; acg[(rbase + 2 * lane + 1) * SSD_H + head] = ac1;
        if (lane == 63) WSP(F, float, WS_SCD)[((size_t)b * 16 + c) * SSD_H + head] = __builtin_amdgcn_exp2f(tot);
    }
    {
        const int ch = tid & 255, th = tid >> 8;
        const int chan = (ch < 128) ? 512 + g * 128 + ch : 768 + g * 128 + (ch - 128);
        const float w0 = cw[chan], w1 = cw[CONV_DIM + chan], w2 = cw[2 * CONV_DIM + chan], w3 = cw[3 * CONV_DIM + chan], bb = cbv[chan];
        const int tl0 = th * 64;
        const float* src = proj + (rbase + tl0) * IN_WP + OFF_XBC + chan;
        const bool hasp = (c > 0) || (th > 0);
        float x0 = hasp ? src[-3 * IN_WP] : 0.f, x1 = hasp ? src[-2 * IN_WP] : 0.f, x2 = hasp ? src[-IN_WP] : 0.f;
        const int n = ch & 127;
        bf16* cbg = WSP(F, bf16, WS_SCB) + (rbase + tl0) * 256 + g * 128 + n;
        for (int i1 = 0; i1 < 64; i1 += 16) {
          float rawv[16];
#pragma unroll
          for (int k = 0; k < 16; ++k) rawv[k] = src[(size_t)(i1 + k) * IN_WP];
#pragma unroll
          for (int i2 = 0; i2 < 16; i2 += 4) { const int i0 = i1 + i2;
            float v[4];
#pragma unroll
            for (int k = 0; k < 4; ++k) { const float cur = rawv[i2 + k]; v[k] = siluf_(bb + w0 * x0 + w1 * x1 + w2 * x2 + w3 * cur); x0 = x1; x1 = x2; x2 = cur; }
            const int s = tl0 + i0;
            if (ch < 128) {
#pragma unroll
                for (int k = 0; k < 4; ++k) *(LAS unsigned short*)(lds + SD_B + (s + k) * 256 + (((n >> 3) ^ ((s + k) & 15)) << 4) + (n & 7) * 2) = (unsigned short)f2bf(v[k]);
                *(LAS unsigned long long*)(lds + SD_BT + n * 256 + (((s >> 2) ^ (n & 31)) << 3)) = pack4bf(v[0], v[1], v[2], v[3]);
            } else {
#pragma unroll
                for (int k = 0; k < 4; ++k) { const unsigned short hv = (unsigned short)f2bf(v[k]);
                    *(LAS unsigned short*)(lds + SD_C + (s + k) * 256 + (((n >> 3) ^ ((s + k) & 15)) << 4) + (n & 7) * 2) = hv; cbg[(size_t)(i0 + k) * 256] = hv; }
            }
          }
        }
    }
    __syncthreads();
    const int lb = wave & 3, hw = wave >> 2;
    int lane_g = lane; asm volatile("" : "+v"(lane_g));
    f32x16 Gt[4];
    {
        const int r32 = lane_g & 31, hp = lane_g >> 5, lloc = lb * 32 + r32;
        bf16x8 cf[8];
#pragma unroll
        for (int ks = 0; ks < 8; ++ks) cf[ks] = *(const LAS bf16x8*)(lds + SD_C + lloc * 256 + (((2 * ks + hp) ^ (lloc & 15)) << 4));
#pragma unroll
        for (int sb = 0; sb < 4; ++sb) {
#pragma unroll
            for (int i = 0; i < 16; ++i) Gt[sb][i] = 0.f;
            if (sb <= lb) {
                int s = sb * 32 + r32; asm volatile("" : "+v"(s));
#pragma unroll
                for (int ks = 0; ks < 8; ++ks) { const bf16x8 a = *(const LAS bf16x8*)(lds + SD_B + s * 256 + (((2 * ks + hp) ^ (s & 15)) << 4));
                    Gt[sb] = __builtin_amdgcn_mfma_f32_32x32x16_bf16(a, cf[ks], Gt[sb], 0, 0, 0); }
            }
            __builtin_amdgcn_sched_barrier(0);
        }
    }
    __syncthreads();
    for (int rd = 0; rd < 2; ++rd) {
        {
            int tid_r = tid; asm volatile("" : "+v"(tid_r));
            const int ch = tid_r & 127, tq = tid_r >> 7; const int hh2 = ch >> 6, p = ch & 63, hh = 2 * rd + hh2;
            const int chan = (4 * g + hh) * 64 + p;
            const float w0 = cw[chan], w1 = cw[CONV_DIM + chan], w2 = cw[2 * CONV_DIM + chan], w3 = cw[3 * CONV_DIM + chan], bb = cbv[chan];
            const int tl0 = tq * 32;
            const float* src = proj + (rbase + tl0) * IN_WP + OFF_XBC + chan;
            const bool hasp = (c > 0) || (tq > 0);
            float x0 = hasp ? src[-3 * IN_WP] : 0.f, x1 = hasp ? src[-2 * IN_WP] : 0.f, x2 = hasp ? src[-IN_WP] : 0.f;
            for (int i1 = 0; i1 < 32; i1 += 16) {
              float rawv[16];
#pragma unroll
              for (int k = 0; k < 16; ++k) rawv[k] = src[(size_t)(i1 + k) * IN_WP];
#pragma unroll
              for (int i2 = 0; i2 < 16; i2 += 4) { const int i0 = i1 + i2;
                float v[4]; const int s = tl0 + i0;
#pragma unroll
                for (int k = 0; k < 4; ++k) { const float cur = rawv[i2 + k]; v[k] = siluf_(bb + w0 * x0 + w1 * x1 + w2 * x2 + w3 * cur) * dts[hh * 128 + s + k]; x0 = x1; x1 = x2; x2 = cur; }
                *(LAS unsigned long long*)(lds + SD_C + hh2 * 16384 + p * 256 + (((s >> 2) ^ (p & 31)) << 3)) = pack4bf(v[0], v[1], v[2], v[3]);
              }
            }
        }
        __syncthreads();
        int lane_r = lane; asm volatile("" : "+v"(lane_r));
        const int r32 = lane_r & 31, hp = lane_r >> 5, lloc = lb * 32 + r32;
        const int hh = 2 * rd + hw, head = 4 * g + hh;
        const LAS float* ac = acs + hh * 128; const LAS float* wp = wts + hh * 128;
        const LAS unsigned char* xt = lds + SD_C + hw * 16384;
        const float acl = ac[lloc], ddt = INP(F, I_SSDD)[l * SSD_H + head] / dts[hh * 128 + lloc];
        f32x16 Y[2];
#pragma unroll
        for (int i = 0; i < 16; ++i) { Y[0][i] = 0.f; Y[1][i] = 0.f; }
#pragma unroll
        for (int sb = 0; sb < 4; ++sb) {
            if (sb <= lb) {
                f32x16 mt;
#pragma unroll
                for (int i = 0; i < 16; ++i) { const int s = sb * 32 + crow16(i, hp);
                    float mv = Gt[sb][i] * __builtin_amdgcn_exp2f(acl - ac[s]);
                    if (sb == lb) { mv = (s > lloc) ? 0.f : mv; mv += (s == lloc) ? ddt : 0.f; }
                    mt[i] = mv; }
                bf16x8 pf[2];
#pragma unroll
                for (int sp = 0; sp < 2; ++sp) { v4u a; a.x = cvtpk(mt[8 * sp + 0], mt[8 * sp + 1]); a.y = cvtpk(mt[8 * sp + 2], mt[8 * sp + 3]); a.z = cvtpk(mt[8 * sp + 4], mt[8 * sp + 5]); a.w = cvtpk(mt[8 * sp + 6], mt[8 * sp + 7]);
                    pf[sp] = __builtin_bit_cast(bf16x8, a); }
#pragma unroll
                for (int pt = 0; pt < 2; ++pt) { int p = pt * 32 + r32; asm volatile("" : "+v"(p)); const int sw = p & 31; const LAS unsigned char* rb = xt + p * 256;
#pragma unroll
                    for (int sp = 0; sp < 2; ++sp) { const int q0 = sb * 8 + 4 * sp + hp;
                        const unsigned long long lo8 = *(const LAS unsigned long long*)(rb + ((q0 ^ sw) << 3)), hi8 = *(const LAS unsigned long long*)(rb + (((q0 + 2) ^ sw) << 3));
                        v4u av; av.x = (unsigned)lo8; av.y = (unsigned)(lo8 >> 32); av.z = (unsigned)hi8; av.w = (unsigned)(hi8 >> 32);
                        Y[pt] = __builtin_amdgcn_mfma_f32_32x32x16_bf16(__builtin_bit_cast(bf16x8, av), pf[sp], Y[pt], 0, 0, 0); } }
            }
            __builtin_amdgcn_sched_barrier(0);
        }
        {
            float* yo = WSP(F, float, WS_YSSD) + (rbase + lloc) * SSD_W + head * 64;
#pragma unroll
            for (int pt = 0; pt < 2; ++pt)
#pragma unroll
                for (int qd = 0; qd < 4; ++qd) *(f32x4*)(yo + pt * 32 + 8 * qd + 4 * hp) = (f32x4){Y[pt][4 * qd], Y[pt][4 * qd + 1], Y[pt][4 * qd + 2], Y[pt][4 * qd + 3]};
        }
        {
            f32x16 St[2];
#pragma unroll
            for (int i = 0; i < 16; ++i) { St[0][i] = 0.f; St[1][i] = 0.f; }
            const int n = lb * 32 + r32;
#pragma unroll
            for (int ks = 0; ks < 8; ++ks) {
                const int cb0 = 4 * ks + 2 * hp; int nn = n; asm volatile("" : "+v"(nn));
                const unsigned long long blo = *(const LAS unsigned long long*)(lds + SD_BT + nn * 256 + ((cb0 ^ (nn & 31)) << 3)), bhi = *(const LAS unsigned long long*)(lds + SD_BT + nn * 256 + (((cb0 + 1) ^ (nn & 31)) << 3));
                v4u bv; bv.x = (unsigned)blo; bv.y = (unsigned)(blo >> 32); bv.z = (unsigned)bhi; bv.w = (unsigned)(bhi >> 32);
                const f32x4 wa = *(const LAS f32x4*)(wp + 16 * ks + 8 * hp), wb = *(const LAS f32x4*)(wp + 16 * ks + 8 * hp + 4);
#pragma unroll
                for (int pt = 0; pt < 2; ++pt) { const int p = pt * 32 + (nn & 31); const LAS unsigned char* rb = xt + p * 256;
                    const unsigned long long alo = *(const LAS unsigned long long*)(rb + ((cb0 ^ (p & 31)) << 3)), ahi = *(const LAS unsigned long long*)(rb + (((cb0 + 1) ^ (p & 31)) << 3));
                    const unsigned a0 = (unsigned)alo, a1 = (unsigned)(alo >> 32), a2 = (unsigned)ahi, a3 = (unsigned)(ahi >> 32);
                    v4u av;
                    av.x = cvtpk(__uint_as_float(a0 << 16) * wa.x, __uint_as_float(a0 & 0xffff0000u) * wa.y); av.y = cvtpk(__uint_as_float(a1 << 16) * wa.z, __uint_as_float(a1 & 0xffff0000u) * wa.w);
                    av.z = cvtpk(__uint_as_float(a2 << 16) * wb.x, __uint_as_float(a2 & 0xffff0000u) * wb.y); av.w = cvtpk(__uint_as_float(a3 << 16) * wb.z, __uint_as_float(a3 & 0xffff0000u) * wb.w);
                    St[pt] = __builtin_amdgcn_mfma_f32_32x32x16_bf16(__builtin_bit_cast(bf16x8, av), __builtin_bit_cast(bf16x8, bv), St[pt], 0, 0, 0); }
                __builtin_amdgcn_sched_barrier(0);
            }
            float* cs = WSP(F, float, WS_SCS) + (((size_t)b * 16 + c) * SSD_H + head) * (SSD_HD * SSD_N) + n;
#pragma unroll
            for (int pt = 0; pt < 2; ++pt)
#pragma unroll
                for (int i = 0; i < 16; ++i) cs[(size_t)(pt * 32 + crow16(i, hp)) * SSD_N] = St[pt][i];
        }
        __syncthreads();
    }
}

__device__ __forceinline__ void ssd_scan(const Frame& F, int l) {
    const float* cs = WSP(F, float, WS_SCS); const float* cd = WSP(F, float, WS_SCD); bf16* hs = WSP(F, bf16, WS_SHS);
    const bool upper = (F.G == 256);
    for (int idx0 = blockIdx.x * NTHR + F.tid; idx0 < BP * SSD_H * 2048; idx0 += F.G * NTHR) {
        if (upper && blockIdx.x < 128) continue;
#pragma unroll 1
        for (int rep = 0; rep < (upper ? 2 : 1); ++rep) {
            const int idx = upper ? idx0 - (1 - rep) * 65536 : idx0;
            const int e4 = idx & 2047, bh = idx >> 11, b = bh >> 3, h = bh & 7;
            f32x4 st = (f32x4){0.f, 0.f, 0.f, 0.f};
#pragma unroll 8
            for (int c = 0; c < 16; ++c) {
                const size_t o = (((size_t)b * 16 + c) * SSD_H + h) * (SSD_HD * SSD_N) + e4 * 4;
                *(unsigned long long*)(hs + o) = pack4bf(st.x, st.y, st.z, st.w);
                const f32x4 sv = *(const f32x4*)(cs + o); const float d = cd[((size_t)b * 16 + c) * SSD_H + h];
                st = st * d + sv;
            }
            *(f32x4*)(F.out + O_SSMP + (((size_t)l * BP + b) * SSD_H + h) * (SSD_HD * SSD_N) + e4 * 4) = st;
        }
    }
}

__device__ __forceinline__ void ssd_out_unit(const Frame& F, int l, int b, int hc) {
    const int lane = F.lane, h = F.wave, g = h >> 2, c = hc >> 1, l0 = hc * 64, r32 = lane & 31, hp = lane >> 5;
    LAS float* ssq = (LAS float*)F.lds;
    const bf16* Hs = WSP(F, bf16, WS_SHS) + (((size_t)b * 16 + c) * SSD_H + h) * (SSD_HD * SSD_N);
    const bf16* Cb = WSP(F, bf16, WS_SCB) + ((size_t)b * TP + l0) * 256 + g * 128;
    f32x16 Yo[2][2];
#pragma unroll
    for (int i = 0; i < 16; ++i) { Yo[0][0][i] = 0.f; Yo[0][1][i] = 0.f; Yo[1][0][i] = 0.f; Yo[1][1][i] = 0.f; }
#pragma unroll
    for (int ks = 0; ks < 8; ++ks) {
        bf16x8 af[2], bfr[2];
#pragma unroll
        for (int pt = 0; pt < 2; ++pt) af[pt] = *(const bf16x8*)(Hs + (size_t)(pt * 32 + r32) * SSD_N + 16 * ks + 8 * hp);
#pragma unroll
        for (int lt = 0; lt < 2; ++lt) bfr[lt] = *(const bf16x8*)(Cb + (size_t)(lt * 32 + r32) * 256 + 16 * ks + 8 * hp);
#pragma unroll
        for (int lt = 0; lt < 2; ++lt)
#pragma unroll
            for (int pt = 0; pt < 2; ++pt) Yo[lt][pt] = __builtin_amdgcn_mfma_f32_32x32x16_bf16(af[pt], bfr[lt], Yo[lt][pt], 0, 0, 0);
    }
    __syncthreads();
#pragma unroll
    for (int lt = 0; lt < 2; ++lt) {
        const size_t row = (size_t)b * TP + l0 + lt * 32 + r32;
        const float sc = __builtin_amdgcn_exp2f(WSP(F, float, WS_SAC)[row * SSD_H + h]);
        const float* yd = WSP(F, float, WS_YSSD) + row * SSD_W + h * 64; const float* zz = WSP(F, float, WS_PROJ) + row * IN_WP + h * 64;
        float ss = 0.f;
#pragma unroll
        for (int pt = 0; pt < 2; ++pt) {
            f32x4 y4v[4], z4v[4];
#pragma unroll
            for (int i = 0; i < 4; ++i) { const int p = pt * 32 + 8 * i + 4 * hp; y4v[i] = *(const f32x4*)(yd + p); z4v[i] = *(const f32x4*)(zz + p); }
#pragma unroll
            for (int qd = 0; qd < 4; ++qd) { const f32x4 y4 = y4v[qd], z4 = z4v[qd];
#pragma unroll
                for (int k = 0; k < 4; ++k) { const float v = (y4[k] + sc * Yo[lt][pt][4 * qd + k]) * siluf_(z4[k]); Yo[lt][pt][4 * qd + k] = v; ss += v * v; } }
        }
        ss = half_sum(ss);
        if (hp == 0) ssq[(lt * 32 + r32) * 8 + h] = ss;
    }
    __syncthreads();
    const float* nw = INP(F, I_SSDNORM) + (size_t)l * SSD_W + h * 64;
#pragma unroll
    for (int lt = 0; lt < 2; ++lt) {
        const size_t row = (size_t)b * TP + l0 + lt * 32 + r32;
        const LAS float* sq = ssq + (lt * 32 + r32) * 8;
        const float tot = ((sq[0] + sq[1]) + (sq[2] + sq[3])) + ((sq[4] + sq[5]) + (sq[6] + sq[7]));
        const float rs = 1.f / sqrtf(tot * (1.f / SSD_W) + RMS_EPS);
        bf16* mo = WSP(F, bf16, WS_MIX) + row * DM + h * 64;
#pragma unroll
        for (int pt = 0; pt < 2; ++pt)
#pragma unroll
            for (int qd = 0; qd < 4; ++qd) { const int p = pt * 32 + 8 * qd + 4 * hp; const f32x4 w4 = *(const f32x4*)(nw + p);
                *(unsigned long long*)(mo + p) = pack4bf(Yo[lt][pt][4 * qd] * rs * w4.x, Yo[lt][pt][4 * qd + 1] * rs * w4.y, Yo[lt][pt][4 * qd + 2] * rs * w4.z, Yo[lt][pt][4 * qd + 3] * rs * w4.w); }
    }
    __syncthreads();
}

__device__ __forceinline__ void resid_row(const Frame& F, const float* xold, const float* f, const bf16* fb, int nsl, size_t slstride, const float* w_post, float* xnew, const float* w_next, bf16* xn) {
    const f32x4* xo = (const f32x4*)xold + F.lane; const f32x4* fr = (const f32x4*)f + F.lane; const f32x4* wp = (const f32x4*)w_post + F.lane;
    f32x4 fv[4]; float ss = 0.f;
#pragma unroll
    for (int j = 0; j < 4; ++j) {
        if (fb) fv[j] = bf4_to_f32(((const unsigned long long*)fb + F.lane)[64 * j]); else fv[j] = fr[64 * j];
        for (int s = 1; s < nsl; ++s) fv[j] += ((const f32x4*)(f + s * slstride) + F.lane)[64 * j];
        ss += (fv[j].x * fv[j].x + fv[j].y * fv[j].y) + (fv[j].z * fv[j].z + fv[j].w * fv[j].w); }
    const float rs = 1.f / sqrtf(wave_sum(ss) * (1.f / DM) + RMS_EPS);
    f32x4 xv[4]; float s2 = 0.f;
#pragma unroll
    for (int j = 0; j < 4; ++j) { xv[j] = xo[64 * j] + fv[j] * rs * wp[64 * j]; s2 += (xv[j].x * xv[j].x + xv[j].y * xv[j].y) + (xv[j].z * xv[j].z + xv[j].w * xv[j].w);
        ((f32x4*)xnew + F.lane)[64 * j] = xv[j]; }
    if (w_next) {
        const float r2 = 1.f / sqrtf(wave_sum(s2) * (1.f / DM) + RMS_EPS);
        const f32x4* wn = (const f32x4*)w_next + F.lane; unsigned long long* o8 = (unsigned long long*)xn + F.lane;
#pragma unroll
        for (int j = 0; j < 4; ++j) { const f32x4 g = wn[64 * j];
            o8[64 * j] = (unsigned long long)pk2(xv[j].x * r2 * g.x, xv[j].y * r2 * g.y) | ((unsigned long long)pk2(xv[j].z * r2 * g.z, xv[j].w * r2 * g.w) << 32); }
    }
}
template <int NR>
__device__ __forceinline__ void resid_rowsN(const Frame& F, const float* xold, const bf16* f, const float* w_post, float* xnew, const float* w_next, bf16* xn) {
    const int lane = F.lane;
    unsigned long long fr[NR][4]; f32x4 xv[NR][4];
#pragma unroll
    for (int r = 0; r < NR; ++r)
#pragma unroll
        for (int j = 0; j < 4; ++j) { fr[r][j] = ((const unsigned long long*)(f + (size_t)r * DM) + lane)[64 * j]; xv[r][j] = ((const f32x4*)(xold + (size_t)r * DM) + lane)[64 * j]; }
    float rs[NR];
#pragma unroll
    for (int r = 0; r < NR; ++r) { float s = 0.f;
#pragma unroll
        for (int j = 0; j < 4; ++j) { const f32x4 v = bf4_to_f32(fr[r][j]); s += (v.x * v.x + v.y * v.y) + (v.z * v.z + v.w * v.w); }
        rs[r] = s; }
#pragma unroll
    for (int r = 0; r < NR; ++r) rs[r] = 1.f / sqrtf(wave_sum(rs[r]) * (1.f / DM) + RMS_EPS);
    float s2[NR];
#pragma unroll
    for (int r = 0; r < NR; ++r) s2[r] = 0.f;
#pragma unroll
    for (int j = 0; j < 4; ++j) { const f32x4 wp = ((const f32x4*)w_post + lane)[64 * j];
#pragma unroll
        for (int r = 0; r < NR; ++r) { xv[r][j] = xv[r][j] + bf4_to_f32(fr[r][j]) * rs[r] * wp;
            s2[r] += (xv[r][j].x * xv[r][j].x + xv[r][j].y * xv[r][j].y) + (xv[r][j].z * xv[r][j].z + xv[r][j].w * xv[r][j].w);
            ((f32x4*)(xnew + (size_t)r * DM) + lane)[64 * j] = xv[r][j]; } }
    if (w_next) {
#pragma unroll
        for (int r = 0; r < NR; ++r) s2[r] = 1.f / sqrtf(wave_sum(s2[r]) * (1.f / DM) + RMS_EPS);
#pragma unroll
        for (int j = 0; j < 4; ++j) { const f32x4 g = ((const f32x4*)w_next + lane)[64 * j];
#pragma unroll
            for (int r = 0; r < NR; ++r) { const float q = s2[r];
                ((unsigned long long*)(xn + (size_t)r * DM) + lane)[64 * j] = (unsigned long long)pk2(xv[r][j].x * q * g.x, xv[r][j].y * q * g.y) | ((unsigned long long)pk2(xv[r][j].z * q * g.z, xv[r][j].w * q * g.w) << 32); } }
    }
}
constexpr int RES_NR = 4;
__device__ __forceinline__ void phase_resid_mix(const Frame& F, int l) {
    for (int rp = F.gw; rp < NP / RES_NR; rp += F.ngw) { const int r = RES_NR * rp;
        const float* x0 = (l == 0) ? x_in_row(F, r) : WSP(F, float, WS_X) + (size_t)r * DM;
        resid_rowsN<RES_NR>(F, x0, WSP(F, bf16, WS_MIXO) + (size_t)r * DM, INP(F, I_NMPOST) + (size_t)l * DM, WSP(F, float, WS_X) + (size_t)r * DM,
                            INP(F, I_NFPRE) + (size_t)l * DM, WSP(F, bf16, WS_XN) + (size_t)r * DM);
    }
    for (int r = NP + F.gw; r < MROWS; r += F.ngw) {
        const float* xold = (l == 0) ? x_in_row(F, r) : WSP(F, float, WS_X) + (size_t)r * DM;
        resid_row(F, xold, WSP(F, float, WS_SLAB) + (size_t)(r - NP) * DM, nullptr, SPLIT_OUT, (size_t)256 * DM, INP(F, I_NMPOST) + (size_t)l * DM, WSP(F, float, WS_X) + (size_t)r * DM,
                  INP(F, I_NFPRE) + (size_t)l * DM, WSP(F, bf16, WS_XN) + (size_t)r * DM);
    }
}
__device__ __forceinline__ void phase_resid_ffn(const Frame& F, int l) {
    const float* wn = (l == DEPTH - 1) ? nullptr : INP(F, I_NMPRE) + (size_t)(l + 1) * DM;
    for (int rp = F.gw; rp < NP / RES_NR; rp += F.ngw) { const int r = RES_NR * rp;
        float* xn = (l == DEPTH - 1) ? F.out + O_YP + (size_t)r * DM : WSP(F, float, WS_X) + (size_t)r * DM;
        resid_rowsN<RES_NR>(F, WSP(F, float, WS_X) + (size_t)r * DM, WSP(F, bf16, WS_MIXO) + (size_t)r * DM, INP(F, I_NFPOST) + (size_t)l * DM, xn, wn, WSP(F, bf16, WS_XN) + (size_t)r * DM);
    }
    for (int r = NP + F.gw; r < MROWS; r += F.ngw) {
        float* xnew = (l == DEPTH - 1) ? F.out + O_YS + (size_t)(r - NP) * DM : WSP(F, float, WS_X) + (size_t)r * DM;
        resid_row(F, WSP(F, float, WS_X) + (size_t)r * DM, WSP(F, float, WS_SLAB) + (size_t)(r - NP) * DM, nullptr, SPLIT_DOWN, (size_t)256 * DM, INP(F, I_NFPOST) + (size_t)l * DM, xnew,
                  wn, WSP(F, bf16, WS_XN) + (size_t)r * DM);
    }
}

__device__ __forceinline__ void phase_ffn_act(const Frame& F, int l) {
    bf16* act = WSP(F, bf16, WS_ACT);
    const float* cw = INP(F, I_FCW) + (size_t)l * 3 * DFF; const float* cb = INP(F, I_FCB) + (size_t)l * DFF;
    const float* halo = WSP(F, float, WS_FHALO); const float* last = WSP(F, float, WS_FLAST); const float* raw = WSP(F, float, WS_FRAW);
    for (int it = F.gw; it < 64 * 2 * 16; it += F.ngw) {
        const int pm = it >> 5, j = (it >> 4) & 1, c = (it & 15) * 256 + F.lane * 4;
        const bool first = (pm & 7) == 0;
        const f32x4 z = (f32x4){0.f, 0.f, 0.f, 0.f};
        const f32x4 ga = *(const f32x4*)(halo + ((size_t)pm * 2 + j) * 8192 + c), vv = *(const f32x4*)(halo + ((size_t)pm * 2 + j) * 8192 + 4096 + c);
        f32x4 gb, gc;
        if (j == 0) { gb = first ? z : *(const f32x4*)(last + ((size_t)(pm - 1) * 2 + 1) * 4096 + c); gc = first ? z : *(const f32x4*)(last + ((size_t)(pm - 1) * 2 + 0) * 4096 + c); }
        else { gb = *(const f32x4*)(halo + ((size_t)pm * 2 + 0) * 8192 + c); gc = first ? z : *(const f32x4*)(last + ((size_t)(pm - 1) * 2 + 1) * 4096 + c); }
        const f32x4 w0 = *(const f32x4*)(cw + c), w1 = *(const f32x4*)(cw + DFF + c), w2 = *(const f32x4*)(cw + 2 * DFF + c), bb = *(const f32x4*)(cb + c);
        const f32x4 pre = gc * w0 + gb * w1 + ga * w2 + bb;
        const float a0 = gelu_tanh(pre.x) * vv.x, a1 = gelu_tanh(pre.y) * vv.y, a2 = gelu_tanh(pre.z) * vv.z, a3 = gelu_tanh(pre.w) * vv.w;
        *(unsigned long long*)(act + (size_t)(pm * 256 + j) * DFF + c) = (unsigned long long)pk2(a0, a1) | ((unsigned long long)pk2(a2, a3) << 32);
    }
    for (int it = F.gw; it < BP * 2 * 16; it += F.ngw) {
        const int b = it >> 5, j = (it >> 4) & 1, c = (it & 15) * 256 + F.lane * 4;
        *(f32x4*)(F.out + O_FFNP + (((size_t)l * BP + b) * 2 + j) * DFF + c) = *(const f32x4*)(last + ((size_t)(8 * b + 7) * 2 + j) * 4096 + c);
    }
    for (int it = F.gw; it < NS * 16; it += F.ngw) {
        const int r = NP + (it >> 4), j = it & 15;
        const int qq = r - NP, b = qq >> 3, t = qq & 7;
        const float* sffn = INP(F, I_SFFN) + ((size_t)l * BS + b) * 2 * DFF;
        const float* g0 = raw + (size_t)qq * 2 * DFF;
        { const int c = j * 256 + F.lane * 4;
            constexpr size_t SL = (size_t)256 * 2 * DFF;
            f32x4 ga = *(const f32x4*)(g0 + c), gb, gc, vv = *(const f32x4*)(g0 + DFF + c);
            if (t >= 1) gb = *(const f32x4*)(g0 - (size_t)2 * DFF + c); else gb = *(const f32x4*)(sffn + DFF + c);
            if (t >= 2) gc = *(const f32x4*)(g0 - (size_t)4 * DFF + c); else gc = *(const f32x4*)(sffn + (size_t)t * DFF + c);
#pragma unroll
            for (int sl = 1; sl < SPLIT_UP; ++sl) { ga += *(const f32x4*)(g0 + sl * SL + c); vv += *(const f32x4*)(g0 + sl * SL + DFF + c);
                if (t >= 1) gb += *(const f32x4*)(g0 + sl * SL - (size_t)2 * DFF + c);
                if (t >= 2) gc += *(const f32x4*)(g0 + sl * SL - (size_t)4 * DFF + c); }
            const f32x4 w0 = *(const f32x4*)(cw + c), w1 = *(const f32x4*)(cw + DFF + c), w2 = *(const f32x4*)(cw + 2 * DFF + c), bb = *(const f32x4*)(cb + c);
            const f32x4 pre = gc * w0 + gb * w1 + ga * w2 + bb;
            const float a0 = gelu_tanh(pre.x) * vv.x, a1 = gelu_tanh(pre.y) * vv.y, a2 = gelu_tanh(pre.z) * vv.z, a3 = gelu_tanh(pre.w) * vv.w;
            *(unsigned long long*)(act + (size_t)r * DFF + c) = (unsigned long long)pk2(a0, a1) | ((unsigned long long)pk2(a2, a3) << 32);
            if (t >= TS - 2) *(f32x4*)(F.out + O_FFNS + (((size_t)l * BS + b) * 2 + (t - (TS - 2))) * DFF + c) = ga;
        }
    }
}

__global__ void __launch_bounds__(NTHR, 2) hymba_fwd(Params prm) {
    extern __shared__ __attribute__((aligned(16))) unsigned char lds_raw[];
    Frame F;
    F.lds = (LAS unsigned char*)lds_raw;
#define REFRESH() do { unsigned z_ = 0u; asm volatile("" : "+v"(z_)); int ln_ = (int)__builtin_amdgcn_mbcnt_hi(~0u, __builtin_amdgcn_mbcnt_lo(~0u, z_)); F.lane = ln_; F.wave = wave_s; F.tid = wave_s * 64 + ln_; \
        F.gw = blockIdx.x * NWAVES + F.wave; \
        const __attribute__((address_space(4))) void* kp_ = (const __attribute__((address_space(4))) void*)__builtin_amdgcn_kernarg_segment_ptr(); asm volatile("" : "+s"(kp_)); \
        F.p = (const __attribute__((address_space(4))) Params*)kp_; F.ws = F.p->ws; F.out = F.p->out; } while (0)
    F.G = gridDim.x; F.ngw = F.G * NWAVES;
    const int wave_s = __builtin_amdgcn_readfirstlane((int)threadIdx.x >> 6);
    REFRESH();
    volatile LAS unsigned* MISC = (volatile LAS unsigned*)(F.lds + MISC_OFF);
    for (int u = F.tid; u < (LDS_BYTES - RING_BYTES) / 4; u += NTHR) ((LAS unsigned*)(F.lds + RING_BYTES))[u] = 0u;
    __syncthreads();
    const int lo = F.p->ph_lo, hi = F.p->ph_hi;
    const bool use_bar = (hi - lo) > 1;
    XcdBarrier bar; bar.bar = (unsigned*)(F.ws + WS_CTL) + 4096; bar.x = 0; bar.st = nullptr;
    if (use_bar) bar = xcd_barrier_post((unsigned*)(F.ws + WS_CTL) + 4096, MISC + 8);
#define IN(k) (lo <= (k) && (k) < hi)
#define SEAM(k) do { if (IN((k) + 1)) { REFRESH(); xcd_barrier(bar, F.tid == 0); } } while (0)

    if (IN(0)) { REFRESH(); phase_prologue(F); SEAM(0); }
    if (IN(1)) { REFRESH();
        pg8::Gemm g{WSP(F, pg8::bf16_t, WS_AS), WSP(F, pg8::bf16_t, WS_WTC), 8 * BS * 512, 256, 1024};
        pg8::CmpOrder S; S.G = F.G; S.c = (int)blockIdx.x;
        pg8::EpiCmp E{WSP(F, float, WS_HS)};
        pg8::gemm_phase<pg8::EpiCmp, pg8::CmpOrder, true, true>(F.lds, g, S, E, F.tid);
        SEAM(1);
    }
    if (IN(2)) { REFRESH(); phase_cmp_finish(F); SEAM(2); }
    for (int l = 0; l < DEPTH; ++l) {
        const int pb = N_PRO + l * PH_PER_LAYER;
        if (IN(pb + 0)) { REFRESH();
            pg8::Gemm g{WSP(F, pg8::bf16_t, WS_XN), WSP(F, pg8::bf16_t, WS_WTIN) + (size_t)l * IN_WP * DM, MROWS, IN_WP, DM};
            pg8::StaticOrder S; S.init(MROWS, IN_WP, F.G, (int)blockIdx.x);
            pg8::EpiF32 E{WSP(F, float, WS_PROJ), IN_WP};
            pg8::gemm_phase<pg8::EpiF32, pg8::StaticOrder, true, true>(F.lds, g, S, E, F.tid);
            SEAM(pb + 0);
        }
        if (IN(pb + 1)) { REFRESH(); phase_prep(F, l); SEAM(pb + 1); }
        if (IN(pb + 2)) { REFRESH(); phase_compress(F, l); SEAM(pb + 2); }
        if (IN(pb + 3)) { REFRESH(); phase_attn2(F, l); SEAM(pb + 3); }
        if (IN(pb + 4)) { REFRESH();
            pg8::Gemm g{WSP(F, pg8::bf16_t, WS_MIX), WSP(F, pg8::bf16_t, WS_WTOUT) + (size_t)l * DM * DM, MROWS, DM, DM};
            pg8::TailSplitOrder S; S.init(NP, DM, DM, SPLIT_OUT, F.G, (int)blockIdx.x);
            pg8::EpiB16Split E{WSP(F, pg8::bf16_t, WS_MIXO), WSP(F, float, WS_SLAB), DM, NP / 256};
            pg8::gemm_phase<pg8::EpiB16Split, pg8::TailSplitOrder, true, true>(F.lds, g, S, E, F.tid);
            SEAM(pb + 4);
        }
        if (IN(pb + 5)) { REFRESH(); phase_resid_mix(F, l); SEAM(pb + 5); }
        if (IN(pb + 6)) { REFRESH();
            pg8::Gemm g{WSP(F, pg8::bf16_t, WS_XN), WSP(F, pg8::bf16_t, WS_WTUP) + (size_t)l * 2 * DFF * DM, MROWS, 2 * DFF, DM};
            pg8::StaticOrder S; S.init(MROWS, 2 * DFF, F.G, (int)blockIdx.x);
            pg8::EpiFfn E{WSP(F, pg8::bf16_t, WS_ACT), WSP(F, float, WS_FRAW), WSP(F, float, WS_FHALO), WSP(F, float, WS_FLAST),
                          INP(F, I_FCW) + (size_t)l * 3 * DFF, INP(F, I_FCB) + (size_t)l * DFF, (LAS float*)(F.lds + XB_OFF), NP / 256};
            pg8::gemm_phase<pg8::EpiFfn, pg8::StaticOrder, true, true>(F.lds, g, S, E, F.tid);
            SEAM(pb + 6);
        }
        if (IN(pb + 7)) { REFRESH(); phase_ffn_act(F, l); SEAM(pb + 7); }
        if (IN(pb + 8)) { REFRESH();
            pg8::Gemm g{WSP(F, pg8::bf16_t, WS_ACT), WSP(F, pg8::bf16_t, WS_WTDN) + (size_t)l * DM * DFF, MROWS, DM, DFF};
            pg8::TailSplitOrder S; S.init(NP, DM, DFF, SPLIT_DOWN, F.G, (int)blockIdx.x);
            pg8::EpiB16Split E{WSP(F, pg8::bf16_t, WS_MIXO), WSP(F, float, WS_SLAB), DM, NP / 256};
            pg8::gemm_phase<pg8::EpiB16Split, pg8::TailSplitOrder, true, true>(F.lds, g, S, E, F.tid);
            SEAM(pb + 8);
        }
        if (IN(pb + 9)) { REFRESH(); phase_resid_ffn(F, l); SEAM(pb + 9); }
    }
#undef IN
#undef SEAM
}

#ifndef N_LAUNCH_MODE
#define N_LAUNCH_MODE 1
#endif
extern "C" void kernel_launch(void* const* d_in, const int* in_sizes, int n_in, void* d_out, int out_size, void* d_ws, size_t ws_size, hipStream_t stream) {
    static int grid = 0;
    if (grid == 0) {
        if (n_in != N_IN || (size_t)out_size != O_END || ws_size < WS_END) {
            fprintf(stderr, "kernel_launch: unexpected shapes: n_in %d (want %d), out %d (want %zu), ws %zu (want >= %zu); nothing launched\n", n_in, (int)N_IN, out_size, (size_t)O_END, ws_size, (size_t)WS_END);
            grid = -1; return; }
        int dev = 0, cus = 0, per_cu = 0;
        if (hipGetDevice(&dev) != hipSuccess || hipDeviceGetAttribute(&cus, hipDeviceAttributeMultiprocessorCount, dev) != hipSuccess) { grid = -1; return; }
        if (hipFuncSetAttribute((const void*)hymba_fwd, hipFuncAttributeMaxDynamicSharedMemorySize, LDS_BYTES) != hipSuccess) { fprintf(stderr, "kernel_launch: hipFuncSetAttribute failed\n"); grid = -1; return; }
        if (hipOccupancyMaxActiveBlocksPerMultiprocessor(&per_cu, (const void*)hymba_fwd, NTHR, LDS_BYTES) != hipSuccess || per_cu < 1)
            fprintf(stderr, "kernel_launch: note: occupancy query reports %d workgroups per CU\n", per_cu);
        (void)hipGetLastError();
        grid = cus;
    }
    if (grid < 0) return;
    (void)hipMemsetAsync((char*)d_ws + WS_CTL, 0, CTL_BYTES, stream);
    Params prm{};
    for (int i = 0; i < N_IN; ++i) prm.in[i] = (const float*)d_in[i];
    prm.out = (float*)d_out; prm.ws = (unsigned char*)d_ws;
#if N_LAUNCH_MODE == 1
    prm.ph_lo = 0; prm.ph_hi = N_PHASES;
    hipLaunchKernelGGL(hymba_fwd, dim3(grid), dim3(NTHR), LDS_BYTES, stream, prm);
#else
    for (int ph = 0; ph < N_PHASES; ++ph) {
        prm.ph_lo = ph; prm.ph_hi = ph + 1;
        hipLaunchKernelGGL(hymba_fwd, dim3(grid), dim3(NTHR), LDS_BYTES, stream, prm);
    }
#endif
}
```

```cpp
#include <hip/hip_runtime.h>
#include <cstdio>
#include <cstdint>

namespace pg8 {
#define PG8_LAS __attribute__((address_space(3)))
typedef unsigned short bf16_t;
typedef short bf16x8 __attribute__((ext_vector_type(8)));
typedef float f32x4 __attribute__((ext_vector_type(4)));
typedef unsigned u32x4 __attribute__((ext_vector_type(4)));
constexpr int BM = 256, BK = 64, HALF = 128, HTB = HALF * BK * 2  , STAGE_BYTES = 8 * HTB, NXCD = 8, WGM = 8;

__host__ __device__ __forceinline__ int lds_byte(int r, int c) { const int st = (r >> 4) * 2 + (c >> 5), rr = r & 15, cc = c & 31, ob = rr * 64 + cc * 2; return st * 1024 + (ob ^ (((ob >> 9) & 1) << 5)); }
__host__ __device__ __forceinline__ void stage_rc(int b, int& R, int& C) { const int st = b / 1024, sb = b % 1024, swz = sb ^ (((sb >> 9) & 1) << 5); R = (st >> 1) * 16 + swz / 64; C = (st & 1) * 32 + (swz % 64) / 2; }
__host__ __device__ __forceinline__ int perm32(int rho) { const int n = rho >> 4, i = rho & 15; return 8 * (i >> 2) + 4 * n + (i & 3); }

struct Unit { int pm, pn, kt0, nt; };
struct Gemm { const bf16_t* A; const bf16_t* Bt; int M, N, K; };

struct StaticOrder {
    int nM, nN, nwg, G, c;
    __host__ __device__ __forceinline__ void init(int M, int N, int G_, int c_) { nM = M / BM; nN = N / BM; nwg = nM * nN; G = G_; c = c_; }
    __host__ __device__ __forceinline__ bool next(int i, Unit& u) const {
        const long L = (long)i * G + c; if (L >= nwg) return false;
        int wgid = (int)L; { const int q = nwg / NXCD, r = nwg % NXCD, xcd = wgid % NXCD, off = wgid / NXCD; wgid = (xcd < r ? xcd * (q + 1) : r * (q + 1) + (xcd - r) * q) + off; }
        const int nig = WGM * nN, gid = wgid / nig, fm = gid * WGM, gsz = (nM - fm) < WGM ? (nM - fm) : WGM;
        u.pm = fm + ((wgid % nig) % gsz); u.pn = (wgid % nig) / gsz; u.kt0 = 0; u.nt = 0; return true;
    }
    __device__ __forceinline__ void a_ready(const Unit&) const {}
    __device__ __forceinline__ void done(const Unit&) const {}
};

__device__ __forceinline__ unsigned cvt_pk_bf16(float lo, float hi) { unsigned r; asm volatile("v_cvt_pk_bf16_f32 %0, %1, %2" : "=v"(r) : "v"(lo), "v"(hi)); return r; }
struct EpiF32 {
    static constexpr bool PERM = true, AFTER_DRAIN = false;
    float* O; int ldc;
    __device__ __forceinline__ void operator()(const f32x4 (&acc)[2][2][4][2], const Unit& u, int wr, int wc, int fr, int fq) const {
        const int row0 = u.pm * BM + wr * 64 + fr; const int col0 = u.pn * BM + wc * 32 + 8 * fq;
#pragma unroll
        for (int ai = 0; ai < 2; ++ai)
#pragma unroll
            for (int m = 0; m < 4; ++m) { float* rowp = O + (size_t)(row0 + ai * HALF + m * 16) * ldc + col0;
#pragma unroll
                for (int bj = 0; bj < 2; ++bj) { *(f32x4*)(rowp + bj * HALF) = acc[ai][bj][m][0]; *(f32x4*)(rowp + bj * HALF + 4) = acc[ai][bj][m][1]; } }
    }
};

struct CmpOrder {
    int G, c;
    __device__ __forceinline__ bool next(int i, Unit& u) const { const int L = i * G + c; if (L >= 512) return false; u.pm = L; u.pn = L >> 6; u.kt0 = 0; u.nt = 0; return true; }
    __device__ __forceinline__ void a_ready(const Unit&) const {}
    __device__ __forceinline__ void done(const Unit&) const {}
};
struct EpiCmp {
    static constexpr bool PERM = true, AFTER_DRAIN = false;
    float* O;
    __device__ __forceinline__ void operator()(const f32x4 (&acc)[2][2][4][2], const Unit& u, int wr, int wc, int fr, int fq) const {
        const int row0 = u.pm * BM + wr * 64 + fr; const int col0 = wc * 32 + 8 * fq;
#pragma unroll
        for (int ai = 0; ai < 2; ++ai)
#pragma unroll
            for (int m = 0; m < 4; ++m) { float* rowp = O + (size_t)(row0 + ai * HALF + m * 16) * 256 + col0;
#pragma unroll
                for (int bj = 0; bj < 2; ++bj) { *(f32x4*)(rowp + bj * HALF) = acc[ai][bj][m][0]; *(f32x4*)(rowp + bj * HALF + 4) = acc[ai][bj][m][1]; } }
    }
};

struct EpiB16 {
    static constexpr bool PERM = true, AFTER_DRAIN = false;
    bf16_t* O; int ldc;
    __device__ __forceinline__ void operator()(const f32x4 (&acc)[2][2][4][2], const Unit& u, int wr, int wc, int fr, int fq) const {
        const int row0 = u.pm * BM + wr * 64 + fr; const int col0 = u.pn * BM + wc * 32 + 8 * fq;
#pragma unroll
        for (int ai = 0; ai < 2; ++ai)
#pragma unroll
            for (int m = 0; m < 4; ++m) { bf16_t* rowp = O + (size_t)(row0 + ai * HALF + m * 16) * ldc + col0;
#pragma unroll
                for (int bj = 0; bj < 2; ++bj) { const f32x4 v0 = acc[ai][bj][m][0], v1 = acc[ai][bj][m][1];
                    u32x4 w; w.x = cvt_pk_bf16(v0[0], v0[1]); w.y = cvt_pk_bf16(v0[2], v0[3]); w.z = cvt_pk_bf16(v1[0], v1[1]); w.w = cvt_pk_bf16(v1[2], v1[3]);
                    *(u32x4*)(rowp + bj * HALF) = w; } }
    }
};

struct TailSplitOrder {
    StaticOrder P; int nN, ntf, split;
    __device__ __forceinline__ void init(int Mp, int N, int K, int split_, int G, int c) { P.init(Mp, N, G, c); nN = N / BM; ntf = K / BK; split = split_; }
    __device__ __forceinline__ bool next(int i, Unit& u) const {
        const int L = i * P.G + P.c; const bool isp = L < P.nwg;
        int wgid = isp ? L : 0; { const int q = P.nwg / NXCD, r = P.nwg % NXCD, xcd = wgid % NXCD, off = wgid / NXCD; wgid = (xcd < r ? xcd * (q + 1) : r * (q + 1) + (xcd - r) * q) + off; }
        const int nig = WGM * P.nN, gid = wgid / nig, fm = gid * WGM, gsz = (P.nM - fm) < WGM ? (P.nM - fm) : WGM;
        const int ppm = fm + ((wgid % nig) % gsz), ppn = (wgid % nig) / gsz;
        const int t = L - P.nwg, nts = ntf / split;
        u.pm = isp ? ppm : P.nM; u.pn = isp ? ppn : t % nN; u.nt = isp ? 0 : nts; u.kt0 = isp ? 0 : (t / nN) * nts;
        return isp || t < nN * split;
    }
    __device__ __forceinline__ void a_ready(const Unit&) const {}
    __device__ __forceinline__ void done(const Unit&) const {}
};
struct EpiB16Split {
    static constexpr bool PERM = true, AFTER_DRAIN = false;
    bf16_t* O; float* S; int ldc; int tail_pm;
    __device__ __forceinline__ void operator()(const f32x4 (&acc)[2][2][4][2], const Unit& u, int wr, int wc, int fr, int fq) const {
        const int col0 = u.pn * BM + wc * 32 + 8 * fq;
        if (u.pm < tail_pm) {
            bf16_t* base = O + (size_t)(u.pm * BM + wr * 64 + fr) * ldc + col0;
#pragma unroll
            for (int ai = 0; ai < 2; ++ai)
#pragma unroll
                for (int m = 0; m < 4; ++m) { bf16_t* rowp = base + (size_t)(ai * HALF + m * 16) * ldc;
#pragma unroll
                    for (int bj = 0; bj < 2; ++bj) { const f32x4 v0 = acc[ai][bj][m][0], v1 = acc[ai][bj][m][1];
                        u32x4 w; w.x = cvt_pk_bf16(v0[0], v0[1]); w.y = cvt_pk_bf16(v0[2], v0[3]); w.z = cvt_pk_bf16(v1[0], v1[1]); w.w = cvt_pk_bf16(v1[2], v1[3]);
                        *(u32x4*)(rowp + bj * HALF) = w; } }
        } else {
            float* base = S + ((size_t)(u.kt0 / (u.nt ? u.nt : 1)) * BM + wr * 64 + fr) * ldc + col0;
#pragma unroll
            for (int ai = 0; ai < 2; ++ai)
#pragma unroll
                for (int m = 0; m < 4; ++m) { float* rowp = base + (size_t)(ai * HALF + m * 16) * ldc;
#pragma unroll
                    for (int bj = 0; bj < 2; ++bj) { *(f32x4*)(rowp + bj * HALF) = acc[ai][bj][m][0]; *(f32x4*)(rowp + bj * HALF + 4) = acc[ai][bj][m][1]; } }
        }
    }
};
struct EpiF32Split {
    static constexpr bool PERM = true, AFTER_DRAIN = false;
    float* O; float* S; int ldc; int tail_pm;
    __device__ __forceinline__ void operator()(const f32x4 (&acc)[2][2][4][2], const Unit& u, int wr, int wc, int fr, int fq) const {
        const int col0 = u.pn * BM + wc * 32 + 8 * fq;
        float* base = (u.pm < tail_pm) ? O + (size_t)(u.pm * BM + wr * 64 + fr) * ldc : S + ((size_t)(u.kt0 / (u.nt ? u.nt : 1)) * BM + wr * 64 + fr) * ldc;
#pragma unroll
        for (int ai = 0; ai < 2; ++ai)
#pragma unroll
            for (int m = 0; m < 4; ++m) { float* rowp = base + (size_t)(ai * HALF + m * 16) * ldc + col0;
#pragma unroll
                for (int bj = 0; bj < 2; ++bj) { *(f32x4*)(rowp + bj * HALF) = acc[ai][bj][m][0]; *(f32x4*)(rowp + bj * HALF + 4) = acc[ai][bj][m][1]; } }
    }
};

__device__ __forceinline__ float dpp_ror1(float v) { return __builtin_bit_cast(float, __builtin_amdgcn_update_dpp(0, __builtin_bit_cast(int, v), 0x121, 0xf, 0xf, false)); }
__device__ __forceinline__ float dpp_ror2(float v) { return __builtin_bit_cast(float, __builtin_amdgcn_update_dpp(0, __builtin_bit_cast(int, v), 0x122, 0xf, 0xf, false)); }
__device__ __forceinline__ float dpp_shr1(float old, float v) { return __builtin_bit_cast(float, __builtin_amdgcn_update_dpp(__builtin_bit_cast(int, old), __builtin_bit_cast(int, v), 0x111, 0xf, 0xf, false)); }
__device__ __forceinline__ float dpp_shr2(float old, float v) { return __builtin_bit_cast(float, __builtin_amdgcn_update_dpp(__builtin_bit_cast(int, old), __builtin_bit_cast(int, v), 0x112, 0xf, 0xf, false)); }
__device__ __forceinline__ float gelu_t(float x) {
    const float p = x * __builtin_fmaf(x * x, 0.044715f * 2.302208198f, 2.302208198f);
    return x * __builtin_amdgcn_rcpf(1.f + __builtin_amdgcn_exp2f(-p));
}
struct EpiFfn {
    static constexpr bool PERM = true, AFTER_DRAIN = false;
    bf16_t* ACT;
    float* RAW;
    float* HALO;
    float* LAST;
    const float* cw; const float* cb;
    PG8_LAS float* xb;
    int tail_pm;
    __device__ __forceinline__ void operator()(const f32x4 (&acc)[2][2][4][2], const Unit& u, int wr, int wc, int fr_in, int fq_in) const {
        int fr = fr_in, fq = fq_in; asm volatile("" : "+v"(fr), "+v"(fq));
        const int colt = wc * 32 + 8 * fq, gcol = u.pn * 128 + colt;
        const bool tail = (u.pm >= tail_pm);
#pragma unroll
        for (int ai = 0; ai < 2; ++ai) {
            if (fr >= 14) { PG8_LAS float* d = xb + ((ai * 2 + wr) * 2 + (fr - 14)) * 128 + colt;
                *(PG8_LAS f32x4*)d = acc[ai][0][3][0]; *(PG8_LAS f32x4*)(d + 4) = acc[ai][0][3][1]; }
        }
        if (!tail) {
            if (wr == 1 && fr >= 14) { float* d = LAST + ((size_t)u.pm * 2 + (fr - 14)) * 4096 + gcol; *(f32x4*)d = acc[1][0][3][0]; *(f32x4*)(d + 4) = acc[1][0][3][1]; }
            if (wr == 0 && fr < 2) { float* d = HALO + ((size_t)u.pm * 2 + fr) * 8192 + gcol;
                *(f32x4*)d = acc[0][0][0][0]; *(f32x4*)(d + 4) = acc[0][0][0][1]; *(f32x4*)(d + 4096) = acc[0][1][0][0]; *(f32x4*)(d + 4096 + 4) = acc[0][1][0][1]; }
        } else {
#pragma unroll
            for (int ai = 0; ai < 2; ++ai)
#pragma unroll
                for (int m = 0; m < 4; ++m) { float* d = RAW + ((size_t)(u.kt0 / (u.nt ? u.nt : 1)) * BM + ai * HALF + wr * 64 + m * 16 + fr) * 8192 + gcol;
                    *(f32x4*)d = acc[ai][0][m][0]; *(f32x4*)(d + 4) = acc[ai][0][m][1]; *(f32x4*)(d + 4096) = acc[ai][1][m][0]; *(f32x4*)(d + 4096 + 4) = acc[ai][1][m][1]; }
        }
        asm volatile("s_waitcnt lgkmcnt(0)" ::: "memory");
        __builtin_amdgcn_s_barrier();
        if (tail) return;
#pragma unroll
        for (int n = 0; n < 2; ++n) {
            const f32x4 w0 = *(const f32x4*)(cw + gcol + 4 * n), w1 = *(const f32x4*)(cw + 4096 + gcol + 4 * n), w2 = *(const f32x4*)(cw + 8192 + gcol + 4 * n), bb = *(const f32x4*)(cb + gcol + 4 * n);
#pragma unroll
            for (int ai = 0; ai < 2; ++ai) {
                const int pgrp = (wr == 1) ? (ai * 2 + 0) : (0 * 2 + 1);
                const f32x4 pv = *(const PG8_LAS f32x4*)(xb + (pgrp * 2 + (fr == 15 ? 1 : 0)) * 128 + colt + 4 * n);
#pragma unroll
                for (int m = 0; m < 4; ++m) {
                    float a4[4];
#pragma unroll
                    for (int k = 0; k < 4; ++k) {
                        const float cur = acc[ai][0][m][n][k]; const float prm = (m > 0) ? acc[ai][0][m > 0 ? m - 1 : 0][n][k] : pv[k];
                        const float p1 = dpp_shr1(dpp_ror1(prm), cur), p2 = dpp_shr2(dpp_ror2(prm), cur);
                        const float pre = w0[k] * p2 + w1[k] * p1 + w2[k] * cur + bb[k];
                        a4[k] = gelu_t(pre) * acc[ai][1][m][n][k];
                    }
                    const bool deferred = (ai == 0 && wr == 0 && m == 0 && fr < 2);
                    if (!deferred) *(unsigned long long*)(ACT + (size_t)(u.pm * BM + ai * HALF + wr * 64 + m * 16 + fr) * 4096 + gcol + 4 * n) =
                        (unsigned long long)cvt_pk_bf16(a4[0], a4[1]) | ((unsigned long long)cvt_pk_bf16(a4[2], a4[3]) << 32);
                }
            }
        }
    }
};
template <class Epi, class Sched, bool ALIGN_EPI = false, bool SP2 = false>
__device__ __forceinline__ void gemm_phase(PG8_LAS unsigned char* lds, const Gemm g, const Sched& S, const Epi& E, const int tid_in) {
    int tid_ = tid_in; asm volatile("" : "+v"(tid_));
    const int tid = tid_, wid = __builtin_amdgcn_readfirstlane(tid >> 6), lane = tid & 63, wr = wid >> 2, wc = wid & 3, fr = lane & 15, fq = lane >> 4;
    const int K = g.K, ntf = K / BK;
    unsigned voffA[2], voffB[2];
#pragma unroll
    for (int i = 0; i < 2; ++i) { int R, C; stage_rc(tid * 16 + i * 8192, R, C); const int Rb = Epi::PERM ? ((R & ~31) + perm32(R & 31)) : R;
        voffA[i] = (unsigned)(R * K + C) * 2u; voffB[i] = (unsigned)(Rb * K + C) * 2u; }
    const size_t kstep = (size_t)(BK * 2);
    const size_t hstep = (size_t)HALF * K * 2;
    const size_t tstep = 2 * hstep;
    const unsigned ldsw = (unsigned)wid * 1024u;
    const int aoff = lds_byte(wr * 64 + fr, fq * 8), boff = lds_byte(wc * 32 + fr, fq * 8);
#define PG8_SA(b, h) (((b) * 2 + (h)) * HTB)
#define PG8_SB(b, h) ((4 + (b) * 2 + (h)) * HTB)
#define PG8_STAGE(bufoff, gbase, voff) do { _Pragma("unroll") for (int _i = 0; _i < 2; ++_i) \
        __builtin_amdgcn_global_load_lds((const unsigned*)((const char*)(gbase) + (voff)[_i]), (PG8_LAS unsigned*)(lds + (bufoff) + ldsw + _i * 8192), 16, 0, 0); } while (0)
#define PG8_LDA(dst, b, h) do { _Pragma("unroll") for (int m = 0; m < 4; ++m) _Pragma("unroll") for (int k = 0; k < 2; ++k) dst[m][k] = *(const PG8_LAS bf16x8*)(lds + PG8_SA(b, h) + aoff + m * 2048 + k * 1024); } while (0)
#define PG8_LDB(dst, b, h) do { _Pragma("unroll") for (int n = 0; n < 2; ++n) _Pragma("unroll") for (int k = 0; k < 2; ++k) dst[n][k] = *(const PG8_LAS bf16x8*)(lds + PG8_SB(b, h) + boff + n * 2048 + k * 1024); } while (0)
#define PG8_MMA(ai, bj, At, Bt) do { __builtin_amdgcn_s_setprio(1); _Pragma("unroll") for (int m = 0; m < 4; ++m) _Pragma("unroll") for (int n = 0; n < 2; ++n) _Pragma("unroll") for (int k = 0; k < 2; ++k) \
        acc[ai][bj][m][n] = __builtin_amdgcn_mfma_f32_16x16x32_bf16(Bt[n][k], At[m][k], acc[ai][bj][m][n], 0, 0, 0); __builtin_amdgcn_s_setprio(0); } while (0)
#define PG8_WAIT_V(n) asm volatile("s_waitcnt vmcnt(" #n ")" ::: "memory")
#define PG8_WAIT_L(n) asm volatile("s_waitcnt lgkmcnt(" #n ")" ::: "memory")
#define PG8_BAR __builtin_amdgcn_s_barrier()
#define PG8_SCHED __builtin_amdgcn_sched_barrier(0)
    Unit cur = {0, 0, 0, 0}, nxt = {0, 0, 0, 0}; int ui = 0;
    if (!S.next(0, cur)) return;
    f32x4 acc[2][2][4][2];
#pragma unroll
    for (int a = 0; a < 2; ++a)
#pragma unroll
        for (int b = 0; b < 2; ++b)
#pragma unroll
            for (int m = 0; m < 4; ++m)
#pragma unroll
                for (int n = 0; n < 2; ++n) acc[a][b][m][n] = (f32x4){0.f, 0.f, 0.f, 0.f};
    bf16x8 At[4][2], B0[2][2], B1[2][2];
    const char* cA = (const char*)g.A + (size_t)cur.pm * tstep + (size_t)cur.kt0 * kstep; const char* cB = (const char*)g.Bt + (size_t)cur.pn * tstep + (size_t)cur.kt0 * kstep;
    S.a_ready(cur);
    if constexpr (SP2) {
        PG8_STAGE(PG8_SB(0, 0), cB, voffB); PG8_STAGE(PG8_SB(0, 1), cB + hstep, voffB); PG8_STAGE(PG8_SA(0, 0), cA, voffA); PG8_STAGE(PG8_SA(0, 1), cA + hstep, voffA);
        if (wr == 1) PG8_BAR;
        PG8_WAIT_V(2); PG8_BAR;
        PG8_STAGE(PG8_SB(1, 0), cB + kstep, voffB); PG8_STAGE(PG8_SA(1, 0), cA + kstep, voffA); PG8_STAGE(PG8_SB(1, 1), cB + hstep + kstep, voffB);
        PG8_WAIT_V(6); PG8_BAR;
    } else {
        PG8_STAGE(PG8_SB(0, 0), cB, voffB); PG8_STAGE(PG8_SA(0, 0), cA, voffA); PG8_STAGE(PG8_SB(0, 1), cB + hstep, voffB); PG8_STAGE(PG8_SA(0, 1), cA + hstep, voffA);
        if (wr == 1) PG8_BAR;
        PG8_WAIT_V(4); PG8_BAR;
        PG8_STAGE(PG8_SB(1, 0), cB + kstep, voffB); PG8_STAGE(PG8_SA(1, 0), cA + kstep, voffA); PG8_STAGE(PG8_SB(1, 1), cB + hstep + kstep, voffB);
        PG8_WAIT_V(6); PG8_BAR;
    }
    for (;;) {
        const bool has_next = S.next(ui + 1, nxt);
        const char* nA = has_next ? (const char*)g.A + (size_t)nxt.pm * tstep + (size_t)nxt.kt0 * kstep : cA; const char* nB = has_next ? (const char*)g.Bt + (size_t)nxt.pn * tstep + (size_t)nxt.kt0 * kstep : cB;
        const int nt = cur.nt ? cur.nt : ntf;
        for (int t = 0; t < nt; t += 2) {
            const bool last = (t == nt - 2);
            const char* a1 = cA + (size_t)(t + 1) * kstep;
            const char* a2 = last ? nA : cA + (size_t)(t + 2) * kstep; const char* b2 = last ? nB : cB + (size_t)(t + 2) * kstep;
            const char* a3 = a2 + kstep; const char* b3 = b2 + kstep;
            if (last && has_next) S.a_ready(nxt);
            if constexpr (SP2) {
            PG8_LDB(B0, 0, 0); PG8_LDB(B1, 0, 1); PG8_SCHED; PG8_LDA(At, 0, 0); PG8_STAGE(PG8_SA(1, 1), a1 + hstep, voffA);
            PG8_WAIT_V(8); PG8_WAIT_L(0); PG8_BAR; PG8_MMA(0, 0, At, B0); PG8_MMA(0, 1, At, B1); PG8_BAR; PG8_SCHED;
            PG8_LDA(At, 0, 1); PG8_STAGE(PG8_SB(0, 0), b2, voffB); PG8_STAGE(PG8_SB(0, 1), b2 + hstep, voffB); PG8_STAGE(PG8_SA(0, 0), a2, voffA);
            PG8_WAIT_V(8); PG8_WAIT_L(0); PG8_BAR; PG8_MMA(1, 0, At, B0); PG8_MMA(1, 1, At, B1); PG8_BAR; PG8_SCHED;
            PG8_LDB(B0, 1, 0); PG8_LDB(B1, 1, 1); PG8_SCHED; PG8_LDA(At, 1, 0); PG8_STAGE(PG8_SA(0, 1), a2 + hstep, voffA);
            PG8_WAIT_V(8); PG8_WAIT_L(0); PG8_BAR; PG8_MMA(0, 0, At, B0); PG8_MMA(0, 1, At, B1); PG8_BAR; PG8_SCHED;
            PG8_LDA(At, 1, 1); PG8_STAGE(PG8_SB(1, 0), b3, voffB); PG8_STAGE(PG8_SB(1, 1), b3 + hstep, voffB); PG8_STAGE(PG8_SA(1, 0), a3, voffA);
            PG8_WAIT_V(8); PG8_WAIT_L(0); PG8_BAR; PG8_MMA(1, 0, At, B0); PG8_MMA(1, 1, At, B1); PG8_BAR; PG8_SCHED;
            } else {
            PG8_LDB(B0, 0, 0); PG8_SCHED; PG8_LDA(At, 0, 0); PG8_STAGE(PG8_SA(1, 1), a1 + hstep, voffA);
            PG8_WAIT_L(8); PG8_BAR; PG8_WAIT_L(0); PG8_MMA(0, 0, At, B0); PG8_BAR; PG8_SCHED;
            PG8_LDB(B1, 0, 1); PG8_STAGE(PG8_SB(0, 0), b2, voffB);
            PG8_BAR; PG8_WAIT_L(0); PG8_MMA(0, 1, At, B1); PG8_BAR;
            PG8_LDA(At, 0, 1); PG8_STAGE(PG8_SA(0, 0), a2, voffA);
            PG8_BAR; PG8_WAIT_L(0); PG8_MMA(1, 0, At, B0); PG8_BAR; PG8_SCHED;
            PG8_STAGE(PG8_SB(0, 1), b2 + hstep, voffB);
            PG8_WAIT_V(6); PG8_BAR; PG8_MMA(1, 1, At, B1); PG8_BAR;
            PG8_LDB(B0, 1, 0); PG8_SCHED; PG8_LDA(At, 1, 0); PG8_STAGE(PG8_SA(0, 1), a2 + hstep, voffA);
            PG8_WAIT_L(8); PG8_BAR; PG8_WAIT_L(0); PG8_MMA(0, 0, At, B0); PG8_BAR; PG8_SCHED;
            PG8_LDB(B1, 1, 1); PG8_STAGE(PG8_SB(1, 0), b3, voffB);
            PG8_BAR; PG8_WAIT_L(0); PG8_MMA(0, 1, At, B1); PG8_BAR;
            PG8_LDA(At, 1, 1); PG8_STAGE(PG8_SA(1, 0), a3, voffA);
            PG8_BAR; PG8_WAIT_L(0); PG8_MMA(1, 0, At, B0); PG8_BAR; PG8_SCHED;
            PG8_STAGE(PG8_SB(1, 1), b3 + hstep, voffB);
            PG8_WAIT_V(6); PG8_BAR; PG8_MMA(1, 1, At, B1); PG8_BAR;
            }
        }
        if constexpr (ALIGN_EPI) { if (wr == 0) PG8_BAR; }
        if constexpr (!Epi::AFTER_DRAIN) { E(acc, cur, wr, wc, fr, fq); S.done(cur); }
        if (!has_next) break;
#pragma unroll
        for (int a = 0; a < 2; ++a)
#pragma unroll
            for (int b = 0; b < 2; ++b)
#pragma unroll
                for (int m = 0; m < 4; ++m)
#pragma unroll
                    for (int n = 0; n < 2; ++n) acc[a][b][m][n] = (f32x4){0.f, 0.f, 0.f, 0.f};
        cur = nxt; cA = nA; cB = nB; ++ui;
        if constexpr (ALIGN_EPI) { if (wr == 1) PG8_BAR; }
    }
    PG8_WAIT_V(0);
    if constexpr (!ALIGN_EPI) { if (wr == 0) PG8_BAR; }
    PG8_BAR;
    if constexpr (Epi::AFTER_DRAIN) { E.fused(acc, cur, wr, wc, fr, fq, lds, wid, lane); S.done(cur); }
#undef PG8_SA
#undef PG8_SB
#undef PG8_STAGE
#undef PG8_LDA
#undef PG8_LDB
#undef PG8_MMA
#undef PG8_WAIT_V
#undef PG8_WAIT_L
#undef PG8_BAR
#undef PG8_SCHED
}
}

#define GAS __attribute__((address_space(1)))
#define LAS __attribute__((address_space(3)))
typedef unsigned short bf16;
typedef unsigned v4u __attribute__((ext_vector_type(4)));
typedef float f32x4 __attribute__((ext_vector_type(4)));
typedef short bf16x8 __attribute__((ext_vector_type(8)));

constexpr int DM = 1024, BP = 8, TP = 2048, DEPTH = 4, BS = 32, TS = 8, PAST = 8192, PAGE = 128;
constexpr int NP = BP * TP, NS = BS * TS, MROWS = NP + NS;
constexpr int NSEQ = BP + BS;
constexpr int SSD_W = 512, SSD_H = 8, SSD_HD = 64, SSD_N = 128, CONV_DIM = 1024;
constexpr int POOL_W = 256, POOL_KEEP = 15;
constexpr int NSA_H = 4, NSA_HD = 64;
constexpr int OFF_XBC = 512, OFF_DT = 1536, OFF_POOL = 1544, OFF_Q = 1800, OFF_KV = 2056, OFF_G = 2440, IN_W = 2452, IN_WP = 2560;
constexpr int DFF = 4096;
constexpr int NPHYS = 2560, NPAGES = 64;
constexpr int NCMP_P = 127, NCMP_S = 511;
constexpr float RMS_EPS = 1e-6f;

constexpr size_t O_YP = 0;
constexpr size_t O_YS = O_YP + (size_t)NP * DM;
constexpr size_t O_KVP = O_YS + (size_t)NS * DM;
constexpr size_t O_KVS = O_KVP + (size_t)DEPTH * NP * 256;
constexpr size_t O_WINP = O_KVS + (size_t)DEPTH * NS * 256;
constexpr size_t O_WINS = O_WINP + (size_t)DEPTH * BP * 512 * 128;
constexpr size_t O_CONVP = O_WINS + (size_t)DEPTH * BS * 512 * 128;
constexpr size_t O_CONVS = O_CONVP + (size_t)DEPTH * BP * 3 * 1024;
constexpr size_t O_SSMP = O_CONVS + (size_t)DEPTH * BS * 3 * 1024;
constexpr size_t O_SSMS = O_SSMP + (size_t)DEPTH * BP * 8 * 64 * 128;
constexpr size_t O_POOLP = O_SSMS + (size_t)DEPTH * BS * 8 * 64 * 128;
constexpr size_t O_POOLS = O_POOLP + (size_t)DEPTH * BP * 15 * 256;
constexpr size_t O_FFNP = O_POOLS + (size_t)DEPTH * BS * 15 * 256;
constexpr size_t O_FFNS = O_FFNP + (size_t)DEPTH * BP * 2 * 4096;
constexpr size_t O_END = O_FFNS + (size_t)DEPTH * BS * 2 * 4096;

enum { I_XP = 0, I_XS, I_CACHE, I_PT, I_SWIN, I_SCONV, I_SSM, I_SPOOL, I_SFFN, I_NMPRE, I_WIN, I_CONVW, I_CONVB, I_DTB, I_ALOG, I_SSDD, I_SSDNORM,
       I_POOLW, I_POOLSC, I_PEK, I_PEV, I_W1K, I_W1V, I_W2K, I_W2V, I_WOUT, I_NMPOST, I_NFPRE, I_WGATE, I_WVAL, I_FCW, I_FCB, I_WDOWN, I_NFPOST, N_IN };

constexpr size_t al256(size_t x) { return (x + 255) & ~(size_t)255; }
constexpr size_t WS_CTL = 0, CTL_BYTES = 1u << 20;
constexpr size_t WS_WTIN = WS_CTL + CTL_BYTES;
constexpr size_t WS_WTOUT = WS_WTIN + (size_t)DEPTH * IN_WP * DM * 2;
constexpr size_t WS_WTUP = WS_WTOUT + (size_t)DEPTH * DM * DM * 2;
constexpr size_t WS_WTDN = WS_WTUP + (size_t)DEPTH * 2 * DFF * DM * 2;
constexpr size_t WS_ROPE = WS_WTDN + (size_t)DEPTH * DM * DFF * 2;
constexpr size_t WS_X = WS_ROPE + al256((size_t)2056 * 16 * 4);
constexpr size_t WS_XN = WS_X + (size_t)MROWS * DM * 4;
constexpr size_t WS_PROJ = WS_XN + (size_t)MROWS * DM * 2;
constexpr size_t WS_YSSD = WS_PROJ + (size_t)MROWS * IN_WP * 4;
constexpr size_t WS_Q = WS_YSSD + (size_t)MROWS * SSD_W * 4;
constexpr size_t WS_KWIN = WS_Q + (size_t)MROWS * 256 * 4;
constexpr size_t WS_CKP = WS_KWIN + (size_t)MROWS * 128 * 4;
constexpr size_t WS_CVP = WS_CKP + al256((size_t)BP * NCMP_P * 64 * 4);
constexpr size_t WS_CKS = WS_CVP + al256((size_t)BP * NCMP_P * 64 * 4);
constexpr size_t WS_CVS = WS_CKS + al256((size_t)DEPTH * BS * NCMP_S * 64 * 4);
constexpr size_t WS_MIX = WS_CVS + al256((size_t)DEPTH * BS * NCMP_S * 64 * 4);
constexpr size_t WS_MIXO = WS_MIX + (size_t)MROWS * DM * 2;
constexpr size_t WS_GV = WS_MIXO + (size_t)MROWS * DM * 4;
constexpr size_t WS_ACT = WS_GV + (size_t)MROWS * 2 * DFF * 4;
constexpr size_t WS_QB = WS_ACT + (size_t)MROWS * DFF * 2;
constexpr size_t WS_SAC = WS_QB + (size_t)MROWS * 256 * 2;
constexpr size_t WS_SCD = WS_SAC + (size_t)NP * 8 * 4;
constexpr size_t WS_SCB = WS_SCD + al256((size_t)BP * 16 * 8 * 4);
constexpr size_t WS_SCS = WS_SCB + (size_t)NP * 256 * 2;
constexpr size_t WS_SHS = WS_SCS + (size_t)BP * 16 * 8 * 8192 * 4;
constexpr size_t WS_WTC = WS_SHS + (size_t)BP * 16 * 8 * 8192 * 2;
constexpr size_t WS_CBIAS = WS_WTC + (size_t)8 * 256 * 1024 * 2;
constexpr size_t WS_AS = WS_GV;
constexpr size_t WS_HS = WS_AS + (size_t)8 * BS * 512 * 1024 * 2;
static_assert(WS_HS + (size_t)8 * BS * 512 * 256 * 4 <= WS_GV + (size_t)MROWS * 2 * DFF * 4, "prologue buffers must fit inside the GV region");
constexpr size_t WS_SLAB = WS_CBIAS + 8 * 128 * 4;
constexpr size_t WS_W2T = WS_SLAB + (size_t)8 * 256 * DM * 4;
constexpr size_t WS_FRAW = WS_W2T + (size_t)8 * 64 * 128 * 2;
constexpr int SPLIT_UP = 1;
constexpr size_t WS_FHALO = WS_FRAW + (size_t)SPLIT_UP * 256 * 2 * DFF * 4;
constexpr size_t WS_FLAST = WS_FHALO + (size_t)64 * 2 * 2 * DFF * 4;
constexpr size_t WS_END = WS_FLAST + (size_t)64 * 2 * DFF * 4;
constexpr int SPLIT_OUT = 4, SPLIT_DOWN = 8;

constexpr int RING_BYTES = 131072;
constexpr int MISC_OFF = RING_BYTES + 320;
constexpr int LDS_BYTES = 147456;
constexpr int NWAVES = 8, NTHR = 512;
constexpr int XB_OFF = RING_BYTES + 1024;
static_assert(XB_OFF + 4096 <= LDS_BYTES, "LDS map");

constexpr int PH_PER_LAYER = 10, N_PRO = 3, N_PHASES = N_PRO + DEPTH * PH_PER_LAYER;

struct Params { const float* in[N_IN]; float* out; unsigned char* ws; int ph_lo, ph_hi; };

__device__ __forceinline__ unsigned f2bf(float f) { unsigned u = __builtin_bit_cast(unsigned, f); return (u + 0x7fffu + ((u >> 16) & 1u)) >> 16; }
__device__ __forceinline__ unsigned pk2(float lo, float hi) { return f2bf(lo) | (f2bf(hi) << 16); }
__device__ __forceinline__ f32x4 bf4_to_f32(unsigned long long u) {
    return (f32x4){__uint_as_float((unsigned)u << 16), __uint_as_float((unsigned)u & 0xffff0000u), __uint_as_float((unsigned)(u >> 32) << 16), __uint_as_float((unsigned)(u >> 32) & 0xffff0000u)};
}
__device__ __forceinline__ float wave_sum(float v) {
#pragma unroll
    for (int o = 1; o < 64; o <<= 1) v += __shfl_xor(v, o);
    return v;
}
__device__ __forceinline__ float sum16(float v) {
#pragma unroll
    for (int o = 1; o < 16; o <<= 1) v += __shfl_xor(v, o);
    return v;
}
__device__ __forceinline__ float sigmoidf_(float x) { return 1.f / (1.f + expf(-x)); }
__device__ __forceinline__ float siluf_(float x) { return x / (1.f + expf(-x)); }
__device__ __forceinline__ float softplusf_(float x) { return x > 0.f ? x + log1pf(expf(-x)) : log1pf(expf(x)); }
__device__ __forceinline__ float gelu_tanh(float x) {
    const float u = 0.7978845608028654f * (x + 0.044715f * x * x * x);
    const float t = 1.f - 2.f / (expf(2.f * u) + 1.f);
    return 0.5f * x * (1.f + t);
}
__device__ __forceinline__ void cossin_d(float angf, float& c, float& s) {
    const double a = (double)angf;
    const double k = rint(a * 0.63661977236758134308);
    const double r = (a - k * 1.57079632679489655800) - k * 6.123233995736766036e-17;
    const double r2 = r * r;
    double sp = r * (1.0 + r2 * (-1.0 / 6 + r2 * (1.0 / 120 + r2 * (-1.0 / 5040 + r2 * (1.0 / 362880 + r2 * (-1.0 / 39916800 + r2 * (1.0 / 6227020800.0)))))));
    double cp = 1.0 + r2 * (-0.5 + r2 * (1.0 / 24 + r2 * (-1.0 / 720 + r2 * (1.0 / 40320 + r2 * (-1.0 / 3628800 + r2 * (1.0 / 479001600.0 + r2 * (-1.0 / 87178291200.0)))))));
    const int q = ((int)k) & 3;
    double cc = (q == 0) ? cp : (q == 1) ? -sp : (q == 2) ? -cp : sp;
    double ss = (q == 0) ? sp : (q == 1) ? cp : (q == 2) ? -sp : -cp;
    c = (float)cc; s = (float)ss;
}

struct Seq { int T, row0, pos0, b, samp; };
__device__ __forceinline__ Seq seq_of(int s) {
    Seq q;
    if (s < BP) { q.T = TP; q.row0 = s * TP; q.pos0 = 0; q.b = s; q.samp = 0; }
    else { q.T = TS; q.row0 = NP + (s - BP) * TS; q.pos0 = PAST; q.b = s - BP; q.samp = 1; }
    return q;
}
__device__ __forceinline__ void row_to_seq(int r, int& s, int& t) {
    if (r < NP) { s = r >> 11; t = r & (TP - 1); } else { const int q = r - NP; s = BP + (q >> 3); t = q & 7; }
}

#define XB_TMO      128
#define XB_XCNT(j)  (256  + 64 * (j))
#define XB_XSUB(j)  (1280 + 64 * (j))
#define XB_XGEN(j)  (2304 + 64 * (j))
#define XB_TOP      3328
#define XB_TOPGEN   3392
#define XCD_BAR_WORDS 3456
#define XB_SPIN_CAP (1u << 21)
__device__ __forceinline__ unsigned xb_ld(unsigned* p)              { return __hip_atomic_load(p, __ATOMIC_RELAXED, __HIP_MEMORY_SCOPE_AGENT); }
__device__ __forceinline__ unsigned xb_add(unsigned* p, unsigned v) { return __hip_atomic_fetch_add(p, v, __ATOMIC_RELAXED, __HIP_MEMORY_SCOPE_AGENT); }
__device__ __forceinline__ unsigned xb_xcc_id() { return (unsigned)__builtin_amdgcn_s_getreg((3 << 11) | 20) & 0xFu; }
#define XB_SPIN(cond, bar) do { unsigned _sp = 0; while (cond) { __builtin_amdgcn_s_sleep(1); \
    if ((++_sp & 255u) == 0u) { if (xb_ld(&(bar)[XB_TMO])) break; if (_sp > XB_SPIN_CAP) { atomicAdd(&(bar)[XB_TMO], 1u); break; } } } } while (0)
struct XcdBarrier { unsigned* bar; unsigned x; volatile LAS unsigned* st; };
__device__ __forceinline__ XcdBarrier xcd_barrier_post(unsigned* bar, volatile LAS unsigned* st) {
    XcdBarrier b; b.bar = bar; b.x = xb_xcc_id(); b.st = st;
    if (threadIdx.x == 0) (void)xb_add(&bar[XB_XCNT(b.x)], 1u);
    return b;
}
__device__ __forceinline__ void xcd_barrier_complete(unsigned* bar, unsigned x, unsigned& nloc, unsigned& nx) {
    const unsigned G = gridDim.x * gridDim.y * gridDim.z;
    unsigned sum, cnt, mine, sp = 0u;
    for (;;) {
        sum = 0u; cnt = 0u; mine = 0u;
#pragma unroll
        for (unsigned j = 0; j < 16; ++j) { const unsigned c = xb_ld(&bar[XB_XCNT(j)]); sum += c; cnt += (c > 0u) ? 1u : 0u; mine = (j == x) ? c : mine; }
        if (sum == G) break;
        __builtin_amdgcn_s_sleep(1);
        if ((++sp & 255u) == 0u) { if (xb_ld(&bar[XB_TMO])) break; if (sp > XB_SPIN_CAP) { atomicAdd(&bar[XB_TMO], 1u); break; } }
    }
    nloc = mine > 0u ? mine : 1u; nx = cnt > 0u ? cnt : 1u;
}
__device__ __forceinline__ void xcd_barrier(const XcdBarrier& b, const bool lead) {
    asm volatile("s_waitcnt vmcnt(0)" ::: "memory");
    __syncthreads();
    if (lead) {
        unsigned* bar = b.bar;
        __builtin_amdgcn_s_waitcnt(0);
        unsigned nloc = b.st[0], nx = b.st[1];
        if (nloc == 0u) { xcd_barrier_complete(bar, b.x, nloc, nx); b.st[0] = nloc; b.st[1] = nx; }
        const unsigned old = xb_add(&bar[XB_XSUB(b.x)], 1u);
        const unsigned gen = old / nloc;
        if (old + 1u == (gen + 1u) * nloc) {
            __builtin_amdgcn_fence(__ATOMIC_RELEASE, "agent");
            asm volatile("s_waitcnt vmcnt(0)" ::: "memory");
            const unsigned og = xb_add(&bar[XB_TOP], 1u);
            const unsigned tg = og / nx;
            if (og + 1u == (tg + 1u) * nx) xb_add(&bar[XB_TOPGEN], 1u);
            else XB_SPIN(xb_ld(&bar[XB_TOPGEN]) == tg, bar);
            __builtin_amdgcn_fence(__ATOMIC_ACQUIRE, "agent");
            xb_add(&bar[XB_XGEN(b.x)], 1u);
            asm volatile("s_waitcnt vmcnt(0)" ::: "memory");
        } else {
            XB_SPIN(xb_ld(&bar[XB_XGEN(b.x)]) == gen, bar);
            __builtin_amdgcn_fence(__ATOMIC_ACQUIRE, "agent");
            asm volatile("s_waitcnt vmcnt(0)" ::: "memory");
        }
    }
    __syncthreads();
}

struct Frame {
    LAS unsigned char* lds;
    int tid, lane, wave, gw, ngw, G;
    const __attribute__((address_space(4))) Params* p;
    unsigned char* ws;
    float* out;
};
#define INP(F, i) ((F).p->in[(i)])
#define WSP(F, T, off) ((T*)((F).ws + (off)))

__device__ __forceinline__ const float* x_in_row(const Frame& F, int r) {
    return r < NP ? INP(F, I_XP) + (size_t)r * DM : INP(F, I_XS) + (size_t)(r - NP) * DM;
}

template <bool ILV = false>
__device__ __forceinline__ void transpose_item(const float* W, int K, int N, int nblk, bf16* WT, int row_off, LAS float* scr, int item, int lane) {
    const int kb = item / nblk, nb = item % nblk, k0 = 64 * kb, n0 = 32 * nb;
    const int r0 = ILV ? 256 * (n0 >> 7) + (n0 & 127) : n0;
    const int n = n0 + (lane & 31);
    float tv[32];
#pragma unroll
    for (int i = 0; i < 32; ++i) { const int kk = 2 * i + (lane >> 5); tv[i] = (n < N) ? W[(size_t)(k0 + kk) * N + n] : 0.f; }
#pragma unroll
    for (int i = 0; i < 32; ++i) { const int kk = 2 * i + (lane >> 5); scr[kk * 33 + (lane & 31)] = tv[i]; }
    asm volatile("s_waitcnt lgkmcnt(0)" ::: "memory");
    const int c = lane & 7;
#pragma unroll
    for (int j = 0; j < 4; ++j) { const int nn = (lane >> 3) + 8 * j; const LAS float* s = scr + (8 * c) * 33 + nn;
        v4u o; o.x = pk2(s[0 * 33], s[1 * 33]); o.y = pk2(s[2 * 33], s[3 * 33]); o.z = pk2(s[4 * 33], s[5 * 33]); o.w = pk2(s[6 * 33], s[7 * 33]);
        *(v4u*)(WT + (size_t)(row_off + r0 + nn) * K + k0 + 8 * c) = o; }
    asm volatile("s_waitcnt lgkmcnt(0)" ::: "memory");
}
__device__ __forceinline__ void norm_row_to_bf16(const Frame& F, const float* xrow, const float* w, bf16* orow) {
    const f32x4* xr = (const f32x4*)xrow + F.lane; const f32x4* wr = (const f32x4*)w + F.lane;
    f32x4 v[4]; float ss = 0.f;
#pragma unroll
    for (int j = 0; j < 4; ++j) { v[j] = xr[64 * j]; ss += (v[j].x * v[j].x + v[j].y * v[j].y) + (v[j].z * v[j].z + v[j].w * v[j].w); }
    const float rs = 1.f / sqrtf(wave_sum(ss) * (1.f / DM) + RMS_EPS);
    unsigned long long* o8 = (unsigned long long*)orow + F.lane;
#pragma unroll
    for (int j = 0; j < 4; ++j) { const f32x4 g = wr[64 * j];
        o8[64 * j] = (unsigned long long)pk2(v[j].x * rs * g.x, v[j].y * rs * g.y) | ((unsigned long long)pk2(v[j].z * rs * g.z, v[j].w * rs * g.w) << 32); }
}
__device__ __forceinline__ void phase_prologue(const Frame& F) {
    LAS float* scr = (LAS float*)(F.lds + F.wave * 16384);
    constexpr int IT_IN = 16 * (IN_WP / 32), IT_OUT = 16 * 32, IT_UP = 16 * 128, IT_DN = 64 * 32, IT_L = IT_IN + IT_OUT + 2 * IT_UP + IT_DN;
    for (int it = F.gw; it < DEPTH * IT_L; it += F.ngw) {
        const int l = it / IT_L; int r = it % IT_L;
        if (r < IT_IN) { transpose_item(INP(F, I_WIN) + (size_t)l * DM * IN_W, DM, IN_W, IN_WP / 32, WSP(F, bf16, WS_WTIN) + (size_t)l * IN_WP * DM, 0, scr, r, F.lane); continue; } r -= IT_IN;
        if (r < IT_OUT) { transpose_item(INP(F, I_WOUT) + (size_t)l * DM * DM, DM, DM, 32, WSP(F, bf16, WS_WTOUT) + (size_t)l * DM * DM, 0, scr, r, F.lane); continue; } r -= IT_OUT;
        if (r < IT_UP) { transpose_item<true>(INP(F, I_WGATE) + (size_t)l * DM * DFF, DM, DFF, 128, WSP(F, bf16, WS_WTUP) + (size_t)l * 2 * DFF * DM, 0, scr, r, F.lane); continue; } r -= IT_UP;
        if (r < IT_UP) { transpose_item<true>(INP(F, I_WVAL) + (size_t)l * DM * DFF, DM, DFF, 128, WSP(F, bf16, WS_WTUP) + (size_t)l * 2 * DFF * DM, 128, scr, r, F.lane); continue; } r -= IT_UP;
        transpose_item(INP(F, I_WDOWN) + (size_t)l * DFF * DM, DFF, DM, 32, WSP(F, bf16, WS_WTDN) + (size_t)l * DM * DFF, 0, scr, r, F.lane);
    }
    for (int it = F.gw; it < 8 * 2 * 64; it += F.ngw) {
        const int i = it >> 7, half = (it >> 6) & 1, r = it & 63; const int lyr = i >> 1, kv = i & 1;
        const float* w1 = INP(F, kv ? I_W1V : I_W1K) + (size_t)lyr * 32 * 64 * 128 + (size_t)half * 1024 * 128;
        transpose_item(w1, 1024, 128, 4, WSP(F, bf16, WS_WTC) + (size_t)i * 256 * 1024, half * 128, scr, r, F.lane);
    }
    for (int idx = blockIdx.x * NTHR + F.tid; idx < 8 * 64 * 128; idx += F.G * NTHR) {
        const int i = idx >> 13, d = (idx >> 7) & 63, e = idx & 127;
        WSP(F, bf16, WS_W2T)[idx] = (bf16)f2bf((INP(F, (i & 1) ? I_W2V : I_W2K) + (size_t)(i >> 1) * 128 * 64)[e * 64 + d]);
    }
    for (int idx = blockIdx.x * NTHR + F.tid; idx < 8 * 128; idx += F.G * NTHR) {
        const int i = idx >> 7, e = idx & 127; const int lyr = i >> 1, kv = i & 1;
        const float* w1 = INP(F, kv ? I_W1V : I_W1K) + (size_t)lyr * 32 * 64 * 128; const float* pe = INP(F, kv ? I_PEV : I_PEK) + (size_t)lyr * 32 * 64;
        float a = 0.f; for (int k = 0; k < 2048; ++k) a += pe[k] * w1[(size_t)k * 128 + e];
        WSP(F, float, WS_CBIAS)[idx] = a;
    }
    for (int it2 = F.gw; it2 < DEPTH * BS * 256; it2 += F.ngw) {
        f32x4 a[2][2][4]; int lyrv[2], bv[2], cv[2];
#pragma unroll
        for (int u = 0; u < 2; ++u) {
            const int it = 2 * it2 + u; const int lyr = it >> 14, b = (it >> 9) & 31, c = it & 511; lyrv[u] = lyr; bv[u] = b; cv[u] = c;
            const int page = ((const int*)INP(F, I_PT))[b * NPAGES + (c >> 3)];
            const int row = F.lane >> 2, qd = F.lane & 3;
            const float* src = INP(F, I_CACHE) + ((((size_t)lyr * NPHYS + page) * PAGE + (c & 7) * 16 + row) * 4) * 64 + qd * 16;
#pragma unroll
            for (int kv = 0; kv < 2; ++kv)
#pragma unroll
                for (int k = 0; k < 4; ++k) a[u][kv][k] = *(const f32x4*)(src + kv * 64 + 4 * k);
        }
#pragma unroll
        for (int u = 0; u < 2; ++u) {
            const int row = F.lane >> 2, qd = F.lane & 3;
#pragma unroll
            for (int kv = 0; kv < 2; ++kv) {
                const f32x4 a0 = a[u][kv][0], a1 = a[u][kv][1], a2 = a[u][kv][2], a3 = a[u][kv][3];
                v4u o0, o1; o0.x = pk2(a0.x, a0.y); o0.y = pk2(a0.z, a0.w); o0.z = pk2(a1.x, a1.y); o0.w = pk2(a1.z, a1.w); o1.x = pk2(a2.x, a2.y); o1.y = pk2(a2.z, a2.w); o1.z = pk2(a3.x, a3.y); o1.w = pk2(a3.z, a3.w);
                bf16* dst = WSP(F, bf16, WS_AS) + ((((size_t)(lyrv[u] * 2 + kv) * BS + bv[u]) * 512 + cv[u]) * 1024) + row * 64 + qd * 16;
                *(v4u*)dst = o0; *(v4u*)(dst + 8) = o1;
            }
        }
    }
    {
        const float inv[8] = {1.0f, 0.193922758102417f, 0.03760603070259094f, 0.00729266507551074f, 0.001414213445968926f, 0.00027424818836152554f, 5.318296462064609e-05f, 1.0313385246263351e-05f};
        float* rope = WSP(F, float, WS_ROPE);
        for (int i = blockIdx.x * NTHR + F.tid; i < 2056 * 8; i += F.G * NTHR) {
            const int pi = i >> 3, f = i & 7; const int pos = pi < TP ? pi : PAST + (pi - TP);
            float iv = inv[0];
#pragma unroll
            for (int k = 1; k < 8; ++k) iv = (f == k) ? inv[k] : iv;
            const float ang = (float)pos * iv; float c, s; cossin_d(ang, c, s);
            rope[pi * 16 + f] = c; rope[pi * 16 + 8 + f] = s;
        }
    }
    for (int r = F.gw; r < MROWS; r += F.ngw) norm_row_to_bf16(F, x_in_row(F, r), INP(F, I_NMPRE), WSP(F, bf16, WS_XN) + (size_t)r * DM);
}

typedef float f32x16p __attribute__((ext_vector_type(16)));
__device__ __forceinline__ void phase_cmp_finish(const Frame& F) {
    const float* H = WSP(F, float, WS_HS);
    const int lane = F.lane, r32 = lane & 31, hp = lane >> 5;
    for (int it = F.gw; it < 8 * BS * 16; it += F.ngw) {
        const int i = it >> 9, b = (it >> 4) & 31, n0 = (it & 15) * 32; const int lyr = i >> 1, kv = i & 1;
        const int n = n0 + r32; const int n1 = (n + 1 < 512) ? n + 1 : 511;
        const float* h0 = H + (((size_t)i * BS + b) * 512 + n) * 256; const float* h1 = H + (((size_t)i * BS + b) * 512 + n1) * 256 + 128;
        const float* bias = WSP(F, float, WS_CBIAS) + i * 128;
        const bf16* w2t = WSP(F, bf16, WS_W2T) + (size_t)i * 64 * 128;
        f32x16p acc0, acc1;
#pragma unroll
        for (int k = 0; k < 16; ++k) { acc0[k] = 0.f; acc1[k] = 0.f; }
#pragma unroll
        for (int ks = 0; ks < 8; ++ks) {
            const int e = 16 * ks + 8 * hp;
            const f32x4 a0 = *(const f32x4*)(h0 + e), a1 = *(const f32x4*)(h0 + e + 4), c0 = *(const f32x4*)(h1 + e), c1 = *(const f32x4*)(h1 + e + 4);
            const f32x4 b0 = *(const f32x4*)(bias + e), b1 = *(const f32x4*)(bias + e + 4);
            const f32x4 x0 = a0 + c0 + b0, x1 = a1 + c1 + b1;
            v4u av; av.x = pk2(gelu_tanh(x0.x), gelu_tanh(x0.y)); av.y = pk2(gelu_tanh(x0.z), gelu_tanh(x0.w)); av.z = pk2(gelu_tanh(x1.x), gelu_tanh(x1.y)); av.w = pk2(gelu_tanh(x1.z), gelu_tanh(x1.w));
            const bf16x8 bf0 = *(const bf16x8*)(w2t + (size_t)r32 * 128 + e), bf1 = *(const bf16x8*)(w2t + (size_t)(32 + r32) * 128 + e);
            acc0 = __builtin_amdgcn_mfma_f32_32x32x16_bf16(__builtin_bit_cast(bf16x8, av), bf0, acc0, 0, 0, 0);
            acc1 = __builtin_amdgcn_mfma_f32_32x32x16_bf16(__builtin_bit_cast(bf16x8, av), bf1, acc1, 0, 0, 0);
        }
        float* dst = WSP(F, float, kv ? WS_CVS : WS_CKS) + (((size_t)lyr * BS + b) * NCMP_S) * 64;
#pragma unroll
        for (int k = 0; k < 16; ++k) { const int nn = n0 + (k & 3) + 8 * (k >> 2) + 4 * hp;
            if (nn < NCMP_S) { dst[(size_t)nn * 64 + r32] = acc0[k]; dst[(size_t)nn * 64 + 32 + r32] = acc1[k]; } }
    }
}

__device__ __forceinline__ float rope_lane(float x, int lane, float cs_c, float cs_s) {
    const float other = __shfl_xor(x, 8);
    const float rot = (lane < 8) ? x * cs_c - other * cs_s : x * cs_c + other * cs_s;
    return (lane < 16) ? rot : x;
}
template <int NR>
__device__ __forceinline__ void token_prep4(const Frame& F, int l, int r0, const LAS float* pw_lds, LAS float* pl) {
    int s, t0; row_to_seq(r0, s, t0); const Seq q = seq_of(s);
    const int lane = F.lane;
    const float* spool = INP(F, I_SPOOL) + ((size_t)l * BS + q.b) * POOL_KEEP * POOL_W;
    const float* proj0 = WSP(F, float, WS_PROJ) + (size_t)r0 * IN_WP;
    float qx[NR][4], kx[NR][6], csc[NR], css[NR];
#pragma unroll
    for (int u = 0; u < NR; ++u) {
        const float* proj = proj0 + (size_t)u * IN_WP; const int t = t0 + u;
        const float* rp = WSP(F, float, WS_ROPE) + (size_t)(q.samp ? TP + t : t) * 16;
#pragma unroll
        for (int j = 0; j < 4; ++j) qx[u][j] = proj[OFF_Q + j * 64 + lane];
#pragma unroll
        for (int j = 0; j < 6; ++j) kx[u][j] = proj[OFF_KV + j * 64 + lane];
        csc[u] = rp[lane & 7]; css[u] = rp[8 + (lane & 7)];
    }
    float e0[2 + NR - 1], e1[4 + NR - 1], e2[8 + NR - 1], e3[16 + NR - 1];
#define LOAD_EXT(EARR, G, W) do { _Pragma("unroll") for (int k = 0; k < (W) + NR - 1; ++k) { const int tt = t0 - ((W) - 1) + k; const int c = (G) * 64 + lane; \
          \
        const float* pa = (tt >= 0) ? proj0 + (long)(tt - t0) * IN_WP + OFF_POOL + c : (q.samp ? spool + (POOL_KEEP + tt) * POOL_W + c : proj0 + OFF_POOL + c); \
        const float v = *pa; EARR[k] = (tt >= 0 || q.samp) ? v : 0.f; } } while (0)
    LOAD_EXT(e0, 0, 2); LOAD_EXT(e1, 1, 4); LOAD_EXT(e2, 2, 8); LOAD_EXT(e3, 3, 16);
#undef LOAD_EXT
    float pooled[NR][4], pu[NR][4];
#pragma unroll
    for (int u = 0; u < NR; ++u) {
        const int pos = q.pos0 + t0 + u;
        float s0 = 0.f, s1 = 0.f, s2 = 0.f, s3 = 0.f;
#pragma unroll
        for (int i = 0; i < 2; ++i) s0 += e0[u + i];
#pragma unroll
        for (int i = 0; i < 4; ++i) s1 += e1[u + i];
#pragma unroll
        for (int i = 0; i < 8; ++i) s2 += e2[u + i];
#pragma unroll
        for (int i = 0; i < 16; ++i) s3 += e3[u + i];
        pu[u][0] = e0[u + 1]; pu[u][1] = e1[u + 3]; pu[u][2] = e2[u + 7]; pu[u][3] = e3[u + 15];
        pooled[u][0] = s0 / (float)((pos + 1 < 2) ? pos + 1 : 2) - pu[u][0];
        pooled[u][1] = s1 / (float)((pos + 1 < 4) ? pos + 1 : 4) - pu[u][1];
        pooled[u][2] = s2 / (float)((pos + 1 < 8) ? pos + 1 : 8) - pu[u][2];
        pooled[u][3] = s3 / (float)((pos + 1 < 16) ? pos + 1 : 16) - pu[u][3];
    }
#pragma unroll
    for (int u = 0; u < NR; ++u) {
        const int r = r0 + u, t = t0 + u;
        bf16* qb = WSP(F, bf16, WS_QB) + (size_t)r * 256;
#pragma unroll
        for (int j = 0; j < 4; ++j) qb[j * 64 + lane] = (bf16)f2bf(rope_lane(qx[u][j], lane, csc[u], css[u]) * (0.125f * 1.4426950408889634f));
        float* kvout = q.samp ? F.out + O_KVS + ((size_t)l * NS + (r - NP)) * 256 : F.out + O_KVP + ((size_t)l * NP + r) * 256;
        float* kwin = WSP(F, float, WS_KWIN) + (size_t)r * 128;
#pragma unroll
        for (int j = 0; j < 6; ++j) {
            const float v = (j & 1) ? kx[u][j] : rope_lane(kx[u][j], lane, csc[u], css[u]);
            if (j < 4) kvout[j * 64 + lane] = v;
            else {
                kwin[(j - 4) * 64 + lane] = v;
                if (!q.samp) { if (t >= TP - 512) F.out[O_WINP + (((size_t)l * BP + q.b) * 512 + (t - (TP - 512))) * 128 + (j - 4) * 64 + lane] = v; }
                else F.out[O_WINS + (((size_t)l * BS + q.b) * 512 + 504 + t) * 128 + (j - 4) * 64 + lane] = v;
            }
        }
#pragma unroll
        for (int g = 0; g < 4; ++g) pl[u * 256 + g * 64 + lane] = pooled[u][g];
    }
    asm volatile("s_waitcnt lgkmcnt(0)" ::: "memory");
    const float* psc = INP(F, I_POOLSC) + (size_t)l * POOL_W;
#pragma unroll
    for (int g = 0; g < 4; ++g) {
        float y[NR];
#pragma unroll
        for (int u = 0; u < NR; ++u) y[u] = 0.f;
#pragma unroll 4
        for (int c = 0; c < 64; c += 4) { const LAS float* wv = pw_lds + (g * 64 + c) * 64 + lane;
            const float w0 = wv[0], w1 = wv[64], w2 = wv[128], w3 = wv[192];
#pragma unroll
            for (int u = 0; u < NR; ++u) { const f32x4 pa = *(const LAS f32x4*)(pl + u * 256 + g * 64 + c); y[u] += pa.x * w0 + pa.y * w1 + pa.z * w2 + pa.w * w3; } }
        const float sc = psc[g * 64 + lane];
#pragma unroll
        for (int u = 0; u < NR; ++u) (WSP(F, bf16, WS_MIX) + (size_t)(r0 + u) * DM)[512 + g * 64 + lane] = (bf16)f2bf(y[u] * sc);
    }
    asm volatile("s_waitcnt lgkmcnt(0)" ::: "memory");
#pragma unroll
    for (int u = 0; u < NR; ++u) {
        const int r = r0 + u, t = t0 + u; const float* proj = WSP(F, float, WS_PROJ) + (size_t)r * IN_WP;
        if (!q.samp) {
            if (t >= TP - 15) { float* o = F.out + O_POOLP + (((size_t)l * BP + q.b) * 15 + (t - (TP - 15))) * POOL_W;
#pragma unroll
                for (int j = 0; j < 4; ++j) o[j * 64 + lane] = pu[u][j]; }
            if (t >= TP - 3) { float* o = F.out + O_CONVP + (((size_t)l * BP + q.b) * 3 + (t - (TP - 3))) * CONV_DIM;
                for (int j = 0; j < 16; ++j) o[j * 64 + lane] = proj[OFF_XBC + j * 64 + lane]; }
        } else {
            { float* o = F.out + O_POOLS + (((size_t)l * BS + q.b) * 15 + 7 + t) * POOL_W;
#pragma unroll
                for (int j = 0; j < 4; ++j) o[j * 64 + lane] = pu[u][j]; }
            if (t < 7) { float* o = F.out + O_POOLS + (((size_t)l * BS + q.b) * 15 + t) * POOL_W;
#pragma unroll
                for (int j = 0; j < 4; ++j) o[j * 64 + lane] = spool[(8 + t) * POOL_W + j * 64 + lane]; }
            if (t >= TS - 3) { float* o = F.out + O_CONVS + (((size_t)l * BS + q.b) * 3 + (t - (TS - 3))) * CONV_DIM;
                for (int j = 0; j < 16; ++j) o[j * 64 + lane] = proj[OFF_XBC + j * 64 + lane]; }
        }
    }
}

__device__ __forceinline__ float xbc_conv(const Frame& F, int l, const Seq& q, int t, int c) {
    const float* cw = INP(F, I_CONVW) + (size_t)l * 4 * CONV_DIM; const float* cb = INP(F, I_CONVB) + (size_t)l * CONV_DIM;
    const float* proj = WSP(F, float, WS_PROJ);
    const float* sconv = INP(F, I_SCONV) + ((size_t)l * BS + q.b) * 3 * CONV_DIM;
    float acc = cb[c];
#pragma unroll
    for (int k = 0; k < 4; ++k) { const int tt = t - 3 + k; float e = 0.f;
        if (tt >= 0) e = proj[(size_t)(q.row0 + tt) * IN_WP + OFF_XBC + c];
        else if (q.samp) e = sconv[(3 + tt) * CONV_DIM + c];
        acc += e * cw[k * CONV_DIM + c]; }
    return siluf_(acc);
}
__device__ __forceinline__ void ssd_item(const Frame& F, int l, int s, int h) {
    const Seq q = seq_of(s);
    constexpr int TSTG = 16;
    LAS float* xs = (LAS float*)F.lds;
    LAS float* Bs = xs + TSTG * 64;
    LAS float* Cs = Bs + TSTG * 128;
    LAS float* dts = Cs + TSTG * 128;
    LAS float* dAs = dts + TSTG;
    const int tid = F.tid, p = tid >> 3, nq = tid & 7, g = h >> 2;
    const float a = -expf(INP(F, I_ALOG)[l * SSD_H + h]), dtb = INP(F, I_DTB)[l * SSD_H + h], dsk = INP(F, I_SSDD)[l * SSD_H + h];
    float st[16];
    if (q.samp) { const float* s0 = INP(F, I_SSM) + ((((size_t)l * BS + q.b) * SSD_H + h) * SSD_HD + p) * SSD_N + nq * 16;
#pragma unroll
        for (int i = 0; i < 16; ++i) st[i] = s0[i]; }
    else {
#pragma unroll
        for (int i = 0; i < 16; ++i) st[i] = 0.f; }
    const float* proj = WSP(F, float, WS_PROJ);
    float* yssd = WSP(F, float, WS_YSSD);
    for (int t0 = 0; t0 < q.T; t0 += TSTG) {
        const int nt = (q.T - t0 < TSTG) ? q.T - t0 : TSTG;
        __syncthreads();
        for (int i = tid; i < nt * 320; i += NTHR) { const int tt = i / 320, c = i % 320; const int t = t0 + tt;
            if (c < 64) xs[tt * 64 + c] = xbc_conv(F, l, q, t, h * 64 + c);
            else if (c < 192) Bs[tt * 128 + (c - 64)] = xbc_conv(F, l, q, t, 512 + g * 128 + (c - 64));
            else Cs[tt * 128 + (c - 192)] = xbc_conv(F, l, q, t, 768 + g * 128 + (c - 192)); }
        if (tid < nt) { const float dt = softplusf_(proj[(size_t)(q.row0 + t0 + tid) * IN_WP + OFF_DT + h] + dtb); dts[tid] = dt; dAs[tid] = expf(dt * a); }
        __syncthreads();
        for (int tt = 0; tt < nt; ++tt) {
            const float dt = dts[tt], dA = dAs[tt], x = xs[tt * 64 + p], xd = x * dt;
            float y = 0.f;
#pragma unroll
            for (int i = 0; i < 16; ++i) { st[i] = st[i] * dA + xd * Bs[tt * 128 + nq * 16 + i]; y += st[i] * Cs[tt * 128 + nq * 16 + i]; }
            y += __shfl_xor(y, 1); y += __shfl_xor(y, 2); y += __shfl_xor(y, 4);
            if (nq == 0) yssd[(size_t)(q.row0 + t0 + tt) * SSD_W + h * 64 + p] = y + dsk * x;
        }
    }
    float* so = q.samp ? F.out + O_SSMS + ((((size_t)l * BS + q.b) * SSD_H + h) * SSD_HD + p) * SSD_N + nq * 16
                       : F.out + O_SSMP + ((((size_t)l * BP + q.b) * SSD_H + h) * SSD_HD + p) * SSD_N + nq * 16;
#pragma unroll
    for (int i = 0; i < 16; ++i) so[i] = st[i];
    __syncthreads();
}
__device__ __forceinline__ void ssd_chunk_unit(const Frame& F, int l, int b, int c, int g);
__device__ __forceinline__ void ssd_scan(const Frame& F, int l);
__device__ __forceinline__ void ssd_out_unit(const Frame& F, int l, int b, int hc);
__device__ __forceinline__ void phase_prep(const Frame& F, int l) {
    for (int u = blockIdx.x; u < BP * 16 * 2; u += F.G) ssd_chunk_unit(F, l, u >> 5, (u >> 1) & 15, u & 1);
    {
        __syncthreads();
        LAS float* pw_lds = (LAS float*)F.lds; const float* pw = INP(F, I_POOLW) + (size_t)l * 4 * 64 * 64;
        for (int i = F.tid; i < 4 * 64 * 64 / 4; i += NTHR) *(LAS f32x4*)(pw_lds + i * 4) = *(const f32x4*)(pw + i * 4);
        __syncthreads();
        LAS float* pl = (LAS float*)(F.lds + 65536) + F.wave * 1024;
        for (int rp = F.gw; rp < NP / 4; rp += F.ngw) token_prep4<4>(F, l, 4 * rp, pw_lds, pl);
        for (int j = blockIdx.x * 8 + F.wave; j < NS * 8; j += F.G * 8) if ((j & 7) == 0) token_prep4<1>(F, l, NP + (j >> 3), pw_lds, pl);
        __syncthreads();
    }
}

__device__ __forceinline__ const float* kv_row(const Frame& F, int l, const Seq& q, int tok, int kind) {
    if (!q.samp) return F.out + O_KVP + ((size_t)l * NP + q.row0 + tok) * 256 + kind * 64;
    if (tok >= PAST) return F.out + O_KVS + ((size_t)l * NS + (q.row0 - NP) + (tok - PAST)) * 256 + kind * 64;
    const int page = ((const int*)INP(F, I_PT))[q.b * NPAGES + (tok >> 7)];
    return INP(F, I_CACHE) + ((((size_t)l * NPHYS + page) * PAGE + (tok & 127)) * 4 + kind) * 64;
}
typedef float f32x4c __attribute__((ext_vector_type(4)));
__device__ __forceinline__ void compress_item(const Frame& F, int l, int s, int grp, int kv) {
    const Seq q = seq_of(s);
    const int ncmp = NCMP_P;
    const int n0 = grp * 16; const int nb = (ncmp - n0 < 16) ? ncmp - n0 : 16;
    constexpr int CST = 2064;
    LAS unsigned char* rows = F.lds;
    LAS float* hid = (LAS float*)(F.lds + 36864);
    const int tid = F.tid, lane = F.lane, wave = F.wave;
    __syncthreads();
    for (int i = tid; i < 17 * 16 * 8; i += NTHR) { const int rr = i >> 3, dc = i & 7; const int tok = n0 * 16 + rr;
        v4u o = (v4u){0u, 0u, 0u, 0u};
        if (tok < TP) { const float* p = kv_row(F, l, q, tok, kv) + dc * 8; const f32x4 a = *(const f32x4*)p, b = *(const f32x4*)(p + 4);
            o.x = pk2(a.x, a.y); o.y = pk2(a.z, a.w); o.z = pk2(b.x, b.y); o.w = pk2(b.z, b.w); }
        *(LAS v4u*)(rows + (rr >> 4) * CST + (rr & 15) * 128 + dc * 16) = o; }
    __syncthreads();
    const int i2 = l * 2 + kv;
    const bf16* wt = WSP(F, bf16, WS_WTC) + (size_t)i2 * 256 * 1024;
    const int e = 16 * wave + (lane & 15), kq = lane >> 4, blk = lane & 15;
    f32x4c acc = (f32x4c){0.f, 0.f, 0.f, 0.f};
#pragma unroll 8
    for (int ks = 0; ks < 64; ++ks) {
        const int half = ks >> 5, kk = (ks & 31) * 32 + 8 * kq;
        const bf16x8 bfrag = *(const bf16x8*)(wt + (size_t)(half * 128 + e) * 1024 + kk);
        const bf16x8 afrag = *(const LAS bf16x8*)(rows + (blk + half) * CST + kk * 2);
        acc = __builtin_amdgcn_mfma_f32_16x16x32_bf16(afrag, bfrag, acc, 0, 0, 0);
    }
    { const float bias = WSP(F, float, WS_CBIAS)[i2 * 128 + e];
#pragma unroll
      for (int k = 0; k < 4; ++k) hid[(kq * 4 + k) * 128 + e] = gelu_tanh(acc[k] + bias); }
    __syncthreads();
    const float* w2 = INP(F, kv ? I_W2V : I_W2K) + (size_t)l * 128 * 64;
    float* dst = WSP(F, float, kv ? WS_CVP : WS_CKP) + (size_t)q.b * NCMP_P * 64;
    { const int bi = tid >> 5, d0 = (tid & 31) * 2;
        if (bi < nb) { float o0 = 0.f, o1 = 0.f;
#pragma unroll 8
            for (int k = 0; k < 128; ++k) { const float hv = hid[bi * 128 + k]; o0 += hv * w2[k * 64 + d0]; o1 += hv * w2[k * 64 + d0 + 1]; }
            dst[(size_t)(n0 + bi) * 64 + d0] = o0; dst[(size_t)(n0 + bi) * 64 + d0 + 1] = o1; } }
    __syncthreads();
}
__device__ __forceinline__ void attn_sample_unit(const Frame& F, int l, int b, int t0);
__device__ __forceinline__ void phase_compress(const Frame& F, int l) {
    constexpr int NI_P = BP * 8 * 2;
    for (int it = blockIdx.x; it < NI_P; it += F.G) compress_item(F, l, it >> 4, (it >> 1) & 7, it & 1);
    ssd_scan(F, l);
    { int bi = (int)blockIdx.x, nb = F.G; if (nb == 256) { bi -= 128; nb = 128; }
      if (bi >= 0) for (int it = BP * SSD_H + bi; it < NSEQ * SSD_H; it += nb) ssd_item(F, l, it >> 3, it & 7); }
    { Frame G2 = F; { int ln = G2.lane; asm volatile("" : "+v"(ln)); G2.lane = ln; G2.tid = G2.wave * 64 + ln; }
      for (int u = blockIdx.x; u < NS; u += F.G) attn_sample_unit(G2, l, u >> 3, u & 7); }
}

__device__ __forceinline__ void osm_step(float sc, const f32x4 v, float& m, float& lsum, f32x4& o) {
    const float mn = fmaxf(m, sc); const float al = expf(m - mn), pp = expf(sc - mn);
    lsum = lsum * al + pp; o = o * al + v * pp; m = mn;
}
__device__ __forceinline__ void nsa_token(const Frame& F, int l, int r) {
    int s, t; row_to_seq(r, s, t); const Seq q = seq_of(s);
    const int lane = F.lane, hh = lane >> 4, sub = lane & 15;
    const int tpos = q.pos0 + t;
    LAS float* sc = (LAS float*)(F.lds + F.wave * 12288);
    LAS float* impv = sc + 2048;
    LAS int* sel = (LAS int*)(impv + 192);
    const f32x4 qv = *(const f32x4*)(WSP(F, float, WS_Q) + (size_t)r * 256 + hh * 64 + sub * 4);
    const int ncmp = q.samp ? NCMP_S : NCMP_P;
    const float* ck = q.samp ? WSP(F, float, WS_CKS) + (size_t)q.b * NCMP_S * 64 : WSP(F, float, WS_CKP) + (size_t)q.b * NCMP_P * 64;
    const float* cv = q.samp ? WSP(F, float, WS_CVS) + (size_t)q.b * NCMP_S * 64 : WSP(F, float, WS_CVP) + (size_t)q.b * NCMP_P * 64;
    int nvis = 0; if (tpos >= 31) { nvis = (tpos - 31) / 16 + 1; if (nvis > ncmp) nvis = ncmp; }
    float mx = -INFINITY;
    for (int n = 0; n < nvis; ++n) { const f32x4 kk = *(const f32x4*)(ck + (size_t)n * 64 + sub * 4);
        const float d = sum16(qv.x * kk.x + qv.y * kk.y + qv.z * kk.z + qv.w * kk.w);
        if (sub == 0) sc[hh * 512 + n] = d; mx = fmaxf(mx, d); }
    asm volatile("s_waitcnt lgkmcnt(0)" ::: "memory");
    float ls = 0.f;
    for (int n = sub; n < nvis; n += 16) { const float e = expf(sc[hh * 512 + n] - mx); sc[hh * 512 + n] = e; ls += e; }
    ls = sum16(ls);
    const float rl = ls > 0.f ? 1.f / ls : 0.f;
    for (int n = sub; n < nvis; n += 16) sc[hh * 512 + n] *= rl;
    asm volatile("s_waitcnt lgkmcnt(0)" ::: "memory");
    f32x4 ocmp = (f32x4){0.f, 0.f, 0.f, 0.f};
    for (int n = 0; n < nvis; ++n) { const float pp = sc[hh * 512 + n]; ocmp += *(const f32x4*)(cv + (size_t)n * 64 + sub * 4) * pp; }
    const int nslc = q.samp ? 129 : 32, cur = tpos >> 6;
    for (int j = lane; j < nslc; j += 64) {
        float v;
        if (j > cur) v = -INFINITY;
        else if (j == 0 || j == cur || j == cur - 1) v = INFINITY;
        else { v = 0.f;
            for (int n = 4 * j - 1; n <= 4 * j + 3; ++n) if (n >= 0 && n < nvis) v += (sc[n] + sc[512 + n]) + (sc[1024 + n] + sc[1536 + n]); }
        impv[j] = v;
    }
    asm volatile("s_waitcnt lgkmcnt(0)" ::: "memory");
    int nsel = 0;
    for (int j0 = 0; j0 < nslc; j0 += 64) {
        const int j = j0 + lane; bool selj = false;
        if (j < nslc) { const float vj = impv[j]; int rank = 0;
            for (int k = 0; k < nslc; ++k) { const float vk = impv[k]; rank += (vk > vj || (vk == vj && k < j)) ? 1 : 0; }
            selj = (rank < 16) && (j <= cur); }
        const unsigned long long bal = __ballot(selj);
        if (selj) sel[nsel + __popcll(bal & ((1ull << lane) - 1ull))] = j;
        nsel += __popcll(bal);
    }
    asm volatile("s_waitcnt lgkmcnt(0)" ::: "memory");
    float m2 = -INFINITY, l2 = 0.f; f32x4 o2 = (f32x4){0.f, 0.f, 0.f, 0.f};
    for (int si = 0; si < nsel; ++si) {
        const int j = sel[si]; int ntok = tpos - 64 * j + 1; if (ntok > 64) ntok = 64;
        for (int i = 0; i < ntok; ++i) { const int tok = 64 * j + i;
            const float* kr = kv_row(F, l, q, tok, 2);
            const f32x4 kk = *(const f32x4*)(kr + sub * 4); const f32x4 vv = *(const f32x4*)(kr + 64 + sub * 4);
            const float d = sum16(qv.x * kk.x + qv.y * kk.y + qv.z * kk.z + qv.w * kk.w);
            osm_step(d, vv, m2, l2, o2); }
    }
    float m3 = -INFINITY, l3 = 0.f; f32x4 o3 = (f32x4){0.f, 0.f, 0.f, 0.f};
    {
        int k0 = tpos - 511; if (k0 < 0) k0 = 0;
        const float* swin = INP(F, I_SWIN) + ((size_t)l * BS + q.b) * 512 * 128;
        const float* kwin = WSP(F, float, WS_KWIN);
        for (int kp = k0; kp <= tpos; ++kp) {
            const float* kr;
            if (!q.samp) kr = kwin + (size_t)(q.row0 + kp) * 128;
            else if (kp >= PAST) kr = kwin + (size_t)(q.row0 + kp - PAST) * 128;
            else kr = swin + (size_t)(kp - (PAST - 512)) * 128;
            const f32x4 kk = *(const f32x4*)(kr + sub * 4); const f32x4 vv = *(const f32x4*)(kr + 64 + sub * 4);
            const float d = sum16(qv.x * kk.x + qv.y * kk.y + qv.z * kk.z + qv.w * kk.w);
            osm_step(d, vv, m3, l3, o3); }
    }
    const float* gp = WSP(F, float, WS_PROJ) + (size_t)r * IN_WP + OFF_G + hh * 3;
    const float g0 = sigmoidf_(gp[0]), g1 = sigmoidf_(gp[1]), g2 = sigmoidf_(gp[2]);
    const float r2 = l2 > 0.f ? 1.f / l2 : 0.f, r3 = l3 > 0.f ? 1.f / l3 : 0.f;
    const f32x4 y = ocmp * g0 + o2 * (g1 * r2) + o3 * (g2 * r3);
    unsigned long long* mo = (unsigned long long*)(WSP(F, bf16, WS_MIX) + (size_t)r * DM + 768 + hh * 64 + sub * 4);
    *mo = (unsigned long long)pk2(y.x, y.y) | ((unsigned long long)pk2(y.z, y.w) << 32);
}
__device__ __forceinline__ void ssd_finish_token(const Frame& F, int l, int r) {
    const float* y = WSP(F, float, WS_YSSD) + (size_t)r * SSD_W; const float* z = WSP(F, float, WS_PROJ) + (size_t)r * IN_WP;
    const float* nw = INP(F, I_SSDNORM) + (size_t)l * SSD_W;
    float v[8]; float ss = 0.f;
#pragma unroll
    for (int j = 0; j < 8; ++j) { const int c = j * 64 + F.lane; v[j] = y[c] * siluf_(z[c]); ss += v[j] * v[j]; }
    const float rs = 1.f / sqrtf(wave_sum(ss) * (1.f / SSD_W) + RMS_EPS);
    bf16* mix = WSP(F, bf16, WS_MIX) + (size_t)r * DM;
#pragma unroll
    for (int j = 0; j < 8; ++j) { const int c = j * 64 + F.lane; mix[c] = (bf16)f2bf(v[j] * rs * nw[c]); }
}
__device__ __forceinline__ void phase_attn(const Frame& F, int l) {
    for (int r = F.gw; r < MROWS; r += F.ngw) { nsa_token(F, l, r); ssd_finish_token(F, l, r); }
}


typedef short bf16x8 __attribute__((ext_vector_type(8)));
typedef float f32x16 __attribute__((ext_vector_type(16)));
typedef float f32x2_t __attribute__((ext_vector_type(2))); typedef __bf16 bf16x2_t __attribute__((ext_vector_type(2)));
__device__ __forceinline__ unsigned cvtpk(float lo, float hi) { f32x2_t v = {lo, hi}; bf16x2_t b = __builtin_convertvector(v, bf16x2_t); return __builtin_bit_cast(unsigned, b); }
__device__ __forceinline__ float half_sum(float v) { auto rr = __builtin_amdgcn_permlane32_swap(__float_as_uint(v), __float_as_uint(v), false, false); return __uint_as_float(rr[0]) + __uint_as_float(rr[1]); }
__device__ __forceinline__ float half_max(float v) { auto rr = __builtin_amdgcn_permlane32_swap(__float_as_uint(v), __float_as_uint(v), false, false); return fmaxf(__uint_as_float(rr[0]), __uint_as_float(rr[1])); }

constexpr float QSCALE_B = 0.125f * 1.4426950408889634f;
constexpr int AT_K = 0, AT_V = 16384, AT_IMPG = 32768, AT_IMPE = AT_IMPG + 8192, AT_SEL = AT_IMPE + 8192, AT_UNI = AT_SEL + 2048, AT_LIST = AT_UNI + 64, AT_NLIST = AT_LIST + 768,
              AT_PAGE = AT_NLIST + 64, AT_RANK = AT_PAGE + 768, AT_OUT = AT_RANK + 8 * 1024, AT_END = AT_OUT + 8 * 8192;
static_assert(AT_END <= RING_BYTES, "attention LDS map");
enum { KIND_CMP1 = 0, KIND_CMP2 = 1, KIND_SLC = 2, KIND_WIN = 3 };

struct TileRegs { f32x4 k0, k1, v0, v1; };
__device__ __forceinline__ void tile_load(const Frame& F, int l, const Seq& q, int kind, int tile, int pg, TileRegs& R) {
    int t_ = F.tid; asm volatile("" : "+v"(t_));
    const int key = tile * 64 + (t_ >> 3), dc = t_ & 7;
    const float* kr = nullptr; const float* vr = nullptr;
    if (kind <= KIND_CMP2) {
        const int ncmp = q.samp ? NCMP_S : NCMP_P;
        if (key < ncmp) {
            kr = (q.samp ? WSP(F, float, WS_CKS) + ((size_t)l * BS + q.b) * NCMP_S * 64 : WSP(F, float, WS_CKP) + (size_t)q.b * NCMP_P * 64) + (size_t)key * 64;
            vr = (q.samp ? WSP(F, float, WS_CVS) + ((size_t)l * BS + q.b) * NCMP_S * 64 : WSP(F, float, WS_CVP) + (size_t)q.b * NCMP_P * 64) + (size_t)key * 64; }
    } else if (kind == KIND_SLC) {
        if (key < q.pos0 + q.T) {
            if (!q.samp) kr = F.out + O_KVP + ((size_t)l * NP + q.row0 + key) * 256 + 2 * 64;
            else if (key < PAST) kr = INP(F, I_CACHE) + ((((size_t)l * NPHYS + pg) * PAGE + (key & 127)) * 4 + 2) * 64;
            else kr = F.out + O_KVS + ((size_t)l * NS + (q.row0 - NP) + (key - PAST)) * 256 + 2 * 64;
            vr = kr + 64; }
    } else {
        if (key < q.pos0 + q.T) {
            if (!q.samp) kr = WSP(F, float, WS_KWIN) + (size_t)(q.row0 + key) * 128;
            else if (key >= PAST) kr = WSP(F, float, WS_KWIN) + (size_t)(q.row0 + key - PAST) * 128;
            else if (key >= PAST - 512) kr = INP(F, I_SWIN) + (((size_t)l * BS + q.b) * 512 + (key - (PAST - 512))) * 128;
            if (kr) vr = kr + 64; }
    }
    const f32x4 z = (f32x4){0.f, 0.f, 0.f, 0.f};
    if (kr) { R.k0 = *(const f32x4*)(kr + dc * 8); R.k1 = *(const f32x4*)(kr + dc * 8 + 4); R.v0 = *(const f32x4*)(vr + dc * 8); R.v1 = *(const f32x4*)(vr + dc * 8 + 4); }
    else { R.k0 = z; R.k1 = z; R.v0 = z; R.v1 = z; }
}
__device__ __forceinline__ void tile_store(const Frame& F, LAS unsigned char* kb, LAS unsigned char* vb, const TileRegs& R) {
    int t_ = F.tid; asm volatile("" : "+v"(t_));
    const int key = t_ >> 3, dc = t_ & 7;
    v4u kk; kk.x = cvtpk(R.k0.x, R.k0.y); kk.y = cvtpk(R.k0.z, R.k0.w); kk.z = cvtpk(R.k1.x, R.k1.y); kk.w = cvtpk(R.k1.z, R.k1.w);
    *(LAS v4u*)(kb + key * 128 + ((dc ^ (key & 7)) << 4)) = kk;
    const float vv[8] = {R.v0.x, R.v0.y, R.v0.z, R.v0.w, R.v1.x, R.v1.y, R.v1.z, R.v1.w};
#pragma unroll
    for (int i = 0; i < 8; ++i) { const int d = dc * 8 + i; const int ch = (key >> 2) ^ ((d >> 1) & 15);
        *(LAS unsigned short*)(vb + d * 128 + ch * 8 + (key & 3) * 2) = (unsigned short)f2bf(vv[i]); }
}
__device__ __forceinline__ void qk_tile(const LAS unsigned char* kb, const bf16x8 (&qf)[4], f32x16& s0, f32x16& s1, int lane, float init = 0.f) {
    const int r = lane & 31, h = lane >> 5;
#pragma unroll
    for (int i = 0; i < 16; ++i) { s0[i] = init; s1[i] = init; }
#pragma unroll
    for (int ks = 0; ks < 4; ++ks) {
        const bf16x8 a0 = *(const LAS bf16x8*)(kb + r * 128 + (((2 * ks + h) ^ (r & 7)) << 4));
        const bf16x8 a1 = *(const LAS bf16x8*)(kb + (32 + r) * 128 + (((2 * ks + h) ^ (r & 7)) << 4));
        s0 = __builtin_amdgcn_mfma_f32_32x32x16_bf16(a0, qf[ks], s0, 0, 0, 0);
        s1 = __builtin_amdgcn_mfma_f32_32x32x16_bf16(a1, qf[ks], s1, 0, 0, 0);
    }
}
__device__ __forceinline__ void mask_tile(f32x16& s0, f32x16& s1, int kbase, int lo, int hi) {
#pragma unroll
    for (int i = 0; i < 16; ++i) { const int k = kbase + (i & 3) + 8 * (i >> 2);
        if (k < lo || k > hi) s0[i] = -INFINITY;
        if (k + 32 < lo || k + 32 > hi) s1[i] = -INFINITY; }
}
__device__ __forceinline__ float max3_(float x, float y, float z) { float r; asm("v_max3_f32 %0, %1, %2, %3" : "=v"(r) : "v"(x), "v"(y), "v"(z)); return r; }
__device__ __forceinline__ float tile_max(const f32x16& s0, const f32x16& s1) {
    float a = max3_(s0[0], s0[1], s0[2]), b = max3_(s1[0], s1[1], s1[2]);
#pragma unroll
    for (int i = 3; i < 15; i += 2) { a = max3_(a, s0[i], s0[i + 1]); b = max3_(b, s1[i], s1[i + 1]); }
    return half_max(max3_(a, b, fmaxf(s0[15], s1[15])));
}
__device__ __forceinline__ void pv_tile(const LAS unsigned char* vb, const f32x16& s0, const f32x16& s1, f32x16 (&O)[2], int lane) {
    const int r = lane & 31, h = lane >> 5;
    bf16x8 pf[2][2];
#pragma unroll
    for (int sp = 0; sp < 2; ++sp) {
        v4u a; a.x = cvtpk(s0[8 * sp + 0], s0[8 * sp + 1]); a.y = cvtpk(s0[8 * sp + 2], s0[8 * sp + 3]); a.z = cvtpk(s0[8 * sp + 4], s0[8 * sp + 5]); a.w = cvtpk(s0[8 * sp + 6], s0[8 * sp + 7]);
        v4u b; b.x = cvtpk(s1[8 * sp + 0], s1[8 * sp + 1]); b.y = cvtpk(s1[8 * sp + 2], s1[8 * sp + 3]); b.z = cvtpk(s1[8 * sp + 4], s1[8 * sp + 5]); b.w = cvtpk(s1[8 * sp + 6], s1[8 * sp + 7]);
        pf[0][sp] = __builtin_bit_cast(bf16x8, a); pf[1][sp] = __builtin_bit_cast(bf16x8, b);
    }
#pragma unroll
    for (int dh = 0; dh < 2; ++dh) {
        const int d = dh * 32 + r, sw = (d >> 1) & 15; const LAS unsigned char* rb = vb + d * 128;
#pragma unroll
        for (int kh = 0; kh < 2; ++kh)
#pragma unroll
            for (int sp = 0; sp < 2; ++sp) {
                const int q0 = kh * 8 + 4 * sp + h;
                const unsigned long long lo8 = *(const LAS unsigned long long*)(rb + ((q0 ^ sw) << 3));
                const unsigned long long hi8 = *(const LAS unsigned long long*)(rb + (((q0 + 2) ^ sw) << 3));
                v4u av; av.x = (unsigned)lo8; av.y = (unsigned)(lo8 >> 32); av.z = (unsigned)hi8; av.w = (unsigned)(hi8 >> 32);
                O[dh] = __builtin_amdgcn_mfma_f32_32x32x16_bf16(__builtin_bit_cast(bf16x8, av), pf[kh][sp], O[dh], 0, 0, 0);
            }
        __builtin_amdgcn_sched_barrier(0);
    }
}

__device__ __forceinline__ void attn_unit(const Frame& F, int l, int s, int t0, int ntok) {
    const Seq q = seq_of(s);
    int lane_ = F.lane; asm volatile("" : "+v"(lane_));
    int wave_ = F.wave; asm volatile("" : "+s"(wave_));
    const int lane = lane_, wave = wave_, tid = wave * 64 + lane, h = lane >> 5;
    LAS unsigned char* lds = F.lds;
    LAS float* impG = (LAS float*)(lds + AT_IMPG); LAS float* impE = (LAS float*)(lds + AT_IMPE);
    LAS unsigned* selw = (LAS unsigned*)(lds + AT_SEL);
    LAS unsigned* uni = (LAS unsigned*)(lds + AT_UNI);
    LAS int* list = (LAS int*)(lds + AT_LIST);
    LAS int* nlist = (LAS int*)(lds + AT_NLIST);
    LAS int* lpage = (LAS int*)(lds + AT_PAGE);
    LAS float* rankv = (LAS float*)(lds + AT_RANK + wave * 1024);
    const int nslc = q.samp ? 129 : 32, njs = q.samp ? 128 : 32;
    const int ncmp = q.samp ? NCMP_S : NCMP_P;
    const int tl = wave * 8 + ((lane & 31) >> 2), head = lane & 3;
    const bool vcol = tl < ntok; const bool wact = (wave * 8) < ntok;
    const int tlc = vcol ? tl : 0;
    const int r = q.row0 + t0 + tlc, tpos = q.pos0 + t0 + tlc;
    int nvis = 0; if (vcol && tpos >= 31) { nvis = (tpos - 31) / 16 + 1; if (nvis > ncmp) nvis = ncmp; }
    const int tpos_last = q.pos0 + t0 + ntok - 1;
    int nvis_max = 0; if (tpos_last >= 31) { nvis_max = (tpos_last - 31) / 16 + 1; if (nvis_max > ncmp) nvis_max = ncmp; }
    const int nct = (nvis_max + 63) >> 6;
    bf16x8 qf[4];
    { const bf16* qb = WSP(F, bf16, WS_QB) + ((size_t)r * 4 + head) * 64;
#pragma unroll
      for (int ks = 0; ks < 4; ++ks) qf[ks] = *(const bf16x8*)(qb + 16 * ks + 8 * h); }
    const float* gp = WSP(F, float, WS_PROJ) + (size_t)r * IN_WP + OFF_G + head * 3;
    const float g0 = sigmoidf_(gp[0]), g1 = sigmoidf_(gp[1]), g2 = sigmoidf_(gp[2]);
#define GATE(k) sigmoidf_((WSP(F, float, WS_PROJ) + (size_t)r * IN_WP + OFF_G + head * 3)[(k)])
    f32x16 O[2];
    LAS float* outl = (LAS float*)(lds + AT_OUT + wave * 8192) + lane;
#pragma unroll
    for (int i = 0; i < 16; ++i) { O[0][i] = 0.f; O[1][i] = 0.f; }
    float m = -1e30f, lsum = 0.f, rinv = 0.f;

    __syncthreads();
    if (tid < 2 * nct) list[tid] = (tid < nct ? KIND_CMP1 : KIND_CMP2) | ((tid < nct ? tid : tid - nct) << 4);
    for (int i = tid; i < 64 * 8; i += NTHR) selw[i] = 0u;
    __syncthreads();
    {
        const int n = 2 * nct; TileRegs R;
        if (n > 0) tile_load(F, l, q, KIND_CMP1, 0, 0, R);
        for (int i = 0; i < n; ++i) {
            LAS unsigned char* kb = lds + AT_K + (i & 1) * 8192; LAS unsigned char* vb = lds + AT_V + (i & 1) * 8192;
            tile_store(F, kb, vb, R);
            const int e = __builtin_amdgcn_readfirstlane(list[i]); const int kind = e & 15, tile = e >> 4;
            if (i + 1 < n) { const int e2 = __builtin_amdgcn_readfirstlane(list[i + 1]); tile_load(F, l, q, e2 & 15, e2 >> 4, 0, R); }
            __syncthreads();
            if (wact) {
                if (i == nct) { const float L = half_sum(lsum); rinv = L > 0.f ? 1.f / L : 0.f; }
                f32x16 s0, s1; qk_tile(kb, qf, s0, s1, lane);
                mask_tile(s0, s1, tile * 64 + 4 * h, 0, nvis - 1);
                if (kind == KIND_CMP1) {
                    const float mt = tile_max(s0, s1); const float mn = fmaxf(m, mt); const float al = __builtin_amdgcn_exp2f(m - mn);
                    float rs = 0.f;
#pragma unroll
                    for (int k = 0; k < 16; ++k) rs += __builtin_amdgcn_exp2f(s0[k] - mn) + __builtin_amdgcn_exp2f(s1[k] - mn);
                    lsum = lsum * al + rs; m = mn;
                } else {
#pragma unroll
                    for (int k = 0; k < 16; ++k) { s0[k] = __builtin_amdgcn_exp2f(s0[k] - m) * rinv; s1[k] = __builtin_amdgcn_exp2f(s1[k] - m) * rinv; }
                    pv_tile(vb, s0, s1, O, lane);
#pragma unroll
                    for (int kh = 0; kh < 2; ++kh)
#pragma unroll
                        for (int gq = 0; gq < 4; ++gq) {
                            const f32x16& sv = kh ? s1 : s0;
                            float G = (sv[4 * gq] + sv[4 * gq + 1]) + (sv[4 * gq + 2] + sv[4 * gq + 3]), E = sv[4 * gq + 3];
                            G += __shfl_xor(G, 1); G += __shfl_xor(G, 2); E += __shfl_xor(E, 1); E += __shfl_xor(E, 2);
                            const int j = 16 * tile + 8 * kh + 2 * gq + h;
                            if (head == 0 && vcol && j < njs) { impG[tl * njs + j] = G; impE[tl * njs + j] = E; }
                        }
                }
            }
        }
    }
    const float g0v = GATE(0);
#pragma unroll
    for (int i = 0; i < 16; ++i) { outl[i * 64] = O[0][i] * g0v; outl[(16 + i) * 64] = O[1][i] * g0v; O[0][i] = 0.f; O[1][i] = 0.f; }
    m = 0.f; lsum = 0.f;
    bool started = false;
    asm volatile("s_waitcnt lgkmcnt(0)" ::: "memory");
    if (wact) {
        const int ntw = (ntok - wave * 8 < 8) ? ntok - wave * 8 : 8;
        for (int tt = 0; tt < ntw; ++tt) {
            const int tk = wave * 8 + tt; const int tp = q.pos0 + t0 + tk; const int cur = tp >> 6;
            int nv = 0; if (tp >= 31) { nv = (tp - 31) / 16 + 1; if (nv > ncmp) nv = ncmp; }
            const int jcov = (nv + 3) >> 2;
            for (int j = lane; j < nslc; j += 64) {
                float v;
                if (j > cur) v = -INFINITY;
                else if (j == 0 || j == cur || j == cur - 1) v = INFINITY;
                else { v = 0.f; if (j < jcov) v += impG[tk * njs + j]; if (j - 1 < jcov) v += impE[tk * njs + j - 1]; }
                rankv[j] = v;
            }
            asm volatile("s_waitcnt lgkmcnt(0)" ::: "memory");
            for (int j0 = 0; j0 < nslc; j0 += 64) {
                const int j = j0 + lane; bool selj = false;
                if (j < nslc) { const float vj = rankv[j]; int rank = 0;
                    for (int k = 0; k < nslc; ++k) { const float vk = rankv[k]; rank += (vk > vj || (vk == vj && k < j)) ? 1 : 0; }
                    selj = (rank < 16) && (j <= cur); }
                const unsigned long long bal = __ballot(selj);
                if (lane == 0) { selw[tk * 8 + (j0 >> 5)] = (unsigned)bal; selw[tk * 8 + (j0 >> 5) + 1] = (unsigned)(bal >> 32); }
            }
            asm volatile("s_waitcnt lgkmcnt(0)" ::: "memory");
        }
    }
    __syncthreads();
    if (tid < 8) { unsigned u = 0u; for (int k = 0; k < ntok; ++k) u |= selw[k * 8 + tid]; uni[tid] = u; }
    __syncthreads();
    if (wave == 0) {
        int n = 0;
        for (int j0 = 0; j0 < nslc; j0 += 64) {
            const int j = j0 + lane; const bool sj = (j < nslc) && ((uni[j >> 5] >> (j & 31)) & 1u);
            int pg = 0; if (sj && q.samp && j * 64 < PAST) pg = ((const int*)INP(F, I_PT))[q.b * NPAGES + (j >> 1)];
            const unsigned long long bal = __ballot(sj);
            if (sj) { const int idx = n + __popcll(bal & ((1ull << lane) - 1ull)); list[idx] = KIND_SLC | (j << 4); lpage[idx] = pg; }
            n += __popcll(bal);
        }
        const int p0 = q.pos0 + t0; int w0 = (p0 - 511) >> 6; if (w0 < 0) w0 = 0; if (q.samp && w0 < (PAST - 512) / 64) w0 = (PAST - 512) / 64;
        const int w1 = (p0 + ntok - 1) >> 6;
        if (lane <= w1 - w0) { list[n + lane] = KIND_WIN | ((w0 + lane) << 4); lpage[n + lane] = 0; }
        if (lane == 0) nlist[0] = n + (w1 - w0 + 1);
    }
    __syncthreads();
    {
        const int n = nlist[0]; TileRegs R0, R1; int pkind = KIND_SLC;
        { const int e0 = __builtin_amdgcn_readfirstlane(list[0]); tile_load(F, l, q, e0 & 15, e0 >> 4, __builtin_amdgcn_readfirstlane(lpage[0]), R0); }
        if (n > 1) { const int e1 = __builtin_amdgcn_readfirstlane(list[1]); tile_load(F, l, q, e1 & 15, e1 >> 4, __builtin_amdgcn_readfirstlane(lpage[1]), R1); }
#define ATTN_STEP(RR, BI, II) do { \
            LAS unsigned char* kb = lds + AT_K + (BI) * 8192; LAS unsigned char* vb = lds + AT_V + (BI) * 8192; \
            tile_store(F, kb, vb, RR); \
            const int e = __builtin_amdgcn_readfirstlane(list[(II)]); const int kind = e & 15, tile = e >> 4; \
            if ((II) + 2 < n) { const int e2 = __builtin_amdgcn_readfirstlane(list[(II) + 2]); tile_load(F, l, q, e2 & 15, e2 >> 4, __builtin_amdgcn_readfirstlane(lpage[(II) + 2]), RR); } \
            __syncthreads(); \
            if (wact) { \
                if (kind != pkind) { \
                    const float L = half_sum(lsum); const float sc = L > 0.f ? GATE(1) / L : 0.f; \
                    _Pragma("unroll") for (int k = 0; k < 16; ++k) { outl[k * 64] += O[0][k] * sc; outl[(16 + k) * 64] += O[1][k] * sc; O[0][k] = 0.f; O[1][k] = 0.f; } \
                    m = 0.f; lsum = 0.f; started = false; pkind = kind; \
                } \
                int lo, hi; \
                if (kind == KIND_SLC) { const bool sb = (selw[tlc * 8 + (tile >> 5)] >> (tile & 31)) & 1u; lo = 0; hi = (sb && vcol) ? tpos : -1; } \
                else { lo = tpos - 511; hi = vcol ? tpos : -1; } \
                const bool any = (hi >= tile * 64) && (lo <= tile * 64 + 63); \
                if (__ballot(any) != 0ull) { \
                      \
                      \
                    const bool part = any && !((lo <= tile * 64) && (hi >= tile * 64 + 63)); \
                      \
                      \
                    f32x16 s0, s1; qk_tile(kb, qf, s0, s1, lane, any ? -m : -INFINITY); \
                    if (__ballot(part) != 0ull) mask_tile(s0, s1, tile * 64 + 4 * h, lo, hi); \
                    const float mt = tile_max(s0, s1); \
                    const bool seen = mt > -INFINITY; const bool need = (mt > 8.f) || (seen && !started); started = started || seen; \
                    if (__ballot(need) != 0ull) { \
                        const float dl = need ? mt : 0.f; const float al = __builtin_amdgcn_exp2f(-dl); m += dl; lsum *= al; \
                        _Pragma("unroll") for (int k = 0; k < 16; ++k) { s0[k] -= dl; s1[k] -= dl; O[0][k] *= al; O[1][k] *= al; } } \
                    float rs = 0.f; \
                    _Pragma("unroll") for (int k = 0; k < 16; ++k) { s0[k] = __builtin_amdgcn_exp2f(s0[k]); s1[k] = __builtin_amdgcn_exp2f(s1[k]); rs += s0[k] + s1[k]; } \
                    lsum += rs; \
                    pv_tile(vb, s0, s1, O, lane); \
                } \
            } } while (0)
        for (int i = 0; i < n; i += 2) {
            ATTN_STEP(R0, 0, i);
            if (i + 1 < n) ATTN_STEP(R1, 1, i + 1);
        }
#undef ATTN_STEP
        if (wact) {
            const float L = half_sum(lsum); const float sc = L > 0.f ? (pkind == KIND_SLC ? GATE(1) : GATE(2)) / L : 0.f;
#pragma unroll
            for (int k = 0; k < 16; ++k) { O[0][k] = outl[k * 64] + O[0][k] * sc; O[1][k] = outl[(16 + k) * 64] + O[1][k] * sc; }
        }
    }
    if (vcol) {
        bf16* mo = WSP(F, bf16, WS_MIX) + (size_t)r * DM + 768 + head * 64;
#pragma unroll
        for (int dh = 0; dh < 2; ++dh)
#pragma unroll
            for (int gq = 0; gq < 4; ++gq) {
                const int d = dh * 32 + 8 * gq + 4 * h;
                *(unsigned long long*)(mo + d) = (unsigned long long)cvtpk(O[dh][4 * gq], O[dh][4 * gq + 1]) | ((unsigned long long)cvtpk(O[dh][4 * gq + 2], O[dh][4 * gq + 3]) << 32);
            }
    }
}

#undef GATE
constexpr int SW_T = 0, SW_ML = 65536, SW_IMPG = SW_ML + 4096, SW_IMPE = SW_IMPG + 4096, SW_SEL = SW_IMPE + 4096, SW_UNI = SW_SEL + 256, SW_LIST = SW_UNI + 64,
              SW_PAGE = SW_LIST + 1280, SW_NL = SW_PAGE + 1280, SW_RANK = SW_NL + 64, SW_OUT = SW_RANK + 8 * 1024, SW_END = SW_OUT + 8192;
static_assert(SW_END <= RING_BYTES, "sample attention LDS map");
struct HRegs { f32x4 v[8]; };
__device__ __forceinline__ void h_load(const Frame& F, int l, int b, int kind, int ht, int pg, int which, int lane_in, HRegs& R) {
    int lane = lane_in; asm volatile("" : "+v"(lane));
    const int key = ht * 32 + (lane >> 1), hv = lane & 1;
    const float* base; size_t off; bool ok;
    if (kind <= KIND_CMP2) { ok = key < NCMP_S; const int kc = ok ? key : 0;
        base = WSP(F, float, which ? WS_CVS : WS_CKS); off = (((size_t)l * BS + b) * NCMP_S + kc) * 64; }
    else if (kind == KIND_SLC) { ok = key < PAST + TS;
        if (key < PAST) { base = INP(F, I_CACHE); off = ((((size_t)l * NPHYS + pg) * PAGE + (key & 127)) * 4 + 2 + which) * 64; }
        else { const int kk = ok ? key - PAST : 0; base = F.out + O_KVS; off = ((size_t)l * NS + b * TS + kk) * 256 + (2 + which) * 64; } }
    else { ok = (key >= PAST - 512) && (key < PAST + TS);
        if (key < PAST) { const int kk = ok ? key - (PAST - 512) : 0; base = INP(F, I_SWIN); off = (((size_t)l * BS + b) * 512 + kk) * 128 + which * 64; }
        else { const int kk = ok ? key - PAST : 0; base = WSP(F, float, WS_KWIN); off = ((size_t)NP + b * TS + kk) * 128 + which * 64; } }
    const float* p = base + off + hv * 32;
#pragma unroll
    for (int i = 0; i < 8; ++i) { const f32x4 x = *(const f32x4*)(p + 4 * i); R.v[i] = ok ? x : (f32x4){0.f, 0.f, 0.f, 0.f}; }
}
__device__ __forceinline__ void h_store_k(LAS unsigned char* kb, const HRegs& R, int lane_in) {
    int lane = lane_in; asm volatile("" : "+v"(lane));
    const int key = lane >> 1, hv = lane & 1;
#pragma unroll
    for (int i = 0; i < 4; ++i) { v4u o; o.x = cvtpk(R.v[2 * i].x, R.v[2 * i].y); o.y = cvtpk(R.v[2 * i].z, R.v[2 * i].w); o.z = cvtpk(R.v[2 * i + 1].x, R.v[2 * i + 1].y); o.w = cvtpk(R.v[2 * i + 1].z, R.v[2 * i + 1].w);
        *(LAS v4u*)(kb + key * 128 + (((4 * hv + i) ^ (key & 7)) << 4)) = o; }
}
__device__ __forceinline__ void h_store_v(LAS unsigned char* vb, const HRegs& R, int lane_in) {
    int lane = lane_in; asm volatile("" : "+v"(lane));
    const int key = lane >> 1, hv = lane & 1;
#pragma unroll
    for (int i = 0; i < 8; ++i) {
        const float xs[4] = {R.v[i].x, R.v[i].y, R.v[i].z, R.v[i].w};
#pragma unroll
        for (int k = 0; k < 4; ++k) { const int d = 32 * hv + 4 * i + k;
            *(LAS unsigned short*)(vb + d * 64 + (((key >> 2) ^ ((d >> 2) & 7)) << 3) + (key & 3) * 2) = (unsigned short)f2bf(xs[k]); }
    }
}
__device__ __forceinline__ void qk_half(const LAS unsigned char* kb, const bf16x8 (&qf)[4], f32x16& s0, int lane_in) {
    int lane = lane_in; asm volatile("" : "+v"(lane));
    const int r = lane & 31, h = lane >> 5;
#pragma unroll
    for (int i = 0; i < 16; ++i) s0[i] = 0.f;
#pragma unroll
    for (int ks = 0; ks < 4; ++ks) { const bf16x8 a0 = *(const LAS bf16x8*)(kb + r * 128 + (((2 * ks + h) ^ (r & 7)) << 4));
        s0 = __builtin_amdgcn_mfma_f32_32x32x16_bf16(a0, qf[ks], s0, 0, 0, 0); }
}
__device__ __forceinline__ void pv_half(const LAS unsigned char* vb, const f32x16& s0, f32x16 (&O)[2], int lane_in) {
    int lane = lane_in; asm volatile("" : "+v"(lane));
    const int r = lane & 31, h = lane >> 5;
    bf16x8 pf[2];
#pragma unroll
    for (int sp = 0; sp < 2; ++sp) { v4u a; a.x = cvtpk(s0[8 * sp + 0], s0[8 * sp + 1]); a.y = cvtpk(s0[8 * sp + 2], s0[8 * sp + 3]); a.z = cvtpk(s0[8 * sp + 4], s0[8 * sp + 5]); a.w = cvtpk(s0[8 * sp + 6], s0[8 * sp + 7]);
        pf[sp] = __builtin_bit_cast(bf16x8, a); }
#pragma unroll
    for (int dh = 0; dh < 2; ++dh) { const int d = dh * 32 + r, sw = (d >> 2) & 7; const LAS unsigned char* rb = vb + d * 64;
#pragma unroll
        for (int sp = 0; sp < 2; ++sp) { const int q0 = 4 * sp + h;
            const unsigned long long lo8 = *(const LAS unsigned long long*)(rb + ((q0 ^ sw) << 3)), hi8 = *(const LAS unsigned long long*)(rb + (((q0 + 2) ^ sw) << 3));
            v4u av; av.x = (unsigned)lo8; av.y = (unsigned)(lo8 >> 32); av.z = (unsigned)hi8; av.w = (unsigned)(hi8 >> 32);
            O[dh] = __builtin_amdgcn_mfma_f32_32x32x16_bf16(__builtin_bit_cast(bf16x8, av), pf[sp], O[dh], 0, 0, 0); } }
}
__device__ __forceinline__ void mask_half(f32x16& s0, int kbase, int lo, int hi) {
#pragma unroll
    for (int i = 0; i < 16; ++i) { const int k = kbase + (i & 3) + 8 * (i >> 2); if (k < lo || k > hi) s0[i] = -INFINITY; }
}
__device__ __forceinline__ float max16(const f32x16& s0) {
    float a = s0[0];
#pragma unroll
    for (int i = 1; i < 16; ++i) a = fmaxf(a, s0[i]);
    return half_max(a);
}
__device__ __forceinline__ void merge_branch(LAS unsigned char* lds, int wave, int lane, float m, float lsum, f32x16 (&O)[2], float gate) {
    LAS float* ml = (LAS float*)(lds + SW_ML); LAS float* outl = (LAS float*)(lds + SW_OUT) + lane;
    LAS float* slot = (LAS float*)(lds + SW_T + wave * 8192) + lane;
    const float lw = half_sum(lsum);
    ml[wave * 64 + lane] = m; ml[512 + wave * 64 + lane] = lw;
#pragma unroll
    for (int i = 0; i < 16; ++i) { slot[i * 64] = O[0][i]; slot[(16 + i) * 64] = O[1][i]; O[0][i] = 0.f; O[1][i] = 0.f; }
    __syncthreads();
    float M = -1e30f;
#pragma unroll
    for (int w = 0; w < 8; ++w) M = fmaxf(M, ml[w * 64 + lane]);
    float L = 0.f, sc[8];
#pragma unroll
    for (int w = 0; w < 8; ++w) { sc[w] = __builtin_amdgcn_exp2f(ml[w * 64 + lane] - M); L += ml[512 + w * 64 + lane] * sc[w]; }
    const float gl = (L > 0.f) ? gate / L : 0.f;
#pragma unroll
    for (int k = 0; k < 4; ++k) { const int i = wave * 4 + k; float a = 0.f;
#pragma unroll
        for (int w = 0; w < 8; ++w) a += ((LAS float*)(lds + SW_T + w * 8192))[i * 64 + lane] * sc[w];
        outl[i * 64] += a * gl; }
    __syncthreads();
}

__device__ __forceinline__ void attn_sample_unit(const Frame& F, int l, int b, int t0) {
    int lane_ = F.lane; asm volatile("" : "+v"(lane_));
    const int lane = lane_, wave = F.wave, tid = wave * 64 + lane, h = lane >> 5;
    LAS unsigned char* lds = F.lds;
    LAS unsigned char* kb = lds + SW_T + wave * 8192; LAS unsigned char* vb = kb + 4096;
    LAS float* impG = (LAS float*)(lds + SW_IMPG); LAS float* impE = (LAS float*)(lds + SW_IMPE);
    LAS unsigned* selw = (LAS unsigned*)(lds + SW_SEL); LAS unsigned* uni = (LAS unsigned*)(lds + SW_UNI);
    LAS int* list = (LAS int*)(lds + SW_LIST); LAS int* lpage = (LAS int*)(lds + SW_PAGE); LAS int* nlist = (LAS int*)(lds + SW_NL);
    LAS float* rankv = (LAS float*)(lds + SW_RANK + wave * 1024);
    LAS float* outl = (LAS float*)(lds + SW_OUT);
    const int tl = 0, head = lane & 3; const bool wcol = ((lane & 31) >> 2) == 0;
    const int r = NP + b * TS + t0, tpos = PAST + t0;
    bf16x8 qf[4];
    { const bf16* qb = WSP(F, bf16, WS_QB) + ((size_t)r * 4 + head) * 64;
#pragma unroll
      for (int ks = 0; ks < 4; ++ks) qf[ks] = *(const bf16x8*)(qb + 16 * ks + 8 * h); }
    const float* gp = WSP(F, float, WS_PROJ) + (size_t)r * IN_WP + OFF_G + head * 3;
    const float g0 = sigmoidf_(gp[0]), g1 = sigmoidf_(gp[1]), g2 = sigmoidf_(gp[2]);
    f32x16 O[2];
#pragma unroll
    for (int i = 0; i < 16; ++i) { O[0][i] = 0.f; O[1][i] = 0.f; }
    __syncthreads();
    if (tid < 64) selw[tid] = 0u;
    f32x16 sa, sb; float m = -1e30f, lsum = 0.f;
    {
        HRegs Ra, Rb; h_load(F, l, b, KIND_CMP1, wave, 0, 0, lane, Ra); h_load(F, l, b, KIND_CMP1, wave + 8, 0, 0, lane, Rb);
        h_store_k(kb, Ra, lane); asm volatile("s_waitcnt lgkmcnt(0)" ::: "memory");
        qk_half(kb, qf, sa, lane); mask_half(sa, wave * 32 + 4 * h, 0, NCMP_S - 1);
        asm volatile("s_waitcnt lgkmcnt(0)" ::: "memory");
        h_store_k(kb, Rb, lane); asm volatile("s_waitcnt lgkmcnt(0)" ::: "memory");
        qk_half(kb, qf, sb, lane); mask_half(sb, (wave + 8) * 32 + 4 * h, 0, NCMP_S - 1);
        m = fmaxf(max16(sa), max16(sb));
#pragma unroll
        for (int k = 0; k < 16; ++k) lsum += __builtin_amdgcn_exp2f(sa[k] - m) + __builtin_amdgcn_exp2f(sb[k] - m);
    }
    {
        LAS float* ml = (LAS float*)(lds + SW_ML);
        const float lw = half_sum(lsum);
        ml[wave * 64 + lane] = m; ml[512 + wave * 64 + lane] = lw;
        HRegs Ra, Rb; h_load(F, l, b, KIND_CMP2, wave, 0, 1, lane, Ra); h_load(F, l, b, KIND_CMP2, wave + 8, 0, 1, lane, Rb);
        __syncthreads();
        float M = -1e30f;
#pragma unroll
        for (int w = 0; w < 8; ++w) M = fmaxf(M, ml[w * 64 + lane]);
        float L = 0.f;
#pragma unroll
        for (int w = 0; w < 8; ++w) L += ml[512 + w * 64 + lane] * __builtin_amdgcn_exp2f(ml[w * 64 + lane] - M);
        const float rinv = L > 0.f ? 1.f / L : 0.f;
#pragma unroll
        for (int pass = 0; pass < 2; ++pass) {
            f32x16& sv = pass ? sb : sa; const int ht = pass ? wave + 8 : wave;
#pragma unroll
            for (int k = 0; k < 16; ++k) sv[k] = __builtin_amdgcn_exp2f(sv[k] - M) * rinv;
            if (pass) h_store_v(vb, Rb, lane); else h_store_v(vb, Ra, lane);
            asm volatile("s_waitcnt lgkmcnt(0)" ::: "memory");
            pv_half(vb, sv, O, lane);
            asm volatile("s_waitcnt lgkmcnt(0)" ::: "memory");
#pragma unroll
            for (int gq = 0; gq < 4; ++gq) {
                float G = (sv[4 * gq] + sv[4 * gq + 1]) + (sv[4 * gq + 2] + sv[4 * gq + 3]), E = sv[4 * gq + 3];
                G += __shfl_xor(G, 1); G += __shfl_xor(G, 2); E += __shfl_xor(E, 1); E += __shfl_xor(E, 2);
                const int j = 8 * ht + 2 * gq + h;
                if (head == 0) { impG[tl * 128 + j] = G; impE[tl * 128 + j] = E; }
            }
        }
        { LAS float* slot = (LAS float*)(lds + SW_T + wave * 8192) + lane;
#pragma unroll
          for (int i = 0; i < 16; ++i) { slot[i * 64] = O[0][i]; slot[(16 + i) * 64] = O[1][i]; O[0][i] = 0.f; O[1][i] = 0.f; } }
    }
    __syncthreads();
#pragma unroll
    for (int k = 0; k < 4; ++k) { const int i = wave * 4 + k; float a = 0.f;
#pragma unroll
        for (int w = 0; w < 8; ++w) a += ((LAS float*)(lds + SW_T + w * 8192))[i * 64 + lane];
        outl[i * 64 + lane] = a * g0; }
    __syncthreads();
    if (wave == 0) {
        const int tk = 0, cur = tpos >> 6;
        for (int j = lane; j < 132; j += 64) {
            float v;
            if (j > cur) v = -INFINITY;
            else if (j == 0 || j == cur || j == cur - 1) v = INFINITY;
            else v = impG[tk * 128 + j] + impE[tk * 128 + j - 1];
            rankv[j] = v;
        }
        asm volatile("s_waitcnt lgkmcnt(0)" ::: "memory");
        const float v0 = rankv[lane], v1 = rankv[64 + lane], v2 = (lane < 1) ? rankv[128 + lane] : -INFINITY;
        int r0 = 0, r1 = 0, r2 = 0;
        for (int k4 = 0; k4 < 132; k4 += 4) {
            const f32x4 vk = *(const LAS f32x4*)(rankv + k4);
#pragma unroll
            for (int u = 0; u < 4; ++u) { const float x = vk[u]; const int k = k4 + u;
                r0 += (x > v0 || (x == v0 && k < lane)) ? 1 : 0; r1 += (x > v1 || (x == v1 && k < 64 + lane)) ? 1 : 0; r2 += (x > v2 || (x == v2 && k < 128 + lane)) ? 1 : 0; }
        }
        const unsigned long long b0 = __ballot(r0 < 16 && lane <= cur), b1 = __ballot(r1 < 16 && 64 + lane <= cur), b2 = __ballot(lane < 1 && r2 < 16 && 128 + lane <= cur);
        if (lane == 0) { selw[tk * 8 + 0] = (unsigned)b0; selw[tk * 8 + 1] = (unsigned)(b0 >> 32); selw[tk * 8 + 2] = (unsigned)b1; selw[tk * 8 + 3] = (unsigned)(b1 >> 32); selw[tk * 8 + 4] = (unsigned)b2; }
    }
    __syncthreads();
    if (tid < 8) uni[tid] = selw[tid];
    __syncthreads();
    if (wave == 0) {
        int n = 0;
        for (int j0 = 0; j0 < 129; j0 += 64) {
            const int j = j0 + lane; const bool sj = (j < 129) && ((uni[j >> 5] >> (j & 31)) & 1u);
            int pg = 0; if (sj && j * 64 < PAST) pg = ((const int*)INP(F, I_PT))[b * NPAGES + (j >> 1)];
            const unsigned long long bal = __ballot(sj);
            if (sj) { const int idx = n + 2 * __popcll(bal & ((1ull << lane) - 1ull)); list[idx] = KIND_SLC | ((2 * j) << 4); list[idx + 1] = KIND_SLC | ((2 * j + 1) << 4); lpage[idx] = pg; lpage[idx + 1] = pg; }
            n += 2 * __popcll(bal);
        }
        if (lane == 0) nlist[0] = n;
        const int w0 = (PAST - 512) / 32, w1 = (PAST + TS - 1) / 32;
        if (lane <= w1 - w0) { list[n + lane] = KIND_WIN | ((w0 + lane) << 4); lpage[n + lane] = 0; }
        if (lane == 0) nlist[1] = n + (w1 - w0 + 1);
    }
    __syncthreads();
    const int n_slc = nlist[0], n_all = nlist[1];
#pragma unroll 1
    for (int br = 0; br < 2; ++br) {
        const int i0 = br ? n_slc : 0, i1 = br ? n_all : n_slc;
        m = -1e30f; lsum = 0.f;
        HRegs Rk, Rv;
        int it = i0 + wave;
        if (it < i1) { const int e = list[it], pg = lpage[it]; h_load(F, l, b, e & 15, e >> 4, pg, 0, lane, Rk); h_load(F, l, b, e & 15, e >> 4, pg, 1, lane, Rv); }
#pragma unroll 1
        for (; it < i1; it += 8) {
            const int e = __builtin_amdgcn_readfirstlane(list[it]); const int kind = e & 15, ht = e >> 4;
            h_store_k(kb, Rk, lane); h_store_v(vb, Rv, lane);
            if (it + 8 < i1) { const int e2 = list[it + 8], pg2 = lpage[it + 8]; h_load(F, l, b, e2 & 15, e2 >> 4, pg2, 0, lane, Rk); h_load(F, l, b, e2 & 15, e2 >> 4, pg2, 1, lane, Rv); }
            asm volatile("s_waitcnt lgkmcnt(0)" ::: "memory");
            int lo, hi;
            if (kind == KIND_SLC) { const int j = ht >> 1; const bool sbit = (selw[tl * 8 + (j >> 5)] >> (j & 31)) & 1u; lo = 0; hi = sbit ? tpos : -1; }
            else { lo = tpos - 511; hi = tpos; }
            f32x16 s0; qk_half(kb, qf, s0, lane);
            mask_half(s0, ht * 32 + 4 * h, lo, hi);
            const float mt = max16(s0); const float mn = fmaxf(m, mt); const float al = __builtin_amdgcn_exp2f(m - mn);
            float rs = 0.f;
#pragma unroll
            for (int k = 0; k < 16; ++k) { s0[k] = __builtin_amdgcn_exp2f(s0[k] - mn); rs += s0[k]; }
            lsum = lsum * al + rs; m = mn;
#pragma unroll
            for (int k = 0; k < 16; ++k) { O[0][k] *= al; O[1][k] *= al; }
            pv_half(vb, s0, O, lane);
            asm volatile("s_waitcnt lgkmcnt(0)" ::: "memory");
        }
        merge_branch(lds, wave, lane, m, lsum, O, br ? g2 : g1);
    }
    if (wave == 0 && wcol) {
        bf16* mo = WSP(F, bf16, WS_MIX) + (size_t)r * DM + 768 + head * 64;
#pragma unroll
        for (int dh = 0; dh < 2; ++dh)
#pragma unroll
            for (int gq = 0; gq < 4; ++gq) { const int d = dh * 32 + 8 * gq + 4 * h; const LAS float* o = outl + (dh * 16 + 4 * gq) * 64 + lane;
                *(unsigned long long*)(mo + d) = (unsigned long long)cvtpk(o[0], o[64]) | ((unsigned long long)cvtpk(o[128], o[192]) << 32); }
    }
    __syncthreads();
}


__device__ __forceinline__ void phase_attn2(const Frame& F, int l) {
    for (int u = blockIdx.x; u < 256; u += F.G) attn_unit(F, l, u & 7, (u >> 3) * 64, 64);
    Frame G2 = F; { int ln = G2.lane; asm volatile("" : "+v"(ln)); G2.lane = ln; G2.tid = G2.wave * 64 + ln; }
    if (F.G == 256) { if (blockIdx.x < 128) { ssd_out_unit(G2, l, (int)blockIdx.x >> 5, (int)blockIdx.x & 31); ssd_out_unit(G2, l, ((int)blockIdx.x + 128) >> 5, ((int)blockIdx.x + 128) & 31); } }
    else for (int u = blockIdx.x; u < BP * 32; u += F.G) ssd_out_unit(G2, l, u >> 5, u & 31);
    for (int r = NP + G2.gw; r < MROWS; r += G2.ngw) ssd_finish_token(G2, l, r);
    {
        const int ncb = (F.G == 256) ? 64 : F.G;
        if ((int)blockIdx.x < ncb) {
            const f32x4* src = (const f32x4*)(INP(F, I_SWIN) + (size_t)l * BS * 512 * 128);
            f32x4* dst = (f32x4*)(F.out + O_WINS + (size_t)l * BS * 512 * 128);
            const int nth = ncb * NTHR;
            for (int i0 = blockIdx.x * NTHR + G2.tid; i0 < BS * 504 * 32; i0 += 4 * nth) {
                f32x4 v[4]; size_t o[4]; bool ok[4];
#pragma unroll
                for (int k = 0; k < 4; ++k) { const int i = i0 + k * nth; ok[k] = i < BS * 504 * 32; const int ic = ok[k] ? i : 0; const int b = ic / (504 * 32), rem = ic % (504 * 32);
                    o[k] = (size_t)b * 512 * 32 + rem; v[k] = src[o[k] + 8 * 32]; }
#pragma unroll
                for (int k = 0; k < 4; ++k) if (ok[k]) dst[o[k]] = v[k];
            }
        }
    }
}


constexpr float LOG2E = 1.4426950408889634f;
constexpr int SD_B = 0, SD_BT = 32768, SD_C = 65536, SD_AC = 98304, SD_DT = SD_AC + 2048, SD_W = SD_DT + 2048, SD_END = SD_W + 2048;
static_assert(SD_END <= RING_BYTES, "ssd LDS map");
__device__ __forceinline__ int crow16(int i, int hp) { return (i & 3) + 8 * (i >> 2) + 4 * hp; }
__device__ __forceinline__ unsigned long long pack4bf(float a, float b, float c, float d) { return (unsigned long long)cvtpk(a, b) | ((unsigned long long)cvtpk(c, d) << 32); }

__device__ __forceinline__ void ssd_chunk_unit(const Frame& F, int l, int b, int c, int g) {
    const int tid = F.tid, lane = F.lane, wave = F.wave;
    LAS unsigned char* lds = F.lds;
    const float* proj = WSP(F, float, WS_PROJ);
    const size_t rbase = (size_t)b * TP + (size_t)c * 128;
    const float* cw = INP(F, I_CONVW) + (size_t)l * 4 * CONV_DIM; const float* cbv = INP(F, I_CONVB) + (size_t)l * CONV_DIM;
    LAS float* acs = (LAS float*)(lds + SD_AC); LAS float* dts = (LAS float*)(lds + SD_DT); LAS float* wts = (LAS float*)(lds + SD_W);
    __syncthreads();
    if (wave < 4) {
        const int hh = wave, head = 4 * g + hh;
        const float a2 = -expf(INP(F, I_ALOG)[l * SSD_H + head]) * LOG2E, dtb = INP(F, I_DTB)[l * SSD_H + head];
        const float d0 = softplusf_(proj[(rbase + 2 * lane) * IN_WP + OFF_DT + head] + dtb), d1 = softplusf_(proj[(rbase + 2 * lane + 1) * IN_WP + OFF_DT + head] + dtb);
        float sc = (d0 + d1) * a2;
#pragma unroll
        for (int o = 1; o < 64; o <<= 1) { const float t = __shfl_up(sc, o); if (lane >= o) sc += t; }
        const float ac1 = sc, ac0 = sc - d1 * a2; const float tot = __uint_as_float(__builtin_amdgcn_readlane(__float_as_uint(sc), 63));
        acs[hh * 128 + 2 * lane] = ac0; acs[hh * 128 + 2 * lane + 1] = ac1; dts[hh * 128 + 2 * lane] = d0; dts[hh * 128 + 2 * lane + 1] = d1;
        wts[hh * 128 + 2 * lane] = __builtin_amdgcn_exp2f(tot - ac0); wts[hh * 128 + 2 * lane + 1] = __builtin_amdgcn_exp2f(tot - ac1);
        float* acg = WSP(F, float, WS_SAC); acg[(rbase + 2 * lane) * SSD_H + head] = ac0; acg[(rbase + 2 * lane + 1) * SSD_H + head] = ac1;
        if (lane == 63) WSP(F, float, WS_SCD)[((size_t)b * 16 + c) * SSD_H + head] = __builtin_amdgcn_exp2f(tot);
    }
    {
        const int ch = tid & 255, th = tid >> 8;
        const int chan = (ch < 128) ? 512 + g * 128 + ch : 768 + g * 128 + (ch - 128);
        const float w0 = cw[chan], w1 = cw[CONV_DIM + chan], w2 = cw[2 * CONV_DIM + chan], w3 = cw[3 * CONV_DIM + chan], bb = cbv[chan];
        const int tl0 = th * 64;
        const float* src = proj + (rbase + tl0) * IN_WP + OFF_XBC + chan;
        const bool hasp = (c > 0) || (th > 0);
        float x0 = hasp ? src[-3 * IN_WP] : 0.f, x1 = hasp ? src[-2 * IN_WP] : 0.f, x2 = hasp ? src[-IN_WP] : 0.f;
        const int n = ch & 127;
        bf16* cbg = WSP(F, bf16, WS_SCB) + (rbase + tl0) * 256 + g * 128 + n;
        for (int i1 = 0; i1 < 64; i1 += 16) {
          float rawv[16];
#pragma unroll
          for (int k = 0; k < 16; ++k) rawv[k] = src[(size_t)(i1 + k) * IN_WP];
#pragma unroll
          for (int i2 = 0; i2 < 16; i2 += 4) { const int i0 = i1 + i2;
            float v[4];
#pragma unroll
            for (int k = 0; k < 4; ++k) { const float cur = rawv[i2 + k]; v[k] = siluf_(bb + w0 * x0 + w1 * x1 + w2 * x2 + w3 * cur); x0 = x1; x1 = x2; x2 = cur; }
            const int s = tl0 + i0;
            if (ch < 128) {
#pragma unroll
                for (int k = 0; k < 4; ++k) *(LAS unsigned short*)(lds + SD_B + (s + k) * 256 + (((n >> 3) ^ ((s + k) & 15)) << 4) + (n & 7) * 2) = (unsigned short)f2bf(v[k]);
                *(LAS unsigned long long*)(lds + SD_BT + n * 256 + (((s >> 2) ^ (n & 31)) << 3)) = pack4bf(v[0], v[1], v[2], v[3]);
            } else {
#pragma unroll
                for (int k = 0; k < 4; ++k) { const unsigned short hv = (unsigned short)f2bf(v[k]);
                    *(LAS unsigned short*)(lds + SD_C + (s + k) * 256 + (((n >> 3) ^ ((s + k) & 15)) << 4) + (n & 7) * 2) = hv; cbg[(size_t)(i0 + k) * 256] = hv; }
            }
          }
        }
    }
    __syncthreads();
    const int lb = wave & 3, hw = wave >> 2;
    int lane_g = lane; asm volatile("" : "+v"(lane_g));
    f32x16 Gt[4];
    {
        const int r32 = lane_g & 31, hp = lane_g >> 5, lloc = lb * 32 + r32;
        bf16x8 cf[8];
#pragma unroll
        for (int ks = 0; ks < 8; ++ks) cf[ks] = *(const LAS bf16x8*)(lds + SD_C + lloc * 256 + (((2 * ks + hp) ^ (lloc & 15)) << 4));
#pragma unroll
        for (int sb = 0; sb < 4; ++sb) {
#pragma unroll
            for (int i = 0; i < 16; ++i) Gt[sb][i] = 0.f;
            if (sb <= lb) {
                int s = sb * 32 + r32; asm volatile("" : "+v"(s));
#pragma unroll
                for (int ks = 0; ks < 8; ++ks) { const bf16x8 a = *(const LAS bf16x8*)(lds + SD_B + s * 256 + (((2 * ks + hp) ^ (s & 15)) << 4));
                    Gt[sb] = __builtin_amdgcn_mfma_f32_32x32x16_bf16(a, cf[ks], Gt[sb], 0, 0, 0); }
            }
            __builtin_amdgcn_sched_barrier(0);
        }
    }
    __syncthreads();
    for (int rd = 0; rd < 2; ++rd) {
        {
            int tid_r = tid; asm volatile("" : "+v"(tid_r));
            const int ch = tid_r & 127, tq = tid_r >> 7; const int hh2 = ch >> 6, p = ch & 63, hh = 2 * rd + hh2;
            const int chan = (4 * g + hh) * 64 + p;
            const float w0 = cw[chan], w1 = cw[CONV_DIM + chan], w2 = cw[2 * CONV_DIM + chan], w3 = cw[3 * CONV_DIM + chan], bb = cbv[chan];
            const int tl0 = tq * 32;
            const float* src = proj + (rbase + tl0) * IN_WP + OFF_XBC + chan;
            const bool hasp = (c > 0) || (tq > 0);
            float x0 = hasp ? src[-3 * IN_WP] : 0.f, x1 = hasp ? src[-2 * IN_WP] : 0.f, x2 = hasp ? src[-IN_WP] : 0.f;
            for (int i1 = 0; i1 < 32; i1 += 16) {
              float rawv[16];
#pragma unroll
              for (int k = 0; k < 16; ++k) rawv[k] = src[(size_t)(i1 + k) * IN_WP];
#pragma unroll
              for (int i2 = 0; i2 < 16; i2 += 4) { const int i0 = i1 + i2;
                float v[4]; const int s = tl0 + i0;
#pragma unroll
                for (int k = 0; k < 4; ++k) { const float cur = rawv[i2 + k]; v[k] = siluf_(bb + w0 * x0 + w1 * x1 + w2 * x2 + w3 * cur) * dts[hh * 128 + s + k]; x0 = x1; x1 = x2; x2 = cur; }
                *(LAS unsigned long long*)(lds + SD_C + hh2 * 16384 + p * 256 + (((s >> 2) ^ (p & 31)) << 3)) = pack4bf(v[0], v[1], v[2], v[3]);
              }
            }
        }
        __syncthreads();
        int lane_r = lane; asm volatile("" : "+v"(lane_r));
        const int r32 = lane_r & 31, hp = lane_r >> 5, lloc = lb * 32 + r32;
        const int hh = 2 * rd + hw, head = 4 * g + hh;
        const LAS float* ac = acs + hh * 128; const LAS float* wp = wts + hh * 128;
        const LAS unsigned char* xt = lds + SD_C + hw * 16384;
        const float acl = ac[lloc], ddt = INP(F, I_SSDD)[l * SSD_H + head] / dts[hh * 128 + lloc];
        f32x16 Y[2];
#pragma unroll
        for (int i = 0; i < 16; ++i) { Y[0][i] = 0.f; Y[1][i] = 0.f; }
#pragma unroll
        for (int sb = 0; sb < 4; ++sb) {
            if (sb <= lb) {
                f32x16 mt;
#pragma unroll
                for (int i = 0; i < 16; ++i) { const int s = sb * 32 + crow16(i, hp);
                    float mv = Gt[sb][i] * __builtin_amdgcn_exp2f(acl - ac[s]);
                    if (sb == lb) { mv = (s > lloc) ? 0.f : mv; mv += (s == lloc) ? ddt : 0.f; }
                    mt[i] = mv; }
                bf16x8 pf[2];
#pragma unroll
                for (int sp = 0; sp < 2; ++sp) { v4u a; a.x = cvtpk(mt[8 * sp + 0], mt[8 * sp + 1]); a.y = cvtpk(mt[8 * sp + 2], mt[8 * sp + 3]); a.z = cvtpk(mt[8 * sp + 4], mt[8 * sp + 5]); a.w = cvtpk(mt[8 * sp + 6], mt[8 * sp + 7]);
                    pf[sp] = __builtin_bit_cast(bf16x8, a); }
#pragma unroll
                for (int pt = 0; pt < 2; ++pt) { int p = pt * 32 + r32; asm volatile("" : "+v"(p)); const int sw = p & 31; const LAS unsigned char* rb = xt + p * 256;
#pragma unroll
                    for (int sp = 0; sp < 2; ++sp) { const int q0 = sb * 8 + 4 * sp + hp;
                        const unsigned long long lo8 = *(const LAS unsigned long long*)(rb + ((q0 ^ sw) << 3)), hi8 = *(const LAS unsigned long long*)(rb + (((q0 + 2) ^ sw) << 3));
                        v4u av; av.x = (unsigned)lo8; av.y = (unsigned)(lo8 >> 32); av.z = (unsigned)hi8; av.w = (unsigned)(hi8 >> 32);
                        Y[pt] = __builtin_amdgcn_mfma_f32_32x32x16_bf16(__builtin_bit_cast(bf16x8, av), pf[sp], Y[pt], 0, 0, 0); } }
            }
            __builtin_amdgcn_sched_barrier(0);
        }
        {
            float* yo = WSP(F, float, WS_YSSD) + (rbase + lloc) * SSD_W + head * 64;
#pragma unroll
            for (int pt = 0; pt < 2; ++pt)
#pragma unroll
                for (int qd = 0; qd < 4; ++qd) *(f32x4*)(yo + pt * 32 + 8 * qd + 4 * hp) = (f32x4){Y[pt][4 * qd], Y[pt][4 * qd + 1], Y[pt][4 * qd + 2], Y[pt][4 * qd + 3]};
        }
        {
            f32x16 St[2];
#pragma unroll
            for (int i = 0; i < 16; ++i) { St[0][i] = 0.f; St[1][i] = 0.f; }
            const int n = lb * 32 + r32;
#pragma unroll
            for (int ks = 0; ks < 8; ++ks) {
                const int cb0 = 4 * ks + 2 * hp; int nn = n; asm volatile("" : "+v"(nn));
                const unsigned long long blo = *(const LAS unsigned long long*)(lds + SD_BT + nn * 256 + ((cb0 ^ (nn & 31)) << 3)), bhi = *(const LAS unsigned long long*)(lds + SD_BT + nn * 256 + (((cb0 + 1) ^ (nn & 31)) << 3));
                v4u bv; bv.x = (unsigned)blo; bv.y = (unsigned)(blo >> 32); bv.z = (unsigned)bhi; bv.w = (unsigned)(bhi >> 32);
                const f32x4 wa = *(const LAS f32x4*)(wp + 16 * ks + 8 * hp), wb = *(const LAS f32x4*)(wp + 16 * ks + 8 * hp + 4);
#pragma unroll
                for (int pt = 0; pt < 2; ++pt) { const int p = pt * 32 + (nn & 31); const LAS unsigned char* rb = xt + p * 256;
                    const unsigned long long alo = *(const LAS unsigned long long*)(rb + ((cb0 ^ (p & 31)) << 3)), ahi = *(const LAS unsigned long long*)(rb + (((cb0 + 1) ^ (p & 31)) << 3));
                    const unsigned a0 = (unsigned)alo, a1 = (unsigned)(alo >> 32), a2 = (unsigned)ahi, a3 = (unsigned)(ahi >> 32);
                    v4u av;
                    av.x = cvtpk(__uint_as_float(a0 << 16) * wa.x, __uint_as_float(a0 & 0xffff0000u) * wa.y); av.y = cvtpk(__uint_as_float(a1 << 16) * wa.z, __uint_as_float(a1 & 0xffff0000u) * wa.w);
                    av.z = cvtpk(__uint_as_float(a2 << 16) * wb.x, __uint_as_float(a2 & 0xffff0000u) * wb.y); av.w = cvtpk(__uint_as_float(a3 << 16) * wb.z, __uint_as_float(a3 & 0xffff0000u) * wb.w);
                    St[pt] = __builtin_amdgcn_mfma_f32_32x32x16_bf16(__builtin_bit_cast(bf16x8, av), __builtin_bit_cast(bf16x8, bv), St[pt], 0, 0, 0); }
                __builtin_amdgcn_sched_barrier(0);
            }
            float* cs = WSP(F, float, WS_SCS) + (((size_t)b * 16 + c) * SSD_H + head) * (SSD_HD * SSD_N) + n;
#pragma unroll
            for (int pt = 0; pt < 2; ++pt)
#pragma unroll
                for (int i = 0; i < 16; ++i) cs[(size_t)(pt * 32 + crow16(i, hp)) * SSD_N] = St[pt][i];
        }
        __syncthreads();
    }
}

__device__ __forceinline__ void ssd_scan(const Frame& F, int l) {
    const float* cs = WSP(F, float, WS_SCS); const float* cd = WSP(F, float, WS_SCD); bf16* hs = WSP(F, bf16, WS_SHS);
    const bool upper = (F.G == 256);
    for (int idx0 = blockIdx.x * NTHR + F.tid; idx0 < BP * SSD_H * 2048; idx0 += F.G * NTHR) {
        if (upper && blockIdx.x < 128) continue;
#pragma unroll 1
        for (int rep = 0; rep < (upper ? 2 : 1); ++rep) {
            const int idx = upper ? idx0 - (1 - rep) * 65536 : idx0;
            const int e4 = idx & 2047, bh = idx >> 11, b = bh >> 3, h = bh & 7;
            f32x4 st = (f32x4){0.f, 0.f, 0.f, 0.f};
#pragma unroll 8
            for (int c = 0; c < 16; ++c) {
                const size_t o = (((size_t)b * 16 + c) * SSD_H + h) * (SSD_HD * SSD_N) + e4 * 4;
                *(unsigned long long*)(hs + o) = pack4bf(st.x, st.y, st.z, st.w);
                const f32x4 sv = *(const f32x4*)(cs + o); const float d = cd[((size_t)b * 16 + c) * SSD_H + h];
                st = st * d + sv;
            }
            *(f32x4*)(F.out + O_SSMP + (((size_t)l * BP + b) * SSD_H + h) * (SSD_HD * SSD_N) + e4 * 4) = st;
        }
    }
}

__device__ __forceinline__ void ssd_out_unit(const Frame& F, int l, int b, int hc) {
    const int lane = F.lane, h = F.wave, g = h >> 2, c = hc >> 1, l0 = hc * 64, r32 = lane & 31, hp = lane >> 5;
    LAS float* ssq = (LAS float*)F.lds;
    const bf16* Hs = WSP(F, bf16, WS_SHS) + (((size_t)b * 16 + c) * SSD_H + h) * (SSD_HD * SSD_N);
    const bf16* Cb = WSP(F, bf16, WS_SCB) + ((size_t)b * TP + l0) * 256 + g * 128;
    f32x16 Yo[2][2];
#pragma unroll
    for (int i = 0; i < 16; ++i) { Yo[0][0][i] = 0.f; Yo[0][1][i] = 0.f; Yo[1][0][i] = 0.f; Yo[1][1][i] = 0.f; }
#pragma unroll
    for (int ks = 0; ks < 8; ++ks) {
        bf16x8 af[2], bfr[2];
#pragma unroll
        for (int pt = 0; pt < 2; ++pt) af[pt] = *(const bf16x8*)(Hs + (size_t)(pt * 32 + r32) * SSD_N + 16 * ks + 8 * hp);
#pragma unroll
        for (int lt = 0; lt < 2; ++lt) bfr[lt] = *(const bf16x8*)(Cb + (size_t)(lt * 32 + r32) * 256 + 16 * ks + 8 * hp);
#pragma unroll
        for (int lt = 0; lt < 2; ++lt)
#pragma unroll
            for (int pt = 0; pt < 2; ++pt) Yo[lt][pt] = __builtin_amdgcn_mfma_f32_32x32x16_bf16(af[pt], bfr[lt], Yo[lt][pt], 0, 0, 0);
    }
    __syncthreads();
#pragma unroll
    for (int lt = 0; lt < 2; ++lt) {
        const size_t row = (size_t)b * TP + l0 + lt * 32 + r32;
        const float sc = __builtin_amdgcn_exp2f(WSP(F, float, WS_SAC)[row * SSD_H + h]);
        const float* yd = WSP(F, float, WS_YSSD) + row * SSD_W + h * 64; const float* zz = WSP(F, float, WS_PROJ) + row * IN_WP + h * 64;
        float ss = 0.f;
#pragma unroll
        for (int pt = 0; pt < 2; ++pt) {
            f32x4 y4v[4], z4v[4];
#pragma unroll
            for (int i = 0; i < 4; ++i) { const int p = pt * 32 + 8 * i + 4 * hp; y4v[i] = *(const f32x4*)(yd + p); z4v[i] = *(const f32x4*)(zz + p); }
#pragma unroll
            for (int qd = 0; qd < 4; ++qd) { const f32x4 y4 = y4v[qd], z4 = z4v[qd];
#pragma unroll
                for (int k = 0; k < 4; ++k) { const float v = (y4[k] + sc * Yo[lt][pt][4 * qd + k]) * siluf_(z4[k]); Yo[lt][pt][4 * qd + k] = v; ss += v * v; } }
        }
        ss = half_sum(ss);
        if (hp == 0) ssq[(lt * 32 + r32) * 8 + h] = ss;
    }
    __syncthreads();
    const float* nw = INP(F, I_SSDNORM) + (size_t)l * SSD_W + h * 64;
#pragma unroll
    for (int lt = 0; lt < 2; ++lt) {
        const size_t row = (size_t)b * TP + l0 + lt * 32 + r32;
        const LAS float* sq = ssq + (lt * 32 + r32) * 8;
        const float tot = ((sq[0] + sq[1]) + (sq[2] + sq[3])) + ((sq[4] + sq[5]) + (sq[6] + sq[7]));
        const float rs = 1.f / sqrtf(tot * (1.f / SSD_W) + RMS_EPS);
        bf16* mo = WSP(F, bf16, WS_MIX) + row * DM + h * 64;
#pragma unroll
        for (int pt = 0; pt < 2; ++pt)
#pragma unroll
            for (int qd = 0; qd < 4; ++qd) { const int p = pt * 32 + 8 * qd + 4 * hp; const f32x4 w4 = *(const f32x4*)(nw + p);
                *(unsigned long long*)(mo + p) = pack4bf(Yo[lt][pt][4 * qd] * rs * w4.x, Yo[lt][pt][4 * qd + 1] * rs * w4.y, Yo[lt][pt][4 * qd + 2] * rs * w4.z, Yo[lt][pt][4 * qd + 3] * rs * w4.w); }
    }
    __syncthreads();
}

__device__ __forceinline__ void resid_row(const Frame& F, const float* xold, const float* f, const bf16* fb, int nsl, size_t slstride, const float* w_post, float* xnew, const float* w_next, bf16* xn) {
    const f32x4* xo = (const f32x4*)xold + F.lane; const f32x4* fr = (const f32x4*)f + F.lane; const f32x4* wp = (const f32x4*)w_post + F.lane;
    f32x4 fv[4]; float ss = 0.f;
#pragma unroll
    for (int j = 0; j < 4; ++j) {
        if (fb) fv[j] = bf4_to_f32(((const unsigned long long*)fb + F.lane)[64 * j]); else fv[j] = fr[64 * j];
        for (int s = 1; s < nsl; ++s) fv[j] += ((const f32x4*)(f + s * slstride) + F.lane)[64 * j];
        ss += (fv[j].x * fv[j].x + fv[j].y * fv[j].y) + (fv[j].z * fv[j].z + fv[j].w * fv[j].w); }
    const float rs = 1.f / sqrtf(wave_sum(ss) * (1.f / DM) + RMS_EPS);
    f32x4 xv[4]; float s2 = 0.f;
#pragma unroll
    for (int j = 0; j < 4; ++j) { xv[j] = xo[64 * j] + fv[j] * rs * wp[64 * j]; s2 += (xv[j].x * xv[j].x + xv[j].y * xv[j].y) + (xv[j].z * xv[j].z + xv[j].w * xv[j].w);
        ((f32x4*)xnew + F.lane)[64 * j] = xv[j]; }
    if (w_next) {
        const float r2 = 1.f / sqrtf(wave_sum(s2) * (1.f / DM) + RMS_EPS);
        const f32x4* wn = (const f32x4*)w_next + F.lane; unsigned long long* o8 = (unsigned long long*)xn + F.lane;
#pragma unroll
        for (int j = 0; j < 4; ++j) { const f32x4 g = wn[64 * j];
            o8[64 * j] = (unsigned long long)pk2(xv[j].x * r2 * g.x, xv[j].y * r2 * g.y) | ((unsigned long long)pk2(xv[j].z * r2 * g.z, xv[j].w * r2 * g.w) << 32); }
    }
}
template <int NR>
__device__ __forceinline__ void resid_rowsN(const Frame& F, const float* xold, const bf16* f, const float* w_post, float* xnew, const float* w_next, bf16* xn) {
    const int lane = F.lane;
    unsigned long long fr[NR][4]; f32x4 xv[NR][4];
#pragma unroll
    for (int r = 0; r < NR; ++r)
#pragma unroll
        for (int j = 0; j < 4; ++j) { fr[r][j] = ((const unsigned long long*)(f + (size_t)r * DM) + lane)[64 * j]; xv[r][j] = ((const f32x4*)(xold + (size_t)r * DM) + lane)[64 * j]; }
    float rs[NR];
#pragma unroll
    for (int r = 0; r < NR; ++r) { float s = 0.f;
#pragma unroll
        for (int j = 0; j < 4; ++j) { const f32x4 v = bf4_to_f32(fr[r][j]); s += (v.x * v.x + v.y * v.y) + (v.z * v.z + v.w * v.w); }
        rs[r] = s; }
#pragma unroll
    for (int r = 0; r < NR; ++r) rs[r] = 1.f / sqrtf(wave_sum(rs[r]) * (1.f / DM) + RMS_EPS);
    float s2[NR];
#pragma unroll
    for (int r = 0; r < NR; ++r) s2[r] = 0.f;
#pragma unroll
    for (int j = 0; j < 4; ++j) { const f32x4 wp = ((const f32x4*)w_post + lane)[64 * j];
#pragma unroll
        for (int r = 0; r < NR; ++r) { xv[r][j] = xv[r][j] + bf4_to_f32(fr[r][j]) * rs[r] * wp;
            s2[r] += (xv[r][j].x * xv[r][j].x + xv[r][j].y * xv[r][j].y) + (xv[r][j].z * xv[r][j].z + xv[r][j].w * xv[r][j].w);
            ((f32x4*)(xnew + (size_t)r * DM) + lane)[64 * j] = xv[r][j]; } }
    if (w_next) {
#pragma unroll
        for (int r = 0; r < NR; ++r) s2[r] = 1.f / sqrtf(wave_sum(s2[r]) * (1.f / DM) + RMS_EPS);
#pragma unroll
        for (int j = 0; j < 4; ++j) { const f32x4 g = ((const f32x4*)w_next + lane)[64 * j];
#pragma unroll
            for (int r = 0; r < NR; ++r) { const float q = s2[r];
                ((unsigned long long*)(xn + (size_t)r * DM) + lane)[64 * j] = (unsigned long long)pk2(xv[r][j].x * q * g.x, xv[r][j].y * q * g.y) | ((unsigned long long)pk2(xv[r][j].z * q * g.z, xv[r][j].w * q * g.w) << 32); } }
    }
}
constexpr int RES_NR = 4;
__device__ __forceinline__ void phase_resid_mix(const Frame& F, int l) {
    for (int rp = F.gw; rp < NP / RES_NR; rp += F.ngw) { const int r = RES_NR * rp;
        const float* x0 = (l == 0) ? x_in_row(F, r) : WSP(F, float, WS_X) + (size_t)r * DM;
        resid_rowsN<RES_NR>(F, x0, WSP(F, bf16, WS_MIXO) + (size_t)r * DM, INP(F, I_NMPOST) + (size_t)l * DM, WSP(F, float, WS_X) + (size_t)r * DM,
                            INP(F, I_NFPRE) + (size_t)l * DM, WSP(F, bf16, WS_XN) + (size_t)r * DM);
    }
    for (int j = blockIdx.x * 8 + F.wave; j < NS * 8; j += F.G * 8) { if (j & 7) continue; const int r = NP + (j >> 3);
        const float* xold = (l == 0) ? x_in_row(F, r) : WSP(F, float, WS_X) + (size_t)r * DM;
        resid_row(F, xold, WSP(F, float, WS_SLAB) + (size_t)(r - NP) * DM, nullptr, SPLIT_OUT, (size_t)256 * DM, INP(F, I_NMPOST) + (size_t)l * DM, WSP(F, float, WS_X) + (size_t)r * DM,
                  INP(F, I_NFPRE) + (size_t)l * DM, WSP(F, bf16, WS_XN) + (size_t)r * DM);
    }
}
__device__ __forceinline__ void phase_resid_ffn(const Frame& F, int l) {
    const float* wn = (l == DEPTH - 1) ? nullptr : INP(F, I_NMPRE) + (size_t)(l + 1) * DM;
    for (int rp = F.gw; rp < NP / RES_NR; rp += F.ngw) { const int r = RES_NR * rp;
        float* xn = (l == DEPTH - 1) ? F.out + O_YP + (size_t)r * DM : WSP(F, float, WS_X) + (size_t)r * DM;
        resid_rowsN<RES_NR>(F, WSP(F, float, WS_X) + (size_t)r * DM, WSP(F, bf16, WS_MIXO) + (size_t)r * DM, INP(F, I_NFPOST) + (size_t)l * DM, xn, wn, WSP(F, bf16, WS_XN) + (size_t)r * DM);
    }
    for (int j = blockIdx.x * 8 + F.wave; j < NS * 8; j += F.G * 8) { if (j & 7) continue; const int r = NP + (j >> 3);
        float* xnew = (l == DEPTH - 1) ? F.out + O_YS + (size_t)(r - NP) * DM : WSP(F, float, WS_X) + (size_t)r * DM;
        resid_row(F, WSP(F, float, WS_X) + (size_t)r * DM, WSP(F, float, WS_SLAB) + (size_t)(r - NP) * DM, nullptr, SPLIT_DOWN, (size_t)256 * DM, INP(F, I_NFPOST) + (size_t)l * DM, xnew,
                  wn, WSP(F, bf16, WS_XN) + (size_t)r * DM);
    }
}

__device__ __forceinline__ void phase_ffn_act(const Frame& F, int l) {
    bf16* act = WSP(F, bf16, WS_ACT);
    const float* cw = INP(F, I_FCW) + (size_t)l * 3 * DFF; const float* cb = INP(F, I_FCB) + (size_t)l * DFF;
    const float* halo = WSP(F, float, WS_FHALO); const float* last = WSP(F, float, WS_FLAST); const float* raw = WSP(F, float, WS_FRAW);
    for (int it = F.gw; it < 64 * 2 * 16; it += F.ngw) {
        const int pm = it >> 5, j = (it >> 4) & 1, c = (it & 15) * 256 + F.lane * 4;
        const bool first = (pm & 7) == 0;
        const f32x4 z = (f32x4){0.f, 0.f, 0.f, 0.f};
        const f32x4 ga = *(const f32x4*)(halo + ((size_t)pm * 2 + j) * 8192 + c), vv = *(const f32x4*)(halo + ((size_t)pm * 2 + j) * 8192 + 4096 + c);
        f32x4 gb, gc;
        if (j == 0) { gb = first ? z : *(const f32x4*)(last + ((size_t)(pm - 1) * 2 + 1) * 4096 + c); gc = first ? z : *(const f32x4*)(last + ((size_t)(pm - 1) * 2 + 0) * 4096 + c); }
        else { gb = *(const f32x4*)(halo + ((size_t)pm * 2 + 0) * 8192 + c); gc = first ? z : *(const f32x4*)(last + ((size_t)(pm - 1) * 2 + 1) * 4096 + c); }
        const f32x4 w0 = *(const f32x4*)(cw + c), w1 = *(const f32x4*)(cw + DFF + c), w2 = *(const f32x4*)(cw + 2 * DFF + c), bb = *(const f32x4*)(cb + c);
        const f32x4 pre = gc * w0 + gb * w1 + ga * w2 + bb;
        const float a0 = gelu_tanh(pre.x) * vv.x, a1 = gelu_tanh(pre.y) * vv.y, a2 = gelu_tanh(pre.z) * vv.z, a3 = gelu_tanh(pre.w) * vv.w;
        *(unsigned long long*)(act + (size_t)(pm * 256 + j) * DFF + c) = (unsigned long long)pk2(a0, a1) | ((unsigned long long)pk2(a2, a3) << 32);
    }
    for (int jj = blockIdx.x * 8 + F.wave; jj < BP * 2 * 16 * 8; jj += F.G * 8) { if (jj & 7) continue; const int it = jj >> 3;
        const int b = it >> 5, j = (it >> 4) & 1, c = (it & 15) * 256 + F.lane * 4;
        *(f32x4*)(F.out + O_FFNP + (((size_t)l * BP + b) * 2 + j) * DFF + c) = *(const f32x4*)(last + ((size_t)(8 * b + 7) * 2 + j) * 4096 + c);
    }
    for (int it = F.gw; it < NS * 16; it += F.ngw) {
        const int r = NP + (it >> 4), j = it & 15;
        const int qq = r - NP, b = qq >> 3, t = qq & 7;
        const float* sffn = INP(F, I_SFFN) + ((size_t)l * BS + b) * 2 * DFF;
        const float* g0 = raw + (size_t)qq * 2 * DFF;
        { const int c = j * 256 + F.lane * 4;
            constexpr size_t SL = (size_t)256 * 2 * DFF;
            f32x4 ga = *(const f32x4*)(g0 + c), gb, gc, vv = *(const f32x4*)(g0 + DFF + c);
            if (t >= 1) gb = *(const f32x4*)(g0 - (size_t)2 * DFF + c); else gb = *(const f32x4*)(sffn + DFF + c);
            if (t >= 2) gc = *(const f32x4*)(g0 - (size_t)4 * DFF + c); else gc = *(const f32x4*)(sffn + (size_t)t * DFF + c);
#pragma unroll
            for (int sl = 1; sl < SPLIT_UP; ++sl) { ga += *(const f32x4*)(g0 + sl * SL + c); vv += *(const f32x4*)(g0 + sl * SL + DFF + c);
                if (t >= 1) gb += *(const f32x4*)(g0 + sl * SL - (size_t)2 * DFF + c);
                if (t >= 2) gc += *(const f32x4*)(g0 + sl * SL - (size_t)4 * DFF + c); }
            const f32x4 w0 = *(const f32x4*)(cw + c), w1 = *(const f32x4*)(cw + DFF + c), w2 = *(const f32x4*)(cw + 2 * DFF + c), bb = *(const f32x4*)(cb + c);
            const f32x4 pre = gc * w0 + gb * w1 + ga * w2 + bb;
            const float a0 = gelu_tanh(pre.x) * vv.x, a1 = gelu_tanh(pre.y) * vv.y, a2 = gelu_tanh(pre.z) * vv.z, a3 = gelu_tanh(pre.w) * vv.w;
            *(unsigned long long*)(act + (size_t)r * DFF + c) = (unsigned long long)pk2(a0, a1) | ((unsigned long long)pk2(a2, a3) << 32);
            if (t >= TS - 2) *(f32x4*)(F.out + O_FFNS + (((size_t)l * BS + b) * 2 + (t - (TS - 2))) * DFF + c) = ga;
        }
    }
}

__global__ void __launch_bounds__(NTHR, 2) hymba_fwd(Params prm) {
    extern __shared__ __attribute__((aligned(16))) unsigned char lds_raw[];
    Frame F;
    F.lds = (LAS unsigned char*)lds_raw;
#define REFRESH() do { unsigned z_ = 0u; asm volatile("" : "+v"(z_)); int ln_ = (int)__builtin_amdgcn_mbcnt_hi(~0u, __builtin_amdgcn_mbcnt_lo(~0u, z_)); F.lane = ln_; F.wave = wave_s; F.tid = wave_s * 64 + ln_; \
        F.gw = blockIdx.x * NWAVES + F.wave; \
        const __attribute__((address_space(4))) void* kp_ = (const __attribute__((address_space(4))) void*)__builtin_amdgcn_kernarg_segment_ptr(); asm volatile("" : "+s"(kp_)); \
        F.p = (const __attribute__((address_space(4))) Params*)kp_; F.ws = F.p->ws; F.out = F.p->out; } while (0)
    F.G = gridDim.x; F.ngw = F.G * NWAVES;
    const int wave_s = __builtin_amdgcn_readfirstlane((int)threadIdx.x >> 6);
    REFRESH();
    volatile LAS unsigned* MISC = (volatile LAS unsigned*)(F.lds + MISC_OFF);
    for (int u = F.tid; u < (LDS_BYTES - RING_BYTES) / 4; u += NTHR) ((LAS unsigned*)(F.lds + RING_BYTES))[u] = 0u;
    __syncthreads();
    const int lo = F.p->ph_lo, hi = F.p->ph_hi;
    const bool use_bar = (hi - lo) > 1;
    XcdBarrier bar; bar.bar = (unsigned*)(F.ws + WS_CTL) + 4096; bar.x = 0; bar.st = nullptr;
    if (use_bar) bar = xcd_barrier_post((unsigned*)(F.ws + WS_CTL) + 4096, MISC + 8);
#define IN(k) (lo <= (k) && (k) < hi)
#define SEAM(k) do { if (IN((k) + 1)) { REFRESH(); xcd_barrier(bar, F.tid == 0); } } while (0)

    if (IN(0)) { REFRESH(); phase_prologue(F); SEAM(0); }
    if (IN(1)) { REFRESH();
        pg8::Gemm g{WSP(F, pg8::bf16_t, WS_AS), WSP(F, pg8::bf16_t, WS_WTC), 8 * BS * 512, 256, 1024};
        pg8::CmpOrder S; S.G = F.G; S.c = (int)blockIdx.x;
        pg8::EpiCmp E{WSP(F, float, WS_HS)};
        pg8::gemm_phase<pg8::EpiCmp, pg8::CmpOrder, true, true>(F.lds, g, S, E, F.tid);
        SEAM(1);
    }
    if (IN(2)) { REFRESH(); phase_cmp_finish(F); SEAM(2); }
    for (int l = 0; l < DEPTH; ++l) {
        const int pb = N_PRO + l * PH_PER_LAYER;
        if (IN(pb + 0)) { REFRESH();
            pg8::Gemm g{WSP(F, pg8::bf16_t, WS_XN), WSP(F, pg8::bf16_t, WS_WTIN) + (size_t)l * IN_WP * DM, MROWS, IN_WP, DM};
            pg8::StaticOrder S; S.init(MROWS, IN_WP, F.G, (int)blockIdx.x);
            pg8::EpiF32 E{WSP(F, float, WS_PROJ), IN_WP};
            pg8::gemm_phase<pg8::EpiF32, pg8::StaticOrder, true, true>(F.lds, g, S, E, F.tid);
            SEAM(pb + 0);
        }
        if (IN(pb + 1)) { REFRESH(); phase_prep(F, l); SEAM(pb + 1); }
        if (IN(pb + 2)) { REFRESH(); phase_compress(F, l); SEAM(pb + 2); }
        if (IN(pb + 3)) { REFRESH(); phase_attn2(F, l); SEAM(pb + 3); }
        if (IN(pb + 4)) { REFRESH();
            pg8::Gemm g{WSP(F, pg8::bf16_t, WS_MIX), WSP(F, pg8::bf16_t, WS_WTOUT) + (size_t)l * DM * DM, MROWS, DM, DM};
            pg8::TailSplitOrder S; S.init(NP, DM, DM, SPLIT_OUT, F.G, (int)blockIdx.x);
            pg8::EpiB16Split E{WSP(F, pg8::bf16_t, WS_MIXO), WSP(F, float, WS_SLAB), DM, NP / 256};
            pg8::gemm_phase<pg8::EpiB16Split, pg8::TailSplitOrder, true, true>(F.lds, g, S, E, F.tid);
            SEAM(pb + 4);
        }
        if (IN(pb + 5)) { REFRESH(); phase_resid_mix(F, l); SEAM(pb + 5); }
        if (IN(pb + 6)) { REFRESH();
            pg8::Gemm g{WSP(F, pg8::bf16_t, WS_XN), WSP(F, pg8::bf16_t, WS_WTUP) + (size_t)l * 2 * DFF * DM, MROWS, 2 * DFF, DM};
            pg8::StaticOrder S; S.init(MROWS, 2 * DFF, F.G, (int)blockIdx.x);
            pg8::EpiFfn E{WSP(F, pg8::bf16_t, WS_ACT), WSP(F, float, WS_FRAW), WSP(F, float, WS_FHALO), WSP(F, float, WS_FLAST),
                          INP(F, I_FCW) + (size_t)l * 3 * DFF, INP(F, I_FCB) + (size_t)l * DFF, (LAS float*)(F.lds + XB_OFF), NP / 256};
            pg8::gemm_phase<pg8::EpiFfn, pg8::StaticOrder, true, true>(F.lds, g, S, E, F.tid);
            SEAM(pb + 6);
        }
        if (IN(pb + 7)) { REFRESH(); phase_ffn_act(F, l); SEAM(pb + 7); }
        if (IN(pb + 8)) { REFRESH();
            pg8::Gemm g{WSP(F, pg8::bf16_t, WS_ACT), WSP(F, pg8::bf16_t, WS_WTDN) + (size_t)l * DM * DFF, MROWS, DM, DFF};
            pg8::TailSplitOrder S; S.init(NP, DM, DFF, SPLIT_DOWN, F.G, (int)blockIdx.x);
            pg8::EpiB16Split E{WSP(F, pg8::bf16_t, WS_MIXO), WSP(F, float, WS_SLAB), DM, NP / 256};
            pg8::gemm_phase<pg8::EpiB16Split, pg8::TailSplitOrder, true, true>(F.lds, g, S, E, F.tid);
            SEAM(pb + 8);
        }
        if (IN(pb + 9)) { REFRESH(); phase_resid_ffn(F, l); SEAM(pb + 9); }
    }
#undef IN
#undef SEAM
}

#ifndef N_LAUNCH_MODE
#define N_LAUNCH_MODE 1
#endif
extern "C" void kernel_launch(void* const* d_in, const int* in_sizes, int n_in, void* d_out, int out_size, void* d_ws, size_t ws_size, hipStream_t stream) {
    static int grid = 0;
    if (grid == 0) {
        if (n_in != N_IN || (size_t)out_size != O_END || ws_size < WS_END) {
            fprintf(stderr, "kernel_launch: unexpected shapes: n_in %d (want %d), out %d (want %zu), ws %zu (want >= %zu); nothing launched\n", n_in, (int)N_IN, out_size, (size_t)O_END, ws_size, (size_t)WS_END);
            grid = -1; return; }
        int dev = 0, cus = 0, per_cu = 0;
        if (hipGetDevice(&dev) != hipSuccess || hipDeviceGetAttribute(&cus, hipDeviceAttributeMultiprocessorCount, dev) != hipSuccess) { grid = -1; return; }
        if (hipFuncSetAttribute((const void*)hymba_fwd, hipFuncAttributeMaxDynamicSharedMemorySize, LDS_BYTES) != hipSuccess) { fprintf(stderr, "kernel_launch: hipFuncSetAttribute failed\n"); grid = -1; return; }
        if (hipOccupancyMaxActiveBlocksPerMultiprocessor(&per_cu, (const void*)hymba_fwd, NTHR, LDS_BYTES) != hipSuccess || per_cu < 1)
            fprintf(stderr, "kernel_launch: note: occupancy query reports %d workgroups per CU\n", per_cu);
        (void)hipGetLastError();
        grid = cus;
    }
    if (grid < 0) return;
    (void)hipMemsetAsync((char*)d_ws + WS_CTL, 0, CTL_BYTES, stream);
    Params prm{};
    for (int i = 0; i < N_IN; ++i) prm.in[i] = (const float*)d_in[i];
    prm.out = (float*)d_out; prm.ws = (unsigned char*)d_ws;
#if N_LAUNCH_MODE == 1
    prm.ph_lo = 0; prm.ph_hi = N_PHASES;
    hipLaunchKernelGGL(hymba_fwd, dim3(grid), dim3(NTHR), LDS_BYTES, stream, prm);
#else
    for (int ph = 0; ph < N_PHASES; ++ph) {
        prm.ph_lo = ph; prm.ph_hi = ph + 1;
        hipLaunchKernelGGL(hymba_fwd, dim3(grid), dim3(NTHR), LDS_BYTES, stream, prm);
    }
#endif
}
```

```cpp
#include <hip/hip_runtime.h>
#include <cstdio>
#include <cstdint>

namespace pg8 {
#define PG8_LAS __attribute__((address_space(3)))
typedef unsigned short bf16_t;
typedef short bf16x8 __attribute__((ext_vector_type(8)));
typedef float f32x4 __attribute__((ext_vector_type(4)));
typedef unsigned u32x4 __attribute__((ext_vector_type(4)));
constexpr int BM = 256, BK = 64, HALF = 128, HTB = HALF * BK * 2  , STAGE_BYTES = 8 * HTB, NXCD = 8, WGM = 8;

__host__ __device__ __forceinline__ int lds_byte(int r, int c) { const int st = (r >> 4) * 2 + (c >> 5), rr = r & 15, cc = c & 31, ob = rr * 64 + cc * 2; return st * 1024 + (ob ^ (((ob >> 9) & 1) << 5)); }
__host__ __device__ __forceinline__ void stage_rc(int b, int& R, int& C) { const int st = b / 1024, sb = b % 1024, swz = sb ^ (((sb >> 9) & 1) << 5); R = (st >> 1) * 16 + swz / 64; C = (st & 1) * 32 + (swz % 64) / 2; }
__host__ __device__ __forceinline__ int perm32(int rho) { const int n = rho >> 4, i = rho & 15; return 8 * (i >> 2) + 4 * n + (i & 3); }

struct Unit { int pm, pn, kt0, nt; };
struct Gemm { const bf16_t* A; const bf16_t* Bt; int M, N, K; };

struct StaticOrder {
    int nM, nN, nwg, G, c;
    __host__ __device__ __forceinline__ void init(int M, int N, int G_, int c_) { nM = M / BM; nN = N / BM; nwg = nM * nN; G = G_; c = c_; }
    __host__ __device__ __forceinline__ bool next(int i, Unit& u) const {
        const long L = (long)i * G + c; if (L >= nwg) return false;
        int wgid = (int)L; { const int q = nwg / NXCD, r = nwg % NXCD, xcd = wgid % NXCD, off = wgid / NXCD; wgid = (xcd < r ? xcd * (q + 1) : r * (q + 1) + (xcd - r) * q) + off; }
        const int nig = WGM * nN, gid = wgid / nig, fm = gid * WGM, gsz = (nM - fm) < WGM ? (nM - fm) : WGM;
        u.pm = fm + ((wgid % nig) % gsz); u.pn = (wgid % nig) / gsz; u.kt0 = 0; u.nt = 0; return true;
    }
    __device__ __forceinline__ void a_ready(const Unit&) const {}
    __device__ __forceinline__ void done(const Unit&) const {}
};

__device__ __forceinline__ unsigned cvt_pk_bf16(float lo, float hi) { unsigned r; asm volatile("v_cvt_pk_bf16_f32 %0, %1, %2" : "=v"(r) : "v"(lo), "v"(hi)); return r; }
struct EpiF32 {
    static constexpr bool PERM = true, AFTER_DRAIN = false;
    float* O; int ldc;
    __device__ __forceinline__ void operator()(const f32x4 (&acc)[2][2][4][2], const Unit& u, int wr, int wc, int fr, int fq) const {
        const int row0 = u.pm * BM + wr * 64 + fr; const int col0 = u.pn * BM + wc * 32 + 8 * fq;
#pragma unroll
        for (int ai = 0; ai < 2; ++ai)
#pragma unroll
            for (int m = 0; m < 4; ++m) { float* rowp = O + (size_t)(row0 + ai * HALF + m * 16) * ldc + col0;
#pragma unroll
                for (int bj = 0; bj < 2; ++bj) { *(f32x4*)(rowp + bj * HALF) = acc[ai][bj][m][0]; *(f32x4*)(rowp + bj * HALF + 4) = acc[ai][bj][m][1]; } }
    }
};

struct CmpOrder {
    int G, c;
    __device__ __forceinline__ bool next(int i, Unit& u) const { const int L = i * G + c; if (L >= 512) return false; u.pm = L; u.pn = L >> 6; u.kt0 = 0; u.nt = 0; return true; }
    __device__ __forceinline__ void a_ready(const Unit&) const {}
    __device__ __forceinline__ void done(const Unit&) const {}
};
struct EpiCmp {
    static constexpr bool PERM = true, AFTER_DRAIN = false;
    float* O;
    __device__ __forceinline__ void operator()(const f32x4 (&acc)[2][2][4][2], const Unit& u, int wr, int wc, int fr, int fq) const {
        const int row0 = u.pm * BM + wr * 64 + fr; const int col0 = wc * 32 + 8 * fq;
#pragma unroll
        for (int ai = 0; ai < 2; ++ai)
#pragma unroll
            for (int m = 0; m < 4; ++m) { float* rowp = O + (size_t)(row0 + ai * HALF + m * 16) * 256 + col0;
#pragma unroll
                for (int bj = 0; bj < 2; ++bj) { *(f32x4*)(rowp + bj * HALF) = acc[ai][bj][m][0]; *(f32x4*)(rowp + bj * HALF + 4) = acc[ai][bj][m][1]; } }
    }
};

struct EpiB16 {
    static constexpr bool PERM = true, AFTER_DRAIN = false;
    bf16_t* O; int ldc;
    __device__ __forceinline__ void operator()(const f32x4 (&acc)[2][2][4][2], const Unit& u, int wr, int wc, int fr, int fq) const {
        const int row0 = u.pm * BM + wr * 64 + fr; const int col0 = u.pn * BM + wc * 32 + 8 * fq;
#pragma unroll
        for (int ai = 0; ai < 2; ++ai)
#pragma unroll
            for (int m = 0; m < 4; ++m) { bf16_t* rowp = O + (size_t)(row0 + ai * HALF + m * 16) * ldc + col0;
#pragma unroll
                for (int bj = 0; bj < 2; ++bj) { const f32x4 v0 = acc[ai][bj][m][0], v1 = acc[ai][bj][m][1];
                    u32x4 w; w.x = cvt_pk_bf16(v0[0], v0[1]); w.y = cvt_pk_bf16(v0[2], v0[3]); w.z = cvt_pk_bf16(v1[0], v1[1]); w.w = cvt_pk_bf16(v1[2], v1[3]);
                    *(u32x4*)(rowp + bj * HALF) = w; } }
    }
};

struct TailSplitOrder {
    StaticOrder P; int nN, ntf, split;
    __device__ __forceinline__ void init(int Mp, int N, int K, int split_, int G, int c) { P.init(Mp, N, G, c); nN = N / BM; ntf = K / BK; split = split_; }
    __device__ __forceinline__ bool next(int i, Unit& u) const {
        const int L = i * P.G + P.c; const bool isp = L < P.nwg;
        int wgid = isp ? L : 0; { const int q = P.nwg / NXCD, r = P.nwg % NXCD, xcd = wgid % NXCD, off = wgid / NXCD; wgid = (xcd < r ? xcd * (q + 1) : r * (q + 1) + (xcd - r) * q) + off; }
        const int nig = WGM * P.nN, gid = wgid / nig, fm = gid * WGM, gsz = (P.nM - fm) < WGM ? (P.nM - fm) : WGM;
        const int ppm = fm + ((wgid % nig) % gsz), ppn = (wgid % nig) / gsz;
        const int t = L - P.nwg, nts = ntf / split;
        u.pm = isp ? ppm : P.nM; u.pn = isp ? ppn : t % nN; u.nt = isp ? 0 : nts; u.kt0 = isp ? 0 : (t / nN) * nts;
        return isp || t < nN * split;
    }
    __device__ __forceinline__ void a_ready(const Unit&) const {}
    __device__ __forceinline__ void done(const Unit&) const {}
};
struct EpiB16Split {
    static constexpr bool PERM = true, AFTER_DRAIN = false;
    bf16_t* O; float* S; int ldc; int tail_pm;
    __device__ __forceinline__ void operator()(const f32x4 (&acc)[2][2][4][2], const Unit& u, int wr, int wc, int fr, int fq) const {
        const int col0 = u.pn * BM + wc * 32 + 8 * fq;
        if (u.pm < tail_pm) {
            bf16_t* base = O + (size_t)(u.pm * BM + wr * 64 + fr) * ldc + col0;
#pragma unroll
            for (int ai = 0; ai < 2; ++ai)
#pragma unroll
                for (int m = 0; m < 4; ++m) { bf16_t* rowp = base + (size_t)(ai * HALF + m * 16) * ldc;
#pragma unroll
                    for (int bj = 0; bj < 2; ++bj) { const f32x4 v0 = acc[ai][bj][m][0], v1 = acc[ai][bj][m][1];
                        u32x4 w; w.x = cvt_pk_bf16(v0[0], v0[1]); w.y = cvt_pk_bf16(v0[2], v0[3]); w.z = cvt_pk_bf16(v1[0], v1[1]); w.w = cvt_pk_bf16(v1[2], v1[3]);
                        *(u32x4*)(rowp + bj * HALF) = w; } }
        } else {
            float* base = S + ((size_t)(u.kt0 / (u.nt ? u.nt : 1)) * BM + wr * 64 + fr) * ldc + col0;
#pragma unroll
            for (int ai = 0; ai < 2; ++ai)
#pragma unroll
                for (int m = 0; m < 4; ++m) { float* rowp = base + (size_t)(ai * HALF + m * 16) * ldc;
#pragma unroll
                    for (int bj = 0; bj < 2; ++bj) { *(f32x4*)(rowp + bj * HALF) = acc[ai][bj][m][0]; *(f32x4*)(rowp + bj * HALF + 4) = acc[ai][bj][m][1]; } }
        }
    }
};
struct EpiF32Split {
    static constexpr bool PERM = true, AFTER_DRAIN = false;
    float* O; float* S; int ldc; int tail_pm;
    __device__ __forceinline__ void operator()(const f32x4 (&acc)[2][2][4][2], const Unit& u, int wr, int wc, int fr, int fq) const {
        const int col0 = u.pn * BM + wc * 32 + 8 * fq;
        float* base = (u.pm < tail_pm) ? O + (size_t)(u.pm * BM + wr * 64 + fr) * ldc : S + ((size_t)(u.kt0 / (u.nt ? u.nt : 1)) * BM + wr * 64 + fr) * ldc;
#pragma unroll
        for (int ai = 0; ai < 2; ++ai)
#pragma unroll
            for (int m = 0; m < 4; ++m) { float* rowp = base + (size_t)(ai * HALF + m * 16) * ldc + col0;
#pragma unroll
                for (int bj = 0; bj < 2; ++bj) { *(f32x4*)(rowp + bj * HALF) = acc[ai][bj][m][0]; *(f32x4*)(rowp + bj * HALF + 4) = acc[ai][bj][m][1]; } }
    }
};

__device__ __forceinline__ float dpp_ror1(float v) { return __builtin_bit_cast(float, __builtin_amdgcn_update_dpp(0, __builtin_bit_cast(int, v), 0x121, 0xf, 0xf, false)); }
__device__ __forceinline__ float dpp_ror2(float v) { return __builtin_bit_cast(float, __builtin_amdgcn_update_dpp(0, __builtin_bit_cast(int, v), 0x122, 0xf, 0xf, false)); }
__device__ __forceinline__ float dpp_shr1(float old, float v) { return __builtin_bit_cast(float, __builtin_amdgcn_update_dpp(__builtin_bit_cast(int, old), __builtin_bit_cast(int, v), 0x111, 0xf, 0xf, false)); }
__device__ __forceinline__ float dpp_shr2(float old, float v) { return __builtin_bit_cast(float, __builtin_amdgcn_update_dpp(__builtin_bit_cast(int, old), __builtin_bit_cast(int, v), 0x112, 0xf, 0xf, false)); }
__device__ __forceinline__ float gelu_t(float x) {
    const float p = x * __builtin_fmaf(x * x, 0.044715f * 2.302208198f, 2.302208198f);
    return x * __builtin_amdgcn_rcpf(1.f + __builtin_amdgcn_exp2f(-p));
}
struct EpiFfn {
    static constexpr bool PERM = true, AFTER_DRAIN = false;
    bf16_t* ACT;
    float* RAW;
    float* HALO;
    float* LAST;
    const float* cw; const float* cb;
    PG8_LAS float* xb;
    int tail_pm;
    __device__ __forceinline__ void operator()(const f32x4 (&acc)[2][2][4][2], const Unit& u, int wr, int wc, int fr_in, int fq_in) const {
        int fr = fr_in, fq = fq_in; asm volatile("" : "+v"(fr), "+v"(fq));
        const int colt = wc * 32 + 8 * fq, gcol = u.pn * 128 + colt;
        const bool tail = (u.pm >= tail_pm);
#pragma unroll
        for (int ai = 0; ai < 2; ++ai) {
            if (fr >= 14) { PG8_LAS float* d = xb + ((ai * 2 + wr) * 2 + (fr - 14)) * 128 + colt;
                *(PG8_LAS f32x4*)d = acc[ai][0][3][0]; *(PG8_LAS f32x4*)(d + 4) = acc[ai][0][3][1]; }
        }
        if (!tail) {
            if (wr == 1 && fr >= 14) { float* d = LAST + ((size_t)u.pm * 2 + (fr - 14)) * 4096 + gcol; *(f32x4*)d = acc[1][0][3][0]; *(f32x4*)(d + 4) = acc[1][0][3][1]; }
            if (wr == 0 && fr < 2) { float* d = HALO + ((size_t)u.pm * 2 + fr) * 8192 + gcol;
                *(f32x4*)d = acc[0][0][0][0]; *(f32x4*)(d + 4) = acc[0][0][0][1]; *(f32x4*)(d + 4096) = acc[0][1][0][0]; *(f32x4*)(d + 4096 + 4) = acc[0][1][0][1]; }
        } else {
#pragma unroll
            for (int ai = 0; ai < 2; ++ai)
#pragma unroll
                for (int m = 0; m < 4; ++m) { float* d = RAW + ((size_t)(u.kt0 / (u.nt ? u.nt : 1)) * BM + ai * HALF + wr * 64 + m * 16 + fr) * 8192 + gcol;
                    *(f32x4*)d = acc[ai][0][m][0]; *(f32x4*)(d + 4) = acc[ai][0][m][1]; *(f32x4*)(d + 4096) = acc[ai][1][m][0]; *(f32x4*)(d + 4096 + 4) = acc[ai][1][m][1]; }
        }
        asm volatile("s_waitcnt lgkmcnt(0)" ::: "memory");
        __builtin_amdgcn_s_barrier();
        if (tail) return;
#pragma unroll
        for (int n = 0; n < 2; ++n) {
            const f32x4 w0 = *(const f32x4*)(cw + gcol + 4 * n), w1 = *(const f32x4*)(cw + 4096 + gcol + 4 * n), w2 = *(const f32x4*)(cw + 8192 + gcol + 4 * n), bb = *(const f32x4*)(cb + gcol + 4 * n);
#pragma unroll
            for (int ai = 0; ai < 2; ++ai) {
                const int pgrp = (wr == 1) ? (ai * 2 + 0) : (0 * 2 + 1);
                const f32x4 pv = *(const PG8_LAS f32x4*)(xb + (pgrp * 2 + (fr == 15 ? 1 : 0)) * 128 + colt + 4 * n);
#pragma unroll
                for (int m = 0; m < 4; ++m) {
                    float a4[4];
#pragma unroll
                    for (int k = 0; k < 4; ++k) {
                        const float cur = acc[ai][0][m][n][k]; const float prm = (m > 0) ? acc[ai][0][m > 0 ? m - 1 : 0][n][k] : pv[k];
                        const float p1 = dpp_shr1(dpp_ror1(prm), cur), p2 = dpp_shr2(dpp_ror2(prm), cur);
                        const float pre = w0[k] * p2 + w1[k] * p1 + w2[k] * cur + bb[k];
                        a4[k] = gelu_t(pre) * acc[ai][1][m][n][k];
                    }
                    const bool deferred = (ai == 0 && wr == 0 && m == 0 && fr < 2);
                    if (!deferred) *(unsigned long long*)(ACT + (size_t)(u.pm * BM + ai * HALF + wr * 64 + m * 16 + fr) * 4096 + gcol + 4 * n) =
                        (unsigned long long)cvt_pk_bf16(a4[0], a4[1]) | ((unsigned long long)cvt_pk_bf16(a4[2], a4[3]) << 32);
                }
            }
        }
    }
};
template <class Epi, class Sched, bool ALIGN_EPI = false, bool SP2 = false>
__device__ __forceinline__ void gemm_phase(PG8_LAS unsigned char* lds, const Gemm g, const Sched& S, const Epi& E, const int tid_in) {
    int tid_ = tid_in; asm volatile("" : "+v"(tid_));
    const int tid = tid_, wid = __builtin_amdgcn_readfirstlane(tid >> 6), lane = tid & 63, wr = wid >> 2, wc = wid & 3, fr = lane & 15, fq = lane >> 4;
    const int K = g.K, ntf = K / BK;
    unsigned voffA[2], voffB[2];
#pragma unroll
    for (int i = 0; i < 2; ++i) { int R, C; stage_rc(tid * 16 + i * 8192, R, C); const int Rb = Epi::PERM ? ((R & ~31) + perm32(R & 31)) : R;
        voffA[i] = (unsigned)(R * K + C) * 2u; voffB[i] = (unsigned)(Rb * K + C) * 2u; }
    const size_t kstep = (size_t)(BK * 2);
    const size_t hstep = (size_t)HALF * K * 2;
    const size_t tstep = 2 * hstep;
    const unsigned ldsw = (unsigned)wid * 1024u;
    const int aoff = lds_byte(wr * 64 + fr, fq * 8), boff = lds_byte(wc * 32 + fr, fq * 8);
#define PG8_SA(b, h) (((b) * 2 + (h)) * HTB)
#define PG8_SB(b, h) ((4 + (b) * 2 + (h)) * HTB)
#define PG8_STAGE(bufoff, gbase, voff) do { _Pragma("unroll") for (int _i = 0; _i < 2; ++_i) \
        __builtin_amdgcn_global_load_lds((const unsigned*)((const char*)(gbase) + (voff)[_i]), (PG8_LAS unsigned*)(lds + (bufoff) + ldsw + _i * 8192), 16, 0, 0); } while (0)
#define PG8_LDA(dst, b, h) do { _Pragma("unroll") for (int m = 0; m < 4; ++m) _Pragma("unroll") for (int k = 0; k < 2; ++k) dst[m][k] = *(const PG8_LAS bf16x8*)(lds + PG8_SA(b, h) + aoff + m * 2048 + k * 1024); } while (0)
#define PG8_LDB(dst, b, h) do { _Pragma("unroll") for (int n = 0; n < 2; ++n) _Pragma("unroll") for (int k = 0; k < 2; ++k) dst[n][k] = *(const PG8_LAS bf16x8*)(lds + PG8_SB(b, h) + boff + n * 2048 + k * 1024); } while (0)
#define PG8_MMA(ai, bj, At, Bt) do { __builtin_amdgcn_s_setprio(1); _Pragma("unroll") for (int m = 0; m < 4; ++m) _Pragma("unroll") for (int n = 0; n < 2; ++n) _Pragma("unroll") for (int k = 0; k < 2; ++k) \
        acc[ai][bj][m][n] = __builtin_amdgcn_mfma_f32_16x16x32_bf16(Bt[n][k], At[m][k], acc[ai][bj][m][n], 0, 0, 0); __builtin_amdgcn_s_setprio(0); } while (0)
#define PG8_WAIT_V(n) asm volatile("s_waitcnt vmcnt(" #n ")" ::: "memory")
#define PG8_WAIT_L(n) asm volatile("s_waitcnt lgkmcnt(" #n ")" ::: "memory")
#define PG8_BAR __builtin_amdgcn_s_barrier()
#define PG8_SCHED __builtin_amdgcn_sched_barrier(0)
    Unit cur = {0, 0, 0, 0}, nxt = {0, 0, 0, 0}; int ui = 0;
    if (!S.next(0, cur)) return;
    f32x4 acc[2][2][4][2];
#pragma unroll
    for (int a = 0; a < 2; ++a)
#pragma unroll
        for (int b = 0; b < 2; ++b)
#pragma unroll
            for (int m = 0; m < 4; ++m)
#pragma unroll
                for (int n = 0; n < 2; ++n) acc[a][b][m][n] = (f32x4){0.f, 0.f, 0.f, 0.f};
    bf16x8 At[4][2], B0[2][2], B1[2][2];
    const char* cA = (const char*)g.A + (size_t)cur.pm * tstep + (size_t)cur.kt0 * kstep; const char* cB = (const char*)g.Bt + (size_t)cur.pn * tstep + (size_t)cur.kt0 * kstep;
    S.a_ready(cur);
    if constexpr (SP2) {
        PG8_STAGE(PG8_SB(0, 0), cB, voffB); PG8_STAGE(PG8_SB(0, 1), cB + hstep, voffB); PG8_STAGE(PG8_SA(0, 0), cA, voffA); PG8_STAGE(PG8_SA(0, 1), cA + hstep, voffA);
        if (wr == 1) PG8_BAR;
        PG8_WAIT_V(2); PG8_BAR;
        PG8_STAGE(PG8_SB(1, 0), cB + kstep, voffB); PG8_STAGE(PG8_SA(1, 0), cA + kstep, voffA); PG8_STAGE(PG8_SB(1, 1), cB + hstep + kstep, voffB);
        PG8_WAIT_V(6); PG8_BAR;
    } else {
        PG8_STAGE(PG8_SB(0, 0), cB, voffB); PG8_STAGE(PG8_SA(0, 0), cA, voffA); PG8_STAGE(PG8_SB(0, 1), cB + hstep, voffB); PG8_STAGE(PG8_SA(0, 1), cA + hstep, voffA);
        if (wr == 1) PG8_BAR;
        PG8_WAIT_V(4); PG8_BAR;
        PG8_STAGE(PG8_SB(1, 0), cB + kstep, voffB); PG8_STAGE(PG8_SA(1, 0), cA + kstep, voffA); PG8_STAGE(PG8_SB(1, 1), cB + hstep + kstep, voffB);
        PG8_WAIT_V(6); PG8_BAR;
    }
    for (;;) {
        const bool has_next = S.next(ui + 1, nxt);
        const char* nA = has_next ? (const char*)g.A + (size_t)nxt.pm * tstep + (size_t)nxt.kt0 * kstep : cA; const char* nB = has_next ? (const char*)g.Bt + (size_t)nxt.pn * tstep + (size_t)nxt.kt0 * kstep : cB;
        const int nt = cur.nt ? cur.nt : ntf;
        for (int t = 0; t < nt; t += 2) {
            const bool last = (t == nt - 2);
            const char* a1 = cA + (size_t)(t + 1) * kstep;
            const char* a2 = last ? nA : cA + (size_t)(t + 2) * kstep; const char* b2 = last ? nB : cB + (size_t)(t + 2) * kstep;
            const char* a3 = a2 + kstep; const char* b3 = b2 + kstep;
            if (last && has_next) S.a_ready(nxt);
            if constexpr (SP2) {
            PG8_LDB(B0, 0, 0); PG8_LDB(B1, 0, 1); PG8_SCHED; PG8_LDA(At, 0, 0); PG8_STAGE(PG8_SA(1, 1), a1 + hstep, voffA);
            PG8_WAIT_V(8); PG8_WAIT_L(0); PG8_BAR; PG8_MMA(0, 0, At, B0); PG8_MMA(0, 1, At, B1); PG8_BAR; PG8_SCHED;
            PG8_LDA(At, 0, 1); PG8_STAGE(PG8_SB(0, 0), b2, voffB); PG8_STAGE(PG8_SB(0, 1), b2 + hstep, voffB); PG8_STAGE(PG8_SA(0, 0), a2, voffA);
            PG8_WAIT_V(8); PG8_WAIT_L(0); PG8_BAR; PG8_MMA(1, 0, At, B0); PG8_MMA(1, 1, At, B1); PG8_BAR; PG8_SCHED;
            PG8_LDB(B0, 1, 0); PG8_LDB(B1, 1, 1); PG8_SCHED; PG8_LDA(At, 1, 0); PG8_STAGE(PG8_SA(0, 1), a2 + hstep, voffA);
            PG8_WAIT_V(8); PG8_WAIT_L(0); PG8_BAR; PG8_MMA(0, 0, At, B0); PG8_MMA(0, 1, At, B1); PG8_BAR; PG8_SCHED;
            PG8_LDA(At, 1, 1); PG8_STAGE(PG8_SB(1, 0), b3, voffB); PG8_STAGE(PG8_SB(1, 1), b3 + hstep, voffB); PG8_STAGE(PG8_SA(1, 0), a3, voffA);
            PG8_WAIT_V(8); PG8_WAIT_L(0); PG8_BAR; PG8_MMA(1, 0, At, B0); PG8_MMA(1, 1, At, B1); PG8_BAR; PG8_SCHED;
            } else {
            PG8_LDB(B0, 0, 0); PG8_SCHED; PG8_LDA(At, 0, 0); PG8_STAGE(PG8_SA(1, 1), a1 + hstep, voffA);
            PG8_WAIT_L(8); PG8_BAR; PG8_WAIT_L(0); PG8_MMA(0, 0, At, B0); PG8_BAR; PG8_SCHED;
            PG8_LDB(B1, 0, 1); PG8_STAGE(PG8_SB(0, 0), b2, voffB);
            PG8_BAR; PG8_WAIT_L(0); PG8_MMA(0, 1, At, B1); PG8_BAR;
            PG8_LDA(At, 0, 1); PG8_STAGE(PG8_SA(0, 0), a2, voffA);
            PG8_BAR; PG8_WAIT_L(0); PG8_MMA(1, 0, At, B0); PG8_BAR; PG8_SCHED;
            PG8_STAGE(PG8_SB(0, 1), b2 + hstep, voffB);
            PG8_WAIT_V(6); PG8_BAR; PG8_MMA(1, 1, At, B1); PG8_BAR;
            PG8_LDB(B0, 1, 0); PG8_SCHED; PG8_LDA(At, 1, 0); PG8_STAGE(PG8_SA(0, 1), a2 + hstep, voffA);
            PG8_WAIT_L(8); PG8_BAR; PG8_WAIT_L(0); PG8_MMA(0, 0, At, B0); PG8_BAR; PG8_SCHED;
            PG8_LDB(B1, 1, 1); PG8_STAGE(PG8_SB(1, 0), b3, voffB);
            PG8_BAR; PG8_WAIT_L(0); PG8_MMA(0, 1, At, B1); PG8_BAR;
            PG8_LDA(At, 1, 1); PG8_STAGE(PG8_SA(1, 0), a3, voffA);
            PG8_BAR; PG8_WAIT_L(0); PG8_MMA(1, 0, At, B0); PG8_BAR; PG8_SCHED;
            PG8_STAGE(PG8_SB(1, 1), b3 + hstep, voffB);
            PG8_WAIT_V(6); PG8_BAR; PG8_MMA(1, 1, At, B1); PG8_BAR;
            }
        }
        if constexpr (ALIGN_EPI) { if (wr == 0) PG8_BAR; }
        if constexpr (!Epi::AFTER_DRAIN) { E(acc, cur, wr, wc, fr, fq); S.done(cur); }
        if (!has_next) break;
#pragma unroll
        for (int a = 0; a < 2; ++a)
#pragma unroll
            for (int b = 0; b < 2; ++b)
#pragma unroll
                for (int m = 0; m < 4; ++m)
#pragma unroll
                    for (int n = 0; n < 2; ++n) acc[a][b][m][n] = (f32x4){0.f, 0.f, 0.f, 0.f};
        cur = nxt; cA = nA; cB = nB; ++ui;
        if constexpr (ALIGN_EPI) { if (wr == 1) PG8_BAR; }
    }
    PG8_WAIT_V(0);
    if constexpr (!ALIGN_EPI) { if (wr == 0) PG8_BAR; }
    PG8_BAR;
    if constexpr (Epi::AFTER_DRAIN) { E.fused(acc, cur, wr, wc, fr, fq, lds, wid, lane); S.done(cur); }
#undef PG8_SA
#undef PG8_SB
#undef PG8_STAGE
#undef PG8_LDA
#undef PG8_LDB
#undef PG8_MMA
#undef PG8_WAIT_V
#undef PG8_WAIT_L
#undef PG8_BAR
#undef PG8_SCHED
}
}

#define GAS __attribute__((address_space(1)))
#define LAS __attribute__((address_space(3)))
typedef unsigned short bf16;
typedef unsigned v4u __attribute__((ext_vector_type(4)));
typedef float f32x4 __attribute__((ext_vector_type(4)));
typedef short bf16x8 __attribute__((ext_vector_type(8)));

constexpr int DM = 1024, BP = 8, TP = 2048, DEPTH = 4, BS = 32, TS = 8, PAST = 8192, PAGE = 128;
constexpr int NP = BP * TP, NS = BS * TS, MROWS = NP + NS;
constexpr int NSEQ = BP + BS;
constexpr int SSD_W = 512, SSD_H = 8, SSD_HD = 64, SSD_N = 128, CONV_DIM = 1024;
constexpr int POOL_W = 256, POOL_KEEP = 15;
constexpr int NSA_H = 4, NSA_HD = 64;
constexpr int OFF_XBC = 512, OFF_DT = 1536, OFF_POOL = 1544, OFF_Q = 1800, OFF_KV = 2056, OFF_G = 2440, IN_W = 2452, IN_WP = 2560;
constexpr int DFF = 4096;
constexpr int NPHYS = 2560, NPAGES = 64;
constexpr int NCMP_P = 127, NCMP_S = 511;
constexpr float RMS_EPS = 1e-6f;

constexpr size_t O_YP = 0;
constexpr size_t O_YS = O_YP + (size_t)NP * DM;
constexpr size_t O_KVP = O_YS + (size_t)NS * DM;
constexpr size_t O_KVS = O_KVP + (size_t)DEPTH * NP * 256;
constexpr size_t O_WINP = O_KVS + (size_t)DEPTH * NS * 256;
constexpr size_t O_WINS = O_WINP + (size_t)DEPTH * BP * 512 * 128;
constexpr size_t O_CONVP = O_WINS + (size_t)DEPTH * BS * 512 * 128;
constexpr size_t O_CONVS = O_CONVP + (size_t)DEPTH * BP * 3 * 1024;
constexpr size_t O_SSMP = O_CONVS + (size_t)DEPTH * BS * 3 * 1024;
constexpr size_t O_SSMS = O_SSMP + (size_t)DEPTH * BP * 8 * 64 * 128;
constexpr size_t O_POOLP = O_SSMS + (size_t)DEPTH * BS * 8 * 64 * 128;
constexpr size_t O_POOLS = O_POOLP + (size_t)DEPTH * BP * 15 * 256;
constexpr size_t O_FFNP = O_POOLS + (size_t)DEPTH * BS * 15 * 256;
constexpr size_t O_FFNS = O_FFNP + (size_t)DEPTH * BP * 2 * 4096;
constexpr size_t O_END = O_FFNS + (size_t)DEPTH * BS * 2 * 4096;

enum { I_XP = 0, I_XS, I_CACHE, I_PT, I_SWIN, I_SCONV, I_SSM, I_SPOOL, I_SFFN, I_NMPRE, I_WIN, I_CONVW, I_CONVB, I_DTB, I_ALOG, I_SSDD, I_SSDNORM,
       I_POOLW, I_POOLSC, I_PEK, I_PEV, I_W1K, I_W1V, I_W2K, I_W2V, I_WOUT, I_NMPOST, I_NFPRE, I_WGATE, I_WVAL, I_FCW, I_FCB, I_WDOWN, I_NFPOST, N_IN };

constexpr size_t al256(size_t x) { return (x + 255) & ~(size_t)255; }
constexpr size_t WS_CTL = 0, CTL_BYTES = 1u << 20;
constexpr size_t WS_WTIN = WS_CTL + CTL_BYTES;
constexpr size_t WS_WTOUT = WS_WTIN + (size_t)DEPTH * IN_WP * DM * 2;
constexpr size_t WS_WTUP = WS_WTOUT + (size_t)DEPTH * DM * DM * 2;
constexpr size_t WS_WTDN = WS_WTUP + (size_t)DEPTH * 2 * DFF * DM * 2;
constexpr size_t WS_ROPE = WS_WTDN + (size_t)DEPTH * DM * DFF * 2;
constexpr size_t WS_X = WS_ROPE + al256((size_t)2056 * 16 * 4);
constexpr size_t WS_XN = WS_X + (size_t)MROWS * DM * 4;
constexpr size_t WS_PROJ = WS_XN + (size_t)MROWS * DM * 2;
constexpr size_t WS_YSSD = WS_PROJ + (size_t)MROWS * IN_WP * 4;
constexpr size_t WS_Q = WS_YSSD + (size_t)MROWS * SSD_W * 4;
constexpr size_t WS_KWIN = WS_Q + (size_t)MROWS * 256 * 4;
constexpr size_t WS_CKP = WS_KWIN + (size_t)MROWS * 128 * 4;
constexpr size_t WS_CVP = WS_CKP + al256((size_t)BP * NCMP_P * 64 * 4);
constexpr size_t WS_CKS = WS_CVP + al256((size_t)BP * NCMP_P * 64 * 4);
constexpr size_t WS_CVS = WS_CKS + al256((size_t)DEPTH * BS * NCMP_S * 64 * 4);
constexpr size_t WS_MIX = WS_CVS + al256((size_t)DEPTH * BS * NCMP_S * 64 * 4);
constexpr size_t WS_MIXO = WS_MIX + (size_t)MROWS * DM * 2;
constexpr size_t WS_GV = WS_MIXO + (size_t)MROWS * DM * 4;
constexpr size_t WS_ACT = WS_GV + (size_t)MROWS * 2 * DFF * 4;
constexpr size_t WS_QB = WS_ACT + (size_t)MROWS * DFF * 2;
constexpr size_t WS_SAC = WS_QB + (size_t)MROWS * 256 * 2;
constexpr size_t WS_SCD = WS_SAC + (size_t)NP * 8 * 4;
constexpr size_t WS_SCB = WS_SCD + al256((size_t)BP * 16 * 8 * 4);
constexpr size_t WS_SCS = WS_SCB + (size_t)NP * 256 * 2;
constexpr size_t WS_SHS = WS_SCS + (size_t)BP * 16 * 8 * 8192 * 4;
constexpr size_t WS_WTC = WS_SHS + (size_t)BP * 16 * 8 * 8192 * 2;
constexpr size_t WS_CBIAS = WS_WTC + (size_t)8 * 256 * 1024 * 2;
constexpr size_t WS_AS = WS_GV;
constexpr size_t WS_HS = WS_AS + (size_t)8 * BS * 512 * 1024 * 2;
static_assert(WS_HS + (size_t)8 * BS * 512 * 256 * 4 <= WS_GV + (size_t)MROWS * 2 * DFF * 4, "prologue buffers must fit inside the GV region");
constexpr size_t WS_SLAB = WS_CBIAS + 8 * 128 * 4;
constexpr size_t WS_W2T = WS_SLAB + (size_t)8 * 256 * DM * 4;
constexpr size_t WS_FRAW = WS_W2T + (size_t)8 * 64 * 128 * 2;
constexpr int SPLIT_UP = 1;
constexpr size_t WS_FHALO = WS_FRAW + (size_t)SPLIT_UP * 256 * 2 * DFF * 4;
constexpr size_t WS_FLAST = WS_FHALO + (size_t)64 * 2 * 2 * DFF * 4;
constexpr size_t WS_END = WS_FLAST + (size_t)64 * 2 * DFF * 4;
constexpr int SPLIT_OUT = 4, SPLIT_DOWN = 8;

constexpr int RING_BYTES = 131072;
constexpr int MISC_OFF = RING_BYTES + 320;
constexpr int LDS_BYTES = 147456;
constexpr int NWAVES = 8, NTHR = 512;
constexpr int XB_OFF = RING_BYTES + 1024;
static_assert(XB_OFF + 4096 <= LDS_BYTES, "LDS map");

constexpr int PH_PER_LAYER = 10, N_PRO = 3, N_PHASES = N_PRO + DEPTH * PH_PER_LAYER;

struct Params { const float* in[N_IN]; float* out; unsigned char* ws; int ph_lo, ph_hi; };

__device__ __forceinline__ unsigned f2bf(float f) { unsigned u = __builtin_bit_cast(unsigned, f); return (u + 0x7fffu + ((u >> 16) & 1u)) >> 16; }
__device__ __forceinline__ unsigned pk2(float lo, float hi) { return f2bf(lo) | (f2bf(hi) << 16); }
__device__ __forceinline__ f32x4 bf4_to_f32(unsigned long long u) {
    return (f32x4){__uint_as_float((unsigned)u << 16), __uint_as_float((unsigned)u & 0xffff0000u), __uint_as_float((unsigned)(u >> 32) << 16), __uint_as_float((unsigned)(u >> 32) & 0xffff0000u)};
}
__device__ __forceinline__ float wave_sum(float v) {
#pragma unroll
    for (int o = 1; o < 64; o <<= 1) v += __shfl_xor(v, o);
    return v;
}
__device__ __forceinline__ float sum16(float v) {
#pragma unroll
    for (int o = 1; o < 16; o <<= 1) v += __shfl_xor(v, o);
    return v;
}
__device__ __forceinline__ float sigmoidf_(float x) { return 1.f / (1.f + expf(-x)); }
__device__ __forceinline__ float siluf_(float x) { return x / (1.f + expf(-x)); }
__device__ __forceinline__ float softplusf_(float x) { return x > 0.f ? x + log1pf(expf(-x)) : log1pf(expf(x)); }
__device__ __forceinline__ float gelu_tanh(float x) {
    const float u = 0.7978845608028654f * (x + 0.044715f * x * x * x);
    const float t = 1.f - 2.f / (expf(2.f * u) + 1.f);
    return 0.5f * x * (1.f + t);
}
__device__ __forceinline__ void cossin_d(float angf, float& c, float& s) {
    const double a = (double)angf;
    const double k = rint(a * 0.63661977236758134308);
    const double r = (a - k * 1.57079632679489655800) - k * 6.123233995736766036e-17;
    const double r2 = r * r;
    double sp = r * (1.0 + r2 * (-1.0 / 6 + r2 * (1.0 / 120 + r2 * (-1.0 / 5040 + r2 * (1.0 / 362880 + r2 * (-1.0 / 39916800 + r2 * (1.0 / 6227020800.0)))))));
    double cp = 1.0 + r2 * (-0.5 + r2 * (1.0 / 24 + r2 * (-1.0 / 720 + r2 * (1.0 / 40320 + r2 * (-1.0 / 3628800 + r2 * (1.0 / 479001600.0 + r2 * (-1.0 / 87178291200.0)))))));
    const int q = ((int)k) & 3;
    double cc = (q == 0) ? cp : (q == 1) ? -sp : (q == 2) ? -cp : sp;
    double ss = (q == 0) ? sp : (q == 1) ? cp : (q == 2) ? -sp : -cp;
    c = (float)cc; s = (float)ss;
}

struct Seq { int T, row0, pos0, b, samp; };
__device__ __forceinline__ Seq seq_of(int s) {
    Seq q;
    if (s < BP) { q.T = TP; q.row0 = s * TP; q.pos0 = 0; q.b = s; q.samp = 0; }
    else { q.T = TS; q.row0 = NP + (s - BP) * TS; q.pos0 = PAST; q.b = s - BP; q.samp = 1; }
    return q;
}
__device__ __forceinline__ void row_to_seq(int r, int& s, int& t) {
    if (r < NP) { s = r >> 11; t = r & (TP - 1); } else { const int q = r - NP; s = BP + (q >> 3); t = q & 7; }
}

#define XB_TMO      128
#define XB_XCNT(j)  (256  + 64 * (j))
#define XB_XSUB(j)  (1280 + 64 * (j))
#define XB_XGEN(j)  (2304 + 64 * (j))
#define XB_TOP      3328
#define XB_TOPGEN   3392
#define XCD_BAR_WORDS 3456
#define XB_SPIN_CAP (1u << 21)
__device__ __forceinline__ unsigned xb_ld(unsigned* p)              { return __hip_atomic_load(p, __ATOMIC_RELAXED, __HIP_MEMORY_SCOPE_AGENT); }
__device__ __forceinline__ unsigned xb_add(unsigned* p, unsigned v) { return __hip_atomic_fetch_add(p, v, __ATOMIC_RELAXED, __HIP_MEMORY_SCOPE_AGENT); }
__device__ __forceinline__ unsigned xb_xcc_id() { return (unsigned)__builtin_amdgcn_s_getreg((3 << 11) | 20) & 0xFu; }
#define XB_SPIN(cond, bar) do { unsigned _sp = 0; while (cond) { __builtin_amdgcn_s_sleep(1); \
    if ((++_sp & 255u) == 0u) { if (xb_ld(&(bar)[XB_TMO])) break; if (_sp > XB_SPIN_CAP) { atomicAdd(&(bar)[XB_TMO], 1u); break; } } } } while (0)
struct XcdBarrier { unsigned* bar; unsigned x; volatile LAS unsigned* st; };
__device__ __forceinline__ XcdBarrier xcd_barrier_post(unsigned* bar, volatile LAS unsigned* st) {
    XcdBarrier b; b.bar = bar; b.x = xb_xcc_id(); b.st = st;
    if (threadIdx.x == 0) (void)xb_add(&bar[XB_XCNT(b.x)], 1u);
    return b;
}
__device__ __forceinline__ void xcd_barrier_complete(unsigned* bar, unsigned x, unsigned& nloc, unsigned& nx) {
    const unsigned G = gridDim.x * gridDim.y * gridDim.z;
    unsigned sum, cnt, mine, sp = 0u;
    for (;;) {
        sum = 0u; cnt = 0u; mine = 0u;
#pragma unroll
        for (unsigned j = 0; j < 16; ++j) { const unsigned c = xb_ld(&bar[XB_XCNT(j)]); sum += c; cnt += (c > 0u) ? 1u : 0u; mine = (j == x) ? c : mine; }
        if (sum == G) break;
        __builtin_amdgcn_s_sleep(1);
        if ((++sp & 255u) == 0u) { if (xb_ld(&bar[XB_TMO])) break; if (sp > XB_SPIN_CAP) { atomicAdd(&bar[XB_TMO], 1u); break; } }
    }
    nloc = mine > 0u ? mine : 1u; nx = cnt > 0u ? cnt : 1u;
}
__device__ __forceinline__ void xcd_barrier(const XcdBarrier& b, const bool lead) {
    asm volatile("s_waitcnt vmcnt(0)" ::: "memory");
    __syncthreads();
    if (lead) {
        unsigned* bar = b.bar;
        __builtin_amdgcn_s_waitcnt(0);
        unsigned nloc = b.st[0], nx = b.st[1];
        if (nloc == 0u) { xcd_barrier_complete(bar, b.x, nloc, nx); b.st[0] = nloc; b.st[1] = nx; }
        const unsigned old = xb_add(&bar[XB_XSUB(b.x)], 1u);
        const unsigned gen = old / nloc;
        if (old + 1u == (gen + 1u) * nloc) {
            __builtin_amdgcn_fence(__ATOMIC_RELEASE, "agent");
            asm volatile("s_waitcnt vmcnt(0)" ::: "memory");
            const unsigned og = xb_add(&bar[XB_TOP], 1u);
            const unsigned tg = og / nx;
            if (og + 1u == (tg + 1u) * nx) xb_add(&bar[XB_TOPGEN], 1u);
            else XB_SPIN(xb_ld(&bar[XB_TOPGEN]) == tg, bar);
            __builtin_amdgcn_fence(__ATOMIC_ACQUIRE, "agent");
            xb_add(&bar[XB_XGEN(b.x)], 1u);
            asm volatile("s_waitcnt vmcnt(0)" ::: "memory");
        } else {
            XB_SPIN(xb_ld(&bar[XB_XGEN(b.x)]) == gen, bar);
            __builtin_amdgcn_fence(__ATOMIC_ACQUIRE, "agent");
            asm volatile("s_waitcnt vmcnt(0)" ::: "memory");
        }
    }
    __syncthreads();
}

struct Frame {
    LAS unsigned char* lds;
    int tid, lane, wave, gw, ngw, G;
    const __attribute__((address_space(4))) Params* p;
    unsigned char* ws;
    float* out;
};
#define INP(F, i) ((F).p->in[(i)])
#define WSP(F, T, off) ((T*)((F).ws + (off)))

__device__ __forceinline__ const float* x_in_row(const Frame& F, int r) {
    return r < NP ? INP(F, I_XP) + (size_t)r * DM : INP(F, I_XS) + (size_t)(r - NP) * DM;
}

template <bool ILV = false>
__device__ __forceinline__ void transpose_item(const float* W, int K, int N, int nblk, bf16* WT, int row_off, LAS float* scr, int item, int lane) {
    const int kb = item / nblk, nb = item % nblk, k0 = 64 * kb, n0 = 32 * nb;
    const int r0 = ILV ? 256 * (n0 >> 7) + (n0 & 127) : n0;
    const int n = n0 + (lane & 31);
    float tv[32];
#pragma unroll
    for (int i = 0; i < 32; ++i) { const int kk = 2 * i + (lane >> 5); tv[i] = (n < N) ? W[(size_t)(k0 + kk) * N + n] : 0.f; }
#pragma unroll
    for (int i = 0; i < 32; ++i) { const int kk = 2 * i + (lane >> 5); scr[kk * 33 + (lane & 31)] = tv[i]; }
    asm volatile("s_waitcnt lgkmcnt(0)" ::: "memory");
    const int c = lane & 7;
#pragma unroll
    for (int j = 0; j < 4; ++j) { const int nn = (lane >> 3) + 8 * j; const LAS float* s = scr + (8 * c) * 33 + nn;
        v4u o; o.x = pk2(s[0 * 33], s[1 * 33]); o.y = pk2(s[2 * 33], s[3 * 33]); o.z = pk2(s[4 * 33], s[5 * 33]); o.w = pk2(s[6 * 33], s[7 * 33]);
        *(v4u*)(WT + (size_t)(row_off + r0 + nn) * K + k0 + 8 * c) = o; }
    asm volatile("s_waitcnt lgkmcnt(0)" ::: "memory");
}
__device__ __forceinline__ void norm_row_to_bf16(const Frame& F, const float* xrow, const float* w, bf16* orow) {
    const f32x4* xr = (const f32x4*)xrow + F.lane; const f32x4* wr = (const f32x4*)w + F.lane;
    f32x4 v[4]; float ss = 0.f;
#pragma unroll
    for (int j = 0; j < 4; ++j) { v[j] = xr[64 * j]; ss += (v[j].x * v[j].x + v[j].y * v[j].y) + (v[j].z * v[j].z + v[j].w * v[j].w); }
    const float rs = 1.f / sqrtf(wave_sum(ss) * (1.f / DM) + RMS_EPS);
    unsigned long long* o8 = (unsigned long long*)orow + F.lane;
#pragma unroll
    for (int j = 0; j < 4; ++j) { const f32x4 g = wr[64 * j];
        o8[64 * j] = (unsigned long long)pk2(v[j].x * rs * g.x, v[j].y * rs * g.y) | ((unsigned long long)pk2(v[j].z * rs * g.z, v[j].w * rs * g.w) << 32); }
}
__device__ __forceinline__ void weights_layer(const Frame& F, int l, int gwi, int ngwi) {
    LAS float* scr = (LAS float*)(F.lds + F.wave * 16384);
    constexpr int IT_IN = 16 * (IN_WP / 32), IT_OUT = 16 * 32, IT_UP = 16 * 128, IT_DN = 64 * 32, IT_L = IT_IN + IT_OUT + 2 * IT_UP + IT_DN;
    for (int it = gwi; it < IT_L; it += ngwi) {
        int r = it;
        if (r < IT_IN) { transpose_item(INP(F, I_WIN) + (size_t)l * DM * IN_W, DM, IN_W, IN_WP / 32, WSP(F, bf16, WS_WTIN) + (size_t)l * IN_WP * DM, 0, scr, r, F.lane); continue; } r -= IT_IN;
        if (r < IT_OUT) { transpose_item(INP(F, I_WOUT) + (size_t)l * DM * DM, DM, DM, 32, WSP(F, bf16, WS_WTOUT) + (size_t)l * DM * DM, 0, scr, r, F.lane); continue; } r -= IT_OUT;
        if (r < IT_UP) { transpose_item<true>(INP(F, I_WGATE) + (size_t)l * DM * DFF, DM, DFF, 128, WSP(F, bf16, WS_WTUP) + (size_t)l * 2 * DFF * DM, 0, scr, r, F.lane); continue; } r -= IT_UP;
        if (r < IT_UP) { transpose_item<true>(INP(F, I_WVAL) + (size_t)l * DM * DFF, DM, DFF, 128, WSP(F, bf16, WS_WTUP) + (size_t)l * 2 * DFF * DM, 128, scr, r, F.lane); continue; } r -= IT_UP;
        transpose_item(INP(F, I_WDOWN) + (size_t)l * DFF * DM, DFF, DM, 32, WSP(F, bf16, WS_WTDN) + (size_t)l * DM * DFF, 0, scr, r, F.lane);
    }
}
__device__ __forceinline__ void phase_prologue(const Frame& F) {
    LAS float* scr = (LAS float*)(F.lds + F.wave * 16384);
    weights_layer(F, 0, F.gw, F.ngw);
    for (int it = F.gw; it < 8 * 2 * 64; it += F.ngw) {
        const int i = it >> 7, half = (it >> 6) & 1, r = it & 63; const int lyr = i >> 1, kv = i & 1;
        const float* w1 = INP(F, kv ? I_W1V : I_W1K) + (size_t)lyr * 32 * 64 * 128 + (size_t)half * 1024 * 128;
        transpose_item(w1, 1024, 128, 4, WSP(F, bf16, WS_WTC) + (size_t)i * 256 * 1024, half * 128, scr, r, F.lane);
    }
    for (int idx = blockIdx.x * NTHR + F.tid; idx < 8 * 64 * 128; idx += F.G * NTHR) {
        const int i = idx >> 13, d = (idx >> 7) & 63, e = idx & 127;
        WSP(F, bf16, WS_W2T)[idx] = (bf16)f2bf((INP(F, (i & 1) ? I_W2V : I_W2K) + (size_t)(i >> 1) * 128 * 64)[e * 64 + d]);
    }
    { const int bi = (int)((blockIdx.x + (F.G >> 1)) % F.G);
      for (int idx = bi * NTHR + F.tid; idx < 64 * 8 * 128; idx += F.G * NTHR) {
        const int ks = idx >> 10, ie = idx & 1023; const int i = ie >> 7, e = ie & 127; const int lyr = i >> 1, kv = i & 1;
        const float* w1 = INP(F, kv ? I_W1V : I_W1K) + (size_t)lyr * 32 * 64 * 128; const float* pe = INP(F, kv ? I_PEV : I_PEK) + (size_t)lyr * 32 * 64;
        float a = 0.f;
#pragma unroll 8
        for (int k = ks * 32; k < ks * 32 + 32; ++k) a += pe[k] * w1[(size_t)k * 128 + e];
        WSP(F, float, WS_SLAB)[idx] = a;
      } }
    for (int it2 = F.gw; it2 < DEPTH * BS * 256; it2 += F.ngw) {
        f32x4 a[2][2][4]; int lyrv[2], bv[2], cv[2];
#pragma unroll
        for (int u = 0; u < 2; ++u) {
            const int it = 2 * it2 + u; const int lyr = it >> 14, b = (it >> 9) & 31, c = it & 511; lyrv[u] = lyr; bv[u] = b; cv[u] = c;
            const int page = ((const int*)INP(F, I_PT))[b * NPAGES + (c >> 3)];
            const int row = F.lane >> 2, qd = F.lane & 3;
            const float* src = INP(F, I_CACHE) + ((((size_t)lyr * NPHYS + page) * PAGE + (c & 7) * 16 + row) * 4) * 64 + qd * 16;
#pragma unroll
            for (int kv = 0; kv < 2; ++kv)
#pragma unroll
                for (int k = 0; k < 4; ++k) a[u][kv][k] = *(const f32x4*)(src + kv * 64 + 4 * k);
        }
#pragma unroll
        for (int u = 0; u < 2; ++u) {
            const int row = F.lane >> 2, qd = F.lane & 3;
#pragma unroll
            for (int kv = 0; kv < 2; ++kv) {
                const f32x4 a0 = a[u][kv][0], a1 = a[u][kv][1], a2 = a[u][kv][2], a3 = a[u][kv][3];
                v4u o0, o1; o0.x = pk2(a0.x, a0.y); o0.y = pk2(a0.z, a0.w); o0.z = pk2(a1.x, a1.y); o0.w = pk2(a1.z, a1.w); o1.x = pk2(a2.x, a2.y); o1.y = pk2(a2.z, a2.w); o1.z = pk2(a3.x, a3.y); o1.w = pk2(a3.z, a3.w);
                bf16* dst = WSP(F, bf16, WS_AS) + ((((size_t)(lyrv[u] * 2 + kv) * BS + bv[u]) * 512 + cv[u]) * 1024) + row * 64 + qd * 16;
                *(v4u*)dst = o0; *(v4u*)(dst + 8) = o1;
            }
        }
    }
    {
        const float inv[8] = {1.0f, 0.193922758102417f, 0.03760603070259094f, 0.00729266507551074f, 0.001414213445968926f, 0.00027424818836152554f, 5.318296462064609e-05f, 1.0313385246263351e-05f};
        float* rope = WSP(F, float, WS_ROPE);
        for (int i = blockIdx.x * NTHR + F.tid; i < 2056 * 8; i += F.G * NTHR) {
            const int pi = i >> 3, f = i & 7; const int pos = pi < TP ? pi : PAST + (pi - TP);
            float iv = inv[0];
#pragma unroll
            for (int k = 1; k < 8; ++k) iv = (f == k) ? inv[k] : iv;
            const float ang = (float)pos * iv; float c, s; cossin_d(ang, c, s);
            rope[pi * 16 + f] = c; rope[pi * 16 + 8 + f] = s;
        }
    }
    for (int r = F.gw; r < MROWS; r += F.ngw) norm_row_to_bf16(F, x_in_row(F, r), INP(F, I_NMPRE), WSP(F, bf16, WS_XN) + (size_t)r * DM);
}

typedef float f32x16p __attribute__((ext_vector_type(16)));
__device__ __forceinline__ void phase_cmp_finish(const Frame& F) {
    const float* H = WSP(F, float, WS_HS);
    const int lane = F.lane, r32 = lane & 31, hp = lane >> 5;
    for (int it = F.gw; it < 8 * BS * 16; it += F.ngw) {
        const int i = it >> 9, b = (it >> 4) & 31, n0 = (it & 15) * 32; const int lyr = i >> 1, kv = i & 1;
        const int n = n0 + r32; const int n1 = (n + 1 < 512) ? n + 1 : 511;
        const float* h0 = H + (((size_t)i * BS + b) * 512 + n) * 256; const float* h1 = H + (((size_t)i * BS + b) * 512 + n1) * 256 + 128;
        const float* bias = WSP(F, float, WS_CBIAS) + i * 128;
        const bf16* w2t = WSP(F, bf16, WS_W2T) + (size_t)i * 64 * 128;
        f32x16p acc0, acc1;
#pragma unroll
        for (int k = 0; k < 16; ++k) { acc0[k] = 0.f; acc1[k] = 0.f; }
#pragma unroll
        for (int ks = 0; ks < 8; ++ks) {
            const int e = 16 * ks + 8 * hp;
            const f32x4 a0 = *(const f32x4*)(h0 + e), a1 = *(const f32x4*)(h0 + e + 4), c0 = *(const f32x4*)(h1 + e), c1 = *(const f32x4*)(h1 + e + 4);
            const f32x4 b0 = *(const f32x4*)(bias + e), b1 = *(const f32x4*)(bias + e + 4);
            const f32x4 x0 = a0 + c0 + b0, x1 = a1 + c1 + b1;
            v4u av; av.x = pk2(gelu_tanh(x0.x), gelu_tanh(x0.y)); av.y = pk2(gelu_tanh(x0.z), gelu_tanh(x0.w)); av.z = pk2(gelu_tanh(x1.x), gelu_tanh(x1.y)); av.w = pk2(gelu_tanh(x1.z), gelu_tanh(x1.w));
            const bf16x8 bf0 = *(const bf16x8*)(w2t + (size_t)r32 * 128 + e), bf1 = *(const bf16x8*)(w2t + (size_t)(32 + r32) * 128 + e);
            acc0 = __builtin_amdgcn_mfma_f32_32x32x16_bf16(__builtin_bit_cast(bf16x8, av), bf0, acc0, 0, 0, 0);
            acc1 = __builtin_amdgcn_mfma_f32_32x32x16_bf16(__builtin_bit_cast(bf16x8, av), bf1, acc1, 0, 0, 0);
        }
        float* dst = WSP(F, float, kv ? WS_CVS : WS_CKS) + (((size_t)lyr * BS + b) * NCMP_S) * 64;
#pragma unroll
        for (int k = 0; k < 16; ++k) { const int nn = n0 + (k & 3) + 8 * (k >> 2) + 4 * hp;
            if (nn < NCMP_S) { dst[(size_t)nn * 64 + r32] = acc0[k]; dst[(size_t)nn * 64 + 32 + r32] = acc1[k]; } }
    }
}

__device__ __forceinline__ float rope_lane(float x, int lane, float cs_c, float cs_s) {
    const float other = __shfl_xor(x, 8);
    const float rot = (lane < 8) ? x * cs_c - other * cs_s : x * cs_c + other * cs_s;
    return (lane < 16) ? rot : x;
}
template <int NR>
__device__ __forceinline__ void token_prep4(const Frame& F, int l, int r0, const LAS float* pw_lds, LAS float* pl) {
    int s, t0; row_to_seq(r0, s, t0); const Seq q = seq_of(s);
    const int lane = F.lane;
    const float* spool = INP(F, I_SPOOL) + ((size_t)l * BS + q.b) * POOL_KEEP * POOL_W;
    const float* proj0 = WSP(F, float, WS_PROJ) + (size_t)r0 * IN_WP;
    float qx[NR][4], kx[NR][6], csc[NR], css[NR];
#pragma unroll
    for (int u = 0; u < NR; ++u) {
        const float* proj = proj0 + (size_t)u * IN_WP; const int t = t0 + u;
        const float* rp = WSP(F, float, WS_ROPE) + (size_t)(q.samp ? TP + t : t) * 16;
#pragma unroll
        for (int j = 0; j < 4; ++j) qx[u][j] = proj[OFF_Q + j * 64 + lane];
#pragma unroll
        for (int j = 0; j < 6; ++j) kx[u][j] = proj[OFF_KV + j * 64 + lane];
        csc[u] = rp[lane & 7]; css[u] = rp[8 + (lane & 7)];
    }
    float e0[2 + NR - 1], e1[4 + NR - 1], e2[8 + NR - 1], e3[16 + NR - 1];
#define LOAD_EXT(EARR, G, W) do { _Pragma("unroll") for (int k = 0; k < (W) + NR - 1; ++k) { const int tt = t0 - ((W) - 1) + k; const int c = (G) * 64 + lane; \
          \
        const float* pa = (tt >= 0) ? proj0 + (long)(tt - t0) * IN_WP + OFF_POOL + c : (q.samp ? spool + (POOL_KEEP + tt) * POOL_W + c : proj0 + OFF_POOL + c); \
        const float v = *pa; EARR[k] = (tt >= 0 || q.samp) ? v : 0.f; } } while (0)
    LOAD_EXT(e0, 0, 2); LOAD_EXT(e1, 1, 4); LOAD_EXT(e2, 2, 8); LOAD_EXT(e3, 3, 16);
#undef LOAD_EXT
    float pooled[NR][4], pu[NR][4];
#pragma unroll
    for (int u = 0; u < NR; ++u) {
        const int pos = q.pos0 + t0 + u;
        float s0 = 0.f, s1 = 0.f, s2 = 0.f, s3 = 0.f;
#pragma unroll
        for (int i = 0; i < 2; ++i) s0 += e0[u + i];
#pragma unroll
        for (int i = 0; i < 4; ++i) s1 += e1[u + i];
#pragma unroll
        for (int i = 0; i < 8; ++i) s2 += e2[u + i];
#pragma unroll
        for (int i = 0; i < 16; ++i) s3 += e3[u + i];
        pu[u][0] = e0[u + 1]; pu[u][1] = e1[u + 3]; pu[u][2] = e2[u + 7]; pu[u][3] = e3[u + 15];
        pooled[u][0] = s0 / (float)((pos + 1 < 2) ? pos + 1 : 2) - pu[u][0];
        pooled[u][1] = s1 / (float)((pos + 1 < 4) ? pos + 1 : 4) - pu[u][1];
        pooled[u][2] = s2 / (float)((pos + 1 < 8) ? pos + 1 : 8) - pu[u][2];
        pooled[u][3] = s3 / (float)((pos + 1 < 16) ? pos + 1 : 16) - pu[u][3];
    }
#pragma unroll
    for (int u = 0; u < NR; ++u) {
        const int r = r0 + u, t = t0 + u;
        bf16* qb = WSP(F, bf16, WS_QB) + (size_t)r * 256;
#pragma unroll
        for (int j = 0; j < 4; ++j) qb[j * 64 + lane] = (bf16)f2bf(rope_lane(qx[u][j], lane, csc[u], css[u]) * (0.125f * 1.4426950408889634f));
        float* kvout = q.samp ? F.out + O_KVS + ((size_t)l * NS + (r - NP)) * 256 : F.out + O_KVP + ((size_t)l * NP + r) * 256;
        float* kwin = WSP(F, float, WS_KWIN) + (size_t)r * 128;
#pragma unroll
        for (int j = 0; j < 6; ++j) {
            const float v = (j & 1) ? kx[u][j] : rope_lane(kx[u][j], lane, csc[u], css[u]);
            if (j < 4) kvout[j * 64 + lane] = v;
            else {
                kwin[(j - 4) * 64 + lane] = v;
                if (!q.samp) { if (t >= TP - 512) F.out[O_WINP + (((size_t)l * BP + q.b) * 512 + (t - (TP - 512))) * 128 + (j - 4) * 64 + lane] = v; }
                else F.out[O_WINS + (((size_t)l * BS + q.b) * 512 + 504 + t) * 128 + (j - 4) * 64 + lane] = v;
            }
        }
#pragma unroll
        for (int g = 0; g < 4; ++g) pl[u * 256 + g * 64 + lane] = pooled[u][g];
    }
    asm volatile("s_waitcnt lgkmcnt(0)" ::: "memory");
    const float* psc = INP(F, I_POOLSC) + (size_t)l * POOL_W;
#pragma unroll
    for (int g = 0; g < 4; ++g) {
        float y[NR];
#pragma unroll
        for (int u = 0; u < NR; ++u) y[u] = 0.f;
#pragma unroll 4
        for (int c = 0; c < 64; c += 4) { const LAS float* wv = pw_lds + (g * 64 + c) * 64 + lane;
            const float w0 = wv[0], w1 = wv[64], w2 = wv[128], w3 = wv[192];
#pragma unroll
            for (int u = 0; u < NR; ++u) { const f32x4 pa = *(const LAS f32x4*)(pl + u * 256 + g * 64 + c); y[u] += pa.x * w0 + pa.y * w1 + pa.z * w2 + pa.w * w3; } }
        const float sc = psc[g * 64 + lane];
#pragma unroll
        for (int u = 0; u < NR; ++u) (WSP(F, bf16, WS_MIX) + (size_t)(r0 + u) * DM)[512 + g * 64 + lane] = (bf16)f2bf(y[u] * sc);
    }
    asm volatile("s_waitcnt lgkmcnt(0)" ::: "memory");
#pragma unroll
    for (int u = 0; u < NR; ++u) {
        const int r = r0 + u, t = t0 + u; const float* proj = WSP(F, float, WS_PROJ) + (size_t)r * IN_WP;
        if (!q.samp) {
            if (t >= TP - 15) { float* o = F.out + O_POOLP + (((size_t)l * BP + q.b) * 15 + (t - (TP - 15))) * POOL_W;
#pragma unroll
                for (int j = 0; j < 4; ++j) o[j * 64 + lane] = pu[u][j]; }
            if (t >= TP - 3) { float* o = F.out + O_CONVP + (((size_t)l * BP + q.b) * 3 + (t - (TP - 3))) * CONV_DIM;
                for (int j = 0; j < 16; ++j) o[j * 64 + lane] = proj[OFF_XBC + j * 64 + lane]; }
        } else {
            { float* o = F.out + O_POOLS + (((size_t)l * BS + q.b) * 15 + 7 + t) * POOL_W;
#pragma unroll
                for (int j = 0; j < 4; ++j) o[j * 64 + lane] = pu[u][j]; }
            if (t < 7) { float* o = F.out + O_POOLS + (((size_t)l * BS + q.b) * 15 + t) * POOL_W;
#pragma unroll
                for (int j = 0; j < 4; ++j) o[j * 64 + lane] = spool[(8 + t) * POOL_W + j * 64 + lane]; }
            if (t >= TS - 3) { float* o = F.out + O_CONVS + (((size_t)l * BS + q.b) * 3 + (t - (TS - 3))) * CONV_DIM;
                for (int j = 0; j < 16; ++j) o[j * 64 + lane] = proj[OFF_XBC + j * 64 + lane]; }
        }
    }
}

__device__ __forceinline__ float xbc_conv(const Frame& F, int l, const Seq& q, int t, int c) {
    const float* cw = INP(F, I_CONVW) + (size_t)l * 4 * CONV_DIM; const float* cb = INP(F, I_CONVB) + (size_t)l * CONV_DIM;
    const float* proj = WSP(F, float, WS_PROJ);
    const float* sconv = INP(F, I_SCONV) + ((size_t)l * BS + q.b) * 3 * CONV_DIM;
    float acc = cb[c];
#pragma unroll
    for (int k = 0; k < 4; ++k) { const int tt = t - 3 + k; float e = 0.f;
        if (tt >= 0) e = proj[(size_t)(q.row0 + tt) * IN_WP + OFF_XBC + c];
        else if (q.samp) e = sconv[(3 + tt) * CONV_DIM + c];
        acc += e * cw[k * CONV_DIM + c]; }
    return siluf_(acc);
}
__device__ __forceinline__ void ssd_item(const Frame& F, int l, int s, int h) {
    const Seq q = seq_of(s);
    constexpr int TSTG = 16;
    LAS float* xs = (LAS float*)F.lds;
    LAS float* Bs = xs + TSTG * 64;
    LAS float* Cs = Bs + TSTG * 128;
    LAS float* dts = Cs + TSTG * 128;
    LAS float* dAs = dts + TSTG;
    const int tid = F.tid, p = tid >> 3, nq = tid & 7, g = h >> 2;
    const float a = -expf(INP(F, I_ALOG)[l * SSD_H + h]), dtb = INP(F, I_DTB)[l * SSD_H + h], dsk = INP(F, I_SSDD)[l * SSD_H + h];
    float st[16];
    if (q.samp) { const float* s0 = INP(F, I_SSM) + ((((size_t)l * BS + q.b) * SSD_H + h) * SSD_HD + p) * SSD_N + nq * 16;
#pragma unroll
        for (int i = 0; i < 16; ++i) st[i] = s0[i]; }
    else {
#pragma unroll
        for (int i = 0; i < 16; ++i) st[i] = 0.f; }
    const float* proj = WSP(F, float, WS_PROJ);
    float* yssd = WSP(F, float, WS_YSSD);
    for (int t0 = 0; t0 < q.T; t0 += TSTG) {
        const int nt = (q.T - t0 < TSTG) ? q.T - t0 : TSTG;
        __syncthreads();
        for (int i = tid; i < nt * 320; i += NTHR) { const int tt = i / 320, c = i % 320; const int t = t0 + tt;
            if (c < 64) xs[tt * 64 + c] = xbc_conv(F, l, q, t, h * 64 + c);
            else if (c < 192) Bs[tt * 128 + (c - 64)] = xbc_conv(F, l, q, t, 512 + g * 128 + (c - 64));
            else Cs[tt * 128 + (c - 192)] = xbc_conv(F, l, q, t, 768 + g * 128 + (c - 192)); }
        if (tid < nt) { const float dt = softplusf_(proj[(size_t)(q.row0 + t0 + tid) * IN_WP + OFF_DT + h] + dtb); dts[tid] = dt; dAs[tid] = expf(dt * a); }
        __syncthreads();
        for (int tt = 0; tt < nt; ++tt) {
            const float dt = dts[tt], dA = dAs[tt], x = xs[tt * 64 + p], xd = x * dt;
            float y = 0.f;
#pragma unroll
            for (int i = 0; i < 16; ++i) { st[i] = st[i] * dA + xd * Bs[tt * 128 + nq * 16 + i]; y += st[i] * Cs[tt * 128 + nq * 16 + i]; }
            y += __shfl_xor(y, 1); y += __shfl_xor(y, 2); y += __shfl_xor(y, 4);
            if (nq == 0) yssd[(size_t)(q.row0 + t0 + tt) * SSD_W + h * 64 + p] = y + dsk * x;
        }
    }
    float* so = q.samp ? F.out + O_SSMS + ((((size_t)l * BS + q.b) * SSD_H + h) * SSD_HD + p) * SSD_N + nq * 16
                       : F.out + O_SSMP + ((((size_t)l * BP + q.b) * SSD_H + h) * SSD_HD + p) * SSD_N + nq * 16;
#pragma unroll
    for (int i = 0; i < 16; ++i) so[i] = st[i];
    __syncthreads();
}
__device__ __forceinline__ void ssd_chunk_unit(const Frame& F, int l, int b, int c, int g);
__device__ __forceinline__ void ssd_scan(const Frame& F, int l);
__device__ __forceinline__ void ssd_out_unit(const Frame& F, int l, int b, int hc);
__device__ __forceinline__ void phase_prep(const Frame& F, int l) {
    for (int u = blockIdx.x; u < BP * 16 * 2; u += F.G) ssd_chunk_unit(F, l, u >> 5, (u >> 1) & 15, u & 1);
    {
        __syncthreads();
        LAS float* pw_lds = (LAS float*)F.lds; const float* pw = INP(F, I_POOLW) + (size_t)l * 4 * 64 * 64;
        for (int i = F.tid; i < 4 * 64 * 64 / 4; i += NTHR) *(LAS f32x4*)(pw_lds + i * 4) = *(const f32x4*)(pw + i * 4);
        __syncthreads();
        LAS float* pl = (LAS float*)(F.lds + 65536) + F.wave * 1024;
        for (int rp = F.gw; rp < NP / 4; rp += F.ngw) token_prep4<4>(F, l, 4 * rp, pw_lds, pl);
        for (int j = blockIdx.x * 8 + F.wave; j < NS * 8; j += F.G * 8) if ((j & 7) == 0) token_prep4<1>(F, l, NP + (j >> 3), pw_lds, pl);
        __syncthreads();
    }
}

__device__ __forceinline__ const float* kv_row(const Frame& F, int l, const Seq& q, int tok, int kind) {
    if (!q.samp) return F.out + O_KVP + ((size_t)l * NP + q.row0 + tok) * 256 + kind * 64;
    if (tok >= PAST) return F.out + O_KVS + ((size_t)l * NS + (q.row0 - NP) + (tok - PAST)) * 256 + kind * 64;
    const int page = ((const int*)INP(F, I_PT))[q.b * NPAGES + (tok >> 7)];
    return INP(F, I_CACHE) + ((((size_t)l * NPHYS + page) * PAGE + (tok & 127)) * 4 + kind) * 64;
}
typedef float f32x4c __attribute__((ext_vector_type(4)));
__device__ __forceinline__ void compress_item(const Frame& F, int l, int s, int grp, int kv) {
    const Seq q = seq_of(s);
    const int ncmp = NCMP_P;
    const int n0 = grp * 16; const int nb = (ncmp - n0 < 16) ? ncmp - n0 : 16;
    constexpr int CST = 2064;
    LAS unsigned char* rows = F.lds;
    LAS float* hid = (LAS float*)(F.lds + 36864);
    const int tid = F.tid, lane = F.lane, wave = F.wave;
    __syncthreads();
    for (int i = tid; i < 17 * 16 * 8; i += NTHR) { const int rr = i >> 3, dc = i & 7; const int tok = n0 * 16 + rr;
        v4u o = (v4u){0u, 0u, 0u, 0u};
        if (tok < TP) { const float* p = kv_row(F, l, q, tok, kv) + dc * 8; const f32x4 a = *(const f32x4*)p, b = *(const f32x4*)(p + 4);
            o.x = pk2(a.x, a.y); o.y = pk2(a.z, a.w); o.z = pk2(b.x, b.y); o.w = pk2(b.z, b.w); }
        *(LAS v4u*)(rows + (rr >> 4) * CST + (rr & 15) * 128 + dc * 16) = o; }
    __syncthreads();
    const int i2 = l * 2 + kv;
    const bf16* wt = WSP(F, bf16, WS_WTC) + (size_t)i2 * 256 * 1024;
    const int e = 16 * wave + (lane & 15), kq = lane >> 4, blk = lane & 15;
    f32x4c acc = (f32x4c){0.f, 0.f, 0.f, 0.f};
#pragma unroll 8
    for (int ks = 0; ks < 64; ++ks) {
        const int half = ks >> 5, kk = (ks & 31) * 32 + 8 * kq;
        const bf16x8 bfrag = *(const bf16x8*)(wt + (size_t)(half * 128 + e) * 1024 + kk);
        const bf16x8 afrag = *(const LAS bf16x8*)(rows + (blk + half) * CST + kk * 2);
        acc = __builtin_amdgcn_mfma_f32_16x16x32_bf16(afrag, bfrag, acc, 0, 0, 0);
    }
    { const float bias = WSP(F, float, WS_CBIAS)[i2 * 128 + e];
#pragma unroll
      for (int k = 0; k < 4; ++k) hid[(kq * 4 + k) * 128 + e] = gelu_tanh(acc[k] + bias); }
    __syncthreads();
    const float* w2 = INP(F, kv ? I_W2V : I_W2K) + (size_t)l * 128 * 64;
    float* dst = WSP(F, float, kv ? WS_CVP : WS_CKP) + (size_t)q.b * NCMP_P * 64;
    { const int bi = tid >> 5, d0 = (tid & 31) * 2;
        if (bi < nb) { float o0 = 0.f, o1 = 0.f;
#pragma unroll 8
            for (int k = 0; k < 128; ++k) { const float hv = hid[bi * 128 + k]; o0 += hv * w2[k * 64 + d0]; o1 += hv * w2[k * 64 + d0 + 1]; }
            dst[(size_t)(n0 + bi) * 64 + d0] = o0; dst[(size_t)(n0 + bi) * 64 + d0 + 1] = o1; } }
    __syncthreads();
}
__device__ __forceinline__ void attn_sample_unit(const Frame& F, int l, int b, int t0);
__device__ __forceinline__ void phase_compress(const Frame& F, int l) {
    constexpr int NI_P = BP * 8 * 2;
    for (int it = blockIdx.x; it < NI_P; it += F.G) compress_item(F, l, it >> 4, (it >> 1) & 7, it & 1);
    ssd_scan(F, l);
    { Frame G2 = F; { int ln = G2.lane; asm volatile("" : "+v"(ln)); G2.lane = ln; G2.tid = G2.wave * 64 + ln; }
      for (int u = blockIdx.x; u < NS; u += F.G) attn_sample_unit(G2, l, u >> 3, u & 7);
      unsigned* ctr = (unsigned*)(F.ws + WS_CTL) + 70000 + l * 16 + 8;
      volatile LAS int* su = (volatile LAS int*)(F.lds + RING_BYTES + 768);
      for (;;) {
          __syncthreads();
          if (G2.tid == 0) su[0] = (int)xb_add(ctr, 1u);
          __syncthreads();
          const int u = __builtin_amdgcn_readfirstlane(su[0]);
          if (u >= (NSEQ - BP) * SSD_H) break;
          const int it = BP * SSD_H + u;
          ssd_item(G2, l, it >> 3, it & 7);
      } }
}

__device__ __forceinline__ void osm_step(float sc, const f32x4 v, float& m, float& lsum, f32x4& o) {
    const float mn = fmaxf(m, sc); const float al = expf(m - mn), pp = expf(sc - mn);
    lsum = lsum * al + pp; o = o * al + v * pp; m = mn;
}
__device__ __forceinline__ void nsa_token(const Frame& F, int l, int r) {
    int s, t; row_to_seq(r, s, t); const Seq q = seq_of(s);
    const int lane = F.lane, hh = lane >> 4, sub = lane & 15;
    const int tpos = q.pos0 + t;
    LAS float* sc = (LAS float*)(F.lds + F.wave * 12288);
    LAS float* impv = sc + 2048;
    LAS int* sel = (LAS int*)(impv + 192);
    const f32x4 qv = *(const f32x4*)(WSP(F, float, WS_Q) + (size_t)r * 256 + hh * 64 + sub * 4);
    const int ncmp = q.samp ? NCMP_S : NCMP_P;
    const float* ck = q.samp ? WSP(F, float, WS_CKS) + (size_t)q.b * NCMP_S * 64 : WSP(F, float, WS_CKP) + (size_t)q.b * NCMP_P * 64;
    const float* cv = q.samp ? WSP(F, float, WS_CVS) + (size_t)q.b * NCMP_S * 64 : WSP(F, float, WS_CVP) + (size_t)q.b * NCMP_P * 64;
    int nvis = 0; if (tpos >= 31) { nvis = (tpos - 31) / 16 + 1; if (nvis > ncmp) nvis = ncmp; }
    float mx = -INFINITY;
    for (int n = 0; n < nvis; ++n) { const f32x4 kk = *(const f32x4*)(ck + (size_t)n * 64 + sub * 4);
        const float d = sum16(qv.x * kk.x + qv.y * kk.y + qv.z * kk.z + qv.w * kk.w);
        if (sub == 0) sc[hh * 512 + n] = d; mx = fmaxf(mx, d); }
    asm volatile("s_waitcnt lgkmcnt(0)" ::: "memory");
    float ls = 0.f;
    for (int n = sub; n < nvis; n += 16) { const float e = expf(sc[hh * 512 + n] - mx); sc[hh * 512 + n] = e; ls += e; }
    ls = sum16(ls);
    const float rl = ls > 0.f ? 1.f / ls : 0.f;
    for (int n = sub; n < nvis; n += 16) sc[hh * 512 + n] *= rl;
    asm volatile("s_waitcnt lgkmcnt(0)" ::: "memory");
    f32x4 ocmp = (f32x4){0.f, 0.f, 0.f, 0.f};
    for (int n = 0; n < nvis; ++n) { const float pp = sc[hh * 512 + n]; ocmp += *(const f32x4*)(cv + (size_t)n * 64 + sub * 4) * pp; }
    const int nslc = q.samp ? 129 : 32, cur = tpos >> 6;
    for (int j = lane; j < nslc; j += 64) {
        float v;
        if (j > cur) v = -INFINITY;
        else if (j == 0 || j == cur || j == cur - 1) v = INFINITY;
        else { v = 0.f;
            for (int n = 4 * j - 1; n <= 4 * j + 3; ++n) if (n >= 0 && n < nvis) v += (sc[n] + sc[512 + n]) + (sc[1024 + n] + sc[1536 + n]); }
        impv[j] = v;
    }
    asm volatile("s_waitcnt lgkmcnt(0)" ::: "memory");
    int nsel = 0;
    for (int j0 = 0; j0 < nslc; j0 += 64) {
        const int j = j0 + lane; bool selj = false;
        if (j < nslc) { const float vj = impv[j]; int rank = 0;
            for (int k = 0; k < nslc; ++k) { const float vk = impv[k]; rank += (vk > vj || (vk == vj && k < j)) ? 1 : 0; }
            selj = (rank < 16) && (j <= cur); }
        const unsigned long long bal = __ballot(selj);
        if (selj) sel[nsel + __popcll(bal & ((1ull << lane) - 1ull))] = j;
        nsel += __popcll(bal);
    }
    asm volatile("s_waitcnt lgkmcnt(0)" ::: "memory");
    float m2 = -INFINITY, l2 = 0.f; f32x4 o2 = (f32x4){0.f, 0.f, 0.f, 0.f};
    for (int si = 0; si < nsel; ++si) {
        const int j = sel[si]; int ntok = tpos - 64 * j + 1; if (ntok > 64) ntok = 64;
        for (int i = 0; i < ntok; ++i) { const int tok = 64 * j + i;
            const float* kr = kv_row(F, l, q, tok, 2);
            const f32x4 kk = *(const f32x4*)(kr + sub * 4); const f32x4 vv = *(const f32x4*)(kr + 64 + sub * 4);
            const float d = sum16(qv.x * kk.x + qv.y * kk.y + qv.z * kk.z + qv.w * kk.w);
            osm_step(d, vv, m2, l2, o2); }
    }
    float m3 = -INFINITY, l3 = 0.f; f32x4 o3 = (f32x4){0.f, 0.f, 0.f, 0.f};
    {
        int k0 = tpos - 511; if (k0 < 0) k0 = 0;
        const float* swin = INP(F, I_SWIN) + ((size_t)l * BS + q.b) * 512 * 128;
        const float* kwin = WSP(F, float, WS_KWIN);
        for (int kp = k0; kp <= tpos; ++kp) {
            const float* kr;
            if (!q.samp) kr = kwin + (size_t)(q.row0 + kp) * 128;
            else if (kp >= PAST) kr = kwin + (size_t)(q.row0 + kp - PAST) * 128;
            else kr = swin + (size_t)(kp - (PAST - 512)) * 128;
            const f32x4 kk = *(const f32x4*)(kr + sub * 4); const f32x4 vv = *(const f32x4*)(kr + 64 + sub * 4);
            const float d = sum16(qv.x * kk.x + qv.y * kk.y + qv.z * kk.z + qv.w * kk.w);
            osm_step(d, vv, m3, l3, o3); }
    }
    const float* gp = WSP(F, float, WS_PROJ) + (size_t)r * IN_WP + OFF_G + hh * 3;
    const float g0 = sigmoidf_(gp[0]), g1 = sigmoidf_(gp[1]), g2 = sigmoidf_(gp[2]);
    const float r2 = l2 > 0.f ? 1.f / l2 : 0.f, r3 = l3 > 0.f ? 1.f / l3 : 0.f;
    const f32x4 y = ocmp * g0 + o2 * (g1 * r2) + o3 * (g2 * r3);
    unsigned long long* mo = (unsigned long long*)(WSP(F, bf16, WS_MIX) + (size_t)r * DM + 768 + hh * 64 + sub * 4);
    *mo = (unsigned long long)pk2(y.x, y.y) | ((unsigned long long)pk2(y.z, y.w) << 32);
}
__device__ __forceinline__ void ssd_finish_token(const Frame& F, int l, int r) {
    const float* y = WSP(F, float, WS_YSSD) + (size_t)r * SSD_W; const float* z = WSP(F, float, WS_PROJ) + (size_t)r * IN_WP;
    const float* nw = INP(F, I_SSDNORM) + (size_t)l * SSD_W;
    float v[8]; float ss = 0.f;
#pragma unroll
    for (int j = 0; j < 8; ++j) { const int c = j * 64 + F.lane; v[j] = y[c] * siluf_(z[c]); ss += v[j] * v[j]; }
    const float rs = 1.f / sqrtf(wave_sum(ss) * (1.f / SSD_W) + RMS_EPS);
    bf16* mix = WSP(F, bf16, WS_MIX) + (size_t)r * DM;
#pragma unroll
    for (int j = 0; j < 8; ++j) { const int c = j * 64 + F.lane; mix[c] = (bf16)f2bf(v[j] * rs * nw[c]); }
}
__device__ __forceinline__ void phase_attn(const Frame& F, int l) {
    for (int r = F.gw; r < MROWS; r += F.ngw) { nsa_token(F, l, r); ssd_finish_token(F, l, r); }
}


typedef short bf16x8 __attribute__((ext_vector_type(8)));
typedef float f32x16 __attribute__((ext_vector_type(16)));
typedef float f32x2_t __attribute__((ext_vector_type(2))); typedef __bf16 bf16x2_t __attribute__((ext_vector_type(2)));
__device__ __forceinline__ unsigned cvtpk(float lo, float hi) { f32x2_t v = {lo, hi}; bf16x2_t b = __builtin_convertvector(v, bf16x2_t); return __builtin_bit_cast(unsigned, b); }
__device__ __forceinline__ float half_sum(float v) { auto rr = __builtin_amdgcn_permlane32_swap(__float_as_uint(v), __float_as_uint(v), false, false); return __uint_as_float(rr[0]) + __uint_as_float(rr[1]); }
__device__ __forceinline__ float half_max(float v) { auto rr = __builtin_amdgcn_permlane32_swap(__float_as_uint(v), __float_as_uint(v), false, false); return fmaxf(__uint_as_float(rr[0]), __uint_as_float(rr[1])); }

constexpr float QSCALE_B = 0.125f * 1.4426950408889634f;
constexpr int AT_K = 0, AT_V = 16384, AT_IMPG = 32768, AT_IMPE = AT_IMPG + 8192, AT_SEL = AT_IMPE + 8192, AT_UNI = AT_SEL + 2048, AT_LIST = AT_UNI + 64, AT_NLIST = AT_LIST + 768,
              AT_PAGE = AT_NLIST + 64, AT_RANK = AT_PAGE + 768, AT_OUT = AT_RANK + 8 * 1024, AT_END = AT_OUT + 8 * 8192;
static_assert(AT_END <= RING_BYTES, "attention LDS map");
enum { KIND_CMP1 = 0, KIND_CMP2 = 1, KIND_SLC = 2, KIND_WIN = 3 };

struct TileRegs { f32x4 k0, k1, v0, v1; };
__device__ __forceinline__ void tile_load(const Frame& F, int l, const Seq& q, int kind, int tile, int pg, TileRegs& R) {
    int t_ = F.tid; asm volatile("" : "+v"(t_));
    const int key = tile * 64 + (t_ >> 3), dc = t_ & 7;
    const float* kr = nullptr; const float* vr = nullptr;
    if (kind <= KIND_CMP2) {
        const int ncmp = q.samp ? NCMP_S : NCMP_P;
        if (key < ncmp) {
            kr = (q.samp ? WSP(F, float, WS_CKS) + ((size_t)l * BS + q.b) * NCMP_S * 64 : WSP(F, float, WS_CKP) + (size_t)q.b * NCMP_P * 64) + (size_t)key * 64;
            vr = (q.samp ? WSP(F, float, WS_CVS) + ((size_t)l * BS + q.b) * NCMP_S * 64 : WSP(F, float, WS_CVP) + (size_t)q.b * NCMP_P * 64) + (size_t)key * 64; }
    } else if (kind == KIND_SLC) {
        if (key < q.pos0 + q.T) {
            if (!q.samp) kr = F.out + O_KVP + ((size_t)l * NP + q.row0 + key) * 256 + 2 * 64;
            else if (key < PAST) kr = INP(F, I_CACHE) + ((((size_t)l * NPHYS + pg) * PAGE + (key & 127)) * 4 + 2) * 64;
            else kr = F.out + O_KVS + ((size_t)l * NS + (q.row0 - NP) + (key - PAST)) * 256 + 2 * 64;
            vr = kr + 64; }
    } else {
        if (key < q.pos0 + q.T) {
            if (!q.samp) kr = WSP(F, float, WS_KWIN) + (size_t)(q.row0 + key) * 128;
            else if (key >= PAST) kr = WSP(F, float, WS_KWIN) + (size_t)(q.row0 + key - PAST) * 128;
            else if (key >= PAST - 512) kr = INP(F, I_SWIN) + (((size_t)l * BS + q.b) * 512 + (key - (PAST - 512))) * 128;
            if (kr) vr = kr + 64; }
    }
    const f32x4 z = (f32x4){0.f, 0.f, 0.f, 0.f};
    if (kr) { R.k0 = *(const f32x4*)(kr + dc * 8); R.k1 = *(const f32x4*)(kr + dc * 8 + 4); R.v0 = *(const f32x4*)(vr + dc * 8); R.v1 = *(const f32x4*)(vr + dc * 8 + 4); }
    else { R.k0 = z; R.k1 = z; R.v0 = z; R.v1 = z; }
}
__device__ __forceinline__ void tile_store(const Frame& F, LAS unsigned char* kb, LAS unsigned char* vb, const TileRegs& R) {
    int t_ = F.tid; asm volatile("" : "+v"(t_));
    const int key = t_ >> 3, dc = t_ & 7;
    v4u kk; kk.x = cvtpk(R.k0.x, R.k0.y); kk.y = cvtpk(R.k0.z, R.k0.w); kk.z = cvtpk(R.k1.x, R.k1.y); kk.w = cvtpk(R.k1.z, R.k1.w);
    *(LAS v4u*)(kb + key * 128 + ((dc ^ (key & 7)) << 4)) = kk;
    const float vv[8] = {R.v0.x, R.v0.y, R.v0.z, R.v0.w, R.v1.x, R.v1.y, R.v1.z, R.v1.w};
#pragma unroll
    for (int i = 0; i < 8; ++i) { const int d = dc * 8 + i; const int ch = (key >> 2) ^ ((d >> 1) & 15);
        *(LAS unsigned short*)(vb + d * 128 + ch * 8 + (key & 3) * 2) = (unsigned short)f2bf(vv[i]); }
}
__device__ __forceinline__ void qk_tile(const LAS unsigned char* kb, const bf16x8 (&qf)[4], f32x16& s0, f32x16& s1, int lane, float init = 0.f) {
    const int r = lane & 31, h = lane >> 5;
#pragma unroll
    for (int i = 0; i < 16; ++i) { s0[i] = init; s1[i] = init; }
#pragma unroll
    for (int ks = 0; ks < 4; ++ks) {
        const bf16x8 a0 = *(const LAS bf16x8*)(kb + r * 128 + (((2 * ks + h) ^ (r & 7)) << 4));
        const bf16x8 a1 = *(const LAS bf16x8*)(kb + (32 + r) * 128 + (((2 * ks + h) ^ (r & 7)) << 4));
        s0 = __builtin_amdgcn_mfma_f32_32x32x16_bf16(a0, qf[ks], s0, 0, 0, 0);
        s1 = __builtin_amdgcn_mfma_f32_32x32x16_bf16(a1, qf[ks], s1, 0, 0, 0);
    }
}
__device__ __forceinline__ void mask_tile(f32x16& s0, f32x16& s1, int kbase, int lo, int hi) {
#pragma unroll
    for (int i = 0; i < 16; ++i) { const int k = kbase + (i & 3) + 8 * (i >> 2);
        if (k < lo || k > hi) s0[i] = -INFINITY;
        if (k + 32 < lo || k + 32 > hi) s1[i] = -INFINITY; }
}
__device__ __forceinline__ float max3_(float x, float y, float z) { float r; asm("v_max3_f32 %0, %1, %2, %3" : "=v"(r) : "v"(x), "v"(y), "v"(z)); return r; }
__device__ __forceinline__ float tile_max(const f32x16& s0, const f32x16& s1) {
    float a = max3_(s0[0], s0[1], s0[2]), b = max3_(s1[0], s1[1], s1[2]);
#pragma unroll
    for (int i = 3; i < 15; i += 2) { a = max3_(a, s0[i], s0[i + 1]); b = max3_(b, s1[i], s1[i + 1]); }
    return half_max(max3_(a, b, fmaxf(s0[15], s1[15])));
}
__device__ __forceinline__ void pv_tile(const LAS unsigned char* vb, const f32x16& s0, const f32x16& s1, f32x16 (&O)[2], int lane) {
    const int r = lane & 31, h = lane >> 5;
    bf16x8 pf[2][2];
#pragma unroll
    for (int sp = 0; sp < 2; ++sp) {
        v4u a; a.x = cvtpk(s0[8 * sp + 0], s0[8 * sp + 1]); a.y = cvtpk(s0[8 * sp + 2], s0[8 * sp + 3]); a.z = cvtpk(s0[8 * sp + 4], s0[8 * sp + 5]); a.w = cvtpk(s0[8 * sp + 6], s0[8 * sp + 7]);
        v4u b; b.x = cvtpk(s1[8 * sp + 0], s1[8 * sp + 1]); b.y = cvtpk(s1[8 * sp + 2], s1[8 * sp + 3]); b.z = cvtpk(s1[8 * sp + 4], s1[8 * sp + 5]); b.w = cvtpk(s1[8 * sp + 6], s1[8 * sp + 7]);
        pf[0][sp] = __builtin_bit_cast(bf16x8, a); pf[1][sp] = __builtin_bit_cast(bf16x8, b);
    }
#pragma unroll
    for (int dh = 0; dh < 2; ++dh) {
        const int d = dh * 32 + r, sw = (d >> 1) & 15; const LAS unsigned char* rb = vb + d * 128;
#pragma unroll
        for (int kh = 0; kh < 2; ++kh)
#pragma unroll
            for (int sp = 0; sp < 2; ++sp) {
                const int q0 = kh * 8 + 4 * sp + h;
                const unsigned long long lo8 = *(const LAS unsigned long long*)(rb + ((q0 ^ sw) << 3));
                const unsigned long long hi8 = *(const LAS unsigned long long*)(rb + (((q0 + 2) ^ sw) << 3));
                v4u av; av.x = (unsigned)lo8; av.y = (unsigned)(lo8 >> 32); av.z = (unsigned)hi8; av.w = (unsigned)(hi8 >> 32);
                O[dh] = __builtin_amdgcn_mfma_f32_32x32x16_bf16(__builtin_bit_cast(bf16x8, av), pf[kh][sp], O[dh], 0, 0, 0);
            }
        __builtin_amdgcn_sched_barrier(0);
    }
}

__device__ __forceinline__ void attn_unit(const Frame& F, int l, int s, int t0, int ntok) {
    const Seq q = seq_of(s);
    int lane_ = F.lane; asm volatile("" : "+v"(lane_));
    int wave_ = F.wave; asm volatile("" : "+s"(wave_));
    const int lane = lane_, wave = wave_, tid = wave * 64 + lane, h = lane >> 5;
    LAS unsigned char* lds = F.lds;
    LAS float* impG = (LAS float*)(lds + AT_IMPG); LAS float* impE = (LAS float*)(lds + AT_IMPE);
    LAS unsigned* selw = (LAS unsigned*)(lds + AT_SEL);
    LAS unsigned* uni = (LAS unsigned*)(lds + AT_UNI);
    LAS int* list = (LAS int*)(lds + AT_LIST);
    LAS int* nlist = (LAS int*)(lds + AT_NLIST);
    LAS int* lpage = (LAS int*)(lds + AT_PAGE);
    LAS float* rankv = (LAS float*)(lds + AT_RANK + wave * 1024);
    const int nslc = q.samp ? 129 : 32, njs = q.samp ? 128 : 32;
    const int ncmp = q.samp ? NCMP_S : NCMP_P;
    const int tl = wave * 8 + ((lane & 31) >> 2), head = lane & 3;
    const bool vcol = tl < ntok; const bool wact = (wave * 8) < ntok;
    const int tlc = vcol ? tl : 0;
    const int r = q.row0 + t0 + tlc, tpos = q.pos0 + t0 + tlc;
    int nvis = 0; if (vcol && tpos >= 31) { nvis = (tpos - 31) / 16 + 1; if (nvis > ncmp) nvis = ncmp; }
    const int tpos_last = q.pos0 + t0 + ntok - 1;
    int nvis_max = 0; if (tpos_last >= 31) { nvis_max = (tpos_last - 31) / 16 + 1; if (nvis_max > ncmp) nvis_max = ncmp; }
    const int nct = (nvis_max + 63) >> 6;
    bf16x8 qf[4];
    { const bf16* qb = WSP(F, bf16, WS_QB) + ((size_t)r * 4 + head) * 64;
#pragma unroll
      for (int ks = 0; ks < 4; ++ks) qf[ks] = *(const bf16x8*)(qb + 16 * ks + 8 * h); }
    const float* gp = WSP(F, float, WS_PROJ) + (size_t)r * IN_WP + OFF_G + head * 3;
    const float g0 = sigmoidf_(gp[0]), g1 = sigmoidf_(gp[1]), g2 = sigmoidf_(gp[2]);
#define GATE(k) sigmoidf_((WSP(F, float, WS_PROJ) + (size_t)r * IN_WP + OFF_G + head * 3)[(k)])
    f32x16 O[2];
    LAS float* outl = (LAS float*)(lds + AT_OUT + wave * 8192) + lane;
#pragma unroll
    for (int i = 0; i < 16; ++i) { O[0][i] = 0.f; O[1][i] = 0.f; }
    float m = -1e30f, lsum = 0.f, rinv = 0.f;

    __syncthreads();
    if (tid < 2 * nct) list[tid] = (tid < nct ? KIND_CMP1 : KIND_CMP2) | ((tid < nct ? tid : tid - nct) << 4);
    for (int i = tid; i < 64 * 8; i += NTHR) selw[i] = 0u;
    __syncthreads();
    {
        const int n = 2 * nct; TileRegs R;
        if (n > 0) tile_load(F, l, q, KIND_CMP1, 0, 0, R);
        for (int i = 0; i < n; ++i) {
            LAS unsigned char* kb = lds + AT_K + (i & 1) * 8192; LAS unsigned char* vb = lds + AT_V + (i & 1) * 8192;
            tile_store(F, kb, vb, R);
            const int e = __builtin_amdgcn_readfirstlane(list[i]); const int kind = e & 15, tile = e >> 4;
            if (i + 1 < n) { const int e2 = __builtin_amdgcn_readfirstlane(list[i + 1]); tile_load(F, l, q, e2 & 15, e2 >> 4, 0, R); }
            __syncthreads();
            if (wact) {
                if (i == nct) { const float L = half_sum(lsum); rinv = L > 0.f ? 1.f / L : 0.f; }
                f32x16 s0, s1; qk_tile(kb, qf, s0, s1, lane);
                mask_tile(s0, s1, tile * 64 + 4 * h, 0, nvis - 1);
                if (kind == KIND_CMP1) {
                    const float mt = tile_max(s0, s1); const float mn = fmaxf(m, mt); const float al = __builtin_amdgcn_exp2f(m - mn);
                    float rs = 0.f;
#pragma unroll
                    for (int k = 0; k < 16; ++k) rs += __builtin_amdgcn_exp2f(s0[k] - mn) + __builtin_amdgcn_exp2f(s1[k] - mn);
                    lsum = lsum * al + rs; m = mn;
                } else {
#pragma unroll
                    for (int k = 0; k < 16; ++k) { s0[k] = __builtin_amdgcn_exp2f(s0[k] - m) * rinv; s1[k] = __builtin_amdgcn_exp2f(s1[k] - m) * rinv; }
                    pv_tile(vb, s0, s1, O, lane);
#pragma unroll
                    for (int kh = 0; kh < 2; ++kh)
#pragma unroll
                        for (int gq = 0; gq < 4; ++gq) {
                            const f32x16& sv = kh ? s1 : s0;
                            float G = (sv[4 * gq] + sv[4 * gq + 1]) + (sv[4 * gq + 2] + sv[4 * gq + 3]), E = sv[4 * gq + 3];
                            G += __shfl_xor(G, 1); G += __shfl_xor(G, 2); E += __shfl_xor(E, 1); E += __shfl_xor(E, 2);
                            const int j = 16 * tile + 8 * kh + 2 * gq + h;
                            if (head == 0 && vcol && j < njs) { impG[tl * njs + j] = G; impE[tl * njs + j] = E; }
                        }
                }
            }
        }
    }
    const float g0v = GATE(0);
#pragma unroll
    for (int i = 0; i < 16; ++i) { outl[i * 64] = O[0][i] * g0v; outl[(16 + i) * 64] = O[1][i] * g0v; O[0][i] = 0.f; O[1][i] = 0.f; }
    m = 0.f; lsum = 0.f;
    bool started = false;
    asm volatile("s_waitcnt lgkmcnt(0)" ::: "memory");
    if (wact) {
        const int ntw = (ntok - wave * 8 < 8) ? ntok - wave * 8 : 8;
        for (int tt = 0; tt < ntw; ++tt) {
            const int tk = wave * 8 + tt; const int tp = q.pos0 + t0 + tk; const int cur = tp >> 6;
            int nv = 0; if (tp >= 31) { nv = (tp - 31) / 16 + 1; if (nv > ncmp) nv = ncmp; }
            const int jcov = (nv + 3) >> 2;
            for (int j = lane; j < nslc; j += 64) {
                float v;
                if (j > cur) v = -INFINITY;
                else if (j == 0 || j == cur || j == cur - 1) v = INFINITY;
                else { v = 0.f; if (j < jcov) v += impG[tk * njs + j]; if (j - 1 < jcov) v += impE[tk * njs + j - 1]; }
                rankv[j] = v;
            }
            asm volatile("s_waitcnt lgkmcnt(0)" ::: "memory");
            for (int j0 = 0; j0 < nslc; j0 += 64) {
                const int j = j0 + lane; bool selj = false;
                if (j < nslc) { const float vj = rankv[j]; int rank = 0;
                    for (int k = 0; k < nslc; ++k) { const float vk = rankv[k]; rank += (vk > vj || (vk == vj && k < j)) ? 1 : 0; }
                    selj = (rank < 16) && (j <= cur); }
                const unsigned long long bal = __ballot(selj);
                if (lane == 0) { selw[tk * 8 + (j0 >> 5)] = (unsigned)bal; selw[tk * 8 + (j0 >> 5) + 1] = (unsigned)(bal >> 32); }
            }
            asm volatile("s_waitcnt lgkmcnt(0)" ::: "memory");
        }
    }
    __syncthreads();
    if (tid < 8) { unsigned u = 0u; for (int k = 0; k < ntok; ++k) u |= selw[k * 8 + tid]; uni[tid] = u; }
    __syncthreads();
    if (wave == 0) {
        int n = 0;
        for (int j0 = 0; j0 < nslc; j0 += 64) {
            const int j = j0 + lane; const bool sj = (j < nslc) && ((uni[j >> 5] >> (j & 31)) & 1u);
            int pg = 0; if (sj && q.samp && j * 64 < PAST) pg = ((const int*)INP(F, I_PT))[q.b * NPAGES + (j >> 1)];
            const unsigned long long bal = __ballot(sj);
            if (sj) { const int idx = n + __popcll(bal & ((1ull << lane) - 1ull)); list[idx] = KIND_SLC | (j << 4); lpage[idx] = pg; }
            n += __popcll(bal);
        }
        const int p0 = q.pos0 + t0; int w0 = (p0 - 511) >> 6; if (w0 < 0) w0 = 0; if (q.samp && w0 < (PAST - 512) / 64) w0 = (PAST - 512) / 64;
        const int w1 = (p0 + ntok - 1) >> 6;
        if (lane <= w1 - w0) { list[n + lane] = KIND_WIN | ((w0 + lane) << 4); lpage[n + lane] = 0; }
        if (lane == 0) nlist[0] = n + (w1 - w0 + 1);
    }
    __syncthreads();
    {
        const int n = nlist[0]; TileRegs R0, R1; int pkind = KIND_SLC;
        { const int e0 = __builtin_amdgcn_readfirstlane(list[0]); tile_load(F, l, q, e0 & 15, e0 >> 4, __builtin_amdgcn_readfirstlane(lpage[0]), R0); }
        if (n > 1) { const int e1 = __builtin_amdgcn_readfirstlane(list[1]); tile_load(F, l, q, e1 & 15, e1 >> 4, __builtin_amdgcn_readfirstlane(lpage[1]), R1); }
#define ATTN_STEP(RR, BI, II) do { \
            LAS unsigned char* kb = lds + AT_K + (BI) * 8192; LAS unsigned char* vb = lds + AT_V + (BI) * 8192; \
            tile_store(F, kb, vb, RR); \
            const int e = __builtin_amdgcn_readfirstlane(list[(II)]); const int kind = e & 15, tile = e >> 4; \
            if ((II) + 2 < n) { const int e2 = __builtin_amdgcn_readfirstlane(list[(II) + 2]); tile_load(F, l, q, e2 & 15, e2 >> 4, __builtin_amdgcn_readfirstlane(lpage[(II) + 2]), RR); } \
            __syncthreads(); \
            if (wact) { \
                if (kind != pkind) { \
                    const float L = half_sum(lsum); const float sc = L > 0.f ? GATE(1) / L : 0.f; \
                    _Pragma("unroll") for (int k = 0; k < 16; ++k) { outl[k * 64] += O[0][k] * sc; outl[(16 + k) * 64] += O[1][k] * sc; O[0][k] = 0.f; O[1][k] = 0.f; } \
                    m = 0.f; lsum = 0.f; started = false; pkind = kind; \
                } \
                int lo, hi; \
                if (kind == KIND_SLC) { const bool sb = (selw[tlc * 8 + (tile >> 5)] >> (tile & 31)) & 1u; lo = 0; hi = (sb && vcol) ? tpos : -1; } \
                else { lo = tpos - 511; hi = vcol ? tpos : -1; } \
                const bool any = (hi >= tile * 64) && (lo <= tile * 64 + 63); \
                if (__ballot(any) != 0ull) { \
                      \
                      \
                    const bool part = any && !((lo <= tile * 64) && (hi >= tile * 64 + 63)); \
                      \
                      \
                    f32x16 s0, s1; qk_tile(kb, qf, s0, s1, lane, any ? -m : -INFINITY); \
                    if (__ballot(part) != 0ull) mask_tile(s0, s1, tile * 64 + 4 * h, lo, hi); \
                    const float mt = tile_max(s0, s1); \
                    const bool seen = mt > -INFINITY; const bool need = (mt > 8.f) || (seen && !started); started = started || seen; \
                    if (__ballot(need) != 0ull) { \
                        const float dl = need ? mt : 0.f; const float al = __builtin_amdgcn_exp2f(-dl); m += dl; lsum *= al; \
                        _Pragma("unroll") for (int k = 0; k < 16; ++k) { s0[k] -= dl; s1[k] -= dl; O[0][k] *= al; O[1][k] *= al; } } \
                    float rs = 0.f; \
                    _Pragma("unroll") for (int k = 0; k < 16; ++k) { s0[k] = __builtin_amdgcn_exp2f(s0[k]); s1[k] = __builtin_amdgcn_exp2f(s1[k]); rs += s0[k] + s1[k]; } \
                    lsum += rs; \
                    pv_tile(vb, s0, s1, O, lane); \
                } \
            } } while (0)
        for (int i = 0; i < n; i += 2) {
            ATTN_STEP(R0, 0, i);
            if (i + 1 < n) ATTN_STEP(R1, 1, i + 1);
        }
#undef ATTN_STEP
        if (wact) {
            const float L = half_sum(lsum); const float sc = L > 0.f ? (pkind == KIND_SLC ? GATE(1) : GATE(2)) / L : 0.f;
#pragma unroll
            for (int k = 0; k < 16; ++k) { O[0][k] = outl[k * 64] + O[0][k] * sc; O[1][k] = outl[(16 + k) * 64] + O[1][k] * sc; }
        }
    }
    if (vcol) {
        bf16* mo = WSP(F, bf16, WS_MIX) + (size_t)r * DM + 768 + head * 64;
#pragma unroll
        for (int dh = 0; dh < 2; ++dh)
#pragma unroll
            for (int gq = 0; gq < 4; ++gq) {
                const int d = dh * 32 + 8 * gq + 4 * h;
                *(unsigned long long*)(mo + d) = (unsigned long long)cvtpk(O[dh][4 * gq], O[dh][4 * gq + 1]) | ((unsigned long long)cvtpk(O[dh][4 * gq + 2], O[dh][4 * gq + 3]) << 32);
            }
    }
}

#undef GATE
constexpr int SW_T = 0, SW_ML = 65536, SW_IMPG = SW_ML + 4096, SW_IMPE = SW_IMPG + 4096, SW_SEL = SW_IMPE + 4096, SW_UNI = SW_SEL + 256, SW_LIST = SW_UNI + 64,
              SW_PAGE = SW_LIST + 1280, SW_NL = SW_PAGE + 1280, SW_RANK = SW_NL + 64, SW_OUT = SW_RANK + 8 * 1024, SW_END = SW_OUT + 8192;
static_assert(SW_END <= RING_BYTES, "sample attention LDS map");
struct HRegs { f32x4 v[8]; };
__device__ __forceinline__ void h_load(const Frame& F, int l, int b, int kind, int ht, int pg, int which, int lane_in, HRegs& R) {
    int lane = lane_in; asm volatile("" : "+v"(lane));
    const int key = ht * 32 + (lane >> 1), hv = lane & 1;
    const float* base; size_t off; bool ok;
    if (kind <= KIND_CMP2) { ok = key < NCMP_S; const int kc = ok ? key : 0;
        base = WSP(F, float, which ? WS_CVS : WS_CKS); off = (((size_t)l * BS + b) * NCMP_S + kc) * 64; }
    else if (kind == KIND_SLC) { ok = key < PAST + TS;
        if (key < PAST) { base = INP(F, I_CACHE); off = ((((size_t)l * NPHYS + pg) * PAGE + (key & 127)) * 4 + 2 + which) * 64; }
        else { const int kk = ok ? key - PAST : 0; base = F.out + O_KVS; off = ((size_t)l * NS + b * TS + kk) * 256 + (2 + which) * 64; } }
    else { ok = (key >= PAST - 512) && (key < PAST + TS);
        if (key < PAST) { const int kk = ok ? key - (PAST - 512) : 0; base = INP(F, I_SWIN); off = (((size_t)l * BS + b) * 512 + kk) * 128 + which * 64; }
        else { const int kk = ok ? key - PAST : 0; base = WSP(F, float, WS_KWIN); off = ((size_t)NP + b * TS + kk) * 128 + which * 64; } }
    const float* p = base + off + hv * 32;
#pragma unroll
    for (int i = 0; i < 8; ++i) { const f32x4 x = *(const f32x4*)(p + 4 * i); R.v[i] = ok ? x : (f32x4){0.f, 0.f, 0.f, 0.f}; }
}
__device__ __forceinline__ void h_store_k(LAS unsigned char* kb, const HRegs& R, int lane_in) {
    int lane = lane_in; asm volatile("" : "+v"(lane));
    const int key = lane >> 1, hv = lane & 1;
#pragma unroll
    for (int i = 0; i < 4; ++i) { v4u o; o.x = cvtpk(R.v[2 * i].x, R.v[2 * i].y); o.y = cvtpk(R.v[2 * i].z, R.v[2 * i].w); o.z = cvtpk(R.v[2 * i + 1].x, R.v[2 * i + 1].y); o.w = cvtpk(R.v[2 * i + 1].z, R.v[2 * i + 1].w);
        *(LAS v4u*)(kb + key * 128 + (((4 * hv + i) ^ (key & 7)) << 4)) = o; }
}
__device__ __forceinline__ void h_store_v(LAS unsigned char* vb, const HRegs& R, int lane_in) {
    int lane = lane_in; asm volatile("" : "+v"(lane));
    const int key = lane >> 1, hv = lane & 1;
#pragma unroll
    for (int i = 0; i < 8; ++i) {
        const float xs[4] = {R.v[i].x, R.v[i].y, R.v[i].z, R.v[i].w};
#pragma unroll
        for (int k = 0; k < 4; ++k) { const int d = 32 * hv + 4 * i + k;
            *(LAS unsigned short*)(vb + d * 64 + (((key >> 2) ^ ((d >> 2) & 7)) << 3) + (key & 3) * 2) = (unsigned short)f2bf(xs[k]); }
    }
}
__device__ __forceinline__ void qk_half(const LAS unsigned char* kb, const bf16x8 (&qf)[4], f32x16& s0, int lane_in) {
    int lane = lane_in; asm volatile("" : "+v"(lane));
    const int r = lane & 31, h = lane >> 5;
#pragma unroll
    for (int i = 0; i < 16; ++i) s0[i] = 0.f;
#pragma unroll
    for (int ks = 0; ks < 4; ++ks) { const bf16x8 a0 = *(const LAS bf16x8*)(kb + r * 128 + (((2 * ks + h) ^ (r & 7)) << 4));
        s0 = __builtin_amdgcn_mfma_f32_32x32x16_bf16(a0, qf[ks], s0, 0, 0, 0); }
}
__device__ __forceinline__ void pv_half(const LAS unsigned char* vb, const f32x16& s0, f32x16 (&O)[2], int lane_in) {
    int lane = lane_in; asm volatile("" : "+v"(lane));
    const int r = lane & 31, h = lane >> 5;
    bf16x8 pf[2];
#pragma unroll
    for (int sp = 0; sp < 2; ++sp) { v4u a; a.x = cvtpk(s0[8 * sp + 0], s0[8 * sp + 1]); a.y = cvtpk(s0[8 * sp + 2], s0[8 * sp + 3]); a.z = cvtpk(s0[8 * sp + 4], s0[8 * sp + 5]); a.w = cvtpk(s0[8 * sp + 6], s0[8 * sp + 7]);
        pf[sp] = __builtin_bit_cast(bf16x8, a); }
#pragma unroll
    for (int dh = 0; dh < 2; ++dh) { const int d = dh * 32 + r, sw = (d >> 2) & 7; const LAS unsigned char* rb = vb + d * 64;
#pragma unroll
        for (int sp = 0; sp < 2; ++sp) { const int q0 = 4 * sp + h;
            const unsigned long long lo8 = *(const LAS unsigned long long*)(rb + ((q0 ^ sw) << 3)), hi8 = *(const LAS unsigned long long*)(rb + (((q0 + 2) ^ sw) << 3));
            v4u av; av.x = (unsigned)lo8; av.y = (unsigned)(lo8 >> 32); av.z = (unsigned)hi8; av.w = (unsigned)(hi8 >> 32);
            O[dh] = __builtin_amdgcn_mfma_f32_32x32x16_bf16(__builtin_bit_cast(bf16x8, av), pf[sp], O[dh], 0, 0, 0); } }
}
__device__ __forceinline__ void mask_half(f32x16& s0, int kbase, int lo, int hi) {
#pragma unroll
    for (int i = 0; i < 16; ++i) { const int k = kbase + (i & 3) + 8 * (i >> 2); if (k < lo || k > hi) s0[i] = -INFINITY; }
}
__device__ __forceinline__ float max16(const f32x16& s0) {
    float a = s0[0];
#pragma unroll
    for (int i = 1; i < 16; ++i) a = fmaxf(a, s0[i]);
    return half_max(a);
}
__device__ __forceinline__ void merge_branch(LAS unsigned char* lds, int wave, int lane, float m, float lsum, f32x16 (&O)[2], float gate) {
    LAS float* ml = (LAS float*)(lds + SW_ML); LAS float* outl = (LAS float*)(lds + SW_OUT) + lane;
    LAS float* slot = (LAS float*)(lds + SW_T + wave * 8192) + lane;
    const float lw = half_sum(lsum);
    ml[wave * 64 + lane] = m; ml[512 + wave * 64 + lane] = lw;
#pragma unroll
    for (int i = 0; i < 16; ++i) { slot[i * 64] = O[0][i]; slot[(16 + i) * 64] = O[1][i]; O[0][i] = 0.f; O[1][i] = 0.f; }
    __syncthreads();
    float M = -1e30f;
#pragma unroll
    for (int w = 0; w < 8; ++w) M = fmaxf(M, ml[w * 64 + lane]);
    float L = 0.f, sc[8];
#pragma unroll
    for (int w = 0; w < 8; ++w) { sc[w] = __builtin_amdgcn_exp2f(ml[w * 64 + lane] - M); L += ml[512 + w * 64 + lane] * sc[w]; }
    const float gl = (L > 0.f) ? gate / L : 0.f;
#pragma unroll
    for (int k = 0; k < 4; ++k) { const int i = wave * 4 + k; float a = 0.f;
#pragma unroll
        for (int w = 0; w < 8; ++w) a += ((LAS float*)(lds + SW_T + w * 8192))[i * 64 + lane] * sc[w];
        outl[i * 64] += a * gl; }
    __syncthreads();
}

__device__ __forceinline__ void attn_sample_unit(const Frame& F, int l, int b, int t0) {
    int lane_ = F.lane; asm volatile("" : "+v"(lane_));
    const int lane = lane_, wave = F.wave, tid = wave * 64 + lane, h = lane >> 5;
    LAS unsigned char* lds = F.lds;
    LAS unsigned char* kb = lds + SW_T + wave * 8192; LAS unsigned char* vb = kb + 4096;
    LAS float* impG = (LAS float*)(lds + SW_IMPG); LAS float* impE = (LAS float*)(lds + SW_IMPE);
    LAS unsigned* selw = (LAS unsigned*)(lds + SW_SEL); LAS unsigned* uni = (LAS unsigned*)(lds + SW_UNI);
    LAS int* list = (LAS int*)(lds + SW_LIST); LAS int* lpage = (LAS int*)(lds + SW_PAGE); LAS int* nlist = (LAS int*)(lds + SW_NL);
    LAS float* rankv = (LAS float*)(lds + SW_RANK + wave * 1024);
    LAS float* outl = (LAS float*)(lds + SW_OUT);
    const int tl = 0, head = lane & 3; const bool wcol = ((lane & 31) >> 2) == 0;
    const int r = NP + b * TS + t0, tpos = PAST + t0;
    bf16x8 qf[4];
    { const bf16* qb = WSP(F, bf16, WS_QB) + ((size_t)r * 4 + head) * 64;
#pragma unroll
      for (int ks = 0; ks < 4; ++ks) qf[ks] = *(const bf16x8*)(qb + 16 * ks + 8 * h); }
    const float* gp = WSP(F, float, WS_PROJ) + (size_t)r * IN_WP + OFF_G + head * 3;
    const float g0 = sigmoidf_(gp[0]), g1 = sigmoidf_(gp[1]), g2 = sigmoidf_(gp[2]);
    f32x16 O[2];
#pragma unroll
    for (int i = 0; i < 16; ++i) { O[0][i] = 0.f; O[1][i] = 0.f; }
    __syncthreads();
    if (tid < 64) selw[tid] = 0u;
    f32x16 sa, sb; float m = -1e30f, lsum = 0.f;
    {
        HRegs Ra, Rb; h_load(F, l, b, KIND_CMP1, wave, 0, 0, lane, Ra); h_load(F, l, b, KIND_CMP1, wave + 8, 0, 0, lane, Rb);
        h_store_k(kb, Ra, lane); asm volatile("s_waitcnt lgkmcnt(0)" ::: "memory");
        qk_half(kb, qf, sa, lane); mask_half(sa, wave * 32 + 4 * h, 0, NCMP_S - 1);
        asm volatile("s_waitcnt lgkmcnt(0)" ::: "memory");
        h_store_k(kb, Rb, lane); asm volatile("s_waitcnt lgkmcnt(0)" ::: "memory");
        qk_half(kb, qf, sb, lane); mask_half(sb, (wave + 8) * 32 + 4 * h, 0, NCMP_S - 1);
        m = fmaxf(max16(sa), max16(sb));
#pragma unroll
        for (int k = 0; k < 16; ++k) lsum += __builtin_amdgcn_exp2f(sa[k] - m) + __builtin_amdgcn_exp2f(sb[k] - m);
    }
    {
        LAS float* ml = (LAS float*)(lds + SW_ML);
        const float lw = half_sum(lsum);
        ml[wave * 64 + lane] = m; ml[512 + wave * 64 + lane] = lw;
        HRegs Ra, Rb; h_load(F, l, b, KIND_CMP2, wave, 0, 1, lane, Ra); h_load(F, l, b, KIND_CMP2, wave + 8, 0, 1, lane, Rb);
        __syncthreads();
        float M = -1e30f;
#pragma unroll
        for (int w = 0; w < 8; ++w) M = fmaxf(M, ml[w * 64 + lane]);
        float L = 0.f;
#pragma unroll
        for (int w = 0; w < 8; ++w) L += ml[512 + w * 64 + lane] * __builtin_amdgcn_exp2f(ml[w * 64 + lane] - M);
        const float rinv = L > 0.f ? 1.f / L : 0.f;
#pragma unroll
        for (int pass = 0; pass < 2; ++pass) {
            f32x16& sv = pass ? sb : sa; const int ht = pass ? wave + 8 : wave;
#pragma unroll
            for (int k = 0; k < 16; ++k) sv[k] = __builtin_amdgcn_exp2f(sv[k] - M) * rinv;
            if (pass) h_store_v(vb, Rb, lane); else h_store_v(vb, Ra, lane);
            asm volatile("s_waitcnt lgkmcnt(0)" ::: "memory");
            pv_half(vb, sv, O, lane);
            asm volatile("s_waitcnt lgkmcnt(0)" ::: "memory");
#pragma unroll
            for (int gq = 0; gq < 4; ++gq) {
                float G = (sv[4 * gq] + sv[4 * gq + 1]) + (sv[4 * gq + 2] + sv[4 * gq + 3]), E = sv[4 * gq + 3];
                G += __shfl_xor(G, 1); G += __shfl_xor(G, 2); E += __shfl_xor(E, 1); E += __shfl_xor(E, 2);
                const int j = 8 * ht + 2 * gq + h;
                if (head == 0) { impG[tl * 128 + j] = G; impE[tl * 128 + j] = E; }
            }
        }
        { LAS float* slot = (LAS float*)(lds + SW_T + wave * 8192) + lane;
#pragma unroll
          for (int i = 0; i < 16; ++i) { slot[i * 64] = O[0][i]; slot[(16 + i) * 64] = O[1][i]; O[0][i] = 0.f; O[1][i] = 0.f; } }
    }
    __syncthreads();
#pragma unroll
    for (int k = 0; k < 4; ++k) { const int i = wave * 4 + k; float a = 0.f;
#pragma unroll
        for (int w = 0; w < 8; ++w) a += ((LAS float*)(lds + SW_T + w * 8192))[i * 64 + lane];
        outl[i * 64 + lane] = a * g0; }
    __syncthreads();
    if (wave == 0) {
        const int tk = 0, cur = tpos >> 6;
        for (int j = lane; j < 132; j += 64) {
            float v;
            if (j > cur) v = -INFINITY;
            else if (j == 0 || j == cur || j == cur - 1) v = INFINITY;
            else v = impG[tk * 128 + j] + impE[tk * 128 + j - 1];
            rankv[j] = v;
        }
        asm volatile("s_waitcnt lgkmcnt(0)" ::: "memory");
        const float v0 = rankv[lane], v1 = rankv[64 + lane], v2 = (lane < 1) ? rankv[128 + lane] : -INFINITY;
        int r0 = 0, r1 = 0, r2 = 0;
        for (int k4 = 0; k4 < 132; k4 += 4) {
            const f32x4 vk = *(const LAS f32x4*)(rankv + k4);
#pragma unroll
            for (int u = 0; u < 4; ++u) { const float x = vk[u]; const int k = k4 + u;
                r0 += (x > v0 || (x == v0 && k < lane)) ? 1 : 0; r1 += (x > v1 || (x == v1 && k < 64 + lane)) ? 1 : 0; r2 += (x > v2 || (x == v2 && k < 128 + lane)) ? 1 : 0; }
        }
        const unsigned long long b0 = __ballot(r0 < 16 && lane <= cur), b1 = __ballot(r1 < 16 && 64 + lane <= cur), b2 = __ballot(lane < 1 && r2 < 16 && 128 + lane <= cur);
        if (lane == 0) { selw[tk * 8 + 0] = (unsigned)b0; selw[tk * 8 + 1] = (unsigned)(b0 >> 32); selw[tk * 8 + 2] = (unsigned)b1; selw[tk * 8 + 3] = (unsigned)(b1 >> 32); selw[tk * 8 + 4] = (unsigned)b2; }
    }
    __syncthreads();
    if (tid < 8) uni[tid] = selw[tid];
    __syncthreads();
    if (wave == 0) {
        int n = 0;
        for (int j0 = 0; j0 < 129; j0 += 64) {
            const int j = j0 + lane; const bool sj = (j < 129) && ((uni[j >> 5] >> (j & 31)) & 1u);
            int pg = 0; if (sj && j * 64 < PAST) pg = ((const int*)INP(F, I_PT))[b * NPAGES + (j >> 1)];
            const unsigned long long bal = __ballot(sj);
            if (sj) { const int idx = n + 2 * __popcll(bal & ((1ull << lane) - 1ull)); list[idx] = KIND_SLC | ((2 * j) << 4); list[idx + 1] = KIND_SLC | ((2 * j + 1) << 4); lpage[idx] = pg; lpage[idx + 1] = pg; }
            n += 2 * __popcll(bal);
        }
        if (lane == 0) nlist[0] = n;
        const int w0 = (PAST - 512) / 32, w1 = (PAST + TS - 1) / 32;
        if (lane <= w1 - w0) { list[n + lane] = KIND_WIN | ((w0 + lane) << 4); lpage[n + lane] = 0; }
        if (lane == 0) nlist[1] = n + (w1 - w0 + 1);
    }
    __syncthreads();
    const int n_slc = nlist[0], n_all = nlist[1];
#pragma unroll 1
    for (int br = 0; br < 2; ++br) {
        const int i0 = br ? n_slc : 0, i1 = br ? n_all : n_slc;
        m = -1e30f; lsum = 0.f;
        HRegs Rk, Rv;
        int it = i0 + wave;
        if (it < i1) { const int e = list[it], pg = lpage[it]; h_load(F, l, b, e & 15, e >> 4, pg, 0, lane, Rk); h_load(F, l, b, e & 15, e >> 4, pg, 1, lane, Rv); }
#pragma unroll 1
        for (; it < i1; it += 8) {
            const int e = __builtin_amdgcn_readfirstlane(list[it]); const int kind = e & 15, ht = e >> 4;
            h_store_k(kb, Rk, lane); h_store_v(vb, Rv, lane);
            if (it + 8 < i1) { const int e2 = list[it + 8], pg2 = lpage[it + 8]; h_load(F, l, b, e2 & 15, e2 >> 4, pg2, 0, lane, Rk); h_load(F, l, b, e2 & 15, e2 >> 4, pg2, 1, lane, Rv); }
            asm volatile("s_waitcnt lgkmcnt(0)" ::: "memory");
            int lo, hi;
            if (kind == KIND_SLC) { const int j = ht >> 1; const bool sbit = (selw[tl * 8 + (j >> 5)] >> (j & 31)) & 1u; lo = 0; hi = sbit ? tpos : -1; }
            else { lo = tpos - 511; hi = tpos; }
            f32x16 s0; qk_half(kb, qf, s0, lane);
            mask_half(s0, ht * 32 + 4 * h, lo, hi);
            const float mt = max16(s0); const float mn = fmaxf(m, mt); const float al = __builtin_amdgcn_exp2f(m - mn);
            float rs = 0.f;
#pragma unroll
            for (int k = 0; k < 16; ++k) { s0[k] = __builtin_amdgcn_exp2f(s0[k] - mn); rs += s0[k]; }
            lsum = lsum * al + rs; m = mn;
#pragma unroll
            for (int k = 0; k < 16; ++k) { O[0][k] *= al; O[1][k] *= al; }
            pv_half(vb, s0, O, lane);
            asm volatile("s_waitcnt lgkmcnt(0)" ::: "memory");
        }
        merge_branch(lds, wave, lane, m, lsum, O, br ? g2 : g1);
    }
    if (wave == 0 && wcol) {
        bf16* mo = WSP(F, bf16, WS_MIX) + (size_t)r * DM + 768 + head * 64;
#pragma unroll
        for (int dh = 0; dh < 2; ++dh)
#pragma unroll
            for (int gq = 0; gq < 4; ++gq) { const int d = dh * 32 + 8 * gq + 4 * h; const LAS float* o = outl + (dh * 16 + 4 * gq) * 64 + lane;
                *(unsigned long long*)(mo + d) = (unsigned long long)cvtpk(o[0], o[64]) | ((unsigned long long)cvtpk(o[128], o[192]) << 32); }
    }
    __syncthreads();
}


__device__ __forceinline__ void phase_attn2(const Frame& F, int l) {
    for (int u = blockIdx.x; u < 256; u += F.G) attn_unit(F, l, u & 7, (u >> 3) * 64, 64);
    Frame G2 = F; { int ln = G2.lane; asm volatile("" : "+v"(ln)); G2.lane = ln; G2.tid = G2.wave * 64 + ln; }
    for (int r = NP + G2.gw; r < MROWS; r += G2.ngw) ssd_finish_token(G2, l, r);
    {
        const int ncb = (F.G == 256) ? 64 : F.G;
        if ((int)blockIdx.x < ncb) {
            const f32x4* src = (const f32x4*)(INP(F, I_SWIN) + (size_t)l * BS * 512 * 128);
            f32x4* dst = (f32x4*)(F.out + O_WINS + (size_t)l * BS * 512 * 128);
            const int nth = ncb * NTHR;
            for (int i0 = blockIdx.x * NTHR + G2.tid; i0 < BS * 504 * 32; i0 += 4 * nth) {
                f32x4 v[4]; size_t o[4]; bool ok[4];
#pragma unroll
                for (int k = 0; k < 4; ++k) { const int i = i0 + k * nth; ok[k] = i < BS * 504 * 32; const int ic = ok[k] ? i : 0; const int b = ic / (504 * 32), rem = ic % (504 * 32);
                    o[k] = (size_t)b * 512 * 32 + rem; v[k] = src[o[k] + 8 * 32]; }
#pragma unroll
                for (int k = 0; k < 4; ++k) if (ok[k]) dst[o[k]] = v[k];
            }
        }
    }
    {
        unsigned* ctr = (unsigned*)(F.ws + WS_CTL) + 70000 + l * 16;
        volatile LAS int* su = (volatile LAS int*)(F.lds + RING_BYTES + 768);
        for (;;) {
            __syncthreads();
            if (G2.tid == 0) su[0] = (int)xb_add(ctr, 1u);
            __syncthreads();
            const int u = __builtin_amdgcn_readfirstlane(su[0]);
            if (u >= BP * 32) break;
            ssd_out_unit(G2, l, u >> 5, u & 31);
        }
    }
}


constexpr float LOG2E = 1.4426950408889634f;
constexpr int SD_B = 0, SD_BT = 32768, SD_C = 65536, SD_AC = 98304, SD_DT = SD_AC + 2048, SD_W = SD_DT + 2048, SD_END = SD_W + 2048;
static_assert(SD_END <= RING_BYTES, "ssd LDS map");
__device__ __forceinline__ int crow16(int i, int hp) { return (i & 3) + 8 * (i >> 2) + 4 * hp; }
__device__ __forceinline__ unsigned long long pack4bf(float a, float b, float c, float d) { return (unsigned long long)cvtpk(a, b) | ((unsigned long long)cvtpk(c, d) << 32); }

__device__ __forceinline__ void ssd_chunk_unit(const Frame& F, int l, int b, int c, int g) {
    const int tid = F.tid, lane = F.lane, wave = F.wave;
    LAS unsigned char* lds = F.lds;
    const float* proj = WSP(F, float, WS_PROJ);
    const size_t rbase = (size_t)b * TP + (size_t)c * 128;
    const float* cw = INP(F, I_CONVW) + (size_t)l * 4 * CONV_DIM; const float* cbv = INP(F, I_CONVB) + (size_t)l * CONV_DIM;
    LAS float* acs = (LAS float*)(lds + SD_AC); LAS float* dts = (LAS float*)(lds + SD_DT); LAS float* wts = (LAS float*)(lds + SD_W);
    __syncthreads();
    if (wave < 4) {
        const int hh = wave, head = 4 * g + hh;
        const float a2 = -expf(INP(F, I_ALOG)[l * SSD_H + head]) * LOG2E, dtb = INP(F, I_DTB)[l * SSD_H + head];
        const float d0 = softplusf_(proj[(rbase + 2 * lane) * IN_WP + OFF_DT + head] + dtb), d1 = softplusf_(proj[(rbase + 2 * lane + 1) * IN_WP + OFF_DT + head] + dtb);
        float sc = (d0 + d1) * a2;
#pragma unroll
        for (int o = 1; o < 64; o <<= 1) { const float t = __shfl_up(sc, o); if (lane >= o) sc += t; }
        const float ac1 = sc, ac0 = sc - d1 * a2; const float tot = __uint_as_float(__builtin_amdgcn_readlane(__float_as_uint(sc), 63));
        acs[hh * 128 + 2 * lane] = ac0; acs[hh * 128 + 2 * lane + 1] = ac1; dts[hh * 128 + 2 * lane] = d0; dts[hh * 128 + 2 * lane + 1] = d1;
        wts[hh * 128 + 2 * lane] = __builtin_amdgcn_exp2f(tot - ac0); wts[hh * 128 + 2 * lane + 1] = __builtin_amdgcn_exp2f(tot - ac1);
        float* acg = WSP(F, float, WS_SAC); acg[(rbase + 2 * lane) * SSD_H + head] = ac0; acg[(rbase + 2 * lane + 1) * SSD_H + head] = ac1;
        if (lane == 63) WSP(F, float, WS_SCD)[((size_t)b * 16 + c) * SSD_H + head] = __builtin_amdgcn_exp2f(tot);
    }
    {
        const int ch = tid & 255, th = tid >> 8;
        const int chan = (ch < 128) ? 512 + g * 128 + ch : 768 + g * 128 + (ch - 128);
        const float w0 = cw[chan], w1 = cw[CONV_DIM + chan], w2 = cw[2 * CONV_DIM + chan], w3 = cw[3 * CONV_DIM + chan], bb = cbv[chan];
        const int tl0 = th * 64;
        const float* src = proj + (rbase + tl0) * IN_WP + OFF_XBC + chan;
        const bool hasp = (c > 0) || (th > 0);
        float x0 = hasp ? src[-3 * IN_WP] : 0.f, x1 = hasp ? src[-2 * IN_WP] : 0.f, x2 = hasp ? src[-IN_WP] : 0.f;
        const int n = ch & 127;
        bf16* cbg = WSP(F, bf16, WS_SCB) + (rbase + tl0) * 256 + g * 128 + n;
        for (int i1 = 0; i1 < 64; i1 += 16) {
          float rawv[16];
#pragma unroll
          for (int k = 0; k < 16; ++k) rawv[k] = src[(size_t)(i1 + k) * IN_WP];
#pragma unroll
          for (int i2 = 0; i2 < 16; i2 += 4) { const int i0 = i1 + i2;
            float v[4];
#pragma unroll
            for (int k = 0; k < 4; ++k) { const float cur = rawv[i2 + k]; v[k] = siluf_(bb + w0 * x0 + w1 * x1 + w2 * x2 + w3 * cur); x0 = x1; x1 = x2; x2 = cur; }
            const int s = tl0 + i0;
            if (ch < 128) {
#pragma unroll
                for (int k = 0; k < 4; ++k) *(LAS unsigned short*)(lds + SD_B + (s + k) * 256 + (((n >> 3) ^ ((s + k) & 15)) << 4) + (n & 7) * 2) = (unsigned short)f2bf(v[k]);
                *(LAS unsigned long long*)(lds + SD_BT + n * 256 + (((s >> 2) ^ (n & 31)) << 3)) = pack4bf(v[0], v[1], v[2], v[3]);
            } else {
#pragma unroll
                for (int k = 0; k < 4; ++k) { const unsigned short hv = (unsigned short)f2bf(v[k]);
                    *(LAS unsigned short*)(lds + SD_C + (s + k) * 256 + (((n >> 3) ^ ((s + k) & 15)) << 4) + (n & 7) * 2) = hv; cbg[(size_t)(i0 + k) * 256] = hv; }
            }
          }
        }
    }
    __syncthreads();
    const int lb = wave & 3, hw = wave >> 2;
    int lane_g = lane; asm volatile("" : "+v"(lane_g));
    f32x16 Gt[4];
    {
        const int r32 = lane_g & 31, hp = lane_g >> 5, lloc = lb * 32 + r32;
        bf16x8 cf[8];
#pragma unroll
        for (int ks = 0; ks < 8; ++ks) cf[ks] = *(const LAS bf16x8*)(lds + SD_C + lloc * 256 + (((2 * ks + hp) ^ (lloc & 15)) << 4));
#pragma unroll
        for (int sb = 0; sb < 4; ++sb) {
#pragma unroll
            for (int i = 0; i < 16; ++i) Gt[sb][i] = 0.f;
            if (sb <= lb) {
                int s = sb * 32 + r32; asm volatile("" : "+v"(s));
#pragma unroll
                for (int ks = 0; ks < 8; ++ks) { const bf16x8 a = *(const LAS bf16x8*)(lds + SD_B + s * 256 + (((2 * ks + hp) ^ (s & 15)) << 4));
                    Gt[sb] = __builtin_amdgcn_mfma_f32_32x32x16_bf16(a, cf[ks], Gt[sb], 0, 0, 0); }
            }
            __builtin_amdgcn_sched_barrier(0);
        }
    }
    __syncthreads();
    for (int rd = 0; rd < 2; ++rd) {
        {
            int tid_r = tid; asm volatile("" : "+v"(tid_r));
            const int ch = tid_r & 127, tq = tid_r >> 7; const int hh2 = ch >> 6, p = ch & 63, hh = 2 * rd + hh2;
            const int chan = (4 * g + hh) * 64 + p;
            const float w0 = cw[chan], w1 = cw[CONV_DIM + chan], w2 = cw[2 * CONV_DIM + chan], w3 = cw[3 * CONV_DIM + chan], bb = cbv[chan];
            const int tl0 = tq * 32;
            const float* src = proj + (rbase + tl0) * IN_WP + OFF_XBC + chan;
            const bool hasp = (c > 0) || (tq > 0);
            float x0 = hasp ? src[-3 * IN_WP] : 0.f, x1 = hasp ? src[-2 * IN_WP] : 0.f, x2 = hasp ? src[-IN_WP] : 0.f;
            for (int i1 = 0; i1 < 32; i1 += 16) {
              float rawv[16];
#pragma unroll
              for (int k = 0; k < 16; ++k) rawv[k] = src[(size_t)(i1 + k) * IN_WP];
#pragma unroll
              for (int i2 = 0; i2 < 16; i2 += 4) { const int i0 = i1 + i2;
                float v[4]; const int s = tl0 + i0;
#pragma unroll
                for (int k = 0; k < 4; ++k) { const float cur = rawv[i2 + k]; v[k] = siluf_(bb + w0 * x0 + w1 * x1 + w2 * x2 + w3 * cur) * dts[hh * 128 + s + k]; x0 = x1; x1 = x2; x2 = cur; }
                *(LAS unsigned long long*)(lds + SD_C + hh2 * 16384 + p * 256 + (((s >> 2) ^ (p & 31)) << 3)) = pack4bf(v[0], v[1], v[2], v[3]);
              }
            }
        }
        __syncthreads();
        int lane_r = lane; asm volatile("" : "+v"(lane_r));
        const int r32 = lane_r & 31, hp = lane_r >> 5, lloc = lb * 32 + r32;
        const int hh = 2 * rd + hw, head = 4 * g + hh;
        const LAS float* ac = acs + hh * 128; const LAS float* wp = wts + hh * 128;
        const LAS unsigned char* xt = lds + SD_C + hw * 16384;
        const float acl = ac[lloc], ddt = INP(F, I_SSDD)[l * SSD_H + head] / dts[hh * 128 + lloc];
        f32x16 Y[2];
#pragma unroll
        for (int i = 0; i < 16; ++i) { Y[0][i] = 0.f; Y[1][i] = 0.f; }
#pragma unroll
        for (int sb = 0; sb < 4; ++sb) {
            if (sb <= lb) {
                f32x16 mt;
#pragma unroll
                for (int i = 0; i < 16; ++i) { const int s = sb * 32 + crow16(i, hp);
                    float mv = Gt[sb][i] * __builtin_amdgcn_exp2f(acl - ac[s]);
                    if (sb == lb) { mv = (s > lloc) ? 0.f : mv; mv += (s == lloc) ? ddt : 0.f; }
                    mt[i] = mv; }
                bf16x8 pf[2];
#pragma unroll
                for (int sp = 0; sp < 2; ++sp) { v4u a; a.x = cvtpk(mt[8 * sp + 0], mt[8 * sp + 1]); a.y = cvtpk(mt[8 * sp + 2], mt[8 * sp + 3]); a.z = cvtpk(mt[8 * sp + 4], mt[8 * sp + 5]); a.w = cvtpk(mt[8 * sp + 6], mt[8 * sp + 7]);
                    pf[sp] = __builtin_bit_cast(bf16x8, a); }
#pragma unroll
                for (int pt = 0; pt < 2; ++pt) { int p = pt * 32 + r32; asm volatile("" : "+v"(p)); const int sw = p & 31; const LAS unsigned char* rb = xt + p * 256;
#pragma unroll
                    for (int sp = 0; sp < 2; ++sp) { const int q0 = sb * 8 + 4 * sp + hp;
                        const unsigned long long lo8 = *(const LAS unsigned long long*)(rb + ((q0 ^ sw) << 3)), hi8 = *(const LAS unsigned long long*)(rb + (((q0 + 2) ^ sw) << 3));
                        v4u av; av.x = (unsigned)lo8; av.y = (unsigned)(lo8 >> 32); av.z = (unsigned)hi8; av.w = (unsigned)(hi8 >> 32);
                        Y[pt] = __builtin_amdgcn_mfma_f32_32x32x16_bf16(__builtin_bit_cast(bf16x8, av), pf[sp], Y[pt], 0, 0, 0); } }
            }
            __builtin_amdgcn_sched_barrier(0);
        }
        {
            float* yo = WSP(F, float, WS_YSSD) + (rbase + lloc) * SSD_W + head * 64;
#pragma unroll
            for (int pt = 0; pt < 2; ++pt)
#pragma unroll
                for (int qd = 0; qd < 4; ++qd) *(f32x4*)(yo + pt * 32 + 8 * qd + 4 * hp) = (f32x4){Y[pt][4 * qd], Y[pt][4 * qd + 1], Y[pt][4 * qd + 2], Y[pt][4 * qd + 3]};
        }
        {
            f32x16 St[2];
#pragma unroll
            for (int i = 0; i < 16; ++i) { St[0][i] = 0.f; St[1][i] = 0.f; }
            const int n = lb * 32 + r32;
#pragma unroll
            for (int ks = 0; ks < 8; ++ks) {
                const int cb0 = 4 * ks + 2 * hp; int nn = n; asm volatile("" : "+v"(nn));
                const unsigned long long blo = *(const LAS unsigned long long*)(lds + SD_BT + nn * 256 + ((cb0 ^ (nn & 31)) << 3)), bhi = *(const LAS unsigned long long*)(lds + SD_BT + nn * 256 + (((cb0 + 1) ^ (nn & 31)) << 3));
                v4u bv; bv.x = (unsigned)blo; bv.y = (unsigned)(blo >> 32); bv.z = (unsigned)bhi; bv.w = (unsigned)(bhi >> 32);
                const f32x4 wa = *(const LAS f32x4*)(wp + 16 * ks + 8 * hp), wb = *(const LAS f32x4*)(wp + 16 * ks + 8 * hp + 4);
#pragma unroll
                for (int pt = 0; pt < 2; ++pt) { const int p = pt * 32 + (nn & 31); const LAS unsigned char* rb = xt + p * 256;
                    const unsigned long long alo = *(const LAS unsigned long long*)(rb + ((cb0 ^ (p & 31)) << 3)), ahi = *(const LAS unsigned long long*)(rb + (((cb0 + 1) ^ (p & 31)) << 3));
                    const unsigned a0 = (unsigned)alo, a1 = (unsigned)(alo >> 32), a2 = (unsigned)ahi, a3 = (unsigned)(ahi >> 32);
                    v4u av;
                    av.x = cvtpk(__uint_as_float(a0 << 16) * wa.x, __uint_as_float(a0 & 0xffff0000u) * wa.y); av.y = cvtpk(__uint_as_float(a1 << 16) * wa.z, __uint_as_float(a1 & 0xffff0000u) * wa.w);
                    av.z = cvtpk(__uint_as_float(a2 << 16) * wb.x, __uint_as_float(a2 & 0xffff0000u) * wb.y); av.w = cvtpk(__uint_as_float(a3 << 16) * wb.z, __uint_as_float(a3 & 0xffff0000u) * wb.w);
                    St[pt] = __builtin_amdgcn_mfma_f32_32x32x16_bf16(__builtin_bit_cast(bf16x8, av), __builtin_bit_cast(bf16x8, bv), St[pt], 0, 0, 0); }
                __builtin_amdgcn_sched_barrier(0);
            }
            float* cs = WSP(F, float, WS_SCS) + (((size_t)b * 16 + c) * SSD_H + head) * (SSD_HD * SSD_N) + n;
#pragma unroll
            for (int pt = 0; pt < 2; ++pt)
#pragma unroll
                for (int i = 0; i < 16; ++i) cs[(size_t)(pt * 32 + crow16(i, hp)) * SSD_N] = St[pt][i];
        }
        __syncthreads();
    }
}

__device__ __forceinline__ void ssd_scan(const Frame& F, int l) {
    const float* cs = WSP(F, float, WS_SCS); const float* cd = WSP(F, float, WS_SCD); bf16* hs = WSP(F, bf16, WS_SHS);
    const bool upper = (F.G == 256);
    for (int idx0 = blockIdx.x * NTHR + F.tid; idx0 < BP * SSD_H * 2048; idx0 += F.G * NTHR) {
        if (upper && blockIdx.x < 128) continue;
#pragma unroll 1
        for (int rep = 0; rep < (upper ? 2 : 1); ++rep) {
            const int idx = upper ? idx0 - (1 - rep) * 65536 : idx0;
            const int e4 = idx & 2047, bh = idx >> 11, b = bh >> 3, h = bh & 7;
            f32x4 st = (f32x4){0.f, 0.f, 0.f, 0.f};
#pragma unroll 8
            for (int c = 0; c < 16; ++c) {
                const size_t o = (((size_t)b * 16 + c) * SSD_H + h) * (SSD_HD * SSD_N) + e4 * 4;
                *(unsigned long long*)(hs + o) = pack4bf(st.x, st.y, st.z, st.w);
                const f32x4 sv = *(const f32x4*)(cs + o); const float d = cd[((size_t)b * 16 + c) * SSD_H + h];
                st = st * d + sv;
            }
            *(f32x4*)(F.out + O_SSMP + (((size_t)l * BP + b) * SSD_H + h) * (SSD_HD * SSD_N) + e4 * 4) = st;
        }
    }
}

__device__ __forceinline__ void ssd_out_unit(const Frame& F, int l, int b, int hc) {
    const int lane = F.lane, h = F.wave, g = h >> 2, c = hc >> 1, l0 = hc * 64, r32 = lane & 31, hp = lane >> 5;
    LAS float* ssq = (LAS float*)F.lds;
    const bf16* Hs = WSP(F, bf16, WS_SHS) + (((size_t)b * 16 + c) * SSD_H + h) * (SSD_HD * SSD_N);
    const bf16* Cb = WSP(F, bf16, WS_SCB) + ((size_t)b * TP + l0) * 256 + g * 128;
    f32x16 Yo[2][2];
#pragma unroll
    for (int i = 0; i < 16; ++i) { Yo[0][0][i] = 0.f; Yo[0][1][i] = 0.f; Yo[1][0][i] = 0.f; Yo[1][1][i] = 0.f; }
#pragma unroll
    for (int ks = 0; ks < 8; ++ks) {
        bf16x8 af[2], bfr[2];
#pragma unroll
        for (int pt = 0; pt < 2; ++pt) af[pt] = *(const bf16x8*)(Hs + (size_t)(pt * 32 + r32) * SSD_N + 16 * ks + 8 * hp);
#pragma unroll
        for (int lt = 0; lt < 2; ++lt) bfr[lt] = *(const bf16x8*)(Cb + (size_t)(lt * 32 + r32) * 256 + 16 * ks + 8 * hp);
#pragma unroll
        for (int lt = 0; lt < 2; ++lt)
#pragma unroll
            for (int pt = 0; pt < 2; ++pt) Yo[lt][pt] = __builtin_amdgcn_mfma_f32_32x32x16_bf16(af[pt], bfr[lt], Yo[lt][pt], 0, 0, 0);
    }
    __syncthreads();
#pragma unroll
    for (int lt = 0; lt < 2; ++lt) {
        const size_t row = (size_t)b * TP + l0 + lt * 32 + r32;
        const float sc = __builtin_amdgcn_exp2f(WSP(F, float, WS_SAC)[row * SSD_H + h]);
        const float* yd = WSP(F, float, WS_YSSD) + row * SSD_W + h * 64; const float* zz = WSP(F, float, WS_PROJ) + row * IN_WP + h * 64;
        float ss = 0.f;
#pragma unroll
        for (int pt = 0; pt < 2; ++pt) {
            f32x4 y4v[4], z4v[4];
#pragma unroll
            for (int i = 0; i < 4; ++i) { const int p = pt * 32 + 8 * i + 4 * hp; y4v[i] = *(const f32x4*)(yd + p); z4v[i] = *(const f32x4*)(zz + p); }
#pragma unroll
            for (int qd = 0; qd < 4; ++qd) { const f32x4 y4 = y4v[qd], z4 = z4v[qd];
#pragma unroll
                for (int k = 0; k < 4; ++k) { const float v = (y4[k] + sc * Yo[lt][pt][4 * qd + k]) * siluf_(z4[k]); Yo[lt][pt][4 * qd + k] = v; ss += v * v; } }
        }
        ss = half_sum(ss);
        if (hp == 0) ssq[(lt * 32 + r32) * 8 + h] = ss;
    }
    __syncthreads();
    const float* nw = INP(F, I_SSDNORM) + (size_t)l * SSD_W + h * 64;
#pragma unroll
    for (int lt = 0; lt < 2; ++lt) {
        const size_t row = (size_t)b * TP + l0 + lt * 32 + r32;
        const LAS float* sq = ssq + (lt * 32 + r32) * 8;
        const float tot = ((sq[0] + sq[1]) + (sq[2] + sq[3])) + ((sq[4] + sq[5]) + (sq[6] + sq[7]));
        const float rs = 1.f / sqrtf(tot * (1.f / SSD_W) + RMS_EPS);
        bf16* mo = WSP(F, bf16, WS_MIX) + row * DM + h * 64;
#pragma unroll
        for (int pt = 0; pt < 2; ++pt)
#pragma unroll
            for (int qd = 0; qd < 4; ++qd) { const int p = pt * 32 + 8 * qd + 4 * hp; const f32x4 w4 = *(const f32x4*)(nw + p);
                *(unsigned long long*)(mo + p) = pack4bf(Yo[lt][pt][4 * qd] * rs * w4.x, Yo[lt][pt][4 * qd + 1] * rs * w4.y, Yo[lt][pt][4 * qd + 2] * rs * w4.z, Yo[lt][pt][4 * qd + 3] * rs * w4.w); }
    }
    __syncthreads();
}

__device__ __forceinline__ void resid_row(const Frame& F, const float* xold, const float* f, const bf16* fb, int nsl, size_t slstride, const float* w_post, float* xnew, const float* w_next, bf16* xn) {
    const f32x4* xo = (const f32x4*)xold + F.lane; const f32x4* fr = (const f32x4*)f + F.lane; const f32x4* wp = (const f32x4*)w_post + F.lane;
    f32x4 fv[4]; float ss = 0.f;
#pragma unroll
    for (int j = 0; j < 4; ++j) {
        if (fb) fv[j] = bf4_to_f32(((const unsigned long long*)fb + F.lane)[64 * j]); else fv[j] = fr[64 * j];
        for (int s = 1; s < nsl; ++s) fv[j] += ((const f32x4*)(f + s * slstride) + F.lane)[64 * j];
        ss += (fv[j].x * fv[j].x + fv[j].y * fv[j].y) + (fv[j].z * fv[j].z + fv[j].w * fv[j].w); }
    const float rs = 1.f / sqrtf(wave_sum(ss) * (1.f / DM) + RMS_EPS);
    f32x4 xv[4]; float s2 = 0.f;
#pragma unroll
    for (int j = 0; j < 4; ++j) { xv[j] = xo[64 * j] + fv[j] * rs * wp[64 * j]; s2 += (xv[j].x * xv[j].x + xv[j].y * xv[j].y) + (xv[j].z * xv[j].z + xv[j].w * xv[j].w);
        ((f32x4*)xnew + F.lane)[64 * j] = xv[j]; }
    if (w_next) {
        const float r2 = 1.f / sqrtf(wave_sum(s2) * (1.f / DM) + RMS_EPS);
        const f32x4* wn = (const f32x4*)w_next + F.lane; unsigned long long* o8 = (unsigned long long*)xn + F.lane;
#pragma unroll
        for (int j = 0; j < 4; ++j) { const f32x4 g = wn[64 * j];
            o8[64 * j] = (unsigned long long)pk2(xv[j].x * r2 * g.x, xv[j].y * r2 * g.y) | ((unsigned long long)pk2(xv[j].z * r2 * g.z, xv[j].w * r2 * g.w) << 32); }
    }
}
template <int NR>
__device__ __forceinline__ void resid_rowsN(const Frame& F, const float* xold, const bf16* f, const float* w_post, float* xnew, const float* w_next, bf16* xn) {
    const int lane = F.lane;
    unsigned long long fr[NR][4]; f32x4 xv[NR][4];
#pragma unroll
    for (int r = 0; r < NR; ++r)
#pragma unroll
        for (int j = 0; j < 4; ++j) { fr[r][j] = ((const unsigned long long*)(f + (size_t)r * DM) + lane)[64 * j]; xv[r][j] = ((const f32x4*)(xold + (size_t)r * DM) + lane)[64 * j]; }
    float rs[NR];
#pragma unroll
    for (int r = 0; r < NR; ++r) { float s = 0.f;
#pragma unroll
        for (int j = 0; j < 4; ++j) { const f32x4 v = bf4_to_f32(fr[r][j]); s += (v.x * v.x + v.y * v.y) + (v.z * v.z + v.w * v.w); }
        rs[r] = s; }
#pragma unroll
    for (int r = 0; r < NR; ++r) rs[r] = 1.f / sqrtf(wave_sum(rs[r]) * (1.f / DM) + RMS_EPS);
    float s2[NR];
#pragma unroll
    for (int r = 0; r < NR; ++r) s2[r] = 0.f;
#pragma unroll
    for (int j = 0; j < 4; ++j) { const f32x4 wp = ((const f32x4*)w_post + lane)[64 * j];
#pragma unroll
        for (int r = 0; r < NR; ++r) { xv[r][j] = xv[r][j] + bf4_to_f32(fr[r][j]) * rs[r] * wp;
            s2[r] += (xv[r][j].x * xv[r][j].x + xv[r][j].y * xv[r][j].y) + (xv[r][j].z * xv[r][j].z + xv[r][j].w * xv[r][j].w);
            ((f32x4*)(xnew + (size_t)r * DM) + lane)[64 * j] = xv[r][j]; } }
    if (w_next) {
#pragma unroll
        for (int r = 0; r < NR; ++r) s2[r] = 1.f / sqrtf(wave_sum(s2[r]) * (1.f / DM) + RMS_EPS);
#pragma unroll
        for (int j = 0; j < 4; ++j) { const f32x4 g = ((const f32x4*)w_next + lane)[64 * j];
#pragma unroll
            for (int r = 0; r < NR; ++r) { const float q = s2[r];
                ((unsigned long long*)(xn + (size_t)r * DM) + lane)[64 * j] = (unsigned long long)pk2(xv[r][j].x * q * g.x, xv[r][j].y * q * g.y) | ((unsigned long long)pk2(xv[r][j].z * q * g.z, xv[r][j].w * q * g.w) << 32); } }
    }
}
constexpr int RES_NR = 4;
__device__ __forceinline__ void phase_resid_mix(const Frame& F, int l) {
    for (int rp = F.gw; rp < NP / RES_NR; rp += F.ngw) { const int r = RES_NR * rp;
        const float* x0 = (l == 0) ? x_in_row(F, r) : WSP(F, float, WS_X) + (size_t)r * DM;
        resid_rowsN<RES_NR>(F, x0, WSP(F, bf16, WS_MIXO) + (size_t)r * DM, INP(F, I_NMPOST) + (size_t)l * DM, WSP(F, float, WS_X) + (size_t)r * DM,
                            INP(F, I_NFPRE) + (size_t)l * DM, WSP(F, bf16, WS_XN) + (size_t)r * DM);
    }
    for (int j = blockIdx.x * 8 + F.wave; j < NS * 8; j += F.G * 8) { if (j & 7) continue; const int r = NP + (j >> 3);
        const float* xold = (l == 0) ? x_in_row(F, r) : WSP(F, float, WS_X) + (size_t)r * DM;
        resid_row(F, xold, WSP(F, float, WS_SLAB) + (size_t)(r - NP) * DM, nullptr, SPLIT_OUT, (size_t)256 * DM, INP(F, I_NMPOST) + (size_t)l * DM, WSP(F, float, WS_X) + (size_t)r * DM,
                  INP(F, I_NFPRE) + (size_t)l * DM, WSP(F, bf16, WS_XN) + (size_t)r * DM);
    }
}
__device__ __forceinline__ void phase_resid_ffn(const Frame& F, int l) {
    const float* wn = (l == DEPTH - 1) ? nullptr : INP(F, I_NMPRE) + (size_t)(l + 1) * DM;
    for (int rp = F.gw; rp < NP / RES_NR; rp += F.ngw) { const int r = RES_NR * rp;
        float* xn = (l == DEPTH - 1) ? F.out + O_YP + (size_t)r * DM : WSP(F, float, WS_X) + (size_t)r * DM;
        resid_rowsN<RES_NR>(F, WSP(F, float, WS_X) + (size_t)r * DM, WSP(F, bf16, WS_MIXO) + (size_t)r * DM, INP(F, I_NFPOST) + (size_t)l * DM, xn, wn, WSP(F, bf16, WS_XN) + (size_t)r * DM);
    }
    for (int j = blockIdx.x * 8 + F.wave; j < NS * 8; j += F.G * 8) { if (j & 7) continue; const int r = NP + (j >> 3);
        float* xnew = (l == DEPTH - 1) ? F.out + O_YS + (size_t)(r - NP) * DM : WSP(F, float, WS_X) + (size_t)r * DM;
        resid_row(F, WSP(F, float, WS_X) + (size_t)r * DM, WSP(F, float, WS_SLAB) + (size_t)(r - NP) * DM, nullptr, SPLIT_DOWN, (size_t)256 * DM, INP(F, I_NFPOST) + (size_t)l * DM, xnew,
                  wn, WSP(F, bf16, WS_XN) + (size_t)r * DM);
    }
}

__device__ __forceinline__ void phase_ffn_act(const Frame& F, int l) {
    bf16* act = WSP(F, bf16, WS_ACT);
    const float* cw = INP(F, I_FCW) + (size_t)l * 3 * DFF; const float* cb = INP(F, I_FCB) + (size_t)l * DFF;
    const float* halo = WSP(F, float, WS_FHALO); const float* last = WSP(F, float, WS_FLAST); const float* raw = WSP(F, float, WS_FRAW);
    for (int it = F.gw; it < 64 * 2 * 16; it += F.ngw) {
        const int pm = it >> 5, j = (it >> 4) & 1, c = (it & 15) * 256 + F.lane * 4;
        const bool first = (pm & 7) == 0;
        const f32x4 z = (f32x4){0.f, 0.f, 0.f, 0.f};
        const f32x4 ga = *(const f32x4*)(halo + ((size_t)pm * 2 + j) * 8192 + c), vv = *(const f32x4*)(halo + ((size_t)pm * 2 + j) * 8192 + 4096 + c);
        f32x4 gb, gc;
        if (j == 0) { gb = first ? z : *(const f32x4*)(last + ((size_t)(pm - 1) * 2 + 1) * 4096 + c); gc = first ? z : *(const f32x4*)(last + ((size_t)(pm - 1) * 2 + 0) * 4096 + c); }
        else { gb = *(const f32x4*)(halo + ((size_t)pm * 2 + 0) * 8192 + c); gc = first ? z : *(const f32x4*)(last + ((size_t)(pm - 1) * 2 + 1) * 4096 + c); }
        const f32x4 w0 = *(const f32x4*)(cw + c), w1 = *(const f32x4*)(cw + DFF + c), w2 = *(const f32x4*)(cw + 2 * DFF + c), bb = *(const f32x4*)(cb + c);
        const f32x4 pre = gc * w0 + gb * w1 + ga * w2 + bb;
        const float a0 = gelu_tanh(pre.x) * vv.x, a1 = gelu_tanh(pre.y) * vv.y, a2 = gelu_tanh(pre.z) * vv.z, a3 = gelu_tanh(pre.w) * vv.w;
        *(unsigned long long*)(act + (size_t)(pm * 256 + j) * DFF + c) = (unsigned long long)pk2(a0, a1) | ((unsigned long long)pk2(a2, a3) << 32);
    }
    for (int jj = blockIdx.x * 8 + F.wave; jj < BP * 2 * 16 * 8; jj += F.G * 8) { if (jj & 7) continue; const int it = jj >> 3;
        const int b = it >> 5, j = (it >> 4) & 1, c = (it & 15) * 256 + F.lane * 4;
        *(f32x4*)(F.out + O_FFNP + (((size_t)l * BP + b) * 2 + j) * DFF + c) = *(const f32x4*)(last + ((size_t)(8 * b + 7) * 2 + j) * 4096 + c);
    }
    for (int it = F.gw; it < NS * 16; it += F.ngw) {
        const int r = NP + (it >> 4), j = it & 15;
        const int qq = r - NP, b = qq >> 3, t = qq & 7;
        const float* sffn = INP(F, I_SFFN) + ((size_t)l * BS + b) * 2 * DFF;
        const float* g0 = raw + (size_t)qq * 2 * DFF;
        { const int c = j * 256 + F.lane * 4;
            constexpr size_t SL = (size_t)256 * 2 * DFF;
            f32x4 ga = *(const f32x4*)(g0 + c), gb, gc, vv = *(const f32x4*)(g0 + DFF + c);
            if (t >= 1) gb = *(const f32x4*)(g0 - (size_t)2 * DFF + c); else gb = *(const f32x4*)(sffn + DFF + c);
            if (t >= 2) gc = *(const f32x4*)(g0 - (size_t)4 * DFF + c); else gc = *(const f32x4*)(sffn + (size_t)t * DFF + c);
#pragma unroll
            for (int sl = 1; sl < SPLIT_UP; ++sl) { ga += *(const f32x4*)(g0 + sl * SL + c); vv += *(const f32x4*)(g0 + sl * SL + DFF + c);
                if (t >= 1) gb += *(const f32x4*)(g0 + sl * SL - (size_t)2 * DFF + c);
                if (t >= 2) gc += *(const f32x4*)(g0 + sl * SL - (size_t)4 * DFF + c); }
            const f32x4 w0 = *(const f32x4*)(cw + c), w1 = *(const f32x4*)(cw + DFF + c), w2 = *(const f32x4*)(cw + 2 * DFF + c), bb = *(const f32x4*)(cb + c);
            const f32x4 pre = gc * w0 + gb * w1 + ga * w2 + bb;
            const float a0 = gelu_tanh(pre.x) * vv.x, a1 = gelu_tanh(pre.y) * vv.y, a2 = gelu_tanh(pre.z) * vv.z, a3 = gelu_tanh(pre.w) * vv.w;
            *(unsigned long long*)(act + (size_t)r * DFF + c) = (unsigned long long)pk2(a0, a1) | ((unsigned long long)pk2(a2, a3) << 32);
            if (t >= TS - 2) *(f32x4*)(F.out + O_FFNS + (((size_t)l * BS + b) * 2 + (t - (TS - 2))) * DFF + c) = ga;
        }
    }
}

__global__ void __launch_bounds__(NTHR, 2) hymba_fwd(Params prm) {
    extern __shared__ __attribute__((aligned(16))) unsigned char lds_raw[];
    Frame F;
    F.lds = (LAS unsigned char*)lds_raw;
#define REFRESH() do { unsigned z_ = 0u; asm volatile("" : "+v"(z_)); int ln_ = (int)__builtin_amdgcn_mbcnt_hi(~0u, __builtin_amdgcn_mbcnt_lo(~0u, z_)); F.lane = ln_; F.wave = wave_s; F.tid = wave_s * 64 + ln_; \
        F.gw = blockIdx.x * NWAVES + F.wave; \
        const __attribute__((address_space(4))) void* kp_ = (const __attribute__((address_space(4))) void*)__builtin_amdgcn_kernarg_segment_ptr(); asm volatile("" : "+s"(kp_)); \
        F.p = (const __attribute__((address_space(4))) Params*)kp_; F.ws = F.p->ws; F.out = F.p->out; } while (0)
    F.G = gridDim.x; F.ngw = F.G * NWAVES;
    const int wave_s = __builtin_amdgcn_readfirstlane((int)threadIdx.x >> 6);
    REFRESH();
    volatile LAS unsigned* MISC = (volatile LAS unsigned*)(F.lds + MISC_OFF);
    for (int u = F.tid; u < (LDS_BYTES - RING_BYTES) / 4; u += NTHR) ((LAS unsigned*)(F.lds + RING_BYTES))[u] = 0u;
    __syncthreads();
    const int lo = F.p->ph_lo, hi = F.p->ph_hi;
    const bool use_bar = (hi - lo) > 1;
    XcdBarrier bar; bar.bar = (unsigned*)(F.ws + WS_CTL) + 4096; bar.x = 0; bar.st = nullptr;
    if (use_bar) bar = xcd_barrier_post((unsigned*)(F.ws + WS_CTL) + 4096, MISC + 8);
#define IN(k) (lo <= (k) && (k) < hi)
#define SEAM(k) do { if (IN((k) + 1)) { REFRESH(); xcd_barrier(bar, F.tid == 0); } } while (0)

    if (IN(0)) { REFRESH(); phase_prologue(F); SEAM(0); }
    if (IN(1)) { REFRESH();
        for (int idx = blockIdx.x * NTHR + F.tid; idx < 8 * 128; idx += F.G * NTHR) {
            float a = 0.f;
#pragma unroll 16
            for (int ks = 0; ks < 64; ++ks) a += WSP(F, float, WS_SLAB)[ks * 1024 + idx];
            WSP(F, float, WS_CBIAS)[idx] = a;
        }
        pg8::Gemm g{WSP(F, pg8::bf16_t, WS_AS), WSP(F, pg8::bf16_t, WS_WTC), 8 * BS * 512, 256, 1024};
        pg8::CmpOrder S; S.G = F.G; S.c = (int)blockIdx.x;
        pg8::EpiCmp E{WSP(F, float, WS_HS)};
        pg8::gemm_phase<pg8::EpiCmp, pg8::CmpOrder, true, true>(F.lds, g, S, E, F.tid);
        SEAM(1);
    }
    if (IN(2)) { REFRESH(); phase_cmp_finish(F); SEAM(2); }
    for (int l = 0; l < DEPTH; ++l) {
        const int pb = N_PRO + l * PH_PER_LAYER;
        if (IN(pb + 0)) { REFRESH();
            pg8::Gemm g{WSP(F, pg8::bf16_t, WS_XN), WSP(F, pg8::bf16_t, WS_WTIN) + (size_t)l * IN_WP * DM, MROWS, IN_WP, DM};
            pg8::StaticOrder S; S.init(MROWS, IN_WP, F.G, (int)blockIdx.x);
            pg8::EpiF32 E{WSP(F, float, WS_PROJ), IN_WP};
            pg8::gemm_phase<pg8::EpiF32, pg8::StaticOrder, true, true>(F.lds, g, S, E, F.tid);
            SEAM(pb + 0);
        }
        if (IN(pb + 1)) { REFRESH(); phase_prep(F, l); SEAM(pb + 1); }
        if (IN(pb + 2)) { REFRESH(); phase_compress(F, l); SEAM(pb + 2); }
        if (IN(pb + 3)) { REFRESH(); phase_attn2(F, l); SEAM(pb + 3); }
        if (IN(pb + 4)) { REFRESH();
            pg8::Gemm g{WSP(F, pg8::bf16_t, WS_MIX), WSP(F, pg8::bf16_t, WS_WTOUT) + (size_t)l * DM * DM, MROWS, DM, DM};
            pg8::TailSplitOrder S; S.init(NP, DM, DM, SPLIT_OUT, F.G, (int)blockIdx.x);
            pg8::EpiB16Split E{WSP(F, pg8::bf16_t, WS_MIXO), WSP(F, float, WS_SLAB), DM, NP / 256};
            pg8::gemm_phase<pg8::EpiB16Split, pg8::TailSplitOrder, true, true>(F.lds, g, S, E, F.tid);
            SEAM(pb + 4);
        }
        if (IN(pb + 5)) { REFRESH(); phase_resid_mix(F, l); SEAM(pb + 5); }
        if (IN(pb + 6)) { REFRESH();
            pg8::Gemm g{WSP(F, pg8::bf16_t, WS_XN), WSP(F, pg8::bf16_t, WS_WTUP) + (size_t)l * 2 * DFF * DM, MROWS, 2 * DFF, DM};
            pg8::StaticOrder S; S.init(MROWS, 2 * DFF, F.G, (int)blockIdx.x);
            pg8::EpiFfn E{WSP(F, pg8::bf16_t, WS_ACT), WSP(F, float, WS_FRAW), WSP(F, float, WS_FHALO), WSP(F, float, WS_FLAST),
                          INP(F, I_FCW) + (size_t)l * 3 * DFF, INP(F, I_FCB) + (size_t)l * DFF, (LAS float*)(F.lds + XB_OFF), NP / 256};
            pg8::gemm_phase<pg8::EpiFfn, pg8::StaticOrder, true, true>(F.lds, g, S, E, F.tid);
            if (l + 1 < DEPTH) {
                int gwi = F.gw, ngwi = F.ngw; bool act = true;
                if (F.G == 256) { act = blockIdx.x >= 32; gwi = ((int)blockIdx.x - 32) * 8 + F.wave; ngwi = 224 * 8; }
                __syncthreads();
                if (act) weights_layer(F, l + 1, gwi, ngwi);
            }
            SEAM(pb + 6);
        }
        if (IN(pb + 7)) { REFRESH(); phase_ffn_act(F, l); SEAM(pb + 7); }
        if (IN(pb + 8)) { REFRESH();
            pg8::Gemm g{WSP(F, pg8::bf16_t, WS_ACT), WSP(F, pg8::bf16_t, WS_WTDN) + (size_t)l * DM * DFF, MROWS, DM, DFF};
            pg8::TailSplitOrder S; S.init(NP, DM, DFF, SPLIT_DOWN, F.G, (int)blockIdx.x);
            pg8::EpiB16Split E{WSP(F, pg8::bf16_t, WS_MIXO), WSP(F, float, WS_SLAB), DM, NP / 256};
            pg8::gemm_phase<pg8::EpiB16Split, pg8::TailSplitOrder, true, true>(F.lds, g, S, E, F.tid);
            SEAM(pb + 8);
        }
        if (IN(pb + 9)) { REFRESH(); phase_resid_ffn(F, l); SEAM(pb + 9); }
    }
#undef IN
#undef SEAM
}

#ifndef N_LAUNCH_MODE
#define N_LAUNCH_MODE 1
#endif
extern "C" void kernel_launch(void* const* d_in, const int* in_sizes, int n_in, void* d_out, int out_size, void* d_ws, size_t ws_size, hipStream_t stream) {
    static int grid = 0;
    if (grid == 0) {
        if (n_in != N_IN || (size_t)out_size != O_END || ws_size < WS_END) {
            fprintf(stderr, "kernel_launch: unexpected shapes: n_in %d (want %d), out %d (want %zu), ws %zu (want >= %zu); nothing launched\n", n_in, (int)N_IN, out_size, (size_t)O_END, ws_size, (size_t)WS_END);
            grid = -1; return; }
        int dev = 0, cus = 0, per_cu = 0;
        if (hipGetDevice(&dev) != hipSuccess || hipDeviceGetAttribute(&cus, hipDeviceAttributeMultiprocessorCount, dev) != hipSuccess) { grid = -1; return; }
        if (hipFuncSetAttribute((const void*)hymba_fwd, hipFuncAttributeMaxDynamicSharedMemorySize, LDS_BYTES) != hipSuccess) { fprintf(stderr, "kernel_launch: hipFuncSetAttribute failed\n"); grid = -1; return; }
        if (hipOccupancyMaxActiveBlocksPerMultiprocessor(&per_cu, (const void*)hymba_fwd, NTHR, LDS_BYTES) != hipSuccess || per_cu < 1)
            fprintf(stderr, "kernel_launch: note: occupancy query reports %d workgroups per CU\n", per_cu);
        (void)hipGetLastError();
        grid = cus;
    }
    if (grid < 0) return;
    (void)hipMemsetAsync((char*)d_ws + WS_CTL, 0, CTL_BYTES, stream);
    Params prm{};
    for (int i = 0; i < N_IN; ++i) prm.in[i] = (const float*)d_in[i];
    prm.out = (float*)d_out; prm.ws = (unsigned char*)d_ws;
#if N_LAUNCH_MODE == 1
    prm.ph_lo = 0; prm.ph_hi = N_PHASES;
    hipLaunchKernelGGL(hymba_fwd, dim3(grid), dim3(NTHR), LDS_BYTES, stream, prm);
#else
    for (int ph = 0; ph < N_PHASES; ++ph) {
        prm.ph_lo = ph; prm.ph_hi = ph + 1;
        hipLaunchKernelGGL(hymba_fwd, dim3(grid), dim3(NTHR), LDS_BYTES, stream, prm);
    }
#endif
}
```
